# Optimizing an MI355X kernel written in HIP

```python
import jax, jax.numpy as jnp
from jax import lax
import numpy as np

D_MODEL = 1024
BATCH = 8
SEQ = 4096
DEPTH = 1

GRID_W = 64
CTX_LEN = 256
EPS = 1e-6
HG_HEADS = 4
HG_DK = 128
HG_DV = 128
HG_WIDTH = HG_HEADS * HG_DK
CHUNK = 64
FT_GROUPS = 4
FT_GROUP_W = 128
FT_WIDTH = FT_GROUPS * FT_GROUP_W
IN_COLS = 5 * HG_WIDTH + FT_WIDTH + 2 * D_MODEL
SPLIT_POINTS = (HG_WIDTH, 2 * HG_WIDTH, 3 * HG_WIDTH, 4 * HG_WIDTH, 5 * HG_WIDTH,
                5 * HG_WIDTH + FT_WIDTH, 5 * HG_WIDTH + FT_WIDTH + D_MODEL)
PEER_HEADS = 8
PEER_NKEYS = 128
PEER_EXPERTS = PEER_NKEYS * PEER_NKEYS
PEER_DKEY = 256
PEER_TOPK = 16
PEER_TOKEN_BLOCK = 128

kernel_name = "hgrn2_fnet_peer_prefix_dit"


def _rmsnorm(x, g):
    x32 = x.astype(jnp.float32)
    y = x32 * lax.rsqrt(jnp.mean(x32 * x32, axis=-1, keepdims=True) + EPS)
    return y.astype(x.dtype) * g


def _modulate(x, g, shift, scale):
    return _rmsnorm(x, g) * (1.0 + scale) + shift


def _heads(t, n_heads):
    b, l, _ = t.shape
    return t.reshape(b, l, n_heads, -1).transpose(0, 2, 1, 3)


def _flip(t):
    return jnp.flip(t, axis=2)


def _forget(z, lb):
    return lb + (1.0 - lb) * jax.nn.sigmoid(_heads(z, HG_HEADS).astype(jnp.float32))


def _hgrn2_scan(q, f, v, s0):
    b_, h_, l_, dk = q.shape
    n = l_ // CHUNK
    f32 = jnp.float32
    rs = lambda t: t.reshape(b_, h_, n, CHUNK, t.shape[-1])
    q32 = rs(q.astype(f32) * (dk ** -0.5))
    logf = rs(jnp.log(f))
    k = rs(1.0 - f)
    v32 = rs(v.astype(f32))
    b = jnp.cumsum(logf, axis=3)
    b_mid = b[:, :, :, CHUNK // 2 - 1:CHUNK // 2, :]
    b_last = b[:, :, :, -1:, :]
    a = jnp.einsum('bhnik,bhnjk->bhnij', q32 * jnp.exp(b - b_mid), k * jnp.exp(b_mid - b))
    mask = jnp.tril(jnp.ones((CHUNK, CHUNK), dtype=bool))
    a = jnp.where(mask, a, 0.0)
    o_intra = jnp.einsum('bhnij,bhnjv->bhniv', a, v32)
    q_dec = q32 * jnp.exp(b)
    k_dec = k * jnp.exp(b_last - b)
    decay = jnp.exp(b_last[:, :, :, 0, :])

    def step(s, xs):
        qd, kd, vc, dc = xs
        o = jnp.einsum('bhck,bhkv->bhcv', qd, s)
        s = dc[..., None] * s + jnp.einsum('bhck,bhcv->bhkv', kd, vc)
        return s, o

    xs = (jnp.moveaxis(q_dec, 2, 0), jnp.moveaxis(k_dec, 2, 0),
          jnp.moveaxis(v32, 2, 0), jnp.moveaxis(decay, 2, 0))
    s_final, o_inter = lax.scan(step, s0.astype(f32), xs)
    o = o_intra + jnp.moveaxis(o_inter, 0, 2)
    return o.reshape(b_, h_, l_, -1), s_final


def _hgrn2_final_state(f, v):
    b = jnp.cumsum(jnp.log(f), axis=2)
    k_dec = (1.0 - f) * jnp.exp(b[:, :, -1:, :] - b)
    return jnp.einsum('bhlk,bhlv->bhkv', k_dec, v.astype(jnp.float32))


def _fourier(t):
    b_, l_, _ = t.shape
    t32 = t.astype(jnp.float32).reshape(b_, l_, FT_GROUPS, FT_GROUP_W)
    y = jnp.fft.fftn(t32, axes=(1, 3), norm='ortho').real
    return y.reshape(b_, l_, FT_WIDTH).astype(t.dtype)


def _merge(o_hg, zg, zft, zgh, zgf, hg_norm_g, w_hg_out, w_ft_out, w_out):
    dt = zg.dtype
    o = o_hg * lax.rsqrt(jnp.mean(o_hg * o_hg, axis=-1, keepdims=True) + EPS) * hg_norm_g[:, None, :]
    b_, h_, l_, dv = o.shape
    o = o.transpose(0, 2, 1, 3).reshape(b_, l_, h_ * dv).astype(dt) * jax.nn.silu(zg)
    y_hg = o @ w_hg_out
    y_ft = _fourier(zft) @ w_ft_out
    y = jax.nn.sigmoid(zgh) * y_hg + jax.nn.sigmoid(zgf) * y_ft
    return y @ w_out


def _peer(u, w_q, sub_keys, u_tab, v_tab):
    b_, l_, d = u.shape
    xt = u.reshape(-1, PEER_TOKEN_BLOCK, d)

    def block(xb):
        t = xb.shape[0]
        q = (xb @ w_q).reshape(t, PEER_HEADS, 2, PEER_DKEY // 2)
        s = jnp.einsum('thpk,hpnk->thpn', q, sub_keys).astype(jnp.float32)
        sv, si = lax.top_k(s, PEER_TOPK)
        cand = sv[:, :, 0, :, None] + sv[:, :, 1, None, :]
        cidx = si[:, :, 0, :, None] * PEER_NKEYS + si[:, :, 1, None, :]
        cv, ci = lax.top_k(cand.reshape(t, PEER_HEADS, PEER_TOPK * PEER_TOPK), PEER_TOPK)
        eidx = jnp.take_along_axis(cidx.reshape(t, PEER_HEADS, PEER_TOPK * PEER_TOPK), ci, axis=-1)
        gates = jax.nn.softmax(cv, axis=-1)
        ue = jnp.take(u_tab, eidx, axis=0)
        act = jax.nn.gelu(jnp.einsum('thkd,td->thk', ue, xb), approximate=False)
        ve = jnp.take(v_tab, eidx, axis=0)
        w = (gates * act.astype(jnp.float32)).astype(v_tab.dtype)
        return jnp.einsum('thk,thkd->td', w, ve)

    return lax.map(block, xt).reshape(b_, l_, d)


def setup_inputs(seed: int = 0) -> dict:
    key = jax.random.key(seed)
    ks = jax.random.split(key, 20)
    nrm = lambda k, shape, s: jax.random.normal(k, shape, jnp.float32) * s
    return {
        "x": nrm(ks[0], (BATCH, SEQ, D_MODEL), 1.0),
        "c": nrm(ks[1], (BATCH, D_MODEL), 1.0),
        "ctx": nrm(ks[2], (BATCH, CTX_LEN, D_MODEL), 1.0),
        "c_ctx": nrm(ks[3], (D_MODEL,), 1.0),
        "w_ada": nrm(ks[4], (DEPTH, D_MODEL, 6 * D_MODEL), 0.5 * D_MODEL ** -0.5),
        "b_ada": nrm(ks[5], (DEPTH, 6 * D_MODEL), 0.02),
        "norm_mix_g": 1.0 + nrm(ks[6], (DEPTH, D_MODEL), 0.02),
        "norm_ffn_g": 1.0 + nrm(ks[7], (DEPTH, D_MODEL), 0.02),
        "w_in": nrm(ks[8], (DEPTH, D_MODEL, IN_COLS), D_MODEL ** -0.5),
        "hg_lb_f": nrm(ks[9], (DEPTH + 1, HG_WIDTH), 0.1),
        "hg_lb_b": nrm(ks[10], (DEPTH + 1, HG_WIDTH), 0.1),
        "hg_norm_g": 1.0 + nrm(ks[11], (DEPTH, HG_HEADS, HG_DV), 0.02),
        "w_hg_out": nrm(ks[12], (DEPTH, HG_WIDTH, D_MODEL), HG_WIDTH ** -0.5),
        "w_ft_out": nrm(ks[13], (DEPTH, FT_WIDTH, D_MODEL), FT_WIDTH ** -0.5),
        "w_out": nrm(ks[14], (DEPTH, D_MODEL, D_MODEL), D_MODEL ** -0.5),
        "peer_w_q": nrm(ks[15], (DEPTH, D_MODEL, PEER_HEADS * PEER_DKEY), D_MODEL ** -0.5),
        "peer_sub_keys": nrm(ks[16], (DEPTH, PEER_HEADS, 2, PEER_NKEYS, PEER_DKEY // 2), (PEER_DKEY // 2) ** -0.5),
        "peer_u": nrm(ks[17], (DEPTH, PEER_EXPERTS, D_MODEL), D_MODEL ** -0.5),
        "peer_v": nrm(ks[18], (DEPTH, PEER_EXPERTS, D_MODEL), PEER_HEADS ** -0.5),
        "final_norm_g": 1.0 + nrm(ks[19], (D_MODEL,), 0.02),
    }


def reference(x, c, ctx, c_ctx, w_ada, b_ada, norm_mix_g, norm_ffn_g, w_in, hg_lb_f, hg_lb_b,
              hg_norm_g, w_hg_out, w_ft_out, w_out, peer_w_q, peer_sub_keys, peer_u, peer_v,
              final_norm_g):
    lb_f_all = jnp.cumsum(jax.nn.softmax(hg_lb_f.astype(jnp.float32), axis=0), axis=0)
    lb_b_all = jnp.cumsum(jax.nn.softmax(hg_lb_b.astype(jnp.float32), axis=0), axis=0)
    h, hc = x, ctx
    for l in range(DEPTH):
        lb_f = lb_f_all[l].reshape(HG_HEADS, 1, HG_DK)
        lb_b = lb_b_all[l].reshape(HG_HEADS, 1, HG_DK)
        mod = jax.nn.silu(c) @ w_ada[l] + b_ada[l]
        sh1, sc1, g1, sh2, sc2, g2 = jnp.split(mod[:, None, :], 6, axis=-1)
        modc = jax.nn.silu(c_ctx) @ w_ada[l] + b_ada[l]
        sh1c, sc1c, g1c, sh2c, sc2c, g2c = jnp.split(modc, 6)

        uc = _modulate(hc, norm_mix_g[l], sh1c, sc1c)
        if l < DEPTH - 1:
            qc, ffc, fbc, ic, gc, ftc, ghc, gfc = jnp.split(uc @ w_in[l], SPLIT_POINTS, axis=-1)
            ffc, fbc = _forget(ffc, lb_f), _forget(fbc, lb_b)
            vc, qch = _heads(ic, HG_HEADS), _heads(qc, HG_HEADS)
            zeros = jnp.zeros((hc.shape[0], HG_HEADS, HG_DK, HG_DV), jnp.float32)
            oc_f, s_f = _hgrn2_scan(qch, ffc, vc, zeros)
            oc_b, s_b = _hgrn2_scan(_flip(qch), _flip(fbc), _flip(vc), zeros)
            hc = hc + g1c * _merge(oc_f + _flip(oc_b), gc, ftc, ghc, gfc,
                                   hg_norm_g[l], w_hg_out[l], w_ft_out[l], w_out[l])
            hc = hc + g2c * _peer(_modulate(hc, norm_ffn_g[l], sh2c, sc2c),
                                  peer_w_q[l], peer_sub_keys[l], peer_u[l], peer_v[l])
        else:
            ffc, fbc, ic = jnp.split(uc @ w_in[l][:, HG_WIDTH:4 * HG_WIDTH], 3, axis=-1)
            vc = _heads(ic, HG_HEADS)
            s_f = _hgrn2_final_state(_forget(ffc, lb_f), vc)
            s_b = _hgrn2_final_state(_flip(_forget(fbc, lb_b)), _flip(vc))

        u = _modulate(h, norm_mix_g[l], sh1, sc1)
        q, ff, fb, i, g, ft, gh, gf = jnp.split(u @ w_in[l], SPLIT_POINTS, axis=-1)
        qh, vh = _heads(q, HG_HEADS), _heads(i, HG_HEADS)
        o_f, _ = _hgrn2_scan(qh, _forget(ff, lb_f), vh, s_f)
        o_b, _ = _hgrn2_scan(_flip(qh), _flip(_forget(fb, lb_b)), _flip(vh), s_b)
        h = h + g1 * _merge(o_f + _flip(o_b), g, ft, gh, gf,
                            hg_norm_g[l], w_hg_out[l], w_ft_out[l], w_out[l])
        h = h + g2 * _peer(_modulate(h, norm_ffn_g[l], sh2, sc2),
                           peer_w_q[l], peer_sub_keys[l], peer_u[l], peer_v[l])
    return _rmsnorm(h, final_norm_g)
```

```cpp
#include <hip/hip_runtime.h>
#include <hip/hip_cooperative_groups.h>
#include <cstdio>
#include <cstdint>
namespace cg = cooperative_groups;
namespace pg8 {
#define PG8_LAS __attribute__((address_space(3)))
typedef _Float16 f16x8 __attribute__((ext_vector_type(8)));
typedef float f32x4 __attribute__((ext_vector_type(4)));
typedef unsigned u32x4 __attribute__((ext_vector_type(4)));
typedef unsigned u32x2 __attribute__((ext_vector_type(2)));
constexpr int BM = 256, BK = 64, HALF = 128, HTB = HALF * BK * 2, STAGE_BYTES = 8 * HTB, NXCD = 8, WGM = 8;

__host__ __device__ __forceinline__ int lds_byte(int r, int c) { const int st = (r >> 4) * 2 + (c >> 5), rr = r & 15, cc = c & 31, ob = rr * 64 + cc * 2; return st * 1024 + (ob ^ (((ob >> 9) & 1) << 5)); }
__host__ __device__ __forceinline__ void stage_rc(int b, int& R, int& C) { const int st = b / 1024, sb = b % 1024, swz = sb ^ (((sb >> 9) & 1) << 5); R = (st >> 1) * 16 + swz / 64; C = (st & 1) * 32 + (swz % 64) / 2; }
__host__ __device__ __forceinline__ int perm32(int rho) { const int n = rho >> 4, i = rho & 15; return 8 * (i >> 2) + 4 * n + (i & 3); }

struct Unit { int pm, pn; };
struct Gemm { const void* A; const void* Bt; int lda, ldb, K; };

struct TileOrder {
    int nM, nN, nwg, G, c;
    __device__ void init(int nM_, int nN_, int G_, int c_) { nM = nM_; nN = nN_; nwg = nM * nN; G = G_; c = c_; }
    __device__ bool map(long L, Unit& u) const {
        if (L >= nwg) return false;
        int wgid = (int)L; { const int q = nwg / NXCD, r = nwg % NXCD, xcd = wgid % NXCD, off = wgid / NXCD; wgid = (xcd < r ? xcd * (q + 1) : r * (q + 1) + (xcd - r) * q) + off; }
        const int nig = WGM * nN, gid = wgid / nig, fm = gid * WGM, gsz = (nM - fm) < WGM ? (nM - fm) : WGM;
        u.pm = fm + ((wgid % nig) % gsz); u.pn = (wgid % nig) / gsz; return true;
    }
    __device__ bool next(int i, Unit& u) const { return map((long)i * G + c, u); }
};

template <class Epi, class Sched>
__device__ __forceinline__ void gemm_phase(PG8_LAS unsigned char* lds, const Gemm g, const Sched& S, const Epi& E) {
    const int tid = threadIdx.x, wid = __builtin_amdgcn_readfirstlane(tid >> 6), lane = tid & 63, wr = wid >> 2, wc = wid & 3, fr = lane & 15, fq = lane >> 4;
    const int K = g.K, nt = K / BK;
    unsigned voffA[2], voffB[2];
#pragma unroll
    for (int i = 0; i < 2; ++i) { int R, C; stage_rc(tid * 16 + i * 8192, R, C); const int Rb = Epi::PERM ? ((R & ~31) + perm32(R & 31)) : R;
        voffA[i] = (unsigned)(R * g.lda + C) * 2u; voffB[i] = (unsigned)(Rb * g.ldb + C) * 2u; }
    const size_t kstep = (size_t)(BK * 2);
    const size_t hstepA = (size_t)HALF * g.lda * 2, hstepB = (size_t)HALF * g.ldb * 2;
    const size_t tstepA = 2 * hstepA, tstepB = 2 * hstepB;
    const unsigned ldsw = (unsigned)wid * 1024u;
    const int aoff = lds_byte(wr * 64 + fr, fq * 8), boff = lds_byte(wc * 32 + fr, fq * 8);
#define PG8_SA(b, h) (((b) * 2 + (h)) * HTB)
#define PG8_SB(b, h) ((4 + (b) * 2 + (h)) * HTB)
#define PG8_STAGE(bufoff, gbase, voff) do { _Pragma("unroll") for (int _i = 0; _i < 2; ++_i) \
        __builtin_amdgcn_global_load_lds((const unsigned*)((const char*)(gbase) + (voff)[_i]), (PG8_LAS unsigned*)(lds + (bufoff) + ldsw + _i * 8192), 16, 0, 0); } while (0)
#define PG8_LDA(dst, b, h) do { _Pragma("unroll") for (int m = 0; m < 4; ++m) _Pragma("unroll") for (int k = 0; k < 2; ++k) dst[m][k] = *(const PG8_LAS f16x8*)(lds + PG8_SA(b, h) + aoff + m * 2048 + k * 1024); } while (0)
#define PG8_LDB(dst, b, h) do { _Pragma("unroll") for (int n = 0; n < 2; ++n) _Pragma("unroll") for (int k = 0; k < 2; ++k) dst[n][k] = *(const PG8_LAS f16x8*)(lds + PG8_SB(b, h) + boff + n * 2048 + k * 1024); } while (0)
#define PG8_MMA(ai, bj, At, Bt) do { __builtin_amdgcn_s_setprio(1); _Pragma("unroll") for (int m = 0; m < 4; ++m) _Pragma("unroll") for (int n = 0; n < 2; ++n) _Pragma("unroll") for (int k = 0; k < 2; ++k) \
        acc[ai][bj][m][n] = Epi::TRANS ? __builtin_amdgcn_mfma_f32_16x16x32_f16(Bt[n][k], At[m][k], acc[ai][bj][m][n], 0, 0, 0) \
                                       : __builtin_amdgcn_mfma_f32_16x16x32_f16(At[m][k], Bt[n][k], acc[ai][bj][m][n], 0, 0, 0); __builtin_amdgcn_s_setprio(0); } while (0)
#define PG8_WAIT_V(n) asm volatile("s_waitcnt vmcnt(" #n ")" ::: "memory")
#define PG8_WAIT_L(n) asm volatile("s_waitcnt lgkmcnt(" #n ")" ::: "memory")
#define PG8_BAR __builtin_amdgcn_s_barrier()
#define PG8_SCHED __builtin_amdgcn_sched_barrier(0)
    Unit cur, nxt; int ui = 0;
    if (!S.next(0, cur)) return;
    f32x4 acc[2][2][4][2];
#pragma unroll
    for (int a = 0; a < 2; ++a)
#pragma unroll
        for (int b = 0; b < 2; ++b)
#pragma unroll
            for (int m = 0; m < 4; ++m)
#pragma unroll
                for (int n = 0; n < 2; ++n) acc[a][b][m][n] = (f32x4){0.f, 0.f, 0.f, 0.f};
    f16x8 At[4][2], B0[2][2], B1[2][2];
    const char* cA = (const char*)g.A + (size_t)cur.pm * tstepA; const char* cB = (const char*)g.Bt + (size_t)cur.pn * tstepB;
    PG8_STAGE(PG8_SB(0, 0), cB, voffB); PG8_STAGE(PG8_SA(0, 0), cA, voffA); PG8_STAGE(PG8_SB(0, 1), cB + hstepB, voffB); PG8_STAGE(PG8_SA(0, 1), cA + hstepA, voffA);
    if (wr == 1) PG8_BAR;
    PG8_WAIT_V(4); PG8_BAR;
    PG8_STAGE(PG8_SB(1, 0), cB + kstep, voffB); PG8_STAGE(PG8_SA(1, 0), cA + kstep, voffA); PG8_STAGE(PG8_SB(1, 1), cB + hstepB + kstep, voffB);
    PG8_WAIT_V(6); PG8_BAR;
    for (;;) {
        const bool has_next = S.next(ui + 1, nxt);
        const char* nA = has_next ? (const char*)g.A + (size_t)nxt.pm * tstepA : cA; const char* nB = has_next ? (const char*)g.Bt + (size_t)nxt.pn * tstepB : cB;
        for (int t = 0; t < nt; t += 2) {
            const bool last = (t == nt - 2);
            const char* a1 = cA + (size_t)(t + 1) * kstep;
            const char* a2 = last ? nA : cA + (size_t)(t + 2) * kstep; const char* b2 = last ? nB : cB + (size_t)(t + 2) * kstep;
            const char* a3 = a2 + kstep; const char* b3 = b2 + kstep;
            PG8_LDB(B0, 0, 0); PG8_SCHED; PG8_LDA(At, 0, 0); PG8_STAGE(PG8_SA(1, 1), a1 + hstepA, voffA);
            PG8_WAIT_L(8); PG8_BAR; PG8_WAIT_L(0); PG8_MMA(0, 0, At, B0); PG8_BAR; PG8_SCHED;
            PG8_LDB(B1, 0, 1); PG8_STAGE(PG8_SB(0, 0), b2, voffB);
            PG8_BAR; PG8_WAIT_L(0); PG8_MMA(0, 1, At, B1); PG8_BAR;
            PG8_LDA(At, 0, 1); PG8_STAGE(PG8_SA(0, 0), a2, voffA);
            PG8_BAR; PG8_WAIT_L(0); PG8_MMA(1, 0, At, B0); PG8_BAR; PG8_SCHED;
            PG8_STAGE(PG8_SB(0, 1), b2 + hstepB, voffB);
            PG8_WAIT_V(6); PG8_BAR; PG8_MMA(1, 1, At, B1); PG8_BAR;
            PG8_LDB(B0, 1, 0); PG8_SCHED; PG8_LDA(At, 1, 0); PG8_STAGE(PG8_SA(0, 1), a2 + hstepA, voffA);
            PG8_WAIT_L(8); PG8_BAR; PG8_WAIT_L(0); PG8_MMA(0, 0, At, B0); PG8_BAR; PG8_SCHED;
            PG8_LDB(B1, 1, 1); PG8_STAGE(PG8_SB(1, 0), b3, voffB);
            PG8_BAR; PG8_WAIT_L(0); PG8_MMA(0, 1, At, B1); PG8_BAR;
            PG8_LDA(At, 1, 1); PG8_STAGE(PG8_SA(1, 0), a3, voffA);
            PG8_BAR; PG8_WAIT_L(0); PG8_MMA(1, 0, At, B0); PG8_BAR; PG8_SCHED;
            PG8_STAGE(PG8_SB(1, 1), b3 + hstepB, voffB);
            PG8_WAIT_V(6); PG8_BAR; PG8_MMA(1, 1, At, B1); PG8_BAR;
        }
        E(acc, cur, wr, wc, fr, fq);
        if (!has_next) break;
#pragma unroll
        for (int a = 0; a < 2; ++a)
#pragma unroll
            for (int b = 0; b < 2; ++b)
#pragma unroll
                for (int m = 0; m < 4; ++m)
#pragma unroll
                    for (int n = 0; n < 2; ++n) acc[a][b][m][n] = (f32x4){0.f, 0.f, 0.f, 0.f};
        cur = nxt; cA = nA; cB = nB; ++ui;
    }
    PG8_WAIT_V(0);
    if (wr == 0) PG8_BAR;
    PG8_BAR;
#undef PG8_SA
#undef PG8_SB
#undef PG8_STAGE
#undef PG8_LDA
#undef PG8_LDB
#undef PG8_MMA
#undef PG8_WAIT_V
#undef PG8_WAIT_L
#undef PG8_BAR
#undef PG8_SCHED
}
}
#define LAS __attribute__((address_space(3)))
typedef _Float16 h16;
typedef h16 h16x2 __attribute__((ext_vector_type(2)));
typedef h16 h16x4 __attribute__((ext_vector_type(4)));
typedef h16 h16x8 __attribute__((ext_vector_type(8)));
typedef float f32x4 __attribute__((ext_vector_type(4)));
typedef float f32x2 __attribute__((ext_vector_type(2)));
typedef unsigned u32x4 __attribute__((ext_vector_type(4)));
typedef unsigned u32x2 __attribute__((ext_vector_type(2)));

constexpr int D = 1024, NB = 8, SEQ = 4096, T = NB * SEQ, LC = 256, TC = NB * LC, TALL = T + TC;
constexpr int NTHREADS = 512;
constexpr int LDS_BYTES = 136 * 1024;
constexpr float EPS = 1e-6f;
constexpr size_t MiB = (size_t)1 << 20;
constexpr size_t OFF_CTL = 0;
constexpr size_t OFF_MOD = 64 * 1024;
constexpr size_t OFF_LB = 320 * 1024;
constexpr size_t OFF_WA = 1 * MiB;
constexpr size_t OFF_WG = 6 * MiB;
constexpr size_t OFF_WF = 10 * MiB;
constexpr size_t OFF_WHG = 12 * MiB;
constexpr size_t OFF_WFT = 13 * MiB;
constexpr size_t OFF_WOUT = 14 * MiB;
constexpr size_t OFF_WS = 16 * MiB;
constexpr size_t OFF_UALL = 20 * MiB;
constexpr size_t OFF_OF = 88 * MiB;
constexpr size_t OFF_OB = 120 * MiB;
constexpr size_t OFF_FTT = 152 * MiB;
constexpr size_t OFF_Q = 216 * MiB;
constexpr size_t OFF_LF = 248 * MiB;
constexpr size_t OFF_LBK = 282 * MiB;
constexpr size_t OFF_V = 316 * MiB;
constexpr size_t OFF_G = 350 * MiB;
constexpr size_t OFF_DFTM = 382 * MiB;
constexpr size_t OFF_YFT = 446 * MiB;
constexpr size_t WS_NEED = 478 * MiB;
constexpr size_t OFF_GH = 216 * MiB;
constexpr size_t OFF_GF = 280 * MiB;
constexpr size_t OFF_Y = 152 * MiB;
constexpr size_t OFF_U2 = 20 * MiB;
constexpr size_t OFF_TU = 88 * MiB;
constexpr size_t OFF_TV = 120 * MiB;
constexpr size_t OFF_SC = 216 * MiB;
constexpr size_t OFF_EIDX = 152 * MiB;
constexpr size_t OFF_GATE = 168 * MiB;

struct Params { const float* in[20]; float* out; unsigned char* ws; int ph_lo, ph_hi; };

__device__ __forceinline__ unsigned pk2(float a, float b) { h16x2 v = {(h16)a, (h16)b}; return __builtin_bit_cast(unsigned, v); }
__device__ __forceinline__ float wave_sum(float v) {
#pragma unroll
    for (int o = 32; o >= 1; o >>= 1) v += __shfl_xor(v, o);
    return v; }
__device__ __forceinline__ float sigmoidf_(float z) { return 1.0f / (1.0f + __expf(-z)); }

constexpr int N_MOD = 96, N_LB = 1, N_TRA = 640, N_TRG = 512, N_TRHG = 128, N_TRFT = 128, N_TROUT = 256, N_WF = 128, N_WSF = 256, N_DFT = 256;
constexpr int P0_TOTAL = N_MOD + N_LB + N_TRA + N_TRG + N_TRHG + N_TRFT + N_TROUT + N_WF + N_WSF + N_DFT;

__device__ void p0_mod(const Params& p, LAS float* sm, int idx) {
    const int tid = threadIdx.x;
    for (int i = tid; i < 9 * 1024; i += NTHREADS) { const int r = i >> 10, k = i & 1023; const float c = (r < 8) ? p.in[1][r * 1024 + k] : p.in[3][k]; sm[i] = c / (1.0f + __expf(-c)); }
    __syncthreads();
    const int col = tid & 63, ks = tid >> 6;
    float acc[9];
#pragma unroll
    for (int r = 0; r < 9; ++r) acc[r] = 0.f;
    const float* w = p.in[4] + (size_t)(ks * 128) * 6144 + idx * 64 + col;
#pragma unroll 4
    for (int k = 0; k < 128; ++k) { const float wv = w[(size_t)k * 6144];
#pragma unroll
        for (int r = 0; r < 9; ++r) acc[r] += sm[r * 1024 + ks * 128 + k] * wv; }
    LAS float* red = sm + 9 * 1024;
#pragma unroll
    for (int r = 0; r < 9; ++r) red[(ks * 9 + r) * 64 + col] = acc[r];
    __syncthreads();
    float* mod = (float*)(p.ws + OFF_MOD);
    for (int i = tid; i < 576; i += NTHREADS) { const int r = i >> 6, c = i & 63; float s = 0.f;
#pragma unroll
        for (int q = 0; q < 8; ++q) s += red[(q * 9 + r) * 64 + c];
        mod[r * 6144 + idx * 64 + c] = s + p.in[5][idx * 64 + c]; }
    __syncthreads();
}
__device__ void p0_lb(const Params& p) {
    const int tid = threadIdx.x; float* lb = (float*)(p.ws + OFF_LB);
    if (tid < 512) { lb[tid] = 1.0f / (1.0f + expf(p.in[9][512 + tid] - p.in[9][tid])); lb[512 + tid] = 1.0f / (1.0f + expf(p.in[10][512 + tid] - p.in[10][tid])); }
}
__device__ void p0_transpose(const float* src, int ld_src, int ncol0, h16* dst, int ld_dst, int nktiles, int item, LAS float* sm) {
    const int tid = threadIdx.x, kt = item % nktiles, nt = item / nktiles;
    { const int n = tid & 63, kk = tid >> 6;
#pragma unroll
      for (int ps = 0; ps < 8; ++ps) { const int k = kk + 8 * ps; sm[k * 65 + n] = src[(size_t)(kt * 64 + k) * ld_src + ncol0 + nt * 64 + n]; } }
    __syncthreads();
    { const int k = tid & 63, nn = tid >> 6;
#pragma unroll
      for (int ps = 0; ps < 8; ++ps) { const int n = nn + 8 * ps; dst[(size_t)(nt * 64 + n) * ld_dst + kt * 64 + k] = (h16)sm[k * 65 + n]; } }
    __syncthreads();
}
__device__ void p0_wf(const Params& p, LAS float* sm, int item) {
    const int tid = threadIdx.x, dt = item & 15, part = (item >> 4) & 1, g = item >> 5, d0 = dt * 64;
    LAS float* w = sm; LAS float* trig = sm + 64 * 129;
    for (int i = tid; i < 64 * 128; i += NTHREADS) { const int dl = i >> 7, n2 = i & 127; w[dl * 129 + n2] = p.in[8][(size_t)(d0 + dl) * 5120 + 2560 + g * 128 + n2]; }
    if (tid < 128) trig[tid] = part ? sinpif((float)tid / 64.0f) : cospif((float)tid / 64.0f);
    __syncthreads();
    const int dl = tid & 63, kg = tid >> 6; h16* WF = (h16*)(p.ws + OFF_WF);
#pragma unroll 1
    for (int kk = 0; kk < 16; ++kk) { const int k2 = kg * 16 + kk; float s = 0.f;
#pragma unroll 4
        for (int n2 = 0; n2 < 128; ++n2) s += w[dl * 129 + n2] * trig[(k2 * n2) & 127];
        WF[(size_t)(part * 512 + g * 128 + k2) * 1024 + d0 + dl] = (h16)(s * 0.08838834764831845f); }
    __syncthreads();
}
__device__ void p0_wsf(const Params& p, LAS float* sm, int item) {
    const int tid = threadIdx.x, dt = item & 15, hp = item >> 4, d0 = dt * 64;
    LAS float* wq = sm; LAS float* sk = sm + 8256;
    for (int i = tid; i < 64 * 128; i += NTHREADS) { const int dl = i >> 7, k = i & 127; wq[dl * 129 + k] = p.in[15][(size_t)(d0 + dl) * 2048 + hp * 128 + k]; }
    for (int i = tid; i < 128 * 128; i += NTHREADS) sk[i] = p.in[16][(size_t)hp * 16384 + i];
    __syncthreads();
    const int dl = tid & 63, ng = tid >> 6; h16* WS = (h16*)(p.ws + OFF_WS);
#pragma unroll 1
    for (int nn = 0; nn < 16; ++nn) { const int n = ng * 16 + nn; float s = 0.f;
#pragma unroll 4
        for (int k = 0; k < 128; ++k) s += wq[dl * 129 + k] * sk[n * 128 + k];
        WS[(size_t)(hp * 128 + n) * 1024 + d0 + dl] = (h16)s; }
    __syncthreads();
}
__device__ void p0_dftm(const Params& p, LAS float* sm, int item) {
    const int tid = threadIdx.x;
    for (int i = tid; i < 4096; i += NTHREADS) sm[i] = cospif((float)i / 2048.0f) * (1.0f / 64.0f);
    __syncthreads();
    h16* M = (h16*)(p.ws + OFF_DFTM);
#pragma unroll 1
    for (int e = tid; e < 16 * 1024; e += NTHREADS) { const int k1 = item * 16 + (e >> 10), K0 = (e & 1023) * 8, part = K0 >> 12, n1 = K0 & 4095;
        float v[8];
#pragma unroll
        for (int j = 0; j < 8; ++j) { const int m = (k1 * (n1 + j)) & 4095; v[j] = part ? -sm[(m - 1024) & 4095] : sm[m]; }
        u32x4 w; w.x = pk2(v[0], v[1]); w.y = pk2(v[2], v[3]); w.z = pk2(v[4], v[5]); w.w = pk2(v[6], v[7]);
        *(u32x4*)(M + (size_t)k1 * 8192 + K0) = w; }
    __syncthreads();
}
__device__ void phase0(const Params& p, LAS unsigned char* lds) {
    LAS float* sm = (LAS float*)lds;
    for (int it = blockIdx.x; it < P0_TOTAL; it += gridDim.x) {
        int i = it;
        if (i < N_MOD) { p0_mod(p, sm, i); continue; } i -= N_MOD;
        if (i < N_LB) { p0_lb(p); continue; } i -= N_LB;
        if (i < N_TRA) { p0_transpose(p.in[8], 5120, 0, (h16*)(p.ws + OFF_WA), 1024, 16, i, sm); continue; } i -= N_TRA;
        if (i < N_TRG) { p0_transpose(p.in[8], 5120, 3072, (h16*)(p.ws + OFF_WG), 1024, 16, i, sm); continue; } i -= N_TRG;
        if (i < N_TRHG) { p0_transpose(p.in[12], 1024, 0, (h16*)(p.ws + OFF_WHG), 512, 8, i, sm); continue; } i -= N_TRHG;
        if (i < N_TRFT) { p0_transpose(p.in[13], 1024, 0, (h16*)(p.ws + OFF_WFT), 512, 8, i, sm); continue; } i -= N_TRFT;
        if (i < N_TROUT) { p0_transpose(p.in[14], 1024, 0, (h16*)(p.ws + OFF_WOUT), 1024, 16, i, sm); continue; } i -= N_TROUT;
        if (i < N_WF) { p0_wf(p, sm, i); continue; } i -= N_WF;
        if (i < N_WSF) { p0_wsf(p, sm, i); continue; } i -= N_WSF;
        p0_dftm(p, sm, i);
    }
}

__device__ void modulate_rows(const float* src, h16* dst, int nrows, const float* gvec, const float* mod, int sh_off, int sc_off, int ctx_rows) {
    const int wave = threadIdx.x >> 6, lane = threadIdx.x & 63;
    for (int row = blockIdx.x * 8 + wave; row < nrows; row += gridDim.x * 8) {
        const int mr = ctx_rows ? 8 : (row >> 12);
        const float* x = src + (size_t)row * D;
        f32x4 v[4]; float ss = 0.f;
#pragma unroll
        for (int j = 0; j < 4; ++j) { v[j] = *(const f32x4*)(x + j * 256 + lane * 4); ss += v[j].x * v[j].x + v[j].y * v[j].y + v[j].z * v[j].z + v[j].w * v[j].w; }
        ss = wave_sum(ss);
        const float rstd = rsqrtf(ss * (1.0f / D) + EPS);
#pragma unroll
        for (int j = 0; j < 4; ++j) { const int c = j * 256 + lane * 4;
            const f32x4 gg = *(const f32x4*)(gvec + c), sc = *(const f32x4*)(mod + mr * 6144 + sc_off + c), sh = *(const f32x4*)(mod + mr * 6144 + sh_off + c);
            const f32x4 o = (v[j] * rstd) * gg * (sc + 1.0f) + sh;
            u32x2 w; w.x = pk2(o.x, o.y); w.y = pk2(o.z, o.w);
            *(u32x2*)(dst + (size_t)row * D + c) = w; }
    }
}

struct EpiA {
    static constexpr bool PERM = true, TRANS = true;
    unsigned char* ws;
    __device__ __forceinline__ void operator()(const f32x4 (&acc)[2][2][4][2], const pg8::Unit& u, int wr, int wc, int fr, int fq) const {
        const int ty = u.pn >> 1;
        h16* base = (h16*)(ws + (ty == 0 ? OFF_Q : ty == 1 ? OFF_LF : ty == 2 ? OFF_LBK : ty == 3 ? OFF_V : OFF_G));
        const float* lb = (const float*)(ws + OFF_LB) + (ty == 2 ? 512 : 0);
        const int row0 = u.pm * 256 + wr * 64 + fr, col0 = (u.pn & 1) * 256 + wc * 32 + 8 * fq;
#pragma unroll
        for (int bj = 0; bj < 2; ++bj) {
            float lbv[8];
            if (ty == 1 || ty == 2) {
#pragma unroll
                for (int j = 0; j < 8; ++j) lbv[j] = lb[col0 + bj * 128 + j];
            }
#pragma unroll
            for (int ai = 0; ai < 2; ++ai)
#pragma unroll
                for (int m = 0; m < 4; ++m) {
                    float v[8];
#pragma unroll
                    for (int j = 0; j < 4; ++j) { v[j] = acc[ai][bj][m][0][j]; v[4 + j] = acc[ai][bj][m][1][j]; }
                    if (ty == 0) {
#pragma unroll
                        for (int j = 0; j < 8; ++j) v[j] *= 0.08838834764831845f;
                    } else if (ty == 1 || ty == 2) {
#pragma unroll
                        for (int j = 0; j < 8; ++j) v[j] = __logf(lbv[j] + (1.0f - lbv[j]) * sigmoidf_(v[j]));
                    } else if (ty == 4) {
#pragma unroll
                        for (int j = 0; j < 8; ++j) v[j] = v[j] * sigmoidf_(v[j]);
                    }
                    u32x4 w; w.x = pk2(v[0], v[1]); w.y = pk2(v[2], v[3]); w.z = pk2(v[4], v[5]); w.w = pk2(v[6], v[7]);
                    *(u32x4*)(base + (size_t)(row0 + ai * 128 + m * 16) * 512 + col0 + bj * 128) = w;
                }
        }
    }
};
struct OrderA {
    pg8::TileOrder lat; int G, c;
    __device__ void init(int G_, int c_) { lat.init(128, 10, G_, c_); G = G_; c = c_; }
    __device__ bool next(int i, pg8::Unit& u) const {
        const long L = (long)i * G + c;
        if (L < 1280) return lat.map(L, u);
        const int l2 = (int)(L - 1280); if (l2 >= 48) return false;
        u.pm = 128 + l2 / 6; u.pn = 2 + l2 % 6; return true;
    }
};
struct EpiGate {
    static constexpr bool PERM = true, TRANS = true;
    unsigned char* ws;
    __device__ __forceinline__ void operator()(const f32x4 (&acc)[2][2][4][2], const pg8::Unit& u, int wr, int wc, int fr, int fq) const {
        h16* base = (h16*)(ws + (u.pn < 4 ? OFF_GH : OFF_GF));
        const int row0 = u.pm * 256 + wr * 64 + fr, col0 = (u.pn & 3) * 256 + wc * 32 + 8 * fq;
#pragma unroll
        for (int ai = 0; ai < 2; ++ai)
#pragma unroll
            for (int m = 0; m < 4; ++m)
#pragma unroll
                for (int bj = 0; bj < 2; ++bj) {
                    float v[8];
#pragma unroll
                    for (int j = 0; j < 4; ++j) { v[j] = sigmoidf_(acc[ai][bj][m][0][j]); v[4 + j] = sigmoidf_(acc[ai][bj][m][1][j]); }
                    u32x4 w; w.x = pk2(v[0], v[1]); w.y = pk2(v[2], v[3]); w.z = pk2(v[4], v[5]); w.w = pk2(v[6], v[7]);
                    *(u32x4*)(base + (size_t)(row0 + ai * 128 + m * 16) * 1024 + col0 + bj * 128) = w;
                }
    }
};
struct EpiFT {
    static constexpr bool PERM = false, TRANS = false;
    unsigned char* ws;
    __device__ __forceinline__ void operator()(const f32x4 (&acc)[2][2][4][2], const pg8::Unit& u, int wr, int wc, int fr, int fq) const {
        h16* F = (h16*)(ws + OFF_FTT);
        const int t0 = u.pm * 256 + wr * 64 + 4 * fq, c0 = u.pn * 256 + wc * 32 + fr;
#pragma unroll
        for (int ai = 0; ai < 2; ++ai)
#pragma unroll
            for (int m = 0; m < 4; ++m)
#pragma unroll
                for (int bj = 0; bj < 2; ++bj)
#pragma unroll
                    for (int n = 0; n < 2; ++n) {
                        const int t = t0 + ai * 128 + m * 16, c = c0 + bj * 128 + n * 16;
                        const int b = t >> 12, n1 = t & 4095, part = c >> 9, gk = c & 511;
                        const f32x4 a = acc[ai][bj][m][n];
                        u32x2 w; w.x = pk2(a.x, a.y); w.y = pk2(a.z, a.w);
                        *(u32x2*)(F + ((size_t)((b * 512 + gk) * 2 + part)) * 4096 + n1) = w;
                    }
    }
};
struct EpiDFT {
    static constexpr bool PERM = true, TRANS = true;
    unsigned char* ws;
    __device__ __forceinline__ void operator()(const f32x4 (&acc)[2][2][4][2], const pg8::Unit& u, int wr, int wc, int fr, int fq) const {
        h16* Y = (h16*)(ws + OFF_YFT);
        const int b = u.pn >> 1;
        const int row0 = b * 4096 + u.pm * 256 + wr * 64 + fr, col0 = (u.pn & 1) * 256 + wc * 32 + 8 * fq;
#pragma unroll
        for (int ai = 0; ai < 2; ++ai)
#pragma unroll
            for (int m = 0; m < 4; ++m)
#pragma unroll
                for (int bj = 0; bj < 2; ++bj) {
                    const f32x4 a0 = acc[ai][bj][m][0], a1 = acc[ai][bj][m][1];
                    u32x4 w; w.x = pk2(a0.x, a0.y); w.y = pk2(a0.z, a0.w); w.z = pk2(a1.x, a1.y); w.w = pk2(a1.z, a1.w);
                    *(u32x4*)(Y + (size_t)(row0 + ai * 128 + m * 16) * 512 + col0 + bj * 128) = w;
                }
    }
};
template <bool ACCUM> struct EpiMerge1 {
    static constexpr bool PERM = true, TRANS = true;
    unsigned char* ws;
    __device__ __forceinline__ void operator()(const f32x4 (&acc)[2][2][4][2], const pg8::Unit& u, int wr, int wc, int fr, int fq) const {
        h16* Y = (h16*)(ws + OFF_Y); const h16* GT = (const h16*)(ws + (ACCUM ? OFF_GF : OFF_GH));
        const int row0 = u.pm * 256 + wr * 64 + fr, col0 = u.pn * 256 + wc * 32 + 8 * fq;
#pragma unroll
        for (int ai = 0; ai < 2; ++ai)
#pragma unroll
            for (int m = 0; m < 4; ++m)
#pragma unroll
                for (int bj = 0; bj < 2; ++bj) {
                    const size_t off = (size_t)(row0 + ai * 128 + m * 16) * 1024 + col0 + bj * 128;
                    const h16x8 gt = *(const h16x8*)(GT + off);
                    float v[8];
#pragma unroll
                    for (int j = 0; j < 4; ++j) { v[j] = acc[ai][bj][m][0][j] * (float)gt[j]; v[4 + j] = acc[ai][bj][m][1][j] * (float)gt[4 + j]; }
                    if (ACCUM) { const h16x8 y0 = *(const h16x8*)(Y + off);
#pragma unroll
                        for (int j = 0; j < 8; ++j) v[j] += (float)y0[j]; }
                    u32x4 w; w.x = pk2(v[0], v[1]); w.y = pk2(v[2], v[3]); w.z = pk2(v[4], v[5]); w.w = pk2(v[6], v[7]);
                    *(u32x4*)(Y + off) = w;
                }
    }
};
struct EpiMerge2 {
    static constexpr bool PERM = false, TRANS = true;
    const float* x; float* H; const float* mod;
    __device__ __forceinline__ void operator()(const f32x4 (&acc)[2][2][4][2], const pg8::Unit& u, int wr, int wc, int fr, int fq) const {
        const int row0 = u.pm * 256 + wr * 64 + fr, col0 = u.pn * 256 + wc * 32 + 4 * fq;
        const int b = (u.pm * 256) >> 12;
        f32x4 g1[2][2];
#pragma unroll
        for (int bj = 0; bj < 2; ++bj)
#pragma unroll
            for (int n = 0; n < 2; ++n) g1[bj][n] = *(const f32x4*)(mod + b * 6144 + 2048 + col0 + bj * 128 + n * 16);
#pragma unroll
        for (int ai = 0; ai < 2; ++ai)
#pragma unroll
            for (int m = 0; m < 4; ++m) { const size_t ro = (size_t)(row0 + ai * 128 + m * 16) * 1024 + col0;
#pragma unroll
                for (int bj = 0; bj < 2; ++bj)
#pragma unroll
                    for (int n = 0; n < 2; ++n) { const f32x4 xv = *(const f32x4*)(x + ro + bj * 128 + n * 16);
                        *(f32x4*)(H + ro + bj * 128 + n * 16) = xv + g1[bj][n] * acc[ai][bj][m][n]; } }
    }
};
struct EpiF32 {
    static constexpr bool PERM = false, TRANS = true;
    float* C; int ldc;
    __device__ __forceinline__ void operator()(const f32x4 (&acc)[2][2][4][2], const pg8::Unit& u, int wr, int wc, int fr, int fq) const {
        const int row0 = u.pm * 256 + wr * 64 + fr, col0 = u.pn * 256 + wc * 32 + 4 * fq;
#pragma unroll
        for (int ai = 0; ai < 2; ++ai)
#pragma unroll
            for (int m = 0; m < 4; ++m) { float* rowp = C + (size_t)(row0 + ai * 128 + m * 16) * ldc + col0;
#pragma unroll
                for (int bj = 0; bj < 2; ++bj)
#pragma unroll
                    for (int n = 0; n < 2; ++n) *(f32x4*)(rowp + bj * 128 + n * 16) = acc[ai][bj][m][n]; }
    }
};

__device__ __forceinline__ int hgrn_row(int pos, int b, int dir) {
    if (pos < LC) { const int j = dir ? (LC - 1 - pos) : pos; return T + b * LC + j; }
    const int t = pos - LC; return b * SEQ + (dir ? (SEQ - 1 - t) : t);
}
__device__ void hgrn_item(const Params& p, LAS unsigned char* lds, int item) {
    const int tid = threadIdx.x, vq = item & 3, dir = (item >> 2) & 1, h = (item >> 3) & 3, b = item >> 5;
    const h16* Q = (const h16*)(p.ws + OFF_Q); const h16* LF = (const h16*)(p.ws + (dir ? OFF_LBK : OFF_LF)); const h16* V = (const h16*)(p.ws + OFF_V);
    h16* O = (h16*)(p.ws + (dir ? OFF_OB : OFF_OF));
    LAS float* fs = (LAS float*)lds; LAS float* ks = fs + 16 * 128; LAS float* qs = ks + 16 * 128; LAS float* vs = qs + 16 * 128; LAS float* po = vs + 16 * 32;
    const int v = tid & 31, kq = tid >> 5;
    float S[8];
#pragma unroll
    for (int j = 0; j < 8; ++j) S[j] = 0.f;
    const int e = tid * 4, tl_ld = e >> 7, k_ld = e & 127;
    const int tl_v = tid >> 5, vv = tid & 31;
    h16x4 lf4, q4; h16 v1;
    { const int row = hgrn_row(tl_ld, b, dir); lf4 = *(const h16x4*)(LF + (size_t)row * 512 + h * 128 + k_ld); q4 = (h16x4){0, 0, 0, 0};
      const int row2 = hgrn_row(tl_v, b, dir); v1 = V[(size_t)row2 * 512 + h * 128 + vq * 32 + vv]; }
    constexpr int NG = (LC + SEQ) / 16;
    for (int grp = 0; grp < NG; ++grp) {
        const bool latent = grp >= LC / 16;
#pragma unroll
        for (int j = 0; j < 4; ++j) { const float f = __expf((float)lf4[j]); fs[e + j] = f; ks[e + j] = 1.0f - f; qs[e + j] = (float)q4[j]; }
        vs[tid] = (float)v1;
        __syncthreads();
        if (grp + 1 < NG) { const int pos = (grp + 1) * 16; const bool lat2 = (grp + 1) >= LC / 16;
            const int row = hgrn_row(pos + tl_ld, b, dir); lf4 = *(const h16x4*)(LF + (size_t)row * 512 + h * 128 + k_ld);
            if (lat2) q4 = *(const h16x4*)(Q + (size_t)row * 512 + h * 128 + k_ld);
            const int row2 = hgrn_row(pos + tl_v, b, dir); v1 = V[(size_t)row2 * 512 + h * 128 + vq * 32 + vv]; }
#pragma unroll 4
        for (int tl = 0; tl < 16; ++tl) {
            const float vt = vs[tl * 32 + v];
            const f32x4 f0 = *(const LAS f32x4*)(fs + tl * 128 + kq * 8), f1 = *(const LAS f32x4*)(fs + tl * 128 + kq * 8 + 4);
            const f32x4 k0 = *(const LAS f32x4*)(ks + tl * 128 + kq * 8), k1 = *(const LAS f32x4*)(ks + tl * 128 + kq * 8 + 4);
            const f32x4 q0 = *(const LAS f32x4*)(qs + tl * 128 + kq * 8), q1 = *(const LAS f32x4*)(qs + tl * 128 + kq * 8 + 4);
            float a = 0.f;
#pragma unroll
            for (int j = 0; j < 4; ++j) { S[j] = f0[j] * S[j] + k0[j] * vt; a += S[j] * q0[j]; S[4 + j] = f1[j] * S[4 + j] + k1[j] * vt; a += S[4 + j] * q1[j]; }
            po[(tl * 16 + kq) * 32 + v] = a;
        }
        __syncthreads();
        if (latent) { float s = 0.f;
#pragma unroll
            for (int q = 0; q < 16; ++q) s += po[(tl_v * 16 + q) * 32 + vv];
            const int row = hgrn_row(grp * 16 + tl_v, b, dir);
            O[(size_t)row * 512 + h * 128 + vq * 32 + vv] = (h16)s; }
    }
    __syncthreads();
}

__device__ void a1_prepass(const Params& p) {
    const int wave = threadIdx.x >> 6, lane = threadIdx.x & 63;
    const h16* OF = (const h16*)(p.ws + OFF_OF); const h16* OB = (const h16*)(p.ws + OFF_OB); h16* G = (h16*)(p.ws + OFF_G);
    const float* hgn = p.in[11];
    for (int t = blockIdx.x * 8 + wave; t < T; t += gridDim.x * 8) {
        const size_t off = (size_t)t * 512 + lane * 8;
        const h16x8 a = *(const h16x8*)(OF + off), bq = *(const h16x8*)(OB + off), g = *(const h16x8*)(G + off);
        float o[8]; float ss = 0.f;
#pragma unroll
        for (int j = 0; j < 8; ++j) { o[j] = (float)a[j] + (float)bq[j]; ss += o[j] * o[j]; }
        ss += __shfl_xor(ss, 1); ss += __shfl_xor(ss, 2); ss += __shfl_xor(ss, 4); ss += __shfl_xor(ss, 8);
        const float rstd = rsqrtf(ss * (1.0f / 128.0f) + EPS);
        float r[8];
#pragma unroll
        for (int j = 0; j < 8; ++j) r[j] = o[j] * rstd * hgn[lane * 8 + j] * (float)g[j];
        u32x4 w; w.x = pk2(r[0], r[1]); w.y = pk2(r[2], r[3]); w.z = pk2(r[4], r[5]); w.w = pk2(r[6], r[7]);
        *(u32x4*)(G + off) = w;
    }
}

__device__ void convert_tables(const Params& p) {
    const size_t n8 = (size_t)16384 * 1024 / 8;
    for (int tb = 0; tb < 2; ++tb) { const float* src = p.in[17 + tb]; h16* dst = (h16*)(p.ws + (tb ? OFF_TV : OFF_TU));
        for (size_t i = (size_t)blockIdx.x * NTHREADS + threadIdx.x; i < n8; i += (size_t)gridDim.x * NTHREADS) {
            const f32x4 a = *(const f32x4*)(src + i * 8), bq = *(const f32x4*)(src + i * 8 + 4);
            u32x4 w; w.x = pk2(a.x, a.y); w.y = pk2(a.z, a.w); w.z = pk2(bq.x, bq.y); w.w = pk2(bq.z, bq.w);
            *(u32x4*)(dst + i * 8) = w; } }
}

__device__ __forceinline__ unsigned f2key(float x) { const unsigned b = __builtin_bit_cast(unsigned, x); return b ^ ((b >> 31) ? 0xFFFFFFFFu : 0x80000000u); }
__device__ __forceinline__ float key2f(unsigned u) { const unsigned b = (u & 0x80000000u) ? (u ^ 0x80000000u) : ~u; return __builtin_bit_cast(float, b); }
__device__ __forceinline__ unsigned umax3(unsigned a, unsigned b, unsigned c) { return max(max(a, b), c); }
__device__ __forceinline__ void top16_of_128(const float* sc, unsigned (&out)[16]) {
    unsigned s[128];
#pragma unroll
    for (int i = 0; i < 32; ++i) { const f32x4 t = *(const f32x4*)(sc + i * 4);
#pragma unroll
        for (int j = 0; j < 4; ++j) s[4 * i + j] = (f2key(t[j]) & ~127u) | (unsigned)(127 - (4 * i + j)); }
#pragma unroll 1
    for (int it = 0; it < 16; ++it) {
        unsigned m[43];
#pragma unroll
        for (int n = 0; n < 42; ++n) m[n] = umax3(s[3 * n], s[3 * n + 1], s[3 * n + 2]);
        m[42] = max(s[126], s[127]);
        unsigned m2[15];
#pragma unroll
        for (int n = 0; n < 14; ++n) m2[n] = umax3(m[3 * n], m[3 * n + 1], m[3 * n + 2]);
        m2[14] = m[42];
        unsigned m3[5];
#pragma unroll
        for (int n = 0; n < 5; ++n) m3[n] = umax3(m2[3 * n], m2[3 * n + 1], m2[3 * n + 2]);
        const unsigned best = max(umax3(m3[0], m3[1], m3[2]), max(m3[3], m3[4]));
#pragma unroll
        for (int n = 0; n < 128; ++n) s[n] = (s[n] == best) ? 0u : s[n];
#pragma unroll
        for (int i = 0; i < 16; ++i) out[i] = (i == it) ? best : out[i];
    }
}
__device__ void topk_phase(const Params& p, LAS unsigned char* lds) {
    const float* SC = (const float*)(p.ws + OFF_SC); int* EIDX = (int*)(p.ws + OFF_EIDX); float* GATE = (float*)(p.ws + OFF_GATE);
    LAS unsigned* st = (LAS unsigned*)lds;
    const int tid = threadIdx.x;
    for (int base = blockIdx.x * 256; base < T * 8; base += gridDim.x * 256) {
        {
            unsigned ks[16];
#pragma unroll
            for (int i = 0; i < 16; ++i) ks[i] = 0u;
            top16_of_128(SC + ((size_t)base * 2 + tid) * 128, ks);
#pragma unroll
            for (int i = 0; i < 16; ++i) st[i * NTHREADS + tid] = ks[i];
        }
        __syncthreads();
        if (tid < 256) {
            const int th = base + tid;
            float sv1[16];
#pragma unroll
            for (int j = 0; j < 16; ++j) sv1[j] = key2f(st[j * NTHREADS + 2 * tid + 1] & ~127u);
            unsigned cv[50];
            { int c = 0;
#pragma unroll
              for (int i = 0; i < 16; ++i) { const float a = key2f(st[i * NTHREADS + 2 * tid] & ~127u);
#pragma unroll
                  for (int j = 0; j < 16; ++j) if ((i + 1) * (j + 1) <= 16) { cv[c] = (f2key(a + sv1[j]) & ~255u) | (unsigned)(255 - (i * 16 + j)); ++c; } } }
            unsigned ok[16];
#pragma unroll
            for (int i = 0; i < 16; ++i) ok[i] = 0u;
#pragma unroll 1
            for (int it = 0; it < 16; ++it) {
                unsigned m[17];
#pragma unroll
                for (int n = 0; n < 16; ++n) m[n] = umax3(cv[3 * n], cv[3 * n + 1], cv[3 * n + 2]);
                m[16] = max(cv[48], cv[49]);
                unsigned m2[6];
#pragma unroll
                for (int n = 0; n < 5; ++n) m2[n] = umax3(m[3 * n], m[3 * n + 1], m[3 * n + 2]);
                m2[5] = max(m[15], m[16]);
                const unsigned best = max(umax3(m2[0], m2[1], m2[2]), umax3(m2[3], m2[4], m2[5]));
#pragma unroll
                for (int n = 0; n < 50; ++n) cv[n] = (cv[n] == best) ? 0u : cv[n];
#pragma unroll
                for (int i = 0; i < 16; ++i) ok[i] = (i == it) ? best : ok[i];
            }
            float ex[16]; int oe[16]; float den = 0.f;
            const float v0 = key2f(ok[0] & ~255u);
#pragma unroll
            for (int i = 0; i < 16; ++i) { const int ij = 255 - (int)(ok[i] & 255u), ci = ij >> 4, cj = ij & 15;
                const int e0 = 127 - (int)(st[ci * NTHREADS + 2 * tid] & 127u), e1 = 127 - (int)(st[cj * NTHREADS + 2 * tid + 1] & 127u);
                oe[i] = e0 * 128 + e1; ex[i] = __expf(key2f(ok[i] & ~255u) - v0); den += ex[i]; }
            const float inv = 1.0f / den;
#pragma unroll
            for (int i = 0; i < 4; ++i) {
                *(f32x4*)(GATE + (size_t)th * 16 + 4 * i) = (f32x4){ex[4 * i] * inv, ex[4 * i + 1] * inv, ex[4 * i + 2] * inv, ex[4 * i + 3] * inv};
                *(int4*)(EIDX + (size_t)th * 16 + 4 * i) = make_int4(oe[4 * i], oe[4 * i + 1], oe[4 * i + 2], oe[4 * i + 3]); }
        }
        __syncthreads();
    }
}

__device__ __forceinline__ int bitrev6(int x) { return ((x & 1) << 5) | ((x & 2) << 3) | ((x & 4) << 1) | ((x & 8) >> 1) | ((x & 16) >> 3) | ((x & 32) >> 5); }
__device__ void peer_phase(const Params& p) {
    const int wave = threadIdx.x >> 6, lane = threadIdx.x & 63;
    const h16* U2 = (const h16*)(p.ws + OFF_U2); const h16* TU = (const h16*)(p.ws + OFF_TU); const h16* TV = (const h16*)(p.ws + OFF_TV);
    const int* EIDX = (const int*)(p.ws + OFF_EIDX); const float* GATE = (const float*)(p.ws + OFF_GATE);
    const float* mod = (const float*)(p.ws + OFF_MOD); float* H = p.out; const float* fg = p.in[19];
    for (int t = blockIdx.x * 8 + wave; t < T; t += gridDim.x * 8) {
        const int b = t >> 12;
        const h16x8 x0 = *(const h16x8*)(U2 + (size_t)t * D + lane * 16), x1 = *(const h16x8*)(U2 + (size_t)t * D + lane * 16 + 8);
        const int e0 = EIDX[(size_t)t * 128 + lane], e1 = EIDX[(size_t)t * 128 + 64 + lane];
        float part[128];
#pragma unroll
        for (int k = 0; k < 128; ++k) {
            const int e = __builtin_amdgcn_readlane(k < 64 ? e0 : e1, k & 63);
            const h16* ur = TU + (size_t)e * D + lane * 16;
            const h16x8 u0 = *(const h16x8*)ur, u1 = *(const h16x8*)(ur + 8);
            float s = 0.f;
#pragma unroll
            for (int j = 0; j < 8; ++j) s += (float)u0[j] * (float)x0[j] + (float)u1[j] * (float)x1[j];
            part[k] = s;
        }
#define RED_STEP(NIN, MASK) _Pragma("unroll") for (int j = 0; j < (NIN) / 2; ++j) { const bool up = (lane & (MASK)) != 0; \
            const float keep = up ? part[2 * j + 1] : part[2 * j], send = up ? part[2 * j] : part[2 * j + 1]; part[j] = keep + __shfl_xor(send, (MASK)); }
        RED_STEP(128, 1) RED_STEP(64, 2) RED_STEP(32, 4) RED_STEP(16, 8) RED_STEP(8, 16) RED_STEP(4, 32)
#undef RED_STEP
        const int kk = lane;
        float w0, w1;
        { const float a0 = part[0], a1 = part[1];
          const float g0 = GATE[(size_t)t * 128 + kk], g1 = GATE[(size_t)t * 128 + 64 + kk];
          w0 = g0 * (0.5f * a0 * (1.0f + erff(a0 * 0.70710678118654752f)));
          w1 = g1 * (0.5f * a1 * (1.0f + erff(a1 * 0.70710678118654752f))); }
        float acc[16];
#pragma unroll
        for (int j = 0; j < 16; ++j) acc[j] = 0.f;
#pragma unroll
        for (int k = 0; k < 128; ++k) {
            const int e = __builtin_amdgcn_readlane(k < 64 ? e0 : e1, k & 63);
            const float wk = __builtin_bit_cast(float, __builtin_amdgcn_readlane(__builtin_bit_cast(int, k < 64 ? w0 : w1), k & 63));
            const h16* vr = TV + (size_t)e * D + lane * 16;
            const h16x8 v0 = *(const h16x8*)vr, v1 = *(const h16x8*)(vr + 8);
#pragma unroll
            for (int j = 0; j < 8; ++j) { acc[j] += wk * (float)v0[j]; acc[8 + j] += wk * (float)v1[j]; }
        }
        float* hr = H + (size_t)t * D + lane * 16; const float* g2 = mod + b * 6144 + 5120 + lane * 16;
        float h2[16]; float ss = 0.f;
#pragma unroll
        for (int q = 0; q < 4; ++q) { const f32x4 hv = *(const f32x4*)(hr + 4 * q), gv = *(const f32x4*)(g2 + 4 * q);
#pragma unroll
            for (int j = 0; j < 4; ++j) { const float y = hv[j] + gv[j] * acc[4 * q + j]; h2[4 * q + j] = y; ss += y * y; } }
        ss = wave_sum(ss);
        const float rstd = rsqrtf(ss * (1.0f / D) + EPS);
#pragma unroll
        for (int q = 0; q < 4; ++q) { const f32x4 fv = *(const f32x4*)(fg + lane * 16 + 4 * q);
            *(f32x4*)(hr + 4 * q) = (f32x4){h2[4 * q] * rstd * fv.x, h2[4 * q + 1] * rstd * fv.y, h2[4 * q + 2] * rstd * fv.z, h2[4 * q + 3] * rstd * fv.w}; }
    }
}
constexpr int N_PHASES = 11;
__global__ void __launch_bounds__(NTHREADS, 2) mega(Params p) {
    extern __shared__ __attribute__((aligned(16))) unsigned char smem[];
    LAS unsigned char* lds = (LAS unsigned char*)smem;
    const int G = gridDim.x, c = blockIdx.x;
    unsigned char* ws = p.ws;
#define IN(k) (p.ph_lo <= (k) && (k) < p.ph_hi)
#define SEAM(k) do { if (IN(k) && IN((k) + 1)) { cg::grid_group grid = cg::this_grid(); grid.sync(); } } while (0)
    if (IN(0)) phase0(p, lds);
    SEAM(0);
    if (IN(1)) {
        const float* mod = (const float*)(ws + OFF_MOD);
        modulate_rows(p.in[0], (h16*)(ws + OFF_UALL), T, p.in[6], mod, 0, 1024, 0);
        modulate_rows(p.in[2], (h16*)(ws + OFF_UALL) + (size_t)T * D, TC, p.in[6], mod, 0, 1024, 1);
    }
    SEAM(1);
    if (IN(2)) {
        { pg8::Gemm g{ws + OFF_UALL, ws + OFF_WA, 1024, 1024, 1024}; OrderA S; S.init(G, c); EpiA E{ws}; pg8::gemm_phase(lds, g, S, E); }
        { pg8::Gemm g{ws + OFF_UALL, ws + OFF_WF, 1024, 1024, 1024}; pg8::TileOrder S; S.init(128, 4, G, c); EpiFT E{ws}; pg8::gemm_phase(lds, g, S, E); }
    }
    SEAM(2);
    if (IN(3)) { for (int it = blockIdx.x; it < 256; it += gridDim.x) hgrn_item(p, lds, it); }
    SEAM(3);
    if (IN(4)) {
        { pg8::Gemm g{ws + OFF_DFTM, ws + OFF_FTT, 8192, 8192, 8192}; pg8::TileOrder S; S.init(16, 16, G, c); EpiDFT E{ws}; pg8::gemm_phase(lds, g, S, E); }
        { pg8::Gemm g{ws + OFF_UALL, ws + OFF_WG, 1024, 1024, 1024}; pg8::TileOrder S; S.init(128, 8, G, c); EpiGate E{ws}; pg8::gemm_phase(lds, g, S, E); }
        a1_prepass(p);
    }
    SEAM(4);
    if (IN(5)) {
        { pg8::Gemm g{ws + OFF_G, ws + OFF_WHG, 512, 512, 512}; pg8::TileOrder S; S.init(128, 4, G, c); EpiMerge1<false> E{ws}; pg8::gemm_phase(lds, g, S, E); }
        { pg8::Gemm g{ws + OFF_YFT, ws + OFF_WFT, 512, 512, 512}; pg8::TileOrder S; S.init(128, 4, G, c); EpiMerge1<true> E{ws}; pg8::gemm_phase(lds, g, S, E); }
    }
    SEAM(5);
    if (IN(6)) { pg8::Gemm g{ws + OFF_Y, ws + OFF_WOUT, 1024, 1024, 1024}; pg8::TileOrder S; S.init(128, 4, G, c);
                 EpiMerge2 E{p.in[0], p.out, (const float*)(ws + OFF_MOD)}; pg8::gemm_phase(lds, g, S, E); }
    SEAM(6);
    if (IN(7)) { modulate_rows(p.out, (h16*)(ws + OFF_U2), T, p.in[7], (const float*)(ws + OFF_MOD), 3072, 4096, 0); convert_tables(p); }
    SEAM(7);
    if (IN(8)) { pg8::Gemm g{ws + OFF_U2, ws + OFF_WS, 1024, 1024, 1024}; pg8::TileOrder S; S.init(128, 8, G, c);
                 EpiF32 E{(float*)(ws + OFF_SC), 2048}; pg8::gemm_phase(lds, g, S, E); }
    SEAM(8);
    if (IN(9)) topk_phase(p, lds);
    SEAM(9);
    if (IN(10)) peer_phase(p);
#undef IN
#undef SEAM
}

#ifndef MK_SINGLE
#define MK_SINGLE 0
#endif
extern "C" void kernel_launch(void* const* d_in, const int* in_sizes, int n_in, void* d_out, int out_size, void* d_ws, size_t ws_size, hipStream_t stream) {
    static int grid = 0;
    if (grid == 0) {
        if (n_in != 20 || out_size != T * D || ws_size < WS_NEED) { fprintf(stderr, "kernel_launch: unexpected shapes (n_in %d out %d ws %zu)\n", n_in, out_size, ws_size); grid = -1; return; }
        int dev = 0, cus = 0, per_cu = 0;
        hipGetDevice(&dev); hipDeviceGetAttribute(&cus, hipDeviceAttributeMultiprocessorCount, dev);
        if (hipFuncSetAttribute((const void*)mega, hipFuncAttributeMaxDynamicSharedMemorySize, LDS_BYTES) != hipSuccess) { fprintf(stderr, "kernel_launch: hipFuncSetAttribute failed\n"); grid = -1; return; }
        hipOccupancyMaxActiveBlocksPerMultiprocessor(&per_cu, (const void*)mega, NTHREADS, LDS_BYTES);
        if (per_cu < 1) { fprintf(stderr, "kernel_launch: occupancy query says %d blocks per CU\n", per_cu); grid = -1; return; }
        grid = cus;
    }
    if (grid < 0) return;
    Params p{};
    for (int i = 0; i < 20; ++i) p.in[i] = (const float*)d_in[i];
    p.out = (float*)d_out; p.ws = (unsigned char*)d_ws;
#if MK_SINGLE
    p.ph_lo = 0; p.ph_hi = N_PHASES;
    void* args[] = {&p};
    hipError_t e = hipLaunchCooperativeKernel((const void*)mega, dim3(grid), dim3(NTHREADS), args, LDS_BYTES, stream);
    if (e != hipSuccess) fprintf(stderr, "cooperative launch failed: %s (grid %d)\n", hipGetErrorString(e), grid);
#else
    for (int ph = 0; ph < N_PHASES; ++ph) { p.ph_lo = ph; p.ph_hi = ph + 1; hipLaunchKernelGGL(mega, dim3(grid), dim3(NTHREADS), LDS_BYTES, stream, p); }
#endif
}
```

```cpp
#include <hip/hip_runtime.h>
#include <hip/hip_cooperative_groups.h>
#include <cstdio>
#include <cstdint>
namespace cg = cooperative_groups;
namespace pg8 {
#define PG8_LAS __attribute__((address_space(3)))
typedef _Float16 f16x8 __attribute__((ext_vector_type(8)));
typedef float f32x4 __attribute__((ext_vector_type(4)));
typedef unsigned u32x4 __attribute__((ext_vector_type(4)));
typedef unsigned u32x2 __attribute__((ext_vector_type(2)));
constexpr int BM = 256, BK = 64, HALF = 128, HTB = HALF * BK * 2, STAGE_BYTES = 8 * HTB, NXCD = 8, WGM = 8;

__host__ __device__ __forceinline__ int lds_byte(int r, int c) { const int st = (r >> 4) * 2 + (c >> 5), rr = r & 15, cc = c & 31, ob = rr * 64 + cc * 2; return st * 1024 + (ob ^ (((ob >> 9) & 1) << 5)); }
__host__ __device__ __forceinline__ void stage_rc(int b, int& R, int& C) { const int st = b / 1024, sb = b % 1024, swz = sb ^ (((sb >> 9) & 1) << 5); R = (st >> 1) * 16 + swz / 64; C = (st & 1) * 32 + (swz % 64) / 2; }
__host__ __device__ __forceinline__ int perm32(int rho) { const int n = rho >> 4, i = rho & 15; return 8 * (i >> 2) + 4 * n + (i & 3); }

struct Unit { int pm, pn; };
struct Gemm { const void* A; const void* Bt; int lda, ldb, K; };

struct TileOrder {
    int nM, nN, nwg, G, c;
    __device__ void init(int nM_, int nN_, int G_, int c_) { nM = nM_; nN = nN_; nwg = nM * nN; G = G_; c = c_; }
    __device__ bool map(long L, Unit& u) const {
        if (L >= nwg) return false;
        int wgid = (int)L; { const int q = nwg / NXCD, r = nwg % NXCD, xcd = wgid % NXCD, off = wgid / NXCD; wgid = (xcd < r ? xcd * (q + 1) : r * (q + 1) + (xcd - r) * q) + off; }
        const int nig = WGM * nN, gid = wgid / nig, fm = gid * WGM, gsz = (nM - fm) < WGM ? (nM - fm) : WGM;
        u.pm = fm + ((wgid % nig) % gsz); u.pn = (wgid % nig) / gsz; return true;
    }
    __device__ bool next(int i, Unit& u) const { return map((long)i * G + c, u); }
};

template <class Epi, class Sched>
__device__ __forceinline__ void gemm_phase(PG8_LAS unsigned char* lds, const Gemm g, const Sched& S, const Epi& E) {
    const int tid = threadIdx.x, wid = __builtin_amdgcn_readfirstlane(tid >> 6), lane = tid & 63, wr = wid >> 2, wc = wid & 3, fr = lane & 15, fq = lane >> 4;
    const int K = g.K, nt = K / BK;
    unsigned voffA[2], voffB[2];
#pragma unroll
    for (int i = 0; i < 2; ++i) { int R, C; stage_rc(tid * 16 + i * 8192, R, C); const int Rb = Epi::PERM ? ((R & ~31) + perm32(R & 31)) : R;
        voffA[i] = (unsigned)(R * g.lda + C) * 2u; voffB[i] = (unsigned)(Rb * g.ldb + C) * 2u; }
    const size_t kstep = (size_t)(BK * 2);
    const size_t hstepA = (size_t)HALF * g.lda * 2, hstepB = (size_t)HALF * g.ldb * 2;
    const size_t tstepA = 2 * hstepA, tstepB = 2 * hstepB;
    const unsigned ldsw = (unsigned)wid * 1024u;
    const int aoff = lds_byte(wr * 64 + fr, fq * 8), boff = lds_byte(wc * 32 + fr, fq * 8);
#define PG8_SA(b, h) (((b) * 2 + (h)) * HTB)
#define PG8_SB(b, h) ((4 + (b) * 2 + (h)) * HTB)
#define PG8_STAGE(bufoff, gbase, voff) do { _Pragma("unroll") for (int _i = 0; _i < 2; ++_i) \
        __builtin_amdgcn_global_load_lds((const unsigned*)((const char*)(gbase) + (voff)[_i]), (PG8_LAS unsigned*)(lds + (bufoff) + ldsw + _i * 8192), 16, 0, 0); } while (0)
#define PG8_LDA(dst, b, h) do { _Pragma("unroll") for (int m = 0; m < 4; ++m) _Pragma("unroll") for (int k = 0; k < 2; ++k) dst[m][k] = *(const PG8_LAS f16x8*)(lds + PG8_SA(b, h) + aoff + m * 2048 + k * 1024); } while (0)
#define PG8_LDB(dst, b, h) do { _Pragma("unroll") for (int n = 0; n < 2; ++n) _Pragma("unroll") for (int k = 0; k < 2; ++k) dst[n][k] = *(const PG8_LAS f16x8*)(lds + PG8_SB(b, h) + boff + n * 2048 + k * 1024); } while (0)
#define PG8_MMA(ai, bj, At, Bt) do { __builtin_amdgcn_s_setprio(1); _Pragma("unroll") for (int m = 0; m < 4; ++m) _Pragma("unroll") for (int n = 0; n < 2; ++n) _Pragma("unroll") for (int k = 0; k < 2; ++k) \
        acc[ai][bj][m][n] = Epi::TRANS ? __builtin_amdgcn_mfma_f32_16x16x32_f16(Bt[n][k], At[m][k], acc[ai][bj][m][n], 0, 0, 0) \
                                       : __builtin_amdgcn_mfma_f32_16x16x32_f16(At[m][k], Bt[n][k], acc[ai][bj][m][n], 0, 0, 0); __builtin_amdgcn_s_setprio(0); } while (0)
#define PG8_WAIT_V(n) asm volatile("s_waitcnt vmcnt(" #n ")" ::: "memory")
#define PG8_WAIT_L(n) asm volatile("s_waitcnt lgkmcnt(" #n ")" ::: "memory")
#define PG8_BAR __builtin_amdgcn_s_barrier()
#define PG8_SCHED __builtin_amdgcn_sched_barrier(0)
    Unit cur, nxt; int ui = 0;
    if (!S.next(0, cur)) return;
    f32x4 acc[2][2][4][2];
#pragma unroll
    for (int a = 0; a < 2; ++a)
#pragma unroll
        for (int b = 0; b < 2; ++b)
#pragma unroll
            for (int m = 0; m < 4; ++m)
#pragma unroll
                for (int n = 0; n < 2; ++n) acc[a][b][m][n] = (f32x4){0.f, 0.f, 0.f, 0.f};
    f16x8 At[4][2], B0[2][2], B1[2][2];
    const char* cA = (const char*)g.A + (size_t)cur.pm * tstepA; const char* cB = (const char*)g.Bt + (size_t)cur.pn * tstepB;
    PG8_STAGE(PG8_SB(0, 0), cB, voffB); PG8_STAGE(PG8_SA(0, 0), cA, voffA); PG8_STAGE(PG8_SB(0, 1), cB + hstepB, voffB); PG8_STAGE(PG8_SA(0, 1), cA + hstepA, voffA);
    if (wr == 1) PG8_BAR;
    PG8_WAIT_V(4); PG8_BAR;
    PG8_STAGE(PG8_SB(1, 0), cB + kstep, voffB); PG8_STAGE(PG8_SA(1, 0), cA + kstep, voffA); PG8_STAGE(PG8_SB(1, 1), cB + hstepB + kstep, voffB);
    PG8_WAIT_V(6); PG8_BAR;
    for (;;) {
        const bool has_next = S.next(ui + 1, nxt);
        const char* nA = has_next ? (const char*)g.A + (size_t)nxt.pm * tstepA : cA; const char* nB = has_next ? (const char*)g.Bt + (size_t)nxt.pn * tstepB : cB;
        for (int t = 0; t < nt; t += 2) {
            const bool last = (t == nt - 2);
            const char* a1 = cA + (size_t)(t + 1) * kstep;
            const char* a2 = last ? nA : cA + (size_t)(t + 2) * kstep; const char* b2 = last ? nB : cB + (size_t)(t + 2) * kstep;
            const char* a3 = a2 + kstep; const char* b3 = b2 + kstep;
            PG8_LDB(B0, 0, 0); PG8_SCHED; PG8_LDA(At, 0, 0); PG8_STAGE(PG8_SA(1, 1), a1 + hstepA, voffA);
            PG8_WAIT_L(8); PG8_BAR; PG8_WAIT_L(0); PG8_MMA(0, 0, At, B0); PG8_BAR; PG8_SCHED;
            PG8_LDB(B1, 0, 1); PG8_STAGE(PG8_SB(0, 0), b2, voffB);
            PG8_BAR; PG8_WAIT_L(0); PG8_MMA(0, 1, At, B1); PG8_BAR;
            PG8_LDA(At, 0, 1); PG8_STAGE(PG8_SA(0, 0), a2, voffA);
            PG8_BAR; PG8_WAIT_L(0); PG8_MMA(1, 0, At, B0); PG8_BAR; PG8_SCHED;
            PG8_STAGE(PG8_SB(0, 1), b2 + hstepB, voffB);
            PG8_WAIT_V(6); PG8_BAR; PG8_MMA(1, 1, At, B1); PG8_BAR;
            PG8_LDB(B0, 1, 0); PG8_SCHED; PG8_LDA(At, 1, 0); PG8_STAGE(PG8_SA(0, 1), a2 + hstepA, voffA);
            PG8_WAIT_L(8); PG8_BAR; PG8_WAIT_L(0); PG8_MMA(0, 0, At, B0); PG8_BAR; PG8_SCHED;
            PG8_LDB(B1, 1, 1); PG8_STAGE(PG8_SB(1, 0), b3, voffB);
            PG8_BAR; PG8_WAIT_L(0); PG8_MMA(0, 1, At, B1); PG8_BAR;
            PG8_LDA(At, 1, 1); PG8_STAGE(PG8_SA(1, 0), a3, voffA);
            PG8_BAR; PG8_WAIT_L(0); PG8_MMA(1, 0, At, B0); PG8_BAR; PG8_SCHED;
            PG8_STAGE(PG8_SB(1, 1), b3 + hstepB, voffB);
            PG8_WAIT_V(6); PG8_BAR; PG8_MMA(1, 1, At, B1); PG8_BAR;
        }
        E(acc, cur, wr, wc, fr, fq);
        if (!has_next) break;
#pragma unroll
        for (int a = 0; a < 2; ++a)
#pragma unroll
            for (int b = 0; b < 2; ++b)
#pragma unroll
                for (int m = 0; m < 4; ++m)
#pragma unroll
                    for (int n = 0; n < 2; ++n) acc[a][b][m][n] = (f32x4){0.f, 0.f, 0.f, 0.f};
        cur = nxt; cA = nA; cB = nB; ++ui;
    }
    PG8_WAIT_V(0);
    if (wr == 0) PG8_BAR;
    PG8_BAR;
#undef PG8_SA
#undef PG8_SB
#undef PG8_STAGE
#undef PG8_LDA
#undef PG8_LDB
#undef PG8_MMA
#undef PG8_WAIT_V
#undef PG8_WAIT_L
#undef PG8_BAR
#undef PG8_SCHED
}
}
#define LAS __attribute__((address_space(3)))
typedef _Float16 h16;
typedef h16 h16x2 __attribute__((ext_vector_type(2)));
typedef h16 h16x4 __attribute__((ext_vector_type(4)));
typedef h16 h16x8 __attribute__((ext_vector_type(8)));
typedef float f32x4 __attribute__((ext_vector_type(4)));
typedef float f32x2 __attribute__((ext_vector_type(2)));
typedef unsigned u32x4 __attribute__((ext_vector_type(4)));
typedef unsigned u32x2 __attribute__((ext_vector_type(2)));

constexpr int D = 1024, NB = 8, SEQ = 4096, T = NB * SEQ, LC = 256, TC = NB * LC, TALL = T + TC;
constexpr int NTHREADS = 512;
constexpr int LDS_BYTES = 136 * 1024;
constexpr float EPS = 1e-6f;
constexpr size_t MiB = (size_t)1 << 20;
constexpr size_t OFF_CTL = 0;
constexpr size_t OFF_MOD = 64 * 1024;
constexpr size_t OFF_LB = 320 * 1024;
constexpr size_t OFF_WA = 1 * MiB;
constexpr size_t OFF_WG = 6 * MiB;
constexpr size_t OFF_WF = 10 * MiB;
constexpr size_t OFF_WHG = 12 * MiB;
constexpr size_t OFF_WFT = 13 * MiB;
constexpr size_t OFF_WOUT = 14 * MiB;
constexpr size_t OFF_WS = 16 * MiB;
constexpr size_t OFF_UALL = 20 * MiB;
constexpr size_t OFF_OF = 88 * MiB;
constexpr size_t OFF_OB = 120 * MiB;
constexpr size_t OFF_FTT = 152 * MiB;
constexpr size_t OFF_Q = 216 * MiB;
constexpr size_t OFF_LF = 248 * MiB;
constexpr size_t OFF_LBK = 282 * MiB;
constexpr size_t OFF_V = 316 * MiB;
constexpr size_t OFF_G = 350 * MiB;
constexpr size_t OFF_DFTM = 382 * MiB;
constexpr size_t OFF_YFT = 446 * MiB;
constexpr size_t WS_NEED = 478 * MiB;
constexpr size_t OFF_GH = 216 * MiB;
constexpr size_t OFF_GF = 280 * MiB;
constexpr size_t OFF_Y = 152 * MiB;
constexpr size_t OFF_U2 = 20 * MiB;
constexpr size_t OFF_TU = 88 * MiB;
constexpr size_t OFF_TV = 120 * MiB;
constexpr size_t OFF_SC = 216 * MiB;
constexpr size_t OFF_EIDX = 152 * MiB;
constexpr size_t OFF_GATE = 168 * MiB;

struct Params { const float* in[20]; float* out; unsigned char* ws; int ph_lo, ph_hi; };

__device__ __forceinline__ unsigned pk2(float a, float b) { h16x2 v = {(h16)a, (h16)b}; return __builtin_bit_cast(unsigned, v); }
__device__ __forceinline__ float wave_sum(float v) {
#pragma unroll
    for (int o = 32; o >= 1; o >>= 1) v += __shfl_xor(v, o);
    return v; }
__device__ __forceinline__ float sigmoidf_(float z) { return 1.0f / (1.0f + __expf(-z)); }

constexpr int N_MOD = 96, N_LB = 1, N_TRA = 640, N_TRG = 512, N_TRHG = 128, N_TRFT = 128, N_TROUT = 256, N_WF = 128, N_WSF = 256, N_DFT = 256;
constexpr int P0_TOTAL = N_MOD + N_LB + N_TRA + N_TRG + N_TRHG + N_TRFT + N_TROUT + N_WF + N_WSF + N_DFT;

__device__ void p0_mod(const Params& p, LAS float* sm, int idx) {
    const int tid = threadIdx.x;
    for (int i = tid; i < 9 * 1024; i += NTHREADS) { const int r = i >> 10, k = i & 1023; const float c = (r < 8) ? p.in[1][r * 1024 + k] : p.in[3][k]; sm[i] = c / (1.0f + __expf(-c)); }
    __syncthreads();
    const int col = tid & 63, ks = tid >> 6;
    float acc[9];
#pragma unroll
    for (int r = 0; r < 9; ++r) acc[r] = 0.f;
    const float* w = p.in[4] + (size_t)(ks * 128) * 6144 + idx * 64 + col;
#pragma unroll 4
    for (int k = 0; k < 128; ++k) { const float wv = w[(size_t)k * 6144];
#pragma unroll
        for (int r = 0; r < 9; ++r) acc[r] += sm[r * 1024 + ks * 128 + k] * wv; }
    LAS float* red = sm + 9 * 1024;
#pragma unroll
    for (int r = 0; r < 9; ++r) red[(ks * 9 + r) * 64 + col] = acc[r];
    __syncthreads();
    float* mod = (float*)(p.ws + OFF_MOD);
    for (int i = tid; i < 576; i += NTHREADS) { const int r = i >> 6, c = i & 63; float s = 0.f;
#pragma unroll
        for (int q = 0; q < 8; ++q) s += red[(q * 9 + r) * 64 + c];
        mod[r * 6144 + idx * 64 + c] = s + p.in[5][idx * 64 + c]; }
    __syncthreads();
}
__device__ void p0_lb(const Params& p) {
    const int tid = threadIdx.x; float* lb = (float*)(p.ws + OFF_LB);
    if (tid < 512) { lb[tid] = 1.0f / (1.0f + expf(p.in[9][512 + tid] - p.in[9][tid])); lb[512 + tid] = 1.0f / (1.0f + expf(p.in[10][512 + tid] - p.in[10][tid])); }
}
__device__ void p0_transpose(const float* src, int ld_src, int ncol0, h16* dst, int ld_dst, int nktiles, int item, LAS float* sm) {
    const int tid = threadIdx.x, kt = item % nktiles, nt = item / nktiles;
    { const int n = tid & 63, kk = tid >> 6;
#pragma unroll
      for (int ps = 0; ps < 8; ++ps) { const int k = kk + 8 * ps; sm[k * 65 + n] = src[(size_t)(kt * 64 + k) * ld_src + ncol0 + nt * 64 + n]; } }
    __syncthreads();
    { const int k = tid & 63, nn = tid >> 6;
#pragma unroll
      for (int ps = 0; ps < 8; ++ps) { const int n = nn + 8 * ps; dst[(size_t)(nt * 64 + n) * ld_dst + kt * 64 + k] = (h16)sm[k * 65 + n]; } }
    __syncthreads();
}
__device__ void p0_wf(const Params& p, LAS float* sm, int item) {
    const int tid = threadIdx.x, dt = item & 15, part = (item >> 4) & 1, g = item >> 5, d0 = dt * 64;
    LAS float* w = sm; LAS float* trig = sm + 64 * 129;
    for (int i = tid; i < 64 * 128; i += NTHREADS) { const int dl = i >> 7, n2 = i & 127; w[dl * 129 + n2] = p.in[8][(size_t)(d0 + dl) * 5120 + 2560 + g * 128 + n2]; }
    if (tid < 128) trig[tid] = part ? sinpif((float)tid / 64.0f) : cospif((float)tid / 64.0f);
    __syncthreads();
    const int dl = tid & 63, kg = tid >> 6; h16* WF = (h16*)(p.ws + OFF_WF);
#pragma unroll 1
    for (int kk = 0; kk < 16; ++kk) { const int k2 = kg * 16 + kk; float s = 0.f;
#pragma unroll 4
        for (int n2 = 0; n2 < 128; ++n2) s += w[dl * 129 + n2] * trig[(k2 * n2) & 127];
        WF[(size_t)(part * 512 + g * 128 + k2) * 1024 + d0 + dl] = (h16)(s * 0.08838834764831845f); }
    __syncthreads();
}
__device__ void p0_wsf(const Params& p, LAS float* sm, int item) {
    const int tid = threadIdx.x, dt = item & 15, hp = item >> 4, d0 = dt * 64;
    LAS float* wq = sm; LAS float* sk = sm + 8256;
    for (int i = tid; i < 64 * 128; i += NTHREADS) { const int dl = i >> 7, k = i & 127; wq[dl * 129 + k] = p.in[15][(size_t)(d0 + dl) * 2048 + hp * 128 + k]; }
    for (int i = tid; i < 128 * 128; i += NTHREADS) sk[i] = p.in[16][(size_t)hp * 16384 + i];
    __syncthreads();
    const int dl = tid & 63, ng = tid >> 6; h16* WS = (h16*)(p.ws + OFF_WS);
#pragma unroll 1
    for (int nn = 0; nn < 16; ++nn) { const int n = ng * 16 + nn; float s = 0.f;
#pragma unroll 4
        for (int k = 0; k < 128; ++k) s += wq[dl * 129 + k] * sk[n * 128 + k];
        WS[(size_t)(hp * 128 + n) * 1024 + d0 + dl] = (h16)s; }
    __syncthreads();
}
__device__ void p0_dftm(const Params& p, LAS float* sm, int item) {
    const int tid = threadIdx.x;
    for (int i = tid; i < 4096; i += NTHREADS) sm[i] = cospif((float)i / 2048.0f) * (1.0f / 64.0f);
    __syncthreads();
    h16* M = (h16*)(p.ws + OFF_DFTM);
#pragma unroll 1
    for (int e = tid; e < 16 * 1024; e += NTHREADS) { const int k1 = item * 16 + (e >> 10), K0 = (e & 1023) * 8, part = K0 >> 12, n1 = K0 & 4095;
        float v[8];
#pragma unroll
        for (int j = 0; j < 8; ++j) { const int m = (k1 * (n1 + j)) & 4095; v[j] = part ? -sm[(m - 1024) & 4095] : sm[m]; }
        u32x4 w; w.x = pk2(v[0], v[1]); w.y = pk2(v[2], v[3]); w.z = pk2(v[4], v[5]); w.w = pk2(v[6], v[7]);
        *(u32x4*)(M + (size_t)k1 * 8192 + K0) = w; }
    __syncthreads();
}
__device__ void phase0(const Params& p, LAS unsigned char* lds) {
    LAS float* sm = (LAS float*)lds;
    for (int it = blockIdx.x; it < P0_TOTAL; it += gridDim.x) {
        int i = it;
        if (i < N_MOD) { p0_mod(p, sm, i); continue; } i -= N_MOD;
        if (i < N_LB) { p0_lb(p); continue; } i -= N_LB;
        if (i < N_TRA) { p0_transpose(p.in[8], 5120, 0, (h16*)(p.ws + OFF_WA), 1024, 16, i, sm); continue; } i -= N_TRA;
        if (i < N_TRG) { p0_transpose(p.in[8], 5120, 3072, (h16*)(p.ws + OFF_WG), 1024, 16, i, sm); continue; } i -= N_TRG;
        if (i < N_TRHG) { p0_transpose(p.in[12], 1024, 0, (h16*)(p.ws + OFF_WHG), 512, 8, i, sm); continue; } i -= N_TRHG;
        if (i < N_TRFT) { p0_transpose(p.in[13], 1024, 0, (h16*)(p.ws + OFF_WFT), 512, 8, i, sm); continue; } i -= N_TRFT;
        if (i < N_TROUT) { p0_transpose(p.in[14], 1024, 0, (h16*)(p.ws + OFF_WOUT), 1024, 16, i, sm); continue; } i -= N_TROUT;
        if (i < N_WF) { p0_wf(p, sm, i); continue; } i -= N_WF;
        if (i < N_WSF) { p0_wsf(p, sm, i); continue; } i -= N_WSF;
        p0_dftm(p, sm, i);
    }
}

__device__ void modulate_rows(const float* src, h16* dst, int nrows, const float* gvec, const float* mod, int sh_off, int sc_off, int ctx_rows) {
    const int wave = threadIdx.x >> 6, lane = threadIdx.x & 63;
    for (int row = blockIdx.x * 8 + wave; row < nrows; row += gridDim.x * 8) {
        const int mr = ctx_rows ? 8 : (row >> 12);
        const float* x = src + (size_t)row * D;
        f32x4 v[4]; float ss = 0.f;
#pragma unroll
        for (int j = 0; j < 4; ++j) { v[j] = *(const f32x4*)(x + j * 256 + lane * 4); ss += v[j].x * v[j].x + v[j].y * v[j].y + v[j].z * v[j].z + v[j].w * v[j].w; }
        ss = wave_sum(ss);
        const float rstd = rsqrtf(ss * (1.0f / D) + EPS);
#pragma unroll
        for (int j = 0; j < 4; ++j) { const int c = j * 256 + lane * 4;
            const f32x4 gg = *(const f32x4*)(gvec + c), sc = *(const f32x4*)(mod + mr * 6144 + sc_off + c), sh = *(const f32x4*)(mod + mr * 6144 + sh_off + c);
            const f32x4 o = (v[j] * rstd) * gg * (sc + 1.0f) + sh;
            u32x2 w; w.x = pk2(o.x, o.y); w.y = pk2(o.z, o.w);
            *(u32x2*)(dst + (size_t)row * D + c) = w; }
    }
}

struct EpiA {
    static constexpr bool PERM = true, TRANS = true;
    unsigned char* ws;
    __device__ __forceinline__ void operator()(const f32x4 (&acc)[2][2][4][2], const pg8::Unit& u, int wr, int wc, int fr, int fq) const {
        const int ty = u.pn >> 1;
        h16* base = (h16*)(ws + (ty == 0 ? OFF_Q : ty == 1 ? OFF_LF : ty == 2 ? OFF_LBK : ty == 3 ? OFF_V : OFF_G));
        const float* lb = (const float*)(ws + OFF_LB) + (ty == 2 ? 512 : 0);
        const int row0 = u.pm * 256 + wr * 64 + fr, col0 = (u.pn & 1) * 256 + wc * 32 + 8 * fq;
#pragma unroll
        for (int bj = 0; bj < 2; ++bj) {
            float lbv[8];
            if (ty == 1 || ty == 2) {
#pragma unroll
                for (int j = 0; j < 8; ++j) lbv[j] = lb[col0 + bj * 128 + j];
            }
#pragma unroll
            for (int ai = 0; ai < 2; ++ai)
#pragma unroll
                for (int m = 0; m < 4; ++m) {
                    float v[8];
#pragma unroll
                    for (int j = 0; j < 4; ++j) { v[j] = acc[ai][bj][m][0][j]; v[4 + j] = acc[ai][bj][m][1][j]; }
                    if (ty == 0) {
#pragma unroll
                        for (int j = 0; j < 8; ++j) v[j] *= 0.08838834764831845f;
                    } else if (ty == 1 || ty == 2) {
#pragma unroll
                        for (int j = 0; j < 8; ++j) v[j] = __logf(lbv[j] + (1.0f - lbv[j]) * sigmoidf_(v[j]));
                    } else if (ty == 4) {
#pragma unroll
                        for (int j = 0; j < 8; ++j) v[j] = v[j] * sigmoidf_(v[j]);
                    }
                    u32x4 w; w.x = pk2(v[0], v[1]); w.y = pk2(v[2], v[3]); w.z = pk2(v[4], v[5]); w.w = pk2(v[6], v[7]);
                    *(u32x4*)(base + (size_t)(row0 + ai * 128 + m * 16) * 512 + col0 + bj * 128) = w;
                }
        }
    }
};
struct OrderA {
    pg8::TileOrder lat; int G, c;
    __device__ void init(int G_, int c_) { lat.init(128, 10, G_, c_); G = G_; c = c_; }
    __device__ bool next(int i, pg8::Unit& u) const {
        const long L = (long)i * G + c;
        if (L < 1280) return lat.map(L, u);
        const int l2 = (int)(L - 1280); if (l2 >= 48) return false;
        u.pm = 128 + l2 / 6; u.pn = 2 + l2 % 6; return true;
    }
};
struct EpiGate {
    static constexpr bool PERM = true, TRANS = true;
    unsigned char* ws;
    __device__ __forceinline__ void operator()(const f32x4 (&acc)[2][2][4][2], const pg8::Unit& u, int wr, int wc, int fr, int fq) const {
        h16* base = (h16*)(ws + (u.pn < 4 ? OFF_GH : OFF_GF));
        const int row0 = u.pm * 256 + wr * 64 + fr, col0 = (u.pn & 3) * 256 + wc * 32 + 8 * fq;
#pragma unroll
        for (int ai = 0; ai < 2; ++ai)
#pragma unroll
            for (int m = 0; m < 4; ++m)
#pragma unroll
                for (int bj = 0; bj < 2; ++bj) {
                    float v[8];
#pragma unroll
                    for (int j = 0; j < 4; ++j) { v[j] = sigmoidf_(acc[ai][bj][m][0][j]); v[4 + j] = sigmoidf_(acc[ai][bj][m][1][j]); }
                    u32x4 w; w.x = pk2(v[0], v[1]); w.y = pk2(v[2], v[3]); w.z = pk2(v[4], v[5]); w.w = pk2(v[6], v[7]);
                    *(u32x4*)(base + (size_t)(row0 + ai * 128 + m * 16) * 1024 + col0 + bj * 128) = w;
                }
    }
};
struct EpiFT {
    static constexpr bool PERM = false, TRANS = false;
    unsigned char* ws;
    __device__ __forceinline__ void operator()(const f32x4 (&acc)[2][2][4][2], const pg8::Unit& u, int wr, int wc, int fr, int fq) const {
        h16* F = (h16*)(ws + OFF_FTT);
        const int t0 = u.pm * 256 + wr * 64 + 4 * fq, c0 = u.pn * 256 + wc * 32 + fr;
#pragma unroll
        for (int ai = 0; ai < 2; ++ai)
#pragma unroll
            for (int m = 0; m < 4; ++m)
#pragma unroll
                for (int bj = 0; bj < 2; ++bj)
#pragma unroll
                    for (int n = 0; n < 2; ++n) {
                        const int t = t0 + ai * 128 + m * 16, c = c0 + bj * 128 + n * 16;
                        const int b = t >> 12, n1 = t & 4095, part = c >> 9, gk = c & 511;
                        const f32x4 a = acc[ai][bj][m][n];
                        u32x2 w; w.x = pk2(a.x, a.y); w.y = pk2(a.z, a.w);
                        *(u32x2*)(F + ((size_t)((b * 512 + gk) * 2 + part)) * 4096 + n1) = w;
                    }
    }
};
struct EpiDFT {
    static constexpr bool PERM = true, TRANS = true;
    unsigned char* ws;
    __device__ __forceinline__ void operator()(const f32x4 (&acc)[2][2][4][2], const pg8::Unit& u, int wr, int wc, int fr, int fq) const {
        h16* Y = (h16*)(ws + OFF_YFT);
        const int b = u.pn >> 1;
        const int row0 = b * 4096 + u.pm * 256 + wr * 64 + fr, col0 = (u.pn & 1) * 256 + wc * 32 + 8 * fq;
#pragma unroll
        for (int ai = 0; ai < 2; ++ai)
#pragma unroll
            for (int m = 0; m < 4; ++m)
#pragma unroll
                for (int bj = 0; bj < 2; ++bj) {
                    const f32x4 a0 = acc[ai][bj][m][0], a1 = acc[ai][bj][m][1];
                    u32x4 w; w.x = pk2(a0.x, a0.y); w.y = pk2(a0.z, a0.w); w.z = pk2(a1.x, a1.y); w.w = pk2(a1.z, a1.w);
                    *(u32x4*)(Y + (size_t)(row0 + ai * 128 + m * 16) * 512 + col0 + bj * 128) = w;
                }
    }
};
template <bool ACCUM> struct EpiMerge1 {
    static constexpr bool PERM = true, TRANS = true;
    unsigned char* ws;
    __device__ __forceinline__ void operator()(const f32x4 (&acc)[2][2][4][2], const pg8::Unit& u, int wr, int wc, int fr, int fq) const {
        h16* Y = (h16*)(ws + OFF_Y); const h16* GT = (const h16*)(ws + (ACCUM ? OFF_GF : OFF_GH));
        const int row0 = u.pm * 256 + wr * 64 + fr, col0 = u.pn * 256 + wc * 32 + 8 * fq;
#pragma unroll
        for (int ai = 0; ai < 2; ++ai)
#pragma unroll
            for (int m = 0; m < 4; ++m)
#pragma unroll
                for (int bj = 0; bj < 2; ++bj) {
                    const size_t off = (size_t)(row0 + ai * 128 + m * 16) * 1024 + col0 + bj * 128;
                    const h16x8 gt = *(const h16x8*)(GT + off);
                    float v[8];
#pragma unroll
                    for (int j = 0; j < 4; ++j) { v[j] = acc[ai][bj][m][0][j] * (float)gt[j]; v[4 + j] = acc[ai][bj][m][1][j] * (float)gt[4 + j]; }
                    if (ACCUM) { const h16x8 y0 = *(const h16x8*)(Y + off);
#pragma unroll
                        for (int j = 0; j < 8; ++j) v[j] += (float)y0[j]; }
                    u32x4 w; w.x = pk2(v[0], v[1]); w.y = pk2(v[2], v[3]); w.z = pk2(v[4], v[5]); w.w = pk2(v[6], v[7]);
                    *(u32x4*)(Y + off) = w;
                }
    }
};
struct EpiMerge2 {
    static constexpr bool PERM = false, TRANS = true;
    const float* x; float* H; const float* mod;
    __device__ __forceinline__ void operator()(const f32x4 (&acc)[2][2][4][2], const pg8::Unit& u, int wr, int wc, int fr, int fq) const {
        const int row0 = u.pm * 256 + wr * 64 + fr, col0 = u.pn * 256 + wc * 32 + 4 * fq;
        const int b = (u.pm * 256) >> 12;
        f32x4 g1[2][2];
#pragma unroll
        for (int bj = 0; bj < 2; ++bj)
#pragma unroll
            for (int n = 0; n < 2; ++n) g1[bj][n] = *(const f32x4*)(mod + b * 6144 + 2048 + col0 + bj * 128 + n * 16);
#pragma unroll
        for (int ai = 0; ai < 2; ++ai)
#pragma unroll
            for (int m = 0; m < 4; ++m) { const size_t ro = (size_t)(row0 + ai * 128 + m * 16) * 1024 + col0;
#pragma unroll
                for (int bj = 0; bj < 2; ++bj)
#pragma unroll
                    for (int n = 0; n < 2; ++n) { const f32x4 xv = *(const f32x4*)(x + ro + bj * 128 + n * 16);
                        *(f32x4*)(H + ro + bj * 128 + n * 16) = xv + g1[bj][n] * acc[ai][bj][m][n]; } }
    }
};
struct EpiF32 {
    static constexpr bool PERM = false, TRANS = true;
    float* C; int ldc;
    __device__ __forceinline__ void operator()(const f32x4 (&acc)[2][2][4][2], const pg8::Unit& u, int wr, int wc, int fr, int fq) const {
        const int row0 = u.pm * 256 + wr * 64 + fr, col0 = u.pn * 256 + wc * 32 + 4 * fq;
#pragma unroll
        for (int ai = 0; ai < 2; ++ai)
#pragma unroll
            for (int m = 0; m < 4; ++m) { float* rowp = C + (size_t)(row0 + ai * 128 + m * 16) * ldc + col0;
#pragma unroll
                for (int bj = 0; bj < 2; ++bj)
#pragma unroll
                    for (int n = 0; n < 2; ++n) *(f32x4*)(rowp + bj * 128 + n * 16) = acc[ai][bj][m][n]; }
    }
};

__device__ __forceinline__ int hgrn_row(int pos, int b, int dir) {
    if (pos < LC) { const int j = dir ? (LC - 1 - pos) : pos; return T + b * LC + j; }
    const int t = pos - LC; return b * SEQ + (dir ? (SEQ - 1 - t) : t);
}
__device__ void hgrn_item(const Params& p, LAS unsigned char* lds, int item) {
    const int tid = threadIdx.x, vq = item & 3, dir = (item >> 2) & 1, h = (item >> 3) & 3, b = item >> 5;
    const h16* Q = (const h16*)(p.ws + OFF_Q); const h16* LF = (const h16*)(p.ws + (dir ? OFF_LBK : OFF_LF)); const h16* V = (const h16*)(p.ws + OFF_V);
    h16* O = (h16*)(p.ws + (dir ? OFF_OB : OFF_OF));
    LAS float* fs = (LAS float*)lds; LAS float* ks = fs + 16 * 128; LAS float* qs = ks + 16 * 128; LAS float* vs = qs + 16 * 128; LAS float* po = vs + 16 * 32;
    const int v = tid & 31, kq = tid >> 5;
    float S[8];
#pragma unroll
    for (int j = 0; j < 8; ++j) S[j] = 0.f;
    const int e = tid * 4, tl_ld = e >> 7, k_ld = e & 127;
    const int tl_v = tid >> 5, vv = tid & 31;
    h16x4 lf4, q4; h16 v1;
    { const int row = hgrn_row(tl_ld, b, dir); lf4 = *(const h16x4*)(LF + (size_t)row * 512 + h * 128 + k_ld); q4 = (h16x4){0, 0, 0, 0};
      const int row2 = hgrn_row(tl_v, b, dir); v1 = V[(size_t)row2 * 512 + h * 128 + vq * 32 + vv]; }
    constexpr int NG = (LC + SEQ) / 16;
    for (int grp = 0; grp < NG; ++grp) {
        const bool latent = grp >= LC / 16;
#pragma unroll
        for (int j = 0; j < 4; ++j) { const float f = __expf((float)lf4[j]); fs[e + j] = f; ks[e + j] = 1.0f - f; qs[e + j] = (float)q4[j]; }
        vs[tid] = (float)v1;
        __syncthreads();
        if (grp + 1 < NG) { const int pos = (grp + 1) * 16; const bool lat2 = (grp + 1) >= LC / 16;
            const int row = hgrn_row(pos + tl_ld, b, dir); lf4 = *(const h16x4*)(LF + (size_t)row * 512 + h * 128 + k_ld);
            if (lat2) q4 = *(const h16x4*)(Q + (size_t)row * 512 + h * 128 + k_ld);
            const int row2 = hgrn_row(pos + tl_v, b, dir); v1 = V[(size_t)row2 * 512 + h * 128 + vq * 32 + vv]; }
#pragma unroll 4
        for (int tl = 0; tl < 16; ++tl) {
            const float vt = vs[tl * 32 + v];
            const f32x4 f0 = *(const LAS f32x4*)(fs + tl * 128 + kq * 8), f1 = *(const LAS f32x4*)(fs + tl * 128 + kq * 8 + 4);
            const f32x4 k0 = *(const LAS f32x4*)(ks + tl * 128 + kq * 8), k1 = *(const LAS f32x4*)(ks + tl * 128 + kq * 8 + 4);
            const f32x4 q0 = *(const LAS f32x4*)(qs + tl * 128 + kq * 8), q1 = *(const LAS f32x4*)(qs + tl * 128 + kq * 8 + 4);
            float a = 0.f;
#pragma unroll
            for (int j = 0; j < 4; ++j) { S[j] = f0[j] * S[j] + k0[j] * vt; a += S[j] * q0[j]; S[4 + j] = f1[j] * S[4 + j] + k1[j] * vt; a += S[4 + j] * q1[j]; }
            po[(tl * 16 + kq) * 32 + v] = a;
        }
        __syncthreads();
        if (latent) { float s = 0.f;
#pragma unroll
            for (int q = 0; q < 16; ++q) s += po[(tl_v * 16 + q) * 32 + vv];
            const int row = hgrn_row(grp * 16 + tl_v, b, dir);
            O[(size_t)row * 512 + h * 128 + vq * 32 + vv] = (h16)s; }
    }
    __syncthreads();
}

__device__ void a1_prepass(const Params& p) {
    const int wave = threadIdx.x >> 6, lane = threadIdx.x & 63;
    const h16* OF = (const h16*)(p.ws + OFF_OF); const h16* OB = (const h16*)(p.ws + OFF_OB); h16* G = (h16*)(p.ws + OFF_G);
    const float* hgn = p.in[11];
    for (int t = blockIdx.x * 8 + wave; t < T; t += gridDim.x * 8) {
        const size_t off = (size_t)t * 512 + lane * 8;
        const h16x8 a = *(const h16x8*)(OF + off), bq = *(const h16x8*)(OB + off), g = *(const h16x8*)(G + off);
        float o[8]; float ss = 0.f;
#pragma unroll
        for (int j = 0; j < 8; ++j) { o[j] = (float)a[j] + (float)bq[j]; ss += o[j] * o[j]; }
        ss += __shfl_xor(ss, 1); ss += __shfl_xor(ss, 2); ss += __shfl_xor(ss, 4); ss += __shfl_xor(ss, 8);
        const float rstd = rsqrtf(ss * (1.0f / 128.0f) + EPS);
        float r[8];
#pragma unroll
        for (int j = 0; j < 8; ++j) r[j] = o[j] * rstd * hgn[lane * 8 + j] * (float)g[j];
        u32x4 w; w.x = pk2(r[0], r[1]); w.y = pk2(r[2], r[3]); w.z = pk2(r[4], r[5]); w.w = pk2(r[6], r[7]);
        *(u32x4*)(G + off) = w;
    }
}

__device__ void convert_tables(const Params& p) {
    const size_t n8 = (size_t)16384 * 1024 / 8;
    for (int tb = 0; tb < 2; ++tb) { const float* src = p.in[17 + tb]; h16* dst = (h16*)(p.ws + (tb ? OFF_TV : OFF_TU));
        for (size_t i = (size_t)blockIdx.x * NTHREADS + threadIdx.x; i < n8; i += (size_t)gridDim.x * NTHREADS) {
            const f32x4 a = *(const f32x4*)(src + i * 8), bq = *(const f32x4*)(src + i * 8 + 4);
            u32x4 w; w.x = pk2(a.x, a.y); w.y = pk2(a.z, a.w); w.z = pk2(bq.x, bq.y); w.w = pk2(bq.z, bq.w);
            *(u32x4*)(dst + i * 8) = w; } }
}

__device__ __forceinline__ unsigned f2key(float x) { const unsigned b = __builtin_bit_cast(unsigned, x); return b ^ ((b >> 31) ? 0xFFFFFFFFu : 0x80000000u); }
__device__ __forceinline__ float key2f(unsigned u) { const unsigned b = (u & 0x80000000u) ? (u ^ 0x80000000u) : ~u; return __builtin_bit_cast(float, b); }
__device__ __forceinline__ unsigned umax3(unsigned a, unsigned b, unsigned c) { return max(max(a, b), c); }
__device__ __forceinline__ void top16_of_128(const float* sc, unsigned (&out)[16]) {
    unsigned s[128];
#pragma unroll
    for (int i = 0; i < 32; ++i) { const f32x4 t = *(const f32x4*)(sc + i * 4);
#pragma unroll
        for (int j = 0; j < 4; ++j) s[4 * i + j] = (f2key(t[j]) & ~127u) | (unsigned)(127 - (4 * i + j)); }
#pragma unroll 1
    for (int it = 0; it < 16; ++it) {
        unsigned m[43];
#pragma unroll
        for (int n = 0; n < 42; ++n) m[n] = umax3(s[3 * n], s[3 * n + 1], s[3 * n + 2]);
        m[42] = max(s[126], s[127]);
        unsigned m2[15];
#pragma unroll
        for (int n = 0; n < 14; ++n) m2[n] = umax3(m[3 * n], m[3 * n + 1], m[3 * n + 2]);
        m2[14] = m[42];
        unsigned m3[5];
#pragma unroll
        for (int n = 0; n < 5; ++n) m3[n] = umax3(m2[3 * n], m2[3 * n + 1], m2[3 * n + 2]);
        const unsigned best = max(umax3(m3[0], m3[1], m3[2]), max(m3[3], m3[4]));
#pragma unroll
        for (int n = 0; n < 128; ++n) s[n] = (s[n] == best) ? 0u : s[n];
#pragma unroll
        for (int i = 0; i < 16; ++i) out[i] = (i == it) ? best : out[i];
    }
}
__device__ void topk_phase(const Params& p, LAS unsigned char* lds) {
    const float* SC = (const float*)(p.ws + OFF_SC); int* EIDX = (int*)(p.ws + OFF_EIDX); float* GATE = (float*)(p.ws + OFF_GATE);
    LAS unsigned* st = (LAS unsigned*)lds;
    const int tid = threadIdx.x;
    for (int base = blockIdx.x * 256; base < T * 8; base += gridDim.x * 256) {
        {
            unsigned ks[16];
#pragma unroll
            for (int i = 0; i < 16; ++i) ks[i] = 0u;
            top16_of_128(SC + ((size_t)base * 2 + tid) * 128, ks);
#pragma unroll
            for (int i = 0; i < 16; ++i) st[i * NTHREADS + tid] = ks[i];
        }
        __syncthreads();
        if (tid < 256) {
            const int th = base + tid;
            float sv1[16];
#pragma unroll
            for (int j = 0; j < 16; ++j) sv1[j] = key2f(st[j * NTHREADS + 2 * tid + 1] & ~127u);
            unsigned cv[50];
            { int c = 0;
#pragma unroll
              for (int i = 0; i < 16; ++i) { const float a = key2f(st[i * NTHREADS + 2 * tid] & ~127u);
#pragma unroll
                  for (int j = 0; j < 16; ++j) if ((i + 1) * (j + 1) <= 16) { cv[c] = (f2key(a + sv1[j]) & ~255u) | (unsigned)(255 - (i * 16 + j)); ++c; } } }
            unsigned ok[16];
#pragma unroll
            for (int i = 0; i < 16; ++i) ok[i] = 0u;
#pragma unroll 1
            for (int it = 0; it < 16; ++it) {
                unsigned m[17];
#pragma unroll
                for (int n = 0; n < 16; ++n) m[n] = umax3(cv[3 * n], cv[3 * n + 1], cv[3 * n + 2]);
                m[16] = max(cv[48], cv[49]);
                unsigned m2[6];
#pragma unroll
                for (int n = 0; n < 5; ++n) m2[n] = umax3(m[3 * n], m[3 * n + 1], m[3 * n + 2]);
                m2[5] = max(m[15], m[16]);
                const unsigned best = max(umax3(m2[0], m2[1], m2[2]), umax3(m2[3], m2[4], m2[5]));
#pragma unroll
                for (int n = 0; n < 50; ++n) cv[n] = (cv[n] == best) ? 0u : cv[n];
#pragma unroll
                for (int i = 0; i < 16; ++i) ok[i] = (i == it) ? best : ok[i];
            }
            float ex[16]; int oe[16]; float den = 0.f;
            const float v0 = key2f(ok[0] & ~255u);
#pragma unroll
            for (int i = 0; i < 16; ++i) { const int ij = 255 - (int)(ok[i] & 255u), ci = ij >> 4, cj = ij & 15;
                const int e0 = 127 - (int)(st[ci * NTHREADS + 2 * tid] & 127u), e1 = 127 - (int)(st[cj * NTHREADS + 2 * tid + 1] & 127u);
                oe[i] = e0 * 128 + e1; ex[i] = __expf(key2f(ok[i] & ~255u) - v0); den += ex[i]; }
            const float inv = 1.0f / den;
#pragma unroll
            for (int i = 0; i < 4; ++i) {
                *(f32x4*)(GATE + (size_t)th * 16 + 4 * i) = (f32x4){ex[4 * i] * inv, ex[4 * i + 1] * inv, ex[4 * i + 2] * inv, ex[4 * i + 3] * inv};
                *(int4*)(EIDX + (size_t)th * 16 + 4 * i) = make_int4(oe[4 * i], oe[4 * i + 1], oe[4 * i + 2], oe[4 * i + 3]); }
        }
        __syncthreads();
    }
}

__device__ __forceinline__ int bitrev6(int x) { return ((x & 1) << 5) | ((x & 2) << 3) | ((x & 4) << 1) | ((x & 8) >> 1) | ((x & 16) >> 3) | ((x & 32) >> 5); }
__device__ void peer_phase(const Params& p) {
    const int wave = threadIdx.x >> 6, lane = threadIdx.x & 63;
    const h16* U2 = (const h16*)(p.ws + OFF_U2); const h16* TU = (const h16*)(p.ws + OFF_TU); const h16* TV = (const h16*)(p.ws + OFF_TV);
    const int* EIDX = (const int*)(p.ws + OFF_EIDX); const float* GATE = (const float*)(p.ws + OFF_GATE);
    const float* mod = (const float*)(p.ws + OFF_MOD); float* H = p.out; const float* fg = p.in[19];
    for (int t = blockIdx.x * 8 + wave; t < T; t += gridDim.x * 8) {
        const int b = t >> 12;
        const h16x8 x0 = *(const h16x8*)(U2 + (size_t)t * D + lane * 16), x1 = *(const h16x8*)(U2 + (size_t)t * D + lane * 16 + 8);
        const int e0 = EIDX[(size_t)t * 128 + lane], e1 = EIDX[(size_t)t * 128 + 64 + lane];
        float part[128];
#pragma unroll
        for (int k = 0; k < 128; ++k) {
            const int e = __builtin_amdgcn_readlane(k < 64 ? e0 : e1, k & 63);
            const h16* ur = TU + (size_t)e * D + lane * 16;
            const h16x8 u0 = *(const h16x8*)ur, u1 = *(const h16x8*)(ur + 8);
            float s = 0.f;
#pragma unroll
            for (int j = 0; j < 8; ++j) s += (float)u0[j] * (float)x0[j] + (float)u1[j] * (float)x1[j];
            part[k] = s;
        }
#define RED_STEP(NIN, MASK) _Pragma("unroll") for (int j = 0; j < (NIN) / 2; ++j) { const bool up = (lane & (MASK)) != 0; \
            const float keep = up ? part[2 * j + 1] : part[2 * j], send = up ? part[2 * j] : part[2 * j + 1]; part[j] = keep + __shfl_xor(send, (MASK)); }
        RED_STEP(128, 1) RED_STEP(64, 2) RED_STEP(32, 4) RED_STEP(16, 8) RED_STEP(8, 16) RED_STEP(4, 32)
#undef RED_STEP
        const int kk = lane;
        float w0, w1;
        { const float a0 = part[0], a1 = part[1];
          const float g0 = GATE[(size_t)t * 128 + kk], g1 = GATE[(size_t)t * 128 + 64 + kk];
          w0 = g0 * (0.5f * a0 * (1.0f + erff(a0 * 0.70710678118654752f)));
          w1 = g1 * (0.5f * a1 * (1.0f + erff(a1 * 0.70710678118654752f))); }
        float acc[16];
#pragma unroll
        for (int j = 0; j < 16; ++j) acc[j] = 0.f;
#pragma unroll
        for (int k = 0; k < 128; ++k) {
            const int e = __builtin_amdgcn_readlane(k < 64 ? e0 : e1, k & 63);
            const float wk = __builtin_bit_cast(float, __builtin_amdgcn_readlane(__builtin_bit_cast(int, k < 64 ? w0 : w1), k & 63));
            const h16* vr = TV + (size_t)e * D + lane * 16;
            const h16x8 v0 = *(const h16x8*)vr, v1 = *(const h16x8*)(vr + 8);
#pragma unroll
            for (int j = 0; j < 8; ++j) { acc[j] += wk * (float)v0[j]; acc[8 + j] += wk * (float)v1[j]; }
        }
        float* hr = H + (size_t)t * D + lane * 16; const float* g2 = mod + b * 6144 + 5120 + lane * 16;
        float h2[16]; float ss = 0.f;
#pragma unroll
        for (int q = 0; q < 4; ++q) { const f32x4 hv = *(const f32x4*)(hr + 4 * q), gv = *(const f32x4*)(g2 + 4 * q);
#pragma unroll
            for (int j = 0; j < 4; ++j) { const float y = hv[j] + gv[j] * acc[4 * q + j]; h2[4 * q + j] = y; ss += y * y; } }
        ss = wave_sum(ss);
        const float rstd = rsqrtf(ss * (1.0f / D) + EPS);
#pragma unroll
        for (int q = 0; q < 4; ++q) { const f32x4 fv = *(const f32x4*)(fg + lane * 16 + 4 * q);
            *(f32x4*)(hr + 4 * q) = (f32x4){h2[4 * q] * rstd * fv.x, h2[4 * q + 1] * rstd * fv.y, h2[4 * q + 2] * rstd * fv.z, h2[4 * q + 3] * rstd * fv.w}; }
    }
}
constexpr int N_PHASES = 11;
__global__ void __launch_bounds__(NTHREADS, 2) mega(Params p) {
    extern __shared__ __attribute__((aligned(16))) unsigned char smem[];
    LAS unsigned char* lds = (LAS unsigned char*)smem;
    const int G = gridDim.x, c = blockIdx.x;
    unsigned char* ws = p.ws;
#define IN(k) (p.ph_lo <= (k) && (k) < p.ph_hi)
#define SEAM(k) do { if (IN(k) && IN((k) + 1)) { cg::grid_group grid = cg::this_grid(); grid.sync(); } } while (0)
    if (IN(0)) phase0(p, lds);
    SEAM(0);
    if (IN(1)) {
        const float* mod = (const float*)(ws + OFF_MOD);
        modulate_rows(p.in[0], (h16*)(ws + OFF_UALL), T, p.in[6], mod, 0, 1024, 0);
        modulate_rows(p.in[2], (h16*)(ws + OFF_UALL) + (size_t)T * D, TC, p.in[6], mod, 0, 1024, 1);
    }
    SEAM(1);
    if (IN(2)) {
        { pg8::Gemm g{ws + OFF_UALL, ws + OFF_WA, 1024, 1024, 1024}; OrderA S; S.init(G, c); EpiA E{ws}; pg8::gemm_phase(lds, g, S, E); }
        { pg8::Gemm g{ws + OFF_UALL, ws + OFF_WF, 1024, 1024, 1024}; pg8::TileOrder S; S.init(128, 4, G, c); EpiFT E{ws}; pg8::gemm_phase(lds, g, S, E); }
    }
    SEAM(2);
    if (IN(3)) { for (int it = blockIdx.x; it < 256; it += gridDim.x) hgrn_item(p, lds, it); }
    SEAM(3);
    if (IN(4)) {
        { pg8::Gemm g{ws + OFF_DFTM, ws + OFF_FTT, 8192, 8192, 8192}; pg8::TileOrder S; S.init(16, 16, G, c); EpiDFT E{ws}; pg8::gemm_phase(lds, g, S, E); }
        { pg8::Gemm g{ws + OFF_UALL, ws + OFF_WG, 1024, 1024, 1024}; pg8::TileOrder S; S.init(128, 8, G, c); EpiGate E{ws}; pg8::gemm_phase(lds, g, S, E); }
        a1_prepass(p);
    }
    SEAM(4);
    if (IN(5)) {
        { pg8::Gemm g{ws + OFF_G, ws + OFF_WHG, 512, 512, 512}; pg8::TileOrder S; S.init(128, 4, G, c); EpiMerge1<false> E{ws}; pg8::gemm_phase(lds, g, S, E); }
        { pg8::Gemm g{ws + OFF_YFT, ws + OFF_WFT, 512, 512, 512}; pg8::TileOrder S; S.init(128, 4, G, c); EpiMerge1<true> E{ws}; pg8::gemm_phase(lds, g, S, E); }
    }
    SEAM(5);
    if (IN(6)) { pg8::Gemm g{ws + OFF_Y, ws + OFF_WOUT, 1024, 1024, 1024}; pg8::TileOrder S; S.init(128, 4, G, c);
                 EpiMerge2 E{p.in[0], p.out, (const float*)(ws + OFF_MOD)}; pg8::gemm_phase(lds, g, S, E); }
    SEAM(6);
    if (IN(7)) { modulate_rows(p.out, (h16*)(ws + OFF_U2), T, p.in[7], (const float*)(ws + OFF_MOD), 3072, 4096, 0); convert_tables(p); }
    SEAM(7);
    if (IN(8)) { pg8::Gemm g{ws + OFF_U2, ws + OFF_WS, 1024, 1024, 1024}; pg8::TileOrder S; S.init(128, 8, G, c);
                 EpiF32 E{(float*)(ws + OFF_SC), 2048}; pg8::gemm_phase(lds, g, S, E); }
    SEAM(8);
    if (IN(9)) topk_phase(p, lds);
    SEAM(9);
    if (IN(10)) peer_phase(p);
#undef IN
#undef SEAM
}

#ifndef MK_SINGLE
#define MK_SINGLE 1
#endif
extern "C" void kernel_launch(void* const* d_in, const int* in_sizes, int n_in, void* d_out, int out_size, void* d_ws, size_t ws_size, hipStream_t stream) {
    static int grid = 0;
    if (grid == 0) {
        if (n_in != 20 || out_size != T * D || ws_size < WS_NEED) { fprintf(stderr, "kernel_launch: unexpected shapes (n_in %d out %d ws %zu)\n", n_in, out_size, ws_size); grid = -1; return; }
        int dev = 0, cus = 0, per_cu = 0;
        hipGetDevice(&dev); hipDeviceGetAttribute(&cus, hipDeviceAttributeMultiprocessorCount, dev);
        if (hipFuncSetAttribute((const void*)mega, hipFuncAttributeMaxDynamicSharedMemorySize, LDS_BYTES) != hipSuccess) { fprintf(stderr, "kernel_launch: hipFuncSetAttribute failed\n"); grid = -1; return; }
        hipOccupancyMaxActiveBlocksPerMultiprocessor(&per_cu, (const void*)mega, NTHREADS, LDS_BYTES);
        if (per_cu < 1) { fprintf(stderr, "kernel_launch: occupancy query says %d blocks per CU\n", per_cu); grid = -1; return; }
        grid = cus;
    }
    if (grid < 0) return;
    Params p{};
    for (int i = 0; i < 20; ++i) p.in[i] = (const float*)d_in[i];
    p.out = (float*)d_out; p.ws = (unsigned char*)d_ws;
#if MK_SINGLE
    p.ph_lo = 0; p.ph_hi = N_PHASES;
    void* args[] = {&p};
    hipError_t e = hipLaunchCooperativeKernel((const void*)mega, dim3(grid), dim3(NTHREADS), args, LDS_BYTES, stream);
    if (e != hipSuccess) fprintf(stderr, "cooperative launch failed: %s (grid %d)\n", hipGetErrorString(e), grid);
#else
    for (int ph = 0; ph < N_PHASES; ++ph) { p.ph_lo = ph; p.ph_hi = ph + 1; hipLaunchKernelGGL(mega, dim3(grid), dim3(NTHREADS), LDS_BYTES, stream, p); }
#endif
}
```

```cpp
#include <hip/hip_runtime.h>
#include <hip/hip_cooperative_groups.h>
#include <cstdio>
#include <cstdint>
namespace cg = cooperative_groups;
#define LAS __attribute__((address_space(3)))
namespace pg8 {
#define PG8_LAS __attribute__((address_space(3)))
typedef _Float16 f16x8 __attribute__((ext_vector_type(8)));
typedef float f32x4 __attribute__((ext_vector_type(4)));
typedef unsigned u32x4 __attribute__((ext_vector_type(4)));
typedef unsigned u32x2 __attribute__((ext_vector_type(2)));
constexpr int BM = 256, BK = 64, HALF = 128, HTB = HALF * BK * 2, STAGE_BYTES = 8 * HTB, NXCD = 8, WGM = 8;

__host__ __device__ __forceinline__ int lds_byte(int r, int c) { const int st = (r >> 4) * 2 + (c >> 5), rr = r & 15, cc = c & 31, ob = rr * 64 + cc * 2; return st * 1024 + (ob ^ (((ob >> 9) & 1) << 5)); }
__host__ __device__ __forceinline__ void stage_rc(int b, int& R, int& C) { const int st = b / 1024, sb = b % 1024, swz = sb ^ (((sb >> 9) & 1) << 5); R = (st >> 1) * 16 + swz / 64; C = (st & 1) * 32 + (swz % 64) / 2; }
__host__ __device__ __forceinline__ int perm32(int rho) { const int n = rho >> 4, i = rho & 15; return 8 * (i >> 2) + 4 * n + (i & 3); }

struct Unit { int pm, pn; };
struct Gemm { const void* A; const void* Bt; int lda, ldb, K; };

struct TileOrder {
    int nM, nN, nwg, G, c;
    __device__ void init(int nM_, int nN_, int G_, int c_) { nM = nM_; nN = nN_; nwg = nM * nN; G = G_; c = c_; }
    __device__ bool map(long L, Unit& u) const {
        if (L >= nwg) return false;
        int wgid = (int)L; { const int q = nwg / NXCD, r = nwg % NXCD, xcd = wgid % NXCD, off = wgid / NXCD; wgid = (xcd < r ? xcd * (q + 1) : r * (q + 1) + (xcd - r) * q) + off; }
        const int nig = WGM * nN, gid = wgid / nig, fm = gid * WGM, gsz = (nM - fm) < WGM ? (nM - fm) : WGM;
        u.pm = fm + ((wgid % nig) % gsz); u.pn = (wgid % nig) / gsz; return true;
    }
    __device__ bool next(int i, Unit& u) const { return map((long)i * G + c, u); }
};

template <class Epi, class Sched>
__device__ __forceinline__ void gemm_phase(PG8_LAS unsigned char* lds, const Gemm g, const Sched& S, const Epi& E) {
    const int tid = threadIdx.x, wid = __builtin_amdgcn_readfirstlane(tid >> 6), lane = tid & 63, wr = wid >> 2, wc = wid & 3, fr = lane & 15, fq = lane >> 4;
    const int K = g.K, nt = K / BK;
    unsigned voffA[2], voffB[2];
#pragma unroll
    for (int i = 0; i < 2; ++i) { int R, C; stage_rc(tid * 16 + i * 8192, R, C); const int Rb = Epi::PERM ? ((R & ~31) + perm32(R & 31)) : R;
        voffA[i] = (unsigned)(R * g.lda + C) * 2u; voffB[i] = (unsigned)(Rb * g.ldb + C) * 2u; }
    const size_t kstep = (size_t)(BK * 2);
    const size_t hstepA = (size_t)HALF * g.lda * 2, hstepB = (size_t)HALF * g.ldb * 2;
    const size_t tstepA = 2 * hstepA, tstepB = 2 * hstepB;
    const unsigned ldsw = (unsigned)wid * 1024u;
    const int aoff = lds_byte(wr * 64 + fr, fq * 8), boff = lds_byte(wc * 32 + fr, fq * 8);
#define PG8_SA(b, h) (((b) * 2 + (h)) * HTB)
#define PG8_SB(b, h) ((4 + (b) * 2 + (h)) * HTB)
#define PG8_STAGE(bufoff, gbase, voff) do { _Pragma("unroll") for (int _i = 0; _i < 2; ++_i) \
        __builtin_amdgcn_global_load_lds((const unsigned*)((const char*)(gbase) + (voff)[_i]), (PG8_LAS unsigned*)(lds + (bufoff) + ldsw + _i * 8192), 16, 0, 0); } while (0)
#define PG8_LDA(dst, b, h) do { _Pragma("unroll") for (int m = 0; m < 4; ++m) _Pragma("unroll") for (int k = 0; k < 2; ++k) dst[m][k] = *(const PG8_LAS f16x8*)(lds + PG8_SA(b, h) + aoff + m * 2048 + k * 1024); } while (0)
#define PG8_LDB(dst, b, h) do { _Pragma("unroll") for (int n = 0; n < 2; ++n) _Pragma("unroll") for (int k = 0; k < 2; ++k) dst[n][k] = *(const PG8_LAS f16x8*)(lds + PG8_SB(b, h) + boff + n * 2048 + k * 1024); } while (0)
#define PG8_MMA(ai, bj, At, Bt) do { __builtin_amdgcn_s_setprio(1); _Pragma("unroll") for (int m = 0; m < 4; ++m) _Pragma("unroll") for (int n = 0; n < 2; ++n) _Pragma("unroll") for (int k = 0; k < 2; ++k) \
        acc[ai][bj][m][n] = Epi::TRANS ? __builtin_amdgcn_mfma_f32_16x16x32_f16(Bt[n][k], At[m][k], acc[ai][bj][m][n], 0, 0, 0) \
                                       : __builtin_amdgcn_mfma_f32_16x16x32_f16(At[m][k], Bt[n][k], acc[ai][bj][m][n], 0, 0, 0); __builtin_amdgcn_s_setprio(0); } while (0)
#define PG8_WAIT_V(n) asm volatile("s_waitcnt vmcnt(" #n ")" ::: "memory")
#define PG8_WAIT_L(n) asm volatile("s_waitcnt lgkmcnt(" #n ")" ::: "memory")
#define PG8_BAR __builtin_amdgcn_s_barrier()
#define PG8_SCHED __builtin_amdgcn_sched_barrier(0)
    Unit cur, nxt; int ui = 0;
    if (!S.next(0, cur)) return;
    f32x4 acc[2][2][4][2];
#pragma unroll
    for (int a = 0; a < 2; ++a)
#pragma unroll
        for (int b = 0; b < 2; ++b)
#pragma unroll
            for (int m = 0; m < 4; ++m)
#pragma unroll
                for (int n = 0; n < 2; ++n) acc[a][b][m][n] = (f32x4){0.f, 0.f, 0.f, 0.f};
    f16x8 At[4][2], B0[2][2], B1[2][2];
    const char* cA = (const char*)g.A + (size_t)cur.pm * tstepA; const char* cB = (const char*)g.Bt + (size_t)cur.pn * tstepB;
    PG8_STAGE(PG8_SB(0, 0), cB, voffB); PG8_STAGE(PG8_SA(0, 0), cA, voffA); PG8_STAGE(PG8_SB(0, 1), cB + hstepB, voffB); PG8_STAGE(PG8_SA(0, 1), cA + hstepA, voffA);
    if (wr == 1) PG8_BAR;
    PG8_WAIT_V(4); PG8_BAR;
    PG8_STAGE(PG8_SB(1, 0), cB + kstep, voffB); PG8_STAGE(PG8_SA(1, 0), cA + kstep, voffA); PG8_STAGE(PG8_SB(1, 1), cB + hstepB + kstep, voffB);
    PG8_WAIT_V(6); PG8_BAR;
    for (;;) {
        const bool has_next = S.next(ui + 1, nxt);
        const char* nA = has_next ? (const char*)g.A + (size_t)nxt.pm * tstepA : cA; const char* nB = has_next ? (const char*)g.Bt + (size_t)nxt.pn * tstepB : cB;
        for (int t = 0; t < nt; t += 2) {
            const bool last = (t == nt - 2);
            const char* a1 = cA + (size_t)(t + 1) * kstep;
            const char* a2 = last ? nA : cA + (size_t)(t + 2) * kstep; const char* b2 = last ? nB : cB + (size_t)(t + 2) * kstep;
            const char* a3 = a2 + kstep; const char* b3 = b2 + kstep;
            PG8_LDB(B0, 0, 0); PG8_SCHED; PG8_LDA(At, 0, 0); PG8_STAGE(PG8_SA(1, 1), a1 + hstepA, voffA);
            PG8_WAIT_L(8); PG8_BAR; PG8_WAIT_L(0); PG8_MMA(0, 0, At, B0); PG8_BAR; PG8_SCHED;
            PG8_LDB(B1, 0, 1); PG8_STAGE(PG8_SB(0, 0), b2, voffB);
            PG8_BAR; PG8_WAIT_L(0); PG8_MMA(0, 1, At, B1); PG8_BAR;
            PG8_LDA(At, 0, 1); PG8_STAGE(PG8_SA(0, 0), a2, voffA);
            PG8_BAR; PG8_WAIT_L(0); PG8_MMA(1, 0, At, B0); PG8_BAR; PG8_SCHED;
            PG8_STAGE(PG8_SB(0, 1), b2 + hstepB, voffB);
            PG8_WAIT_V(6); PG8_BAR; PG8_MMA(1, 1, At, B1); PG8_BAR;
            PG8_LDB(B0, 1, 0); PG8_SCHED; PG8_LDA(At, 1, 0); PG8_STAGE(PG8_SA(0, 1), a2 + hstepA, voffA);
            PG8_WAIT_L(8); PG8_BAR; PG8_WAIT_L(0); PG8_MMA(0, 0, At, B0); PG8_BAR; PG8_SCHED;
            PG8_LDB(B1, 1, 1); PG8_STAGE(PG8_SB(1, 0), b3, voffB);
            PG8_BAR; PG8_WAIT_L(0); PG8_MMA(0, 1, At, B1); PG8_BAR;
            PG8_LDA(At, 1, 1); PG8_STAGE(PG8_SA(1, 0), a3, voffA);
            PG8_BAR; PG8_WAIT_L(0); PG8_MMA(1, 0, At, B0); PG8_BAR; PG8_SCHED;
            PG8_STAGE(PG8_SB(1, 1), b3 + hstepB, voffB);
            PG8_WAIT_V(6); PG8_BAR; PG8_MMA(1, 1, At, B1); PG8_BAR;
        }
        E(acc, cur, wr, wc, fr, fq);
        if (!has_next) break;
#pragma unroll
        for (int a = 0; a < 2; ++a)
#pragma unroll
            for (int b = 0; b < 2; ++b)
#pragma unroll
                for (int m = 0; m < 4; ++m)
#pragma unroll
                    for (int n = 0; n < 2; ++n) acc[a][b][m][n] = (f32x4){0.f, 0.f, 0.f, 0.f};
        cur = nxt; cA = nA; cB = nB; ++ui;
    }
    PG8_WAIT_V(0);
    if (wr == 0) PG8_BAR;
    PG8_BAR;
#undef PG8_SA
#undef PG8_SB
#undef PG8_STAGE
#undef PG8_LDA
#undef PG8_LDB
#undef PG8_MMA
#undef PG8_WAIT_V
#undef PG8_WAIT_L
#undef PG8_BAR
#undef PG8_SCHED
}
}
#define XB_TMO      128
#define XB_XCNT(j)  (256  + 64 * (j))
#define XB_XSUB(j)  (1280 + 64 * (j))
#define XB_XGEN(j)  (2304 + 64 * (j))
#define XB_TOP      3328
#define XB_TOPGEN   3392
#define XCD_BAR_WORDS 3456
#define XB_SPIN_CAP (1u << 20)


__device__ __forceinline__ unsigned xb_ld(unsigned* p)              { return __hip_atomic_load(p, __ATOMIC_RELAXED, __HIP_MEMORY_SCOPE_AGENT); }
__device__ __forceinline__ unsigned xb_add(unsigned* p, unsigned v) { return __hip_atomic_fetch_add(p, v, __ATOMIC_RELAXED, __HIP_MEMORY_SCOPE_AGENT); }
__device__ __forceinline__ unsigned xb_xcc_id() { return (unsigned)__builtin_amdgcn_s_getreg((3 << 11) | 20) & 0xFu; }
#define XB_SPIN(cond, bar) do { unsigned _sp = 0; while (cond) { __builtin_amdgcn_s_sleep(1); \
    if ((++_sp & 255u) == 0u) { if (xb_ld(&(bar)[XB_TMO])) break; if (_sp > XB_SPIN_CAP) { atomicAdd(&(bar)[XB_TMO], 1u); break; } } } } while (0)

struct XcdBarrier {
    unsigned* bar; unsigned x;
    volatile LAS unsigned* st;
};

__device__ __forceinline__ XcdBarrier xcd_barrier_post(unsigned* bar, volatile LAS unsigned* st) {
    XcdBarrier b; b.bar = bar; b.x = xb_xcc_id(); b.st = st;
    if (threadIdx.x == 0) (void)xb_add(&bar[XB_XCNT(b.x)], 1u);
    return b;
}
__device__ __forceinline__ void xcd_barrier_complete(unsigned* bar, unsigned x, unsigned& nloc, unsigned& nx) {
    const unsigned G = gridDim.x * gridDim.y * gridDim.z;
    unsigned sum, cnt, mine, sp = 0u;
    for (;;) {
        sum = 0u; cnt = 0u; mine = 0u;
#pragma unroll
        for (unsigned j = 0; j < 16; ++j) { const unsigned c = xb_ld(&bar[XB_XCNT(j)]); sum += c; cnt += (c > 0u) ? 1u : 0u; mine = (j == x) ? c : mine; }
        if (sum == G) break;
        __builtin_amdgcn_s_sleep(1);
        if ((++sp & 255u) == 0u) { if (xb_ld(&bar[XB_TMO])) break; if (sp > XB_SPIN_CAP) { atomicAdd(&bar[XB_TMO], 1u); break; } }
    }
    nloc = mine > 0u ? mine : 1u; nx = cnt > 0u ? cnt : 1u;
}

__device__ __forceinline__ void xcd_barrier(const XcdBarrier& b) {
    asm volatile("s_waitcnt vmcnt(0)" ::: "memory");
    __syncthreads();
    if (threadIdx.x == 0) {
        unsigned* bar = b.bar;
        __builtin_amdgcn_s_waitcnt(0);
        unsigned nloc = b.st[0], nx = b.st[1];
        if (nloc == 0u) { xcd_barrier_complete(bar, b.x, nloc, nx); b.st[0] = nloc; b.st[1] = nx; }
        const unsigned old = xb_add(&bar[XB_XSUB(b.x)], 1u);
        const unsigned gen = old / nloc;
        if (old + 1u == (gen + 1u) * nloc) {
            __builtin_amdgcn_fence(__ATOMIC_RELEASE, "agent");
            asm volatile("s_waitcnt vmcnt(0)" ::: "memory");
            const unsigned og = xb_add(&bar[XB_TOP], 1u);
            const unsigned tg = og / nx;
            if (og + 1u == (tg + 1u) * nx) xb_add(&bar[XB_TOPGEN], 1u);
            else XB_SPIN(xb_ld(&bar[XB_TOPGEN]) == tg, bar);
            __builtin_amdgcn_fence(__ATOMIC_ACQUIRE, "agent");
            xb_add(&bar[XB_XGEN(b.x)], 1u);
            asm volatile("s_waitcnt vmcnt(0)" ::: "memory");
        } else {
            XB_SPIN(xb_ld(&bar[XB_XGEN(b.x)]) == gen, bar);
            __builtin_amdgcn_fence(__ATOMIC_ACQUIRE, "agent");
            asm volatile("s_waitcnt vmcnt(0)" ::: "memory");
        }
    }
    __syncthreads();
}

typedef _Float16 h16;
typedef h16 h16x2 __attribute__((ext_vector_type(2)));
typedef h16 h16x4 __attribute__((ext_vector_type(4)));
typedef h16 h16x8 __attribute__((ext_vector_type(8)));
typedef float f32x4 __attribute__((ext_vector_type(4)));
typedef float f32x2 __attribute__((ext_vector_type(2)));
typedef unsigned u32x4 __attribute__((ext_vector_type(4)));
typedef unsigned u32x2 __attribute__((ext_vector_type(2)));

constexpr int D = 1024, NB = 8, SEQ = 4096, T = NB * SEQ, LC = 256, TC = NB * LC, TALL = T + TC;
constexpr int NTHREADS = 512;
constexpr int LDS_BYTES = 136 * 1024;
constexpr float EPS = 1e-6f;
constexpr size_t MiB = (size_t)1 << 20;
constexpr size_t OFF_CTL = 0;
constexpr size_t OFF_MOD = 64 * 1024;
constexpr size_t OFF_LB = 320 * 1024;
constexpr size_t OFF_WA = 1 * MiB;
constexpr size_t OFF_WG = 6 * MiB;
constexpr size_t OFF_WF = 10 * MiB;
constexpr size_t OFF_WHG = 12 * MiB;
constexpr size_t OFF_WFT = 13 * MiB;
constexpr size_t OFF_WOUT = 14 * MiB;
constexpr size_t OFF_WS = 16 * MiB;
constexpr size_t OFF_UALL = 20 * MiB;
constexpr size_t OFF_OF = 88 * MiB;
constexpr size_t OFF_OB = 120 * MiB;
constexpr size_t OFF_FTT = 152 * MiB;
constexpr size_t OFF_Q = 216 * MiB;
constexpr size_t OFF_LF = 248 * MiB;
constexpr size_t OFF_LBK = 282 * MiB;
constexpr size_t OFF_V = 316 * MiB;
constexpr size_t OFF_G = 350 * MiB;
constexpr size_t OFF_DFTM = 382 * MiB;
constexpr size_t OFF_YFT = 446 * MiB;
constexpr size_t WS_NEED = 478 * MiB;
constexpr size_t OFF_GH = 216 * MiB;
constexpr size_t OFF_GF = 280 * MiB;
constexpr size_t OFF_Y = 152 * MiB;
constexpr size_t OFF_U2 = 20 * MiB;
constexpr size_t OFF_TU = 88 * MiB;
constexpr size_t OFF_TV = 120 * MiB;
constexpr size_t OFF_SC = 216 * MiB;
constexpr size_t OFF_EIDX = 152 * MiB;
constexpr size_t OFF_GATE = 168 * MiB;
constexpr size_t OFF_W = 184 * MiB;
constexpr size_t OFF_PSS = 200 * MiB;
constexpr size_t OFF_PACT = 216 * MiB;
constexpr int CTL_RANK = 4096;
constexpr size_t CTL_ZERO_BYTES = 32 * 1024;

struct Params { const float* in[20]; float* out; unsigned char* ws; int ph_lo, ph_hi; };

__device__ __forceinline__ unsigned pk2(float a, float b) { h16x2 v = {(h16)a, (h16)b}; return __builtin_bit_cast(unsigned, v); }
__device__ __forceinline__ float wave_sum(float v) {
#pragma unroll
    for (int o = 32; o >= 1; o >>= 1) v += __shfl_xor(v, o);
    return v; }
__device__ __forceinline__ float sigmoidf_(float z) { return 1.0f / (1.0f + __expf(-z)); }

constexpr int N_MOD = 96, N_LB = 1, N_TRA = 640, N_TRG = 512, N_TRHG = 128, N_TRFT = 128, N_TROUT = 256, N_WF = 128, N_WSF = 256, N_DFT = 256;
constexpr int P0_TOTAL = N_MOD + N_LB + N_TRA + N_TRG + N_TRHG + N_TRFT + N_TROUT + N_WF + N_WSF + N_DFT;

__device__ void p0_mod(const Params& p, LAS float* sm, int idx) {
    const int tid = threadIdx.x;
    for (int i = tid; i < 9 * 1024; i += NTHREADS) { const int r = i >> 10, k = i & 1023; const float c = (r < 8) ? p.in[1][r * 1024 + k] : p.in[3][k]; sm[i] = c / (1.0f + __expf(-c)); }
    __syncthreads();
    const int col = tid & 63, ks = tid >> 6;
    float acc[9];
#pragma unroll
    for (int r = 0; r < 9; ++r) acc[r] = 0.f;
    const float* w = p.in[4] + (size_t)(ks * 128) * 6144 + idx * 64 + col;
#pragma unroll 4
    for (int k = 0; k < 128; ++k) { const float wv = w[(size_t)k * 6144];
#pragma unroll
        for (int r = 0; r < 9; ++r) acc[r] += sm[r * 1024 + ks * 128 + k] * wv; }
    LAS float* red = sm + 9 * 1024;
#pragma unroll
    for (int r = 0; r < 9; ++r) red[(ks * 9 + r) * 64 + col] = acc[r];
    __syncthreads();
    float* mod = (float*)(p.ws + OFF_MOD);
    for (int i = tid; i < 576; i += NTHREADS) { const int r = i >> 6, c = i & 63; float s = 0.f;
#pragma unroll
        for (int q = 0; q < 8; ++q) s += red[(q * 9 + r) * 64 + c];
        mod[r * 6144 + idx * 64 + c] = s + p.in[5][idx * 64 + c]; }
    __syncthreads();
}
__device__ void p0_lb(const Params& p) {
    const int tid = threadIdx.x; float* lb = (float*)(p.ws + OFF_LB);
    if (tid < 512) { lb[tid] = 1.0f / (1.0f + expf(p.in[9][512 + tid] - p.in[9][tid])); lb[512 + tid] = 1.0f / (1.0f + expf(p.in[10][512 + tid] - p.in[10][tid])); }
}
__device__ void p0_transpose(const float* src, int ld_src, int ncol0, h16* dst, int ld_dst, int nktiles, int item, LAS float* sm) {
    const int tid = threadIdx.x, kt = item % nktiles, nt = item / nktiles;
    { const int n = tid & 63, kk = tid >> 6;
#pragma unroll
      for (int ps = 0; ps < 8; ++ps) { const int k = kk + 8 * ps; sm[k * 65 + n] = src[(size_t)(kt * 64 + k) * ld_src + ncol0 + nt * 64 + n]; } }
    __syncthreads();
    { const int k = tid & 63, nn = tid >> 6;
#pragma unroll
      for (int ps = 0; ps < 8; ++ps) { const int n = nn + 8 * ps; dst[(size_t)(nt * 64 + n) * ld_dst + kt * 64 + k] = (h16)sm[k * 65 + n]; } }
    __syncthreads();
}
__device__ void p0_wf(const Params& p, LAS float* sm, int item) {
    const int tid = threadIdx.x, dt = item & 15, part = (item >> 4) & 1, g = item >> 5, d0 = dt * 64;
    LAS float* w = sm; LAS float* trig = sm + 64 * 129;
    for (int i = tid; i < 64 * 128; i += NTHREADS) { const int dl = i >> 7, n2 = i & 127; w[dl * 129 + n2] = p.in[8][(size_t)(d0 + dl) * 5120 + 2560 + g * 128 + n2]; }
    if (tid < 128) trig[tid] = part ? sinpif((float)tid / 64.0f) : cospif((float)tid / 64.0f);
    __syncthreads();
    const int dl = tid & 63, kg = tid >> 6; h16* WF = (h16*)(p.ws + OFF_WF);
#pragma unroll 1
    for (int kk = 0; kk < 16; ++kk) { const int k2 = kg * 16 + kk; float s = 0.f;
#pragma unroll 4
        for (int n2 = 0; n2 < 128; ++n2) s += w[dl * 129 + n2] * trig[(k2 * n2) & 127];
        WF[(size_t)(part * 512 + g * 128 + k2) * 1024 + d0 + dl] = (h16)(s * 0.08838834764831845f); }
    __syncthreads();
}
__device__ void p0_wsf(const Params& p, LAS float* sm, int item) {
    const int tid = threadIdx.x, dt = item & 15, hp = item >> 4, d0 = dt * 64;
    LAS float* wq = sm; LAS float* sk = sm + 8256;
    for (int i = tid; i < 64 * 128; i += NTHREADS) { const int dl = i >> 7, k = i & 127; wq[dl * 129 + k] = p.in[15][(size_t)(d0 + dl) * 2048 + hp * 128 + k]; }
    for (int i = tid; i < 128 * 128; i += NTHREADS) sk[i] = p.in[16][(size_t)hp * 16384 + i];
    __syncthreads();
    const int dl = tid & 63, ng = tid >> 6; h16* WS = (h16*)(p.ws + OFF_WS);
#pragma unroll 1
    for (int nn = 0; nn < 16; ++nn) { const int n = ng * 16 + nn; float s = 0.f;
#pragma unroll 4
        for (int k = 0; k < 128; ++k) s += wq[dl * 129 + k] * sk[n * 128 + k];
        WS[(size_t)(hp * 128 + n) * 1024 + d0 + dl] = (h16)s; }
    __syncthreads();
}
__device__ void p0_dftm(const Params& p, LAS float* sm, int item) {
    const int tid = threadIdx.x;
    for (int i = tid; i < 4096; i += NTHREADS) sm[i] = cospif((float)i / 2048.0f) * (1.0f / 64.0f);
    __syncthreads();
    h16* M = (h16*)(p.ws + OFF_DFTM);
#pragma unroll 1
    for (int e = tid; e < 16 * 1024; e += NTHREADS) { const int k1 = item * 16 + (e >> 10), K0 = (e & 1023) * 8, part = K0 >> 12, n1 = K0 & 4095;
        float v[8];
#pragma unroll
        for (int j = 0; j < 8; ++j) { const int m = (k1 * (n1 + j)) & 4095; v[j] = part ? -sm[(m - 1024) & 4095] : sm[m]; }
        u32x4 w; w.x = pk2(v[0], v[1]); w.y = pk2(v[2], v[3]); w.z = pk2(v[4], v[5]); w.w = pk2(v[6], v[7]);
        *(u32x4*)(M + (size_t)k1 * 8192 + K0) = w; }
    __syncthreads();
}
__device__ void phase0(const Params& p, LAS unsigned char* lds) {
    LAS float* sm = (LAS float*)lds;
    for (int it = blockIdx.x; it < P0_TOTAL; it += gridDim.x) {
        int i = it;
        if (i < N_MOD) { p0_mod(p, sm, i); continue; } i -= N_MOD;
        if (i < N_LB) { p0_lb(p); continue; } i -= N_LB;
        if (i < N_TRA) { p0_transpose(p.in[8], 5120, 0, (h16*)(p.ws + OFF_WA), 1024, 16, i, sm); continue; } i -= N_TRA;
        if (i < N_TRG) { p0_transpose(p.in[8], 5120, 3072, (h16*)(p.ws + OFF_WG), 1024, 16, i, sm); continue; } i -= N_TRG;
        if (i < N_TRHG) { p0_transpose(p.in[12], 1024, 0, (h16*)(p.ws + OFF_WHG), 512, 8, i, sm); continue; } i -= N_TRHG;
        if (i < N_TRFT) { p0_transpose(p.in[13], 1024, 0, (h16*)(p.ws + OFF_WFT), 512, 8, i, sm); continue; } i -= N_TRFT;
        if (i < N_TROUT) { p0_transpose(p.in[14], 1024, 0, (h16*)(p.ws + OFF_WOUT), 1024, 16, i, sm); continue; } i -= N_TROUT;
        if (i < N_WF) { p0_wf(p, sm, i); continue; } i -= N_WF;
        if (i < N_WSF) { p0_wsf(p, sm, i); continue; } i -= N_WSF;
        p0_dftm(p, sm, i);
    }
}

__device__ void modulate_rows(const float* src, h16* dst, int nrows, const float* gvec, const float* mod, int sh_off, int sc_off, int ctx_rows) {
    const int wave = threadIdx.x >> 6, lane = threadIdx.x & 63;
    for (int row = blockIdx.x * 8 + wave; row < nrows; row += gridDim.x * 8) {
        const int mr = ctx_rows ? 8 : (row >> 12);
        const float* x = src + (size_t)row * D;
        f32x4 v[4]; float ss = 0.f;
#pragma unroll
        for (int j = 0; j < 4; ++j) { v[j] = *(const f32x4*)(x + j * 256 + lane * 4); ss += v[j].x * v[j].x + v[j].y * v[j].y + v[j].z * v[j].z + v[j].w * v[j].w; }
        ss = wave_sum(ss);
        const float rstd = rsqrtf(ss * (1.0f / D) + EPS);
#pragma unroll
        for (int j = 0; j < 4; ++j) { const int c = j * 256 + lane * 4;
            const f32x4 gg = *(const f32x4*)(gvec + c), sc = *(const f32x4*)(mod + mr * 6144 + sc_off + c), sh = *(const f32x4*)(mod + mr * 6144 + sh_off + c);
            const f32x4 o = (v[j] * rstd) * gg * (sc + 1.0f) + sh;
            u32x2 w; w.x = pk2(o.x, o.y); w.y = pk2(o.z, o.w);
            *(u32x2*)(dst + (size_t)row * D + c) = w; }
    }
}

struct EpiA {
    static constexpr bool PERM = true, TRANS = true;
    unsigned char* ws;
    __device__ __forceinline__ void operator()(const f32x4 (&acc)[2][2][4][2], const pg8::Unit& u, int wr, int wc, int fr, int fq) const {
        const int ty = u.pn >> 1;
        h16* base = (h16*)(ws + (ty == 0 ? OFF_Q : ty == 1 ? OFF_LF : ty == 2 ? OFF_LBK : ty == 3 ? OFF_V : OFF_G));
        const float* lb = (const float*)(ws + OFF_LB) + (ty == 2 ? 512 : 0);
        const int row0 = u.pm * 256 + wr * 64 + fr, col0 = (u.pn & 1) * 256 + wc * 32 + 8 * fq;
#pragma unroll
        for (int bj = 0; bj < 2; ++bj) {
            float lbv[8];
            if (ty == 1 || ty == 2) {
#pragma unroll
                for (int j = 0; j < 8; ++j) lbv[j] = lb[col0 + bj * 128 + j];
            }
#pragma unroll
            for (int ai = 0; ai < 2; ++ai)
#pragma unroll
                for (int m = 0; m < 4; ++m) {
                    float v[8];
#pragma unroll
                    for (int j = 0; j < 4; ++j) { v[j] = acc[ai][bj][m][0][j]; v[4 + j] = acc[ai][bj][m][1][j]; }
                    if (ty == 0) {
#pragma unroll
                        for (int j = 0; j < 8; ++j) v[j] *= 0.08838834764831845f;
                    } else if (ty == 1 || ty == 2) {
#pragma unroll
                        for (int j = 0; j < 8; ++j) v[j] = __logf(lbv[j] + (1.0f - lbv[j]) * sigmoidf_(v[j]));
                    } else if (ty == 4) {
#pragma unroll
                        for (int j = 0; j < 8; ++j) v[j] = v[j] * sigmoidf_(v[j]);
                    }
                    u32x4 w; w.x = pk2(v[0], v[1]); w.y = pk2(v[2], v[3]); w.z = pk2(v[4], v[5]); w.w = pk2(v[6], v[7]);
                    *(u32x4*)(base + (size_t)(row0 + ai * 128 + m * 16) * 512 + col0 + bj * 128) = w;
                }
        }
    }
};
struct OrderA {
    pg8::TileOrder lat; int G, c;
    __device__ void init(int G_, int c_) { lat.init(128, 10, G_, c_); G = G_; c = c_; }
    __device__ bool next(int i, pg8::Unit& u) const {
        const long L = (long)i * G + c;
        if (L < 1280) return lat.map(L, u);
        const int l2 = (int)(L - 1280); if (l2 >= 48) return false;
        u.pm = 128 + l2 / 6; u.pn = 2 + l2 % 6; return true;
    }
};
struct EpiGate {
    static constexpr bool PERM = true, TRANS = true;
    unsigned char* ws;
    __device__ __forceinline__ void operator()(const f32x4 (&acc)[2][2][4][2], const pg8::Unit& u, int wr, int wc, int fr, int fq) const {
        h16* base = (h16*)(ws + (u.pn < 4 ? OFF_GH : OFF_GF));
        const int row0 = u.pm * 256 + wr * 64 + fr, col0 = (u.pn & 3) * 256 + wc * 32 + 8 * fq;
#pragma unroll
        for (int ai = 0; ai < 2; ++ai)
#pragma unroll
            for (int m = 0; m < 4; ++m)
#pragma unroll
                for (int bj = 0; bj < 2; ++bj) {
                    float v[8];
#pragma unroll
                    for (int j = 0; j < 4; ++j) { v[j] = sigmoidf_(acc[ai][bj][m][0][j]); v[4 + j] = sigmoidf_(acc[ai][bj][m][1][j]); }
                    u32x4 w; w.x = pk2(v[0], v[1]); w.y = pk2(v[2], v[3]); w.z = pk2(v[4], v[5]); w.w = pk2(v[6], v[7]);
                    *(u32x4*)(base + (size_t)(row0 + ai * 128 + m * 16) * 1024 + col0 + bj * 128) = w;
                }
    }
};
struct EpiFT {
    static constexpr bool PERM = false, TRANS = false;
    unsigned char* ws;
    __device__ __forceinline__ void operator()(const f32x4 (&acc)[2][2][4][2], const pg8::Unit& u, int wr, int wc, int fr, int fq) const {
        h16* F = (h16*)(ws + OFF_FTT);
        const int t0 = u.pm * 256 + wr * 64 + 4 * fq, c0 = u.pn * 256 + wc * 32 + fr;
#pragma unroll
        for (int ai = 0; ai < 2; ++ai)
#pragma unroll
            for (int m = 0; m < 4; ++m)
#pragma unroll
                for (int bj = 0; bj < 2; ++bj)
#pragma unroll
                    for (int n = 0; n < 2; ++n) {
                        const int t = t0 + ai * 128 + m * 16, c = c0 + bj * 128 + n * 16;
                        const int b = t >> 12, n1 = t & 4095, part = c >> 9, gk = c & 511;
                        const f32x4 a = acc[ai][bj][m][n];
                        u32x2 w; w.x = pk2(a.x, a.y); w.y = pk2(a.z, a.w);
                        *(u32x2*)(F + ((size_t)((b * 512 + gk) * 2 + part)) * 4096 + n1) = w;
                    }
    }
};
struct EpiDFT {
    static constexpr bool PERM = true, TRANS = true;
    unsigned char* ws;
    __device__ __forceinline__ void operator()(const f32x4 (&acc)[2][2][4][2], const pg8::Unit& u, int wr, int wc, int fr, int fq) const {
        h16* Y = (h16*)(ws + OFF_YFT);
        const int b = u.pn >> 1;
        const int row0 = b * 4096 + u.pm * 256 + wr * 64 + fr, col0 = (u.pn & 1) * 256 + wc * 32 + 8 * fq;
#pragma unroll
        for (int ai = 0; ai < 2; ++ai)
#pragma unroll
            for (int m = 0; m < 4; ++m)
#pragma unroll
                for (int bj = 0; bj < 2; ++bj) {
                    const f32x4 a0 = acc[ai][bj][m][0], a1 = acc[ai][bj][m][1];
                    u32x4 w; w.x = pk2(a0.x, a0.y); w.y = pk2(a0.z, a0.w); w.z = pk2(a1.x, a1.y); w.w = pk2(a1.z, a1.w);
                    *(u32x4*)(Y + (size_t)(row0 + ai * 128 + m * 16) * 512 + col0 + bj * 128) = w;
                }
    }
};
template <bool ACCUM> struct EpiMerge1 {
    static constexpr bool PERM = true, TRANS = true;
    unsigned char* ws;
    __device__ __forceinline__ void operator()(const f32x4 (&acc)[2][2][4][2], const pg8::Unit& u, int wr, int wc, int fr, int fq) const {
        h16* Y = (h16*)(ws + OFF_Y); const h16* GT = (const h16*)(ws + (ACCUM ? OFF_GF : OFF_GH));
        const int row0 = u.pm * 256 + wr * 64 + fr, col0 = u.pn * 256 + wc * 32 + 8 * fq;
#pragma unroll
        for (int ai = 0; ai < 2; ++ai)
#pragma unroll
            for (int m = 0; m < 4; ++m)
#pragma unroll
                for (int bj = 0; bj < 2; ++bj) {
                    const size_t off = (size_t)(row0 + ai * 128 + m * 16) * 1024 + col0 + bj * 128;
                    const h16x8 gt = *(const h16x8*)(GT + off);
                    float v[8];
#pragma unroll
                    for (int j = 0; j < 4; ++j) { v[j] = acc[ai][bj][m][0][j] * (float)gt[j]; v[4 + j] = acc[ai][bj][m][1][j] * (float)gt[4 + j]; }
                    if (ACCUM) { const h16x8 y0 = *(const h16x8*)(Y + off);
#pragma unroll
                        for (int j = 0; j < 8; ++j) v[j] += (float)y0[j]; }
                    u32x4 w; w.x = pk2(v[0], v[1]); w.y = pk2(v[2], v[3]); w.z = pk2(v[4], v[5]); w.w = pk2(v[6], v[7]);
                    *(u32x4*)(Y + off) = w;
                }
    }
};
struct EpiMerge2 {
    static constexpr bool PERM = false, TRANS = true;
    const float* x; float* H; const float* mod;
    __device__ __forceinline__ void operator()(const f32x4 (&acc)[2][2][4][2], const pg8::Unit& u, int wr, int wc, int fr, int fq) const {
        const int row0 = u.pm * 256 + wr * 64 + fr, col0 = u.pn * 256 + wc * 32 + 4 * fq;
        const int b = (u.pm * 256) >> 12;
        f32x4 g1[2][2];
#pragma unroll
        for (int bj = 0; bj < 2; ++bj)
#pragma unroll
            for (int n = 0; n < 2; ++n) g1[bj][n] = *(const f32x4*)(mod + b * 6144 + 2048 + col0 + bj * 128 + n * 16);
#pragma unroll
        for (int ai = 0; ai < 2; ++ai)
#pragma unroll
            for (int m = 0; m < 4; ++m) { const size_t ro = (size_t)(row0 + ai * 128 + m * 16) * 1024 + col0;
#pragma unroll
                for (int bj = 0; bj < 2; ++bj)
#pragma unroll
                    for (int n = 0; n < 2; ++n) { const f32x4 xv = *(const f32x4*)(x + ro + bj * 128 + n * 16);
                        *(f32x4*)(H + ro + bj * 128 + n * 16) = xv + g1[bj][n] * acc[ai][bj][m][n]; } }
    }
};
struct EpiF32 {
    static constexpr bool PERM = false, TRANS = true;
    float* C; int ldc;
    __device__ __forceinline__ void operator()(const f32x4 (&acc)[2][2][4][2], const pg8::Unit& u, int wr, int wc, int fr, int fq) const {
        const int row0 = u.pm * 256 + wr * 64 + fr, col0 = u.pn * 256 + wc * 32 + 4 * fq;
#pragma unroll
        for (int ai = 0; ai < 2; ++ai)
#pragma unroll
            for (int m = 0; m < 4; ++m) { float* rowp = C + (size_t)(row0 + ai * 128 + m * 16) * ldc + col0;
#pragma unroll
                for (int bj = 0; bj < 2; ++bj)
#pragma unroll
                    for (int n = 0; n < 2; ++n) *(f32x4*)(rowp + bj * 128 + n * 16) = acc[ai][bj][m][n]; }
    }
};

__device__ __forceinline__ int hgrn_row(int pos, int b, int dir) {
    if (pos < LC) { const int j = dir ? (LC - 1 - pos) : pos; return T + b * LC + j; }
    const int t = pos - LC; return b * SEQ + (dir ? (SEQ - 1 - t) : t);
}
__device__ void hgrn_item(const Params& p, LAS unsigned char* lds, int item) {
    const int tid = threadIdx.x, vq = item & 3, dir = (item >> 2) & 1, h = (item >> 3) & 3, b = item >> 5;
    const h16* Q = (const h16*)(p.ws + OFF_Q); const h16* LF = (const h16*)(p.ws + (dir ? OFF_LBK : OFF_LF)); const h16* V = (const h16*)(p.ws + OFF_V);
    h16* O = (h16*)(p.ws + (dir ? OFF_OB : OFF_OF));
    LAS float* fs = (LAS float*)lds; LAS float* ks = fs + 16 * 128; LAS float* qs = ks + 16 * 128; LAS float* vs = qs + 16 * 128; LAS float* po = vs + 16 * 32;
    const int v = tid & 31, kq = tid >> 5;
    float S[8];
#pragma unroll
    for (int j = 0; j < 8; ++j) S[j] = 0.f;
    const int e = tid * 4, tl_ld = e >> 7, k_ld = e & 127;
    const int tl_v = tid >> 5, vv = tid & 31;
    h16x4 lf4, q4; h16 v1;
    { const int row = hgrn_row(tl_ld, b, dir); lf4 = *(const h16x4*)(LF + (size_t)row * 512 + h * 128 + k_ld); q4 = (h16x4){0, 0, 0, 0};
      const int row2 = hgrn_row(tl_v, b, dir); v1 = V[(size_t)row2 * 512 + h * 128 + vq * 32 + vv]; }
    constexpr int NG = (LC + SEQ) / 16;
    for (int grp = 0; grp < NG; ++grp) {
        const bool latent = grp >= LC / 16;
#pragma unroll
        for (int j = 0; j < 4; ++j) { const float f = __expf((float)lf4[j]); fs[e + j] = f; ks[e + j] = 1.0f - f; qs[e + j] = (float)q4[j]; }
        vs[tid] = (float)v1;
        __syncthreads();
        if (grp + 1 < NG) { const int pos = (grp + 1) * 16; const bool lat2 = (grp + 1) >= LC / 16;
            const int row = hgrn_row(pos + tl_ld, b, dir); lf4 = *(const h16x4*)(LF + (size_t)row * 512 + h * 128 + k_ld);
            if (lat2) q4 = *(const h16x4*)(Q + (size_t)row * 512 + h * 128 + k_ld);
            const int row2 = hgrn_row(pos + tl_v, b, dir); v1 = V[(size_t)row2 * 512 + h * 128 + vq * 32 + vv]; }
#pragma unroll 4
        for (int tl = 0; tl < 16; ++tl) {
            const float vt = vs[tl * 32 + v];
            const f32x4 f0 = *(const LAS f32x4*)(fs + tl * 128 + kq * 8), f1 = *(const LAS f32x4*)(fs + tl * 128 + kq * 8 + 4);
            const f32x4 k0 = *(const LAS f32x4*)(ks + tl * 128 + kq * 8), k1 = *(const LAS f32x4*)(ks + tl * 128 + kq * 8 + 4);
            const f32x4 q0 = *(const LAS f32x4*)(qs + tl * 128 + kq * 8), q1 = *(const LAS f32x4*)(qs + tl * 128 + kq * 8 + 4);
            float a = 0.f;
#pragma unroll
            for (int j = 0; j < 4; ++j) { S[j] = f0[j] * S[j] + k0[j] * vt; a += S[j] * q0[j]; S[4 + j] = f1[j] * S[4 + j] + k1[j] * vt; a += S[4 + j] * q1[j]; }
            po[(tl * 16 + kq) * 32 + v] = a;
        }
        __syncthreads();
        if (latent) { float s = 0.f;
#pragma unroll
            for (int q = 0; q < 16; ++q) s += po[(tl_v * 16 + q) * 32 + vv];
            const int row = hgrn_row(grp * 16 + tl_v, b, dir);
            O[(size_t)row * 512 + h * 128 + vq * 32 + vv] = (h16)s; }
    }
    __syncthreads();
}

typedef short s16x8 __attribute__((ext_vector_type(8)));
typedef short s16x4 __attribute__((ext_vector_type(4)));
__device__ __forceinline__ unsigned cvt_pk_bf16(float lo, float hi) { unsigned r; asm volatile("v_cvt_pk_bf16_f32 %0, %1, %2" : "=v"(r) : "v"(lo), "v"(hi)); return r; }
constexpr int HG_QT = 0, HG_KT = 16384, HG_QD = 32768, HG_KDT = 49152, HG_VT = 65536, HG_AM = 81920, HG_DEC = 90112, HG_SEG = 90624;
__device__ __forceinline__ int rm_off(int r, int c16) { return r * 256 + ((c16 ^ (r & 15)) << 4); }
__device__ __forceinline__ int tm_off(int r, int c8) { return r * 128 + ((c8 ^ (r & 7)) << 4); }
__device__ __forceinline__ s16x8 lds_frag16(LAS unsigned char* base) { return *(LAS s16x8*)base; }
__device__ __forceinline__ s16x8 lds_frag8x2(LAS unsigned char* p0, LAS unsigned char* p1) {
    const s16x4 a = *(LAS s16x4*)p0, b = *(LAS s16x4*)p1; return (s16x8){a[0], a[1], a[2], a[3], b[0], b[1], b[2], b[3]}; }

__device__ void hgrn_mfma_item(const Params& p, LAS unsigned char* lds, int item) {
    const int tid = threadIdx.x, wave = __builtin_amdgcn_readfirstlane(tid >> 6), lane = tid & 63, fr = lane & 15, fq = lane >> 4;
    const int dir = item & 1, h = (item >> 1) & 3, b = item >> 3;
    const h16* Q = (const h16*)(p.ws + OFF_Q); const h16* LF = (const h16*)(p.ws + (dir ? OFF_LBK : OFF_LF)); const h16* V = (const h16*)(p.ws + OFF_V);
    h16* O = (h16*)(p.ws + (dir ? OFF_OB : OFF_OF));
    LAS float* DEC = (LAS float*)(lds + HG_DEC); LAS float* SEG = (LAS float*)(lds + HG_SEG);
    f32x4 S[8];
#pragma unroll
    for (int m = 0; m < 8; ++m) S[m] = (f32x4){0.f, 0.f, 0.f, 0.f};
    for (int i = tid; i < 8192 / 16; i += NTHREADS) ((LAS u32x4*)(lds + HG_AM))[i] = (u32x4){0u, 0u, 0u, 0u};
    const int kp = lane;
    const size_t chan = (size_t)h * 128 + 2 * kp;
    unsigned lfr[8], qr[8], vr[8];
#pragma unroll
    for (int r = 0; r < 8; ++r) { const size_t row = (size_t)hgrn_row(8 * wave + r, b, dir); lfr[r] = *(const unsigned*)(LF + row * 512 + chan); vr[r] = *(const unsigned*)(V + row * 512 + chan); qr[r] = 0u; }
    constexpr int NCH = (LC + SEQ) / 64;
    for (int ch = 0; ch < NCH; ++ch) {
        const bool latent = ch >= LC / 64;
        float c0[8], c1[8]; float run0 = 0.f, run1 = 0.f;
#pragma unroll
        for (int r = 0; r < 8; ++r) { const h16x2 l = __builtin_bit_cast(h16x2, lfr[r]); run0 += (float)l[0]; run1 += (float)l[1]; c0[r] = run0; c1[r] = run1; }
        *(LAS f32x2*)(SEG + wave * 128 + 2 * kp) = (f32x2){run0, run1};
        __syncthreads();
        float off0 = 0.f, off1 = 0.f, mid0 = 0.f, mid1 = 0.f, tot0 = 0.f, tot1 = 0.f;
#pragma unroll
        for (int w2 = 0; w2 < 8; ++w2) { const f32x2 tt = *(LAS f32x2*)(SEG + w2 * 128 + 2 * kp);
            if (w2 < wave) { off0 += tt[0]; off1 += tt[1]; } if (w2 < 4) { mid0 += tt[0]; mid1 += tt[1]; } tot0 += tt[0]; tot1 += tt[1]; }
        const float em0 = __expf(mid0), em1 = __expf(mid1), el0 = __expf(tot0 - mid0), el1 = __expf(tot1 - mid1);
        if (wave == 0) *(LAS f32x2*)(DEC + 2 * kp) = (f32x2){__expf(tot0), __expf(tot1)};
        unsigned kd0[4], kd1[4], vt0[4], vt1[4];
#pragma unroll
        for (int r = 0; r < 8; ++r) {
            const h16x2 l = __builtin_bit_cast(h16x2, lfr[r]), q = __builtin_bit_cast(h16x2, qr[r]), v = __builtin_bit_cast(h16x2, vr[r]);
            const float b0 = off0 + c0[r], b1 = off1 + c1[r];
            const float e10 = __expf(b0 - mid0), e11 = __expf(b1 - mid1), e20 = __expf(mid0 - b0), e21 = __expf(mid1 - b1);
            const float k0 = 1.0f - __expf((float)l[0]), k1 = 1.0f - __expf((float)l[1]);
            const float qt0 = (float)q[0] * e10, qt1 = (float)q[1] * e11, kt0 = k0 * e20, kt1 = k1 * e21;
            const int t = 8 * wave + r;
            *(LAS unsigned*)(lds + HG_QT + rm_off(t, kp >> 2) + (kp & 3) * 4) = cvt_pk_bf16(qt0, qt1);
            *(LAS unsigned*)(lds + HG_KT + rm_off(t, kp >> 2) + (kp & 3) * 4) = cvt_pk_bf16(kt0, kt1);
            *(LAS unsigned*)(lds + HG_QD + rm_off(t, kp >> 2) + (kp & 3) * 4) = cvt_pk_bf16(qt0 * em0, qt1 * em1);
            const float kdv0 = kt0 * el0, kdv1 = kt1 * el1;
            if (r & 1) { kd0[r >> 1] = cvt_pk_bf16(__builtin_bit_cast(float, kd0[r >> 1]), kdv0); kd1[r >> 1] = cvt_pk_bf16(__builtin_bit_cast(float, kd1[r >> 1]), kdv1);
                         vt0[r >> 1] = cvt_pk_bf16(__builtin_bit_cast(float, vt0[r >> 1]), (float)v[0]); vt1[r >> 1] = cvt_pk_bf16(__builtin_bit_cast(float, vt1[r >> 1]), (float)v[1]); }
            else { kd0[r >> 1] = __builtin_bit_cast(unsigned, kdv0); kd1[r >> 1] = __builtin_bit_cast(unsigned, kdv1);
                   vt0[r >> 1] = __builtin_bit_cast(unsigned, (float)v[0]); vt1[r >> 1] = __builtin_bit_cast(unsigned, (float)v[1]); }
        }
        *(LAS u32x4*)(lds + HG_KDT + tm_off(2 * kp, wave)) = (u32x4){kd0[0], kd0[1], kd0[2], kd0[3]};
        *(LAS u32x4*)(lds + HG_KDT + tm_off(2 * kp + 1, wave)) = (u32x4){kd1[0], kd1[1], kd1[2], kd1[3]};
        *(LAS u32x4*)(lds + HG_VT + tm_off(2 * kp, wave)) = (u32x4){vt0[0], vt0[1], vt0[2], vt0[3]};
        *(LAS u32x4*)(lds + HG_VT + tm_off(2 * kp + 1, wave)) = (u32x4){vt1[0], vt1[1], vt1[2], vt1[3]};
        __syncthreads();
        if (ch + 1 < NCH) { const bool lat2 = (ch + 1) >= LC / 64;
#pragma unroll
            for (int r = 0; r < 8; ++r) { const size_t row = (size_t)hgrn_row((ch + 1) * 64 + 8 * wave + r, b, dir);
                lfr[r] = *(const unsigned*)(LF + row * 512 + chan); vr[r] = *(const unsigned*)(V + row * 512 + chan); qr[r] = lat2 ? *(const unsigned*)(Q + row * 512 + chan) : 0u; } }
        if (latent) {
#pragma unroll
            for (int rep = 0; rep < 2; ++rep) {
                const int tile = wave + 8 * rep;
                if (tile < 10) {
                    const int ti = tile < 1 ? 0 : tile < 3 ? 1 : tile < 6 ? 2 : 3, si = tile - (ti * (ti + 1)) / 2;
                    f32x4 acc = (f32x4){0.f, 0.f, 0.f, 0.f};
#pragma unroll
                    for (int kk = 0; kk < 4; ++kk) {
                        const s16x8 af = lds_frag16(lds + HG_KT + rm_off(16 * si + fr, kk * 4 + fq)), bf = lds_frag16(lds + HG_QT + rm_off(16 * ti + fr, kk * 4 + fq));
                        acc = __builtin_amdgcn_mfma_f32_16x16x32_bf16(af, bf, acc, 0, 0, 0); }
                    const int t = 16 * ti + fr, s0 = 16 * si + 4 * fq;
                    if (ti == si) {
#pragma unroll
                        for (int j = 0; j < 4; ++j) acc[j] = (s0 + j <= t) ? acc[j] : 0.f; }
                    *(LAS u32x2*)(lds + HG_AM + tm_off(t, s0 >> 3) + (s0 & 7) * 2) = (u32x2){cvt_pk_bf16(acc[0], acc[1]), cvt_pk_bf16(acc[2], acc[3])};
                }
            }
        }
        __syncthreads();
        s16x8 vfrag[2];
#pragma unroll
        for (int ks = 0; ks < 2; ++ks) vfrag[ks] = lds_frag16(lds + HG_VT + tm_off(16 * wave + fr, ks * 4 + fq));
        if (latent) {
            s16x8 sfrag[4];
#pragma unroll
            for (int kk = 0; kk < 4; ++kk) { const unsigned w0 = cvt_pk_bf16(S[2 * kk][0], S[2 * kk][1]), w1 = cvt_pk_bf16(S[2 * kk][2], S[2 * kk][3]),
                                                          w2 = cvt_pk_bf16(S[2 * kk + 1][0], S[2 * kk + 1][1]), w3 = cvt_pk_bf16(S[2 * kk + 1][2], S[2 * kk + 1][3]);
                sfrag[kk] = __builtin_bit_cast(s16x8, (u32x4){w0, w1, w2, w3}); }
#pragma unroll
            for (int ti = 0; ti < 4; ++ti) {
                f32x4 acc = (f32x4){0.f, 0.f, 0.f, 0.f};
                const int t = 16 * ti + fr;
#pragma unroll
                for (int ks = 0; ks < 2; ++ks) if (ks <= (ti >> 1)) {
                    const s16x8 bf = lds_frag16(lds + HG_AM + tm_off(t, ks * 4 + fq));
                    acc = __builtin_amdgcn_mfma_f32_16x16x32_bf16(vfrag[ks], bf, acc, 0, 0, 0); }
#pragma unroll
                for (int kk = 0; kk < 4; ++kk) {
                    const s16x8 bf = lds_frag8x2(lds + HG_QD + rm_off(t, 4 * kk + (fq >> 1)) + (fq & 1) * 8, lds + HG_QD + rm_off(t, 4 * kk + 2 + (fq >> 1)) + (fq & 1) * 8);
                    acc = __builtin_amdgcn_mfma_f32_16x16x32_bf16(sfrag[kk], bf, acc, 0, 0, 0); }
                const size_t row = (size_t)hgrn_row(ch * 64 + t, b, dir);
                *(u32x2*)(O + row * 512 + h * 128 + 16 * wave + 4 * fq) = (u32x2){pk2(acc[0], acc[1]), pk2(acc[2], acc[3])};
            }
        }
#pragma unroll
        for (int m = 0; m < 8; ++m) {
            const f32x4 dc = *(LAS f32x4*)(DEC + 16 * m + 4 * fq);
            S[m] = S[m] * dc;
#pragma unroll
            for (int ks = 0; ks < 2; ++ks) { const s16x8 af = lds_frag16(lds + HG_KDT + tm_off(16 * m + fr, ks * 4 + fq));
                S[m] = __builtin_amdgcn_mfma_f32_16x16x32_bf16(af, vfrag[ks], S[m], 0, 0, 0); }
        }
    }
    __syncthreads();
}

__device__ void a1_prepass(const Params& p) {
    const int wave = threadIdx.x >> 6, lane = threadIdx.x & 63;
    const h16* OF = (const h16*)(p.ws + OFF_OF); const h16* OB = (const h16*)(p.ws + OFF_OB); h16* G = (h16*)(p.ws + OFF_G);
    const float* hgn = p.in[11];
    for (int t = blockIdx.x * 8 + wave; t < T; t += gridDim.x * 8) {
        const size_t off = (size_t)t * 512 + lane * 8;
        const h16x8 a = *(const h16x8*)(OF + off), bq = *(const h16x8*)(OB + off), g = *(const h16x8*)(G + off);
        float o[8]; float ss = 0.f;
#pragma unroll
        for (int j = 0; j < 8; ++j) { o[j] = (float)a[j] + (float)bq[j]; ss += o[j] * o[j]; }
        ss += __shfl_xor(ss, 1); ss += __shfl_xor(ss, 2); ss += __shfl_xor(ss, 4); ss += __shfl_xor(ss, 8);
        const float rstd = rsqrtf(ss * (1.0f / 128.0f) + EPS);
        float r[8];
#pragma unroll
        for (int j = 0; j < 8; ++j) r[j] = o[j] * rstd * hgn[lane * 8 + j] * (float)g[j];
        u32x4 w; w.x = pk2(r[0], r[1]); w.y = pk2(r[2], r[3]); w.z = pk2(r[4], r[5]); w.w = pk2(r[6], r[7]);
        *(u32x4*)(G + off) = w;
    }
}

__device__ void convert_tables(const Params& p) {
    const size_t n8 = (size_t)16384 * 1024 / 8;
    for (int tb = 0; tb < 2; ++tb) { const float* src = p.in[17 + tb]; h16* dst = (h16*)(p.ws + (tb ? OFF_TV : OFF_TU));
        for (size_t i = (size_t)blockIdx.x * NTHREADS + threadIdx.x; i < n8; i += (size_t)gridDim.x * NTHREADS) {
            const f32x4 a = *(const f32x4*)(src + i * 8), bq = *(const f32x4*)(src + i * 8 + 4);
            u32x4 w; w.x = pk2(a.x, a.y); w.y = pk2(a.z, a.w); w.z = pk2(bq.x, bq.y); w.w = pk2(bq.z, bq.w);
            const size_t e = i >> 7; const int d0 = (int)(i & 127) * 8;
            *(u32x4*)(dst + ((size_t)(d0 >> 6) * 16384 + e) * 64 + (d0 & 63)) = w; } }
}

__device__ __forceinline__ unsigned f2key(float x) { const unsigned b = __builtin_bit_cast(unsigned, x); return b ^ ((b >> 31) ? 0xFFFFFFFFu : 0x80000000u); }
__device__ __forceinline__ float key2f(unsigned u) { const unsigned b = (u & 0x80000000u) ? (u ^ 0x80000000u) : ~u; return __builtin_bit_cast(float, b); }
__device__ __forceinline__ unsigned umax3(unsigned a, unsigned b, unsigned c) { return max(max(a, b), c); }
__device__ __forceinline__ void top16_of_128(const float* sc, unsigned (&out)[16]) {
    unsigned s[128];
#pragma unroll
    for (int i = 0; i < 32; ++i) { const f32x4 t = *(const f32x4*)(sc + i * 4);
#pragma unroll
        for (int j = 0; j < 4; ++j) s[4 * i + j] = (f2key(t[j]) & ~127u) | (unsigned)(127 - (4 * i + j)); }
#pragma unroll 1
    for (int it = 0; it < 16; ++it) {
        unsigned m[43];
#pragma unroll
        for (int n = 0; n < 42; ++n) m[n] = umax3(s[3 * n], s[3 * n + 1], s[3 * n + 2]);
        m[42] = max(s[126], s[127]);
        unsigned m2[15];
#pragma unroll
        for (int n = 0; n < 14; ++n) m2[n] = umax3(m[3 * n], m[3 * n + 1], m[3 * n + 2]);
        m2[14] = m[42];
        unsigned m3[5];
#pragma unroll
        for (int n = 0; n < 5; ++n) m3[n] = umax3(m2[3 * n], m2[3 * n + 1], m2[3 * n + 2]);
        const unsigned best = max(umax3(m3[0], m3[1], m3[2]), max(m3[3], m3[4]));
#pragma unroll
        for (int n = 0; n < 128; ++n) s[n] = (s[n] == best) ? 0u : s[n];
#pragma unroll
        for (int i = 0; i < 16; ++i) out[i] = (i == it) ? best : out[i];
    }
}
__device__ void topk_phase(const Params& p, LAS unsigned char* lds) {
    const float* SC = (const float*)(p.ws + OFF_SC); int* EIDX = (int*)(p.ws + OFF_EIDX); float* GATE = (float*)(p.ws + OFF_GATE);
    LAS unsigned* st = (LAS unsigned*)lds;
    const int tid = threadIdx.x;
    for (int base = blockIdx.x * 256; base < T * 8; base += gridDim.x * 256) {
        {
            unsigned ks[16];
#pragma unroll
            for (int i = 0; i < 16; ++i) ks[i] = 0u;
            top16_of_128(SC + ((size_t)base * 2 + tid) * 128, ks);
#pragma unroll
            for (int i = 0; i < 16; ++i) st[i * NTHREADS + tid] = ks[i];
        }
        __syncthreads();
        if (tid < 256) {
            const int th = base + tid;
            float sv1[16];
#pragma unroll
            for (int j = 0; j < 16; ++j) sv1[j] = key2f(st[j * NTHREADS + 2 * tid + 1] & ~127u);
            unsigned cv[50];
            { int c = 0;
#pragma unroll
              for (int i = 0; i < 16; ++i) { const float a = key2f(st[i * NTHREADS + 2 * tid] & ~127u);
#pragma unroll
                  for (int j = 0; j < 16; ++j) if ((i + 1) * (j + 1) <= 16) { cv[c] = (f2key(a + sv1[j]) & ~255u) | (unsigned)(255 - (i * 16 + j)); ++c; } } }
            unsigned ok[16];
#pragma unroll
            for (int i = 0; i < 16; ++i) ok[i] = 0u;
#pragma unroll 1
            for (int it = 0; it < 16; ++it) {
                unsigned m[17];
#pragma unroll
                for (int n = 0; n < 16; ++n) m[n] = umax3(cv[3 * n], cv[3 * n + 1], cv[3 * n + 2]);
                m[16] = max(cv[48], cv[49]);
                unsigned m2[6];
#pragma unroll
                for (int n = 0; n < 5; ++n) m2[n] = umax3(m[3 * n], m[3 * n + 1], m[3 * n + 2]);
                m2[5] = max(m[15], m[16]);
                const unsigned best = max(umax3(m2[0], m2[1], m2[2]), umax3(m2[3], m2[4], m2[5]));
#pragma unroll
                for (int n = 0; n < 50; ++n) cv[n] = (cv[n] == best) ? 0u : cv[n];
#pragma unroll
                for (int i = 0; i < 16; ++i) ok[i] = (i == it) ? best : ok[i];
            }
            float ex[16]; int oe[16]; float den = 0.f;
            const float v0 = key2f(ok[0] & ~255u);
#pragma unroll
            for (int i = 0; i < 16; ++i) { const int ij = 255 - (int)(ok[i] & 255u), ci = ij >> 4, cj = ij & 15;
                const int e0 = 127 - (int)(st[ci * NTHREADS + 2 * tid] & 127u), e1 = 127 - (int)(st[cj * NTHREADS + 2 * tid + 1] & 127u);
                oe[i] = e0 * 128 + e1; ex[i] = __expf(key2f(ok[i] & ~255u) - v0); den += ex[i]; }
            const float inv = 1.0f / den;
#pragma unroll
            for (int i = 0; i < 4; ++i) {
                *(f32x4*)(GATE + (size_t)th * 16 + 4 * i) = (f32x4){ex[4 * i] * inv, ex[4 * i + 1] * inv, ex[4 * i + 2] * inv, ex[4 * i + 3] * inv};
                *(int4*)(EIDX + (size_t)th * 16 + 4 * i) = make_int4(oe[4 * i], oe[4 * i + 1], oe[4 * i + 2], oe[4 * i + 3]); }
        }
        __syncthreads();
    }
}

struct XcdInfo { int px, npop, rank, nloc; };
__device__ __forceinline__ float dot8(const h16x8 a, const h16x8 b, float s) {
    s = __builtin_amdgcn_fdot2((h16x2){a[0], a[1]}, (h16x2){b[0], b[1]}, s, false); s = __builtin_amdgcn_fdot2((h16x2){a[2], a[3]}, (h16x2){b[2], b[3]}, s, false);
    s = __builtin_amdgcn_fdot2((h16x2){a[4], a[5]}, (h16x2){b[4], b[5]}, s, false); s = __builtin_amdgcn_fdot2((h16x2){a[6], a[7]}, (h16x2){b[6], b[7]}, s, false); return s; }
__device__ void peer_u_phase(const Params& p, const XcdInfo xi) {
    const int wave = threadIdx.x >> 6, lane = threadIdx.x & 63, g = lane >> 3, c = lane & 7;
    const h16* U2 = (const h16*)(p.ws + OFF_U2); const h16* TU = (const h16*)(p.ws + OFF_TU);
    const int* EIDX = (const int*)(p.ws + OFF_EIDX); float* PACT = (float*)(p.ws + OFF_PACT);
    for (int s = xi.px; s < 16; s += xi.npop) {
        const h16* tus = TU + (size_t)s * 16384 * 64 + 8 * c;
        for (int t = xi.rank * 8 + wave; t < T; t += xi.nloc * 8) {
            int e[16];
#pragma unroll
            for (int q = 0; q < 4; ++q) { const int4 v = *(const int4*)(EIDX + (size_t)t * 128 + 16 * g + 4 * q); e[4 * q] = v.x; e[4 * q + 1] = v.y; e[4 * q + 2] = v.z; e[4 * q + 3] = v.w; }
            const h16x8 xv = *(const h16x8*)(U2 + (size_t)t * D + s * 64 + 8 * c);
            float pj[16];
#pragma unroll
            for (int j = 0; j < 16; ++j) { const h16x8 u = *(const h16x8*)(tus + (size_t)e[j] * 64); pj[j] = dot8(u, xv, 0.f); }
#define RED_STEP(NIN, MASK) _Pragma("unroll") for (int j = 0; j < (NIN) / 2; ++j) { const bool up = (lane & (MASK)) != 0; \
            const float keep = up ? pj[2 * j + 1] : pj[2 * j], send = up ? pj[2 * j] : pj[2 * j + 1]; pj[j] = keep + __shfl_xor(send, (MASK)); }
            RED_STEP(16, 1) RED_STEP(8, 2) RED_STEP(4, 4)
#undef RED_STEP
            float* po = PACT + ((size_t)s * T + t) * 128 + 16 * g + c;
            po[0] = pj[0]; po[8] = pj[1];
        }
    }
}
__device__ void peer_combine(const Params& p) {
    const float* PACT = (const float*)(p.ws + OFF_PACT); const float* GATE = (const float*)(p.ws + OFF_GATE); float* W = (float*)(p.ws + OFF_W);
    for (size_t i = (size_t)blockIdx.x * NTHREADS + threadIdx.x; i < (size_t)T * 128 / 4; i += (size_t)gridDim.x * NTHREADS) {
        f32x4 a = *(const f32x4*)(PACT + i * 4);
#pragma unroll
        for (int s = 1; s < 16; ++s) a += *(const f32x4*)(PACT + (size_t)s * T * 128 + i * 4);
        const f32x4 gt = *(const f32x4*)(GATE + i * 4);
        f32x4 w;
#pragma unroll
        for (int j = 0; j < 4; ++j) w[j] = gt[j] * (0.5f * a[j] * (1.0f + erff(a[j] * 0.70710678118654752f)));
        *(f32x4*)(W + i * 4) = w; }
}
__device__ void peer_v_phase(const Params& p, const XcdInfo xi) {
    const int wave = threadIdx.x >> 6, lane = threadIdx.x & 63, g = lane >> 3, c = lane & 7;
    const h16* TV = (const h16*)(p.ws + OFF_TV); const int* EIDX = (const int*)(p.ws + OFF_EIDX); const float* W = (const float*)(p.ws + OFF_W);
    const float* mod = (const float*)(p.ws + OFF_MOD); float* H = p.out; float* PSS = (float*)(p.ws + OFF_PSS);
    for (int s = xi.px; s < 16; s += xi.npop) {
        const h16* tvs = TV + (size_t)s * 16384 * 64 + 8 * c;
        for (int t = xi.rank * 8 + wave; t < T; t += xi.nloc * 8) {
            int e[16]; float w[16];
#pragma unroll
            for (int q = 0; q < 4; ++q) { const int4 v = *(const int4*)(EIDX + (size_t)t * 128 + 16 * g + 4 * q); e[4 * q] = v.x; e[4 * q + 1] = v.y; e[4 * q + 2] = v.z; e[4 * q + 3] = v.w;
                const f32x4 wv = *(const f32x4*)(W + (size_t)t * 128 + 16 * g + 4 * q); w[4 * q] = wv.x; w[4 * q + 1] = wv.y; w[4 * q + 2] = wv.z; w[4 * q + 3] = wv.w; }
            float acc[8];
#pragma unroll
            for (int i = 0; i < 8; ++i) acc[i] = 0.f;
#pragma unroll
            for (int j = 0; j < 16; ++j) { const h16x8 v = *(const h16x8*)(tvs + (size_t)e[j] * 64);
#pragma unroll
                for (int i = 0; i < 8; ++i) acc[i] += w[j] * (float)v[i]; }
#define RED_STEP(NIN, MASK) _Pragma("unroll") for (int j = 0; j < (NIN) / 2; ++j) { const bool up = (lane & (MASK)) != 0; \
            const float keep = up ? acc[2 * j + 1] : acc[2 * j], send = up ? acc[2 * j] : acc[2 * j + 1]; acc[j] = keep + __shfl_xor(send, (MASK)); }
            RED_STEP(8, 8) RED_STEP(4, 16) RED_STEP(2, 32)
#undef RED_STEP
            const int col = s * 64 + 8 * c + g;
            const float h2 = H[(size_t)t * D + col] + mod[(t >> 12) * 6144 + 5120 + col] * acc[0];
            H[(size_t)t * D + col] = h2;
            const float ss = wave_sum(h2 * h2);
            if (lane == 0) PSS[(size_t)s * T + t] = ss;
        }
    }
}
__device__ void peer_final(const Params& p) {
    const int wave = threadIdx.x >> 6, lane = threadIdx.x & 63;
    const float* PSS = (const float*)(p.ws + OFF_PSS); float* H = p.out; const float* fg = p.in[19];
    for (int t = blockIdx.x * 8 + wave; t < T; t += gridDim.x * 8) {
        float ss = (lane < 16) ? PSS[(size_t)lane * T + t] : 0.f;
        ss = wave_sum(ss);
        const float rstd = rsqrtf(ss * (1.0f / D) + EPS);
        float* hr = H + (size_t)t * D;
#pragma unroll
        for (int j = 0; j < 4; ++j) { const int cc = j * 256 + lane * 4; const f32x4 hv = *(const f32x4*)(hr + cc), fv = *(const f32x4*)(fg + cc);
            *(f32x4*)(hr + cc) = hv * rstd * fv; }
    }
}
constexpr int N_PHASES = 14;
#ifndef MK_CGSYNC
#define MK_CGSYNC 0
#endif
__global__ void __launch_bounds__(NTHREADS, 2) mega(Params p) {
    extern __shared__ __attribute__((aligned(16))) unsigned char smem[];
    LAS unsigned char* lds = (LAS unsigned char*)smem;
    const int G = gridDim.x, c = blockIdx.x;
    unsigned char* ws = p.ws;
    unsigned* ctl = (unsigned*)(ws + OFF_CTL);
    volatile LAS unsigned* misc = (volatile LAS unsigned*)(lds + LDS_BYTES - 64);
    if (threadIdx.x < 16) misc[threadIdx.x] = 0u;
    __syncthreads();
    const bool fused = (p.ph_hi - p.ph_lo) > 1;
    XcdBarrier bar; bar.bar = ctl; bar.x = 0; bar.st = misc;
    if (fused) {
        bar = xcd_barrier_post(ctl, misc);
        if (threadIdx.x == 0) misc[2] = xb_add(&ctl[CTL_RANK + 64 * bar.x], 1u);
    }
#define IN(k) (p.ph_lo <= (k) && (k) < p.ph_hi)
#if MK_CGSYNC
#define SEAM(k) do { if (IN(k) && IN((k) + 1)) { cg::grid_group grid = cg::this_grid(); grid.sync(); } } while (0)
#else
#define SEAM(k) do { if (IN(k) && IN((k) + 1)) xcd_barrier(bar); } while (0)
#endif
    if (IN(0)) phase0(p, lds);
    SEAM(0);
    if (IN(1)) {
        const float* mod = (const float*)(ws + OFF_MOD);
        modulate_rows(p.in[0], (h16*)(ws + OFF_UALL), T, p.in[6], mod, 0, 1024, 0);
        modulate_rows(p.in[2], (h16*)(ws + OFF_UALL) + (size_t)T * D, TC, p.in[6], mod, 0, 1024, 1);
    }
    SEAM(1);
    if (IN(2)) {
        { pg8::Gemm g{ws + OFF_UALL, ws + OFF_WA, 1024, 1024, 1024}; OrderA S; S.init(G, c); EpiA E{ws}; pg8::gemm_phase(lds, g, S, E); }
        { pg8::Gemm g{ws + OFF_UALL, ws + OFF_WF, 1024, 1024, 1024}; pg8::TileOrder S; S.init(128, 4, G, c); EpiFT E{ws}; pg8::gemm_phase(lds, g, S, E); }
    }
    SEAM(2);
#ifdef HGRN_NAIVE
    if (IN(3)) { for (int it = blockIdx.x; it < 256; it += gridDim.x) hgrn_item(p, lds, it); }
#else
    if (IN(3)) { for (int it = blockIdx.x; it < 64; it += gridDim.x) hgrn_mfma_item(p, lds, it); }
#endif
    SEAM(3);
    if (IN(4)) {
        { pg8::Gemm g{ws + OFF_DFTM, ws + OFF_FTT, 8192, 8192, 8192}; pg8::TileOrder S; S.init(16, 16, G, c); EpiDFT E{ws}; pg8::gemm_phase(lds, g, S, E); }
        { pg8::Gemm g{ws + OFF_UALL, ws + OFF_WG, 1024, 1024, 1024}; pg8::TileOrder S; S.init(128, 8, G, c); EpiGate E{ws}; pg8::gemm_phase(lds, g, S, E); }
        a1_prepass(p);
    }
    SEAM(4);
    if (IN(5)) {
        { pg8::Gemm g{ws + OFF_G, ws + OFF_WHG, 512, 512, 512}; pg8::TileOrder S; S.init(128, 4, G, c); EpiMerge1<false> E{ws}; pg8::gemm_phase(lds, g, S, E); }
        { pg8::Gemm g{ws + OFF_YFT, ws + OFF_WFT, 512, 512, 512}; pg8::TileOrder S; S.init(128, 4, G, c); EpiMerge1<true> E{ws}; pg8::gemm_phase(lds, g, S, E); }
    }
    SEAM(5);
    if (IN(6)) { pg8::Gemm g{ws + OFF_Y, ws + OFF_WOUT, 1024, 1024, 1024}; pg8::TileOrder S; S.init(128, 4, G, c);
                 EpiMerge2 E{p.in[0], p.out, (const float*)(ws + OFF_MOD)}; pg8::gemm_phase(lds, g, S, E); }
    SEAM(6);
    if (IN(7)) { modulate_rows(p.out, (h16*)(ws + OFF_U2), T, p.in[7], (const float*)(ws + OFF_MOD), 3072, 4096, 0); convert_tables(p); }
    SEAM(7);
    if (IN(8)) { pg8::Gemm g{ws + OFF_U2, ws + OFF_WS, 1024, 1024, 1024}; pg8::TileOrder S; S.init(128, 8, G, c);
                 EpiF32 E{(float*)(ws + OFF_SC), 2048}; pg8::gemm_phase(lds, g, S, E); }
    SEAM(8);
    if (IN(9)) topk_phase(p, lds);
    SEAM(9);
    XcdInfo xi;
    if (fused) {
        unsigned cnt[8]; int npop = 0, px = 0;
#pragma unroll
        for (int j = 0; j < 8; ++j) { cnt[j] = xb_ld(&ctl[CTL_RANK + 64 * j]); if (j < (int)(bar.x & 7u)) px += (cnt[j] > 0u); npop += (cnt[j] > 0u); }
        xi.px = px; xi.npop = npop > 0 ? npop : 1; xi.rank = (int)misc[2]; xi.nloc = (int)cnt[bar.x & 7u]; if (xi.nloc < 1) xi.nloc = 1;
    } else { xi.px = c & 7; xi.npop = 8; xi.rank = c >> 3; xi.nloc = G >> 3; }
    if (IN(10)) peer_u_phase(p, xi);
    SEAM(10);
    if (IN(11)) peer_combine(p);
    SEAM(11);
    if (IN(12)) peer_v_phase(p, xi);
    SEAM(12);
    if (IN(13)) peer_final(p);
#undef IN
#undef SEAM
}

#ifndef MK_SINGLE
#define MK_SINGLE 1
#endif
extern "C" void kernel_launch(void* const* d_in, const int* in_sizes, int n_in, void* d_out, int out_size, void* d_ws, size_t ws_size, hipStream_t stream) {
    static int grid = 0;
    if (grid == 0) {
        if (n_in != 20 || out_size != T * D || ws_size < WS_NEED) { fprintf(stderr, "kernel_launch: unexpected shapes (n_in %d out %d ws %zu)\n", n_in, out_size, ws_size); grid = -1; return; }
        int dev = 0, cus = 0, per_cu = 0;
        hipGetDevice(&dev); hipDeviceGetAttribute(&cus, hipDeviceAttributeMultiprocessorCount, dev);
        if (hipFuncSetAttribute((const void*)mega, hipFuncAttributeMaxDynamicSharedMemorySize, LDS_BYTES) != hipSuccess) { fprintf(stderr, "kernel_launch: hipFuncSetAttribute failed\n"); grid = -1; return; }
        hipOccupancyMaxActiveBlocksPerMultiprocessor(&per_cu, (const void*)mega, NTHREADS, LDS_BYTES);
        if (per_cu < 1) { fprintf(stderr, "kernel_launch: occupancy query says %d blocks per CU\n", per_cu); grid = -1; return; }
        grid = cus;
    }
    if (grid < 0) return;
    if (hipMemsetAsync((char*)d_ws + OFF_CTL, 0, CTL_ZERO_BYTES, stream) != hipSuccess) { fprintf(stderr, "kernel_launch: memset failed\n"); return; }
    Params p{};
    for (int i = 0; i < 20; ++i) p.in[i] = (const float*)d_in[i];
    p.out = (float*)d_out; p.ws = (unsigned char*)d_ws;
#if MK_SINGLE
    p.ph_lo = 0; p.ph_hi = N_PHASES;
    void* args[] = {&p};
    hipError_t e = hipLaunchCooperativeKernel((const void*)mega, dim3(grid), dim3(NTHREADS), args, LDS_BYTES, stream);
    if (e != hipSuccess) fprintf(stderr, "cooperative launch failed: %s (grid %d)\n", hipGetErrorString(e), grid);
#else
    for (int ph = 0; ph < N_PHASES; ++ph) { p.ph_lo = ph; p.ph_hi = ph + 1; hipLaunchKernelGGL(mega, dim3(grid), dim3(NTHREADS), LDS_BYTES, stream, p); }
#endif
}
```

```cpp
#include <hip/hip_runtime.h>
#include <hip/hip_cooperative_groups.h>
#include <cstdio>
#include <cstdint>
namespace cg = cooperative_groups;
#define LAS __attribute__((address_space(3)))
namespace pg8 {
#define PG8_LAS __attribute__((address_space(3)))
typedef _Float16 f16x8 __attribute__((ext_vector_type(8)));
typedef float f32x4 __attribute__((ext_vector_type(4)));
typedef unsigned u32x4 __attribute__((ext_vector_type(4)));
typedef unsigned u32x2 __attribute__((ext_vector_type(2)));
constexpr int BM = 256, BK = 64, HALF = 128, HTB = HALF * BK * 2, STAGE_BYTES = 8 * HTB, NXCD = 8, WGM = 8;

__host__ __device__ __forceinline__ int lds_byte(int r, int c) { const int st = (r >> 4) * 2 + (c >> 5), rr = r & 15, cc = c & 31, ob = rr * 64 + cc * 2; return st * 1024 + (ob ^ (((ob >> 9) & 1) << 5)); }
__host__ __device__ __forceinline__ void stage_rc(int b, int& R, int& C) { const int st = b / 1024, sb = b % 1024, swz = sb ^ (((sb >> 9) & 1) << 5); R = (st >> 1) * 16 + swz / 64; C = (st & 1) * 32 + (swz % 64) / 2; }
__host__ __device__ __forceinline__ int perm32(int rho) { const int n = rho >> 4, i = rho & 15; return 8 * (i >> 2) + 4 * n + (i & 3); }

struct Unit { int pm, pn; };
struct Gemm { const void* A; const void* Bt; int lda, ldb, K; };

struct TileOrder {
    int nM, nN, nwg, G, c, rep;
    __device__ void init(int nM_, int nN_, int G_, int c_, int rep_ = 1) { nM = nM_; nN = nN_; nwg = nM * nN; G = G_; c = c_; rep = rep_; }
    __device__ bool map(long L, Unit& u) const {
        if (L >= nwg) return false;
        int wgid = (int)L; { const int q = nwg / NXCD, r = nwg % NXCD, xcd = wgid % NXCD, off = wgid / NXCD; wgid = (xcd < r ? xcd * (q + 1) : r * (q + 1) + (xcd - r) * q) + off; }
        const int nig = WGM * nN, gid = wgid / nig, fm = gid * WGM, gsz = (nM - fm) < WGM ? (nM - fm) : WGM;
        u.pm = fm + ((wgid % nig) % gsz); u.pn = (wgid % nig) / gsz; return true;
    }
    __device__ bool next(int i, Unit& u) const { const long L = (long)i * G + c; if (L >= (long)nwg * rep) return false; return map(L % nwg, u); }
};

template <class Epi, class Sched>
__device__ __forceinline__ void gemm_phase(PG8_LAS unsigned char* lds, const Gemm g, const Sched& S, const Epi& E) {
    const int tid = threadIdx.x, wid = __builtin_amdgcn_readfirstlane(tid >> 6), lane = tid & 63, wr = wid >> 2, wc = wid & 3, fr = lane & 15, fq = lane >> 4;
    const int K = g.K, nt = K / BK;
    unsigned voffA[2], voffB[2];
#pragma unroll
    for (int i = 0; i < 2; ++i) { int R, C; stage_rc(tid * 16 + i * 8192, R, C); const int Rb = Epi::PERM ? ((R & ~31) + perm32(R & 31)) : R;
        voffA[i] = (unsigned)(R * g.lda + C) * 2u; voffB[i] = (unsigned)(Rb * g.ldb + C) * 2u; }
    const size_t kstep = (size_t)(BK * 2);
    const size_t hstepA = (size_t)HALF * g.lda * 2, hstepB = (size_t)HALF * g.ldb * 2;
    const size_t tstepA = 2 * hstepA, tstepB = 2 * hstepB;
    const unsigned ldsw = (unsigned)wid * 1024u;
    const int aoff = lds_byte(wr * 64 + fr, fq * 8), boff = lds_byte(wc * 32 + fr, fq * 8);
#define PG8_SA(b, h) (((b) * 2 + (h)) * HTB)
#define PG8_SB(b, h) ((4 + (b) * 2 + (h)) * HTB)
#define PG8_STAGE(bufoff, gbase, voff) do { _Pragma("unroll") for (int _i = 0; _i < 2; ++_i) \
        __builtin_amdgcn_global_load_lds((const unsigned*)((const char*)(gbase) + (voff)[_i]), (PG8_LAS unsigned*)(lds + (bufoff) + ldsw + _i * 8192), 16, 0, 0); } while (0)
#define PG8_LDA(dst, b, h) do { _Pragma("unroll") for (int m = 0; m < 4; ++m) _Pragma("unroll") for (int k = 0; k < 2; ++k) dst[m][k] = *(const PG8_LAS f16x8*)(lds + PG8_SA(b, h) + aoff + m * 2048 + k * 1024); } while (0)
#define PG8_LDB(dst, b, h) do { _Pragma("unroll") for (int n = 0; n < 2; ++n) _Pragma("unroll") for (int k = 0; k < 2; ++k) dst[n][k] = *(const PG8_LAS f16x8*)(lds + PG8_SB(b, h) + boff + n * 2048 + k * 1024); } while (0)
#define PG8_MMA(ai, bj, At, Bt) do { __builtin_amdgcn_s_setprio(1); _Pragma("unroll") for (int m = 0; m < 4; ++m) _Pragma("unroll") for (int n = 0; n < 2; ++n) _Pragma("unroll") for (int k = 0; k < 2; ++k) \
        acc[ai][bj][m][n] = Epi::TRANS ? __builtin_amdgcn_mfma_f32_16x16x32_f16(Bt[n][k], At[m][k], acc[ai][bj][m][n], 0, 0, 0) \
                                       : __builtin_amdgcn_mfma_f32_16x16x32_f16(At[m][k], Bt[n][k], acc[ai][bj][m][n], 0, 0, 0); __builtin_amdgcn_s_setprio(0); } while (0)
#define PG8_WAIT_V(n) asm volatile("s_waitcnt vmcnt(" #n ")" ::: "memory")
#define PG8_WAIT_L(n) asm volatile("s_waitcnt lgkmcnt(" #n ")" ::: "memory")
#define PG8_BAR __builtin_amdgcn_s_barrier()
#define PG8_SCHED __builtin_amdgcn_sched_barrier(0)
    Unit cur, nxt; int ui = 0;
    if (!S.next(0, cur)) return;
    f32x4 acc[2][2][4][2];
#pragma unroll
    for (int a = 0; a < 2; ++a)
#pragma unroll
        for (int b = 0; b < 2; ++b)
#pragma unroll
            for (int m = 0; m < 4; ++m)
#pragma unroll
                for (int n = 0; n < 2; ++n) acc[a][b][m][n] = (f32x4){0.f, 0.f, 0.f, 0.f};
    f16x8 At[4][2], B0[2][2], B1[2][2];
    const char* cA = (const char*)g.A + (size_t)cur.pm * tstepA; const char* cB = (const char*)g.Bt + (size_t)cur.pn * tstepB;
    PG8_STAGE(PG8_SB(0, 0), cB, voffB); PG8_STAGE(PG8_SA(0, 0), cA, voffA); PG8_STAGE(PG8_SB(0, 1), cB + hstepB, voffB); PG8_STAGE(PG8_SA(0, 1), cA + hstepA, voffA);
    if (wr == 1) PG8_BAR;
    PG8_WAIT_V(4); PG8_BAR;
    PG8_STAGE(PG8_SB(1, 0), cB + kstep, voffB); PG8_STAGE(PG8_SA(1, 0), cA + kstep, voffA); PG8_STAGE(PG8_SB(1, 1), cB + hstepB + kstep, voffB);
    PG8_WAIT_V(6); PG8_BAR;
    for (;;) {
        const bool has_next = S.next(ui + 1, nxt);
        const char* nA = has_next ? (const char*)g.A + (size_t)nxt.pm * tstepA : cA; const char* nB = has_next ? (const char*)g.Bt + (size_t)nxt.pn * tstepB : cB;
        for (int t = 0; t < nt; t += 2) {
            const bool last = (t == nt - 2);
            const char* a1 = cA + (size_t)(t + 1) * kstep;
            const char* a2 = last ? nA : cA + (size_t)(t + 2) * kstep; const char* b2 = last ? nB : cB + (size_t)(t + 2) * kstep;
            const char* a3 = a2 + kstep; const char* b3 = b2 + kstep;
            PG8_LDB(B0, 0, 0); PG8_SCHED; PG8_LDA(At, 0, 0); PG8_STAGE(PG8_SA(1, 1), a1 + hstepA, voffA);
            PG8_WAIT_L(8); PG8_BAR; PG8_WAIT_L(0); PG8_MMA(0, 0, At, B0); PG8_BAR; PG8_SCHED;
            PG8_LDB(B1, 0, 1); PG8_STAGE(PG8_SB(0, 0), b2, voffB);
            PG8_BAR; PG8_WAIT_L(0); PG8_MMA(0, 1, At, B1); PG8_BAR;
            PG8_LDA(At, 0, 1); PG8_STAGE(PG8_SA(0, 0), a2, voffA);
            PG8_BAR; PG8_WAIT_L(0); PG8_MMA(1, 0, At, B0); PG8_BAR; PG8_SCHED;
            PG8_STAGE(PG8_SB(0, 1), b2 + hstepB, voffB);
            PG8_WAIT_V(6); PG8_BAR; PG8_MMA(1, 1, At, B1); PG8_BAR;
            PG8_LDB(B0, 1, 0); PG8_SCHED; PG8_LDA(At, 1, 0); PG8_STAGE(PG8_SA(0, 1), a2 + hstepA, voffA);
            PG8_WAIT_L(8); PG8_BAR; PG8_WAIT_L(0); PG8_MMA(0, 0, At, B0); PG8_BAR; PG8_SCHED;
            PG8_LDB(B1, 1, 1); PG8_STAGE(PG8_SB(1, 0), b3, voffB);
            PG8_BAR; PG8_WAIT_L(0); PG8_MMA(0, 1, At, B1); PG8_BAR;
            PG8_LDA(At, 1, 1); PG8_STAGE(PG8_SA(1, 0), a3, voffA);
            PG8_BAR; PG8_WAIT_L(0); PG8_MMA(1, 0, At, B0); PG8_BAR; PG8_SCHED;
            PG8_STAGE(PG8_SB(1, 1), b3 + hstepB, voffB);
            PG8_WAIT_V(6); PG8_BAR; PG8_MMA(1, 1, At, B1); PG8_BAR;
        }
        E(acc, cur, wr, wc, fr, fq);
        if (!has_next) break;
#pragma unroll
        for (int a = 0; a < 2; ++a)
#pragma unroll
            for (int b = 0; b < 2; ++b)
#pragma unroll
                for (int m = 0; m < 4; ++m)
#pragma unroll
                    for (int n = 0; n < 2; ++n) acc[a][b][m][n] = (f32x4){0.f, 0.f, 0.f, 0.f};
        cur = nxt; cA = nA; cB = nB; ++ui;
    }
    PG8_WAIT_V(0);
    if (wr == 0) PG8_BAR;
    PG8_BAR;
#undef PG8_SA
#undef PG8_SB
#undef PG8_STAGE
#undef PG8_LDA
#undef PG8_LDB
#undef PG8_MMA
#undef PG8_WAIT_V
#undef PG8_WAIT_L
#undef PG8_BAR
#undef PG8_SCHED
}
}
#define XB_TMO      128
#define XB_XCNT(j)  (256  + 64 * (j))
#define XB_XSUB(j)  (1280 + 64 * (j))
#define XB_XGEN(j)  (2304 + 64 * (j))
#define XB_TOP      3328
#define XB_TOPGEN   3392
#define XCD_BAR_WORDS 3456
#define XB_SPIN_CAP (1u << 20)


__device__ __forceinline__ unsigned xb_ld(unsigned* p)              { return __hip_atomic_load(p, __ATOMIC_RELAXED, __HIP_MEMORY_SCOPE_AGENT); }
__device__ __forceinline__ unsigned xb_add(unsigned* p, unsigned v) { return __hip_atomic_fetch_add(p, v, __ATOMIC_RELAXED, __HIP_MEMORY_SCOPE_AGENT); }
__device__ __forceinline__ unsigned xb_xcc_id() { return (unsigned)__builtin_amdgcn_s_getreg((3 << 11) | 20) & 0xFu; }
#define XB_SPIN(cond, bar) do { unsigned _sp = 0; while (cond) { __builtin_amdgcn_s_sleep(1); \
    if ((++_sp & 255u) == 0u) { if (xb_ld(&(bar)[XB_TMO])) break; if (_sp > XB_SPIN_CAP) { atomicAdd(&(bar)[XB_TMO], 1u); break; } } } } while (0)

struct XcdBarrier {
    unsigned* bar; unsigned x;
    volatile LAS unsigned* st;
};

__device__ __forceinline__ XcdBarrier xcd_barrier_post(unsigned* bar, volatile LAS unsigned* st) {
    XcdBarrier b; b.bar = bar; b.x = xb_xcc_id(); b.st = st;
    if (threadIdx.x == 0) (void)xb_add(&bar[XB_XCNT(b.x)], 1u);
    return b;
}
__device__ __forceinline__ void xcd_barrier_complete(unsigned* bar, unsigned x, unsigned& nloc, unsigned& nx) {
    const unsigned G = gridDim.x * gridDim.y * gridDim.z;
    unsigned sum, cnt, mine, sp = 0u;
    for (;;) {
        sum = 0u; cnt = 0u; mine = 0u;
#pragma unroll
        for (unsigned j = 0; j < 16; ++j) { const unsigned c = xb_ld(&bar[XB_XCNT(j)]); sum += c; cnt += (c > 0u) ? 1u : 0u; mine = (j == x) ? c : mine; }
        if (sum == G) break;
        __builtin_amdgcn_s_sleep(1);
        if ((++sp & 255u) == 0u) { if (xb_ld(&bar[XB_TMO])) break; if (sp > XB_SPIN_CAP) { atomicAdd(&bar[XB_TMO], 1u); break; } }
    }
    nloc = mine > 0u ? mine : 1u; nx = cnt > 0u ? cnt : 1u;
}

__device__ __forceinline__ void xcd_barrier(const XcdBarrier& b) {
    asm volatile("s_waitcnt vmcnt(0)" ::: "memory");
    __syncthreads();
    if (threadIdx.x == 0) {
        unsigned* bar = b.bar;
        __builtin_amdgcn_s_waitcnt(0);
        unsigned nloc = b.st[0], nx = b.st[1];
        if (nloc == 0u) { xcd_barrier_complete(bar, b.x, nloc, nx); b.st[0] = nloc; b.st[1] = nx; }
        const unsigned old = xb_add(&bar[XB_XSUB(b.x)], 1u);
        const unsigned gen = old / nloc;
        if (old + 1u == (gen + 1u) * nloc) {
            __builtin_amdgcn_fence(__ATOMIC_RELEASE, "agent");
            asm volatile("s_waitcnt vmcnt(0)" ::: "memory");
            const unsigned og = xb_add(&bar[XB_TOP], 1u);
            const unsigned tg = og / nx;
            if (og + 1u == (tg + 1u) * nx) xb_add(&bar[XB_TOPGEN], 1u);
            else XB_SPIN(xb_ld(&bar[XB_TOPGEN]) == tg, bar);
            __builtin_amdgcn_fence(__ATOMIC_ACQUIRE, "agent");
            xb_add(&bar[XB_XGEN(b.x)], 1u);
            asm volatile("s_waitcnt vmcnt(0)" ::: "memory");
        } else {
            XB_SPIN(xb_ld(&bar[XB_XGEN(b.x)]) == gen, bar);
            __builtin_amdgcn_fence(__ATOMIC_ACQUIRE, "agent");
            asm volatile("s_waitcnt vmcnt(0)" ::: "memory");
        }
    }
    __syncthreads();
}

typedef _Float16 h16;
typedef h16 h16x2 __attribute__((ext_vector_type(2)));
typedef h16 h16x4 __attribute__((ext_vector_type(4)));
typedef h16 h16x8 __attribute__((ext_vector_type(8)));
typedef float f32x4 __attribute__((ext_vector_type(4)));
typedef float f32x2 __attribute__((ext_vector_type(2)));
typedef unsigned u32x4 __attribute__((ext_vector_type(4)));
typedef unsigned u32x2 __attribute__((ext_vector_type(2)));

constexpr int D = 1024, NB = 8, SEQ = 4096, T = NB * SEQ, LC = 256, TC = NB * LC, TALL = T + TC;
constexpr int NTHREADS = 512;
constexpr int LDS_BYTES = 136 * 1024;
constexpr float EPS = 1e-6f;
constexpr size_t MiB = (size_t)1 << 20;
constexpr size_t OFF_CTL = 0;
constexpr size_t OFF_MOD = 64 * 1024;
constexpr size_t OFF_LB = 320 * 1024;
constexpr size_t OFF_WA = 1 * MiB;
constexpr size_t OFF_WG = 6 * MiB;
constexpr size_t OFF_WF = 10 * MiB;
constexpr size_t OFF_WHG = 12 * MiB;
constexpr size_t OFF_WFT = 13 * MiB;
constexpr size_t OFF_WOUT = 14 * MiB;
constexpr size_t OFF_WS = 16 * MiB;
constexpr size_t OFF_UALL = 20 * MiB;
constexpr size_t OFF_OF = 88 * MiB;
constexpr size_t OFF_OB = 120 * MiB;
constexpr size_t OFF_FTT = 152 * MiB;
constexpr size_t OFF_Q = 216 * MiB;
constexpr size_t OFF_LF = 248 * MiB;
constexpr size_t OFF_LBK = 282 * MiB;
constexpr size_t OFF_V = 316 * MiB;
constexpr size_t OFF_G = 350 * MiB;
constexpr size_t OFF_DFTM = 382 * MiB;
constexpr size_t OFF_YFT = 446 * MiB;
constexpr size_t OFF_USTATE = 446 * MiB;
constexpr size_t OFF_DLOG = 460 * MiB;
constexpr size_t WS_NEED = 478 * MiB;
constexpr size_t OFF_GH = 216 * MiB;
constexpr size_t OFF_GF = 280 * MiB;
constexpr size_t OFF_Y = 152 * MiB;
constexpr size_t OFF_U2 = 20 * MiB;
constexpr size_t OFF_TU = 88 * MiB;
constexpr size_t OFF_TV = 104 * MiB;
constexpr size_t OFF_QX = 120 * MiB;
constexpr size_t OFF_SU = 204 * MiB;
constexpr size_t OFF_SV = 204 * MiB + 65536;
constexpr size_t OFF_SX = 205 * MiB;
constexpr size_t OFF_SC = 216 * MiB;
constexpr size_t OFF_EIDX = 152 * MiB;
constexpr size_t OFF_GATE = 168 * MiB;
constexpr size_t OFF_W = 184 * MiB;
constexpr size_t OFF_PSS = 200 * MiB;
constexpr size_t OFF_PACT = 216 * MiB;
constexpr size_t OFF_H2 = 216 * MiB;
constexpr int CTL_RANK = 4096;
constexpr size_t CTL_ZERO_BYTES = 32 * 1024;

struct Params { const float* in[20]; float* out; unsigned char* ws; int ph_lo, ph_hi; };

__device__ __forceinline__ unsigned pk2(float a, float b) { h16x2 v = {(h16)a, (h16)b}; return __builtin_bit_cast(unsigned, v); }
__device__ __forceinline__ float wave_sum(float v) {
#pragma unroll
    for (int o = 32; o >= 1; o >>= 1) v += __shfl_xor(v, o);
    return v; }
__device__ __forceinline__ float sigmoidf_(float z) { return 1.0f / (1.0f + __expf(-z)); }

constexpr int N_MOD = 96, N_LB = 1, N_TRA = 640, N_TRG = 512, N_TRHG = 128, N_TRFT = 128, N_TROUT = 256, N_WF = 128, N_WSF = 256, N_DFT = 256;
constexpr int P0_TOTAL = N_MOD + N_LB + N_TRA + N_TRG + N_TRHG + N_TRFT + N_TROUT + N_WF + N_WSF + N_DFT;

__device__ __forceinline__ void p0_mod(const Params& p, LAS float* sm, int idx) {
    const int tid = threadIdx.x;
    for (int i = tid; i < 9 * 1024; i += NTHREADS) { const int r = i >> 10, k = i & 1023; const float c = (r < 8) ? p.in[1][r * 1024 + k] : p.in[3][k]; sm[i] = c / (1.0f + __expf(-c)); }
    __syncthreads();
    const int col = tid & 63, ks = tid >> 6;
    float acc[9];
#pragma unroll
    for (int r = 0; r < 9; ++r) acc[r] = 0.f;
    const float* w = p.in[4] + (size_t)(ks * 128) * 6144 + idx * 64 + col;
#pragma unroll 4
    for (int k = 0; k < 128; ++k) { const float wv = w[(size_t)k * 6144];
#pragma unroll
        for (int r = 0; r < 9; ++r) acc[r] += sm[r * 1024 + ks * 128 + k] * wv; }
    LAS float* red = sm + 9 * 1024;
#pragma unroll
    for (int r = 0; r < 9; ++r) red[(ks * 9 + r) * 64 + col] = acc[r];
    __syncthreads();
    float* mod = (float*)(p.ws + OFF_MOD);
    for (int i = tid; i < 576; i += NTHREADS) { const int r = i >> 6, c = i & 63; float s = 0.f;
#pragma unroll
        for (int q = 0; q < 8; ++q) s += red[(q * 9 + r) * 64 + c];
        mod[r * 6144 + idx * 64 + c] = s + p.in[5][idx * 64 + c]; }
    __syncthreads();
}
__device__ __forceinline__ void p0_lb(const Params& p) {
    const int tid = threadIdx.x; float* lb = (float*)(p.ws + OFF_LB);
    if (tid < 512) { lb[tid] = 1.0f / (1.0f + expf(p.in[9][512 + tid] - p.in[9][tid])); lb[512 + tid] = 1.0f / (1.0f + expf(p.in[10][512 + tid] - p.in[10][tid])); }
}
__device__ __forceinline__ void p0_transpose(const float* src, int ld_src, int ncol0, h16* dst, int ld_dst, int nktiles, int item, LAS float* sm) {
    const int tid = threadIdx.x, kt = item % nktiles, nt = item / nktiles;
    { const int n = tid & 63, kk = tid >> 6;
#pragma unroll
      for (int ps = 0; ps < 8; ++ps) { const int k = kk + 8 * ps; sm[k * 65 + n] = src[(size_t)(kt * 64 + k) * ld_src + ncol0 + nt * 64 + n]; } }
    __syncthreads();
    { const int k = tid & 63, nn = tid >> 6;
#pragma unroll
      for (int ps = 0; ps < 8; ++ps) { const int n = nn + 8 * ps; dst[(size_t)(nt * 64 + n) * ld_dst + kt * 64 + k] = (h16)sm[k * 65 + n]; } }
    __syncthreads();
}
__device__ __forceinline__ void p0_wf(const Params& p, LAS float* sm, int item) {
    const int tid = threadIdx.x, dt = item & 15, part = (item >> 4) & 1, g = item >> 5, d0 = dt * 64;
    LAS float* w = sm; LAS float* trig = sm + 64 * 129;
    for (int i = tid; i < 64 * 128; i += NTHREADS) { const int dl = i >> 7, n2 = i & 127; w[dl * 129 + n2] = p.in[8][(size_t)(d0 + dl) * 5120 + 2560 + g * 128 + n2]; }
    if (tid < 128) trig[tid] = part ? sinpif((float)tid / 64.0f) : cospif((float)tid / 64.0f);
    __syncthreads();
    const int dl = tid & 63, kg = tid >> 6; h16* WF = (h16*)(p.ws + OFF_WF);
#pragma unroll 1
    for (int kk = 0; kk < 16; ++kk) { const int k2 = kg * 16 + kk; float s = 0.f;
#pragma unroll 4
        for (int n2 = 0; n2 < 128; ++n2) s += w[dl * 129 + n2] * trig[(k2 * n2) & 127];
        WF[(size_t)(part * 512 + g * 128 + k2) * 1024 + d0 + dl] = (h16)(s * 0.08838834764831845f); }
    __syncthreads();
}
__device__ __forceinline__ void p0_wsf(const Params& p, LAS float* sm, int item) {
    const int tid = threadIdx.x, dt = item & 15, hp = item >> 4, d0 = dt * 64;
    LAS float* wq = sm; LAS float* sk = sm + 8256;
    for (int i = tid; i < 64 * 128; i += NTHREADS) { const int dl = i >> 7, k = i & 127; wq[dl * 129 + k] = p.in[15][(size_t)(d0 + dl) * 2048 + hp * 128 + k]; }
    for (int i = tid; i < 128 * 128; i += NTHREADS) sk[i] = p.in[16][(size_t)hp * 16384 + i];
    __syncthreads();
    const int dl = tid & 63, ng = tid >> 6; h16* WS = (h16*)(p.ws + OFF_WS);
#pragma unroll 1
    for (int nn = 0; nn < 16; ++nn) { const int n = ng * 16 + nn; float s = 0.f;
#pragma unroll 4
        for (int k = 0; k < 128; ++k) s += wq[dl * 129 + k] * sk[n * 128 + k];
        WS[(size_t)(hp * 128 + n) * 1024 + d0 + dl] = (h16)s; }
    __syncthreads();
}
__device__ __forceinline__ void p0_dftm(const Params& p, LAS float* sm, int item) {
    const int tid = threadIdx.x;
    for (int i = tid; i < 4096; i += NTHREADS) sm[i] = cospif((float)i / 2048.0f) * (1.0f / 64.0f);
    __syncthreads();
    h16* M = (h16*)(p.ws + OFF_DFTM);
#pragma unroll 1
    for (int e = tid; e < 16 * 1024; e += NTHREADS) { const int k1 = item * 16 + (e >> 10), K0 = (e & 1023) * 8, part = K0 >> 12, n1 = K0 & 4095;
        float v[8];
#pragma unroll
        for (int j = 0; j < 8; ++j) { const int m = (k1 * (n1 + j)) & 4095; v[j] = part ? -sm[(m - 1024) & 4095] : sm[m]; }
        u32x4 w; w.x = pk2(v[0], v[1]); w.y = pk2(v[2], v[3]); w.z = pk2(v[4], v[5]); w.w = pk2(v[6], v[7]);
        *(u32x4*)(M + (size_t)k1 * 8192 + K0) = w; }
    __syncthreads();
}
__device__ __forceinline__ void phase0(const Params& p, LAS unsigned char* lds) {
    LAS float* sm = (LAS float*)lds;
    for (int it = blockIdx.x; it < P0_TOTAL; it += gridDim.x) {
        int i = it;
        if (i < N_MOD) { p0_mod(p, sm, i); continue; } i -= N_MOD;
        if (i < N_LB) { p0_lb(p); continue; } i -= N_LB;
        if (i < N_TRA) { p0_transpose(p.in[8], 5120, 0, (h16*)(p.ws + OFF_WA), 1024, 16, i, sm); continue; } i -= N_TRA;
        if (i < N_TRG) { p0_transpose(p.in[8], 5120, 3072, (h16*)(p.ws + OFF_WG), 1024, 16, i, sm); continue; } i -= N_TRG;
        if (i < N_TRHG) { p0_transpose(p.in[12], 1024, 0, (h16*)(p.ws + OFF_WHG), 512, 8, i, sm); continue; } i -= N_TRHG;
        if (i < N_TRFT) { p0_transpose(p.in[13], 1024, 0, (h16*)(p.ws + OFF_WFT), 512, 8, i, sm); continue; } i -= N_TRFT;
        if (i < N_TROUT) { p0_transpose(p.in[14], 1024, 0, (h16*)(p.ws + OFF_WOUT), 1024, 16, i, sm); continue; } i -= N_TROUT;
        if (i < N_WF) { p0_wf(p, sm, i); continue; } i -= N_WF;
        if (i < N_WSF) { p0_wsf(p, sm, i); continue; } i -= N_WSF;
        p0_dftm(p, sm, i);
    }
}

__device__ __forceinline__ void modulate_rows(const float* src, h16* dst, int nrows, const float* gvec, const float* mod, int sh_off, int sc_off, int ctx_rows, signed char* qdst = nullptr, float* qscale = nullptr) {
    const int wave = threadIdx.x >> 6, lane = threadIdx.x & 63;
    for (int row = blockIdx.x * 8 + wave; row < nrows; row += gridDim.x * 8) {
        const int mr = ctx_rows ? 8 : (row >> 12);
        const float* x = src + (size_t)row * D;
        f32x4 v[4]; float ss = 0.f;
#pragma unroll
        for (int j = 0; j < 4; ++j) { v[j] = *(const f32x4*)(x + j * 256 + lane * 4); ss += v[j].x * v[j].x + v[j].y * v[j].y + v[j].z * v[j].z + v[j].w * v[j].w; }
        ss = wave_sum(ss);
        const float rstd = rsqrtf(ss * (1.0f / D) + EPS);
        float amax = 0.f;
#pragma unroll
        for (int j = 0; j < 4; ++j) { const int c = j * 256 + lane * 4;
            const f32x4 gg = *(const f32x4*)(gvec + c), sc = *(const f32x4*)(mod + mr * 6144 + sc_off + c), sh = *(const f32x4*)(mod + mr * 6144 + sh_off + c);
            const f32x4 o = (v[j] * rstd) * gg * (sc + 1.0f) + sh; v[j] = o;
            amax = fmaxf(amax, fmaxf(fmaxf(fabsf(o.x), fabsf(o.y)), fmaxf(fabsf(o.z), fabsf(o.w))));
            u32x2 w; w.x = pk2(o.x, o.y); w.y = pk2(o.z, o.w);
            *(u32x2*)(dst + (size_t)row * D + c) = w; }
        if (qdst) {
#pragma unroll
            for (int o = 32; o >= 1; o >>= 1) amax = fmaxf(amax, __shfl_xor(amax, o));
            const float qs = amax > 0.f ? amax * (1.0f / 127.0f) : 1.0f, inv = 1.0f / qs;
#pragma unroll
            for (int j = 0; j < 4; ++j) { const int c = j * 256 + lane * 4;
                const int q0 = (int)rintf(v[j].x * inv), q1 = (int)rintf(v[j].y * inv), q2 = (int)rintf(v[j].z * inv), q3 = (int)rintf(v[j].w * inv);
                *(unsigned*)(qdst + (size_t)row * D + c) = (unsigned)(q0 & 255) | ((unsigned)(q1 & 255) << 8) | ((unsigned)(q2 & 255) << 16) | ((unsigned)(q3 & 255) << 24); }
            if (lane == 0) qscale[row] = qs;
        }
    }
}

struct EpiA {
    static constexpr bool PERM = true, TRANS = true;
    unsigned char* ws;
    __device__ __forceinline__ void operator()(const f32x4 (&acc)[2][2][4][2], const pg8::Unit& u, int wr, int wc, int fr, int fq) const {
        const int ty = u.pn >> 1;
        h16* base = (h16*)(ws + (ty == 0 ? OFF_Q : ty == 1 ? OFF_LF : ty == 2 ? OFF_LBK : ty == 3 ? OFF_V : OFF_G));
        const float* lb = (const float*)(ws + OFF_LB) + (ty == 2 ? 512 : 0);
        const int row0 = u.pm * 256 + wr * 64 + fr, col0 = (u.pn & 1) * 256 + wc * 32 + 8 * fq;
#pragma unroll
        for (int bj = 0; bj < 2; ++bj) {
            float lbv[8];
            if (ty == 1 || ty == 2) {
#pragma unroll
                for (int j = 0; j < 8; ++j) lbv[j] = lb[col0 + bj * 128 + j];
            }
#pragma unroll
            for (int ai = 0; ai < 2; ++ai)
#pragma unroll
                for (int m = 0; m < 4; ++m) {
                    float v[8];
#pragma unroll
                    for (int j = 0; j < 4; ++j) { v[j] = acc[ai][bj][m][0][j]; v[4 + j] = acc[ai][bj][m][1][j]; }
                    if (ty == 0) {
#pragma unroll
                        for (int j = 0; j < 8; ++j) v[j] *= 0.08838834764831845f;
                    } else if (ty == 1 || ty == 2) {
#pragma unroll
                        for (int j = 0; j < 8; ++j) v[j] = __logf(lbv[j] + (1.0f - lbv[j]) * sigmoidf_(v[j]));
                    } else if (ty == 4) {
#pragma unroll
                        for (int j = 0; j < 8; ++j) v[j] = v[j] * sigmoidf_(v[j]);
                    }
                    u32x4 w; w.x = pk2(v[0], v[1]); w.y = pk2(v[2], v[3]); w.z = pk2(v[4], v[5]); w.w = pk2(v[6], v[7]);
                    *(u32x4*)(base + (size_t)(row0 + ai * 128 + m * 16) * 512 + col0 + bj * 128) = w;
                }
        }
    }
};
struct OrderA {
    pg8::TileOrder lat; int G, c, rep;
    __device__ void init(int G_, int c_, int rep_ = 1) { lat.init(128, 10, G_, c_); G = G_; c = c_; rep = rep_; }
    __device__ bool next(int i, pg8::Unit& u) const {
        long L = (long)i * G + c; if (L >= 1328L * rep) return false; L %= 1328;
        if (L < 1280) return lat.map(L, u);
        const int l2 = (int)(L - 1280); if (l2 >= 48) return false;
        u.pm = 128 + l2 / 6; u.pn = 2 + l2 % 6; return true;
    }
};
struct EpiGate {
    static constexpr bool PERM = true, TRANS = true;
    unsigned char* ws;
    __device__ __forceinline__ void operator()(const f32x4 (&acc)[2][2][4][2], const pg8::Unit& u, int wr, int wc, int fr, int fq) const {
        h16* base = (h16*)(ws + (u.pn < 4 ? OFF_GH : OFF_GF));
        const int row0 = u.pm * 256 + wr * 64 + fr, col0 = (u.pn & 3) * 256 + wc * 32 + 8 * fq;
#pragma unroll
        for (int ai = 0; ai < 2; ++ai)
#pragma unroll
            for (int m = 0; m < 4; ++m)
#pragma unroll
                for (int bj = 0; bj < 2; ++bj) {
                    float v[8];
#pragma unroll
                    for (int j = 0; j < 4; ++j) { v[j] = sigmoidf_(acc[ai][bj][m][0][j]); v[4 + j] = sigmoidf_(acc[ai][bj][m][1][j]); }
                    u32x4 w; w.x = pk2(v[0], v[1]); w.y = pk2(v[2], v[3]); w.z = pk2(v[4], v[5]); w.w = pk2(v[6], v[7]);
                    *(u32x4*)(base + (size_t)(row0 + ai * 128 + m * 16) * 1024 + col0 + bj * 128) = w;
                }
    }
};
struct EpiFT {
    static constexpr bool PERM = false, TRANS = false;
    unsigned char* ws;
    __device__ __forceinline__ void operator()(const f32x4 (&acc)[2][2][4][2], const pg8::Unit& u, int wr, int wc, int fr, int fq) const {
        h16* F = (h16*)(ws + OFF_FTT);
        const int t0 = u.pm * 256 + wr * 64 + 4 * fq, c0 = u.pn * 256 + wc * 32 + fr;
#pragma unroll
        for (int ai = 0; ai < 2; ++ai)
#pragma unroll
            for (int m = 0; m < 4; ++m)
#pragma unroll
                for (int bj = 0; bj < 2; ++bj)
#pragma unroll
                    for (int n = 0; n < 2; ++n) {
                        const int t = t0 + ai * 128 + m * 16, c = c0 + bj * 128 + n * 16;
                        const int b = t >> 12, n1 = t & 4095, part = c >> 9, gk = c & 511;
                        const f32x4 a = acc[ai][bj][m][n];
                        u32x2 w; w.x = pk2(a.x, a.y); w.y = pk2(a.z, a.w);
                        *(u32x2*)(F + ((size_t)((b * 512 + gk) * 2 + part)) * 4096 + n1) = w;
                    }
    }
};
struct EpiDFT {
    static constexpr bool PERM = true, TRANS = true;
    unsigned char* ws;
    __device__ __forceinline__ void operator()(const f32x4 (&acc)[2][2][4][2], const pg8::Unit& u, int wr, int wc, int fr, int fq) const {
        h16* Y = (h16*)(ws + OFF_YFT);
        const int b = u.pn >> 1;
        const int row0 = b * 4096 + u.pm * 256 + wr * 64 + fr, col0 = (u.pn & 1) * 256 + wc * 32 + 8 * fq;
#pragma unroll
        for (int ai = 0; ai < 2; ++ai)
#pragma unroll
            for (int m = 0; m < 4; ++m)
#pragma unroll
                for (int bj = 0; bj < 2; ++bj) {
                    const f32x4 a0 = acc[ai][bj][m][0], a1 = acc[ai][bj][m][1];
                    u32x4 w; w.x = pk2(a0.x, a0.y); w.y = pk2(a0.z, a0.w); w.z = pk2(a1.x, a1.y); w.w = pk2(a1.z, a1.w);
                    *(u32x4*)(Y + (size_t)(row0 + ai * 128 + m * 16) * 512 + col0 + bj * 128) = w;
                }
    }
};
template <bool ACCUM> struct EpiMerge1 {
    static constexpr bool PERM = true, TRANS = true;
    unsigned char* ws;
    __device__ __forceinline__ void operator()(const f32x4 (&acc)[2][2][4][2], const pg8::Unit& u, int wr, int wc, int fr, int fq) const {
        h16* Y = (h16*)(ws + OFF_Y); const h16* GT = (const h16*)(ws + (ACCUM ? OFF_GF : OFF_GH));
        const int row0 = u.pm * 256 + wr * 64 + fr, col0 = u.pn * 256 + wc * 32 + 8 * fq;
#pragma unroll
        for (int ai = 0; ai < 2; ++ai)
#pragma unroll
            for (int m = 0; m < 4; ++m)
#pragma unroll
                for (int bj = 0; bj < 2; ++bj) {
                    const size_t off = (size_t)(row0 + ai * 128 + m * 16) * 1024 + col0 + bj * 128;
                    const h16x8 gt = *(const h16x8*)(GT + off);
                    float v[8];
#pragma unroll
                    for (int j = 0; j < 4; ++j) { v[j] = acc[ai][bj][m][0][j] * (float)gt[j]; v[4 + j] = acc[ai][bj][m][1][j] * (float)gt[4 + j]; }
                    if (ACCUM) { const h16x8 y0 = *(const h16x8*)(Y + off);
#pragma unroll
                        for (int j = 0; j < 8; ++j) v[j] += (float)y0[j]; }
                    u32x4 w; w.x = pk2(v[0], v[1]); w.y = pk2(v[2], v[3]); w.z = pk2(v[4], v[5]); w.w = pk2(v[6], v[7]);
                    *(u32x4*)(Y + off) = w;
                }
    }
};
struct EpiMerge2 {
    static constexpr bool PERM = false, TRANS = true;
    const float* x; float* H; const float* mod;
    __device__ __forceinline__ void operator()(const f32x4 (&acc)[2][2][4][2], const pg8::Unit& u, int wr, int wc, int fr, int fq) const {
        const int row0 = u.pm * 256 + wr * 64 + fr, col0 = u.pn * 256 + wc * 32 + 4 * fq;
        const int b = (u.pm * 256) >> 12;
        f32x4 g1[2][2];
#pragma unroll
        for (int bj = 0; bj < 2; ++bj)
#pragma unroll
            for (int n = 0; n < 2; ++n) g1[bj][n] = *(const f32x4*)(mod + b * 6144 + 2048 + col0 + bj * 128 + n * 16);
#pragma unroll
        for (int ai = 0; ai < 2; ++ai)
#pragma unroll
            for (int m = 0; m < 4; ++m) { const size_t ro = (size_t)(row0 + ai * 128 + m * 16) * 1024 + col0;
#pragma unroll
                for (int bj = 0; bj < 2; ++bj)
#pragma unroll
                    for (int n = 0; n < 2; ++n) { const f32x4 xv = *(const f32x4*)(x + ro + bj * 128 + n * 16);
                        *(f32x4*)(H + ro + bj * 128 + n * 16) = xv + g1[bj][n] * acc[ai][bj][m][n]; } }
    }
};
struct EpiF32 {
    static constexpr bool PERM = false, TRANS = true;
    float* C; int ldc;
    __device__ __forceinline__ void operator()(const f32x4 (&acc)[2][2][4][2], const pg8::Unit& u, int wr, int wc, int fr, int fq) const {
        const int row0 = u.pm * 256 + wr * 64 + fr, col0 = u.pn * 256 + wc * 32 + 4 * fq;
#pragma unroll
        for (int ai = 0; ai < 2; ++ai)
#pragma unroll
            for (int m = 0; m < 4; ++m) { float* rowp = C + (size_t)(row0 + ai * 128 + m * 16) * ldc + col0;
#pragma unroll
                for (int bj = 0; bj < 2; ++bj)
#pragma unroll
                    for (int n = 0; n < 2; ++n) *(f32x4*)(rowp + bj * 128 + n * 16) = acc[ai][bj][m][n]; }
    }
};

__device__ __forceinline__ int hgrn_row(int pos, int b, int dir) {
    if (pos < LC) { const int j = dir ? (LC - 1 - pos) : pos; return T + b * LC + j; }
    const int t = pos - LC; return b * SEQ + (dir ? (SEQ - 1 - t) : t);
}
__device__ void hgrn_item(const Params& p, LAS unsigned char* lds, int item) {
    const int tid = threadIdx.x, vq = item & 3, dir = (item >> 2) & 1, h = (item >> 3) & 3, b = item >> 5;
    const h16* Q = (const h16*)(p.ws + OFF_Q); const h16* LF = (const h16*)(p.ws + (dir ? OFF_LBK : OFF_LF)); const h16* V = (const h16*)(p.ws + OFF_V);
    h16* O = (h16*)(p.ws + (dir ? OFF_OB : OFF_OF));
    LAS float* fs = (LAS float*)lds; LAS float* ks = fs + 16 * 128; LAS float* qs = ks + 16 * 128; LAS float* vs = qs + 16 * 128; LAS float* po = vs + 16 * 32;
    const int v = tid & 31, kq = tid >> 5;
    float S[8];
#pragma unroll
    for (int j = 0; j < 8; ++j) S[j] = 0.f;
    const int e = tid * 4, tl_ld = e >> 7, k_ld = e & 127;
    const int tl_v = tid >> 5, vv = tid & 31;
    h16x4 lf4, q4; h16 v1;
    { const int row = hgrn_row(tl_ld, b, dir); lf4 = *(const h16x4*)(LF + (size_t)row * 512 + h * 128 + k_ld); q4 = (h16x4){0, 0, 0, 0};
      const int row2 = hgrn_row(tl_v, b, dir); v1 = V[(size_t)row2 * 512 + h * 128 + vq * 32 + vv]; }
    constexpr int NG = (LC + SEQ) / 16;
    for (int grp = 0; grp < NG; ++grp) {
        const bool latent = grp >= LC / 16;
#pragma unroll
        for (int j = 0; j < 4; ++j) { const float f = __expf((float)lf4[j]); fs[e + j] = f; ks[e + j] = 1.0f - f; qs[e + j] = (float)q4[j]; }
        vs[tid] = (float)v1;
        __syncthreads();
        if (grp + 1 < NG) { const int pos = (grp + 1) * 16; const bool lat2 = (grp + 1) >= LC / 16;
            const int row = hgrn_row(pos + tl_ld, b, dir); lf4 = *(const h16x4*)(LF + (size_t)row * 512 + h * 128 + k_ld);
            if (lat2) q4 = *(const h16x4*)(Q + (size_t)row * 512 + h * 128 + k_ld);
            const int row2 = hgrn_row(pos + tl_v, b, dir); v1 = V[(size_t)row2 * 512 + h * 128 + vq * 32 + vv]; }
#pragma unroll 4
        for (int tl = 0; tl < 16; ++tl) {
            const float vt = vs[tl * 32 + v];
            const f32x4 f0 = *(const LAS f32x4*)(fs + tl * 128 + kq * 8), f1 = *(const LAS f32x4*)(fs + tl * 128 + kq * 8 + 4);
            const f32x4 k0 = *(const LAS f32x4*)(ks + tl * 128 + kq * 8), k1 = *(const LAS f32x4*)(ks + tl * 128 + kq * 8 + 4);
            const f32x4 q0 = *(const LAS f32x4*)(qs + tl * 128 + kq * 8), q1 = *(const LAS f32x4*)(qs + tl * 128 + kq * 8 + 4);
            float a = 0.f;
#pragma unroll
            for (int j = 0; j < 4; ++j) { S[j] = f0[j] * S[j] + k0[j] * vt; a += S[j] * q0[j]; S[4 + j] = f1[j] * S[4 + j] + k1[j] * vt; a += S[4 + j] * q1[j]; }
            po[(tl * 16 + kq) * 32 + v] = a;
        }
        __syncthreads();
        if (latent) { float s = 0.f;
#pragma unroll
            for (int q = 0; q < 16; ++q) s += po[(tl_v * 16 + q) * 32 + vv];
            const int row = hgrn_row(grp * 16 + tl_v, b, dir);
            O[(size_t)row * 512 + h * 128 + vq * 32 + vv] = (h16)s; }
    }
    __syncthreads();
}

typedef short s16x8 __attribute__((ext_vector_type(8)));
typedef short s16x4 __attribute__((ext_vector_type(4)));
__device__ __forceinline__ unsigned cvt_pk_bf16(float lo, float hi) { unsigned r; asm volatile("v_cvt_pk_bf16_f32 %0, %1, %2" : "=v"(r) : "v"(lo), "v"(hi)); return r; }
constexpr int HG_RP = 272, HG_QT = 0, HG_KT = 17408, HG_QD = 34816, HG_KDT = 52224, HG_VT = 68608, HG_AM = 84992, HG_DEC = 93184, HG_SEG = 93696, HG_SEGCH = 17;
#define HG_OPAQUE(x) asm volatile("" : "+v"(x))
template <bool FULL>
__device__ __forceinline__ void hgrn_mfma_unit(const Params& p, LAS unsigned char* lds, int item, int seg) {
    const int tid = threadIdx.x, wave = __builtin_amdgcn_readfirstlane(tid >> 6), lane = tid & 63, fr = lane & 15, fq = lane >> 4;
    const int dir = item & 1, h = (item >> 1) & 3, b = item >> 3;
    const h16* Q = (const h16*)(p.ws + OFF_Q); const h16* LF = (const h16*)(p.ws + (dir ? OFF_LBK : OFF_LF)); const h16* V = (const h16*)(p.ws + OFF_V);
    h16* O = (h16*)(p.ws + (dir ? OFF_OB : OFF_OF));
    float* USTATE = (float*)(p.ws + OFF_USTATE); float* DLOG = (float*)(p.ws + OFF_DLOG);
    const int ch_lo = seg * HG_SEGCH, ch_hi = ch_lo + HG_SEGCH;
    f32x4 S[8];
#pragma unroll
    for (int m = 0; m < 8; ++m) S[m] = (f32x4){0.f, 0.f, 0.f, 0.f};
    if (FULL && seg > 0) {
        for (int i = 0; i < seg; ++i) { const float* U = USTATE + (size_t)(item * 3 + i) * 16384; const float* DL = DLOG + (size_t)(item * 3 + i) * 128;
#pragma unroll
            for (int m = 0; m < 8; ++m)
#pragma unroll
                for (int j = 0; j < 4; ++j) { const int k = 16 * m + 4 * fq + j; const float d = (i > 0) ? __expf(DL[k]) : 0.f; S[m][j] = d * S[m][j] + U[k * 128 + 16 * wave + fr]; } } }
    float dl0 = 0.f, dl1 = 0.f;
    for (int i = tid; i < 8192 / 16; i += NTHREADS) ((LAS u32x4*)(lds + HG_AM))[i] = (u32x4){0u, 0u, 0u, 0u};
    const int kp = lane;
    const unsigned chan = (unsigned)(h * 128 + 2 * kp);
    int bw_rm = wave * 8 * HG_RP + 4 * kp;
    int bw_t0 = (2 * kp) * 128 + ((wave ^ ((2 * kp) & 7)) << 4), bw_t1 = (2 * kp + 1) * 128 + ((wave ^ ((2 * kp + 1) & 7)) << 4);
    int br_rm = fr * HG_RP + 16 * fq;
    int br_qd = HG_QD + fr * HG_RP + 8 * fq;
    int br_t0 = fr * 128 + ((fq ^ (fr & 7)) << 4), br_t1 = fr * 128 + (((4 + fq) ^ (fr & 7)) << 4);
    HG_OPAQUE(bw_rm); HG_OPAQUE(bw_t0); HG_OPAQUE(bw_t1); HG_OPAQUE(br_rm); HG_OPAQUE(br_qd); HG_OPAQUE(br_t0); HG_OPAQUE(br_t1);
    int br_v0 = br_t0 + HG_VT + wave * 2048, br_v1 = br_t1 + HG_VT + wave * 2048, br_k0 = br_t0 + HG_KDT, br_k1 = br_t1 + HG_KDT, br_a0 = br_t0 + HG_AM, br_a1 = br_t1 + HG_AM;
    HG_OPAQUE(br_v0); HG_OPAQUE(br_v1); HG_OPAQUE(br_k0); HG_OPAQUE(br_k1); HG_OPAQUE(br_a0); HG_OPAQUE(br_a1);
    LAS float* DEC = (LAS float*)(lds + HG_DEC); LAS float* SEG = (LAS float*)(lds + HG_SEG);
    unsigned lfr[8], qr[8], vr[8];
#pragma unroll
    for (int r = 0; r < 8; ++r) { const unsigned eo = (unsigned)hgrn_row(ch_lo * 64 + 8 * wave + r, b, dir) * 512u + chan; lfr[r] = *(const unsigned*)(LF + eo); vr[r] = *(const unsigned*)(V + eo);
        qr[r] = (FULL && ch_lo >= LC / 64) ? *(const unsigned*)(Q + eo) : 0u; }
    for (int ch = ch_lo; ch < ch_hi; ++ch) {
        const bool latent = FULL && (ch >= LC / 64);
        float c0[8], c1[8]; float run0 = 0.f, run1 = 0.f;
#pragma unroll
        for (int r = 0; r < 8; ++r) { const h16x2 l = __builtin_bit_cast(h16x2, lfr[r]); run0 += (float)l[0]; run1 += (float)l[1]; c0[r] = run0; c1[r] = run1; }
        *(LAS f32x2*)(SEG + wave * 128 + 2 * kp) = (f32x2){run0, run1};
        __syncthreads();
        float off0 = 0.f, off1 = 0.f, mid0 = 0.f, mid1 = 0.f, tot0 = 0.f, tot1 = 0.f;
#pragma unroll
        for (int w2 = 0; w2 < 8; ++w2) { const f32x2 tt = *(LAS f32x2*)(SEG + w2 * 128 + 2 * kp);
            if (w2 < wave) { off0 += tt[0]; off1 += tt[1]; } if (w2 < 4) { mid0 += tt[0]; mid1 += tt[1]; } tot0 += tt[0]; tot1 += tt[1]; }
        dl0 += tot0; dl1 += tot1;
        const float em0 = __expf(mid0), em1 = __expf(mid1), el0 = __expf(tot0 - mid0), el1 = __expf(tot1 - mid1);
        if (wave == 0) *(LAS f32x2*)(DEC + 2 * kp) = (f32x2){__expf(tot0), __expf(tot1)};
        unsigned kd0[4], kd1[4], vt0[4], vt1[4];
#pragma unroll
        for (int r = 0; r < 8; ++r) {
            const h16x2 l = __builtin_bit_cast(h16x2, lfr[r]), q = __builtin_bit_cast(h16x2, qr[r]), v = __builtin_bit_cast(h16x2, vr[r]);
            const float b0 = off0 + c0[r], b1 = off1 + c1[r];
            const float e20 = __expf(mid0 - b0), e21 = __expf(mid1 - b1);
            const float k0 = 1.0f - __expf((float)l[0]), k1 = 1.0f - __expf((float)l[1]);
            const float kt0 = k0 * e20, kt1 = k1 * e21;
            if (FULL) {
                const float e10 = __expf(b0 - mid0), e11 = __expf(b1 - mid1);
                const float qt0 = (float)q[0] * e10, qt1 = (float)q[1] * e11;
                *(LAS unsigned*)(lds + bw_rm + HG_QT + r * HG_RP) = cvt_pk_bf16(qt0, qt1);
                *(LAS unsigned*)(lds + bw_rm + HG_KT + r * HG_RP) = cvt_pk_bf16(kt0, kt1);
                *(LAS unsigned*)(lds + bw_rm + HG_QD + r * HG_RP) = cvt_pk_bf16(qt0 * em0, qt1 * em1);
            }
            const float kdv0 = kt0 * el0, kdv1 = kt1 * el1;
            if (r & 1) { kd0[r >> 1] = cvt_pk_bf16(__builtin_bit_cast(float, kd0[r >> 1]), kdv0); kd1[r >> 1] = cvt_pk_bf16(__builtin_bit_cast(float, kd1[r >> 1]), kdv1);
                         vt0[r >> 1] = cvt_pk_bf16(__builtin_bit_cast(float, vt0[r >> 1]), (float)v[0]); vt1[r >> 1] = cvt_pk_bf16(__builtin_bit_cast(float, vt1[r >> 1]), (float)v[1]); }
            else { kd0[r >> 1] = __builtin_bit_cast(unsigned, kdv0); kd1[r >> 1] = __builtin_bit_cast(unsigned, kdv1);
                   vt0[r >> 1] = __builtin_bit_cast(unsigned, (float)v[0]); vt1[r >> 1] = __builtin_bit_cast(unsigned, (float)v[1]); }
        }
        *(LAS u32x4*)(lds + bw_t0 + HG_KDT) = (u32x4){kd0[0], kd0[1], kd0[2], kd0[3]};
        *(LAS u32x4*)(lds + bw_t1 + HG_KDT) = (u32x4){kd1[0], kd1[1], kd1[2], kd1[3]};
        *(LAS u32x4*)(lds + bw_t0 + HG_VT) = (u32x4){vt0[0], vt0[1], vt0[2], vt0[3]};
        *(LAS u32x4*)(lds + bw_t1 + HG_VT) = (u32x4){vt1[0], vt1[1], vt1[2], vt1[3]};
        __syncthreads();
        if (ch + 1 < ch_hi) { const bool lat2 = FULL && ((ch + 1) >= LC / 64);
#pragma unroll
            for (int r = 0; r < 8; ++r) { const unsigned eo = (unsigned)hgrn_row((ch + 1) * 64 + 8 * wave + r, b, dir) * 512u + chan;
                lfr[r] = *(const unsigned*)(LF + eo); vr[r] = *(const unsigned*)(V + eo); qr[r] = lat2 ? *(const unsigned*)(Q + eo) : 0u; } }
        if (latent) {
#pragma unroll
            for (int rep = 0; rep < 2; ++rep) {
                const int tile = wave + 8 * rep;
                if (tile < 10) {
                    const int ti = tile < 1 ? 0 : tile < 3 ? 1 : tile < 6 ? 2 : 3, si = tile - (ti * (ti + 1)) / 2;
                    f32x4 acc = (f32x4){0.f, 0.f, 0.f, 0.f};
                    LAS unsigned char* pa = lds + br_rm + HG_KT + 16 * si * HG_RP; LAS unsigned char* pb = lds + br_rm + HG_QT + 16 * ti * HG_RP;
#pragma unroll
                    for (int kk = 0; kk < 4; ++kk) acc = __builtin_amdgcn_mfma_f32_16x16x32_bf16(*(LAS s16x8*)(pa + 64 * kk), *(LAS s16x8*)(pb + 64 * kk), acc, 0, 0, 0);
                    const int t = 16 * ti + fr, s0 = 16 * si + 4 * fq;
                    if (ti == si) {
#pragma unroll
                        for (int j = 0; j < 4; ++j) acc[j] = (s0 + j <= t) ? acc[j] : 0.f; }
                    *(LAS u32x2*)(lds + HG_AM + t * 128 + ((((s0 >> 3)) ^ (fr & 7)) << 4) + (s0 & 7) * 2) = (u32x2){cvt_pk_bf16(acc[0], acc[1]), cvt_pk_bf16(acc[2], acc[3])};
                }
            }
        }
        __syncthreads();
        const s16x8 vf0 = *(LAS s16x8*)(lds + br_v0), vf1 = *(LAS s16x8*)(lds + br_v1);
        if (latent) {
            s16x8 sfrag[4];
#pragma unroll
            for (int kk = 0; kk < 4; ++kk) { const unsigned w0 = cvt_pk_bf16(S[2 * kk][0], S[2 * kk][1]), w1 = cvt_pk_bf16(S[2 * kk][2], S[2 * kk][3]),
                                                          w2 = cvt_pk_bf16(S[2 * kk + 1][0], S[2 * kk + 1][1]), w3 = cvt_pk_bf16(S[2 * kk + 1][2], S[2 * kk + 1][3]);
                sfrag[kk] = __builtin_bit_cast(s16x8, (u32x4){w0, w1, w2, w3}); }
#pragma unroll
            for (int ti = 0; ti < 4; ++ti) {
                f32x4 acc = (f32x4){0.f, 0.f, 0.f, 0.f};
                acc = __builtin_amdgcn_mfma_f32_16x16x32_bf16(vf0, *(LAS s16x8*)(lds + br_a0 + 2048 * ti), acc, 0, 0, 0);
                if (ti >= 2) acc = __builtin_amdgcn_mfma_f32_16x16x32_bf16(vf1, *(LAS s16x8*)(lds + br_a1 + 2048 * ti), acc, 0, 0, 0);
#pragma unroll
                for (int kk = 0; kk < 4; ++kk) {
                    const s16x4 lo = *(LAS s16x4*)(lds + br_qd + 16 * ti * HG_RP + 64 * kk), hi = *(LAS s16x4*)(lds + br_qd + 16 * ti * HG_RP + 64 * kk + 32);
                    const s16x8 bf = (s16x8){lo[0], lo[1], lo[2], lo[3], hi[0], hi[1], hi[2], hi[3]};
                    acc = __builtin_amdgcn_mfma_f32_16x16x32_bf16(sfrag[kk], bf, acc, 0, 0, 0); }
                const unsigned oo = (unsigned)hgrn_row(ch * 64 + 16 * ti + fr, b, dir) * 512u + (unsigned)(h * 128 + 16 * wave + 4 * fq);
                *(u32x2*)(O + oo) = (u32x2){pk2(acc[0], acc[1]), pk2(acc[2], acc[3])};
            }
        }
#pragma unroll
        for (int m = 0; m < 8; ++m) {
            const f32x4 dc = *(LAS f32x4*)(DEC + 16 * m + 4 * fq);
            S[m] = S[m] * dc;
            S[m] = __builtin_amdgcn_mfma_f32_16x16x32_bf16(*(LAS s16x8*)(lds + br_k0 + 2048 * m), vf0, S[m], 0, 0, 0);
            S[m] = __builtin_amdgcn_mfma_f32_16x16x32_bf16(*(LAS s16x8*)(lds + br_k1 + 2048 * m), vf1, S[m], 0, 0, 0);
        }
    }
    if (!FULL) {
        float* U = USTATE + (size_t)(item * 3 + seg) * 16384;
#pragma unroll
        for (int m = 0; m < 8; ++m)
#pragma unroll
            for (int j = 0; j < 4; ++j) U[(16 * m + 4 * fq + j) * 128 + 16 * wave + fr] = S[m][j];
        if (wave == 0) *(f32x2*)(DLOG + (size_t)(item * 3 + seg) * 128 + 2 * kp) = (f32x2){dl0, dl1};
    }
    __syncthreads();
}

__device__ __forceinline__ void a1_prepass(const Params& p) {
    const int wave = threadIdx.x >> 6, lane = threadIdx.x & 63;
    const h16* OF = (const h16*)(p.ws + OFF_OF); const h16* OB = (const h16*)(p.ws + OFF_OB); h16* G = (h16*)(p.ws + OFF_G);
    const float* hgn = p.in[11];
    for (int t = blockIdx.x * 8 + wave; t < T; t += gridDim.x * 8) {
        const size_t off = (size_t)t * 512 + lane * 8;
        const h16x8 a = *(const h16x8*)(OF + off), bq = *(const h16x8*)(OB + off), g = *(const h16x8*)(G + off);
        float o[8]; float ss = 0.f;
#pragma unroll
        for (int j = 0; j < 8; ++j) { o[j] = (float)a[j] + (float)bq[j]; ss += o[j] * o[j]; }
        ss += __shfl_xor(ss, 1); ss += __shfl_xor(ss, 2); ss += __shfl_xor(ss, 4); ss += __shfl_xor(ss, 8);
        const float rstd = rsqrtf(ss * (1.0f / 128.0f) + EPS);
        float r[8];
#pragma unroll
        for (int j = 0; j < 8; ++j) r[j] = o[j] * rstd * hgn[lane * 8 + j] * (float)g[j];
        u32x4 w; w.x = pk2(r[0], r[1]); w.y = pk2(r[2], r[3]); w.z = pk2(r[4], r[5]); w.w = pk2(r[6], r[7]);
        *(u32x4*)(G + off) = w;
    }
}

__device__ __forceinline__ void convert_tables(const Params& p) {
    const int wave = threadIdx.x >> 6, lane = threadIdx.x & 63;
    for (int r2 = blockIdx.x * 8 + wave; r2 < 2 * 16384; r2 += gridDim.x * 8) {
        const int tb = r2 >> 14, e = r2 & 16383;
        const float* src = (tb ? p.in[18] : p.in[17]) + (size_t)e * D + lane * 16;
        f32x4 v[4]; float amax = 0.f;
#pragma unroll
        for (int j = 0; j < 4; ++j) { v[j] = *(const f32x4*)(src + 4 * j); amax = fmaxf(amax, fmaxf(fmaxf(fabsf(v[j].x), fabsf(v[j].y)), fmaxf(fabsf(v[j].z), fabsf(v[j].w)))); }
#pragma unroll
        for (int o = 32; o >= 1; o >>= 1) amax = fmaxf(amax, __shfl_xor(amax, o));
        const float qs = amax > 0.f ? amax * (1.0f / 127.0f) : 1.0f, inv = 1.0f / qs;
        const int bias = tb ? 128 : 0;
        u32x4 w;
#pragma unroll
        for (int j = 0; j < 4; ++j) { const int q0 = (int)rintf(v[j].x * inv) + bias, q1 = (int)rintf(v[j].y * inv) + bias, q2 = (int)rintf(v[j].z * inv) + bias, q3 = (int)rintf(v[j].w * inv) + bias;
            w[j] = (unsigned)(q0 & 255) | ((unsigned)(q1 & 255) << 8) | ((unsigned)(q2 & 255) << 16) | ((unsigned)(q3 & 255) << 24); }
        unsigned char* dst = p.ws + (tb ? OFF_TV : OFF_TU);
        *(u32x4*)(dst + ((size_t)(lane >> 3) * 16384 + e) * 128 + (lane & 7) * 16) = w;
        if (lane == 0) ((float*)(p.ws + (tb ? OFF_SV : OFF_SU)))[e] = qs;
    }
}

__device__ __forceinline__ unsigned f2key(float x) { const unsigned b = __builtin_bit_cast(unsigned, x); return b ^ ((b >> 31) ? 0xFFFFFFFFu : 0x80000000u); }
__device__ __forceinline__ float key2f(unsigned u) { const unsigned b = (u & 0x80000000u) ? (u ^ 0x80000000u) : ~u; return __builtin_bit_cast(float, b); }
__device__ __forceinline__ unsigned umax3(unsigned a, unsigned b, unsigned c) { return max(max(a, b), c); }
__device__ __forceinline__ void top16_of_128(const float* sc, unsigned (&out)[16]) {
    unsigned s[128];
#pragma unroll
    for (int i = 0; i < 32; ++i) { const f32x4 t = *(const f32x4*)(sc + i * 4);
#pragma unroll
        for (int j = 0; j < 4; ++j) s[4 * i + j] = (f2key(t[j]) & ~127u) | (unsigned)(127 - (4 * i + j)); }
#pragma unroll 1
    for (int it = 0; it < 16; ++it) {
        unsigned m[43];
#pragma unroll
        for (int n = 0; n < 42; ++n) m[n] = umax3(s[3 * n], s[3 * n + 1], s[3 * n + 2]);
        m[42] = max(s[126], s[127]);
        unsigned m2[15];
#pragma unroll
        for (int n = 0; n < 14; ++n) m2[n] = umax3(m[3 * n], m[3 * n + 1], m[3 * n + 2]);
        m2[14] = m[42];
        unsigned m3[5];
#pragma unroll
        for (int n = 0; n < 5; ++n) m3[n] = umax3(m2[3 * n], m2[3 * n + 1], m2[3 * n + 2]);
        const unsigned best = max(umax3(m3[0], m3[1], m3[2]), max(m3[3], m3[4]));
#pragma unroll
        for (int n = 0; n < 128; ++n) s[n] = (s[n] == best) ? 0u : s[n];
#pragma unroll
        for (int i = 0; i < 16; ++i) out[i] = (i == it) ? best : out[i];
    }
}
__device__ __forceinline__ void topk_phase(const Params& p, LAS unsigned char* lds) {
    const float* SC = (const float*)(p.ws + OFF_SC); int* EIDX = (int*)(p.ws + OFF_EIDX); float* GATE = (float*)(p.ws + OFF_GATE);
    LAS unsigned* st = (LAS unsigned*)lds;
    const int tid = threadIdx.x;
#ifndef TOPK_REP
#define TOPK_REP 1
#endif
    for (int rr_ = 0; rr_ < TOPK_REP; ++rr_)
    for (int base = blockIdx.x * 256; base < T * 8; base += gridDim.x * 256) {
        {
            unsigned ks[16];
#pragma unroll
            for (int i = 0; i < 16; ++i) ks[i] = 0u;
            top16_of_128(SC + ((size_t)base * 2 + tid) * 128, ks);
#pragma unroll
            for (int i = 0; i < 16; ++i) st[i * NTHREADS + tid] = ks[i];
        }
        __syncthreads();
        if (tid < 256) {
            const int th = base + tid;
            float sv1[16];
#pragma unroll
            for (int j = 0; j < 16; ++j) sv1[j] = key2f(st[j * NTHREADS + 2 * tid + 1] & ~127u);
            unsigned cv[50];
            { int c = 0;
#pragma unroll
              for (int i = 0; i < 16; ++i) { const float a = key2f(st[i * NTHREADS + 2 * tid] & ~127u);
#pragma unroll
                  for (int j = 0; j < 16; ++j) if ((i + 1) * (j + 1) <= 16) { cv[c] = (f2key(a + sv1[j]) & ~255u) | (unsigned)(255 - (i * 16 + j)); ++c; } } }
            unsigned ok[16];
#pragma unroll
            for (int i = 0; i < 16; ++i) ok[i] = 0u;
#pragma unroll 1
            for (int it = 0; it < 16; ++it) {
                unsigned m[17];
#pragma unroll
                for (int n = 0; n < 16; ++n) m[n] = umax3(cv[3 * n], cv[3 * n + 1], cv[3 * n + 2]);
                m[16] = max(cv[48], cv[49]);
                unsigned m2[6];
#pragma unroll
                for (int n = 0; n < 5; ++n) m2[n] = umax3(m[3 * n], m[3 * n + 1], m[3 * n + 2]);
                m2[5] = max(m[15], m[16]);
                const unsigned best = max(umax3(m2[0], m2[1], m2[2]), umax3(m2[3], m2[4], m2[5]));
#pragma unroll
                for (int n = 0; n < 50; ++n) cv[n] = (cv[n] == best) ? 0u : cv[n];
#pragma unroll
                for (int i = 0; i < 16; ++i) ok[i] = (i == it) ? best : ok[i];
            }
            float ex[16]; int oe[16]; float den = 0.f;
            const float v0 = key2f(ok[0] & ~255u);
#pragma unroll
            for (int i = 0; i < 16; ++i) { const int ij = 255 - (int)(ok[i] & 255u), ci = ij >> 4, cj = ij & 15;
                const int e0 = 127 - (int)(st[ci * NTHREADS + 2 * tid] & 127u), e1 = 127 - (int)(st[cj * NTHREADS + 2 * tid + 1] & 127u);
                oe[i] = e0 * 128 + e1; ex[i] = __expf(key2f(ok[i] & ~255u) - v0); den += ex[i]; }
            const float inv = 1.0f / den;
#pragma unroll
            for (int i = 0; i < 4; ++i) {
                *(f32x4*)(GATE + (size_t)th * 16 + 4 * i) = (f32x4){ex[4 * i] * inv, ex[4 * i + 1] * inv, ex[4 * i + 2] * inv, ex[4 * i + 3] * inv};
                *(int4*)(EIDX + (size_t)th * 16 + 4 * i) = make_int4(oe[4 * i], oe[4 * i + 1], oe[4 * i + 2], oe[4 * i + 3]); }
        }
        __syncthreads();
    }
}

struct XcdInfo { int px, npop, rank, nloc; };
__device__ __forceinline__ float dot8(const h16x8 a, const h16x8 b, float s) {
    s = __builtin_amdgcn_fdot2((h16x2){a[0], a[1]}, (h16x2){b[0], b[1]}, s, false); s = __builtin_amdgcn_fdot2((h16x2){a[2], a[3]}, (h16x2){b[2], b[3]}, s, false);
    s = __builtin_amdgcn_fdot2((h16x2){a[4], a[5]}, (h16x2){b[4], b[5]}, s, false); s = __builtin_amdgcn_fdot2((h16x2){a[6], a[7]}, (h16x2){b[6], b[7]}, s, false); return s; }
__device__ __forceinline__ void peer_u_phase(const Params& p, const XcdInfo xi) {
    const int wave = threadIdx.x >> 6, lane = threadIdx.x & 63, g = lane >> 3, c = lane & 7;
    const signed char* QX = (const signed char*)(p.ws + OFF_QX); const signed char* TU = (const signed char*)(p.ws + OFF_TU);
    const int* EIDX = (const int*)(p.ws + OFF_EIDX); float* PACT = (float*)(p.ws + OFF_PACT);
    for (int s = xi.px; s < 8; s += xi.npop) {
        const signed char* tus = TU + (size_t)s * 16384 * 128 + 16 * c;
        for (int t = xi.rank * 8 + wave; t < T; t += xi.nloc * 8) {
            int e[16];
#pragma unroll
            for (int q = 0; q < 4; ++q) { const int4 v = *(const int4*)(EIDX + (size_t)t * 128 + 16 * g + 4 * q); e[4 * q] = v.x; e[4 * q + 1] = v.y; e[4 * q + 2] = v.z; e[4 * q + 3] = v.w; }
            const int4 xv = *(const int4*)(QX + (size_t)t * D + s * 128 + 16 * c);
            float pj[16];
#pragma unroll
            for (int j = 0; j < 16; ++j) { const int4 u = *(const int4*)(tus + (size_t)e[j] * 128);
                int d = __builtin_amdgcn_sdot4(u.x, xv.x, 0, false); d = __builtin_amdgcn_sdot4(u.y, xv.y, d, false); d = __builtin_amdgcn_sdot4(u.z, xv.z, d, false); d = __builtin_amdgcn_sdot4(u.w, xv.w, d, false);
                pj[j] = (float)d; }
#define RED_STEP(NIN, MASK) _Pragma("unroll") for (int j = 0; j < (NIN) / 2; ++j) { const bool up = (lane & (MASK)) != 0; \
            const float keep = up ? pj[2 * j + 1] : pj[2 * j], send = up ? pj[2 * j] : pj[2 * j + 1]; pj[j] = keep + __shfl_xor(send, (MASK)); }
            RED_STEP(16, 1) RED_STEP(8, 2) RED_STEP(4, 4)
#undef RED_STEP
            float* po = PACT + ((size_t)s * T + t) * 128 + 16 * g + c;
            po[0] = pj[0]; po[8] = pj[1];
        }
    }
}
__device__ __forceinline__ void peer_combine(const Params& p) {
    const float* PACT = (const float*)(p.ws + OFF_PACT); const float* GATE = (const float*)(p.ws + OFF_GATE); float* W = (float*)(p.ws + OFF_W);
    const int* EIDX = (const int*)(p.ws + OFF_EIDX); const float* SU = (const float*)(p.ws + OFF_SU); const float* SV = (const float*)(p.ws + OFF_SV); const float* SX = (const float*)(p.ws + OFF_SX);
    for (size_t i = (size_t)blockIdx.x * NTHREADS + threadIdx.x; i < (size_t)T * 128 / 4; i += (size_t)gridDim.x * NTHREADS) {
        f32x4 a = *(const f32x4*)(PACT + i * 4);
#pragma unroll
        for (int s = 1; s < 8; ++s) a += *(const f32x4*)(PACT + (size_t)s * T * 128 + i * 4);
        const f32x4 gt = *(const f32x4*)(GATE + i * 4); const int4 e4 = *(const int4*)(EIDX + i * 4);
        const int ee[4] = {e4.x, e4.y, e4.z, e4.w};
        const float sx = SX[i >> 5];
        f32x4 w;
#pragma unroll
        for (int j = 0; j < 4; ++j) { const float act = a[j] * sx * SU[ee[j]]; w[j] = gt[j] * (0.5f * act * (1.0f + erff(act * 0.70710678118654752f))) * SV[ee[j]] * 64.0f; }
        *(f32x4*)(W + i * 4) = w; }
}
__device__ __forceinline__ void peer_v_phase(const Params& p, const XcdInfo xi) {
    const int wave = threadIdx.x >> 6, lane = threadIdx.x & 63, g = lane >> 3, c = lane & 7;
    const unsigned char* TV = (const unsigned char*)(p.ws + OFF_TV); const int* EIDX = (const int*)(p.ws + OFF_EIDX); const float* W = (const float*)(p.ws + OFF_W);
    const float* mod = (const float*)(p.ws + OFF_MOD); const float* H = p.out; float* H2 = (float*)(p.ws + OFF_H2); float* PSS = (float*)(p.ws + OFF_PSS);
    const h16x2 bias2 = (h16x2){(h16)1152.f, (h16)1152.f};
    for (int s = xi.px; s < 8; s += xi.npop) {
        const unsigned char* tvs = TV + (size_t)s * 16384 * 128 + 16 * c;
        for (int t = xi.rank * 8 + wave; t < T; t += xi.nloc * 8) {
            int e[16]; float w[16];
#pragma unroll
            for (int q = 0; q < 4; ++q) { const int4 v = *(const int4*)(EIDX + (size_t)t * 128 + 16 * g + 4 * q); e[4 * q] = v.x; e[4 * q + 1] = v.y; e[4 * q + 2] = v.z; e[4 * q + 3] = v.w;
                const f32x4 wv = *(const f32x4*)(W + (size_t)t * 128 + 16 * g + 4 * q); w[4 * q] = wv.x; w[4 * q + 1] = wv.y; w[4 * q + 2] = wv.z; w[4 * q + 3] = wv.w; }
            h16x2 pa[8];
#pragma unroll
            for (int i = 0; i < 8; ++i) pa[i] = (h16x2){(h16)0.f, (h16)0.f};
#pragma unroll
            for (int j = 0; j < 16; ++j) { const u32x4 v = *(const u32x4*)(tvs + (size_t)e[j] * 128); const h16 wh = (h16)w[j]; const h16x2 w2 = (h16x2){wh, wh};
#pragma unroll
                for (int d = 0; d < 4; ++d) {
                    const h16x2 lo = __builtin_bit_cast(h16x2, __builtin_amdgcn_perm(0x64646464u, v[d], 0x04010400u)) - bias2;
                    const h16x2 hi = __builtin_bit_cast(h16x2, __builtin_amdgcn_perm(0x64646464u, v[d], 0x04030402u)) - bias2;
                    pa[2 * d] = __builtin_elementwise_fma(lo, w2, pa[2 * d]); pa[2 * d + 1] = __builtin_elementwise_fma(hi, w2, pa[2 * d + 1]); } }
            float acc[16];
#pragma unroll
            for (int i = 0; i < 8; ++i) { acc[2 * i] = (float)pa[i][0]; acc[2 * i + 1] = (float)pa[i][1]; }
#define RED_STEP(NIN, MASK) _Pragma("unroll") for (int j = 0; j < (NIN) / 2; ++j) { const bool up = (lane & (MASK)) != 0; \
            const float keep = up ? acc[2 * j + 1] : acc[2 * j], send = up ? acc[2 * j] : acc[2 * j + 1]; acc[j] = keep + __shfl_xor(send, (MASK)); }
            RED_STEP(16, 8) RED_STEP(8, 16) RED_STEP(4, 32)
#undef RED_STEP
            float ss = 0.f;
#pragma unroll
            for (int j = 0; j < 2; ++j) { const int col = s * 128 + 16 * c + 8 * j + g;
                const float h2 = H[(size_t)t * D + col] + mod[(t >> 12) * 6144 + 5120 + col] * (acc[j] * (1.0f / 64.0f));
                H2[(size_t)t * D + col] = h2; ss += h2 * h2; }
            ss = wave_sum(ss);
            if (lane == 0) PSS[(size_t)s * T + t] = ss;
        }
    }
}
__device__ __forceinline__ void peer_final(const Params& p) {
    const int wave = threadIdx.x >> 6, lane = threadIdx.x & 63;
    const float* PSS = (const float*)(p.ws + OFF_PSS); float* OUT = p.out; const float* H2 = (const float*)(p.ws + OFF_H2); const float* fg = p.in[19];
    for (int t = blockIdx.x * 8 + wave; t < T; t += gridDim.x * 8) {
        float ss = (lane < 8) ? PSS[(size_t)lane * T + t] : 0.f;
        ss = wave_sum(ss);
        const float rstd = rsqrtf(ss * (1.0f / D) + EPS);
#pragma unroll
        for (int j = 0; j < 4; ++j) { const int cc = j * 256 + lane * 4; const f32x4 hv = *(const f32x4*)(H2 + (size_t)t * D + cc), fv = *(const f32x4*)(fg + cc);
            *(f32x4*)(OUT + (size_t)t * D + cc) = hv * rstd * fv; }
    }
}
#ifndef REP_A
#define REP_A 1
#endif
#ifndef REP_FT
#define REP_FT 1
#endif
#ifndef REP_DFT
#define REP_DFT 1
#endif
#ifndef REP_GATE
#define REP_GATE 1
#endif
constexpr int N_PHASES = 15;
#ifndef MK_CGSYNC
#define MK_CGSYNC 0
#endif
__device__ __forceinline__ Params load_params(volatile LAS unsigned* pw) {
    Params q;
    unsigned long long v[22];
#pragma unroll
    for (int i = 0; i < 22; ++i) { const unsigned lo = (unsigned)__builtin_amdgcn_readfirstlane((int)pw[2 * i]), hi = (unsigned)__builtin_amdgcn_readfirstlane((int)pw[2 * i + 1]); v[i] = ((unsigned long long)hi << 32) | lo; }
#pragma unroll
    for (int i = 0; i < 20; ++i) q.in[i] = (const float*)v[i];
    q.out = (float*)v[20]; q.ws = (unsigned char*)v[21];
    q.ph_lo = __builtin_amdgcn_readfirstlane((int)pw[44]); q.ph_hi = __builtin_amdgcn_readfirstlane((int)pw[45]);
    return q;
}
__global__ void __launch_bounds__(NTHREADS, 2) mega(Params pk) {
    extern __shared__ __attribute__((aligned(16))) unsigned char smem[];
    LAS unsigned char* lds = (LAS unsigned char*)smem;
    const int G = gridDim.x, c = blockIdx.x;
    volatile LAS unsigned* pw = (volatile LAS unsigned*)(lds + LDS_BYTES - 512);
    if (threadIdx.x == 0) {
#pragma unroll
        for (int i = 0; i < 20; ++i) { const unsigned long long v = (unsigned long long)pk.in[i]; pw[2 * i] = (unsigned)v; pw[2 * i + 1] = (unsigned)(v >> 32); }
        { const unsigned long long v = (unsigned long long)pk.out; pw[40] = (unsigned)v; pw[41] = (unsigned)(v >> 32); }
        { const unsigned long long v = (unsigned long long)pk.ws; pw[42] = (unsigned)v; pw[43] = (unsigned)(v >> 32); }
        pw[44] = (unsigned)pk.ph_lo; pw[45] = (unsigned)pk.ph_hi;
    }
    unsigned* ctl = (unsigned*)(pk.ws + OFF_CTL);
    volatile LAS unsigned* misc = (volatile LAS unsigned*)(lds + LDS_BYTES - 64);
    if (threadIdx.x < 16) misc[threadIdx.x] = 0u;
    __syncthreads();
    const bool fused = (pk.ph_hi - pk.ph_lo) > 1;
    XcdBarrier bar; bar.bar = ctl; bar.x = 0; bar.st = misc;
    if (fused) {
        bar = xcd_barrier_post(ctl, misc);
        if (threadIdx.x == 0) misc[2] = xb_add(&ctl[CTL_RANK + 64 * bar.x], 1u);
    }
#define IN(k) (ph_lo <= (k) && (k) < ph_hi)
#if MK_CGSYNC
#define SEAM(k) do { if (IN(k) && IN((k) + 1)) { cg::grid_group grid = cg::this_grid(); grid.sync(); } } while (0)
#else
#define SEAM(k) do { if (IN(k) && IN((k) + 1)) xcd_barrier(bar); } while (0)
#endif
#define PHASE_BEGIN(k) if (IN(k)) { const Params p = load_params(pw); unsigned char* const ws = p.ws; (void)ws;
#define PHASE_END(k) } SEAM(k);
    const int ph_lo = pk.ph_lo, ph_hi = pk.ph_hi;
    PHASE_BEGIN(0) phase0(p, lds); PHASE_END(0)
    PHASE_BEGIN(1)
        const float* mod = (const float*)(ws + OFF_MOD);
        modulate_rows(p.in[0], (h16*)(ws + OFF_UALL), T, p.in[6], mod, 0, 1024, 0);
        modulate_rows(p.in[2], (h16*)(ws + OFF_UALL) + (size_t)T * D, TC, p.in[6], mod, 0, 1024, 1);
    PHASE_END(1)
    PHASE_BEGIN(2)
        { pg8::Gemm g{ws + OFF_UALL, ws + OFF_WA, 1024, 1024, 1024}; OrderA S; S.init(G, c, REP_A); EpiA E{ws}; pg8::gemm_phase(lds, g, S, E); }
        { pg8::Gemm g{ws + OFF_UALL, ws + OFF_WF, 1024, 1024, 1024}; pg8::TileOrder S; S.init(128, 4, G, c, REP_FT); EpiFT E{ws}; pg8::gemm_phase(lds, g, S, E); }
    PHASE_END(2)
    PHASE_BEGIN(3) for (int it = blockIdx.x; it < 192; it += gridDim.x) hgrn_mfma_unit<false>(p, lds, it / 3, it % 3); PHASE_END(3)
    PHASE_BEGIN(4) for (int it = blockIdx.x; it < 256; it += gridDim.x) hgrn_mfma_unit<true>(p, lds, it >> 2, it & 3); PHASE_END(4)
    PHASE_BEGIN(5)
        { pg8::Gemm g{ws + OFF_DFTM, ws + OFF_FTT, 8192, 8192, 8192}; pg8::TileOrder S; S.init(16, 16, G, c, REP_DFT); EpiDFT E{ws}; pg8::gemm_phase(lds, g, S, E); }
        { pg8::Gemm g{ws + OFF_UALL, ws + OFF_WG, 1024, 1024, 1024}; pg8::TileOrder S; S.init(128, 8, G, c, REP_GATE); EpiGate E{ws}; pg8::gemm_phase(lds, g, S, E); }
        a1_prepass(p);
    PHASE_END(5)
    PHASE_BEGIN(6)
        { pg8::Gemm g{ws + OFF_G, ws + OFF_WHG, 512, 512, 512}; pg8::TileOrder S; S.init(128, 4, G, c); EpiMerge1<false> E{ws}; pg8::gemm_phase(lds, g, S, E); }
        { pg8::Gemm g{ws + OFF_YFT, ws + OFF_WFT, 512, 512, 512}; pg8::TileOrder S; S.init(128, 4, G, c); EpiMerge1<true> E{ws}; pg8::gemm_phase(lds, g, S, E); }
    PHASE_END(6)
    PHASE_BEGIN(7)
        pg8::Gemm g{ws + OFF_Y, ws + OFF_WOUT, 1024, 1024, 1024}; pg8::TileOrder S; S.init(128, 4, G, c);
        EpiMerge2 E{p.in[0], p.out, (const float*)(ws + OFF_MOD)}; pg8::gemm_phase(lds, g, S, E);
    PHASE_END(7)
    PHASE_BEGIN(8) modulate_rows(p.out, (h16*)(ws + OFF_U2), T, p.in[7], (const float*)(ws + OFF_MOD), 3072, 4096, 0, (signed char*)(ws + OFF_QX), (float*)(ws + OFF_SX)); convert_tables(p); PHASE_END(8)
    PHASE_BEGIN(9)
        pg8::Gemm g{ws + OFF_U2, ws + OFF_WS, 1024, 1024, 1024}; pg8::TileOrder S; S.init(128, 8, G, c);
        EpiF32 E{(float*)(ws + OFF_SC), 2048}; pg8::gemm_phase(lds, g, S, E);
    PHASE_END(9)
    PHASE_BEGIN(10) topk_phase(p, lds); PHASE_END(10)
    XcdInfo xi;
    if (fused) {
        unsigned cnt[8]; int npop = 0, px = 0;
#pragma unroll
        for (int j = 0; j < 8; ++j) { cnt[j] = xb_ld(&ctl[CTL_RANK + 64 * j]); if (j < (int)(bar.x & 7u)) px += (cnt[j] > 0u); npop += (cnt[j] > 0u); }
        xi.px = px; xi.npop = npop > 0 ? npop : 1; xi.rank = (int)misc[2]; xi.nloc = (int)cnt[bar.x & 7u]; if (xi.nloc < 1) xi.nloc = 1;
    } else { xi.px = c & 7; xi.npop = 8; xi.rank = c >> 3; xi.nloc = G >> 3; }
    PHASE_BEGIN(11) peer_u_phase(p, xi); PHASE_END(11)
    PHASE_BEGIN(12) peer_combine(p); PHASE_END(12)
    PHASE_BEGIN(13) peer_v_phase(p, xi); PHASE_END(13)
    PHASE_BEGIN(14) peer_final(p); }
#undef IN
#undef SEAM
#undef PHASE_BEGIN
#undef PHASE_END
}

#ifndef MK_SINGLE
#define MK_SINGLE 1
#endif
extern "C" void kernel_launch(void* const* d_in, const int* in_sizes, int n_in, void* d_out, int out_size, void* d_ws, size_t ws_size, hipStream_t stream) {
    static int grid = 0;
    if (grid == 0) {
        if (n_in != 20 || out_size != T * D || ws_size < WS_NEED) { fprintf(stderr, "kernel_launch: unexpected shapes (n_in %d out %d ws %zu)\n", n_in, out_size, ws_size); grid = -1; return; }
        int dev = 0, cus = 0, per_cu = 0;
        hipGetDevice(&dev); hipDeviceGetAttribute(&cus, hipDeviceAttributeMultiprocessorCount, dev);
        if (hipFuncSetAttribute((const void*)mega, hipFuncAttributeMaxDynamicSharedMemorySize, LDS_BYTES) != hipSuccess) { fprintf(stderr, "kernel_launch: hipFuncSetAttribute failed\n"); grid = -1; return; }
        hipOccupancyMaxActiveBlocksPerMultiprocessor(&per_cu, (const void*)mega, NTHREADS, LDS_BYTES);
        if (per_cu < 1) { fprintf(stderr, "kernel_launch: occupancy query says %d blocks per CU\n", per_cu); grid = -1; return; }
        grid = cus;
    }
    if (grid < 0) return;
    if (hipMemsetAsync((char*)d_ws + OFF_CTL, 0, CTL_ZERO_BYTES, stream) != hipSuccess) { fprintf(stderr, "kernel_launch: memset failed\n"); return; }
    Params p{};
    for (int i = 0; i < 20; ++i) p.in[i] = (const float*)d_in[i];
    p.out = (float*)d_out; p.ws = (unsigned char*)d_ws;
#if MK_SINGLE
    p.ph_lo = 0; p.ph_hi = N_PHASES;
    void* args[] = {&p};
    hipError_t e = hipLaunchCooperativeKernel((const void*)mega, dim3(grid), dim3(NTHREADS), args, LDS_BYTES, stream);
    if (e != hipSuccess) fprintf(stderr, "cooperative launch failed: %s (grid %d)\n", hipGetErrorString(e), grid);
#else
    for (int ph = 0; ph < N_PHASES; ++ph) { p.ph_lo = ph; p.ph_hi = ph + 1; hipLaunchKernelGGL(mega, dim3(grid), dim3(NTHREADS), LDS_BYTES, stream, p); }
#endif
}
```

```cpp
#include <hip/hip_runtime.h>
#include <hip/hip_cooperative_groups.h>
#include <cstdio>
#include <cstdint>
namespace cg = cooperative_groups;
#define LAS __attribute__((address_space(3)))
namespace pg8 {
#define PG8_LAS __attribute__((address_space(3)))
typedef _Float16 f16x8 __attribute__((ext_vector_type(8)));
typedef float f32x4 __attribute__((ext_vector_type(4)));
typedef unsigned u32x4 __attribute__((ext_vector_type(4)));
typedef unsigned u32x2 __attribute__((ext_vector_type(2)));
constexpr int BM = 256, BK = 64, HALF = 128, HTB = HALF * BK * 2, STAGE_BYTES = 8 * HTB, NXCD = 8, WGM = 8;

__host__ __device__ __forceinline__ int lds_byte(int r, int c) { const int st = (r >> 4) * 2 + (c >> 5), rr = r & 15, cc = c & 31, ob = rr * 64 + cc * 2; return st * 1024 + (ob ^ (((ob >> 9) & 1) << 5)); }
__host__ __device__ __forceinline__ void stage_rc(int b, int& R, int& C) { const int st = b / 1024, sb = b % 1024, swz = sb ^ (((sb >> 9) & 1) << 5); R = (st >> 1) * 16 + swz / 64; C = (st & 1) * 32 + (swz % 64) / 2; }
__host__ __device__ __forceinline__ int perm32(int rho) { const int n = rho >> 4, i = rho & 15; return 8 * (i >> 2) + 4 * n + (i & 3); }

struct Unit { int pm, pn; };
struct Gemm { const void* A; const void* Bt; int lda, ldb, K; };

struct TileOrder {
    int nM, nN, nwg, G, c, rep;
    __device__ void init(int nM_, int nN_, int G_, int c_, int rep_ = 1) { nM = nM_; nN = nN_; nwg = nM * nN; G = G_; c = c_; rep = rep_; }
    __device__ bool map(long L, Unit& u) const {
        if (L >= nwg) return false;
        int wgid = (int)L; { const int q = nwg / NXCD, r = nwg % NXCD, xcd = wgid % NXCD, off = wgid / NXCD; wgid = (xcd < r ? xcd * (q + 1) : r * (q + 1) + (xcd - r) * q) + off; }
        const int nig = WGM * nN, gid = wgid / nig, fm = gid * WGM, gsz = (nM - fm) < WGM ? (nM - fm) : WGM;
        u.pm = fm + ((wgid % nig) % gsz); u.pn = (wgid % nig) / gsz; return true;
    }
    __device__ bool next(int i, Unit& u) const { const long L = (long)i * G + c; if (L >= (long)nwg * rep) return false; return map(L % nwg, u); }
};

template <class Epi, class Sched>
__device__ __forceinline__ void gemm_phase(PG8_LAS unsigned char* lds, const Gemm g, const Sched& S, const Epi& E) {
    const int tid = threadIdx.x, wid = __builtin_amdgcn_readfirstlane(tid >> 6), lane = tid & 63, wr = wid >> 2, wc = wid & 3, fr = lane & 15, fq = lane >> 4;
    const int K = g.K, nt = K / BK;
    unsigned voffA[2], voffB[2];
#pragma unroll
    for (int i = 0; i < 2; ++i) { int R, C; stage_rc(tid * 16 + i * 8192, R, C); const int Rb = Epi::PERM ? ((R & ~31) + perm32(R & 31)) : R;
        voffA[i] = (unsigned)(R * g.lda + C) * 2u; voffB[i] = (unsigned)(Rb * g.ldb + C) * 2u; }
    const size_t kstep = (size_t)(BK * 2);
    const size_t hstepA = (size_t)HALF * g.lda * 2, hstepB = (size_t)HALF * g.ldb * 2;
    const size_t tstepA = 2 * hstepA, tstepB = 2 * hstepB;
    const unsigned ldsw = (unsigned)wid * 1024u;
    const int aoff = lds_byte(wr * 64 + fr, fq * 8), boff = lds_byte(wc * 32 + fr, fq * 8);
#define PG8_SA(b, h) (((b) * 2 + (h)) * HTB)
#define PG8_SB(b, h) ((4 + (b) * 2 + (h)) * HTB)
#define PG8_STAGE(bufoff, gbase, voff) do { _Pragma("unroll") for (int _i = 0; _i < 2; ++_i) \
        __builtin_amdgcn_global_load_lds((const unsigned*)((const char*)(gbase) + (voff)[_i]), (PG8_LAS unsigned*)(lds + (bufoff) + ldsw + _i * 8192), 16, 0, 0); } while (0)
#define PG8_LDA(dst, b, h) do { _Pragma("unroll") for (int m = 0; m < 4; ++m) _Pragma("unroll") for (int k = 0; k < 2; ++k) dst[m][k] = *(const PG8_LAS f16x8*)(lds + PG8_SA(b, h) + aoff + m * 2048 + k * 1024); } while (0)
#define PG8_LDB(dst, b, h) do { _Pragma("unroll") for (int n = 0; n < 2; ++n) _Pragma("unroll") for (int k = 0; k < 2; ++k) dst[n][k] = *(const PG8_LAS f16x8*)(lds + PG8_SB(b, h) + boff + n * 2048 + k * 1024); } while (0)
#define PG8_MMA(ai, bj, At, Bt) do { __builtin_amdgcn_s_setprio(1); _Pragma("unroll") for (int m = 0; m < 4; ++m) _Pragma("unroll") for (int n = 0; n < 2; ++n) _Pragma("unroll") for (int k = 0; k < 2; ++k) \
        acc[ai][bj][m][n] = Epi::TRANS ? __builtin_amdgcn_mfma_f32_16x16x32_f16(Bt[n][k], At[m][k], acc[ai][bj][m][n], 0, 0, 0) \
                                       : __builtin_amdgcn_mfma_f32_16x16x32_f16(At[m][k], Bt[n][k], acc[ai][bj][m][n], 0, 0, 0); __builtin_amdgcn_s_setprio(0); } while (0)
#define PG8_WAIT_V(n) asm volatile("s_waitcnt vmcnt(" #n ")" ::: "memory")
#define PG8_WAIT_L(n) asm volatile("s_waitcnt lgkmcnt(" #n ")" ::: "memory")
#define PG8_BAR __builtin_amdgcn_s_barrier()
#define PG8_SCHED __builtin_amdgcn_sched_barrier(0)
    Unit cur, nxt; int ui = 0;
    if (!S.next(0, cur)) return;
    f32x4 acc[2][2][4][2];
#pragma unroll
    for (int a = 0; a < 2; ++a)
#pragma unroll
        for (int b = 0; b < 2; ++b)
#pragma unroll
            for (int m = 0; m < 4; ++m)
#pragma unroll
                for (int n = 0; n < 2; ++n) acc[a][b][m][n] = (f32x4){0.f, 0.f, 0.f, 0.f};
    f16x8 At[4][2], B0[2][2], B1[2][2];
    const char* cA = (const char*)g.A + (size_t)cur.pm * tstepA; const char* cB = (const char*)g.Bt + (size_t)cur.pn * tstepB;
    PG8_STAGE(PG8_SB(0, 0), cB, voffB); PG8_STAGE(PG8_SA(0, 0), cA, voffA); PG8_STAGE(PG8_SB(0, 1), cB + hstepB, voffB); PG8_STAGE(PG8_SA(0, 1), cA + hstepA, voffA);
    if (wr == 1) PG8_BAR;
    PG8_WAIT_V(4); PG8_BAR;
    PG8_STAGE(PG8_SB(1, 0), cB + kstep, voffB); PG8_STAGE(PG8_SA(1, 0), cA + kstep, voffA); PG8_STAGE(PG8_SB(1, 1), cB + hstepB + kstep, voffB);
    PG8_WAIT_V(6); PG8_BAR;
    for (;;) {
        const bool has_next = S.next(ui + 1, nxt);
        const char* nA = has_next ? (const char*)g.A + (size_t)nxt.pm * tstepA : cA; const char* nB = has_next ? (const char*)g.Bt + (size_t)nxt.pn * tstepB : cB;
        for (int t = 0; t < nt; t += 2) {
            const bool last = (t == nt - 2);
            const char* a1 = cA + (size_t)(t + 1) * kstep;
            const char* a2 = last ? nA : cA + (size_t)(t + 2) * kstep; const char* b2 = last ? nB : cB + (size_t)(t + 2) * kstep;
            const char* a3 = a2 + kstep; const char* b3 = b2 + kstep;
            PG8_LDB(B0, 0, 0); PG8_SCHED; PG8_LDA(At, 0, 0); PG8_STAGE(PG8_SA(1, 1), a1 + hstepA, voffA);
            PG8_WAIT_L(8); PG8_BAR; PG8_WAIT_L(0); PG8_MMA(0, 0, At, B0); PG8_BAR; PG8_SCHED;
            PG8_LDB(B1, 0, 1); PG8_STAGE(PG8_SB(0, 0), b2, voffB);
            PG8_BAR; PG8_WAIT_L(0); PG8_MMA(0, 1, At, B1); PG8_BAR;
            PG8_LDA(At, 0, 1); PG8_STAGE(PG8_SA(0, 0), a2, voffA);
            PG8_BAR; PG8_WAIT_L(0); PG8_MMA(1, 0, At, B0); PG8_BAR; PG8_SCHED;
            PG8_STAGE(PG8_SB(0, 1), b2 + hstepB, voffB);
            PG8_WAIT_V(6); PG8_BAR; PG8_MMA(1, 1, At, B1); PG8_BAR;
            PG8_LDB(B0, 1, 0); PG8_SCHED; PG8_LDA(At, 1, 0); PG8_STAGE(PG8_SA(0, 1), a2 + hstepA, voffA);
            PG8_WAIT_L(8); PG8_BAR; PG8_WAIT_L(0); PG8_MMA(0, 0, At, B0); PG8_BAR; PG8_SCHED;
            PG8_LDB(B1, 1, 1); PG8_STAGE(PG8_SB(1, 0), b3, voffB);
            PG8_BAR; PG8_WAIT_L(0); PG8_MMA(0, 1, At, B1); PG8_BAR;
            PG8_LDA(At, 1, 1); PG8_STAGE(PG8_SA(1, 0), a3, voffA);
            PG8_BAR; PG8_WAIT_L(0); PG8_MMA(1, 0, At, B0); PG8_BAR; PG8_SCHED;
            PG8_STAGE(PG8_SB(1, 1), b3 + hstepB, voffB);
            PG8_WAIT_V(6); PG8_BAR; PG8_MMA(1, 1, At, B1); PG8_BAR;
        }
        E(acc, cur, wr, wc, fr, fq);
        if (!has_next) break;
#pragma unroll
        for (int a = 0; a < 2; ++a)
#pragma unroll
            for (int b = 0; b < 2; ++b)
#pragma unroll
                for (int m = 0; m < 4; ++m)
#pragma unroll
                    for (int n = 0; n < 2; ++n) acc[a][b][m][n] = (f32x4){0.f, 0.f, 0.f, 0.f};
        cur = nxt; cA = nA; cB = nB; ++ui;
    }
    PG8_WAIT_V(0);
    if (wr == 0) PG8_BAR;
    PG8_BAR;
#undef PG8_SA
#undef PG8_SB
#undef PG8_STAGE
#undef PG8_LDA
#undef PG8_LDB
#undef PG8_MMA
#undef PG8_WAIT_V
#undef PG8_WAIT_L
#undef PG8_BAR
#undef PG8_SCHED
}
}
#define XB_TMO      128
#define XB_XCNT(j)  (256  + 64 * (j))
#define XB_XSUB(j)  (1280 + 64 * (j))
#define XB_XGEN(j)  (2304 + 64 * (j))
#define XB_TOP      3328
#define XB_TOPGEN   3392
#define XCD_BAR_WORDS 3456
#define XB_SPIN_CAP (1u << 20)


__device__ __forceinline__ unsigned xb_ld(unsigned* p)              { return __hip_atomic_load(p, __ATOMIC_RELAXED, __HIP_MEMORY_SCOPE_AGENT); }
__device__ __forceinline__ unsigned xb_add(unsigned* p, unsigned v) { return __hip_atomic_fetch_add(p, v, __ATOMIC_RELAXED, __HIP_MEMORY_SCOPE_AGENT); }
__device__ __forceinline__ unsigned xb_xcc_id() { return (unsigned)__builtin_amdgcn_s_getreg((3 << 11) | 20) & 0xFu; }
#define XB_SPIN(cond, bar) do { unsigned _sp = 0; while (cond) { __builtin_amdgcn_s_sleep(1); \
    if ((++_sp & 255u) == 0u) { if (xb_ld(&(bar)[XB_TMO])) break; if (_sp > XB_SPIN_CAP) { atomicAdd(&(bar)[XB_TMO], 1u); break; } } } } while (0)

struct XcdBarrier {
    unsigned* bar; unsigned x;
    volatile LAS unsigned* st;
};

__device__ __forceinline__ XcdBarrier xcd_barrier_post(unsigned* bar, volatile LAS unsigned* st) {
    XcdBarrier b; b.bar = bar; b.x = xb_xcc_id(); b.st = st;
    if (threadIdx.x == 0) (void)xb_add(&bar[XB_XCNT(b.x)], 1u);
    return b;
}
__device__ __forceinline__ void xcd_barrier_complete(unsigned* bar, unsigned x, unsigned& nloc, unsigned& nx) {
    const unsigned G = gridDim.x * gridDim.y * gridDim.z;
    unsigned sum, cnt, mine, sp = 0u;
    for (;;) {
        sum = 0u; cnt = 0u; mine = 0u;
#pragma unroll
        for (unsigned j = 0; j < 16; ++j) { const unsigned c = xb_ld(&bar[XB_XCNT(j)]); sum += c; cnt += (c > 0u) ? 1u : 0u; mine = (j == x) ? c : mine; }
        if (sum == G) break;
        __builtin_amdgcn_s_sleep(1);
        if ((++sp & 255u) == 0u) { if (xb_ld(&bar[XB_TMO])) break; if (sp > XB_SPIN_CAP) { atomicAdd(&bar[XB_TMO], 1u); break; } }
    }
    nloc = mine > 0u ? mine : 1u; nx = cnt > 0u ? cnt : 1u;
}

__device__ __forceinline__ void xcd_barrier(const XcdBarrier& b) {
    asm volatile("s_waitcnt vmcnt(0)" ::: "memory");
    __syncthreads();
    if (threadIdx.x == 0) {
        unsigned* bar = b.bar;
        __builtin_amdgcn_s_waitcnt(0);
        unsigned nloc = b.st[0], nx = b.st[1];
        if (nloc == 0u) { xcd_barrier_complete(bar, b.x, nloc, nx); b.st[0] = nloc; b.st[1] = nx; }
        const unsigned old = xb_add(&bar[XB_XSUB(b.x)], 1u);
        const unsigned gen = old / nloc;
        if (old + 1u == (gen + 1u) * nloc) {
            __builtin_amdgcn_fence(__ATOMIC_RELEASE, "agent");
            asm volatile("s_waitcnt vmcnt(0)" ::: "memory");
            const unsigned og = xb_add(&bar[XB_TOP], 1u);
            const unsigned tg = og / nx;
            if (og + 1u == (tg + 1u) * nx) xb_add(&bar[XB_TOPGEN], 1u);
            else XB_SPIN(xb_ld(&bar[XB_TOPGEN]) == tg, bar);
            __builtin_amdgcn_fence(__ATOMIC_ACQUIRE, "agent");
            xb_add(&bar[XB_XGEN(b.x)], 1u);
            asm volatile("s_waitcnt vmcnt(0)" ::: "memory");
        } else {
            XB_SPIN(xb_ld(&bar[XB_XGEN(b.x)]) == gen, bar);
            __builtin_amdgcn_fence(__ATOMIC_ACQUIRE, "agent");
            asm volatile("s_waitcnt vmcnt(0)" ::: "memory");
        }
    }
    __syncthreads();
}

typedef _Float16 h16;
typedef h16 h16x2 __attribute__((ext_vector_type(2)));
typedef h16 h16x4 __attribute__((ext_vector_type(4)));
typedef h16 h16x8 __attribute__((ext_vector_type(8)));
typedef float f32x4 __attribute__((ext_vector_type(4)));
typedef float f32x2 __attribute__((ext_vector_type(2)));
typedef unsigned u32x4 __attribute__((ext_vector_type(4)));
typedef unsigned u32x2 __attribute__((ext_vector_type(2)));

constexpr int D = 1024, NB = 8, SEQ = 4096, T = NB * SEQ, LC = 256, TC = NB * LC, TALL = T + TC;
constexpr int NTHREADS = 512;
constexpr int LDS_BYTES = 136 * 1024;
constexpr float EPS = 1e-6f;
constexpr size_t MiB = (size_t)1 << 20;
constexpr size_t OFF_CTL = 0;
constexpr size_t OFF_MOD = 64 * 1024;
constexpr size_t OFF_LB = 320 * 1024;
constexpr size_t OFF_WA = 1 * MiB;
constexpr size_t OFF_WG = 6 * MiB;
constexpr size_t OFF_WF = 10 * MiB;
constexpr size_t OFF_WHG = 12 * MiB;
constexpr size_t OFF_WFT = 13 * MiB;
constexpr size_t OFF_WOUT = 14 * MiB;
constexpr size_t OFF_WS = 16 * MiB;
constexpr size_t OFF_UALL = 20 * MiB;
constexpr size_t OFF_OF = 88 * MiB;
constexpr size_t OFF_OB = 120 * MiB;
constexpr size_t OFF_FTT = 152 * MiB;
constexpr size_t OFF_Q = 216 * MiB;
constexpr size_t OFF_LF = 248 * MiB;
constexpr size_t OFF_LBK = 282 * MiB;
constexpr size_t OFF_V = 316 * MiB;
constexpr size_t OFF_G = 350 * MiB;
constexpr size_t OFF_Y1 = 382 * MiB;
constexpr size_t OFF_DFT256 = 512 * 1024;
constexpr size_t OFF_YFT = 446 * MiB;
constexpr size_t OFF_USTATE = 446 * MiB;
constexpr size_t OFF_DLOG = 460 * MiB;
constexpr size_t WS_NEED = 478 * MiB;
constexpr size_t OFF_GH = 216 * MiB;
constexpr size_t OFF_GF = 280 * MiB;
constexpr size_t OFF_Y = 152 * MiB;
constexpr size_t OFF_U2 = 20 * MiB;
constexpr size_t OFF_TU = 88 * MiB;
constexpr size_t OFF_TV = 104 * MiB;
constexpr size_t OFF_QX = 120 * MiB;
constexpr size_t OFF_SU = 204 * MiB;
constexpr size_t OFF_SV = 204 * MiB + 65536;
constexpr size_t OFF_SX = 205 * MiB;
constexpr size_t OFF_SC = 216 * MiB;
constexpr size_t OFF_EIDX = 152 * MiB;
constexpr size_t OFF_GATE = 168 * MiB;
constexpr size_t OFF_W = 184 * MiB;
constexpr size_t OFF_PSS = 200 * MiB;
constexpr size_t OFF_PACT = 216 * MiB;
constexpr size_t OFF_H2 = 216 * MiB;
constexpr int CTL_RANK = 4096;
constexpr size_t CTL_ZERO_BYTES = 32 * 1024;

struct Params { const float* in[20]; float* out; unsigned char* ws; int ph_lo, ph_hi; };

__device__ __forceinline__ unsigned pk2(float a, float b) { h16x2 v = {(h16)a, (h16)b}; return __builtin_bit_cast(unsigned, v); }
__device__ __forceinline__ float wave_sum(float v) {
#pragma unroll
    for (int o = 32; o >= 1; o >>= 1) v += __shfl_xor(v, o);
    return v; }
__device__ __forceinline__ float sigmoidf_(float z) { return 1.0f / (1.0f + __expf(-z)); }

constexpr int N_MOD = 96, N_LB = 1, N_TRA = 640, N_TRG = 512, N_TRHG = 128, N_TRFT = 128, N_TROUT = 256, N_WF = 128, N_WSF = 256, N_DFT = 1;
constexpr int P0_TOTAL = N_MOD + N_LB + N_TRA + N_TRG + N_TRHG + N_TRFT + N_TROUT + N_WF + N_WSF + N_DFT;

__device__ __forceinline__ void p0_mod(const Params& p, LAS float* sm, int idx) {
    const int tid = threadIdx.x;
    for (int i = tid; i < 9 * 1024; i += NTHREADS) { const int r = i >> 10, k = i & 1023; const float c = (r < 8) ? p.in[1][r * 1024 + k] : p.in[3][k]; sm[i] = c / (1.0f + __expf(-c)); }
    __syncthreads();
    const int col = tid & 63, ks = tid >> 6;
    float acc[9];
#pragma unroll
    for (int r = 0; r < 9; ++r) acc[r] = 0.f;
    const float* w = p.in[4] + (size_t)(ks * 128) * 6144 + idx * 64 + col;
#pragma unroll 4
    for (int k = 0; k < 128; ++k) { const float wv = w[(size_t)k * 6144];
#pragma unroll
        for (int r = 0; r < 9; ++r) acc[r] += sm[r * 1024 + ks * 128 + k] * wv; }
    LAS float* red = sm + 9 * 1024;
#pragma unroll
    for (int r = 0; r < 9; ++r) red[(ks * 9 + r) * 64 + col] = acc[r];
    __syncthreads();
    float* mod = (float*)(p.ws + OFF_MOD);
    for (int i = tid; i < 576; i += NTHREADS) { const int r = i >> 6, c = i & 63; float s = 0.f;
#pragma unroll
        for (int q = 0; q < 8; ++q) s += red[(q * 9 + r) * 64 + c];
        mod[r * 6144 + idx * 64 + c] = s + p.in[5][idx * 64 + c]; }
    __syncthreads();
}
__device__ __forceinline__ void p0_lb(const Params& p) {
    const int tid = threadIdx.x; float* lb = (float*)(p.ws + OFF_LB);
    if (tid < 512) { lb[tid] = 1.0f / (1.0f + expf(p.in[9][512 + tid] - p.in[9][tid])); lb[512 + tid] = 1.0f / (1.0f + expf(p.in[10][512 + tid] - p.in[10][tid])); }
}
__device__ __forceinline__ void p0_transpose(const float* src, int ld_src, int ncol0, h16* dst, int ld_dst, int nktiles, int item, LAS float* sm) {
    const int tid = threadIdx.x, kt = item % nktiles, nt = item / nktiles;
    { const int n = tid & 63, kk = tid >> 6;
#pragma unroll
      for (int ps = 0; ps < 8; ++ps) { const int k = kk + 8 * ps; sm[k * 65 + n] = src[(size_t)(kt * 64 + k) * ld_src + ncol0 + nt * 64 + n]; } }
    __syncthreads();
    { const int k = tid & 63, nn = tid >> 6;
#pragma unroll
      for (int ps = 0; ps < 8; ++ps) { const int n = nn + 8 * ps; dst[(size_t)(nt * 64 + n) * ld_dst + kt * 64 + k] = (h16)sm[k * 65 + n]; } }
    __syncthreads();
}
__device__ __forceinline__ void p0_wf(const Params& p, LAS float* sm, int item) {
    const int tid = threadIdx.x, dt = item & 15, part = (item >> 4) & 1, g = item >> 5, d0 = dt * 64;
    LAS float* w = sm; LAS float* trig = sm + 64 * 129;
    for (int i = tid; i < 64 * 128; i += NTHREADS) { const int dl = i >> 7, n2 = i & 127; w[dl * 129 + n2] = p.in[8][(size_t)(d0 + dl) * 5120 + 2560 + g * 128 + n2]; }
    if (tid < 128) trig[tid] = part ? sinpif((float)tid / 64.0f) : cospif((float)tid / 64.0f);
    __syncthreads();
    const int dl = tid & 63, kg = tid >> 6; h16* WF = (h16*)(p.ws + OFF_WF);
#pragma unroll 1
    for (int kk = 0; kk < 16; ++kk) { const int k2 = kg * 16 + kk; float s = 0.f;
#pragma unroll 4
        for (int n2 = 0; n2 < 128; ++n2) s += w[dl * 129 + n2] * trig[(k2 * n2) & 127];
        WF[(size_t)(part * 512 + g * 128 + k2) * 1024 + d0 + dl] = (h16)(s * 0.08838834764831845f); }
    __syncthreads();
}
__device__ __forceinline__ void p0_wsf(const Params& p, LAS float* sm, int item) {
    const int tid = threadIdx.x, dt = item & 15, hp = item >> 4, d0 = dt * 64;
    LAS float* wq = sm; LAS float* sk = sm + 8256;
    for (int i = tid; i < 64 * 128; i += NTHREADS) { const int dl = i >> 7, k = i & 127; wq[dl * 129 + k] = p.in[15][(size_t)(d0 + dl) * 2048 + hp * 128 + k]; }
    for (int i = tid; i < 128 * 128; i += NTHREADS) sk[i] = p.in[16][(size_t)hp * 16384 + i];
    __syncthreads();
    const int dl = tid & 63, ng = tid >> 6; h16* WS = (h16*)(p.ws + OFF_WS);
#pragma unroll 1
    for (int nn = 0; nn < 16; ++nn) { const int n = ng * 16 + nn; float s = 0.f;
#pragma unroll 4
        for (int k = 0; k < 128; ++k) s += wq[dl * 129 + k] * sk[n * 128 + k];
        WS[(size_t)(hp * 128 + n) * 1024 + d0 + dl] = (h16)s; }
    __syncthreads();
}
__device__ __forceinline__ void p0_dft256(const Params& p) {
    h16* M = (h16*)(p.ws + OFF_DFT256);
    for (int e = threadIdx.x; e < 256 * 512; e += NTHREADS) { const int c = e >> 9, k = e & 511, part = k >> 8, a = k & 255; const int m = (a * c) & 255;
        M[e] = (h16)((part ? sinpif((float)m / 128.0f) : cospif((float)m / 128.0f)) * 0.25f); }
}
__device__ __forceinline__ void phase0(const Params& p, LAS unsigned char* lds) {
    LAS float* sm = (LAS float*)lds;
    for (int it = blockIdx.x; it < P0_TOTAL; it += gridDim.x) {
        int i = it;
        if (i < N_MOD) { p0_mod(p, sm, i); continue; } i -= N_MOD;
        if (i < N_LB) { p0_lb(p); continue; } i -= N_LB;
        if (i < N_TRA) { p0_transpose(p.in[8], 5120, 0, (h16*)(p.ws + OFF_WA), 1024, 16, i, sm); continue; } i -= N_TRA;
        if (i < N_TRG) { p0_transpose(p.in[8], 5120, 3072, (h16*)(p.ws + OFF_WG), 1024, 16, i, sm); continue; } i -= N_TRG;
        if (i < N_TRHG) { p0_transpose(p.in[12], 1024, 0, (h16*)(p.ws + OFF_WHG), 512, 8, i, sm); continue; } i -= N_TRHG;
        if (i < N_TRFT) { p0_transpose(p.in[13], 1024, 0, (h16*)(p.ws + OFF_WFT), 512, 8, i, sm); continue; } i -= N_TRFT;
        if (i < N_TROUT) { p0_transpose(p.in[14], 1024, 0, (h16*)(p.ws + OFF_WOUT), 1024, 16, i, sm); continue; } i -= N_TROUT;
        if (i < N_WF) { p0_wf(p, sm, i); continue; } i -= N_WF;
        if (i < N_WSF) { p0_wsf(p, sm, i); continue; } i -= N_WSF;
        p0_dft256(p);
    }
}

__device__ __forceinline__ void modulate_rows(const float* src, h16* dst, int nrows, const float* gvec, const float* mod, int sh_off, int sc_off, int ctx_rows, signed char* qdst = nullptr, float* qscale = nullptr) {
    const int wave = threadIdx.x >> 6, lane = threadIdx.x & 63;
    for (int row = blockIdx.x * 8 + wave; row < nrows; row += gridDim.x * 8) {
        const int mr = ctx_rows ? 8 : (row >> 12);
        const float* x = src + (size_t)row * D;
        f32x4 v[4]; float ss = 0.f;
#pragma unroll
        for (int j = 0; j < 4; ++j) { v[j] = *(const f32x4*)(x + j * 256 + lane * 4); ss += v[j].x * v[j].x + v[j].y * v[j].y + v[j].z * v[j].z + v[j].w * v[j].w; }
        ss = wave_sum(ss);
        const float rstd = rsqrtf(ss * (1.0f / D) + EPS);
        float amax = 0.f;
#pragma unroll
        for (int j = 0; j < 4; ++j) { const int c = j * 256 + lane * 4;
            const f32x4 gg = *(const f32x4*)(gvec + c), sc = *(const f32x4*)(mod + mr * 6144 + sc_off + c), sh = *(const f32x4*)(mod + mr * 6144 + sh_off + c);
            const f32x4 o = (v[j] * rstd) * gg * (sc + 1.0f) + sh; v[j] = o;
            amax = fmaxf(amax, fmaxf(fmaxf(fabsf(o.x), fabsf(o.y)), fmaxf(fabsf(o.z), fabsf(o.w))));
            u32x2 w; w.x = pk2(o.x, o.y); w.y = pk2(o.z, o.w);
            *(u32x2*)(dst + (size_t)row * D + c) = w; }
        if (qdst) {
#pragma unroll
            for (int o = 32; o >= 1; o >>= 1) amax = fmaxf(amax, __shfl_xor(amax, o));
            const float qs = amax > 0.f ? amax * (1.0f / 127.0f) : 1.0f, inv = 1.0f / qs;
#pragma unroll
            for (int j = 0; j < 4; ++j) { const int c = j * 256 + lane * 4;
                const int q0 = (int)rintf(v[j].x * inv), q1 = (int)rintf(v[j].y * inv), q2 = (int)rintf(v[j].z * inv), q3 = (int)rintf(v[j].w * inv);
                *(unsigned*)(qdst + (size_t)row * D + c) = (unsigned)(q0 & 255) | ((unsigned)(q1 & 255) << 8) | ((unsigned)(q2 & 255) << 16) | ((unsigned)(q3 & 255) << 24); }
            if (lane == 0) qscale[row] = qs;
        }
    }
}

struct EpiA {
    static constexpr bool PERM = true, TRANS = true;
    unsigned char* ws;
    __device__ __forceinline__ void operator()(const f32x4 (&acc)[2][2][4][2], const pg8::Unit& u, int wr, int wc, int fr, int fq) const {
        const int ty = u.pn >> 1;
        h16* base = (h16*)(ws + (ty == 0 ? OFF_Q : ty == 1 ? OFF_LF : ty == 2 ? OFF_LBK : ty == 3 ? OFF_V : OFF_G));
        const float* lb = (const float*)(ws + OFF_LB) + (ty == 2 ? 512 : 0);
        const int row0 = u.pm * 256 + wr * 64 + fr, col0 = (u.pn & 1) * 256 + wc * 32 + 8 * fq;
#pragma unroll
        for (int bj = 0; bj < 2; ++bj) {
            float lbv[8];
            if (ty == 1 || ty == 2) {
#pragma unroll
                for (int j = 0; j < 8; ++j) lbv[j] = lb[col0 + bj * 128 + j];
            }
#pragma unroll
            for (int ai = 0; ai < 2; ++ai)
#pragma unroll
                for (int m = 0; m < 4; ++m) {
                    float v[8];
#pragma unroll
                    for (int j = 0; j < 4; ++j) { v[j] = acc[ai][bj][m][0][j]; v[4 + j] = acc[ai][bj][m][1][j]; }
                    if (ty == 0) {
#pragma unroll
                        for (int j = 0; j < 8; ++j) v[j] *= 0.08838834764831845f;
                    } else if (ty == 1 || ty == 2) {
#pragma unroll
                        for (int j = 0; j < 8; ++j) v[j] = __logf(lbv[j] + (1.0f - lbv[j]) * sigmoidf_(v[j]));
                    } else if (ty == 4) {
#pragma unroll
                        for (int j = 0; j < 8; ++j) v[j] = v[j] * sigmoidf_(v[j]);
                    }
                    u32x4 w; w.x = pk2(v[0], v[1]); w.y = pk2(v[2], v[3]); w.z = pk2(v[4], v[5]); w.w = pk2(v[6], v[7]);
                    *(u32x4*)(base + (size_t)(row0 + ai * 128 + m * 16) * 512 + col0 + bj * 128) = w;
                }
        }
    }
};
struct OrderA {
    pg8::TileOrder lat; int G, c, rep;
    __device__ void init(int G_, int c_, int rep_ = 1) { lat.init(128, 10, G_, c_); G = G_; c = c_; rep = rep_; }
    __device__ bool next(int i, pg8::Unit& u) const {
        long L = (long)i * G + c; if (L >= 1328L * rep) return false; L %= 1328;
        if (L < 1280) return lat.map(L, u);
        const int l2 = (int)(L - 1280); if (l2 >= 48) return false;
        u.pm = 128 + l2 / 6; u.pn = 2 + l2 % 6; return true;
    }
};
struct EpiGate {
    static constexpr bool PERM = true, TRANS = true;
    unsigned char* ws;
    __device__ __forceinline__ void operator()(const f32x4 (&acc)[2][2][4][2], const pg8::Unit& u, int wr, int wc, int fr, int fq) const {
        h16* base = (h16*)(ws + (u.pn < 4 ? OFF_GH : OFF_GF));
        const int row0 = u.pm * 256 + wr * 64 + fr, col0 = (u.pn & 3) * 256 + wc * 32 + 8 * fq;
#pragma unroll
        for (int ai = 0; ai < 2; ++ai)
#pragma unroll
            for (int m = 0; m < 4; ++m)
#pragma unroll
                for (int bj = 0; bj < 2; ++bj) {
                    float v[8];
#pragma unroll
                    for (int j = 0; j < 4; ++j) { v[j] = sigmoidf_(acc[ai][bj][m][0][j]); v[4 + j] = sigmoidf_(acc[ai][bj][m][1][j]); }
                    u32x4 w; w.x = pk2(v[0], v[1]); w.y = pk2(v[2], v[3]); w.z = pk2(v[4], v[5]); w.w = pk2(v[6], v[7]);
                    *(u32x4*)(base + (size_t)(row0 + ai * 128 + m * 16) * 1024 + col0 + bj * 128) = w;
                }
    }
};
struct EpiFT {
    static constexpr bool PERM = false, TRANS = false;
    unsigned char* ws;
    __device__ __forceinline__ void operator()(const f32x4 (&acc)[2][2][4][2], const pg8::Unit& u, int wr, int wc, int fr, int fq) const {
        h16* F = (h16*)(ws + OFF_FTT);
        const int t0 = u.pm * 256 + wr * 64 + 4 * fq, c0 = u.pn * 256 + wc * 32 + fr;
#pragma unroll
        for (int ai = 0; ai < 2; ++ai)
#pragma unroll
            for (int m = 0; m < 4; ++m)
#pragma unroll
                for (int bj = 0; bj < 2; ++bj)
#pragma unroll
                    for (int n = 0; n < 2; ++n) {
                        const int t = t0 + ai * 128 + m * 16, c = c0 + bj * 128 + n * 16;
                        const int b = t >> 12, n1 = t & 4095, part = c >> 9, gk = c & 511;
                        const f32x4 a = acc[ai][bj][m][n];
                        u32x2 w; w.x = pk2(a.x, a.y); w.y = pk2(a.z, a.w);
                        *(u32x2*)(F + ((size_t)((b * 512 + gk) * 2 + part)) * 4096 + n1) = w;
                    }
    }
};
struct EpiDFT {
    static constexpr bool PERM = true, TRANS = true;
    unsigned char* ws;
    __device__ __forceinline__ void operator()(const f32x4 (&acc)[2][2][4][2], const pg8::Unit& u, int wr, int wc, int fr, int fq) const {
        h16* Y = (h16*)(ws + OFF_YFT);
        const int b = u.pn >> 5, d = (u.pn >> 1) & 15;
        const int c0 = wr * 64 + fr, col0 = (u.pn & 1) * 256 + wc * 32 + 8 * fq;
#pragma unroll
        for (int ai = 0; ai < 2; ++ai)
#pragma unroll
            for (int m = 0; m < 4; ++m)
#pragma unroll
                for (int bj = 0; bj < 2; ++bj) {
                    const int c = c0 + ai * 128 + m * 16;
                    const f32x4 a0 = acc[ai][bj][m][0], a1 = acc[ai][bj][m][1];
                    u32x4 w; w.x = pk2(a0.x, a0.y); w.y = pk2(a0.z, a0.w); w.z = pk2(a1.x, a1.y); w.w = pk2(a1.z, a1.w);
                    *(u32x4*)(Y + (size_t)(b * 4096 + d + 16 * c) * 512 + col0 + bj * 128) = w;
                }
    }
};
template <bool ACCUM> struct EpiMerge1 {
    static constexpr bool PERM = true, TRANS = true;
    unsigned char* ws;
    __device__ __forceinline__ void operator()(const f32x4 (&acc)[2][2][4][2], const pg8::Unit& u, int wr, int wc, int fr, int fq) const {
        h16* Y = (h16*)(ws + OFF_Y); const h16* GT = (const h16*)(ws + (ACCUM ? OFF_GF : OFF_GH));
        const int row0 = u.pm * 256 + wr * 64 + fr, col0 = u.pn * 256 + wc * 32 + 8 * fq;
#pragma unroll
        for (int ai = 0; ai < 2; ++ai)
#pragma unroll
            for (int m = 0; m < 4; ++m)
#pragma unroll
                for (int bj = 0; bj < 2; ++bj) {
                    const size_t off = (size_t)(row0 + ai * 128 + m * 16) * 1024 + col0 + bj * 128;
                    const h16x8 gt = *(const h16x8*)(GT + off);
                    float v[8];
#pragma unroll
                    for (int j = 0; j < 4; ++j) { v[j] = acc[ai][bj][m][0][j] * (float)gt[j]; v[4 + j] = acc[ai][bj][m][1][j] * (float)gt[4 + j]; }
                    if (ACCUM) { const h16x8 y0 = *(const h16x8*)(Y + off);
#pragma unroll
                        for (int j = 0; j < 8; ++j) v[j] += (float)y0[j]; }
                    u32x4 w; w.x = pk2(v[0], v[1]); w.y = pk2(v[2], v[3]); w.z = pk2(v[4], v[5]); w.w = pk2(v[6], v[7]);
                    *(u32x4*)(Y + off) = w;
                }
    }
};
struct EpiMerge2 {
    static constexpr bool PERM = false, TRANS = true;
    const float* x; float* H; const float* mod;
    __device__ __forceinline__ void operator()(const f32x4 (&acc)[2][2][4][2], const pg8::Unit& u, int wr, int wc, int fr, int fq) const {
        const int row0 = u.pm * 256 + wr * 64 + fr, col0 = u.pn * 256 + wc * 32 + 4 * fq;
        const int b = (u.pm * 256) >> 12;
        f32x4 g1[2][2];
#pragma unroll
        for (int bj = 0; bj < 2; ++bj)
#pragma unroll
            for (int n = 0; n < 2; ++n) g1[bj][n] = *(const f32x4*)(mod + b * 6144 + 2048 + col0 + bj * 128 + n * 16);
#pragma unroll
        for (int ai = 0; ai < 2; ++ai)
#pragma unroll
            for (int m = 0; m < 4; ++m) { const size_t ro = (size_t)(row0 + ai * 128 + m * 16) * 1024 + col0;
#pragma unroll
                for (int bj = 0; bj < 2; ++bj)
#pragma unroll
                    for (int n = 0; n < 2; ++n) { const f32x4 xv = *(const f32x4*)(x + ro + bj * 128 + n * 16);
                        *(f32x4*)(H + ro + bj * 128 + n * 16) = xv + g1[bj][n] * acc[ai][bj][m][n]; } }
    }
};
struct EpiF32 {
    static constexpr bool PERM = false, TRANS = true;
    float* C; int ldc;
    __device__ __forceinline__ void operator()(const f32x4 (&acc)[2][2][4][2], const pg8::Unit& u, int wr, int wc, int fr, int fq) const {
        const int row0 = u.pm * 256 + wr * 64 + fr, col0 = u.pn * 256 + wc * 32 + 4 * fq;
#pragma unroll
        for (int ai = 0; ai < 2; ++ai)
#pragma unroll
            for (int m = 0; m < 4; ++m) { float* rowp = C + (size_t)(row0 + ai * 128 + m * 16) * ldc + col0;
#pragma unroll
                for (int bj = 0; bj < 2; ++bj)
#pragma unroll
                    for (int n = 0; n < 2; ++n) *(f32x4*)(rowp + bj * 128 + n * 16) = acc[ai][bj][m][n]; }
    }
};

__device__ __forceinline__ int hgrn_row(int pos, int b, int dir) {
    if (pos < LC) { const int j = dir ? (LC - 1 - pos) : pos; return T + b * LC + j; }
    const int t = pos - LC; return b * SEQ + (dir ? (SEQ - 1 - t) : t);
}
__device__ void hgrn_item(const Params& p, LAS unsigned char* lds, int item) {
    const int tid = threadIdx.x, vq = item & 3, dir = (item >> 2) & 1, h = (item >> 3) & 3, b = item >> 5;
    const h16* Q = (const h16*)(p.ws + OFF_Q); const h16* LF = (const h16*)(p.ws + (dir ? OFF_LBK : OFF_LF)); const h16* V = (const h16*)(p.ws + OFF_V);
    h16* O = (h16*)(p.ws + (dir ? OFF_OB : OFF_OF));
    LAS float* fs = (LAS float*)lds; LAS float* ks = fs + 16 * 128; LAS float* qs = ks + 16 * 128; LAS float* vs = qs + 16 * 128; LAS float* po = vs + 16 * 32;
    const int v = tid & 31, kq = tid >> 5;
    float S[8];
#pragma unroll
    for (int j = 0; j < 8; ++j) S[j] = 0.f;
    const int e = tid * 4, tl_ld = e >> 7, k_ld = e & 127;
    const int tl_v = tid >> 5, vv = tid & 31;
    h16x4 lf4, q4; h16 v1;
    { const int row = hgrn_row(tl_ld, b, dir); lf4 = *(const h16x4*)(LF + (size_t)row * 512 + h * 128 + k_ld); q4 = (h16x4){0, 0, 0, 0};
      const int row2 = hgrn_row(tl_v, b, dir); v1 = V[(size_t)row2 * 512 + h * 128 + vq * 32 + vv]; }
    constexpr int NG = (LC + SEQ) / 16;
    for (int grp = 0; grp < NG; ++grp) {
        const bool latent = grp >= LC / 16;
#pragma unroll
        for (int j = 0; j < 4; ++j) { const float f = __expf((float)lf4[j]); fs[e + j] = f; ks[e + j] = 1.0f - f; qs[e + j] = (float)q4[j]; }
        vs[tid] = (float)v1;
        __syncthreads();
        if (grp + 1 < NG) { const int pos = (grp + 1) * 16; const bool lat2 = (grp + 1) >= LC / 16;
            const int row = hgrn_row(pos + tl_ld, b, dir); lf4 = *(const h16x4*)(LF + (size_t)row * 512 + h * 128 + k_ld);
            if (lat2) q4 = *(const h16x4*)(Q + (size_t)row * 512 + h * 128 + k_ld);
            const int row2 = hgrn_row(pos + tl_v, b, dir); v1 = V[(size_t)row2 * 512 + h * 128 + vq * 32 + vv]; }
#pragma unroll 4
        for (int tl = 0; tl < 16; ++tl) {
            const float vt = vs[tl * 32 + v];
            const f32x4 f0 = *(const LAS f32x4*)(fs + tl * 128 + kq * 8), f1 = *(const LAS f32x4*)(fs + tl * 128 + kq * 8 + 4);
            const f32x4 k0 = *(const LAS f32x4*)(ks + tl * 128 + kq * 8), k1 = *(const LAS f32x4*)(ks + tl * 128 + kq * 8 + 4);
            const f32x4 q0 = *(const LAS f32x4*)(qs + tl * 128 + kq * 8), q1 = *(const LAS f32x4*)(qs + tl * 128 + kq * 8 + 4);
            float a = 0.f;
#pragma unroll
            for (int j = 0; j < 4; ++j) { S[j] = f0[j] * S[j] + k0[j] * vt; a += S[j] * q0[j]; S[4 + j] = f1[j] * S[4 + j] + k1[j] * vt; a += S[4 + j] * q1[j]; }
            po[(tl * 16 + kq) * 32 + v] = a;
        }
        __syncthreads();
        if (latent) { float s = 0.f;
#pragma unroll
            for (int q = 0; q < 16; ++q) s += po[(tl_v * 16 + q) * 32 + vv];
            const int row = hgrn_row(grp * 16 + tl_v, b, dir);
            O[(size_t)row * 512 + h * 128 + vq * 32 + vv] = (h16)s; }
    }
    __syncthreads();
}

typedef short s16x8 __attribute__((ext_vector_type(8)));
typedef short s16x4 __attribute__((ext_vector_type(4)));
__device__ __forceinline__ unsigned cvt_pk_bf16(float lo, float hi) { unsigned r; asm volatile("v_cvt_pk_bf16_f32 %0, %1, %2" : "=v"(r) : "v"(lo), "v"(hi)); return r; }
constexpr int HG_RP = 272, HG_QT = 0, HG_KT = 17408, HG_QD = 34816, HG_KDT = 52224, HG_VT = 68608, HG_AM = 84992, HG_DEC = 93184, HG_SEG = 93696, HG_SEGCH = 17;
#define HG_OPAQUE(x) asm volatile("" : "+v"(x))
template <bool FULL>
__device__ __forceinline__ void hgrn_mfma_unit(const Params& p, LAS unsigned char* lds, int item, int seg) {
    const int tid = threadIdx.x, wave = __builtin_amdgcn_readfirstlane(tid >> 6), lane = tid & 63, fr = lane & 15, fq = lane >> 4;
    const int dir = item & 1, h = (item >> 1) & 3, b = item >> 3;
    const h16* Q = (const h16*)(p.ws + OFF_Q); const h16* LF = (const h16*)(p.ws + (dir ? OFF_LBK : OFF_LF)); const h16* V = (const h16*)(p.ws + OFF_V);
    h16* O = (h16*)(p.ws + (dir ? OFF_OB : OFF_OF));
    float* USTATE = (float*)(p.ws + OFF_USTATE); float* DLOG = (float*)(p.ws + OFF_DLOG);
    const int ch_lo = seg * HG_SEGCH, ch_hi = ch_lo + HG_SEGCH;
    f32x4 S[8];
#pragma unroll
    for (int m = 0; m < 8; ++m) S[m] = (f32x4){0.f, 0.f, 0.f, 0.f};
    if (FULL && seg > 0) {
        for (int i = 0; i < seg; ++i) { const float* U = USTATE + (size_t)(item * 3 + i) * 16384; const float* DL = DLOG + (size_t)(item * 3 + i) * 128;
#pragma unroll
            for (int m = 0; m < 8; ++m)
#pragma unroll
                for (int j = 0; j < 4; ++j) { const int k = 16 * m + 4 * fq + j; const float d = (i > 0) ? __expf(DL[k]) : 0.f; S[m][j] = d * S[m][j] + U[k * 128 + 16 * wave + fr]; } } }
    float dl0 = 0.f, dl1 = 0.f;
    for (int i = tid; i < 8192 / 16; i += NTHREADS) ((LAS u32x4*)(lds + HG_AM))[i] = (u32x4){0u, 0u, 0u, 0u};
    const int kp = lane;
    const unsigned chan = (unsigned)(h * 128 + 2 * kp);
    int bw_rm = wave * 8 * HG_RP + 4 * kp;
    int bw_t0 = (2 * kp) * 128 + ((wave ^ ((2 * kp) & 7)) << 4), bw_t1 = (2 * kp + 1) * 128 + ((wave ^ ((2 * kp + 1) & 7)) << 4);
    int br_rm = fr * HG_RP + 16 * fq;
    int br_qd = HG_QD + fr * HG_RP + 8 * fq;
    int br_t0 = fr * 128 + ((fq ^ (fr & 7)) << 4), br_t1 = fr * 128 + (((4 + fq) ^ (fr & 7)) << 4);
    HG_OPAQUE(bw_rm); HG_OPAQUE(bw_t0); HG_OPAQUE(bw_t1); HG_OPAQUE(br_rm); HG_OPAQUE(br_qd); HG_OPAQUE(br_t0); HG_OPAQUE(br_t1);
    int br_v0 = br_t0 + HG_VT + wave * 2048, br_v1 = br_t1 + HG_VT + wave * 2048, br_k0 = br_t0 + HG_KDT, br_k1 = br_t1 + HG_KDT, br_a0 = br_t0 + HG_AM, br_a1 = br_t1 + HG_AM;
    HG_OPAQUE(br_v0); HG_OPAQUE(br_v1); HG_OPAQUE(br_k0); HG_OPAQUE(br_k1); HG_OPAQUE(br_a0); HG_OPAQUE(br_a1);
    LAS float* DEC = (LAS float*)(lds + HG_DEC); LAS float* SEG = (LAS float*)(lds + HG_SEG);
    unsigned lfr[8], qr[8], vr[8];
#pragma unroll
    for (int r = 0; r < 8; ++r) { const unsigned eo = (unsigned)hgrn_row(ch_lo * 64 + 8 * wave + r, b, dir) * 512u + chan; lfr[r] = *(const unsigned*)(LF + eo); vr[r] = *(const unsigned*)(V + eo);
        qr[r] = (FULL && ch_lo >= LC / 64) ? *(const unsigned*)(Q + eo) : 0u; }
    for (int ch = ch_lo; ch < ch_hi; ++ch) {
        const bool latent = FULL && (ch >= LC / 64);
        float c0[8], c1[8]; float run0 = 0.f, run1 = 0.f;
#pragma unroll
        for (int r = 0; r < 8; ++r) { const h16x2 l = __builtin_bit_cast(h16x2, lfr[r]); run0 += (float)l[0]; run1 += (float)l[1]; c0[r] = run0; c1[r] = run1; }
        *(LAS f32x2*)(SEG + wave * 128 + 2 * kp) = (f32x2){run0, run1};
        __syncthreads();
        float off0 = 0.f, off1 = 0.f, mid0 = 0.f, mid1 = 0.f, tot0 = 0.f, tot1 = 0.f;
#pragma unroll
        for (int w2 = 0; w2 < 8; ++w2) { const f32x2 tt = *(LAS f32x2*)(SEG + w2 * 128 + 2 * kp);
            if (w2 < wave) { off0 += tt[0]; off1 += tt[1]; } if (w2 < 4) { mid0 += tt[0]; mid1 += tt[1]; } tot0 += tt[0]; tot1 += tt[1]; }
        dl0 += tot0; dl1 += tot1;
        const float em0 = __expf(mid0), em1 = __expf(mid1), el0 = __expf(tot0 - mid0), el1 = __expf(tot1 - mid1);
        if (wave == 0) *(LAS f32x2*)(DEC + 2 * kp) = (f32x2){__expf(tot0), __expf(tot1)};
        unsigned kd0[4], kd1[4], vt0[4], vt1[4];
#pragma unroll
        for (int r = 0; r < 8; ++r) {
            const h16x2 l = __builtin_bit_cast(h16x2, lfr[r]), q = __builtin_bit_cast(h16x2, qr[r]), v = __builtin_bit_cast(h16x2, vr[r]);
            const float b0 = off0 + c0[r], b1 = off1 + c1[r];
            const float e20 = __expf(mid0 - b0), e21 = __expf(mid1 - b1);
            const float k0 = 1.0f - __expf((float)l[0]), k1 = 1.0f - __expf((float)l[1]);
            const float kt0 = k0 * e20, kt1 = k1 * e21;
            if (FULL) {
                const float e10 = __expf(b0 - mid0), e11 = __expf(b1 - mid1);
                const float qt0 = (float)q[0] * e10, qt1 = (float)q[1] * e11;
                *(LAS unsigned*)(lds + bw_rm + HG_QT + r * HG_RP) = cvt_pk_bf16(qt0, qt1);
                *(LAS unsigned*)(lds + bw_rm + HG_KT + r * HG_RP) = cvt_pk_bf16(kt0, kt1);
                *(LAS unsigned*)(lds + bw_rm + HG_QD + r * HG_RP) = cvt_pk_bf16(qt0 * em0, qt1 * em1);
            }
            const float kdv0 = kt0 * el0, kdv1 = kt1 * el1;
            if (r & 1) { kd0[r >> 1] = cvt_pk_bf16(__builtin_bit_cast(float, kd0[r >> 1]), kdv0); kd1[r >> 1] = cvt_pk_bf16(__builtin_bit_cast(float, kd1[r >> 1]), kdv1);
                         vt0[r >> 1] = cvt_pk_bf16(__builtin_bit_cast(float, vt0[r >> 1]), (float)v[0]); vt1[r >> 1] = cvt_pk_bf16(__builtin_bit_cast(float, vt1[r >> 1]), (float)v[1]); }
            else { kd0[r >> 1] = __builtin_bit_cast(unsigned, kdv0); kd1[r >> 1] = __builtin_bit_cast(unsigned, kdv1);
                   vt0[r >> 1] = __builtin_bit_cast(unsigned, (float)v[0]); vt1[r >> 1] = __builtin_bit_cast(unsigned, (float)v[1]); }
        }
        *(LAS u32x4*)(lds + bw_t0 + HG_KDT) = (u32x4){kd0[0], kd0[1], kd0[2], kd0[3]};
        *(LAS u32x4*)(lds + bw_t1 + HG_KDT) = (u32x4){kd1[0], kd1[1], kd1[2], kd1[3]};
        *(LAS u32x4*)(lds + bw_t0 + HG_VT) = (u32x4){vt0[0], vt0[1], vt0[2], vt0[3]};
        *(LAS u32x4*)(lds + bw_t1 + HG_VT) = (u32x4){vt1[0], vt1[1], vt1[2], vt1[3]};
        __syncthreads();
        if (ch + 1 < ch_hi) { const bool lat2 = FULL && ((ch + 1) >= LC / 64);
#pragma unroll
            for (int r = 0; r < 8; ++r) { const unsigned eo = (unsigned)hgrn_row((ch + 1) * 64 + 8 * wave + r, b, dir) * 512u + chan;
                lfr[r] = *(const unsigned*)(LF + eo); vr[r] = *(const unsigned*)(V + eo); qr[r] = lat2 ? *(const unsigned*)(Q + eo) : 0u; } }
        if (latent) {
#pragma unroll
            for (int rep = 0; rep < 2; ++rep) {
                const int tile = wave + 8 * rep;
                if (tile < 10) {
                    const int ti = tile < 1 ? 0 : tile < 3 ? 1 : tile < 6 ? 2 : 3, si = tile - (ti * (ti + 1)) / 2;
                    f32x4 acc = (f32x4){0.f, 0.f, 0.f, 0.f};
                    LAS unsigned char* pa = lds + br_rm + HG_KT + 16 * si * HG_RP; LAS unsigned char* pb = lds + br_rm + HG_QT + 16 * ti * HG_RP;
#pragma unroll
                    for (int kk = 0; kk < 4; ++kk) acc = __builtin_amdgcn_mfma_f32_16x16x32_bf16(*(LAS s16x8*)(pa + 64 * kk), *(LAS s16x8*)(pb + 64 * kk), acc, 0, 0, 0);
                    const int t = 16 * ti + fr, s0 = 16 * si + 4 * fq;
                    if (ti == si) {
#pragma unroll
                        for (int j = 0; j < 4; ++j) acc[j] = (s0 + j <= t) ? acc[j] : 0.f; }
                    *(LAS u32x2*)(lds + HG_AM + t * 128 + ((((s0 >> 3)) ^ (fr & 7)) << 4) + (s0 & 7) * 2) = (u32x2){cvt_pk_bf16(acc[0], acc[1]), cvt_pk_bf16(acc[2], acc[3])};
                }
            }
        }
        __syncthreads();
        const s16x8 vf0 = *(LAS s16x8*)(lds + br_v0), vf1 = *(LAS s16x8*)(lds + br_v1);
        if (latent) {
            s16x8 sfrag[4];
#pragma unroll
            for (int kk = 0; kk < 4; ++kk) { const unsigned w0 = cvt_pk_bf16(S[2 * kk][0], S[2 * kk][1]), w1 = cvt_pk_bf16(S[2 * kk][2], S[2 * kk][3]),
                                                          w2 = cvt_pk_bf16(S[2 * kk + 1][0], S[2 * kk + 1][1]), w3 = cvt_pk_bf16(S[2 * kk + 1][2], S[2 * kk + 1][3]);
                sfrag[kk] = __builtin_bit_cast(s16x8, (u32x4){w0, w1, w2, w3}); }
#pragma unroll
            for (int ti = 0; ti < 4; ++ti) {
                f32x4 acc = (f32x4){0.f, 0.f, 0.f, 0.f};
                acc = __builtin_amdgcn_mfma_f32_16x16x32_bf16(vf0, *(LAS s16x8*)(lds + br_a0 + 2048 * ti), acc, 0, 0, 0);
                if (ti >= 2) acc = __builtin_amdgcn_mfma_f32_16x16x32_bf16(vf1, *(LAS s16x8*)(lds + br_a1 + 2048 * ti), acc, 0, 0, 0);
#pragma unroll
                for (int kk = 0; kk < 4; ++kk) {
                    const s16x4 lo = *(LAS s16x4*)(lds + br_qd + 16 * ti * HG_RP + 64 * kk), hi = *(LAS s16x4*)(lds + br_qd + 16 * ti * HG_RP + 64 * kk + 32);
                    const s16x8 bf = (s16x8){lo[0], lo[1], lo[2], lo[3], hi[0], hi[1], hi[2], hi[3]};
                    acc = __builtin_amdgcn_mfma_f32_16x16x32_bf16(sfrag[kk], bf, acc, 0, 0, 0); }
                const unsigned oo = (unsigned)hgrn_row(ch * 64 + 16 * ti + fr, b, dir) * 512u + (unsigned)(h * 128 + 16 * wave + 4 * fq);
                *(u32x2*)(O + oo) = (u32x2){pk2(acc[0], acc[1]), pk2(acc[2], acc[3])};
            }
        }
#pragma unroll
        for (int m = 0; m < 8; ++m) {
            const f32x4 dc = *(LAS f32x4*)(DEC + 16 * m + 4 * fq);
            S[m] = S[m] * dc;
            S[m] = __builtin_amdgcn_mfma_f32_16x16x32_bf16(*(LAS s16x8*)(lds + br_k0 + 2048 * m), vf0, S[m], 0, 0, 0);
            S[m] = __builtin_amdgcn_mfma_f32_16x16x32_bf16(*(LAS s16x8*)(lds + br_k1 + 2048 * m), vf1, S[m], 0, 0, 0);
        }
    }
    if (!FULL) {
        float* U = USTATE + (size_t)(item * 3 + seg) * 16384;
#pragma unroll
        for (int m = 0; m < 8; ++m)
#pragma unroll
            for (int j = 0; j < 4; ++j) U[(16 * m + 4 * fq + j) * 128 + 16 * wave + fr] = S[m][j];
        if (wave == 0) *(f32x2*)(DLOG + (size_t)(item * 3 + seg) * 128 + 2 * kp) = (f32x2){dl0, dl1};
    }
    __syncthreads();
}

__device__ __forceinline__ void fft1_phase(const Params& p, LAS unsigned char* lds, int first_item, int item_stride) {
    LAS float* ctab = (LAS float*)lds;
    LAS float* w16 = ctab + 4096;
    for (int i = threadIdx.x; i < 4096; i += NTHREADS) ctab[i] = cospif((float)i / 2048.0f);
    if (threadIdx.x < 16) { w16[threadIdx.x] = cospif((float)threadIdx.x / 8.0f); w16[16 + threadIdx.x] = sinpif((float)threadIdx.x / 8.0f); }
    __syncthreads();
    const h16* F = (const h16*)(p.ws + OFF_FTT); h16* Y1 = (h16*)(p.ws + OFF_Y1);
    const int ap = threadIdx.x & 127, gl = threadIdx.x >> 7;
    for (int item = first_item; item < 8 * 128; item += item_stride) {
        const int b = item >> 7, gk = (item & 127) * 4 + gl;
        float zr[16][2], zi[16][2];
        const h16* src = F + ((size_t)(b * 512 + gk) * 2) * 4096 + 2 * ap;
#pragma unroll
        for (int r = 0; r < 16; ++r) { const h16x2 c2 = *(const h16x2*)(src + 256 * r), s2 = *(const h16x2*)(src + 4096 + 256 * r);
            zr[r][0] = (float)c2[0]; zr[r][1] = (float)c2[1]; zi[r][0] = -(float)s2[0]; zi[r][1] = -(float)s2[1]; }
#pragma unroll 1
        for (int d = 0; d < 16; ++d) {
            float yr[2] = {0.f, 0.f}, yi[2] = {0.f, 0.f};
#pragma unroll
            for (int r = 0; r < 16; ++r) { const int m = (r * d) & 15; const float cs = w16[m], sn = w16[16 + m];
#pragma unroll
                for (int j = 0; j < 2; ++j) { yr[j] += zr[r][j] * cs + zi[r][j] * sn; yi[j] += zi[r][j] * cs - zr[r][j] * sn; } }
            float ore[2], oim[2];
#pragma unroll
            for (int j = 0; j < 2; ++j) { const int t = ((2 * ap + j) * d) & 4095; const float ct = ctab[t], st = ctab[(t - 1024) & 4095];
                ore[j] = (yr[j] * ct + yi[j] * st) * 0.0625f; oim[j] = (yi[j] * ct - yr[j] * st) * 0.0625f; }
            h16* dst = Y1 + ((size_t)((b * 16 + d) * 512 + gk)) * 512 + 2 * ap;
            *(unsigned*)dst = pk2(ore[0], ore[1]); *(unsigned*)(dst + 256) = pk2(oim[0], oim[1]);
        }
    }
    __syncthreads();
}

__device__ __forceinline__ void a1_prepass(const Params& p) {
    const int wave = threadIdx.x >> 6, lane = threadIdx.x & 63;
    const h16* OF = (const h16*)(p.ws + OFF_OF); const h16* OB = (const h16*)(p.ws + OFF_OB); h16* G = (h16*)(p.ws + OFF_G);
    const float* hgn = p.in[11];
    for (int t = blockIdx.x * 8 + wave; t < T; t += gridDim.x * 8) {
        const size_t off = (size_t)t * 512 + lane * 8;
        const h16x8 a = *(const h16x8*)(OF + off), bq = *(const h16x8*)(OB + off), g = *(const h16x8*)(G + off);
        float o[8]; float ss = 0.f;
#pragma unroll
        for (int j = 0; j < 8; ++j) { o[j] = (float)a[j] + (float)bq[j]; ss += o[j] * o[j]; }
        ss += __shfl_xor(ss, 1); ss += __shfl_xor(ss, 2); ss += __shfl_xor(ss, 4); ss += __shfl_xor(ss, 8);
        const float rstd = rsqrtf(ss * (1.0f / 128.0f) + EPS);
        float r[8];
#pragma unroll
        for (int j = 0; j < 8; ++j) r[j] = o[j] * rstd * hgn[lane * 8 + j] * (float)g[j];
        u32x4 w; w.x = pk2(r[0], r[1]); w.y = pk2(r[2], r[3]); w.z = pk2(r[4], r[5]); w.w = pk2(r[6], r[7]);
        *(u32x4*)(G + off) = w;
    }
}

__device__ __forceinline__ void convert_tables(const Params& p) {
    const int wave = threadIdx.x >> 6, lane = threadIdx.x & 63;
    for (int r2 = blockIdx.x * 8 + wave; r2 < 2 * 16384; r2 += gridDim.x * 8) {
        const int tb = r2 >> 14, e = r2 & 16383;
        const float* src = (tb ? p.in[18] : p.in[17]) + (size_t)e * D + lane * 16;
        f32x4 v[4]; float amax = 0.f;
#pragma unroll
        for (int j = 0; j < 4; ++j) { v[j] = *(const f32x4*)(src + 4 * j); amax = fmaxf(amax, fmaxf(fmaxf(fabsf(v[j].x), fabsf(v[j].y)), fmaxf(fabsf(v[j].z), fabsf(v[j].w)))); }
#pragma unroll
        for (int o = 32; o >= 1; o >>= 1) amax = fmaxf(amax, __shfl_xor(amax, o));
        const float qs = amax > 0.f ? amax * (1.0f / 127.0f) : 1.0f, inv = 1.0f / qs;
        const int bias = tb ? 128 : 0;
        u32x4 w;
#pragma unroll
        for (int j = 0; j < 4; ++j) { const int q0 = (int)rintf(v[j].x * inv) + bias, q1 = (int)rintf(v[j].y * inv) + bias, q2 = (int)rintf(v[j].z * inv) + bias, q3 = (int)rintf(v[j].w * inv) + bias;
            w[j] = (unsigned)(q0 & 255) | ((unsigned)(q1 & 255) << 8) | ((unsigned)(q2 & 255) << 16) | ((unsigned)(q3 & 255) << 24); }
        unsigned char* dst = p.ws + (tb ? OFF_TV : OFF_TU);
        *(u32x4*)(dst + ((size_t)(lane >> 3) * 16384 + e) * 128 + (lane & 7) * 16) = w;
        if (lane == 0) ((float*)(p.ws + (tb ? OFF_SV : OFF_SU)))[e] = qs;
    }
}

__device__ __forceinline__ unsigned f2key(float x) { const unsigned b = __builtin_bit_cast(unsigned, x); return b ^ ((b >> 31) ? 0xFFFFFFFFu : 0x80000000u); }
__device__ __forceinline__ float key2f(unsigned u) { const unsigned b = (u & 0x80000000u) ? (u ^ 0x80000000u) : ~u; return __builtin_bit_cast(float, b); }
__device__ __forceinline__ unsigned umax3(unsigned a, unsigned b, unsigned c) { return max(max(a, b), c); }
__device__ __forceinline__ void top16_of_128(const float* sc, unsigned (&out)[16]) {
    unsigned s[128];
#pragma unroll
    for (int i = 0; i < 32; ++i) { const f32x4 t = *(const f32x4*)(sc + i * 4);
#pragma unroll
        for (int j = 0; j < 4; ++j) s[4 * i + j] = (f2key(t[j]) & ~127u) | (unsigned)(127 - (4 * i + j)); }
#pragma unroll 1
    for (int it = 0; it < 16; ++it) {
        unsigned m[43];
#pragma unroll
        for (int n = 0; n < 42; ++n) m[n] = umax3(s[3 * n], s[3 * n + 1], s[3 * n + 2]);
        m[42] = max(s[126], s[127]);
        unsigned m2[15];
#pragma unroll
        for (int n = 0; n < 14; ++n) m2[n] = umax3(m[3 * n], m[3 * n + 1], m[3 * n + 2]);
        m2[14] = m[42];
        unsigned m3[5];
#pragma unroll
        for (int n = 0; n < 5; ++n) m3[n] = umax3(m2[3 * n], m2[3 * n + 1], m2[3 * n + 2]);
        const unsigned best = max(umax3(m3[0], m3[1], m3[2]), max(m3[3], m3[4]));
#pragma unroll
        for (int n = 0; n < 128; ++n) s[n] = (s[n] == best) ? 0u : s[n];
#pragma unroll
        for (int i = 0; i < 16; ++i) out[i] = (i == it) ? best : out[i];
    }
}
__device__ __forceinline__ void topk_phase(const Params& p, LAS unsigned char* lds) {
    const float* SC = (const float*)(p.ws + OFF_SC); int* EIDX = (int*)(p.ws + OFF_EIDX); float* GATE = (float*)(p.ws + OFF_GATE);
    LAS unsigned* st = (LAS unsigned*)lds;
    const int tid = threadIdx.x;
#ifndef TOPK_REP
#define TOPK_REP 1
#endif
    for (int rr_ = 0; rr_ < TOPK_REP; ++rr_)
    for (int base = blockIdx.x * 256; base < T * 8; base += gridDim.x * 256) {
        {
            unsigned ks[16];
#pragma unroll
            for (int i = 0; i < 16; ++i) ks[i] = 0u;
            top16_of_128(SC + ((size_t)base * 2 + tid) * 128, ks);
#pragma unroll
            for (int i = 0; i < 16; ++i) st[i * NTHREADS + tid] = ks[i];
        }
        __syncthreads();
        if (tid < 256) {
            const int th = base + tid;
            float sv1[16];
#pragma unroll
            for (int j = 0; j < 16; ++j) sv1[j] = key2f(st[j * NTHREADS + 2 * tid + 1] & ~127u);
            unsigned cv[50];
            { int c = 0;
#pragma unroll
              for (int i = 0; i < 16; ++i) { const float a = key2f(st[i * NTHREADS + 2 * tid] & ~127u);
#pragma unroll
                  for (int j = 0; j < 16; ++j) if ((i + 1) * (j + 1) <= 16) { cv[c] = (f2key(a + sv1[j]) & ~255u) | (unsigned)(255 - (i * 16 + j)); ++c; } } }
            unsigned ok[16];
#pragma unroll
            for (int i = 0; i < 16; ++i) ok[i] = 0u;
#pragma unroll 1
            for (int it = 0; it < 16; ++it) {
                unsigned m[17];
#pragma unroll
                for (int n = 0; n < 16; ++n) m[n] = umax3(cv[3 * n], cv[3 * n + 1], cv[3 * n + 2]);
                m[16] = max(cv[48], cv[49]);
                unsigned m2[6];
#pragma unroll
                for (int n = 0; n < 5; ++n) m2[n] = umax3(m[3 * n], m[3 * n + 1], m[3 * n + 2]);
                m2[5] = max(m[15], m[16]);
                const unsigned best = max(umax3(m2[0], m2[1], m2[2]), umax3(m2[3], m2[4], m2[5]));
#pragma unroll
                for (int n = 0; n < 50; ++n) cv[n] = (cv[n] == best) ? 0u : cv[n];
#pragma unroll
                for (int i = 0; i < 16; ++i) ok[i] = (i == it) ? best : ok[i];
            }
            float ex[16]; int oe[16]; float den = 0.f;
            const float v0 = key2f(ok[0] & ~255u);
#pragma unroll
            for (int i = 0; i < 16; ++i) { const int ij = 255 - (int)(ok[i] & 255u), ci = ij >> 4, cj = ij & 15;
                const int e0 = 127 - (int)(st[ci * NTHREADS + 2 * tid] & 127u), e1 = 127 - (int)(st[cj * NTHREADS + 2 * tid + 1] & 127u);
                oe[i] = e0 * 128 + e1; ex[i] = __expf(key2f(ok[i] & ~255u) - v0); den += ex[i]; }
            const float inv = 1.0f / den;
#pragma unroll
            for (int i = 0; i < 4; ++i) {
                *(f32x4*)(GATE + (size_t)th * 16 + 4 * i) = (f32x4){ex[4 * i] * inv, ex[4 * i + 1] * inv, ex[4 * i + 2] * inv, ex[4 * i + 3] * inv};
                *(int4*)(EIDX + (size_t)th * 16 + 4 * i) = make_int4(oe[4 * i], oe[4 * i + 1], oe[4 * i + 2], oe[4 * i + 3]); }
        }
        __syncthreads();
    }
}

struct XcdInfo { int px, npop, rank, nloc; };
__device__ __forceinline__ float dot8(const h16x8 a, const h16x8 b, float s) {
    s = __builtin_amdgcn_fdot2((h16x2){a[0], a[1]}, (h16x2){b[0], b[1]}, s, false); s = __builtin_amdgcn_fdot2((h16x2){a[2], a[3]}, (h16x2){b[2], b[3]}, s, false);
    s = __builtin_amdgcn_fdot2((h16x2){a[4], a[5]}, (h16x2){b[4], b[5]}, s, false); s = __builtin_amdgcn_fdot2((h16x2){a[6], a[7]}, (h16x2){b[6], b[7]}, s, false); return s; }
struct PeerTok { int t; bool ok; };
#define PEER_TOUCH(R) do { unsigned tt_ = (R).w; asm volatile("" : "+v"(tt_)); (R).w = tt_; __builtin_amdgcn_sched_barrier(0); } while (0)
__device__ __forceinline__ PeerTok peer_tok(int i, int t0, int step) { const int t = t0 + i * step; PeerTok r; r.ok = t < T; r.t = r.ok ? t : (T - 1); return r; }
__device__ __forceinline__ void peer_ld_e(const int* EIDX, int t, int g, int (&e)[16]) {
#pragma unroll
    for (int q = 0; q < 4; ++q) { const int4 v = *(const int4*)(EIDX + (size_t)t * 128 + 16 * g + 4 * q); e[4 * q] = v.x; e[4 * q + 1] = v.y; e[4 * q + 2] = v.z; e[4 * q + 3] = v.w; } }
__device__ __forceinline__ void peer_ld_rows(const unsigned char* tab, const int (&e)[16], u32x4 (&r)[16]) {
#pragma unroll
    for (int j = 0; j < 16; ++j) r[j] = *(const u32x4*)(tab + (size_t)e[j] * 128); }
__device__ __forceinline__ void peer_u_compute(const u32x4 (&r)[16], const u32x4 xv, float* PACT, int s, PeerTok tk, int lane, int g, int c) {
    float pj[16];
#pragma unroll
    for (int j = 0; j < 16; ++j) { int d = __builtin_amdgcn_sdot4((int)r[j].x, (int)xv.x, 0, false); d = __builtin_amdgcn_sdot4((int)r[j].y, (int)xv.y, d, false);
        d = __builtin_amdgcn_sdot4((int)r[j].z, (int)xv.z, d, false); d = __builtin_amdgcn_sdot4((int)r[j].w, (int)xv.w, d, false); pj[j] = (float)d; }
#define RED_STEP(NIN, MASK) _Pragma("unroll") for (int j = 0; j < (NIN) / 2; ++j) { const bool up = (lane & (MASK)) != 0; \
    const float keep = up ? pj[2 * j + 1] : pj[2 * j], send = up ? pj[2 * j] : pj[2 * j + 1]; pj[j] = keep + __shfl_xor(send, (MASK)); }
    RED_STEP(16, 1) RED_STEP(8, 2) RED_STEP(4, 4)
#undef RED_STEP
    if (tk.ok) { float* po = PACT + ((size_t)s * T + tk.t) * 128 + 16 * g + c; po[0] = pj[0]; po[8] = pj[1]; }
}
__device__ __forceinline__ void peer_u_phase(const Params& p, const XcdInfo xi) {
    const int wave = threadIdx.x >> 6, lane = threadIdx.x & 63, g = lane >> 3, c = lane & 7;
    const unsigned char* QX = (const unsigned char*)(p.ws + OFF_QX); const unsigned char* TU = (const unsigned char*)(p.ws + OFF_TU);
    const int* EIDX = (const int*)(p.ws + OFF_EIDX); float* PACT = (float*)(p.ws + OFF_PACT);
    const int t0 = xi.rank * 8 + wave, step = xi.nloc * 8, ntok = (T - t0 + step - 1) / step;
    for (int s = xi.px; s < 8; s += xi.npop) {
        const unsigned char* tus = TU + (size_t)s * 16384 * 128 + 16 * c; const unsigned char* qxs = QX + s * 128 + 16 * c;
        int eN[16]; u32x4 rA[16], rB[16]; u32x4 xA, xB;
        { PeerTok k0 = peer_tok(0, t0, step); peer_ld_e(EIDX, k0.t, g, eN); xA = *(const u32x4*)(qxs + (size_t)k0.t * D); peer_ld_rows(tus, eN, rA);
          PeerTok k1 = peer_tok(1, t0, step); peer_ld_e(EIDX, k1.t, g, eN); }
        for (int i = 0; i < ntok; i += 2) {
            { const PeerTok k1 = peer_tok(i + 1, t0, step), k2 = peer_tok(i + 2, t0, step);
              PEER_TOUCH(rA[15]);
              xB = *(const u32x4*)(qxs + (size_t)k1.t * D); peer_ld_rows(tus, eN, rB); peer_ld_e(EIDX, k2.t, g, eN);
              __builtin_amdgcn_sched_barrier(0);
              peer_u_compute(rA, xA, PACT, s, peer_tok(i, t0, step), lane, g, c);
              __builtin_amdgcn_sched_barrier(0); }
            { const PeerTok k2 = peer_tok(i + 2, t0, step), k3 = peer_tok(i + 3, t0, step);
              PEER_TOUCH(rB[15]);
              xA = *(const u32x4*)(qxs + (size_t)k2.t * D); peer_ld_rows(tus, eN, rA); peer_ld_e(EIDX, k3.t, g, eN);
              __builtin_amdgcn_sched_barrier(0);
              PeerTok k1 = peer_tok(i + 1, t0, step); k1.ok = k1.ok && (i + 1 < ntok);
              peer_u_compute(rB, xB, PACT, s, k1, lane, g, c);
              __builtin_amdgcn_sched_barrier(0); }
        }
    }
}
__device__ __forceinline__ void peer_combine(const Params& p) {
    const float* PACT = (const float*)(p.ws + OFF_PACT); const float* GATE = (const float*)(p.ws + OFF_GATE); h16* WH = (h16*)(p.ws + OFF_W);
    const int* EIDX = (const int*)(p.ws + OFF_EIDX); const float* SU = (const float*)(p.ws + OFF_SU); const float* SV = (const float*)(p.ws + OFF_SV); const float* SX = (const float*)(p.ws + OFF_SX);
    for (size_t i = (size_t)blockIdx.x * NTHREADS + threadIdx.x; i < (size_t)T * 128 / 4; i += (size_t)gridDim.x * NTHREADS) {
        f32x4 a = *(const f32x4*)(PACT + i * 4);
#pragma unroll
        for (int s = 1; s < 8; ++s) a += *(const f32x4*)(PACT + (size_t)s * T * 128 + i * 4);
        const f32x4 gt = *(const f32x4*)(GATE + i * 4); const int4 e4 = *(const int4*)(EIDX + i * 4);
        const int ee[4] = {e4.x, e4.y, e4.z, e4.w};
        const float sx = SX[i >> 5];
        float w[4];
#pragma unroll
        for (int j = 0; j < 4; ++j) { const float act = a[j] * sx * SU[ee[j]]; w[j] = gt[j] * (0.5f * act * (1.0f + erff(act * 0.70710678118654752f))) * SV[ee[j]] * 64.0f; }
        *(u32x2*)(WH + i * 4) = (u32x2){pk2(w[0], w[1]), pk2(w[2], w[3])}; }
}
__device__ __forceinline__ void peer_v_compute(const u32x4 (&r)[16], const u32x4 wlo, const u32x4 whi, const f32x2 hv, const f32x2 gv, float* H2, float* PSS, int s, PeerTok tk, int lane, int g, int c) {
    float acc[16];
#pragma unroll
    for (int i = 0; i < 16; ++i) acc[i] = 0.f;
    float wsum = 0.f;
#pragma unroll
    for (int jp = 0; jp < 8; ++jp) {
        const unsigned wpair = jp < 4 ? wlo[jp] : whi[jp - 4]; const h16x2 w2 = __builtin_bit_cast(h16x2, wpair);
        wsum += (float)w2[0] + (float)w2[1];
#pragma unroll
        for (int d = 0; d < 4; ++d) { const unsigned a = r[2 * jp][d], bq = r[2 * jp + 1][d];
            acc[4 * d + 0] = __builtin_amdgcn_fdot2(__builtin_bit_cast(h16x2, __builtin_amdgcn_perm(bq, a, 0x0C040C00u)), w2, acc[4 * d + 0], false);
            acc[4 * d + 1] = __builtin_amdgcn_fdot2(__builtin_bit_cast(h16x2, __builtin_amdgcn_perm(bq, a, 0x0C050C01u)), w2, acc[4 * d + 1], false);
            acc[4 * d + 2] = __builtin_amdgcn_fdot2(__builtin_bit_cast(h16x2, __builtin_amdgcn_perm(bq, a, 0x0C060C02u)), w2, acc[4 * d + 2], false);
            acc[4 * d + 3] = __builtin_amdgcn_fdot2(__builtin_bit_cast(h16x2, __builtin_amdgcn_perm(bq, a, 0x0C070C03u)), w2, acc[4 * d + 3], false); }
    }
    const float corr = wsum * (128.0f / 16777216.0f);
#pragma unroll
    for (int i = 0; i < 16; ++i) acc[i] -= corr;
#define RED_STEP(NIN, MASK) _Pragma("unroll") for (int j = 0; j < (NIN) / 2; ++j) { const bool up = (lane & (MASK)) != 0; \
    const float keep = up ? acc[2 * j + 1] : acc[2 * j], send = up ? acc[2 * j] : acc[2 * j + 1]; acc[j] = keep + __shfl_xor(send, (MASK)); }
    RED_STEP(16, 8) RED_STEP(8, 16) RED_STEP(4, 32)
#undef RED_STEP
    float ss = 0.f;
#pragma unroll
    for (int j = 0; j < 2; ++j) { const int col = s * 128 + 16 * c + 8 * j + g;
        const float h2 = hv[j] + gv[j] * (acc[j] * (16777216.0f / 64.0f));
        if (tk.ok) H2[(size_t)tk.t * D + col] = h2;
        ss += h2 * h2; }
    ss = wave_sum(ss);
    if (lane == 0 && tk.ok) PSS[(size_t)s * T + tk.t] = ss;
}
__device__ __forceinline__ void peer_v_phase(const Params& p, const XcdInfo xi) {
    const int wave = threadIdx.x >> 6, lane = threadIdx.x & 63, g = lane >> 3, c = lane & 7;
    const unsigned char* TV = (const unsigned char*)(p.ws + OFF_TV); const int* EIDX = (const int*)(p.ws + OFF_EIDX); const h16* WH = (const h16*)(p.ws + OFF_W);
    const float* mod = (const float*)(p.ws + OFF_MOD); const float* H = p.out; float* H2 = (float*)(p.ws + OFF_H2); float* PSS = (float*)(p.ws + OFF_PSS);
    const int t0 = xi.rank * 8 + wave, step = xi.nloc * 8, ntok = (T - t0 + step - 1) / step;
    for (int s = xi.px; s < 8; s += xi.npop) {
        const unsigned char* tvs = TV + (size_t)s * 16384 * 128 + 16 * c;
        const int colb = s * 128 + 16 * c + g;
        int eN[16]; u32x4 rA[16], rB[16]; u32x4 wA0, wA1, wB0, wB1; f32x2 hA, hB, gA, gB;
#define V_LD_SIDE(W0, W1, HV, GV, tt) do { W0 = *(const u32x4*)(WH + (size_t)(tt) * 128 + 16 * g); W1 = *(const u32x4*)(WH + (size_t)(tt) * 128 + 16 * g + 8); \
        HV = (f32x2){H[(size_t)(tt) * D + colb], H[(size_t)(tt) * D + colb + 8]}; GV = (f32x2){mod[((tt) >> 12) * 6144 + 5120 + colb], mod[((tt) >> 12) * 6144 + 5120 + colb + 8]}; } while (0)
        { PeerTok k0 = peer_tok(0, t0, step); peer_ld_e(EIDX, k0.t, g, eN); V_LD_SIDE(wA0, wA1, hA, gA, k0.t); peer_ld_rows(tvs, eN, rA);
          PeerTok k1 = peer_tok(1, t0, step); peer_ld_e(EIDX, k1.t, g, eN); }
        for (int i = 0; i < ntok; i += 2) {
            { const PeerTok k1 = peer_tok(i + 1, t0, step), k2 = peer_tok(i + 2, t0, step);
              PEER_TOUCH(rA[15]);
              V_LD_SIDE(wB0, wB1, hB, gB, k1.t); peer_ld_rows(tvs, eN, rB); peer_ld_e(EIDX, k2.t, g, eN);
              __builtin_amdgcn_sched_barrier(0);
              peer_v_compute(rA, wA0, wA1, hA, gA, H2, PSS, s, peer_tok(i, t0, step), lane, g, c);
              __builtin_amdgcn_sched_barrier(0); }
            { const PeerTok k2 = peer_tok(i + 2, t0, step), k3 = peer_tok(i + 3, t0, step);
              PEER_TOUCH(rB[15]);
              V_LD_SIDE(wA0, wA1, hA, gA, k2.t); peer_ld_rows(tvs, eN, rA); peer_ld_e(EIDX, k3.t, g, eN);
              __builtin_amdgcn_sched_barrier(0);
              PeerTok k1 = peer_tok(i + 1, t0, step); k1.ok = k1.ok && (i + 1 < ntok);
              peer_v_compute(rB, wB0, wB1, hB, gB, H2, PSS, s, k1, lane, g, c);
              __builtin_amdgcn_sched_barrier(0); }
        }
#undef V_LD_SIDE
    }
}
__device__ __forceinline__ void peer_final(const Params& p) {
    const int wave = threadIdx.x >> 6, lane = threadIdx.x & 63;
    const float* PSS = (const float*)(p.ws + OFF_PSS); float* OUT = p.out; const float* H2 = (const float*)(p.ws + OFF_H2); const float* fg = p.in[19];
    for (int t = blockIdx.x * 8 + wave; t < T; t += gridDim.x * 8) {
        float ss = (lane < 8) ? PSS[(size_t)lane * T + t] : 0.f;
        ss = wave_sum(ss);
        const float rstd = rsqrtf(ss * (1.0f / D) + EPS);
#pragma unroll
        for (int j = 0; j < 4; ++j) { const int cc = j * 256 + lane * 4; const f32x4 hv = *(const f32x4*)(H2 + (size_t)t * D + cc), fv = *(const f32x4*)(fg + cc);
            *(f32x4*)(OUT + (size_t)t * D + cc) = hv * rstd * fv; }
    }
}
#ifndef REP_A
#define REP_A 1
#endif
#ifndef REP_FT
#define REP_FT 1
#endif
#ifndef REP_DFT
#define REP_DFT 1
#endif
#ifndef REP_GATE
#define REP_GATE 1
#endif
constexpr int N_PHASES = 15;
#ifndef MK_CGSYNC
#define MK_CGSYNC 0
#endif
__device__ __forceinline__ Params load_params(volatile LAS unsigned* pw) {
    Params q;
    unsigned long long v[22];
#pragma unroll
    for (int i = 0; i < 22; ++i) { const unsigned lo = (unsigned)__builtin_amdgcn_readfirstlane((int)pw[2 * i]), hi = (unsigned)__builtin_amdgcn_readfirstlane((int)pw[2 * i + 1]); v[i] = ((unsigned long long)hi << 32) | lo; }
#pragma unroll
    for (int i = 0; i < 20; ++i) q.in[i] = (const float*)v[i];
    q.out = (float*)v[20]; q.ws = (unsigned char*)v[21];
    q.ph_lo = __builtin_amdgcn_readfirstlane((int)pw[44]); q.ph_hi = __builtin_amdgcn_readfirstlane((int)pw[45]);
    return q;
}
__global__ void __launch_bounds__(NTHREADS, 2) mega(Params pk) {
    extern __shared__ __attribute__((aligned(16))) unsigned char smem[];
    LAS unsigned char* lds = (LAS unsigned char*)smem;
    const int G = gridDim.x, c = blockIdx.x;
    volatile LAS unsigned* pw = (volatile LAS unsigned*)(lds + LDS_BYTES - 512);
    if (threadIdx.x == 0) {
#pragma unroll
        for (int i = 0; i < 20; ++i) { const unsigned long long v = (unsigned long long)pk.in[i]; pw[2 * i] = (unsigned)v; pw[2 * i + 1] = (unsigned)(v >> 32); }
        { const unsigned long long v = (unsigned long long)pk.out; pw[40] = (unsigned)v; pw[41] = (unsigned)(v >> 32); }
        { const unsigned long long v = (unsigned long long)pk.ws; pw[42] = (unsigned)v; pw[43] = (unsigned)(v >> 32); }
        pw[44] = (unsigned)pk.ph_lo; pw[45] = (unsigned)pk.ph_hi;
    }
    unsigned* ctl = (unsigned*)(pk.ws + OFF_CTL);
    volatile LAS unsigned* misc = (volatile LAS unsigned*)(lds + LDS_BYTES - 64);
    if (threadIdx.x < 16) misc[threadIdx.x] = 0u;
    __syncthreads();
    const bool fused = (pk.ph_hi - pk.ph_lo) > 1;
    XcdBarrier bar; bar.bar = ctl; bar.x = 0; bar.st = misc;
    if (fused) {
        bar = xcd_barrier_post(ctl, misc);
        if (threadIdx.x == 0) misc[2] = xb_add(&ctl[CTL_RANK + 64 * bar.x], 1u);
    }
#define IN(k) (ph_lo <= (k) && (k) < ph_hi)
#if MK_CGSYNC
#define SEAM(k) do { if (IN(k) && IN((k) + 1)) { cg::grid_group grid = cg::this_grid(); grid.sync(); } } while (0)
#else
#define SEAM(k) do { if (IN(k) && IN((k) + 1)) xcd_barrier(bar); } while (0)
#endif
#define PHASE_BEGIN(k) if (IN(k)) { const Params p = load_params(pw); unsigned char* const ws = p.ws; (void)ws;
#define PHASE_END(k) } SEAM(k);
    const int ph_lo = pk.ph_lo, ph_hi = pk.ph_hi;
    PHASE_BEGIN(0) phase0(p, lds); PHASE_END(0)
    PHASE_BEGIN(1)
        const float* mod = (const float*)(ws + OFF_MOD);
        modulate_rows(p.in[0], (h16*)(ws + OFF_UALL), T, p.in[6], mod, 0, 1024, 0);
        modulate_rows(p.in[2], (h16*)(ws + OFF_UALL) + (size_t)T * D, TC, p.in[6], mod, 0, 1024, 1);
    PHASE_END(1)
    PHASE_BEGIN(2)
        { pg8::Gemm g{ws + OFF_UALL, ws + OFF_WA, 1024, 1024, 1024}; OrderA S; S.init(G, c, REP_A); EpiA E{ws}; pg8::gemm_phase(lds, g, S, E); }
        { pg8::Gemm g{ws + OFF_UALL, ws + OFF_WF, 1024, 1024, 1024}; pg8::TileOrder S; S.init(128, 4, G, c, REP_FT); EpiFT E{ws}; pg8::gemm_phase(lds, g, S, E); }
    PHASE_END(2)
    PHASE_BEGIN(3) for (int it = blockIdx.x; it < 192; it += gridDim.x) hgrn_mfma_unit<false>(p, lds, it / 3, it % 3);
        fft1_phase(p, lds, (int)((blockIdx.x + 64u) % gridDim.x), gridDim.x); PHASE_END(3)
    PHASE_BEGIN(4) for (int it = blockIdx.x; it < 256; it += gridDim.x) hgrn_mfma_unit<true>(p, lds, it >> 2, it & 3); PHASE_END(4)
    PHASE_BEGIN(5)
        { pg8::Gemm g{ws + OFF_DFT256, ws + OFF_Y1, 512, 512, 512}; pg8::TileOrder S; S.init(1, 256, G, c, REP_DFT); EpiDFT E{ws}; pg8::gemm_phase(lds, g, S, E); }
        { pg8::Gemm g{ws + OFF_UALL, ws + OFF_WG, 1024, 1024, 1024}; pg8::TileOrder S; S.init(128, 8, G, c, REP_GATE); EpiGate E{ws}; pg8::gemm_phase(lds, g, S, E); }
        a1_prepass(p);
    PHASE_END(5)
    PHASE_BEGIN(6)
        { pg8::Gemm g{ws + OFF_G, ws + OFF_WHG, 512, 512, 512}; pg8::TileOrder S; S.init(128, 4, G, c); EpiMerge1<false> E{ws}; pg8::gemm_phase(lds, g, S, E); }
        { pg8::Gemm g{ws + OFF_YFT, ws + OFF_WFT, 512, 512, 512}; pg8::TileOrder S; S.init(128, 4, G, c); EpiMerge1<true> E{ws}; pg8::gemm_phase(lds, g, S, E); }
    PHASE_END(6)
    PHASE_BEGIN(7)
        pg8::Gemm g{ws + OFF_Y, ws + OFF_WOUT, 1024, 1024, 1024}; pg8::TileOrder S; S.init(128, 4, G, c);
        EpiMerge2 E{p.in[0], p.out, (const float*)(ws + OFF_MOD)}; pg8::gemm_phase(lds, g, S, E);
    PHASE_END(7)
    PHASE_BEGIN(8) modulate_rows(p.out, (h16*)(ws + OFF_U2), T, p.in[7], (const float*)(ws + OFF_MOD), 3072, 4096, 0, (signed char*)(ws + OFF_QX), (float*)(ws + OFF_SX)); convert_tables(p); PHASE_END(8)
    PHASE_BEGIN(9)
        pg8::Gemm g{ws + OFF_U2, ws + OFF_WS, 1024, 1024, 1024}; pg8::TileOrder S; S.init(128, 8, G, c);
        EpiF32 E{(float*)(ws + OFF_SC), 2048}; pg8::gemm_phase(lds, g, S, E);
    PHASE_END(9)
    PHASE_BEGIN(10) topk_phase(p, lds); PHASE_END(10)
    XcdInfo xi;
    if (fused) {
        unsigned cnt[8]; int npop = 0, px = 0;
#pragma unroll
        for (int j = 0; j < 8; ++j) { cnt[j] = xb_ld(&ctl[CTL_RANK + 64 * j]); if (j < (int)(bar.x & 7u)) px += (cnt[j] > 0u); npop += (cnt[j] > 0u); }
        xi.px = px; xi.npop = npop > 0 ? npop : 1; xi.rank = (int)misc[2]; xi.nloc = (int)cnt[bar.x & 7u]; if (xi.nloc < 1) xi.nloc = 1;
    } else { xi.px = c & 7; xi.npop = 8; xi.rank = c >> 3; xi.nloc = G >> 3; }
    PHASE_BEGIN(11) peer_u_phase(p, xi); PHASE_END(11)
    PHASE_BEGIN(12) peer_combine(p); PHASE_END(12)
    PHASE_BEGIN(13) peer_v_phase(p, xi); PHASE_END(13)
    PHASE_BEGIN(14) peer_final(p); }
#undef IN
#undef SEAM
#undef PHASE_BEGIN
#undef PHASE_END
}

#ifndef MK_SINGLE
#define MK_SINGLE 1
#endif
extern "C" void kernel_launch(void* const* d_in, const int* in_sizes, int n_in, void* d_out, int out_size, void* d_ws, size_t ws_size, hipStream_t stream) {
    static int grid = 0;
    if (grid == 0) {
        if (n_in != 20 || out_size != T * D || ws_size < WS_NEED) { fprintf(stderr, "kernel_launch: unexpected shapes (n_in %d out %d ws %zu)\n", n_in, out_size, ws_size); grid = -1; return; }
        int dev = 0, cus = 0, per_cu = 0;
        hipGetDevice(&dev); hipDeviceGetAttribute(&cus, hipDeviceAttributeMultiprocessorCount, dev);
        if (hipFuncSetAttribute((const void*)mega, hipFuncAttributeMaxDynamicSharedMemorySize, LDS_BYTES) != hipSuccess) { fprintf(stderr, "kernel_launch: hipFuncSetAttribute failed\n"); grid = -1; return; }
        hipOccupancyMaxActiveBlocksPerMultiprocessor(&per_cu, (const void*)mega, NTHREADS, LDS_BYTES);
        if (per_cu < 1) { fprintf(stderr, "kernel_launch: occupancy query says %d blocks per CU\n", per_cu); grid = -1; return; }
        grid = cus;
    }
    if (grid < 0) return;
    if (hipMemsetAsync((char*)d_ws + OFF_CTL, 0, CTL_ZERO_BYTES, stream) != hipSuccess) { fprintf(stderr, "kernel_launch: memset failed\n"); return; }
    Params p{};
    for (int i = 0; i < 20; ++i) p.in[i] = (const float*)d_in[i];
    p.out = (float*)d_out; p.ws = (unsigned char*)d_ws;
#if MK_SINGLE
    p.ph_lo = 0; p.ph_hi = N_PHASES;
    void* args[] = {&p};
    hipError_t e = hipLaunchCooperativeKernel((const void*)mega, dim3(grid), dim3(NTHREADS), args, LDS_BYTES, stream);
    if (e != hipSuccess) fprintf(stderr, "cooperative launch failed: %s (grid %d)\n", hipGetErrorString(e), grid);
#else
    for (int ph = 0; ph < N_PHASES; ++ph) { p.ph_lo = ph; p.ph_hi = ph + 1; hipLaunchKernelGGL(mega, dim3(grid), dim3(NTHREADS), LDS_BYTES, stream, p); }
#endif
}
```

```cpp
#include <hip/hip_runtime.h>
#include <hip/hip_cooperative_groups.h>
#include <cstdio>
#include <cstdint>
namespace cg = cooperative_groups;
#define LAS __attribute__((address_space(3)))
namespace pg8 {
#define PG8_LAS __attribute__((address_space(3)))
typedef _Float16 f16x8 __attribute__((ext_vector_type(8)));
typedef float f32x4 __attribute__((ext_vector_type(4)));
typedef unsigned u32x4 __attribute__((ext_vector_type(4)));
typedef unsigned u32x2 __attribute__((ext_vector_type(2)));
constexpr int BM = 256, BK = 64, HALF = 128, HTB = HALF * BK * 2, STAGE_BYTES = 8 * HTB, NXCD = 8, WGM = 8;

__host__ __device__ __forceinline__ int lds_byte(int r, int c) { const int st = (r >> 4) * 2 + (c >> 5), rr = r & 15, cc = c & 31, ob = rr * 64 + cc * 2; return st * 1024 + (ob ^ (((ob >> 9) & 1) << 5)); }
__host__ __device__ __forceinline__ void stage_rc(int b, int& R, int& C) { const int st = b / 1024, sb = b % 1024, swz = sb ^ (((sb >> 9) & 1) << 5); R = (st >> 1) * 16 + swz / 64; C = (st & 1) * 32 + (swz % 64) / 2; }
__host__ __device__ __forceinline__ int perm32(int rho) { const int n = rho >> 4, i = rho & 15; return 8 * (i >> 2) + 4 * n + (i & 3); }

struct Unit { int pm, pn; };
struct Gemm { const void* A; const void* Bt; int lda, ldb, K; };

struct TileOrder {
    int nM, nN, nwg, G, c, rep;
    __device__ void init(int nM_, int nN_, int G_, int c_, int rep_ = 1) { nM = nM_; nN = nN_; nwg = nM * nN; G = G_; c = c_; rep = rep_; }
    __device__ bool map(long L, Unit& u) const {
        if (L >= nwg) return false;
        int wgid = (int)L; { const int q = nwg / NXCD, r = nwg % NXCD, xcd = wgid % NXCD, off = wgid / NXCD; wgid = (xcd < r ? xcd * (q + 1) : r * (q + 1) + (xcd - r) * q) + off; }
        const int nig = WGM * nN, gid = wgid / nig, fm = gid * WGM, gsz = (nM - fm) < WGM ? (nM - fm) : WGM;
        u.pm = fm + ((wgid % nig) % gsz); u.pn = (wgid % nig) / gsz; return true;
    }
    __device__ bool next(int i, Unit& u) const { const long L = (long)i * G + c; if (L >= (long)nwg * rep) return false; return map(L % nwg, u); }
};

template <class Epi, class Sched>
__device__ __forceinline__ void gemm_phase(PG8_LAS unsigned char* lds, const Gemm g, const Sched& S, const Epi& E) {
    const int tid = threadIdx.x, wid = __builtin_amdgcn_readfirstlane(tid >> 6), lane = tid & 63, wr = wid >> 2, wc = wid & 3, fr = lane & 15, fq = lane >> 4;
    const int K = g.K, nt = K / BK;
    unsigned voffA[2], voffB[2];
#pragma unroll
    for (int i = 0; i < 2; ++i) { int R, C; stage_rc(tid * 16 + i * 8192, R, C); const int Rb = Epi::PERM ? ((R & ~31) + perm32(R & 31)) : R;
        voffA[i] = (unsigned)(R * g.lda + C) * 2u; voffB[i] = (unsigned)(Rb * g.ldb + C) * 2u; }
    const size_t kstep = (size_t)(BK * 2);
    const size_t hstepA = (size_t)HALF * g.lda * 2, hstepB = (size_t)HALF * g.ldb * 2;
    const size_t tstepA = 2 * hstepA, tstepB = 2 * hstepB;
    const unsigned ldsw = (unsigned)wid * 1024u;
    const int aoff = lds_byte(wr * 64 + fr, fq * 8), boff = lds_byte(wc * 32 + fr, fq * 8);
#define PG8_SA(b, h) (((b) * 2 + (h)) * HTB)
#define PG8_SB(b, h) ((4 + (b) * 2 + (h)) * HTB)
#define PG8_STAGE(bufoff, gbase, voff) do { _Pragma("unroll") for (int _i = 0; _i < 2; ++_i) \
        __builtin_amdgcn_global_load_lds((const unsigned*)((const char*)(gbase) + (voff)[_i]), (PG8_LAS unsigned*)(lds + (bufoff) + ldsw + _i * 8192), 16, 0, 0); } while (0)
#define PG8_LDA(dst, b, h) do { _Pragma("unroll") for (int m = 0; m < 4; ++m) _Pragma("unroll") for (int k = 0; k < 2; ++k) dst[m][k] = *(const PG8_LAS f16x8*)(lds + PG8_SA(b, h) + aoff + m * 2048 + k * 1024); } while (0)
#define PG8_LDB(dst, b, h) do { _Pragma("unroll") for (int n = 0; n < 2; ++n) _Pragma("unroll") for (int k = 0; k < 2; ++k) dst[n][k] = *(const PG8_LAS f16x8*)(lds + PG8_SB(b, h) + boff + n * 2048 + k * 1024); } while (0)
#define PG8_MMA(ai, bj, At, Bt) do { __builtin_amdgcn_s_setprio(1); _Pragma("unroll") for (int m = 0; m < 4; ++m) _Pragma("unroll") for (int n = 0; n < 2; ++n) _Pragma("unroll") for (int k = 0; k < 2; ++k) \
        acc[ai][bj][m][n] = Epi::TRANS ? __builtin_amdgcn_mfma_f32_16x16x32_f16(Bt[n][k], At[m][k], acc[ai][bj][m][n], 0, 0, 0) \
                                       : __builtin_amdgcn_mfma_f32_16x16x32_f16(At[m][k], Bt[n][k], acc[ai][bj][m][n], 0, 0, 0); __builtin_amdgcn_s_setprio(0); } while (0)
#define PG8_WAIT_V(n) asm volatile("s_waitcnt vmcnt(" #n ")" ::: "memory")
#define PG8_WAIT_L(n) asm volatile("s_waitcnt lgkmcnt(" #n ")" ::: "memory")
#define PG8_BAR __builtin_amdgcn_s_barrier()
#define PG8_SCHED __builtin_amdgcn_sched_barrier(0)
    Unit cur, nxt; int ui = 0;
    if (!S.next(0, cur)) return;
    f32x4 acc[2][2][4][2];
#pragma unroll
    for (int a = 0; a < 2; ++a)
#pragma unroll
        for (int b = 0; b < 2; ++b)
#pragma unroll
            for (int m = 0; m < 4; ++m)
#pragma unroll
                for (int n = 0; n < 2; ++n) acc[a][b][m][n] = (f32x4){0.f, 0.f, 0.f, 0.f};
    f16x8 At[4][2], B0[2][2], B1[2][2];
    const char* cA = (const char*)g.A + (size_t)cur.pm * tstepA; const char* cB = (const char*)g.Bt + (size_t)cur.pn * tstepB;
    PG8_STAGE(PG8_SB(0, 0), cB, voffB); PG8_STAGE(PG8_SA(0, 0), cA, voffA); PG8_STAGE(PG8_SB(0, 1), cB + hstepB, voffB); PG8_STAGE(PG8_SA(0, 1), cA + hstepA, voffA);
    if (wr == 1) PG8_BAR;
    PG8_WAIT_V(4); PG8_BAR;
    PG8_STAGE(PG8_SB(1, 0), cB + kstep, voffB); PG8_STAGE(PG8_SA(1, 0), cA + kstep, voffA); PG8_STAGE(PG8_SB(1, 1), cB + hstepB + kstep, voffB);
    PG8_WAIT_V(6); PG8_BAR;
    for (;;) {
        const bool has_next = S.next(ui + 1, nxt);
        const char* nA = has_next ? (const char*)g.A + (size_t)nxt.pm * tstepA : cA; const char* nB = has_next ? (const char*)g.Bt + (size_t)nxt.pn * tstepB : cB;
        for (int t = 0; t < nt; t += 2) {
            const bool last = (t == nt - 2);
            const char* a1 = cA + (size_t)(t + 1) * kstep;
            const char* a2 = last ? nA : cA + (size_t)(t + 2) * kstep; const char* b2 = last ? nB : cB + (size_t)(t + 2) * kstep;
            const char* a3 = a2 + kstep; const char* b3 = b2 + kstep;
            PG8_LDB(B0, 0, 0); PG8_SCHED; PG8_LDA(At, 0, 0); PG8_STAGE(PG8_SA(1, 1), a1 + hstepA, voffA);
            PG8_WAIT_L(8); PG8_BAR; PG8_WAIT_L(0); PG8_MMA(0, 0, At, B0); PG8_BAR; PG8_SCHED;
            PG8_LDB(B1, 0, 1); PG8_STAGE(PG8_SB(0, 0), b2, voffB);
            PG8_BAR; PG8_WAIT_L(0); PG8_MMA(0, 1, At, B1); PG8_BAR;
            PG8_LDA(At, 0, 1); PG8_STAGE(PG8_SA(0, 0), a2, voffA);
            PG8_BAR; PG8_WAIT_L(0); PG8_MMA(1, 0, At, B0); PG8_BAR; PG8_SCHED;
            PG8_STAGE(PG8_SB(0, 1), b2 + hstepB, voffB);
            PG8_WAIT_V(6); PG8_BAR; PG8_MMA(1, 1, At, B1); PG8_BAR;
            PG8_LDB(B0, 1, 0); PG8_SCHED; PG8_LDA(At, 1, 0); PG8_STAGE(PG8_SA(0, 1), a2 + hstepA, voffA);
            PG8_WAIT_L(8); PG8_BAR; PG8_WAIT_L(0); PG8_MMA(0, 0, At, B0); PG8_BAR; PG8_SCHED;
            PG8_LDB(B1, 1, 1); PG8_STAGE(PG8_SB(1, 0), b3, voffB);
            PG8_BAR; PG8_WAIT_L(0); PG8_MMA(0, 1, At, B1); PG8_BAR;
            PG8_LDA(At, 1, 1); PG8_STAGE(PG8_SA(1, 0), a3, voffA);
            PG8_BAR; PG8_WAIT_L(0); PG8_MMA(1, 0, At, B0); PG8_BAR; PG8_SCHED;
            PG8_STAGE(PG8_SB(1, 1), b3 + hstepB, voffB);
            PG8_WAIT_V(6); PG8_BAR; PG8_MMA(1, 1, At, B1); PG8_BAR;
        }
        E(acc, cur, wr, wc, fr, fq);
        if (!has_next) break;
#pragma unroll
        for (int a = 0; a < 2; ++a)
#pragma unroll
            for (int b = 0; b < 2; ++b)
#pragma unroll
                for (int m = 0; m < 4; ++m)
#pragma unroll
                    for (int n = 0; n < 2; ++n) acc[a][b][m][n] = (f32x4){0.f, 0.f, 0.f, 0.f};
        cur = nxt; cA = nA; cB = nB; ++ui;
    }
    PG8_WAIT_V(0);
    if (wr == 0) PG8_BAR;
    PG8_BAR;
#undef PG8_SA
#undef PG8_SB
#undef PG8_STAGE
#undef PG8_LDA
#undef PG8_LDB
#undef PG8_MMA
#undef PG8_WAIT_V
#undef PG8_WAIT_L
#undef PG8_BAR
#undef PG8_SCHED
}
}
#define XB_TMO      128
#define XB_XCNT(j)  (256  + 64 * (j))
#define XB_XSUB(j)  (1280 + 64 * (j))
#define XB_XGEN(j)  (2304 + 64 * (j))
#define XB_TOP      3328
#define XB_TOPGEN   3392
#define XCD_BAR_WORDS 3456
#define XB_SPIN_CAP (1u << 20)


__device__ __forceinline__ unsigned xb_ld(unsigned* p)              { return __hip_atomic_load(p, __ATOMIC_RELAXED, __HIP_MEMORY_SCOPE_AGENT); }
__device__ __forceinline__ unsigned xb_add(unsigned* p, unsigned v) { return __hip_atomic_fetch_add(p, v, __ATOMIC_RELAXED, __HIP_MEMORY_SCOPE_AGENT); }
__device__ __forceinline__ unsigned xb_xcc_id() { return (unsigned)__builtin_amdgcn_s_getreg((3 << 11) | 20) & 0xFu; }
#define XB_SPIN(cond, bar) do { unsigned _sp = 0; while (cond) { __builtin_amdgcn_s_sleep(1); \
    if ((++_sp & 255u) == 0u) { if (xb_ld(&(bar)[XB_TMO])) break; if (_sp > XB_SPIN_CAP) { atomicAdd(&(bar)[XB_TMO], 1u); break; } } } } while (0)

struct XcdBarrier {
    unsigned* bar; unsigned x;
    volatile LAS unsigned* st;
};

__device__ __forceinline__ XcdBarrier xcd_barrier_post(unsigned* bar, volatile LAS unsigned* st) {
    XcdBarrier b; b.bar = bar; b.x = xb_xcc_id(); b.st = st;
    if (threadIdx.x == 0) (void)xb_add(&bar[XB_XCNT(b.x)], 1u);
    return b;
}
__device__ __forceinline__ void xcd_barrier_complete(unsigned* bar, unsigned x, unsigned& nloc, unsigned& nx) {
    const unsigned G = gridDim.x * gridDim.y * gridDim.z;
    unsigned sum, cnt, mine, sp = 0u;
    for (;;) {
        sum = 0u; cnt = 0u; mine = 0u;
#pragma unroll
        for (unsigned j = 0; j < 16; ++j) { const unsigned c = xb_ld(&bar[XB_XCNT(j)]); sum += c; cnt += (c > 0u) ? 1u : 0u; mine = (j == x) ? c : mine; }
        if (sum == G) break;
        __builtin_amdgcn_s_sleep(1);
        if ((++sp & 255u) == 0u) { if (xb_ld(&bar[XB_TMO])) break; if (sp > XB_SPIN_CAP) { atomicAdd(&bar[XB_TMO], 1u); break; } }
    }
    nloc = mine > 0u ? mine : 1u; nx = cnt > 0u ? cnt : 1u;
}

__device__ __forceinline__ void xcd_barrier(const XcdBarrier& b) {
    asm volatile("s_waitcnt vmcnt(0)" ::: "memory");
    __syncthreads();
    if (threadIdx.x == 0) {
        unsigned* bar = b.bar;
        __builtin_amdgcn_s_waitcnt(0);
        unsigned nloc = b.st[0], nx = b.st[1];
        if (nloc == 0u) { xcd_barrier_complete(bar, b.x, nloc, nx); b.st[0] = nloc; b.st[1] = nx; }
        const unsigned old = xb_add(&bar[XB_XSUB(b.x)], 1u);
        const unsigned gen = old / nloc;
        if (old + 1u == (gen + 1u) * nloc) {
            __builtin_amdgcn_fence(__ATOMIC_RELEASE, "agent");
            asm volatile("s_waitcnt vmcnt(0)" ::: "memory");
            const unsigned og = xb_add(&bar[XB_TOP], 1u);
            const unsigned tg = og / nx;
            if (og + 1u == (tg + 1u) * nx) xb_add(&bar[XB_TOPGEN], 1u);
            else XB_SPIN(xb_ld(&bar[XB_TOPGEN]) == tg, bar);
            __builtin_amdgcn_fence(__ATOMIC_ACQUIRE, "agent");
            xb_add(&bar[XB_XGEN(b.x)], 1u);
            asm volatile("s_waitcnt vmcnt(0)" ::: "memory");
        } else {
            XB_SPIN(xb_ld(&bar[XB_XGEN(b.x)]) == gen, bar);
            __builtin_amdgcn_fence(__ATOMIC_ACQUIRE, "agent");
            asm volatile("s_waitcnt vmcnt(0)" ::: "memory");
        }
    }
    __syncthreads();
}

typedef _Float16 h16;
typedef h16 h16x2 __attribute__((ext_vector_type(2)));
typedef h16 h16x4 __attribute__((ext_vector_type(4)));
typedef h16 h16x8 __attribute__((ext_vector_type(8)));
typedef float f32x4 __attribute__((ext_vector_type(4)));
typedef float f32x2 __attribute__((ext_vector_type(2)));
typedef unsigned u32x4 __attribute__((ext_vector_type(4)));
typedef unsigned u32x2 __attribute__((ext_vector_type(2)));

constexpr int D = 1024, NB = 8, SEQ = 4096, T = NB * SEQ, LC = 256, TC = NB * LC, TALL = T + TC;
constexpr int NTHREADS = 512;
constexpr int LDS_BYTES = 136 * 1024;
constexpr float EPS = 1e-6f;
constexpr size_t MiB = (size_t)1 << 20;
constexpr size_t OFF_CTL = 0;
constexpr size_t OFF_MOD = 64 * 1024;
constexpr size_t OFF_LB = 320 * 1024;
constexpr size_t OFF_WA = 1 * MiB;
constexpr size_t OFF_WG = 6 * MiB;
constexpr size_t OFF_WF = 10 * MiB;
constexpr size_t OFF_WHG = 12 * MiB;
constexpr size_t OFF_WFT = 13 * MiB;
constexpr size_t OFF_WOUT = 14 * MiB;
constexpr size_t OFF_WS = 16 * MiB;
constexpr size_t OFF_UALL = 20 * MiB;
constexpr size_t OFF_OF = 88 * MiB;
constexpr size_t OFF_OB = 120 * MiB;
constexpr size_t OFF_FTT = 152 * MiB;
constexpr size_t OFF_Q = 216 * MiB;
constexpr size_t OFF_LF = 248 * MiB;
constexpr size_t OFF_LBK = 282 * MiB;
constexpr size_t OFF_V = 316 * MiB;
constexpr size_t OFF_G = 350 * MiB;
constexpr size_t OFF_Y1 = 382 * MiB;
constexpr size_t OFF_DFT256 = 512 * 1024;
constexpr size_t OFF_YFT = 446 * MiB;
constexpr size_t OFF_USTATE = 446 * MiB;
constexpr size_t OFF_DLOG = 460 * MiB;
constexpr size_t WS_NEED = 510 * MiB;
constexpr size_t OFF_GH = 216 * MiB;
constexpr size_t OFF_GF = 280 * MiB;
constexpr size_t OFF_Y = 152 * MiB;
constexpr size_t OFF_U2 = 20 * MiB;
constexpr size_t OFF_TU = 478 * MiB;
constexpr size_t OFF_TV = 494 * MiB;
constexpr size_t OFF_QX = 120 * MiB;
constexpr size_t OFF_SU = 768 * 1024;
constexpr size_t OFF_SV = 832 * 1024;
constexpr size_t OFF_SX = 205 * MiB;
constexpr size_t OFF_SC = 216 * MiB;
constexpr size_t OFF_EIDX = 152 * MiB;
constexpr size_t OFF_GATE = 168 * MiB;
constexpr size_t OFF_W = 184 * MiB;
constexpr size_t OFF_PSS = 200 * MiB;
constexpr size_t OFF_PACT = 216 * MiB;
constexpr size_t OFF_H2 = 216 * MiB;
constexpr int CTL_RANK = 4096;
constexpr size_t CTL_ZERO_BYTES = 32 * 1024;

struct Params { const float* in[20]; float* out; unsigned char* ws; int ph_lo, ph_hi; };

__device__ __forceinline__ unsigned pk2(float a, float b) { h16x2 v = {(h16)a, (h16)b}; return __builtin_bit_cast(unsigned, v); }
__device__ __forceinline__ float wave_sum(float v) {
#pragma unroll
    for (int o = 32; o >= 1; o >>= 1) v += __shfl_xor(v, o);
    return v; }
__device__ __forceinline__ float sigmoidf_(float z) { return 1.0f / (1.0f + __expf(-z)); }

constexpr int N_MOD = 192, N_LB = 1, N_TRA = 640, N_TRG = 512, N_TRHG = 128, N_TRFT = 128, N_TROUT = 256, N_WF = 128, N_WSF = 256, N_DFT = 1;
constexpr int P0_TOTAL = N_MOD + N_LB + N_TRA + N_TRG + N_TRHG + N_TRFT + N_TROUT + N_WF + N_WSF + N_DFT;

__device__ __forceinline__ void p0_mod(const Params& p, LAS float* sm, int idx) {
    const int tid = threadIdx.x;
    for (int i = tid; i < 9 * 1024; i += NTHREADS) { const int r = i >> 10, k = i & 1023; const float c = (r < 8) ? p.in[1][r * 1024 + k] : p.in[3][k]; sm[i] = c / (1.0f + __expf(-c)); }
    __syncthreads();
    const int col = tid & 31, ks = tid >> 5;
    float acc[9];
#pragma unroll
    for (int r = 0; r < 9; ++r) acc[r] = 0.f;
    const float* w = p.in[4] + (size_t)(ks * 64) * 6144 + idx * 32 + col;
#pragma unroll 8
    for (int k = 0; k < 64; ++k) { const float wv = w[(size_t)k * 6144];
#pragma unroll
        for (int r = 0; r < 9; ++r) acc[r] += sm[r * 1024 + ks * 64 + k] * wv; }
    LAS float* red = sm + 9 * 1024;
#pragma unroll
    for (int r = 0; r < 9; ++r) red[(ks * 9 + r) * 32 + col] = acc[r];
    __syncthreads();
    float* mod = (float*)(p.ws + OFF_MOD);
    if (tid < 288) { const int r = tid >> 5, c = tid & 31; float s = 0.f;
#pragma unroll
        for (int q = 0; q < 16; ++q) s += red[(q * 9 + r) * 32 + c];
        mod[r * 6144 + idx * 32 + c] = s + p.in[5][idx * 32 + c]; }
    __syncthreads();
}
__device__ __forceinline__ void p0_lb(const Params& p) {
    const int tid = threadIdx.x; float* lb = (float*)(p.ws + OFF_LB);
    if (tid < 512) { lb[tid] = 1.0f / (1.0f + expf(p.in[9][512 + tid] - p.in[9][tid])); lb[512 + tid] = 1.0f / (1.0f + expf(p.in[10][512 + tid] - p.in[10][tid])); }
}
__device__ __forceinline__ void p0_transpose(const float* src, int ld_src, int ncol0, h16* dst, int ld_dst, int nktiles, int item, LAS float* sm) {
    const int tid = threadIdx.x, kt = item % nktiles, nt = item / nktiles;
    { const int n = tid & 63, kk = tid >> 6;
#pragma unroll
      for (int ps = 0; ps < 8; ++ps) { const int k = kk + 8 * ps; sm[k * 65 + n] = src[(size_t)(kt * 64 + k) * ld_src + ncol0 + nt * 64 + n]; } }
    __syncthreads();
    { const int k = tid & 63, nn = tid >> 6;
#pragma unroll
      for (int ps = 0; ps < 8; ++ps) { const int n = nn + 8 * ps; dst[(size_t)(nt * 64 + n) * ld_dst + kt * 64 + k] = (h16)sm[k * 65 + n]; } }
    __syncthreads();
}
__device__ __forceinline__ void p0_wf(const Params& p, LAS float* sm, int item) {
    const int tid = threadIdx.x, dt = item & 15, part = (item >> 4) & 1, g = item >> 5, d0 = dt * 64;
    LAS float* w = sm; LAS float* trig = sm + 64 * 129;
    for (int i = tid; i < 64 * 128; i += NTHREADS) { const int dl = i >> 7, n2 = i & 127; w[dl * 129 + n2] = p.in[8][(size_t)(d0 + dl) * 5120 + 2560 + g * 128 + n2]; }
    if (tid < 128) trig[tid] = part ? sinpif((float)tid / 64.0f) : cospif((float)tid / 64.0f);
    __syncthreads();
    const int dl = tid & 63, kg = tid >> 6; h16* WF = (h16*)(p.ws + OFF_WF);
#pragma unroll 1
    for (int kk = 0; kk < 16; ++kk) { const int k2 = kg * 16 + kk; float s = 0.f;
#pragma unroll 4
        for (int n2 = 0; n2 < 128; ++n2) s += w[dl * 129 + n2] * trig[(k2 * n2) & 127];
        WF[(size_t)(part * 512 + g * 128 + k2) * 1024 + d0 + dl] = (h16)(s * 0.08838834764831845f); }
    __syncthreads();
}
__device__ __forceinline__ void p0_wsf(const Params& p, LAS float* sm, int item) {
    const int tid = threadIdx.x, dt = item & 15, hp = item >> 4, d0 = dt * 64;
    LAS float* wq = sm; LAS float* sk = sm + 8256;
    for (int i = tid; i < 64 * 128; i += NTHREADS) { const int dl = i >> 7, k = i & 127; wq[dl * 129 + k] = p.in[15][(size_t)(d0 + dl) * 2048 + hp * 128 + k]; }
    for (int i = tid; i < 128 * 128; i += NTHREADS) sk[i] = p.in[16][(size_t)hp * 16384 + i];
    __syncthreads();
    const int dl = tid & 63, ng = tid >> 6; h16* WS = (h16*)(p.ws + OFF_WS);
#pragma unroll 1
    for (int nn = 0; nn < 16; ++nn) { const int n = ng * 16 + nn; float s = 0.f;
#pragma unroll 4
        for (int k = 0; k < 128; ++k) s += wq[dl * 129 + k] * sk[n * 128 + k];
        WS[(size_t)(hp * 128 + n) * 1024 + d0 + dl] = (h16)s; }
    __syncthreads();
}
__device__ __forceinline__ void p0_dft256(const Params& p) {
    h16* M = (h16*)(p.ws + OFF_DFT256);
    for (int e = threadIdx.x; e < 256 * 512; e += NTHREADS) { const int c = e >> 9, k = e & 511, part = k >> 8, a = k & 255; const int m = (a * c) & 255;
        M[e] = (h16)((part ? sinpif((float)m / 128.0f) : cospif((float)m / 128.0f)) * 0.25f); }
}
__device__ __forceinline__ void phase0(const Params& p, LAS unsigned char* lds) {
    LAS float* sm = (LAS float*)lds;
    for (int it = blockIdx.x; it < P0_TOTAL; it += gridDim.x) {
        int i = it;
        if (i < N_MOD) { p0_mod(p, sm, i); continue; } i -= N_MOD;
        if (i < N_LB) { p0_lb(p); continue; } i -= N_LB;
        if (i < N_TRA) { p0_transpose(p.in[8], 5120, 0, (h16*)(p.ws + OFF_WA), 1024, 16, i, sm); continue; } i -= N_TRA;
        if (i < N_TRG) { p0_transpose(p.in[8], 5120, 3072, (h16*)(p.ws + OFF_WG), 1024, 16, i, sm); continue; } i -= N_TRG;
        if (i < N_TRHG) { p0_transpose(p.in[12], 1024, 0, (h16*)(p.ws + OFF_WHG), 512, 8, i, sm); continue; } i -= N_TRHG;
        if (i < N_TRFT) { p0_transpose(p.in[13], 1024, 0, (h16*)(p.ws + OFF_WFT), 512, 8, i, sm); continue; } i -= N_TRFT;
        if (i < N_TROUT) { p0_transpose(p.in[14], 1024, 0, (h16*)(p.ws + OFF_WOUT), 1024, 16, i, sm); continue; } i -= N_TROUT;
        if (i < N_WF) { p0_wf(p, sm, i); continue; } i -= N_WF;
        if (i < N_WSF) { p0_wsf(p, sm, i); continue; } i -= N_WSF;
        p0_dft256(p);
    }
}

__device__ __forceinline__ void modulate_rows(const float* src, h16* dst, int nrows, const float* gvec, const float* mod, int sh_off, int sc_off, int ctx_rows, signed char* qdst = nullptr, float* qscale = nullptr) {
    const int wave = threadIdx.x >> 6, lane = threadIdx.x & 63;
    for (int row = blockIdx.x * 8 + wave; row < nrows; row += gridDim.x * 8) {
        const int mr = ctx_rows ? 8 : (row >> 12);
        const float* x = src + (size_t)row * D;
        f32x4 v[4]; float ss = 0.f;
#pragma unroll
        for (int j = 0; j < 4; ++j) { v[j] = *(const f32x4*)(x + j * 256 + lane * 4); ss += v[j].x * v[j].x + v[j].y * v[j].y + v[j].z * v[j].z + v[j].w * v[j].w; }
        ss = wave_sum(ss);
        const float rstd = rsqrtf(ss * (1.0f / D) + EPS);
        float amax = 0.f;
#pragma unroll
        for (int j = 0; j < 4; ++j) { const int c = j * 256 + lane * 4;
            const f32x4 gg = *(const f32x4*)(gvec + c), sc = *(const f32x4*)(mod + mr * 6144 + sc_off + c), sh = *(const f32x4*)(mod + mr * 6144 + sh_off + c);
            const f32x4 o = (v[j] * rstd) * gg * (sc + 1.0f) + sh; v[j] = o;
            amax = fmaxf(amax, fmaxf(fmaxf(fabsf(o.x), fabsf(o.y)), fmaxf(fabsf(o.z), fabsf(o.w))));
            u32x2 w; w.x = pk2(o.x, o.y); w.y = pk2(o.z, o.w);
            *(u32x2*)(dst + (size_t)row * D + c) = w; }
        if (qdst) {
#pragma unroll
            for (int o = 32; o >= 1; o >>= 1) amax = fmaxf(amax, __shfl_xor(amax, o));
            const float qs = amax > 0.f ? amax * (1.0f / 127.0f) : 1.0f, inv = 1.0f / qs;
#pragma unroll
            for (int j = 0; j < 4; ++j) { const int c = j * 256 + lane * 4;
                const int q0 = (int)rintf(v[j].x * inv), q1 = (int)rintf(v[j].y * inv), q2 = (int)rintf(v[j].z * inv), q3 = (int)rintf(v[j].w * inv);
                *(unsigned*)(qdst + (size_t)row * D + c) = (unsigned)(q0 & 255) | ((unsigned)(q1 & 255) << 8) | ((unsigned)(q2 & 255) << 16) | ((unsigned)(q3 & 255) << 24); }
            if (lane == 0) qscale[row] = qs;
        }
    }
}

struct EpiA {
    static constexpr bool PERM = true, TRANS = true;
    unsigned char* ws;
    __device__ __forceinline__ void operator()(const f32x4 (&acc)[2][2][4][2], const pg8::Unit& u, int wr, int wc, int fr, int fq) const {
        const int ty = u.pn >> 1;
        h16* base = (h16*)(ws + (ty == 0 ? OFF_Q : ty == 1 ? OFF_LF : ty == 2 ? OFF_LBK : ty == 3 ? OFF_V : OFF_G));
        const float* lb = (const float*)(ws + OFF_LB) + (ty == 2 ? 512 : 0);
        const int row0 = u.pm * 256 + wr * 64 + fr, col0 = (u.pn & 1) * 256 + wc * 32 + 8 * fq;
#pragma unroll
        for (int bj = 0; bj < 2; ++bj) {
            float lbv[8];
            if (ty == 1 || ty == 2) {
#pragma unroll
                for (int j = 0; j < 8; ++j) lbv[j] = lb[col0 + bj * 128 + j];
            }
#pragma unroll
            for (int ai = 0; ai < 2; ++ai)
#pragma unroll
                for (int m = 0; m < 4; ++m) {
                    float v[8];
#pragma unroll
                    for (int j = 0; j < 4; ++j) { v[j] = acc[ai][bj][m][0][j]; v[4 + j] = acc[ai][bj][m][1][j]; }
                    if (ty == 0) {
#pragma unroll
                        for (int j = 0; j < 8; ++j) v[j] *= 0.08838834764831845f;
                    } else if (ty == 1 || ty == 2) {
#pragma unroll
                        for (int j = 0; j < 8; ++j) v[j] = __logf(lbv[j] + (1.0f - lbv[j]) * sigmoidf_(v[j]));
                    } else if (ty == 4) {
#pragma unroll
                        for (int j = 0; j < 8; ++j) v[j] = v[j] * sigmoidf_(v[j]);
                    }
                    u32x4 w; w.x = pk2(v[0], v[1]); w.y = pk2(v[2], v[3]); w.z = pk2(v[4], v[5]); w.w = pk2(v[6], v[7]);
                    *(u32x4*)(base + (size_t)(row0 + ai * 128 + m * 16) * 512 + col0 + bj * 128) = w;
                }
        }
    }
};
struct OrderA {
    pg8::TileOrder lat; int G, c, rep;
    __device__ void init(int G_, int c_, int rep_ = 1) { lat.init(128, 10, G_, c_); G = G_; c = c_; rep = rep_; }
    __device__ bool next(int i, pg8::Unit& u) const {
        long L = (long)i * G + c; if (L >= 1328L * rep) return false; L %= 1328;
        if (L < 1280) return lat.map(L, u);
        const int l2 = (int)(L - 1280); if (l2 >= 48) return false;
        u.pm = 128 + l2 / 6; u.pn = 2 + l2 % 6; return true;
    }
};
struct EpiGate {
    static constexpr bool PERM = true, TRANS = true;
    unsigned char* ws;
    __device__ __forceinline__ void operator()(const f32x4 (&acc)[2][2][4][2], const pg8::Unit& u, int wr, int wc, int fr, int fq) const {
        h16* base = (h16*)(ws + (u.pn < 4 ? OFF_GH : OFF_GF));
        const int row0 = u.pm * 256 + wr * 64 + fr, col0 = (u.pn & 3) * 256 + wc * 32 + 8 * fq;
#pragma unroll
        for (int ai = 0; ai < 2; ++ai)
#pragma unroll
            for (int m = 0; m < 4; ++m)
#pragma unroll
                for (int bj = 0; bj < 2; ++bj) {
                    float v[8];
#pragma unroll
                    for (int j = 0; j < 4; ++j) { v[j] = sigmoidf_(acc[ai][bj][m][0][j]); v[4 + j] = sigmoidf_(acc[ai][bj][m][1][j]); }
                    u32x4 w; w.x = pk2(v[0], v[1]); w.y = pk2(v[2], v[3]); w.z = pk2(v[4], v[5]); w.w = pk2(v[6], v[7]);
                    *(u32x4*)(base + (size_t)(row0 + ai * 128 + m * 16) * 1024 + col0 + bj * 128) = w;
                }
    }
};
struct EpiFT {
    static constexpr bool PERM = false, TRANS = false;
    unsigned char* ws;
    __device__ __forceinline__ void operator()(const f32x4 (&acc)[2][2][4][2], const pg8::Unit& u, int wr, int wc, int fr, int fq) const {
        h16* F = (h16*)(ws + OFF_FTT);
        const int t0 = u.pm * 256 + wr * 64 + 4 * fq, c0 = u.pn * 256 + wc * 32 + fr;
#pragma unroll
        for (int ai = 0; ai < 2; ++ai)
#pragma unroll
            for (int m = 0; m < 4; ++m)
#pragma unroll
                for (int bj = 0; bj < 2; ++bj)
#pragma unroll
                    for (int n = 0; n < 2; ++n) {
                        const int t = t0 + ai * 128 + m * 16, c = c0 + bj * 128 + n * 16;
                        const int b = t >> 12, n1 = t & 4095, part = c >> 9, gk = c & 511;
                        const f32x4 a = acc[ai][bj][m][n];
                        u32x2 w; w.x = pk2(a.x, a.y); w.y = pk2(a.z, a.w);
                        *(u32x2*)(F + ((size_t)((b * 512 + gk) * 2 + part)) * 4096 + n1) = w;
                    }
    }
};
struct EpiDFT {
    static constexpr bool PERM = true, TRANS = true;
    unsigned char* ws;
    __device__ __forceinline__ void operator()(const f32x4 (&acc)[2][2][4][2], const pg8::Unit& u, int wr, int wc, int fr, int fq) const {
        h16* Y = (h16*)(ws + OFF_YFT);
        const int b = u.pn >> 5, d = (u.pn >> 1) & 15;
        const int c0 = wr * 64 + fr, col0 = (u.pn & 1) * 256 + wc * 32 + 8 * fq;
#pragma unroll
        for (int ai = 0; ai < 2; ++ai)
#pragma unroll
            for (int m = 0; m < 4; ++m)
#pragma unroll
                for (int bj = 0; bj < 2; ++bj) {
                    const int c = c0 + ai * 128 + m * 16;
                    const f32x4 a0 = acc[ai][bj][m][0], a1 = acc[ai][bj][m][1];
                    u32x4 w; w.x = pk2(a0.x, a0.y); w.y = pk2(a0.z, a0.w); w.z = pk2(a1.x, a1.y); w.w = pk2(a1.z, a1.w);
                    *(u32x4*)(Y + (size_t)(b * 4096 + d + 16 * c) * 512 + col0 + bj * 128) = w;
                }
    }
};
template <bool ACCUM> struct EpiMerge1 {
    static constexpr bool PERM = true, TRANS = true;
    unsigned char* ws;
    __device__ __forceinline__ void operator()(const f32x4 (&acc)[2][2][4][2], const pg8::Unit& u, int wr, int wc, int fr, int fq) const {
        h16* Y = (h16*)(ws + OFF_Y); const h16* GT = (const h16*)(ws + (ACCUM ? OFF_GF : OFF_GH));
        const int row0 = u.pm * 256 + wr * 64 + fr, col0 = u.pn * 256 + wc * 32 + 8 * fq;
#pragma unroll
        for (int ai = 0; ai < 2; ++ai)
#pragma unroll
            for (int m = 0; m < 4; ++m)
#pragma unroll
                for (int bj = 0; bj < 2; ++bj) {
                    const size_t off = (size_t)(row0 + ai * 128 + m * 16) * 1024 + col0 + bj * 128;
                    const h16x8 gt = *(const h16x8*)(GT + off);
                    float v[8];
#pragma unroll
                    for (int j = 0; j < 4; ++j) { v[j] = acc[ai][bj][m][0][j] * (float)gt[j]; v[4 + j] = acc[ai][bj][m][1][j] * (float)gt[4 + j]; }
                    if (ACCUM) { const h16x8 y0 = *(const h16x8*)(Y + off);
#pragma unroll
                        for (int j = 0; j < 8; ++j) v[j] += (float)y0[j]; }
                    u32x4 w; w.x = pk2(v[0], v[1]); w.y = pk2(v[2], v[3]); w.z = pk2(v[4], v[5]); w.w = pk2(v[6], v[7]);
                    *(u32x4*)(Y + off) = w;
                }
    }
};
struct EpiMerge2 {
    static constexpr bool PERM = false, TRANS = true;
    const float* x; float* H; const float* mod;
    __device__ __forceinline__ void operator()(const f32x4 (&acc)[2][2][4][2], const pg8::Unit& u, int wr, int wc, int fr, int fq) const {
        const int row0 = u.pm * 256 + wr * 64 + fr, col0 = u.pn * 256 + wc * 32 + 4 * fq;
        const int b = (u.pm * 256) >> 12;
        f32x4 g1[2][2];
#pragma unroll
        for (int bj = 0; bj < 2; ++bj)
#pragma unroll
            for (int n = 0; n < 2; ++n) g1[bj][n] = *(const f32x4*)(mod + b * 6144 + 2048 + col0 + bj * 128 + n * 16);
#pragma unroll
        for (int ai = 0; ai < 2; ++ai)
#pragma unroll
            for (int m = 0; m < 4; ++m) { const size_t ro = (size_t)(row0 + ai * 128 + m * 16) * 1024 + col0;
#pragma unroll
                for (int bj = 0; bj < 2; ++bj)
#pragma unroll
                    for (int n = 0; n < 2; ++n) { const f32x4 xv = *(const f32x4*)(x + ro + bj * 128 + n * 16);
                        *(f32x4*)(H + ro + bj * 128 + n * 16) = xv + g1[bj][n] * acc[ai][bj][m][n]; } }
    }
};
struct EpiF32 {
    static constexpr bool PERM = false, TRANS = true;
    float* C; int ldc;
    __device__ __forceinline__ void operator()(const f32x4 (&acc)[2][2][4][2], const pg8::Unit& u, int wr, int wc, int fr, int fq) const {
        const int row0 = u.pm * 256 + wr * 64 + fr, col0 = u.pn * 256 + wc * 32 + 4 * fq;
#pragma unroll
        for (int ai = 0; ai < 2; ++ai)
#pragma unroll
            for (int m = 0; m < 4; ++m) { float* rowp = C + (size_t)(row0 + ai * 128 + m * 16) * ldc + col0;
#pragma unroll
                for (int bj = 0; bj < 2; ++bj)
#pragma unroll
                    for (int n = 0; n < 2; ++n) *(f32x4*)(rowp + bj * 128 + n * 16) = acc[ai][bj][m][n]; }
    }
};

__device__ __forceinline__ int hgrn_row(int pos, int b, int dir) {
    if (pos < LC) { const int j = dir ? (LC - 1 - pos) : pos; return T + b * LC + j; }
    const int t = pos - LC; return b * SEQ + (dir ? (SEQ - 1 - t) : t);
}
__device__ void hgrn_item(const Params& p, LAS unsigned char* lds, int item) {
    const int tid = threadIdx.x, vq = item & 3, dir = (item >> 2) & 1, h = (item >> 3) & 3, b = item >> 5;
    const h16* Q = (const h16*)(p.ws + OFF_Q); const h16* LF = (const h16*)(p.ws + (dir ? OFF_LBK : OFF_LF)); const h16* V = (const h16*)(p.ws + OFF_V);
    h16* O = (h16*)(p.ws + (dir ? OFF_OB : OFF_OF));
    LAS float* fs = (LAS float*)lds; LAS float* ks = fs + 16 * 128; LAS float* qs = ks + 16 * 128; LAS float* vs = qs + 16 * 128; LAS float* po = vs + 16 * 32;
    const int v = tid & 31, kq = tid >> 5;
    float S[8];
#pragma unroll
    for (int j = 0; j < 8; ++j) S[j] = 0.f;
    const int e = tid * 4, tl_ld = e >> 7, k_ld = e & 127;
    const int tl_v = tid >> 5, vv = tid & 31;
    h16x4 lf4, q4; h16 v1;
    { const int row = hgrn_row(tl_ld, b, dir); lf4 = *(const h16x4*)(LF + (size_t)row * 512 + h * 128 + k_ld); q4 = (h16x4){0, 0, 0, 0};
      const int row2 = hgrn_row(tl_v, b, dir); v1 = V[(size_t)row2 * 512 + h * 128 + vq * 32 + vv]; }
    constexpr int NG = (LC + SEQ) / 16;
    for (int grp = 0; grp < NG; ++grp) {
        const bool latent = grp >= LC / 16;
#pragma unroll
        for (int j = 0; j < 4; ++j) { const float f = __expf((float)lf4[j]); fs[e + j] = f; ks[e + j] = 1.0f - f; qs[e + j] = (float)q4[j]; }
        vs[tid] = (float)v1;
        __syncthreads();
        if (grp + 1 < NG) { const int pos = (grp + 1) * 16; const bool lat2 = (grp + 1) >= LC / 16;
            const int row = hgrn_row(pos + tl_ld, b, dir); lf4 = *(const h16x4*)(LF + (size_t)row * 512 + h * 128 + k_ld);
            if (lat2) q4 = *(const h16x4*)(Q + (size_t)row * 512 + h * 128 + k_ld);
            const int row2 = hgrn_row(pos + tl_v, b, dir); v1 = V[(size_t)row2 * 512 + h * 128 + vq * 32 + vv]; }
#pragma unroll 4
        for (int tl = 0; tl < 16; ++tl) {
            const float vt = vs[tl * 32 + v];
            const f32x4 f0 = *(const LAS f32x4*)(fs + tl * 128 + kq * 8), f1 = *(const LAS f32x4*)(fs + tl * 128 + kq * 8 + 4);
            const f32x4 k0 = *(const LAS f32x4*)(ks + tl * 128 + kq * 8), k1 = *(const LAS f32x4*)(ks + tl * 128 + kq * 8 + 4);
            const f32x4 q0 = *(const LAS f32x4*)(qs + tl * 128 + kq * 8), q1 = *(const LAS f32x4*)(qs + tl * 128 + kq * 8 + 4);
            float a = 0.f;
#pragma unroll
            for (int j = 0; j < 4; ++j) { S[j] = f0[j] * S[j] + k0[j] * vt; a += S[j] * q0[j]; S[4 + j] = f1[j] * S[4 + j] + k1[j] * vt; a += S[4 + j] * q1[j]; }
            po[(tl * 16 + kq) * 32 + v] = a;
        }
        __syncthreads();
        if (latent) { float s = 0.f;
#pragma unroll
            for (int q = 0; q < 16; ++q) s += po[(tl_v * 16 + q) * 32 + vv];
            const int row = hgrn_row(grp * 16 + tl_v, b, dir);
            O[(size_t)row * 512 + h * 128 + vq * 32 + vv] = (h16)s; }
    }
    __syncthreads();
}

typedef short s16x8 __attribute__((ext_vector_type(8)));
typedef short s16x4 __attribute__((ext_vector_type(4)));
__device__ __forceinline__ unsigned cvt_pk_bf16(float lo, float hi) { unsigned r; asm volatile("v_cvt_pk_bf16_f32 %0, %1, %2" : "=v"(r) : "v"(lo), "v"(hi)); return r; }
constexpr int HG_RP = 272, HG_QT = 0, HG_KT = 17408, HG_QD = 34816, HG_KDT = 52224, HG_VT = 68608, HG_AM = 84992, HG_DEC = 93184, HG_SEG = 93696, HG_SEGCH = 17;
#define HG_OPAQUE(x) asm volatile("" : "+v"(x))
template <bool FULL>
__device__ __forceinline__ void hgrn_mfma_unit(const Params& p, LAS unsigned char* lds, int item, int seg) {
    const int tid = threadIdx.x, wave = __builtin_amdgcn_readfirstlane(tid >> 6), lane = tid & 63, fr = lane & 15, fq = lane >> 4;
    const int dir = item & 1, h = (item >> 1) & 3, b = item >> 3;
    const h16* Q = (const h16*)(p.ws + OFF_Q); const h16* LF = (const h16*)(p.ws + (dir ? OFF_LBK : OFF_LF)); const h16* V = (const h16*)(p.ws + OFF_V);
    h16* O = (h16*)(p.ws + (dir ? OFF_OB : OFF_OF));
    float* USTATE = (float*)(p.ws + OFF_USTATE); float* DLOG = (float*)(p.ws + OFF_DLOG);
    const int ch_lo = seg * HG_SEGCH, ch_hi = ch_lo + HG_SEGCH;
    f32x4 S[8];
#pragma unroll
    for (int m = 0; m < 8; ++m) S[m] = (f32x4){0.f, 0.f, 0.f, 0.f};
    if (FULL && seg > 0) {
        for (int i = 0; i < seg; ++i) { const float* U = USTATE + (size_t)(item * 3 + i) * 16384; const float* DL = DLOG + (size_t)(item * 3 + i) * 128;
#pragma unroll
            for (int m = 0; m < 8; ++m)
#pragma unroll
                for (int j = 0; j < 4; ++j) { const int k = 16 * m + 4 * fq + j; const float d = (i > 0) ? __expf(DL[k]) : 0.f; S[m][j] = d * S[m][j] + U[k * 128 + 16 * wave + fr]; } } }
    float dl0 = 0.f, dl1 = 0.f;
    for (int i = tid; i < 8192 / 16; i += NTHREADS) ((LAS u32x4*)(lds + HG_AM))[i] = (u32x4){0u, 0u, 0u, 0u};
    const int kp = lane;
    const unsigned chan = (unsigned)(h * 128 + 2 * kp);
    int bw_rm = wave * 8 * HG_RP + 4 * kp;
    int bw_t0 = (2 * kp) * 128 + ((wave ^ ((2 * kp) & 7)) << 4), bw_t1 = (2 * kp + 1) * 128 + ((wave ^ ((2 * kp + 1) & 7)) << 4);
    int br_rm = fr * HG_RP + 16 * fq;
    int br_qd = HG_QD + fr * HG_RP + 8 * fq;
    int br_t0 = fr * 128 + ((fq ^ (fr & 7)) << 4), br_t1 = fr * 128 + (((4 + fq) ^ (fr & 7)) << 4);
    HG_OPAQUE(bw_rm); HG_OPAQUE(bw_t0); HG_OPAQUE(bw_t1); HG_OPAQUE(br_rm); HG_OPAQUE(br_qd); HG_OPAQUE(br_t0); HG_OPAQUE(br_t1);
    int br_v0 = br_t0 + HG_VT + wave * 2048, br_v1 = br_t1 + HG_VT + wave * 2048, br_k0 = br_t0 + HG_KDT, br_k1 = br_t1 + HG_KDT, br_a0 = br_t0 + HG_AM, br_a1 = br_t1 + HG_AM;
    HG_OPAQUE(br_v0); HG_OPAQUE(br_v1); HG_OPAQUE(br_k0); HG_OPAQUE(br_k1); HG_OPAQUE(br_a0); HG_OPAQUE(br_a1);
    LAS float* DEC = (LAS float*)(lds + HG_DEC); LAS float* SEG = (LAS float*)(lds + HG_SEG);
    unsigned lfr[8], qr[8], vr[8];
#pragma unroll
    for (int r = 0; r < 8; ++r) { const unsigned eo = (unsigned)hgrn_row(ch_lo * 64 + 8 * wave + r, b, dir) * 512u + chan; lfr[r] = *(const unsigned*)(LF + eo); vr[r] = *(const unsigned*)(V + eo);
        qr[r] = (FULL && ch_lo >= LC / 64) ? *(const unsigned*)(Q + eo) : 0u; }
    for (int ch = ch_lo; ch < ch_hi; ++ch) {
        const bool latent = FULL && (ch >= LC / 64);
        float c0[8], c1[8]; float run0 = 0.f, run1 = 0.f;
#pragma unroll
        for (int r = 0; r < 8; ++r) { const h16x2 l = __builtin_bit_cast(h16x2, lfr[r]); run0 += (float)l[0]; run1 += (float)l[1]; c0[r] = run0; c1[r] = run1; }
        *(LAS f32x2*)(SEG + wave * 128 + 2 * kp) = (f32x2){run0, run1};
        __syncthreads();
        float off0 = 0.f, off1 = 0.f, mid0 = 0.f, mid1 = 0.f, tot0 = 0.f, tot1 = 0.f;
#pragma unroll
        for (int w2 = 0; w2 < 8; ++w2) { const f32x2 tt = *(LAS f32x2*)(SEG + w2 * 128 + 2 * kp);
            if (w2 < wave) { off0 += tt[0]; off1 += tt[1]; } if (w2 < 4) { mid0 += tt[0]; mid1 += tt[1]; } tot0 += tt[0]; tot1 += tt[1]; }
        dl0 += tot0; dl1 += tot1;
        const float em0 = __expf(mid0), em1 = __expf(mid1), el0 = __expf(tot0 - mid0), el1 = __expf(tot1 - mid1);
        if (wave == 0) *(LAS f32x2*)(DEC + 2 * kp) = (f32x2){__expf(tot0), __expf(tot1)};
        unsigned kd0[4], kd1[4], vt0[4], vt1[4];
#pragma unroll
        for (int r = 0; r < 8; ++r) {
            const h16x2 l = __builtin_bit_cast(h16x2, lfr[r]), q = __builtin_bit_cast(h16x2, qr[r]), v = __builtin_bit_cast(h16x2, vr[r]);
            const float b0 = off0 + c0[r], b1 = off1 + c1[r];
            const float e20 = __expf(mid0 - b0), e21 = __expf(mid1 - b1);
            const float k0 = 1.0f - __expf((float)l[0]), k1 = 1.0f - __expf((float)l[1]);
            const float kt0 = k0 * e20, kt1 = k1 * e21;
            if (FULL) {
                const float e10 = __expf(b0 - mid0), e11 = __expf(b1 - mid1);
                const float qt0 = (float)q[0] * e10, qt1 = (float)q[1] * e11;
                *(LAS unsigned*)(lds + bw_rm + HG_QT + r * HG_RP) = cvt_pk_bf16(qt0, qt1);
                *(LAS unsigned*)(lds + bw_rm + HG_KT + r * HG_RP) = cvt_pk_bf16(kt0, kt1);
                *(LAS unsigned*)(lds + bw_rm + HG_QD + r * HG_RP) = cvt_pk_bf16(qt0 * em0, qt1 * em1);
            }
            const float kdv0 = kt0 * el0, kdv1 = kt1 * el1;
            if (r & 1) { kd0[r >> 1] = cvt_pk_bf16(__builtin_bit_cast(float, kd0[r >> 1]), kdv0); kd1[r >> 1] = cvt_pk_bf16(__builtin_bit_cast(float, kd1[r >> 1]), kdv1);
                         vt0[r >> 1] = cvt_pk_bf16(__builtin_bit_cast(float, vt0[r >> 1]), (float)v[0]); vt1[r >> 1] = cvt_pk_bf16(__builtin_bit_cast(float, vt1[r >> 1]), (float)v[1]); }
            else { kd0[r >> 1] = __builtin_bit_cast(unsigned, kdv0); kd1[r >> 1] = __builtin_bit_cast(unsigned, kdv1);
                   vt0[r >> 1] = __builtin_bit_cast(unsigned, (float)v[0]); vt1[r >> 1] = __builtin_bit_cast(unsigned, (float)v[1]); }
        }
        *(LAS u32x4*)(lds + bw_t0 + HG_KDT) = (u32x4){kd0[0], kd0[1], kd0[2], kd0[3]};
        *(LAS u32x4*)(lds + bw_t1 + HG_KDT) = (u32x4){kd1[0], kd1[1], kd1[2], kd1[3]};
        *(LAS u32x4*)(lds + bw_t0 + HG_VT) = (u32x4){vt0[0], vt0[1], vt0[2], vt0[3]};
        *(LAS u32x4*)(lds + bw_t1 + HG_VT) = (u32x4){vt1[0], vt1[1], vt1[2], vt1[3]};
        __syncthreads();
        if (ch + 1 < ch_hi) { const bool lat2 = FULL && ((ch + 1) >= LC / 64);
#pragma unroll
            for (int r = 0; r < 8; ++r) { const unsigned eo = (unsigned)hgrn_row((ch + 1) * 64 + 8 * wave + r, b, dir) * 512u + chan;
                lfr[r] = *(const unsigned*)(LF + eo); vr[r] = *(const unsigned*)(V + eo); qr[r] = lat2 ? *(const unsigned*)(Q + eo) : 0u; } }
        if (latent) {
#pragma unroll
            for (int rep = 0; rep < 2; ++rep) {
                const int tile = wave + 8 * rep;
                if (tile < 10) {
                    const int ti = tile < 1 ? 0 : tile < 3 ? 1 : tile < 6 ? 2 : 3, si = tile - (ti * (ti + 1)) / 2;
                    f32x4 acc = (f32x4){0.f, 0.f, 0.f, 0.f};
                    LAS unsigned char* pa = lds + br_rm + HG_KT + 16 * si * HG_RP; LAS unsigned char* pb = lds + br_rm + HG_QT + 16 * ti * HG_RP;
#pragma unroll
                    for (int kk = 0; kk < 4; ++kk) acc = __builtin_amdgcn_mfma_f32_16x16x32_bf16(*(LAS s16x8*)(pa + 64 * kk), *(LAS s16x8*)(pb + 64 * kk), acc, 0, 0, 0);
                    const int t = 16 * ti + fr, s0 = 16 * si + 4 * fq;
                    if (ti == si) {
#pragma unroll
                        for (int j = 0; j < 4; ++j) acc[j] = (s0 + j <= t) ? acc[j] : 0.f; }
                    *(LAS u32x2*)(lds + HG_AM + t * 128 + ((((s0 >> 3)) ^ (fr & 7)) << 4) + (s0 & 7) * 2) = (u32x2){cvt_pk_bf16(acc[0], acc[1]), cvt_pk_bf16(acc[2], acc[3])};
                }
            }
        }
        __syncthreads();
        const s16x8 vf0 = *(LAS s16x8*)(lds + br_v0), vf1 = *(LAS s16x8*)(lds + br_v1);
        if (latent) {
            s16x8 sfrag[4];
#pragma unroll
            for (int kk = 0; kk < 4; ++kk) { const unsigned w0 = cvt_pk_bf16(S[2 * kk][0], S[2 * kk][1]), w1 = cvt_pk_bf16(S[2 * kk][2], S[2 * kk][3]),
                                                          w2 = cvt_pk_bf16(S[2 * kk + 1][0], S[2 * kk + 1][1]), w3 = cvt_pk_bf16(S[2 * kk + 1][2], S[2 * kk + 1][3]);
                sfrag[kk] = __builtin_bit_cast(s16x8, (u32x4){w0, w1, w2, w3}); }
#pragma unroll
            for (int ti = 0; ti < 4; ++ti) {
                f32x4 acc = (f32x4){0.f, 0.f, 0.f, 0.f};
                acc = __builtin_amdgcn_mfma_f32_16x16x32_bf16(vf0, *(LAS s16x8*)(lds + br_a0 + 2048 * ti), acc, 0, 0, 0);
                if (ti >= 2) acc = __builtin_amdgcn_mfma_f32_16x16x32_bf16(vf1, *(LAS s16x8*)(lds + br_a1 + 2048 * ti), acc, 0, 0, 0);
#pragma unroll
                for (int kk = 0; kk < 4; ++kk) {
                    const s16x4 lo = *(LAS s16x4*)(lds + br_qd + 16 * ti * HG_RP + 64 * kk), hi = *(LAS s16x4*)(lds + br_qd + 16 * ti * HG_RP + 64 * kk + 32);
                    const s16x8 bf = (s16x8){lo[0], lo[1], lo[2], lo[3], hi[0], hi[1], hi[2], hi[3]};
                    acc = __builtin_amdgcn_mfma_f32_16x16x32_bf16(sfrag[kk], bf, acc, 0, 0, 0); }
                const unsigned oo = (unsigned)hgrn_row(ch * 64 + 16 * ti + fr, b, dir) * 512u + (unsigned)(h * 128 + 16 * wave + 4 * fq);
                *(u32x2*)(O + oo) = (u32x2){pk2(acc[0], acc[1]), pk2(acc[2], acc[3])};
            }
        }
#pragma unroll
        for (int m = 0; m < 8; ++m) {
            const f32x4 dc = *(LAS f32x4*)(DEC + 16 * m + 4 * fq);
            S[m] = S[m] * dc;
            S[m] = __builtin_amdgcn_mfma_f32_16x16x32_bf16(*(LAS s16x8*)(lds + br_k0 + 2048 * m), vf0, S[m], 0, 0, 0);
            S[m] = __builtin_amdgcn_mfma_f32_16x16x32_bf16(*(LAS s16x8*)(lds + br_k1 + 2048 * m), vf1, S[m], 0, 0, 0);
        }
    }
    if (!FULL) {
        float* U = USTATE + (size_t)(item * 3 + seg) * 16384;
#pragma unroll
        for (int m = 0; m < 8; ++m)
#pragma unroll
            for (int j = 0; j < 4; ++j) U[(16 * m + 4 * fq + j) * 128 + 16 * wave + fr] = S[m][j];
        if (wave == 0) *(f32x2*)(DLOG + (size_t)(item * 3 + seg) * 128 + 2 * kp) = (f32x2){dl0, dl1};
    }
    __syncthreads();
}

__device__ __forceinline__ void fft1_phase(const Params& p, LAS unsigned char* lds, int first_item, int item_stride) {
    LAS float* ctab = (LAS float*)lds;
    LAS float* w16 = ctab + 4096;
    for (int i = threadIdx.x; i < 4096; i += NTHREADS) ctab[i] = cospif((float)i / 2048.0f);
    if (threadIdx.x < 16) { w16[threadIdx.x] = cospif((float)threadIdx.x / 8.0f); w16[16 + threadIdx.x] = sinpif((float)threadIdx.x / 8.0f); }
    __syncthreads();
    const h16* F = (const h16*)(p.ws + OFF_FTT); h16* Y1 = (h16*)(p.ws + OFF_Y1);
    const int ap = threadIdx.x & 127, gl = threadIdx.x >> 7;
    for (int item = first_item; item < 8 * 128; item += item_stride) {
        const int b = item >> 7, gk = (item & 127) * 4 + gl;
        float zr[16][2], zi[16][2];
        const h16* src = F + ((size_t)(b * 512 + gk) * 2) * 4096 + 2 * ap;
#pragma unroll
        for (int r = 0; r < 16; ++r) { const h16x2 c2 = *(const h16x2*)(src + 256 * r), s2 = *(const h16x2*)(src + 4096 + 256 * r);
            zr[r][0] = (float)c2[0]; zr[r][1] = (float)c2[1]; zi[r][0] = -(float)s2[0]; zi[r][1] = -(float)s2[1]; }
#pragma unroll 1
        for (int d = 0; d < 16; ++d) {
            float yr[2] = {0.f, 0.f}, yi[2] = {0.f, 0.f};
#pragma unroll
            for (int r = 0; r < 16; ++r) { const int m = (r * d) & 15; const float cs = w16[m], sn = w16[16 + m];
#pragma unroll
                for (int j = 0; j < 2; ++j) { yr[j] += zr[r][j] * cs + zi[r][j] * sn; yi[j] += zi[r][j] * cs - zr[r][j] * sn; } }
            float ore[2], oim[2];
#pragma unroll
            for (int j = 0; j < 2; ++j) { const int t = ((2 * ap + j) * d) & 4095; const float ct = ctab[t], st = ctab[(t - 1024) & 4095];
                ore[j] = (yr[j] * ct + yi[j] * st) * 0.0625f; oim[j] = (yi[j] * ct - yr[j] * st) * 0.0625f; }
            h16* dst = Y1 + ((size_t)((b * 16 + d) * 512 + gk)) * 512 + 2 * ap;
            *(unsigned*)dst = pk2(ore[0], ore[1]); *(unsigned*)(dst + 256) = pk2(oim[0], oim[1]);
        }
    }
    __syncthreads();
}

__device__ __forceinline__ void a1_prepass(const Params& p) {
    const int wave = threadIdx.x >> 6, lane = threadIdx.x & 63;
    const h16* OF = (const h16*)(p.ws + OFF_OF); const h16* OB = (const h16*)(p.ws + OFF_OB); h16* G = (h16*)(p.ws + OFF_G);
    const float* hgn = p.in[11];
    for (int t = blockIdx.x * 8 + wave; t < T; t += gridDim.x * 8) {
        const size_t off = (size_t)t * 512 + lane * 8;
        const h16x8 a = *(const h16x8*)(OF + off), bq = *(const h16x8*)(OB + off), g = *(const h16x8*)(G + off);
        float o[8]; float ss = 0.f;
#pragma unroll
        for (int j = 0; j < 8; ++j) { o[j] = (float)a[j] + (float)bq[j]; ss += o[j] * o[j]; }
        ss += __shfl_xor(ss, 1); ss += __shfl_xor(ss, 2); ss += __shfl_xor(ss, 4); ss += __shfl_xor(ss, 8);
        const float rstd = rsqrtf(ss * (1.0f / 128.0f) + EPS);
        float r[8];
#pragma unroll
        for (int j = 0; j < 8; ++j) r[j] = o[j] * rstd * hgn[lane * 8 + j] * (float)g[j];
        u32x4 w; w.x = pk2(r[0], r[1]); w.y = pk2(r[2], r[3]); w.z = pk2(r[4], r[5]); w.w = pk2(r[6], r[7]);
        *(u32x4*)(G + off) = w;
    }
}

__device__ __forceinline__ void convert_tables(const Params& p) {
    const int wave = threadIdx.x >> 6, lane = threadIdx.x & 63;
    for (int r2 = blockIdx.x * 8 + wave; r2 < 2 * 16384; r2 += gridDim.x * 8) {
        const int tb = r2 >> 14, e = r2 & 16383;
        const float* src = (tb ? p.in[18] : p.in[17]) + (size_t)e * D + lane * 16;
        f32x4 v[4]; float amax = 0.f;
#pragma unroll
        for (int j = 0; j < 4; ++j) { v[j] = *(const f32x4*)(src + 4 * j); amax = fmaxf(amax, fmaxf(fmaxf(fabsf(v[j].x), fabsf(v[j].y)), fmaxf(fabsf(v[j].z), fabsf(v[j].w)))); }
#pragma unroll
        for (int o = 32; o >= 1; o >>= 1) amax = fmaxf(amax, __shfl_xor(amax, o));
        const float qs = amax > 0.f ? amax * (1.0f / 127.0f) : 1.0f, inv = 1.0f / qs;
        const int bias = tb ? 128 : 0;
        u32x4 w;
#pragma unroll
        for (int j = 0; j < 4; ++j) { const int q0 = (int)rintf(v[j].x * inv) + bias, q1 = (int)rintf(v[j].y * inv) + bias, q2 = (int)rintf(v[j].z * inv) + bias, q3 = (int)rintf(v[j].w * inv) + bias;
            w[j] = (unsigned)(q0 & 255) | ((unsigned)(q1 & 255) << 8) | ((unsigned)(q2 & 255) << 16) | ((unsigned)(q3 & 255) << 24); }
        unsigned char* dst = p.ws + (tb ? OFF_TV : OFF_TU);
        *(u32x4*)(dst + ((size_t)(lane >> 3) * 16384 + e) * 128 + (lane & 7) * 16) = w;
        if (lane == 0) ((float*)(p.ws + (tb ? OFF_SV : OFF_SU)))[e] = qs;
    }
}

__device__ __forceinline__ unsigned f2key(float x) { const unsigned b = __builtin_bit_cast(unsigned, x); return b ^ ((b >> 31) ? 0xFFFFFFFFu : 0x80000000u); }
__device__ __forceinline__ float key2f(unsigned u) { const unsigned b = (u & 0x80000000u) ? (u ^ 0x80000000u) : ~u; return __builtin_bit_cast(float, b); }
__device__ __forceinline__ unsigned umax3(unsigned a, unsigned b, unsigned c) { return max(max(a, b), c); }
#define CE_DESC(a, b) do { const unsigned hi_ = max(a, b), lo_ = min(a, b); a = hi_; b = lo_; } while (0)
template <int N> __device__ __forceinline__ void sort16_desc(unsigned (&k)[N], const int base) {
#pragma unroll
    for (int size = 2; size <= 16; size *= 2)
#pragma unroll
        for (int stride = size / 2; stride > 0; stride /= 2)
#pragma unroll
            for (int i = 0; i < 16; ++i) { const int j = i ^ stride;
                if (j > i) { if ((i & size) == 0 || size == 16) CE_DESC(k[base + i], k[base + j]); else CE_DESC(k[base + j], k[base + i]); } }
}
template <int N> __device__ __forceinline__ void merge16_desc(unsigned (&k)[N], const int a, const int b) {
#pragma unroll
    for (int i = 0; i < 16; ++i) k[a + i] = max(k[a + i], k[b + 15 - i]);
#pragma unroll
    for (int stride = 8; stride > 0; stride /= 2)
#pragma unroll
        for (int i = 0; i < 16; ++i) if ((i & stride) == 0) CE_DESC(k[a + i], k[a + i + stride]);
}
__device__ __forceinline__ void top16_of_128(const float* sc, unsigned (&out)[16]) {
    unsigned s[128];
#pragma unroll
    for (int i = 0; i < 32; ++i) { const f32x4 t = *(const f32x4*)(sc + i * 4);
#pragma unroll
        for (int j = 0; j < 4; ++j) s[4 * i + j] = (f2key(t[j]) & ~127u) | (unsigned)(127 - (4 * i + j)); }
#pragma unroll
    for (int g = 0; g < 8; ++g) sort16_desc(s, 16 * g);
    merge16_desc(s, 0, 16); merge16_desc(s, 32, 48); merge16_desc(s, 64, 80); merge16_desc(s, 96, 112);
    merge16_desc(s, 0, 32); merge16_desc(s, 64, 96);
    merge16_desc(s, 0, 64);
#pragma unroll
    for (int i = 0; i < 16; ++i) out[i] = s[i];
}
__device__ __forceinline__ void topk_phase(const Params& p, LAS unsigned char* lds) {
    const float* SC = (const float*)(p.ws + OFF_SC); int* EIDX = (int*)(p.ws + OFF_EIDX); float* GATE = (float*)(p.ws + OFF_GATE);
    LAS unsigned* st = (LAS unsigned*)lds;
    const int tid = threadIdx.x;
#ifndef TOPK_REP
#define TOPK_REP 1
#endif
    for (int rr_ = 0; rr_ < TOPK_REP; ++rr_)
    for (int base = blockIdx.x * 256; base < T * 8; base += gridDim.x * 256) {
        {
            unsigned ks[16];
#pragma unroll
            for (int i = 0; i < 16; ++i) ks[i] = 0u;
            top16_of_128(SC + ((size_t)base * 2 + tid) * 128, ks);
#pragma unroll
            for (int i = 0; i < 16; ++i) st[i * NTHREADS + tid] = ks[i];
        }
        __syncthreads();
        if (tid < 256) {
            const int th = base + tid;
            float sv1[16];
#pragma unroll
            for (int j = 0; j < 16; ++j) sv1[j] = key2f(st[j * NTHREADS + 2 * tid + 1] & ~127u);
            unsigned cv[50];
            { int c = 0;
#pragma unroll
              for (int i = 0; i < 16; ++i) { const float a = key2f(st[i * NTHREADS + 2 * tid] & ~127u);
#pragma unroll
                  for (int j = 0; j < 16; ++j) if ((i + 1) * (j + 1) <= 16) { cv[c] = (f2key(a + sv1[j]) & ~255u) | (unsigned)(255 - (i * 16 + j)); ++c; } } }
            unsigned c64[64];
#pragma unroll
            for (int i = 0; i < 64; ++i) c64[i] = (i < 50) ? cv[i] : 0u;
#pragma unroll
            for (int g = 0; g < 4; ++g) sort16_desc(c64, 16 * g);
            merge16_desc(c64, 0, 16); merge16_desc(c64, 32, 48); merge16_desc(c64, 0, 32);
            unsigned ok[16];
#pragma unroll
            for (int i = 0; i < 16; ++i) ok[i] = c64[i];
            float ex[16]; int oe[16]; float den = 0.f;
            const float v0 = key2f(ok[0] & ~255u);
#pragma unroll
            for (int i = 0; i < 16; ++i) { const int ij = 255 - (int)(ok[i] & 255u), ci = ij >> 4, cj = ij & 15;
                const int e0 = 127 - (int)(st[ci * NTHREADS + 2 * tid] & 127u), e1 = 127 - (int)(st[cj * NTHREADS + 2 * tid + 1] & 127u);
                oe[i] = e0 * 128 + e1; ex[i] = __expf(key2f(ok[i] & ~255u) - v0); den += ex[i]; }
            const float inv = 1.0f / den;
#pragma unroll
            for (int i = 0; i < 4; ++i) {
                *(f32x4*)(GATE + (size_t)th * 16 + 4 * i) = (f32x4){ex[4 * i] * inv, ex[4 * i + 1] * inv, ex[4 * i + 2] * inv, ex[4 * i + 3] * inv};
                *(int4*)(EIDX + (size_t)th * 16 + 4 * i) = make_int4(oe[4 * i], oe[4 * i + 1], oe[4 * i + 2], oe[4 * i + 3]); }
        }
        __syncthreads();
    }
}

struct XcdInfo { int px, npop, rank, nloc; };
__device__ __forceinline__ float dot8(const h16x8 a, const h16x8 b, float s) {
    s = __builtin_amdgcn_fdot2((h16x2){a[0], a[1]}, (h16x2){b[0], b[1]}, s, false); s = __builtin_amdgcn_fdot2((h16x2){a[2], a[3]}, (h16x2){b[2], b[3]}, s, false);
    s = __builtin_amdgcn_fdot2((h16x2){a[4], a[5]}, (h16x2){b[4], b[5]}, s, false); s = __builtin_amdgcn_fdot2((h16x2){a[6], a[7]}, (h16x2){b[6], b[7]}, s, false); return s; }
struct PeerTok { int t; bool ok; };
#define PEER_TOUCH(R) do { unsigned tt_ = (R).w; asm volatile("" : "+v"(tt_)); (R).w = tt_; __builtin_amdgcn_sched_barrier(0); } while (0)
__device__ __forceinline__ PeerTok peer_tok(int i, int t0, int step) { const int t = t0 + i * step; PeerTok r; r.ok = t < T; r.t = r.ok ? t : (T - 1); return r; }
__device__ __forceinline__ void peer_ld_e(const int* EIDX, int t, int g, int (&e)[16]) {
#pragma unroll
    for (int q = 0; q < 4; ++q) { const int4 v = *(const int4*)(EIDX + (size_t)t * 128 + 16 * g + 4 * q); e[4 * q] = v.x; e[4 * q + 1] = v.y; e[4 * q + 2] = v.z; e[4 * q + 3] = v.w; } }
__device__ __forceinline__ void peer_ld_rows(const unsigned char* tab, const int (&e)[16], u32x4 (&r)[16]) {
#pragma unroll
    for (int j = 0; j < 16; ++j) r[j] = *(const u32x4*)(tab + (size_t)e[j] * 128); }
__device__ __forceinline__ void peer_u_compute(const u32x4 (&r)[16], const u32x4 xv, float* PACT, int s, PeerTok tk, int lane, int g, int c) {
    float pj[16];
#pragma unroll
    for (int j = 0; j < 16; ++j) { int d = __builtin_amdgcn_sdot4((int)r[j].x, (int)xv.x, 0, false); d = __builtin_amdgcn_sdot4((int)r[j].y, (int)xv.y, d, false);
        d = __builtin_amdgcn_sdot4((int)r[j].z, (int)xv.z, d, false); d = __builtin_amdgcn_sdot4((int)r[j].w, (int)xv.w, d, false); pj[j] = (float)d; }
#define RED_STEP(NIN, MASK) _Pragma("unroll") for (int j = 0; j < (NIN) / 2; ++j) { const bool up = (lane & (MASK)) != 0; \
    const float keep = up ? pj[2 * j + 1] : pj[2 * j], send = up ? pj[2 * j] : pj[2 * j + 1]; pj[j] = keep + __shfl_xor(send, (MASK)); }
    RED_STEP(16, 1) RED_STEP(8, 2) RED_STEP(4, 4)
#undef RED_STEP
    if (tk.ok) { float* po = PACT + ((size_t)s * T + tk.t) * 128 + 16 * g + c; po[0] = pj[0]; po[8] = pj[1]; }
}
__device__ __forceinline__ void peer_u_phase(const Params& p, const XcdInfo xi) {
    const int wave = threadIdx.x >> 6, lane = threadIdx.x & 63, g = lane >> 3, c = lane & 7;
    const unsigned char* QX = (const unsigned char*)(p.ws + OFF_QX); const unsigned char* TU = (const unsigned char*)(p.ws + OFF_TU);
    const int* EIDX = (const int*)(p.ws + OFF_EIDX); float* PACT = (float*)(p.ws + OFF_PACT);
    const int t0 = xi.rank * 8 + wave, step = xi.nloc * 8, ntok = (T - t0 + step - 1) / step;
    for (int s = xi.px; s < 8; s += xi.npop) {
        const unsigned char* tus = TU + (size_t)s * 16384 * 128 + 16 * c; const unsigned char* qxs = QX + s * 128 + 16 * c;
        int eN[16]; u32x4 rA[16], rB[16]; u32x4 xA, xB;
        { PeerTok k0 = peer_tok(0, t0, step); peer_ld_e(EIDX, k0.t, g, eN); xA = *(const u32x4*)(qxs + (size_t)k0.t * D); peer_ld_rows(tus, eN, rA);
          PeerTok k1 = peer_tok(1, t0, step); peer_ld_e(EIDX, k1.t, g, eN); }
        for (int i = 0; i < ntok; i += 2) {
            { const PeerTok k1 = peer_tok(i + 1, t0, step), k2 = peer_tok(i + 2, t0, step);
              PEER_TOUCH(rA[15]);
              xB = *(const u32x4*)(qxs + (size_t)k1.t * D); peer_ld_rows(tus, eN, rB); peer_ld_e(EIDX, k2.t, g, eN);
              __builtin_amdgcn_sched_barrier(0);
              peer_u_compute(rA, xA, PACT, s, peer_tok(i, t0, step), lane, g, c);
              __builtin_amdgcn_sched_barrier(0); }
            { const PeerTok k2 = peer_tok(i + 2, t0, step), k3 = peer_tok(i + 3, t0, step);
              PEER_TOUCH(rB[15]);
              xA = *(const u32x4*)(qxs + (size_t)k2.t * D); peer_ld_rows(tus, eN, rA); peer_ld_e(EIDX, k3.t, g, eN);
              __builtin_amdgcn_sched_barrier(0);
              PeerTok k1 = peer_tok(i + 1, t0, step); k1.ok = k1.ok && (i + 1 < ntok);
              peer_u_compute(rB, xB, PACT, s, k1, lane, g, c);
              __builtin_amdgcn_sched_barrier(0); }
        }
    }
}
__device__ __forceinline__ void peer_combine(const Params& p) {
    const float* PACT = (const float*)(p.ws + OFF_PACT); const float* GATE = (const float*)(p.ws + OFF_GATE); h16* WH = (h16*)(p.ws + OFF_W);
    const int* EIDX = (const int*)(p.ws + OFF_EIDX); const float* SU = (const float*)(p.ws + OFF_SU); const float* SV = (const float*)(p.ws + OFF_SV); const float* SX = (const float*)(p.ws + OFF_SX);
    for (size_t i = (size_t)blockIdx.x * NTHREADS + threadIdx.x; i < (size_t)T * 128 / 4; i += (size_t)gridDim.x * NTHREADS) {
        f32x4 a = *(const f32x4*)(PACT + i * 4);
#pragma unroll
        for (int s = 1; s < 8; ++s) a += *(const f32x4*)(PACT + (size_t)s * T * 128 + i * 4);
        const f32x4 gt = *(const f32x4*)(GATE + i * 4); const int4 e4 = *(const int4*)(EIDX + i * 4);
        const int ee[4] = {e4.x, e4.y, e4.z, e4.w};
        const float sx = SX[i >> 5];
        float w[4];
#pragma unroll
        for (int j = 0; j < 4; ++j) { const float act = a[j] * sx * SU[ee[j]]; w[j] = gt[j] * (0.5f * act * (1.0f + erff(act * 0.70710678118654752f))) * SV[ee[j]] * 64.0f; }
        *(u32x2*)(WH + i * 4) = (u32x2){pk2(w[0], w[1]), pk2(w[2], w[3])}; }
}
__device__ __forceinline__ void peer_v_compute(const u32x4 (&r)[16], const u32x4 wlo, const u32x4 whi, const f32x2 hv, const f32x2 gv, float* H2, float* PSS, int s, PeerTok tk, int lane, int g, int c) {
    float acc[16];
#pragma unroll
    for (int i = 0; i < 16; ++i) acc[i] = 0.f;
    float wsum = 0.f;
#pragma unroll
    for (int jp = 0; jp < 8; ++jp) {
        const unsigned wpair = jp < 4 ? wlo[jp] : whi[jp - 4]; const h16x2 w2 = __builtin_bit_cast(h16x2, wpair);
        wsum += (float)w2[0] + (float)w2[1];
#pragma unroll
        for (int d = 0; d < 4; ++d) { const unsigned a = r[2 * jp][d], bq = r[2 * jp + 1][d];
            acc[4 * d + 0] = __builtin_amdgcn_fdot2(__builtin_bit_cast(h16x2, __builtin_amdgcn_perm(bq, a, 0x0C040C00u)), w2, acc[4 * d + 0], false);
            acc[4 * d + 1] = __builtin_amdgcn_fdot2(__builtin_bit_cast(h16x2, __builtin_amdgcn_perm(bq, a, 0x0C050C01u)), w2, acc[4 * d + 1], false);
            acc[4 * d + 2] = __builtin_amdgcn_fdot2(__builtin_bit_cast(h16x2, __builtin_amdgcn_perm(bq, a, 0x0C060C02u)), w2, acc[4 * d + 2], false);
            acc[4 * d + 3] = __builtin_amdgcn_fdot2(__builtin_bit_cast(h16x2, __builtin_amdgcn_perm(bq, a, 0x0C070C03u)), w2, acc[4 * d + 3], false); }
    }
    const float corr = wsum * (128.0f / 16777216.0f);
#pragma unroll
    for (int i = 0; i < 16; ++i) acc[i] -= corr;
#define RED_STEP(NIN, MASK) _Pragma("unroll") for (int j = 0; j < (NIN) / 2; ++j) { const bool up = (lane & (MASK)) != 0; \
    const float keep = up ? acc[2 * j + 1] : acc[2 * j], send = up ? acc[2 * j] : acc[2 * j + 1]; acc[j] = keep + __shfl_xor(send, (MASK)); }
    RED_STEP(16, 8) RED_STEP(8, 16) RED_STEP(4, 32)
#undef RED_STEP
    float ss = 0.f;
#pragma unroll
    for (int j = 0; j < 2; ++j) { const int col = s * 128 + 16 * c + 8 * j + g;
        const float h2 = hv[j] + gv[j] * (acc[j] * (16777216.0f / 64.0f));
        if (tk.ok) H2[(size_t)tk.t * D + col] = h2;
        ss += h2 * h2; }
    ss = wave_sum(ss);
    if (lane == 0 && tk.ok) PSS[(size_t)s * T + tk.t] = ss;
}
__device__ __forceinline__ void peer_v_phase(const Params& p, const XcdInfo xi) {
    const int wave = threadIdx.x >> 6, lane = threadIdx.x & 63, g = lane >> 3, c = lane & 7;
    const unsigned char* TV = (const unsigned char*)(p.ws + OFF_TV); const int* EIDX = (const int*)(p.ws + OFF_EIDX); const h16* WH = (const h16*)(p.ws + OFF_W);
    const float* mod = (const float*)(p.ws + OFF_MOD); const float* H = p.out; float* H2 = (float*)(p.ws + OFF_H2); float* PSS = (float*)(p.ws + OFF_PSS);
    const int t0 = xi.rank * 8 + wave, step = xi.nloc * 8, ntok = (T - t0 + step - 1) / step;
    for (int s = xi.px; s < 8; s += xi.npop) {
        const unsigned char* tvs = TV + (size_t)s * 16384 * 128 + 16 * c;
        const int colb = s * 128 + 16 * c + g;
        int eN[16]; u32x4 rA[16], rB[16]; u32x4 wA0, wA1, wB0, wB1; f32x2 hA, hB, gA, gB;
#define V_LD_SIDE(W0, W1, HV, GV, tt) do { W0 = *(const u32x4*)(WH + (size_t)(tt) * 128 + 16 * g); W1 = *(const u32x4*)(WH + (size_t)(tt) * 128 + 16 * g + 8); \
        HV = (f32x2){H[(size_t)(tt) * D + colb], H[(size_t)(tt) * D + colb + 8]}; GV = (f32x2){mod[((tt) >> 12) * 6144 + 5120 + colb], mod[((tt) >> 12) * 6144 + 5120 + colb + 8]}; } while (0)
        { PeerTok k0 = peer_tok(0, t0, step); peer_ld_e(EIDX, k0.t, g, eN); V_LD_SIDE(wA0, wA1, hA, gA, k0.t); peer_ld_rows(tvs, eN, rA);
          PeerTok k1 = peer_tok(1, t0, step); peer_ld_e(EIDX, k1.t, g, eN); }
        for (int i = 0; i < ntok; i += 2) {
            { const PeerTok k1 = peer_tok(i + 1, t0, step), k2 = peer_tok(i + 2, t0, step);
              PEER_TOUCH(rA[15]);
              V_LD_SIDE(wB0, wB1, hB, gB, k1.t); peer_ld_rows(tvs, eN, rB); peer_ld_e(EIDX, k2.t, g, eN);
              __builtin_amdgcn_sched_barrier(0);
              peer_v_compute(rA, wA0, wA1, hA, gA, H2, PSS, s, peer_tok(i, t0, step), lane, g, c);
              __builtin_amdgcn_sched_barrier(0); }
            { const PeerTok k2 = peer_tok(i + 2, t0, step), k3 = peer_tok(i + 3, t0, step);
              PEER_TOUCH(rB[15]);
              V_LD_SIDE(wA0, wA1, hA, gA, k2.t); peer_ld_rows(tvs, eN, rA); peer_ld_e(EIDX, k3.t, g, eN);
              __builtin_amdgcn_sched_barrier(0);
              PeerTok k1 = peer_tok(i + 1, t0, step); k1.ok = k1.ok && (i + 1 < ntok);
              peer_v_compute(rB, wB0, wB1, hB, gB, H2, PSS, s, k1, lane, g, c);
              __builtin_amdgcn_sched_barrier(0); }
        }
#undef V_LD_SIDE
    }
}
__device__ __forceinline__ void peer_final(const Params& p) {
    const int wave = threadIdx.x >> 6, lane = threadIdx.x & 63;
    const float* PSS = (const float*)(p.ws + OFF_PSS); float* OUT = p.out; const float* H2 = (const float*)(p.ws + OFF_H2); const float* fg = p.in[19];
    for (int t = blockIdx.x * 8 + wave; t < T; t += gridDim.x * 8) {
        float ss = (lane < 8) ? PSS[(size_t)lane * T + t] : 0.f;
        ss = wave_sum(ss);
        const float rstd = rsqrtf(ss * (1.0f / D) + EPS);
#pragma unroll
        for (int j = 0; j < 4; ++j) { const int cc = j * 256 + lane * 4; const f32x4 hv = *(const f32x4*)(H2 + (size_t)t * D + cc), fv = *(const f32x4*)(fg + cc);
            *(f32x4*)(OUT + (size_t)t * D + cc) = hv * rstd * fv; }
    }
}
#ifndef REP_A
#define REP_A 1
#endif
#ifndef REP_FT
#define REP_FT 1
#endif
#ifndef REP_DFT
#define REP_DFT 1
#endif
#ifndef REP_GATE
#define REP_GATE 1
#endif
constexpr int N_PHASES = 15;
#ifndef MK_CGSYNC
#define MK_CGSYNC 0
#endif
__device__ __forceinline__ Params load_params(volatile LAS unsigned* pw) {
    Params q;
    unsigned long long v[22];
#pragma unroll
    for (int i = 0; i < 22; ++i) { const unsigned lo = (unsigned)__builtin_amdgcn_readfirstlane((int)pw[2 * i]), hi = (unsigned)__builtin_amdgcn_readfirstlane((int)pw[2 * i + 1]); v[i] = ((unsigned long long)hi << 32) | lo; }
#pragma unroll
    for (int i = 0; i < 20; ++i) q.in[i] = (const float*)v[i];
    q.out = (float*)v[20]; q.ws = (unsigned char*)v[21];
    q.ph_lo = __builtin_amdgcn_readfirstlane((int)pw[44]); q.ph_hi = __builtin_amdgcn_readfirstlane((int)pw[45]);
    return q;
}
__global__ void __launch_bounds__(NTHREADS, 2) mega(Params pk) {
    extern __shared__ __attribute__((aligned(16))) unsigned char smem[];
    LAS unsigned char* lds = (LAS unsigned char*)smem;
    const int G = gridDim.x, c = blockIdx.x;
    volatile LAS unsigned* pw = (volatile LAS unsigned*)(lds + LDS_BYTES - 512);
    if (threadIdx.x == 0) {
#pragma unroll
        for (int i = 0; i < 20; ++i) { const unsigned long long v = (unsigned long long)pk.in[i]; pw[2 * i] = (unsigned)v; pw[2 * i + 1] = (unsigned)(v >> 32); }
        { const unsigned long long v = (unsigned long long)pk.out; pw[40] = (unsigned)v; pw[41] = (unsigned)(v >> 32); }
        { const unsigned long long v = (unsigned long long)pk.ws; pw[42] = (unsigned)v; pw[43] = (unsigned)(v >> 32); }
        pw[44] = (unsigned)pk.ph_lo; pw[45] = (unsigned)pk.ph_hi;
    }
    unsigned* ctl = (unsigned*)(pk.ws + OFF_CTL);
    volatile LAS unsigned* misc = (volatile LAS unsigned*)(lds + LDS_BYTES - 64);
    if (threadIdx.x < 16) misc[threadIdx.x] = 0u;
    __syncthreads();
    const bool fused = (pk.ph_hi - pk.ph_lo) > 1;
    XcdBarrier bar; bar.bar = ctl; bar.x = 0; bar.st = misc;
    if (fused) {
        bar = xcd_barrier_post(ctl, misc);
        if (threadIdx.x == 0) misc[2] = xb_add(&ctl[CTL_RANK + 64 * bar.x], 1u);
    }
#define IN(k) (ph_lo <= (k) && (k) < ph_hi)
#if MK_CGSYNC
#define SEAM(k) do { if (IN(k) && IN((k) + 1)) { cg::grid_group grid = cg::this_grid(); grid.sync(); } } while (0)
#else
#define SEAM(k) do { if (IN(k) && IN((k) + 1)) xcd_barrier(bar); } while (0)
#endif
#define PHASE_BEGIN(k) if (IN(k)) { const Params p = load_params(pw); unsigned char* const ws = p.ws; (void)ws;
#define PHASE_END(k) } SEAM(k);
    const int ph_lo = pk.ph_lo, ph_hi = pk.ph_hi;
    PHASE_BEGIN(0) phase0(p, lds); PHASE_END(0)
    PHASE_BEGIN(1)
        const float* mod = (const float*)(ws + OFF_MOD);
        modulate_rows(p.in[0], (h16*)(ws + OFF_UALL), T, p.in[6], mod, 0, 1024, 0);
        modulate_rows(p.in[2], (h16*)(ws + OFF_UALL) + (size_t)T * D, TC, p.in[6], mod, 0, 1024, 1);
    PHASE_END(1)
    PHASE_BEGIN(2)
        { pg8::Gemm g{ws + OFF_UALL, ws + OFF_WA, 1024, 1024, 1024}; OrderA S; S.init(G, c, REP_A); EpiA E{ws}; pg8::gemm_phase(lds, g, S, E); }
        { pg8::Gemm g{ws + OFF_UALL, ws + OFF_WF, 1024, 1024, 1024}; pg8::TileOrder S; S.init(128, 4, G, c, REP_FT); EpiFT E{ws}; pg8::gemm_phase(lds, g, S, E); }
    PHASE_END(2)
    PHASE_BEGIN(3) for (int it = blockIdx.x; it < 192; it += gridDim.x) hgrn_mfma_unit<false>(p, lds, it / 3, it % 3);
        fft1_phase(p, lds, (int)((blockIdx.x + 64u) % gridDim.x), gridDim.x); convert_tables(p); PHASE_END(3)
    PHASE_BEGIN(4) for (int it = blockIdx.x; it < 256; it += gridDim.x) hgrn_mfma_unit<true>(p, lds, it >> 2, it & 3); PHASE_END(4)
    PHASE_BEGIN(5)
        { pg8::Gemm g{ws + OFF_DFT256, ws + OFF_Y1, 512, 512, 512}; pg8::TileOrder S; S.init(1, 256, G, c, REP_DFT); EpiDFT E{ws}; pg8::gemm_phase(lds, g, S, E); }
        { pg8::Gemm g{ws + OFF_UALL, ws + OFF_WG, 1024, 1024, 1024}; pg8::TileOrder S; S.init(128, 8, G, c, REP_GATE); EpiGate E{ws}; pg8::gemm_phase(lds, g, S, E); }
        a1_prepass(p);
    PHASE_END(5)
    PHASE_BEGIN(6)
        { pg8::Gemm g{ws + OFF_G, ws + OFF_WHG, 512, 512, 512}; pg8::TileOrder S; S.init(128, 4, G, c); EpiMerge1<false> E{ws}; pg8::gemm_phase(lds, g, S, E); }
        { pg8::Gemm g{ws + OFF_YFT, ws + OFF_WFT, 512, 512, 512}; pg8::TileOrder S; S.init(128, 4, G, c); EpiMerge1<true> E{ws}; pg8::gemm_phase(lds, g, S, E); }
    PHASE_END(6)
    PHASE_BEGIN(7)
        pg8::Gemm g{ws + OFF_Y, ws + OFF_WOUT, 1024, 1024, 1024}; pg8::TileOrder S; S.init(128, 4, G, c);
        EpiMerge2 E{p.in[0], p.out, (const float*)(ws + OFF_MOD)}; pg8::gemm_phase(lds, g, S, E);
    PHASE_END(7)
    PHASE_BEGIN(8) modulate_rows(p.out, (h16*)(ws + OFF_U2), T, p.in[7], (const float*)(ws + OFF_MOD), 3072, 4096, 0, (signed char*)(ws + OFF_QX), (float*)(ws + OFF_SX)); PHASE_END(8)
    PHASE_BEGIN(9)
        pg8::Gemm g{ws + OFF_U2, ws + OFF_WS, 1024, 1024, 1024}; pg8::TileOrder S; S.init(128, 8, G, c);
        EpiF32 E{(float*)(ws + OFF_SC), 2048}; pg8::gemm_phase(lds, g, S, E);
    PHASE_END(9)
    PHASE_BEGIN(10) topk_phase(p, lds); PHASE_END(10)
    XcdInfo xi;
    if (fused) {
        unsigned cnt[8]; int npop = 0, px = 0;
#pragma unroll
        for (int j = 0; j < 8; ++j) { cnt[j] = xb_ld(&ctl[CTL_RANK + 64 * j]); if (j < (int)(bar.x & 7u)) px += (cnt[j] > 0u); npop += (cnt[j] > 0u); }
        xi.px = px; xi.npop = npop > 0 ? npop : 1; xi.rank = (int)misc[2]; xi.nloc = (int)cnt[bar.x & 7u]; if (xi.nloc < 1) xi.nloc = 1;
    } else { xi.px = c & 7; xi.npop = 8; xi.rank = c >> 3; xi.nloc = G >> 3; }
    PHASE_BEGIN(11) peer_u_phase(p, xi); PHASE_END(11)
    PHASE_BEGIN(12) peer_combine(p); PHASE_END(12)
    PHASE_BEGIN(13) peer_v_phase(p, xi); PHASE_END(13)
    PHASE_BEGIN(14) peer_final(p); }
#undef IN
#undef SEAM
#undef PHASE_BEGIN
#undef PHASE_END
}

#ifndef MK_SINGLE
#define MK_SINGLE 1
#endif
extern "C" void kernel_launch(void* const* d_in, const int* in_sizes, int n_in, void* d_out, int out_size, void* d_ws, size_t ws_size, hipStream_t stream) {
    static int grid = 0;
    if (grid == 0) {
        if (n_in != 20 || out_size != T * D || ws_size < WS_NEED) { fprintf(stderr, "kernel_launch: unexpected shapes (n_in %d out %d ws %zu)\n", n_in, out_size, ws_size); grid = -1; return; }
        int dev = 0, cus = 0, per_cu = 0;
        hipGetDevice(&dev); hipDeviceGetAttribute(&cus, hipDeviceAttributeMultiprocessorCount, dev);
        if (hipFuncSetAttribute((const void*)mega, hipFuncAttributeMaxDynamicSharedMemorySize, LDS_BYTES) != hipSuccess) { fprintf(stderr, "kernel_launch: hipFuncSetAttribute failed\n"); grid = -1; return; }
        hipOccupancyMaxActiveBlocksPerMultiprocessor(&per_cu, (const void*)mega, NTHREADS, LDS_BYTES);
        if (per_cu < 1) { fprintf(stderr, "kernel_launch: occupancy query says %d blocks per CU\n", per_cu); grid = -1; return; }
        grid = cus;
    }
    if (grid < 0) return;
    if (hipMemsetAsync((char*)d_ws + OFF_CTL, 0, CTL_ZERO_BYTES, stream) != hipSuccess) { fprintf(stderr, "kernel_launch: memset failed\n"); return; }
    Params p{};
    for (int i = 0; i < 20; ++i) p.in[i] = (const float*)d_in[i];
    p.out = (float*)d_out; p.ws = (unsigned char*)d_ws;
#if MK_SINGLE
    p.ph_lo = 0; p.ph_hi = N_PHASES;
    void* args[] = {&p};
    hipError_t e = hipLaunchCooperativeKernel((const void*)mega, dim3(grid), dim3(NTHREADS), args, LDS_BYTES, stream);
    if (e != hipSuccess) fprintf(stderr, "cooperative launch failed: %s (grid %d)\n", hipGetErrorString(e), grid);
#else
    for (int ph = 0; ph < N_PHASES; ++ph) { p.ph_lo = ph; p.ph_hi = ph + 1; hipLaunchKernelGGL(mega, dim3(grid), dim3(NTHREADS), LDS_BYTES, stream, p); }
#endif
}
```

```cpp
#include <hip/hip_runtime.h>
#include <hip/hip_cooperative_groups.h>
#include <cstdio>
#include <cstdint>
namespace cg = cooperative_groups;
#define LAS __attribute__((address_space(3)))
namespace pg8 {
#define PG8_LAS __attribute__((address_space(3)))
typedef _Float16 f16x8 __attribute__((ext_vector_type(8)));
typedef float f32x4 __attribute__((ext_vector_type(4)));
typedef unsigned u32x4 __attribute__((ext_vector_type(4)));
typedef unsigned u32x2 __attribute__((ext_vector_type(2)));
constexpr int BM = 256, BK = 64, HALF = 128, HTB = HALF * BK * 2, STAGE_BYTES = 8 * HTB, NXCD = 8, WGM = 8;

__host__ __device__ __forceinline__ int lds_byte(int r, int c) { const int st = (r >> 4) * 2 + (c >> 5), rr = r & 15, cc = c & 31, ob = rr * 64 + cc * 2; return st * 1024 + (ob ^ (((ob >> 9) & 1) << 5)); }
__host__ __device__ __forceinline__ void stage_rc(int b, int& R, int& C) { const int st = b / 1024, sb = b % 1024, swz = sb ^ (((sb >> 9) & 1) << 5); R = (st >> 1) * 16 + swz / 64; C = (st & 1) * 32 + (swz % 64) / 2; }
__host__ __device__ __forceinline__ int perm32(int rho) { const int n = rho >> 4, i = rho & 15; return 8 * (i >> 2) + 4 * n + (i & 3); }

struct Unit { int pm, pn; };
struct Gemm { const void* A; const void* Bt; int lda, ldb, K; };

struct TileOrder {
    int nM, nN, nwg, G, c, rep;
    __device__ void init(int nM_, int nN_, int G_, int c_, int rep_ = 1) { nM = nM_; nN = nN_; nwg = nM * nN; G = G_; c = c_; rep = rep_; }
    __device__ bool map(long L, Unit& u) const {
        if (L >= nwg) return false;
        int wgid = (int)L; { const int q = nwg / NXCD, r = nwg % NXCD, xcd = wgid % NXCD, off = wgid / NXCD; wgid = (xcd < r ? xcd * (q + 1) : r * (q + 1) + (xcd - r) * q) + off; }
        const int nig = WGM * nN, gid = wgid / nig, fm = gid * WGM, gsz = (nM - fm) < WGM ? (nM - fm) : WGM;
        u.pm = fm + ((wgid % nig) % gsz); u.pn = (wgid % nig) / gsz; return true;
    }
    __device__ bool next(int i, Unit& u) const { const long L = (long)i * G + c; if (L >= (long)nwg * rep) return false; return map(L % nwg, u); }
};

template <class Epi, class Sched>
__device__ __forceinline__ void gemm_phase(PG8_LAS unsigned char* lds, const Gemm g, const Sched& S, const Epi& E) {
    const int tid = threadIdx.x, wid = __builtin_amdgcn_readfirstlane(tid >> 6), lane = tid & 63, wr = wid >> 2, wc = wid & 3, fr = lane & 15, fq = lane >> 4;
    const int K = g.K, nt = K / BK;
    unsigned voffA[2], voffB[2];
#pragma unroll
    for (int i = 0; i < 2; ++i) { int R, C; stage_rc(tid * 16 + i * 8192, R, C); const int Rb = Epi::PERM ? ((R & ~31) + perm32(R & 31)) : R;
        voffA[i] = (unsigned)(R * g.lda + C) * 2u; voffB[i] = (unsigned)(Rb * g.ldb + C) * 2u; }
    const size_t kstep = (size_t)(BK * 2);
    const size_t hstepA = (size_t)HALF * g.lda * 2, hstepB = (size_t)HALF * g.ldb * 2;
    const size_t tstepA = 2 * hstepA, tstepB = 2 * hstepB;
    const unsigned ldsw = (unsigned)wid * 1024u;
    const int aoff = lds_byte(wr * 64 + fr, fq * 8), boff = lds_byte(wc * 32 + fr, fq * 8);
#define PG8_SA(b, h) (((b) * 2 + (h)) * HTB)
#define PG8_SB(b, h) ((4 + (b) * 2 + (h)) * HTB)
#define PG8_STAGE(bufoff, gbase, voff) do { _Pragma("unroll") for (int _i = 0; _i < 2; ++_i) \
        __builtin_amdgcn_global_load_lds((const unsigned*)((const char*)(gbase) + (voff)[_i]), (PG8_LAS unsigned*)(lds + (bufoff) + ldsw + _i * 8192), 16, 0, 0); } while (0)
#define PG8_LDA(dst, b, h) do { _Pragma("unroll") for (int m = 0; m < 4; ++m) _Pragma("unroll") for (int k = 0; k < 2; ++k) dst[m][k] = *(const PG8_LAS f16x8*)(lds + PG8_SA(b, h) + aoff + m * 2048 + k * 1024); } while (0)
#define PG8_LDB(dst, b, h) do { _Pragma("unroll") for (int n = 0; n < 2; ++n) _Pragma("unroll") for (int k = 0; k < 2; ++k) dst[n][k] = *(const PG8_LAS f16x8*)(lds + PG8_SB(b, h) + boff + n * 2048 + k * 1024); } while (0)
#define PG8_MMA(ai, bj, At, Bt) do { __builtin_amdgcn_s_setprio(1); _Pragma("unroll") for (int m = 0; m < 4; ++m) _Pragma("unroll") for (int n = 0; n < 2; ++n) _Pragma("unroll") for (int k = 0; k < 2; ++k) \
        acc[ai][bj][m][n] = Epi::TRANS ? __builtin_amdgcn_mfma_f32_16x16x32_f16(Bt[n][k], At[m][k], acc[ai][bj][m][n], 0, 0, 0) \
                                       : __builtin_amdgcn_mfma_f32_16x16x32_f16(At[m][k], Bt[n][k], acc[ai][bj][m][n], 0, 0, 0); __builtin_amdgcn_s_setprio(0); } while (0)
#define PG8_WAIT_V(n) asm volatile("s_waitcnt vmcnt(" #n ")" ::: "memory")
#define PG8_WAIT_L(n) asm volatile("s_waitcnt lgkmcnt(" #n ")" ::: "memory")
#define PG8_BAR __builtin_amdgcn_s_barrier()
#define PG8_SCHED __builtin_amdgcn_sched_barrier(0)
    Unit cur, nxt; int ui = 0;
    if (!S.next(0, cur)) return;
    f32x4 acc[2][2][4][2];
#pragma unroll
    for (int a = 0; a < 2; ++a)
#pragma unroll
        for (int b = 0; b < 2; ++b)
#pragma unroll
            for (int m = 0; m < 4; ++m)
#pragma unroll
                for (int n = 0; n < 2; ++n) acc[a][b][m][n] = (f32x4){0.f, 0.f, 0.f, 0.f};
    f16x8 At[4][2], B0[2][2], B1[2][2];
    const char* cA = (const char*)g.A + (size_t)cur.pm * tstepA; const char* cB = (const char*)g.Bt + (size_t)cur.pn * tstepB;
    PG8_STAGE(PG8_SB(0, 0), cB, voffB); PG8_STAGE(PG8_SA(0, 0), cA, voffA); PG8_STAGE(PG8_SB(0, 1), cB + hstepB, voffB); PG8_STAGE(PG8_SA(0, 1), cA + hstepA, voffA);
    if (wr == 1) PG8_BAR;
    PG8_WAIT_V(4); PG8_BAR;
    PG8_STAGE(PG8_SB(1, 0), cB + kstep, voffB); PG8_STAGE(PG8_SA(1, 0), cA + kstep, voffA); PG8_STAGE(PG8_SB(1, 1), cB + hstepB + kstep, voffB);
    PG8_WAIT_V(6); PG8_BAR;
    for (;;) {
        const bool has_next = S.next(ui + 1, nxt);
        const char* nA = has_next ? (const char*)g.A + (size_t)nxt.pm * tstepA : cA; const char* nB = has_next ? (const char*)g.Bt + (size_t)nxt.pn * tstepB : cB;
        for (int t = 0; t < nt; t += 2) {
            const bool last = (t == nt - 2);
            const char* a1 = cA + (size_t)(t + 1) * kstep;
            const char* a2 = last ? nA : cA + (size_t)(t + 2) * kstep; const char* b2 = last ? nB : cB + (size_t)(t + 2) * kstep;
            const char* a3 = a2 + kstep; const char* b3 = b2 + kstep;
            PG8_LDB(B0, 0, 0); PG8_SCHED; PG8_LDA(At, 0, 0); PG8_STAGE(PG8_SA(1, 1), a1 + hstepA, voffA);
            PG8_WAIT_L(8); PG8_BAR; PG8_WAIT_L(0); PG8_MMA(0, 0, At, B0); PG8_BAR; PG8_SCHED;
            PG8_LDB(B1, 0, 1); PG8_STAGE(PG8_SB(0, 0), b2, voffB);
            PG8_BAR; PG8_WAIT_L(0); PG8_MMA(0, 1, At, B1); PG8_BAR;
            PG8_LDA(At, 0, 1); PG8_STAGE(PG8_SA(0, 0), a2, voffA);
            PG8_BAR; PG8_WAIT_L(0); PG8_MMA(1, 0, At, B0); PG8_BAR; PG8_SCHED;
            PG8_STAGE(PG8_SB(0, 1), b2 + hstepB, voffB);
            PG8_WAIT_V(6); PG8_BAR; PG8_MMA(1, 1, At, B1); PG8_BAR;
            PG8_LDB(B0, 1, 0); PG8_SCHED; PG8_LDA(At, 1, 0); PG8_STAGE(PG8_SA(0, 1), a2 + hstepA, voffA);
            PG8_WAIT_L(8); PG8_BAR; PG8_WAIT_L(0); PG8_MMA(0, 0, At, B0); PG8_BAR; PG8_SCHED;
            PG8_LDB(B1, 1, 1); PG8_STAGE(PG8_SB(1, 0), b3, voffB);
            PG8_BAR; PG8_WAIT_L(0); PG8_MMA(0, 1, At, B1); PG8_BAR;
            PG8_LDA(At, 1, 1); PG8_STAGE(PG8_SA(1, 0), a3, voffA);
            PG8_BAR; PG8_WAIT_L(0); PG8_MMA(1, 0, At, B0); PG8_BAR; PG8_SCHED;
            PG8_STAGE(PG8_SB(1, 1), b3 + hstepB, voffB);
            PG8_WAIT_V(6); PG8_BAR; PG8_MMA(1, 1, At, B1); PG8_BAR;
        }
        E(acc, cur, wr, wc, fr, fq);
        if (!has_next) break;
#pragma unroll
        for (int a = 0; a < 2; ++a)
#pragma unroll
            for (int b = 0; b < 2; ++b)
#pragma unroll
                for (int m = 0; m < 4; ++m)
#pragma unroll
                    for (int n = 0; n < 2; ++n) acc[a][b][m][n] = (f32x4){0.f, 0.f, 0.f, 0.f};
        cur = nxt; cA = nA; cB = nB; ++ui;
    }
    PG8_WAIT_V(0);
    if (wr == 0) PG8_BAR;
    PG8_BAR;
#undef PG8_SA
#undef PG8_SB
#undef PG8_STAGE
#undef PG8_LDA
#undef PG8_LDB
#undef PG8_MMA
#undef PG8_WAIT_V
#undef PG8_WAIT_L
#undef PG8_BAR
#undef PG8_SCHED
}
}
#define XB_TMO      128
#define XB_XCNT(j)  (256  + 64 * (j))
#define XB_XSUB(j)  (1280 + 64 * (j))
#define XB_XGEN(j)  (2304 + 64 * (j))
#define XB_TOP      3328
#define XB_TOPGEN   3392
#define XCD_BAR_WORDS 3456
#define XB_SPIN_CAP (1u << 20)


__device__ __forceinline__ unsigned xb_ld(unsigned* p)              { return __hip_atomic_load(p, __ATOMIC_RELAXED, __HIP_MEMORY_SCOPE_AGENT); }
__device__ __forceinline__ unsigned xb_add(unsigned* p, unsigned v) { return __hip_atomic_fetch_add(p, v, __ATOMIC_RELAXED, __HIP_MEMORY_SCOPE_AGENT); }
__device__ __forceinline__ unsigned xb_xcc_id() { return (unsigned)__builtin_amdgcn_s_getreg((3 << 11) | 20) & 0xFu; }
#define XB_SPIN(cond, bar) do { unsigned _sp = 0; while (cond) { __builtin_amdgcn_s_sleep(1); \
    if ((++_sp & 255u) == 0u) { if (xb_ld(&(bar)[XB_TMO])) break; if (_sp > XB_SPIN_CAP) { atomicAdd(&(bar)[XB_TMO], 1u); break; } } } } while (0)

struct XcdBarrier {
    unsigned* bar; unsigned x;
    volatile LAS unsigned* st;
};

__device__ __forceinline__ XcdBarrier xcd_barrier_post(unsigned* bar, volatile LAS unsigned* st) {
    XcdBarrier b; b.bar = bar; b.x = xb_xcc_id(); b.st = st;
    if (threadIdx.x == 0) (void)xb_add(&bar[XB_XCNT(b.x)], 1u);
    return b;
}
__device__ __forceinline__ void xcd_barrier_complete(unsigned* bar, unsigned x, unsigned& nloc, unsigned& nx) {
    const unsigned G = gridDim.x * gridDim.y * gridDim.z;
    unsigned sum, cnt, mine, sp = 0u;
    for (;;) {
        sum = 0u; cnt = 0u; mine = 0u;
#pragma unroll
        for (unsigned j = 0; j < 16; ++j) { const unsigned c = xb_ld(&bar[XB_XCNT(j)]); sum += c; cnt += (c > 0u) ? 1u : 0u; mine = (j == x) ? c : mine; }
        if (sum == G) break;
        __builtin_amdgcn_s_sleep(1);
        if ((++sp & 255u) == 0u) { if (xb_ld(&bar[XB_TMO])) break; if (sp > XB_SPIN_CAP) { atomicAdd(&bar[XB_TMO], 1u); break; } }
    }
    nloc = mine > 0u ? mine : 1u; nx = cnt > 0u ? cnt : 1u;
}

__device__ __forceinline__ void xcd_barrier(const XcdBarrier& b) {
    asm volatile("s_waitcnt vmcnt(0)" ::: "memory");
    __syncthreads();
    if (threadIdx.x == 0) {
        unsigned* bar = b.bar;
        __builtin_amdgcn_s_waitcnt(0);
        unsigned nloc = b.st[0], nx = b.st[1];
        if (nloc == 0u) { xcd_barrier_complete(bar, b.x, nloc, nx); b.st[0] = nloc; b.st[1] = nx; }
        const unsigned old = xb_add(&bar[XB_XSUB(b.x)], 1u);
        const unsigned gen = old / nloc;
        if (old + 1u == (gen + 1u) * nloc) {
            __builtin_amdgcn_fence(__ATOMIC_RELEASE, "agent");
            asm volatile("s_waitcnt vmcnt(0)" ::: "memory");
            const unsigned og = xb_add(&bar[XB_TOP], 1u);
            const unsigned tg = og / nx;
            if (og + 1u == (tg + 1u) * nx) xb_add(&bar[XB_TOPGEN], 1u);
            else XB_SPIN(xb_ld(&bar[XB_TOPGEN]) == tg, bar);
            __builtin_amdgcn_fence(__ATOMIC_ACQUIRE, "agent");
            xb_add(&bar[XB_XGEN(b.x)], 1u);
            asm volatile("s_waitcnt vmcnt(0)" ::: "memory");
        } else {
            XB_SPIN(xb_ld(&bar[XB_XGEN(b.x)]) == gen, bar);
            __builtin_amdgcn_fence(__ATOMIC_ACQUIRE, "agent");
            asm volatile("s_waitcnt vmcnt(0)" ::: "memory");
        }
    }
    __syncthreads();
}

typedef _Float16 h16;
typedef h16 h16x2 __attribute__((ext_vector_type(2)));
typedef h16 h16x4 __attribute__((ext_vector_type(4)));
typedef h16 h16x8 __attribute__((ext_vector_type(8)));
typedef float f32x4 __attribute__((ext_vector_type(4)));
typedef float f32x2 __attribute__((ext_vector_type(2)));
typedef unsigned u32x4 __attribute__((ext_vector_type(4)));
typedef unsigned u32x2 __attribute__((ext_vector_type(2)));

constexpr int D = 1024, NB = 8, SEQ = 4096, T = NB * SEQ, LC = 256, TC = NB * LC, TALL = T + TC;
constexpr int NTHREADS = 512;
constexpr int LDS_BYTES = 156 * 1024;
constexpr float EPS = 1e-6f;
constexpr size_t MiB = (size_t)1 << 20;
constexpr size_t OFF_CTL = 0;
constexpr size_t OFF_MOD = 64 * 1024;
constexpr size_t OFF_LB = 320 * 1024;
constexpr size_t OFF_WA = 1 * MiB;
constexpr size_t OFF_WG = 6 * MiB;
constexpr size_t OFF_WF = 10 * MiB;
constexpr size_t OFF_WHG = 12 * MiB;
constexpr size_t OFF_WFT = 13 * MiB;
constexpr size_t OFF_WOUT = 14 * MiB;
constexpr size_t OFF_WS = 16 * MiB;
constexpr size_t OFF_UALL = 20 * MiB;
constexpr size_t OFF_OF = 88 * MiB;
constexpr size_t OFF_OB = 120 * MiB;
constexpr size_t OFF_FTT = 152 * MiB;
constexpr size_t OFF_Q = 216 * MiB;
constexpr size_t OFF_LF = 248 * MiB;
constexpr size_t OFF_LBK = 282 * MiB;
constexpr size_t OFF_V = 316 * MiB;
constexpr size_t OFF_G = 350 * MiB;
constexpr size_t OFF_Y1 = 382 * MiB;
constexpr size_t OFF_DFT256 = 512 * 1024;
constexpr size_t OFF_YFT = 446 * MiB;
constexpr size_t OFF_USTATE = 446 * MiB;
constexpr size_t OFF_DLOG = 460 * MiB;
constexpr size_t WS_NEED = 510 * MiB;
constexpr size_t OFF_GH = 216 * MiB;
constexpr size_t OFF_GF = 280 * MiB;
constexpr size_t OFF_Y = 152 * MiB;
constexpr size_t OFF_U2 = 20 * MiB;
constexpr size_t OFF_TU = 478 * MiB;
constexpr size_t OFF_TV = 494 * MiB;
constexpr size_t OFF_QX = 120 * MiB;
constexpr size_t OFF_SU = 768 * 1024;
constexpr size_t OFF_SV = 832 * 1024;
constexpr size_t OFF_SX = 205 * MiB;
constexpr size_t OFF_SC = 216 * MiB;
constexpr size_t OFF_EIDX = 152 * MiB;
constexpr size_t OFF_GATE = 168 * MiB;
constexpr size_t OFF_W = 184 * MiB;
constexpr size_t OFF_PSS = 200 * MiB;
constexpr size_t OFF_PACT = 216 * MiB;
constexpr size_t OFF_PO = 216 * MiB;
constexpr size_t OFF_SIDE = 88 * MiB;
constexpr int CTL_RANK = 4096;
constexpr size_t CTL_ZERO_BYTES = 32 * 1024;

struct Params { const float* in[20]; float* out; unsigned char* ws; int ph_lo, ph_hi; };

__device__ __forceinline__ unsigned pk2(float a, float b) { h16x2 v = {(h16)a, (h16)b}; return __builtin_bit_cast(unsigned, v); }
__device__ __forceinline__ float wave_sum(float v) {
#pragma unroll
    for (int o = 32; o >= 1; o >>= 1) v += __shfl_xor(v, o);
    return v; }
__device__ __forceinline__ float sigmoidf_(float z) { return 1.0f / (1.0f + __expf(-z)); }

constexpr int N_MOD = 192, N_LB = 1, N_TRA = 640, N_TRG = 512, N_TRHG = 128, N_TRFT = 128, N_TROUT = 256, N_WF = 128, N_WSF = 256, N_DFT = 1;
constexpr int P0_TOTAL = N_MOD + N_LB + N_TRA + N_TRG + N_TRHG + N_TRFT + N_TROUT + N_WF + N_WSF + N_DFT;

__device__ __forceinline__ void p0_mod(const Params& p, LAS float* sm, int idx) {
    const int tid = threadIdx.x;
    for (int i = tid; i < 9 * 1024; i += NTHREADS) { const int r = i >> 10, k = i & 1023; const float c = (r < 8) ? p.in[1][r * 1024 + k] : p.in[3][k]; sm[i] = c / (1.0f + __expf(-c)); }
    __syncthreads();
    const int col = tid & 31, ks = tid >> 5;
    float acc[9];
#pragma unroll
    for (int r = 0; r < 9; ++r) acc[r] = 0.f;
    const float* w = p.in[4] + (size_t)(ks * 64) * 6144 + idx * 32 + col;
#pragma unroll 8
    for (int k = 0; k < 64; ++k) { const float wv = w[(size_t)k * 6144];
#pragma unroll
        for (int r = 0; r < 9; ++r) acc[r] += sm[r * 1024 + ks * 64 + k] * wv; }
    LAS float* red = sm + 9 * 1024;
#pragma unroll
    for (int r = 0; r < 9; ++r) red[(ks * 9 + r) * 32 + col] = acc[r];
    __syncthreads();
    float* mod = (float*)(p.ws + OFF_MOD);
    if (tid < 288) { const int r = tid >> 5, c = tid & 31; float s = 0.f;
#pragma unroll
        for (int q = 0; q < 16; ++q) s += red[(q * 9 + r) * 32 + c];
        mod[r * 6144 + idx * 32 + c] = s + p.in[5][idx * 32 + c]; }
    __syncthreads();
}
__device__ __forceinline__ void p0_lb(const Params& p) {
    const int tid = threadIdx.x; float* lb = (float*)(p.ws + OFF_LB);
    if (tid < 512) { lb[tid] = 1.0f / (1.0f + expf(p.in[9][512 + tid] - p.in[9][tid])); lb[512 + tid] = 1.0f / (1.0f + expf(p.in[10][512 + tid] - p.in[10][tid])); }
}
__device__ __forceinline__ void p0_transpose(const float* src, int ld_src, int ncol0, h16* dst, int ld_dst, int nktiles, int item, LAS float* sm) {
    const int tid = threadIdx.x, kt = item % nktiles, nt = item / nktiles;
    { const int n = tid & 63, kk = tid >> 6;
#pragma unroll
      for (int ps = 0; ps < 8; ++ps) { const int k = kk + 8 * ps; sm[k * 65 + n] = src[(size_t)(kt * 64 + k) * ld_src + ncol0 + nt * 64 + n]; } }
    __syncthreads();
    { const int k = tid & 63, nn = tid >> 6;
#pragma unroll
      for (int ps = 0; ps < 8; ++ps) { const int n = nn + 8 * ps; dst[(size_t)(nt * 64 + n) * ld_dst + kt * 64 + k] = (h16)sm[k * 65 + n]; } }
    __syncthreads();
}
__device__ __forceinline__ void p0_wf(const Params& p, LAS float* sm, int item) {
    const int tid = threadIdx.x, dt = item & 15, part = (item >> 4) & 1, g = item >> 5, d0 = dt * 64;
    LAS float* w = sm; LAS float* trig = sm + 64 * 129;
    for (int i = tid; i < 64 * 128; i += NTHREADS) { const int dl = i >> 7, n2 = i & 127; w[dl * 129 + n2] = p.in[8][(size_t)(d0 + dl) * 5120 + 2560 + g * 128 + n2]; }
    if (tid < 128) trig[tid] = part ? sinpif((float)tid / 64.0f) : cospif((float)tid / 64.0f);
    __syncthreads();
    const int dl = tid & 63, kg = tid >> 6; h16* WF = (h16*)(p.ws + OFF_WF);
#pragma unroll 1
    for (int kk = 0; kk < 16; ++kk) { const int k2 = kg * 16 + kk; float s = 0.f;
#pragma unroll 4
        for (int n2 = 0; n2 < 128; ++n2) s += w[dl * 129 + n2] * trig[(k2 * n2) & 127];
        WF[(size_t)(part * 512 + g * 128 + k2) * 1024 + d0 + dl] = (h16)(s * 0.08838834764831845f); }
    __syncthreads();
}
__device__ __forceinline__ void p0_wsf(const Params& p, LAS float* sm, int item) {
    const int tid = threadIdx.x, dt = item & 15, hp = item >> 4, d0 = dt * 64;
    LAS float* wq = sm; LAS float* sk = sm + 8256;
    for (int i = tid; i < 64 * 128; i += NTHREADS) { const int dl = i >> 7, k = i & 127; wq[dl * 129 + k] = p.in[15][(size_t)(d0 + dl) * 2048 + hp * 128 + k]; }
    for (int i = tid; i < 128 * 128; i += NTHREADS) sk[i] = p.in[16][(size_t)hp * 16384 + i];
    __syncthreads();
    const int dl = tid & 63, ng = tid >> 6; h16* WS = (h16*)(p.ws + OFF_WS);
#pragma unroll 1
    for (int nn = 0; nn < 16; ++nn) { const int n = ng * 16 + nn; float s = 0.f;
#pragma unroll 4
        for (int k = 0; k < 128; ++k) s += wq[dl * 129 + k] * sk[n * 128 + k];
        WS[(size_t)(hp * 128 + n) * 1024 + d0 + dl] = (h16)s; }
    __syncthreads();
}
__device__ __forceinline__ void p0_dft256(const Params& p) {
    h16* M = (h16*)(p.ws + OFF_DFT256);
    for (int e = threadIdx.x; e < 256 * 512; e += NTHREADS) { const int c = e >> 9, k = e & 511, part = k >> 8, a = k & 255; const int m = (a * c) & 255;
        M[e] = (h16)((part ? sinpif((float)m / 128.0f) : cospif((float)m / 128.0f)) * 0.25f); }
}
__device__ __forceinline__ void phase0(const Params& p, LAS unsigned char* lds) {
    LAS float* sm = (LAS float*)lds;
    for (int it = blockIdx.x; it < P0_TOTAL; it += gridDim.x) {
        int i = it;
        if (i < N_MOD) { p0_mod(p, sm, i); continue; } i -= N_MOD;
        if (i < N_LB) { p0_lb(p); continue; } i -= N_LB;
        if (i < N_TRA) { p0_transpose(p.in[8], 5120, 0, (h16*)(p.ws + OFF_WA), 1024, 16, i, sm); continue; } i -= N_TRA;
        if (i < N_TRG) { p0_transpose(p.in[8], 5120, 3072, (h16*)(p.ws + OFF_WG), 1024, 16, i, sm); continue; } i -= N_TRG;
        if (i < N_TRHG) { p0_transpose(p.in[12], 1024, 0, (h16*)(p.ws + OFF_WHG), 512, 8, i, sm); continue; } i -= N_TRHG;
        if (i < N_TRFT) { p0_transpose(p.in[13], 1024, 0, (h16*)(p.ws + OFF_WFT), 512, 8, i, sm); continue; } i -= N_TRFT;
        if (i < N_TROUT) { p0_transpose(p.in[14], 1024, 0, (h16*)(p.ws + OFF_WOUT), 1024, 16, i, sm); continue; } i -= N_TROUT;
        if (i < N_WF) { p0_wf(p, sm, i); continue; } i -= N_WF;
        if (i < N_WSF) { p0_wsf(p, sm, i); continue; } i -= N_WSF;
        p0_dft256(p);
    }
}

__device__ __forceinline__ void modulate_rows(const float* src, h16* dst, int nrows, const float* gvec, const float* mod, int sh_off, int sc_off, int ctx_rows, signed char* qdst = nullptr, float* qscale = nullptr) {
    const int wave = threadIdx.x >> 6, lane = threadIdx.x & 63;
    for (int row = blockIdx.x * 8 + wave; row < nrows; row += gridDim.x * 8) {
        const int mr = ctx_rows ? 8 : (row >> 12);
        const float* x = src + (size_t)row * D;
        f32x4 v[4]; float ss = 0.f;
#pragma unroll
        for (int j = 0; j < 4; ++j) { v[j] = *(const f32x4*)(x + j * 256 + lane * 4); ss += v[j].x * v[j].x + v[j].y * v[j].y + v[j].z * v[j].z + v[j].w * v[j].w; }
        ss = wave_sum(ss);
        const float rstd = rsqrtf(ss * (1.0f / D) + EPS);
        float amax = 0.f;
#pragma unroll
        for (int j = 0; j < 4; ++j) { const int c = j * 256 + lane * 4;
            const f32x4 gg = *(const f32x4*)(gvec + c), sc = *(const f32x4*)(mod + mr * 6144 + sc_off + c), sh = *(const f32x4*)(mod + mr * 6144 + sh_off + c);
            const f32x4 o = (v[j] * rstd) * gg * (sc + 1.0f) + sh; v[j] = o;
            amax = fmaxf(amax, fmaxf(fmaxf(fabsf(o.x), fabsf(o.y)), fmaxf(fabsf(o.z), fabsf(o.w))));
            u32x2 w; w.x = pk2(o.x, o.y); w.y = pk2(o.z, o.w);
            *(u32x2*)(dst + (size_t)row * D + c) = w; }
        if (qdst) {
#pragma unroll
            for (int o = 32; o >= 1; o >>= 1) amax = fmaxf(amax, __shfl_xor(amax, o));
            const float qs = amax > 0.f ? amax * (1.0f / 127.0f) : 1.0f, inv = 1.0f / qs;
#pragma unroll
            for (int j = 0; j < 4; ++j) { const int c = j * 256 + lane * 4;
                const int q0 = (int)rintf(v[j].x * inv), q1 = (int)rintf(v[j].y * inv), q2 = (int)rintf(v[j].z * inv), q3 = (int)rintf(v[j].w * inv);
                *(unsigned*)(qdst + (size_t)row * D + c) = (unsigned)(q0 & 255) | ((unsigned)(q1 & 255) << 8) | ((unsigned)(q2 & 255) << 16) | ((unsigned)(q3 & 255) << 24); }
            if (lane == 0) qscale[row] = qs;
        }
    }
}

struct EpiA {
    static constexpr bool PERM = true, TRANS = true;
    unsigned char* ws;
    __device__ __forceinline__ void operator()(const f32x4 (&acc)[2][2][4][2], const pg8::Unit& u, int wr, int wc, int fr, int fq) const {
        const int ty = u.pn >> 1;
        h16* base = (h16*)(ws + (ty == 0 ? OFF_Q : ty == 1 ? OFF_LF : ty == 2 ? OFF_LBK : ty == 3 ? OFF_V : OFF_G));
        const float* lb = (const float*)(ws + OFF_LB) + (ty == 2 ? 512 : 0);
        const int row0 = u.pm * 256 + wr * 64 + fr, col0 = (u.pn & 1) * 256 + wc * 32 + 8 * fq;
#pragma unroll
        for (int bj = 0; bj < 2; ++bj) {
            float lbv[8];
            if (ty == 1 || ty == 2) {
#pragma unroll
                for (int j = 0; j < 8; ++j) lbv[j] = lb[col0 + bj * 128 + j];
            }
#pragma unroll
            for (int ai = 0; ai < 2; ++ai)
#pragma unroll
                for (int m = 0; m < 4; ++m) {
                    float v[8];
#pragma unroll
                    for (int j = 0; j < 4; ++j) { v[j] = acc[ai][bj][m][0][j]; v[4 + j] = acc[ai][bj][m][1][j]; }
                    if (ty == 0) {
#pragma unroll
                        for (int j = 0; j < 8; ++j) v[j] *= 0.08838834764831845f;
                    } else if (ty == 1 || ty == 2) {
#pragma unroll
                        for (int j = 0; j < 8; ++j) v[j] = __logf(lbv[j] + (1.0f - lbv[j]) * sigmoidf_(v[j]));
                    } else if (ty == 4) {
#pragma unroll
                        for (int j = 0; j < 8; ++j) v[j] = v[j] * sigmoidf_(v[j]);
                    }
                    u32x4 w; w.x = pk2(v[0], v[1]); w.y = pk2(v[2], v[3]); w.z = pk2(v[4], v[5]); w.w = pk2(v[6], v[7]);
                    *(u32x4*)(base + (size_t)(row0 + ai * 128 + m * 16) * 512 + col0 + bj * 128) = w;
                }
        }
    }
};
struct OrderA {
    pg8::TileOrder lat; int G, c, rep;
    __device__ void init(int G_, int c_, int rep_ = 1) { lat.init(128, 10, G_, c_); G = G_; c = c_; rep = rep_; }
    __device__ bool next(int i, pg8::Unit& u) const {
        long L = (long)i * G + c; if (L >= 1328L * rep) return false; L %= 1328;
        if (L < 1280) return lat.map(L, u);
        const int l2 = (int)(L - 1280); if (l2 >= 48) return false;
        u.pm = 128 + l2 / 6; u.pn = 2 + l2 % 6; return true;
    }
};
struct EpiGate {
    static constexpr bool PERM = true, TRANS = true;
    unsigned char* ws;
    __device__ __forceinline__ void operator()(const f32x4 (&acc)[2][2][4][2], const pg8::Unit& u, int wr, int wc, int fr, int fq) const {
        h16* base = (h16*)(ws + (u.pn < 4 ? OFF_GH : OFF_GF));
        const int row0 = u.pm * 256 + wr * 64 + fr, col0 = (u.pn & 3) * 256 + wc * 32 + 8 * fq;
#pragma unroll
        for (int ai = 0; ai < 2; ++ai)
#pragma unroll
            for (int m = 0; m < 4; ++m)
#pragma unroll
                for (int bj = 0; bj < 2; ++bj) {
                    float v[8];
#pragma unroll
                    for (int j = 0; j < 4; ++j) { v[j] = sigmoidf_(acc[ai][bj][m][0][j]); v[4 + j] = sigmoidf_(acc[ai][bj][m][1][j]); }
                    u32x4 w; w.x = pk2(v[0], v[1]); w.y = pk2(v[2], v[3]); w.z = pk2(v[4], v[5]); w.w = pk2(v[6], v[7]);
                    *(u32x4*)(base + (size_t)(row0 + ai * 128 + m * 16) * 1024 + col0 + bj * 128) = w;
                }
    }
};
struct EpiFT {
    static constexpr bool PERM = false, TRANS = false;
    unsigned char* ws;
    __device__ __forceinline__ void operator()(const f32x4 (&acc)[2][2][4][2], const pg8::Unit& u, int wr, int wc, int fr, int fq) const {
        h16* F = (h16*)(ws + OFF_FTT);
        const int t0 = u.pm * 256 + wr * 64 + 4 * fq, c0 = u.pn * 256 + wc * 32 + fr;
#pragma unroll
        for (int ai = 0; ai < 2; ++ai)
#pragma unroll
            for (int m = 0; m < 4; ++m)
#pragma unroll
                for (int bj = 0; bj < 2; ++bj)
#pragma unroll
                    for (int n = 0; n < 2; ++n) {
                        const int t = t0 + ai * 128 + m * 16, c = c0 + bj * 128 + n * 16;
                        const int b = t >> 12, n1 = t & 4095, part = c >> 9, gk = c & 511;
                        const f32x4 a = acc[ai][bj][m][n];
                        u32x2 w; w.x = pk2(a.x, a.y); w.y = pk2(a.z, a.w);
                        *(u32x2*)(F + ((size_t)((b * 512 + gk) * 2 + part)) * 4096 + n1) = w;
                    }
    }
};
struct EpiDFT {
    static constexpr bool PERM = true, TRANS = true;
    unsigned char* ws;
    __device__ __forceinline__ void operator()(const f32x4 (&acc)[2][2][4][2], const pg8::Unit& u, int wr, int wc, int fr, int fq) const {
        h16* Y = (h16*)(ws + OFF_YFT);
        const int b = u.pn >> 5, d = (u.pn >> 1) & 15;
        const int c0 = wr * 64 + fr, col0 = (u.pn & 1) * 256 + wc * 32 + 8 * fq;
#pragma unroll
        for (int ai = 0; ai < 2; ++ai)
#pragma unroll
            for (int m = 0; m < 4; ++m)
#pragma unroll
                for (int bj = 0; bj < 2; ++bj) {
                    const int c = c0 + ai * 128 + m * 16;
                    const f32x4 a0 = acc[ai][bj][m][0], a1 = acc[ai][bj][m][1];
                    u32x4 w; w.x = pk2(a0.x, a0.y); w.y = pk2(a0.z, a0.w); w.z = pk2(a1.x, a1.y); w.w = pk2(a1.z, a1.w);
                    *(u32x4*)(Y + (size_t)(b * 4096 + d + 16 * c) * 512 + col0 + bj * 128) = w;
                }
    }
};
template <bool ACCUM> struct EpiMerge1 {
    static constexpr bool PERM = true, TRANS = true;
    unsigned char* ws;
    __device__ __forceinline__ void operator()(const f32x4 (&acc)[2][2][4][2], const pg8::Unit& u, int wr, int wc, int fr, int fq) const {
        h16* Y = (h16*)(ws + OFF_Y); const h16* GT = (const h16*)(ws + (ACCUM ? OFF_GF : OFF_GH));
        const int row0 = u.pm * 256 + wr * 64 + fr, col0 = u.pn * 256 + wc * 32 + 8 * fq;
#pragma unroll
        for (int ai = 0; ai < 2; ++ai)
#pragma unroll
            for (int m = 0; m < 4; ++m)
#pragma unroll
                for (int bj = 0; bj < 2; ++bj) {
                    const size_t off = (size_t)(row0 + ai * 128 + m * 16) * 1024 + col0 + bj * 128;
                    const h16x8 gt = *(const h16x8*)(GT + off);
                    float v[8];
#pragma unroll
                    for (int j = 0; j < 4; ++j) { v[j] = acc[ai][bj][m][0][j] * (float)gt[j]; v[4 + j] = acc[ai][bj][m][1][j] * (float)gt[4 + j]; }
                    if (ACCUM) { const h16x8 y0 = *(const h16x8*)(Y + off);
#pragma unroll
                        for (int j = 0; j < 8; ++j) v[j] += (float)y0[j]; }
                    u32x4 w; w.x = pk2(v[0], v[1]); w.y = pk2(v[2], v[3]); w.z = pk2(v[4], v[5]); w.w = pk2(v[6], v[7]);
                    *(u32x4*)(Y + off) = w;
                }
    }
};
struct EpiMerge2 {
    static constexpr bool PERM = false, TRANS = true;
    const float* x; float* H; const float* mod;
    __device__ __forceinline__ void operator()(const f32x4 (&acc)[2][2][4][2], const pg8::Unit& u, int wr, int wc, int fr, int fq) const {
        const int row0 = u.pm * 256 + wr * 64 + fr, col0 = u.pn * 256 + wc * 32 + 4 * fq;
        const int b = (u.pm * 256) >> 12;
        f32x4 g1[2][2];
#pragma unroll
        for (int bj = 0; bj < 2; ++bj)
#pragma unroll
            for (int n = 0; n < 2; ++n) g1[bj][n] = *(const f32x4*)(mod + b * 6144 + 2048 + col0 + bj * 128 + n * 16);
#pragma unroll
        for (int ai = 0; ai < 2; ++ai)
#pragma unroll
            for (int m = 0; m < 4; ++m) { const size_t ro = (size_t)(row0 + ai * 128 + m * 16) * 1024 + col0;
#pragma unroll
                for (int bj = 0; bj < 2; ++bj)
#pragma unroll
                    for (int n = 0; n < 2; ++n) { const f32x4 xv = *(const f32x4*)(x + ro + bj * 128 + n * 16);
                        *(f32x4*)(H + ro + bj * 128 + n * 16) = xv + g1[bj][n] * acc[ai][bj][m][n]; } }
    }
};
struct EpiF32 {
    static constexpr bool PERM = false, TRANS = true;
    float* C; int ldc;
    __device__ __forceinline__ void operator()(const f32x4 (&acc)[2][2][4][2], const pg8::Unit& u, int wr, int wc, int fr, int fq) const {
        const int row0 = u.pm * 256 + wr * 64 + fr, col0 = u.pn * 256 + wc * 32 + 4 * fq;
#pragma unroll
        for (int ai = 0; ai < 2; ++ai)
#pragma unroll
            for (int m = 0; m < 4; ++m) { float* rowp = C + (size_t)(row0 + ai * 128 + m * 16) * ldc + col0;
#pragma unroll
                for (int bj = 0; bj < 2; ++bj)
#pragma unroll
                    for (int n = 0; n < 2; ++n) *(f32x4*)(rowp + bj * 128 + n * 16) = acc[ai][bj][m][n]; }
    }
};

__device__ __forceinline__ int hgrn_row(int pos, int b, int dir) {
    if (pos < LC) { const int j = dir ? (LC - 1 - pos) : pos; return T + b * LC + j; }
    const int t = pos - LC; return b * SEQ + (dir ? (SEQ - 1 - t) : t);
}
__device__ void hgrn_item(const Params& p, LAS unsigned char* lds, int item) {
    const int tid = threadIdx.x, vq = item & 3, dir = (item >> 2) & 1, h = (item >> 3) & 3, b = item >> 5;
    const h16* Q = (const h16*)(p.ws + OFF_Q); const h16* LF = (const h16*)(p.ws + (dir ? OFF_LBK : OFF_LF)); const h16* V = (const h16*)(p.ws + OFF_V);
    h16* O = (h16*)(p.ws + (dir ? OFF_OB : OFF_OF));
    LAS float* fs = (LAS float*)lds; LAS float* ks = fs + 16 * 128; LAS float* qs = ks + 16 * 128; LAS float* vs = qs + 16 * 128; LAS float* po = vs + 16 * 32;
    const int v = tid & 31, kq = tid >> 5;
    float S[8];
#pragma unroll
    for (int j = 0; j < 8; ++j) S[j] = 0.f;
    const int e = tid * 4, tl_ld = e >> 7, k_ld = e & 127;
    const int tl_v = tid >> 5, vv = tid & 31;
    h16x4 lf4, q4; h16 v1;
    { const int row = hgrn_row(tl_ld, b, dir); lf4 = *(const h16x4*)(LF + (size_t)row * 512 + h * 128 + k_ld); q4 = (h16x4){0, 0, 0, 0};
      const int row2 = hgrn_row(tl_v, b, dir); v1 = V[(size_t)row2 * 512 + h * 128 + vq * 32 + vv]; }
    constexpr int NG = (LC + SEQ) / 16;
    for (int grp = 0; grp < NG; ++grp) {
        const bool latent = grp >= LC / 16;
#pragma unroll
        for (int j = 0; j < 4; ++j) { const float f = __expf((float)lf4[j]); fs[e + j] = f; ks[e + j] = 1.0f - f; qs[e + j] = (float)q4[j]; }
        vs[tid] = (float)v1;
        __syncthreads();
        if (grp + 1 < NG) { const int pos = (grp + 1) * 16; const bool lat2 = (grp + 1) >= LC / 16;
            const int row = hgrn_row(pos + tl_ld, b, dir); lf4 = *(const h16x4*)(LF + (size_t)row * 512 + h * 128 + k_ld);
            if (lat2) q4 = *(const h16x4*)(Q + (size_t)row * 512 + h * 128 + k_ld);
            const int row2 = hgrn_row(pos + tl_v, b, dir); v1 = V[(size_t)row2 * 512 + h * 128 + vq * 32 + vv]; }
#pragma unroll 4
        for (int tl = 0; tl < 16; ++tl) {
            const float vt = vs[tl * 32 + v];
            const f32x4 f0 = *(const LAS f32x4*)(fs + tl * 128 + kq * 8), f1 = *(const LAS f32x4*)(fs + tl * 128 + kq * 8 + 4);
            const f32x4 k0 = *(const LAS f32x4*)(ks + tl * 128 + kq * 8), k1 = *(const LAS f32x4*)(ks + tl * 128 + kq * 8 + 4);
            const f32x4 q0 = *(const LAS f32x4*)(qs + tl * 128 + kq * 8), q1 = *(const LAS f32x4*)(qs + tl * 128 + kq * 8 + 4);
            float a = 0.f;
#pragma unroll
            for (int j = 0; j < 4; ++j) { S[j] = f0[j] * S[j] + k0[j] * vt; a += S[j] * q0[j]; S[4 + j] = f1[j] * S[4 + j] + k1[j] * vt; a += S[4 + j] * q1[j]; }
            po[(tl * 16 + kq) * 32 + v] = a;
        }
        __syncthreads();
        if (latent) { float s = 0.f;
#pragma unroll
            for (int q = 0; q < 16; ++q) s += po[(tl_v * 16 + q) * 32 + vv];
            const int row = hgrn_row(grp * 16 + tl_v, b, dir);
            O[(size_t)row * 512 + h * 128 + vq * 32 + vv] = (h16)s; }
    }
    __syncthreads();
}

typedef short s16x8 __attribute__((ext_vector_type(8)));
typedef short s16x4 __attribute__((ext_vector_type(4)));
__device__ __forceinline__ unsigned cvt_pk_bf16(float lo, float hi) { unsigned r; asm volatile("v_cvt_pk_bf16_f32 %0, %1, %2" : "=v"(r) : "v"(lo), "v"(hi)); return r; }
constexpr int HG_RP = 272, HG_QT = 0, HG_KT = 17408, HG_QD = 34816, HG_KDT = 52224, HG_VT = 68608, HG_AM = 84992, HG_DEC = 93184, HG_SEG = 93696, HG_SEGCH = 17;
#define HG_OPAQUE(x) asm volatile("" : "+v"(x))
template <bool FULL>
__device__ __forceinline__ void hgrn_mfma_unit(const Params& p, LAS unsigned char* lds, int item, int seg) {
    const int tid = threadIdx.x, wave = __builtin_amdgcn_readfirstlane(tid >> 6), lane = tid & 63, fr = lane & 15, fq = lane >> 4;
    const int dir = item & 1, h = (item >> 1) & 3, b = item >> 3;
    const h16* Q = (const h16*)(p.ws + OFF_Q); const h16* LF = (const h16*)(p.ws + (dir ? OFF_LBK : OFF_LF)); const h16* V = (const h16*)(p.ws + OFF_V);
    h16* O = (h16*)(p.ws + (dir ? OFF_OB : OFF_OF));
    float* USTATE = (float*)(p.ws + OFF_USTATE); float* DLOG = (float*)(p.ws + OFF_DLOG);
    const int ch_lo = seg * HG_SEGCH, ch_hi = ch_lo + HG_SEGCH;
    f32x4 S[8];
#pragma unroll
    for (int m = 0; m < 8; ++m) S[m] = (f32x4){0.f, 0.f, 0.f, 0.f};
    if (FULL && seg > 0) {
        for (int i = 0; i < seg; ++i) { const float* U = USTATE + (size_t)(item * 3 + i) * 16384; const float* DL = DLOG + (size_t)(item * 3 + i) * 128;
#pragma unroll
            for (int m = 0; m < 8; ++m)
#pragma unroll
                for (int j = 0; j < 4; ++j) { const int k = 16 * m + 4 * fq + j; const float d = (i > 0) ? __expf(DL[k]) : 0.f; S[m][j] = d * S[m][j] + U[k * 128 + 16 * wave + fr]; } } }
    float dl0 = 0.f, dl1 = 0.f;
    for (int i = tid; i < 8192 / 16; i += NTHREADS) ((LAS u32x4*)(lds + HG_AM))[i] = (u32x4){0u, 0u, 0u, 0u};
    const int kp = lane;
    const unsigned chan = (unsigned)(h * 128 + 2 * kp);
    int bw_rm = wave * 8 * HG_RP + 4 * kp;
    int bw_t0 = (2 * kp) * 128 + ((wave ^ ((2 * kp) & 7)) << 4), bw_t1 = (2 * kp + 1) * 128 + ((wave ^ ((2 * kp + 1) & 7)) << 4);
    int br_rm = fr * HG_RP + 16 * fq;
    int br_qd = HG_QD + fr * HG_RP + 8 * fq;
    int br_t0 = fr * 128 + ((fq ^ (fr & 7)) << 4), br_t1 = fr * 128 + (((4 + fq) ^ (fr & 7)) << 4);
    HG_OPAQUE(bw_rm); HG_OPAQUE(bw_t0); HG_OPAQUE(bw_t1); HG_OPAQUE(br_rm); HG_OPAQUE(br_qd); HG_OPAQUE(br_t0); HG_OPAQUE(br_t1);
    int br_v0 = br_t0 + HG_VT + wave * 2048, br_v1 = br_t1 + HG_VT + wave * 2048, br_k0 = br_t0 + HG_KDT, br_k1 = br_t1 + HG_KDT, br_a0 = br_t0 + HG_AM, br_a1 = br_t1 + HG_AM;
    HG_OPAQUE(br_v0); HG_OPAQUE(br_v1); HG_OPAQUE(br_k0); HG_OPAQUE(br_k1); HG_OPAQUE(br_a0); HG_OPAQUE(br_a1);
    LAS float* DEC = (LAS float*)(lds + HG_DEC); LAS float* SEG = (LAS float*)(lds + HG_SEG);
    unsigned lfr[8], qr[8], vr[8];
#pragma unroll
    for (int r = 0; r < 8; ++r) { const unsigned eo = (unsigned)hgrn_row(ch_lo * 64 + 8 * wave + r, b, dir) * 512u + chan; lfr[r] = *(const unsigned*)(LF + eo); vr[r] = *(const unsigned*)(V + eo);
        qr[r] = (FULL && ch_lo >= LC / 64) ? *(const unsigned*)(Q + eo) : 0u; }
    for (int ch = ch_lo; ch < ch_hi; ++ch) {
        const bool latent = FULL && (ch >= LC / 64);
        float c0[8], c1[8]; float run0 = 0.f, run1 = 0.f;
#pragma unroll
        for (int r = 0; r < 8; ++r) { const h16x2 l = __builtin_bit_cast(h16x2, lfr[r]); run0 += (float)l[0]; run1 += (float)l[1]; c0[r] = run0; c1[r] = run1; }
        *(LAS f32x2*)(SEG + wave * 128 + 2 * kp) = (f32x2){run0, run1};
        __syncthreads();
        float off0 = 0.f, off1 = 0.f, mid0 = 0.f, mid1 = 0.f, tot0 = 0.f, tot1 = 0.f;
#pragma unroll
        for (int w2 = 0; w2 < 8; ++w2) { const f32x2 tt = *(LAS f32x2*)(SEG + w2 * 128 + 2 * kp);
            if (w2 < wave) { off0 += tt[0]; off1 += tt[1]; } if (w2 < 4) { mid0 += tt[0]; mid1 += tt[1]; } tot0 += tt[0]; tot1 += tt[1]; }
        dl0 += tot0; dl1 += tot1;
        const float em0 = __expf(mid0), em1 = __expf(mid1), el0 = __expf(tot0 - mid0), el1 = __expf(tot1 - mid1);
        if (wave == 0) *(LAS f32x2*)(DEC + 2 * kp) = (f32x2){__expf(tot0), __expf(tot1)};
        unsigned kd0[4], kd1[4], vt0[4], vt1[4];
#pragma unroll
        for (int r = 0; r < 8; ++r) {
            const h16x2 l = __builtin_bit_cast(h16x2, lfr[r]), q = __builtin_bit_cast(h16x2, qr[r]), v = __builtin_bit_cast(h16x2, vr[r]);
            const float b0 = off0 + c0[r], b1 = off1 + c1[r];
            const float e20 = __expf(mid0 - b0), e21 = __expf(mid1 - b1);
            const float k0 = 1.0f - __expf((float)l[0]), k1 = 1.0f - __expf((float)l[1]);
            const float kt0 = k0 * e20, kt1 = k1 * e21;
            if (FULL) {
                const float e10 = __expf(b0 - mid0), e11 = __expf(b1 - mid1);
                const float qt0 = (float)q[0] * e10, qt1 = (float)q[1] * e11;
                *(LAS unsigned*)(lds + bw_rm + HG_QT + r * HG_RP) = cvt_pk_bf16(qt0, qt1);
                *(LAS unsigned*)(lds + bw_rm + HG_KT + r * HG_RP) = cvt_pk_bf16(kt0, kt1);
                *(LAS unsigned*)(lds + bw_rm + HG_QD + r * HG_RP) = cvt_pk_bf16(qt0 * em0, qt1 * em1);
            }
            const float kdv0 = kt0 * el0, kdv1 = kt1 * el1;
            if (r & 1) { kd0[r >> 1] = cvt_pk_bf16(__builtin_bit_cast(float, kd0[r >> 1]), kdv0); kd1[r >> 1] = cvt_pk_bf16(__builtin_bit_cast(float, kd1[r >> 1]), kdv1);
                         vt0[r >> 1] = cvt_pk_bf16(__builtin_bit_cast(float, vt0[r >> 1]), (float)v[0]); vt1[r >> 1] = cvt_pk_bf16(__builtin_bit_cast(float, vt1[r >> 1]), (float)v[1]); }
            else { kd0[r >> 1] = __builtin_bit_cast(unsigned, kdv0); kd1[r >> 1] = __builtin_bit_cast(unsigned, kdv1);
                   vt0[r >> 1] = __builtin_bit_cast(unsigned, (float)v[0]); vt1[r >> 1] = __builtin_bit_cast(unsigned, (float)v[1]); }
        }
        *(LAS u32x4*)(lds + bw_t0 + HG_KDT) = (u32x4){kd0[0], kd0[1], kd0[2], kd0[3]};
        *(LAS u32x4*)(lds + bw_t1 + HG_KDT) = (u32x4){kd1[0], kd1[1], kd1[2], kd1[3]};
        *(LAS u32x4*)(lds + bw_t0 + HG_VT) = (u32x4){vt0[0], vt0[1], vt0[2], vt0[3]};
        *(LAS u32x4*)(lds + bw_t1 + HG_VT) = (u32x4){vt1[0], vt1[1], vt1[2], vt1[3]};
        __syncthreads();
        if (ch + 1 < ch_hi) { const bool lat2 = FULL && ((ch + 1) >= LC / 64);
#pragma unroll
            for (int r = 0; r < 8; ++r) { const unsigned eo = (unsigned)hgrn_row((ch + 1) * 64 + 8 * wave + r, b, dir) * 512u + chan;
                lfr[r] = *(const unsigned*)(LF + eo); vr[r] = *(const unsigned*)(V + eo); qr[r] = lat2 ? *(const unsigned*)(Q + eo) : 0u; } }
        if (latent) {
#pragma unroll
            for (int rep = 0; rep < 2; ++rep) {
                const int tile = wave + 8 * rep;
                if (tile < 10) {
                    const int ti = tile < 1 ? 0 : tile < 3 ? 1 : tile < 6 ? 2 : 3, si = tile - (ti * (ti + 1)) / 2;
                    f32x4 acc = (f32x4){0.f, 0.f, 0.f, 0.f};
                    LAS unsigned char* pa = lds + br_rm + HG_KT + 16 * si * HG_RP; LAS unsigned char* pb = lds + br_rm + HG_QT + 16 * ti * HG_RP;
#pragma unroll
                    for (int kk = 0; kk < 4; ++kk) acc = __builtin_amdgcn_mfma_f32_16x16x32_bf16(*(LAS s16x8*)(pa + 64 * kk), *(LAS s16x8*)(pb + 64 * kk), acc, 0, 0, 0);
                    const int t = 16 * ti + fr, s0 = 16 * si + 4 * fq;
                    if (ti == si) {
#pragma unroll
                        for (int j = 0; j < 4; ++j) acc[j] = (s0 + j <= t) ? acc[j] : 0.f; }
                    *(LAS u32x2*)(lds + HG_AM + t * 128 + ((((s0 >> 3)) ^ (fr & 7)) << 4) + (s0 & 7) * 2) = (u32x2){cvt_pk_bf16(acc[0], acc[1]), cvt_pk_bf16(acc[2], acc[3])};
                }
            }
        }
        __syncthreads();
        const s16x8 vf0 = *(LAS s16x8*)(lds + br_v0), vf1 = *(LAS s16x8*)(lds + br_v1);
        if (latent) {
            s16x8 sfrag[4];
#pragma unroll
            for (int kk = 0; kk < 4; ++kk) { const unsigned w0 = cvt_pk_bf16(S[2 * kk][0], S[2 * kk][1]), w1 = cvt_pk_bf16(S[2 * kk][2], S[2 * kk][3]),
                                                          w2 = cvt_pk_bf16(S[2 * kk + 1][0], S[2 * kk + 1][1]), w3 = cvt_pk_bf16(S[2 * kk + 1][2], S[2 * kk + 1][3]);
                sfrag[kk] = __builtin_bit_cast(s16x8, (u32x4){w0, w1, w2, w3}); }
#pragma unroll
            for (int ti = 0; ti < 4; ++ti) {
                f32x4 acc = (f32x4){0.f, 0.f, 0.f, 0.f};
                acc = __builtin_amdgcn_mfma_f32_16x16x32_bf16(vf0, *(LAS s16x8*)(lds + br_a0 + 2048 * ti), acc, 0, 0, 0);
                if (ti >= 2) acc = __builtin_amdgcn_mfma_f32_16x16x32_bf16(vf1, *(LAS s16x8*)(lds + br_a1 + 2048 * ti), acc, 0, 0, 0);
#pragma unroll
                for (int kk = 0; kk < 4; ++kk) {
                    const s16x4 lo = *(LAS s16x4*)(lds + br_qd + 16 * ti * HG_RP + 64 * kk), hi = *(LAS s16x4*)(lds + br_qd + 16 * ti * HG_RP + 64 * kk + 32);
                    const s16x8 bf = (s16x8){lo[0], lo[1], lo[2], lo[3], hi[0], hi[1], hi[2], hi[3]};
                    acc = __builtin_amdgcn_mfma_f32_16x16x32_bf16(sfrag[kk], bf, acc, 0, 0, 0); }
                const unsigned oo = (unsigned)hgrn_row(ch * 64 + 16 * ti + fr, b, dir) * 512u + (unsigned)(h * 128 + 16 * wave + 4 * fq);
                *(u32x2*)(O + oo) = (u32x2){pk2(acc[0], acc[1]), pk2(acc[2], acc[3])};
            }
        }
#pragma unroll
        for (int m = 0; m < 8; ++m) {
            const f32x4 dc = *(LAS f32x4*)(DEC + 16 * m + 4 * fq);
            S[m] = S[m] * dc;
            S[m] = __builtin_amdgcn_mfma_f32_16x16x32_bf16(*(LAS s16x8*)(lds + br_k0 + 2048 * m), vf0, S[m], 0, 0, 0);
            S[m] = __builtin_amdgcn_mfma_f32_16x16x32_bf16(*(LAS s16x8*)(lds + br_k1 + 2048 * m), vf1, S[m], 0, 0, 0);
        }
    }
    if (!FULL) {
        float* U = USTATE + (size_t)(item * 3 + seg) * 16384;
#pragma unroll
        for (int m = 0; m < 8; ++m)
#pragma unroll
            for (int j = 0; j < 4; ++j) U[(16 * m + 4 * fq + j) * 128 + 16 * wave + fr] = S[m][j];
        if (wave == 0) *(f32x2*)(DLOG + (size_t)(item * 3 + seg) * 128 + 2 * kp) = (f32x2){dl0, dl1};
    }
    __syncthreads();
}

__device__ __forceinline__ void fft1_phase(const Params& p, LAS unsigned char* lds, int first_item, int item_stride) {
    LAS float* ctab = (LAS float*)lds;
    LAS float* w16 = ctab + 4096;
    for (int i = threadIdx.x; i < 4096; i += NTHREADS) ctab[i] = cospif((float)i / 2048.0f);
    if (threadIdx.x < 16) { w16[threadIdx.x] = cospif((float)threadIdx.x / 8.0f); w16[16 + threadIdx.x] = sinpif((float)threadIdx.x / 8.0f); }
    __syncthreads();
    const h16* F = (const h16*)(p.ws + OFF_FTT); h16* Y1 = (h16*)(p.ws + OFF_Y1);
    const int ap = threadIdx.x & 127, gl = threadIdx.x >> 7;
    for (int item = first_item; item < 8 * 128; item += item_stride) {
        const int b = item >> 7, gk = (item & 127) * 4 + gl;
        float zr[16][2], zi[16][2];
        const h16* src = F + ((size_t)(b * 512 + gk) * 2) * 4096 + 2 * ap;
#pragma unroll
        for (int r = 0; r < 16; ++r) { const h16x2 c2 = *(const h16x2*)(src + 256 * r), s2 = *(const h16x2*)(src + 4096 + 256 * r);
            zr[r][0] = (float)c2[0]; zr[r][1] = (float)c2[1]; zi[r][0] = -(float)s2[0]; zi[r][1] = -(float)s2[1]; }
#pragma unroll 1
        for (int d = 0; d < 16; ++d) {
            float yr[2] = {0.f, 0.f}, yi[2] = {0.f, 0.f};
#pragma unroll
            for (int r = 0; r < 16; ++r) { const int m = (r * d) & 15; const float cs = w16[m], sn = w16[16 + m];
#pragma unroll
                for (int j = 0; j < 2; ++j) { yr[j] += zr[r][j] * cs + zi[r][j] * sn; yi[j] += zi[r][j] * cs - zr[r][j] * sn; } }
            float ore[2], oim[2];
#pragma unroll
            for (int j = 0; j < 2; ++j) { const int t = ((2 * ap + j) * d) & 4095; const float ct = ctab[t], st = ctab[(t - 1024) & 4095];
                ore[j] = (yr[j] * ct + yi[j] * st) * 0.0625f; oim[j] = (yi[j] * ct - yr[j] * st) * 0.0625f; }
            h16* dst = Y1 + ((size_t)((b * 16 + d) * 512 + gk)) * 512 + 2 * ap;
            *(unsigned*)dst = pk2(ore[0], ore[1]); *(unsigned*)(dst + 256) = pk2(oim[0], oim[1]);
        }
    }
    __syncthreads();
}

__device__ __forceinline__ void a1_prepass(const Params& p) {
    const int wave = threadIdx.x >> 6, lane = threadIdx.x & 63;
    const h16* OF = (const h16*)(p.ws + OFF_OF); const h16* OB = (const h16*)(p.ws + OFF_OB); h16* G = (h16*)(p.ws + OFF_G);
    const float* hgn = p.in[11];
    for (int t = blockIdx.x * 8 + wave; t < T; t += gridDim.x * 8) {
        const size_t off = (size_t)t * 512 + lane * 8;
        const h16x8 a = *(const h16x8*)(OF + off), bq = *(const h16x8*)(OB + off), g = *(const h16x8*)(G + off);
        float o[8]; float ss = 0.f;
#pragma unroll
        for (int j = 0; j < 8; ++j) { o[j] = (float)a[j] + (float)bq[j]; ss += o[j] * o[j]; }
        ss += __shfl_xor(ss, 1); ss += __shfl_xor(ss, 2); ss += __shfl_xor(ss, 4); ss += __shfl_xor(ss, 8);
        const float rstd = rsqrtf(ss * (1.0f / 128.0f) + EPS);
        float r[8];
#pragma unroll
        for (int j = 0; j < 8; ++j) r[j] = o[j] * rstd * hgn[lane * 8 + j] * (float)g[j];
        u32x4 w; w.x = pk2(r[0], r[1]); w.y = pk2(r[2], r[3]); w.z = pk2(r[4], r[5]); w.w = pk2(r[6], r[7]);
        *(u32x4*)(G + off) = w;
    }
}

__device__ __forceinline__ void convert_tables(const Params& p) {
    const int wave = threadIdx.x >> 6, lane = threadIdx.x & 63;
    for (int r2 = blockIdx.x * 8 + wave; r2 < 2 * 16384; r2 += gridDim.x * 8) {
        const int tb = r2 >> 14, e = r2 & 16383;
        const float* src = (tb ? p.in[18] : p.in[17]) + (size_t)e * D + lane * 16;
        f32x4 v[4]; float amax = 0.f;
#pragma unroll
        for (int j = 0; j < 4; ++j) { v[j] = *(const f32x4*)(src + 4 * j); amax = fmaxf(amax, fmaxf(fmaxf(fabsf(v[j].x), fabsf(v[j].y)), fmaxf(fabsf(v[j].z), fabsf(v[j].w)))); }
#pragma unroll
        for (int o = 32; o >= 1; o >>= 1) amax = fmaxf(amax, __shfl_xor(amax, o));
        const float qs = amax > 0.f ? amax * (1.0f / 127.0f) : 1.0f, inv = 1.0f / qs;
        const int bias = 0;
        u32x4 w;
#pragma unroll
        for (int j = 0; j < 4; ++j) { const int q0 = (int)rintf(v[j].x * inv) + bias, q1 = (int)rintf(v[j].y * inv) + bias, q2 = (int)rintf(v[j].z * inv) + bias, q3 = (int)rintf(v[j].w * inv) + bias;
            w[j] = (unsigned)(q0 & 255) | ((unsigned)(q1 & 255) << 8) | ((unsigned)(q2 & 255) << 16) | ((unsigned)(q3 & 255) << 24); }
        unsigned char* dst = p.ws + (tb ? OFF_TV : OFF_TU);
        *(u32x4*)(dst + ((size_t)(lane >> 3) * 16384 + e) * 128 + (lane & 7) * 16) = w;
        if (lane == 0) ((float*)(p.ws + (tb ? OFF_SV : OFF_SU)))[e] = qs;
    }
}

__device__ __forceinline__ unsigned f2key(float x) { const unsigned b = __builtin_bit_cast(unsigned, x); return b ^ ((b >> 31) ? 0xFFFFFFFFu : 0x80000000u); }
__device__ __forceinline__ float key2f(unsigned u) { const unsigned b = (u & 0x80000000u) ? (u ^ 0x80000000u) : ~u; return __builtin_bit_cast(float, b); }
__device__ __forceinline__ unsigned umax3(unsigned a, unsigned b, unsigned c) { return max(max(a, b), c); }
#define CE_DESC(a, b) do { const unsigned hi_ = max(a, b), lo_ = min(a, b); a = hi_; b = lo_; } while (0)
template <int N> __device__ __forceinline__ void sort16_desc(unsigned (&k)[N], const int base) {
#pragma unroll
    for (int size = 2; size <= 16; size *= 2)
#pragma unroll
        for (int stride = size / 2; stride > 0; stride /= 2)
#pragma unroll
            for (int i = 0; i < 16; ++i) { const int j = i ^ stride;
                if (j > i) { if ((i & size) == 0 || size == 16) CE_DESC(k[base + i], k[base + j]); else CE_DESC(k[base + j], k[base + i]); } }
}
template <int N> __device__ __forceinline__ void merge16_desc(unsigned (&k)[N], const int a, const int b) {
#pragma unroll
    for (int i = 0; i < 16; ++i) k[a + i] = max(k[a + i], k[b + 15 - i]);
#pragma unroll
    for (int stride = 8; stride > 0; stride /= 2)
#pragma unroll
        for (int i = 0; i < 16; ++i) if ((i & stride) == 0) CE_DESC(k[a + i], k[a + i + stride]);
}
__device__ __forceinline__ void top16_of_128(const float* sc, unsigned (&out)[16]) {
    unsigned s[128];
#pragma unroll
    for (int i = 0; i < 32; ++i) { const f32x4 t = *(const f32x4*)(sc + i * 4);
#pragma unroll
        for (int j = 0; j < 4; ++j) s[4 * i + j] = (f2key(t[j]) & ~127u) | (unsigned)(127 - (4 * i + j)); }
#pragma unroll
    for (int g = 0; g < 8; ++g) sort16_desc(s, 16 * g);
    merge16_desc(s, 0, 16); merge16_desc(s, 32, 48); merge16_desc(s, 64, 80); merge16_desc(s, 96, 112);
    merge16_desc(s, 0, 32); merge16_desc(s, 64, 96);
    merge16_desc(s, 0, 64);
#pragma unroll
    for (int i = 0; i < 16; ++i) out[i] = s[i];
}
__device__ __forceinline__ void topk_phase(const Params& p, LAS unsigned char* lds) {
    const float* SC = (const float*)(p.ws + OFF_SC); int* EIDX = (int*)(p.ws + OFF_EIDX); float* GATE = (float*)(p.ws + OFF_GATE);
    LAS unsigned* st = (LAS unsigned*)lds;
    const int tid = threadIdx.x;
#ifndef TOPK_REP
#define TOPK_REP 1
#endif
    for (int rr_ = 0; rr_ < TOPK_REP; ++rr_)
    for (int base = blockIdx.x * 256; base < T * 8; base += gridDim.x * 256) {
        {
            unsigned ks[16];
#pragma unroll
            for (int i = 0; i < 16; ++i) ks[i] = 0u;
            top16_of_128(SC + ((size_t)base * 2 + tid) * 128, ks);
#pragma unroll
            for (int i = 0; i < 16; ++i) st[i * NTHREADS + tid] = ks[i];
        }
        __syncthreads();
        if (tid < 256) {
            const int th = base + tid;
            float sv1[16];
#pragma unroll
            for (int j = 0; j < 16; ++j) sv1[j] = key2f(st[j * NTHREADS + 2 * tid + 1] & ~127u);
            unsigned cv[50];
            { int c = 0;
#pragma unroll
              for (int i = 0; i < 16; ++i) { const float a = key2f(st[i * NTHREADS + 2 * tid] & ~127u);
#pragma unroll
                  for (int j = 0; j < 16; ++j) if ((i + 1) * (j + 1) <= 16) { cv[c] = (f2key(a + sv1[j]) & ~255u) | (unsigned)(255 - (i * 16 + j)); ++c; } } }
            unsigned c64[64];
#pragma unroll
            for (int i = 0; i < 64; ++i) c64[i] = (i < 50) ? cv[i] : 0u;
#pragma unroll
            for (int g = 0; g < 4; ++g) sort16_desc(c64, 16 * g);
            merge16_desc(c64, 0, 16); merge16_desc(c64, 32, 48); merge16_desc(c64, 0, 32);
            unsigned ok[16];
#pragma unroll
            for (int i = 0; i < 16; ++i) ok[i] = c64[i];
            float ex[16]; int oe[16]; float den = 0.f;
            const float v0 = key2f(ok[0] & ~255u);
#pragma unroll
            for (int i = 0; i < 16; ++i) { const int ij = 255 - (int)(ok[i] & 255u), ci = ij >> 4, cj = ij & 15;
                const int e0 = 127 - (int)(st[ci * NTHREADS + 2 * tid] & 127u), e1 = 127 - (int)(st[cj * NTHREADS + 2 * tid + 1] & 127u);
                oe[i] = e0 * 128 + e1; ex[i] = __expf(key2f(ok[i] & ~255u) - v0); den += ex[i]; }
            const float inv = 1.0f / den;
#pragma unroll
            for (int i = 0; i < 4; ++i) {
                *(f32x4*)(GATE + (size_t)th * 16 + 4 * i) = (f32x4){ex[4 * i] * inv, ex[4 * i + 1] * inv, ex[4 * i + 2] * inv, ex[4 * i + 3] * inv};
                *(int4*)(EIDX + (size_t)th * 16 + 4 * i) = make_int4(oe[4 * i], oe[4 * i + 1], oe[4 * i + 2], oe[4 * i + 3]); }
        }
        __syncthreads();
    }
}

struct XcdInfo { int px, npop, rank, nloc; };
__device__ __forceinline__ float dot8(const h16x8 a, const h16x8 b, float s) {
    s = __builtin_amdgcn_fdot2((h16x2){a[0], a[1]}, (h16x2){b[0], b[1]}, s, false); s = __builtin_amdgcn_fdot2((h16x2){a[2], a[3]}, (h16x2){b[2], b[3]}, s, false);
    s = __builtin_amdgcn_fdot2((h16x2){a[4], a[5]}, (h16x2){b[4], b[5]}, s, false); s = __builtin_amdgcn_fdot2((h16x2){a[6], a[7]}, (h16x2){b[6], b[7]}, s, false); return s; }
struct PeerTok { int t; bool ok; };
#define PEER_TOUCH(R) do { unsigned tt_ = (R).w; asm volatile("" : "+v"(tt_)); (R).w = tt_; __builtin_amdgcn_sched_barrier(0); } while (0)
__device__ __forceinline__ PeerTok peer_tok(int i, int t0, int step) { const int t = t0 + i * step; PeerTok r; r.ok = t < T; r.t = r.ok ? t : (T - 1); return r; }
__device__ __forceinline__ void peer_ld_e(const int* EIDX, int t, int g, int (&e)[16]) {
#pragma unroll
    for (int q = 0; q < 4; ++q) { const int4 v = *(const int4*)(EIDX + (size_t)t * 128 + 16 * g + 4 * q); e[4 * q] = v.x; e[4 * q + 1] = v.y; e[4 * q + 2] = v.z; e[4 * q + 3] = v.w; } }
__device__ __forceinline__ void peer_ld_rows(const unsigned char* tab, const int (&e)[16], u32x4 (&r)[16]) {
#pragma unroll
    for (int j = 0; j < 16; ++j) r[j] = *(const u32x4*)(tab + (size_t)e[j] * 128); }
__device__ __forceinline__ void peer_u_compute(const u32x4 (&r)[16], const u32x4 xv, float* PACT, int s, PeerTok tk, int lane, int g, int c) {
    float pj[16];
#pragma unroll
    for (int j = 0; j < 16; ++j) { int d = __builtin_amdgcn_sdot4((int)r[j].x, (int)xv.x, 0, false); d = __builtin_amdgcn_sdot4((int)r[j].y, (int)xv.y, d, false);
        d = __builtin_amdgcn_sdot4((int)r[j].z, (int)xv.z, d, false); d = __builtin_amdgcn_sdot4((int)r[j].w, (int)xv.w, d, false); pj[j] = (float)d; }
#define RED_STEP(NIN, MASK) _Pragma("unroll") for (int j = 0; j < (NIN) / 2; ++j) { const bool up = (lane & (MASK)) != 0; \
    const float keep = up ? pj[2 * j + 1] : pj[2 * j], send = up ? pj[2 * j] : pj[2 * j + 1]; pj[j] = keep + __shfl_xor(send, (MASK)); }
    RED_STEP(16, 1) RED_STEP(8, 2) RED_STEP(4, 4)
#undef RED_STEP
    if (tk.ok) { float* po = PACT + ((size_t)s * T + tk.t) * 128 + 16 * g + c; po[0] = pj[0]; po[8] = pj[1]; }
}
__device__ __forceinline__ void peer_u_phase(const Params& p, const XcdInfo xi) {
    const int wave = threadIdx.x >> 6, lane = threadIdx.x & 63, g = lane >> 3, c = lane & 7;
    const unsigned char* QX = (const unsigned char*)(p.ws + OFF_QX); const unsigned char* TU = (const unsigned char*)(p.ws + OFF_TU);
    const int* EIDX = (const int*)(p.ws + OFF_EIDX); float* PACT = (float*)(p.ws + OFF_PACT);
    const int t0 = xi.rank * 8 + wave, step = xi.nloc * 8, ntok = (T - t0 + step - 1) / step;
    for (int s = xi.px; s < 8; s += xi.npop) {
        const unsigned char* tus = TU + (size_t)s * 16384 * 128 + 16 * c; const unsigned char* qxs = QX + s * 128 + 16 * c;
        int eN[16]; u32x4 rA[16], rB[16]; u32x4 xA, xB;
        { PeerTok k0 = peer_tok(0, t0, step); peer_ld_e(EIDX, k0.t, g, eN); xA = *(const u32x4*)(qxs + (size_t)k0.t * D); peer_ld_rows(tus, eN, rA);
          PeerTok k1 = peer_tok(1, t0, step); peer_ld_e(EIDX, k1.t, g, eN); }
        for (int i = 0; i < ntok; i += 2) {
            { const PeerTok k1 = peer_tok(i + 1, t0, step), k2 = peer_tok(i + 2, t0, step);
              PEER_TOUCH(rA[15]);
              xB = *(const u32x4*)(qxs + (size_t)k1.t * D); peer_ld_rows(tus, eN, rB); peer_ld_e(EIDX, k2.t, g, eN);
              __builtin_amdgcn_sched_barrier(0);
              peer_u_compute(rA, xA, PACT, s, peer_tok(i, t0, step), lane, g, c);
              __builtin_amdgcn_sched_barrier(0); }
            { const PeerTok k2 = peer_tok(i + 2, t0, step), k3 = peer_tok(i + 3, t0, step);
              PEER_TOUCH(rB[15]);
              xA = *(const u32x4*)(qxs + (size_t)k2.t * D); peer_ld_rows(tus, eN, rA); peer_ld_e(EIDX, k3.t, g, eN);
              __builtin_amdgcn_sched_barrier(0);
              PeerTok k1 = peer_tok(i + 1, t0, step); k1.ok = k1.ok && (i + 1 < ntok);
              peer_u_compute(rB, xB, PACT, s, k1, lane, g, c);
              __builtin_amdgcn_sched_barrier(0); }
        }
    }
}
__device__ __forceinline__ void peer_combine(const Params& p) {
    const int wave = threadIdx.x >> 6, lane = threadIdx.x & 63;
    const float* PACT = (const float*)(p.ws + OFF_PACT); const float* GATE = (const float*)(p.ws + OFF_GATE); unsigned char* SIDE = p.ws + OFF_SIDE;
    const int* EIDX = (const int*)(p.ws + OFF_EIDX); const float* SU = (const float*)(p.ws + OFF_SU); const float* SV = (const float*)(p.ws + OFF_SV); const float* SX = (const float*)(p.ws + OFF_SX);
    for (int t = blockIdx.x * 8 + wave; t < T; t += gridDim.x * 8) {
        const float sx = SX[t]; float w[2]; int e[2]; float amax = 0.f;
#pragma unroll
        for (int j = 0; j < 2; ++j) { const int k = lane + 64 * j; float a = 0.f;
#pragma unroll
            for (int s = 0; s < 8; ++s) a += PACT[((size_t)s * T + t) * 128 + k];
            e[j] = EIDX[(size_t)t * 128 + k];
            const float act = a * sx * SU[e[j]];
            w[j] = GATE[(size_t)t * 128 + k] * (0.5f * act * (1.0f + erff(act * 0.70710678118654752f))) * SV[e[j]];
            amax = fmaxf(amax, fabsf(w[j])); }
#pragma unroll
        for (int o = 32; o >= 1; o >>= 1) amax = fmaxf(amax, __shfl_xor(amax, o));
        const float inv = amax > 0.f ? 16256.0f / amax : 0.f;
        unsigned char* rec = SIDE + (size_t)t * 1024;
#pragma unroll
        for (int j = 0; j < 2; ++j) { const int k = lane + 64 * j; const int W = (int)rintf(w[j] * inv); const int hi = W >> 7, lo = W & 127;
            const int y = k >> 4, ks = (k >> 3) & 1, h = (k >> 2) & 1, gk = k & 3, off = 512 + ks * 128 + gk * 16 + 8 * h + y;
            ((int*)rec)[k] = e[j]; rec[off] = (unsigned char)(hi & 255); rec[off + 64] = (unsigned char)lo; }
        if (lane == 0) *(float*)(rec + 768) = amax * (1.0f / 16256.0f);
    }
}
typedef int i32x4 __attribute__((ext_vector_type(4)));
__device__ __forceinline__ unsigned lds_addr(const volatile LAS void* p) { return (unsigned)(size_t)p; }
__device__ __forceinline__ void glds16_asm(const void* gsrc, unsigned lds_dst) {
    unsigned keep;
    asm volatile("s_mov_b32 %0, m0\n\ts_mov_b32 m0, %2\n\ts_nop 0\n\tglobal_load_lds_dwordx4 %1, off\n\ts_mov_b32 m0, %0" : "=&s"(keep) : "v"(gsrc), "s"(lds_dst) : "memory");
}
#define PV_WAIT_VM(n) asm volatile("s_waitcnt vmcnt(" #n ")" ::: "memory")
__device__ __forceinline__ void pv_fill(const unsigned char* tvs, LAS unsigned char* lds, unsigned side_slot, unsigned ring_buf, const int ks, int lane) {
    const int g = lane >> 3;
    const u32x4 i0 = *(LAS u32x4*)(lds + side_slot + (16 * g + 8 * ks) * 4), i1 = *(LAS u32x4*)(lds + side_slot + (16 * g + 8 * ks + 4) * 4);
    const unsigned ids[8] = {i0.x, i0.y, i0.z, i0.w, i1.x, i1.y, i1.z, i1.w};
#pragma unroll
    for (int m = 0; m < 8; ++m) glds16_asm(tvs + (size_t)ids[m] * 128 + ((((lane & 7) ^ g ^ (m & 1))) << 4), ring_buf + m * 1024);
}
__device__ __forceinline__ void pv_kstep(LAS unsigned char* lds, unsigned ring_buf, const i32x4 afrag, i32x4 (&acc)[8], int lane) {
    const int gk = lane >> 4, q = (lane & 15) >> 1, pp = lane & 1;
    const unsigned base0 = ring_buf + (8 * gk + q) * 128 + 8 * pp;
    const int xr = q ^ (gk & 1);
#pragma unroll
    for (int ng = 0; ng < 2; ++ng) {
        u32x2 r[8];
#pragma unroll
        for (int j = 0; j < 4; ++j) { const int n = 4 * ng + j;
#pragma unroll
            for (int h = 0; h < 2; ++h) { const unsigned a = base0 + h * 4096 + (((unsigned)(n ^ xr)) << 4);
                asm volatile("ds_read_b64_tr_b8 %0, %1" : "=v"(r[2 * j + h]) : "v"(a) : "memory"); } }
        asm volatile("s_waitcnt lgkmcnt(0)" : "+v"(r[0]), "+v"(r[1]), "+v"(r[2]), "+v"(r[3]), "+v"(r[4]), "+v"(r[5]), "+v"(r[6]), "+v"(r[7]) :: "memory");
        __builtin_amdgcn_sched_barrier(0);
#pragma unroll
        for (int j = 0; j < 4; ++j) { const i32x4 bf = (i32x4){(int)r[2 * j].x, (int)r[2 * j].y, (int)r[2 * j + 1].x, (int)r[2 * j + 1].y};
            acc[4 * ng + j] = __builtin_amdgcn_mfma_i32_16x16x64_i8(afrag, bf, acc[4 * ng + j], 0, 0, 0); }
    }
}
__device__ __forceinline__ void peer_v_phase(const Params& p, LAS unsigned char* lds, const XcdInfo xi) {
    const int wave = __builtin_amdgcn_readfirstlane(threadIdx.x >> 6), lane = threadIdx.x & 63;
    const unsigned char* TV = p.ws + OFF_TV; const unsigned char* SIDE = p.ws + OFF_SIDE; float* PO = (float*)(p.ws + OFF_PO);
    const int t0 = xi.rank * 8 + wave, step = xi.nloc * 8, ntok = (T - t0 + step - 1) / step;
    const unsigned ring = __builtin_amdgcn_readfirstlane(lds_addr(lds + wave * 16384)), side = __builtin_amdgcn_readfirstlane(lds_addr(lds + 131072 + wave * 3072));
    LAS unsigned char* l0 = (LAS unsigned char*)0;
    for (int s = xi.px; s < 8; s += xi.npop) {
        const unsigned char* tvs = TV + (size_t)s * 16384 * 128;
        glds16_asm(SIDE + (size_t)peer_tok(0, t0, step).t * 1024 + lane * 16, side);
        glds16_asm(SIDE + (size_t)peer_tok(1, t0, step).t * 1024 + lane * 16, side + 1024);
        PV_WAIT_VM(0);
        pv_fill(tvs, l0, side, ring, 0, lane); pv_fill(tvs, l0, side, ring + 8192, 1, lane);
        for (int i = 0; i < ntok; ++i) {
            const unsigned sl_cur = side + (unsigned)(i % 3) * 1024, sl_nxt = side + (unsigned)((i + 1) % 3) * 1024, sl_nn = side + (unsigned)((i + 2) % 3) * 1024;
            i32x4 acc[8];
#pragma unroll
            for (int n = 0; n < 8; ++n) acc[n] = (i32x4){0, 0, 0, 0};
            if (i == 0) PV_WAIT_VM(8); else PV_WAIT_VM(16);
            const int fi = lane & 15;
            const i32x4 z4 = (i32x4){0, 0, 0, 0};
            i32x4 af = *(LAS i32x4*)(l0 + sl_cur + 512 + (fi < 2 ? fi : 0) * 64 + (lane >> 4) * 16); af = fi < 2 ? af : z4;
            pv_kstep(l0, ring, af, acc, lane);
            glds16_asm(SIDE + (size_t)peer_tok(i + 2, t0, step).t * 1024 + lane * 16, sl_nn);
            pv_fill(tvs, l0, sl_nxt, ring, 0, lane);
            PV_WAIT_VM(9);
            af = *(LAS i32x4*)(l0 + sl_cur + 512 + 128 + (fi < 2 ? fi : 0) * 64 + (lane >> 4) * 16); af = fi < 2 ? af : z4;
            pv_kstep(l0, ring + 8192, af, acc, lane);
            const float sw = *(LAS float*)(l0 + sl_cur + 768);
            const PeerTok tk = peer_tok(i, t0, step);
            float* po = PO + (size_t)(tk.ok ? tk.t : T) * D + s * 128 + (lane & 15);
            if (lane < 16) {
#pragma unroll
                for (int n = 0; n < 8; ++n) { const float v = (float)(128 * acc[n][0] + acc[n][1]) * sw;
                    asm volatile("global_store_dword %0, %1, off" :: "v"(po + 16 * n), "v"(v) : "memory"); }
            }
            pv_fill(tvs, l0, sl_nxt, ring + 8192, 1, lane);
        }
        PV_WAIT_VM(0);
    }
}
__device__ __forceinline__ void peer_final(const Params& p) {
    const int wave = threadIdx.x >> 6, lane = threadIdx.x & 63;
    float* OUT = p.out; const float* PO = (const float*)(p.ws + OFF_PO); const float* mod = (const float*)(p.ws + OFF_MOD); const float* fg = p.in[19];
    for (int t = blockIdx.x * 8 + wave; t < T; t += gridDim.x * 8) {
        f32x4 h2[4]; float ss = 0.f;
#pragma unroll
        for (int j = 0; j < 4; ++j) { const int cc = j * 256 + lane * 4;
            const f32x4 hv = *(const f32x4*)(OUT + (size_t)t * D + cc), pv = *(const f32x4*)(PO + (size_t)t * D + cc), gv = *(const f32x4*)(mod + (t >> 12) * 6144 + 5120 + cc);
            h2[j] = hv + gv * pv; ss += h2[j].x * h2[j].x + h2[j].y * h2[j].y + h2[j].z * h2[j].z + h2[j].w * h2[j].w; }
        ss = wave_sum(ss);
        const float rstd = rsqrtf(ss * (1.0f / D) + EPS);
#pragma unroll
        for (int j = 0; j < 4; ++j) { const int cc = j * 256 + lane * 4; const f32x4 fv = *(const f32x4*)(fg + cc);
            *(f32x4*)(OUT + (size_t)t * D + cc) = h2[j] * rstd * fv; }
    }
}
#ifndef REP_A
#define REP_A 1
#endif
#ifndef REP_FT
#define REP_FT 1
#endif
#ifndef REP_DFT
#define REP_DFT 1
#endif
#ifndef REP_GATE
#define REP_GATE 1
#endif
constexpr int N_PHASES = 15;
#ifndef MK_CGSYNC
#define MK_CGSYNC 0
#endif
__device__ __forceinline__ Params load_params(volatile LAS unsigned* pw) {
    Params q;
    unsigned long long v[22];
#pragma unroll
    for (int i = 0; i < 22; ++i) { const unsigned lo = (unsigned)__builtin_amdgcn_readfirstlane((int)pw[2 * i]), hi = (unsigned)__builtin_amdgcn_readfirstlane((int)pw[2 * i + 1]); v[i] = ((unsigned long long)hi << 32) | lo; }
#pragma unroll
    for (int i = 0; i < 20; ++i) q.in[i] = (const float*)v[i];
    q.out = (float*)v[20]; q.ws = (unsigned char*)v[21];
    q.ph_lo = __builtin_amdgcn_readfirstlane((int)pw[44]); q.ph_hi = __builtin_amdgcn_readfirstlane((int)pw[45]);
    return q;
}
__global__ void __launch_bounds__(NTHREADS, 2) mega(Params pk) {
    extern __shared__ __attribute__((aligned(16))) unsigned char smem[];
    LAS unsigned char* lds = (LAS unsigned char*)smem;
    const int G = gridDim.x, c = blockIdx.x;
    volatile LAS unsigned* pw = (volatile LAS unsigned*)(lds + LDS_BYTES - 512);
    if (threadIdx.x == 0) {
#pragma unroll
        for (int i = 0; i < 20; ++i) { const unsigned long long v = (unsigned long long)pk.in[i]; pw[2 * i] = (unsigned)v; pw[2 * i + 1] = (unsigned)(v >> 32); }
        { const unsigned long long v = (unsigned long long)pk.out; pw[40] = (unsigned)v; pw[41] = (unsigned)(v >> 32); }
        { const unsigned long long v = (unsigned long long)pk.ws; pw[42] = (unsigned)v; pw[43] = (unsigned)(v >> 32); }
        pw[44] = (unsigned)pk.ph_lo; pw[45] = (unsigned)pk.ph_hi;
    }
    unsigned* ctl = (unsigned*)(pk.ws + OFF_CTL);
    volatile LAS unsigned* misc = (volatile LAS unsigned*)(lds + LDS_BYTES - 64);
    if (threadIdx.x < 16) misc[threadIdx.x] = 0u;
    __syncthreads();
    const bool fused = (pk.ph_hi - pk.ph_lo) > 1;
    XcdBarrier bar; bar.bar = ctl; bar.x = 0; bar.st = misc;
    if (fused) {
        bar = xcd_barrier_post(ctl, misc);
        if (threadIdx.x == 0) misc[2] = xb_add(&ctl[CTL_RANK + 64 * bar.x], 1u);
    }
#define IN(k) (ph_lo <= (k) && (k) < ph_hi)
#if MK_CGSYNC
#define SEAM(k) do { if (IN(k) && IN((k) + 1)) { cg::grid_group grid = cg::this_grid(); grid.sync(); } } while (0)
#else
#define SEAM(k) do { if (IN(k) && IN((k) + 1)) xcd_barrier(bar); } while (0)
#endif
#define PHASE_BEGIN(k) if (IN(k)) { const Params p = load_params(pw); unsigned char* const ws = p.ws; (void)ws;
#define PHASE_END(k) } SEAM(k);
    const int ph_lo = pk.ph_lo, ph_hi = pk.ph_hi;
    PHASE_BEGIN(0) phase0(p, lds); PHASE_END(0)
    PHASE_BEGIN(1)
        const float* mod = (const float*)(ws + OFF_MOD);
        modulate_rows(p.in[0], (h16*)(ws + OFF_UALL), T, p.in[6], mod, 0, 1024, 0);
        modulate_rows(p.in[2], (h16*)(ws + OFF_UALL) + (size_t)T * D, TC, p.in[6], mod, 0, 1024, 1);
    PHASE_END(1)
    PHASE_BEGIN(2)
        { pg8::Gemm g{ws + OFF_UALL, ws + OFF_WA, 1024, 1024, 1024}; OrderA S; S.init(G, c, REP_A); EpiA E{ws}; pg8::gemm_phase(lds, g, S, E); }
        { pg8::Gemm g{ws + OFF_UALL, ws + OFF_WF, 1024, 1024, 1024}; pg8::TileOrder S; S.init(128, 4, G, c, REP_FT); EpiFT E{ws}; pg8::gemm_phase(lds, g, S, E); }
    PHASE_END(2)
    PHASE_BEGIN(3) for (int it = blockIdx.x; it < 192; it += gridDim.x) hgrn_mfma_unit<false>(p, lds, it / 3, it % 3);
        fft1_phase(p, lds, (int)((blockIdx.x + 64u) % gridDim.x), gridDim.x); convert_tables(p); PHASE_END(3)
    PHASE_BEGIN(4) for (int it = blockIdx.x; it < 256; it += gridDim.x) hgrn_mfma_unit<true>(p, lds, it >> 2, it & 3); PHASE_END(4)
    PHASE_BEGIN(5)
        { pg8::Gemm g{ws + OFF_DFT256, ws + OFF_Y1, 512, 512, 512}; pg8::TileOrder S; S.init(1, 256, G, c, REP_DFT); EpiDFT E{ws}; pg8::gemm_phase(lds, g, S, E); }
        { pg8::Gemm g{ws + OFF_UALL, ws + OFF_WG, 1024, 1024, 1024}; pg8::TileOrder S; S.init(128, 8, G, c, REP_GATE); EpiGate E{ws}; pg8::gemm_phase(lds, g, S, E); }
        a1_prepass(p);
    PHASE_END(5)
    PHASE_BEGIN(6)
        { pg8::Gemm g{ws + OFF_G, ws + OFF_WHG, 512, 512, 512}; pg8::TileOrder S; S.init(128, 4, G, c); EpiMerge1<false> E{ws}; pg8::gemm_phase(lds, g, S, E); }
        { pg8::Gemm g{ws + OFF_YFT, ws + OFF_WFT, 512, 512, 512}; pg8::TileOrder S; S.init(128, 4, G, c); EpiMerge1<true> E{ws}; pg8::gemm_phase(lds, g, S, E); }
    PHASE_END(6)
    PHASE_BEGIN(7)
        pg8::Gemm g{ws + OFF_Y, ws + OFF_WOUT, 1024, 1024, 1024}; pg8::TileOrder S; S.init(128, 4, G, c);
        EpiMerge2 E{p.in[0], p.out, (const float*)(ws + OFF_MOD)}; pg8::gemm_phase(lds, g, S, E);
    PHASE_END(7)
    PHASE_BEGIN(8) modulate_rows(p.out, (h16*)(ws + OFF_U2), T, p.in[7], (const float*)(ws + OFF_MOD), 3072, 4096, 0, (signed char*)(ws + OFF_QX), (float*)(ws + OFF_SX)); PHASE_END(8)
    PHASE_BEGIN(9)
        pg8::Gemm g{ws + OFF_U2, ws + OFF_WS, 1024, 1024, 1024}; pg8::TileOrder S; S.init(128, 8, G, c);
        EpiF32 E{(float*)(ws + OFF_SC), 2048}; pg8::gemm_phase(lds, g, S, E);
    PHASE_END(9)
    PHASE_BEGIN(10) topk_phase(p, lds); PHASE_END(10)
    XcdInfo xi;
    if (fused) {
        unsigned cnt[8]; int npop = 0, px = 0;
#pragma unroll
        for (int j = 0; j < 8; ++j) { cnt[j] = xb_ld(&ctl[CTL_RANK + 64 * j]); if (j < (int)(bar.x & 7u)) px += (cnt[j] > 0u); npop += (cnt[j] > 0u); }
        xi.px = px; xi.npop = npop > 0 ? npop : 1; xi.rank = (int)misc[2]; xi.nloc = (int)cnt[bar.x & 7u]; if (xi.nloc < 1) xi.nloc = 1;
    } else { xi.px = c & 7; xi.npop = 8; xi.rank = c >> 3; xi.nloc = G >> 3; }
    PHASE_BEGIN(11) peer_u_phase(p, xi); PHASE_END(11)
    PHASE_BEGIN(12) peer_combine(p); PHASE_END(12)
    PHASE_BEGIN(13) peer_v_phase(p, lds, xi); PHASE_END(13)
    PHASE_BEGIN(14) peer_final(p); }
#undef IN
#undef SEAM
#undef PHASE_BEGIN
#undef PHASE_END
}

#ifndef MK_SINGLE
#define MK_SINGLE 1
#endif
extern "C" void kernel_launch(void* const* d_in, const int* in_sizes, int n_in, void* d_out, int out_size, void* d_ws, size_t ws_size, hipStream_t stream) {
    static int grid = 0;
    if (grid == 0) {
        if (n_in != 20 || out_size != T * D || ws_size < WS_NEED) { fprintf(stderr, "kernel_launch: unexpected shapes (n_in %d out %d ws %zu)\n", n_in, out_size, ws_size); grid = -1; return; }
        int dev = 0, cus = 0, per_cu = 0;
        hipGetDevice(&dev); hipDeviceGetAttribute(&cus, hipDeviceAttributeMultiprocessorCount, dev);
        if (hipFuncSetAttribute((const void*)mega, hipFuncAttributeMaxDynamicSharedMemorySize, LDS_BYTES) != hipSuccess) { fprintf(stderr, "kernel_launch: hipFuncSetAttribute failed\n"); grid = -1; return; }
        hipOccupancyMaxActiveBlocksPerMultiprocessor(&per_cu, (const void*)mega, NTHREADS, LDS_BYTES);
        if (per_cu < 1) { fprintf(stderr, "kernel_launch: occupancy query says %d blocks per CU\n", per_cu); grid = -1; return; }
        grid = cus;
    }
    if (grid < 0) return;
    if (hipMemsetAsync((char*)d_ws + OFF_CTL, 0, CTL_ZERO_BYTES, stream) != hipSuccess) { fprintf(stderr, "kernel_launch: memset failed\n"); return; }
    Params p{};
    for (int i = 0; i < 20; ++i) p.in[i] = (const float*)d_in[i];
    p.out = (float*)d_out; p.ws = (unsigned char*)d_ws;
#if MK_SINGLE
    p.ph_lo = 0; p.ph_hi = N_PHASES;
    void* args[] = {&p};
    hipError_t e = hipLaunchCooperativeKernel((const void*)mega, dim3(grid), dim3(NTHREADS), args, LDS_BYTES, stream);
    if (e != hipSuccess) fprintf(stderr, "cooperative launch failed: %s (grid %d)\n", hipGetErrorString(e), grid);
#else
    for (int ph = 0; ph < N_PHASES; ++ph) { p.ph_lo = ph; p.ph_hi = ph + 1; hipLaunchKernelGGL(mega, dim3(grid), dim3(NTHREADS), LDS_BYTES, stream, p); }
#endif
}
```

```cpp
#include <hip/hip_runtime.h>
#include <hip/hip_cooperative_groups.h>
#include <cstdio>
#include <cstdint>
namespace cg = cooperative_groups;
#define LAS __attribute__((address_space(3)))
namespace pg8 {
#define PG8_LAS __attribute__((address_space(3)))
typedef _Float16 f16x8 __attribute__((ext_vector_type(8)));
typedef float f32x4 __attribute__((ext_vector_type(4)));
typedef unsigned u32x4 __attribute__((ext_vector_type(4)));
typedef unsigned u32x2 __attribute__((ext_vector_type(2)));
constexpr int BM = 256, BK = 64, HALF = 128, HTB = HALF * BK * 2, STAGE_BYTES = 8 * HTB, NXCD = 8, WGM = 8;

__host__ __device__ __forceinline__ int lds_byte(int r, int c) { const int st = (r >> 4) * 2 + (c >> 5), rr = r & 15, cc = c & 31, ob = rr * 64 + cc * 2; return st * 1024 + (ob ^ (((ob >> 9) & 1) << 5)); }
__host__ __device__ __forceinline__ void stage_rc(int b, int& R, int& C) { const int st = b / 1024, sb = b % 1024, swz = sb ^ (((sb >> 9) & 1) << 5); R = (st >> 1) * 16 + swz / 64; C = (st & 1) * 32 + (swz % 64) / 2; }
__host__ __device__ __forceinline__ int perm32(int rho) { const int n = rho >> 4, i = rho & 15; return 8 * (i >> 2) + 4 * n + (i & 3); }

struct Unit { int pm, pn; };
struct Gemm { const void* A; const void* Bt; int lda, ldb, K; };

struct TileOrder {
    int nM, nN, nwg, G, c, rep;
    __device__ void init(int nM_, int nN_, int G_, int c_, int rep_ = 1) { nM = nM_; nN = nN_; nwg = nM * nN; G = G_; c = c_; rep = rep_; }
    __device__ bool map(long L, Unit& u) const {
        if (L >= nwg) return false;
        int wgid = (int)L; { const int q = nwg / NXCD, r = nwg % NXCD, xcd = wgid % NXCD, off = wgid / NXCD; wgid = (xcd < r ? xcd * (q + 1) : r * (q + 1) + (xcd - r) * q) + off; }
        const int nig = WGM * nN, gid = wgid / nig, fm = gid * WGM, gsz = (nM - fm) < WGM ? (nM - fm) : WGM;
        u.pm = fm + ((wgid % nig) % gsz); u.pn = (wgid % nig) / gsz; return true;
    }
    __device__ bool next(int i, Unit& u) const { const long L = (long)i * G + c; if (L >= (long)nwg * rep) return false; return map(L % nwg, u); }
};

template <class Epi, class Sched>
__device__ __forceinline__ void gemm_phase(PG8_LAS unsigned char* lds, const Gemm g, const Sched& S, const Epi& E) {
    const int tid = threadIdx.x, wid = __builtin_amdgcn_readfirstlane(tid >> 6), lane = tid & 63, wr = wid >> 2, wc = wid & 3, fr = lane & 15, fq = lane >> 4;
    const int K = g.K, nt = K / BK;
    unsigned voffA[2], voffB[2];
#pragma unroll
    for (int i = 0; i < 2; ++i) { int R, C; stage_rc(tid * 16 + i * 8192, R, C); const int Rb = Epi::PERM ? ((R & ~31) + perm32(R & 31)) : R;
        voffA[i] = (unsigned)(R * g.lda + C) * 2u; voffB[i] = (unsigned)(Rb * g.ldb + C) * 2u; }
    const size_t kstep = (size_t)(BK * 2);
    const size_t hstepA = (size_t)HALF * g.lda * 2, hstepB = (size_t)HALF * g.ldb * 2;
    const size_t tstepA = 2 * hstepA, tstepB = 2 * hstepB;
    const unsigned ldsw = (unsigned)wid * 1024u;
    const int aoff = lds_byte(wr * 64 + fr, fq * 8), boff = lds_byte(wc * 32 + fr, fq * 8);
#define PG8_SA(b, h) (((b) * 2 + (h)) * HTB)
#define PG8_SB(b, h) ((4 + (b) * 2 + (h)) * HTB)
#define PG8_STAGE(bufoff, gbase, voff) do { _Pragma("unroll") for (int _i = 0; _i < 2; ++_i) \
        __builtin_amdgcn_global_load_lds((const unsigned*)((const char*)(gbase) + (voff)[_i]), (PG8_LAS unsigned*)(lds + (bufoff) + ldsw + _i * 8192), 16, 0, 0); } while (0)
#define PG8_LDA(dst, b, h) do { _Pragma("unroll") for (int m = 0; m < 4; ++m) _Pragma("unroll") for (int k = 0; k < 2; ++k) dst[m][k] = *(const PG8_LAS f16x8*)(lds + PG8_SA(b, h) + aoff + m * 2048 + k * 1024); } while (0)
#define PG8_LDB(dst, b, h) do { _Pragma("unroll") for (int n = 0; n < 2; ++n) _Pragma("unroll") for (int k = 0; k < 2; ++k) dst[n][k] = *(const PG8_LAS f16x8*)(lds + PG8_SB(b, h) + boff + n * 2048 + k * 1024); } while (0)
#define PG8_MMA(ai, bj, At, Bt) do { __builtin_amdgcn_s_setprio(1); _Pragma("unroll") for (int m = 0; m < 4; ++m) _Pragma("unroll") for (int n = 0; n < 2; ++n) _Pragma("unroll") for (int k = 0; k < 2; ++k) \
        acc[ai][bj][m][n] = Epi::TRANS ? __builtin_amdgcn_mfma_f32_16x16x32_f16(Bt[n][k], At[m][k], acc[ai][bj][m][n], 0, 0, 0) \
                                       : __builtin_amdgcn_mfma_f32_16x16x32_f16(At[m][k], Bt[n][k], acc[ai][bj][m][n], 0, 0, 0); __builtin_amdgcn_s_setprio(0); } while (0)
#define PG8_WAIT_V(n) asm volatile("s_waitcnt vmcnt(" #n ")" ::: "memory")
#define PG8_WAIT_L(n) asm volatile("s_waitcnt lgkmcnt(" #n ")" ::: "memory")
#define PG8_BAR __builtin_amdgcn_s_barrier()
#define PG8_SCHED __builtin_amdgcn_sched_barrier(0)
    Unit cur, nxt; int ui = 0;
    if (!S.next(0, cur)) return;
    f32x4 acc[2][2][4][2];
#pragma unroll
    for (int a = 0; a < 2; ++a)
#pragma unroll
        for (int b = 0; b < 2; ++b)
#pragma unroll
            for (int m = 0; m < 4; ++m)
#pragma unroll
                for (int n = 0; n < 2; ++n) acc[a][b][m][n] = (f32x4){0.f, 0.f, 0.f, 0.f};
    f16x8 At[4][2], B0[2][2], B1[2][2];
    const char* cA = (const char*)g.A + (size_t)cur.pm * tstepA; const char* cB = (const char*)g.Bt + (size_t)cur.pn * tstepB;
    PG8_STAGE(PG8_SB(0, 0), cB, voffB); PG8_STAGE(PG8_SA(0, 0), cA, voffA); PG8_STAGE(PG8_SB(0, 1), cB + hstepB, voffB); PG8_STAGE(PG8_SA(0, 1), cA + hstepA, voffA);
    if (wr == 1) PG8_BAR;
    PG8_WAIT_V(4); PG8_BAR;
    PG8_STAGE(PG8_SB(1, 0), cB + kstep, voffB); PG8_STAGE(PG8_SA(1, 0), cA + kstep, voffA); PG8_STAGE(PG8_SB(1, 1), cB + hstepB + kstep, voffB);
    PG8_WAIT_V(6); PG8_BAR;
    for (;;) {
        const bool has_next = S.next(ui + 1, nxt);
        const char* nA = has_next ? (const char*)g.A + (size_t)nxt.pm * tstepA : cA; const char* nB = has_next ? (const char*)g.Bt + (size_t)nxt.pn * tstepB : cB;
        for (int t = 0; t < nt; t += 2) {
            const bool last = (t == nt - 2);
            const char* a1 = cA + (size_t)(t + 1) * kstep;
            const char* a2 = last ? nA : cA + (size_t)(t + 2) * kstep; const char* b2 = last ? nB : cB + (size_t)(t + 2) * kstep;
            const char* a3 = a2 + kstep; const char* b3 = b2 + kstep;
            PG8_LDB(B0, 0, 0); PG8_SCHED; PG8_LDA(At, 0, 0); PG8_STAGE(PG8_SA(1, 1), a1 + hstepA, voffA);
            PG8_WAIT_L(8); PG8_BAR; PG8_WAIT_L(0); PG8_MMA(0, 0, At, B0); PG8_BAR; PG8_SCHED;
            PG8_LDB(B1, 0, 1); PG8_STAGE(PG8_SB(0, 0), b2, voffB);
            PG8_BAR; PG8_WAIT_L(0); PG8_MMA(0, 1, At, B1); PG8_BAR;
            PG8_LDA(At, 0, 1); PG8_STAGE(PG8_SA(0, 0), a2, voffA);
            PG8_BAR; PG8_WAIT_L(0); PG8_MMA(1, 0, At, B0); PG8_BAR; PG8_SCHED;
            PG8_STAGE(PG8_SB(0, 1), b2 + hstepB, voffB);
            PG8_WAIT_V(6); PG8_BAR; PG8_MMA(1, 1, At, B1); PG8_BAR;
            PG8_LDB(B0, 1, 0); PG8_SCHED; PG8_LDA(At, 1, 0); PG8_STAGE(PG8_SA(0, 1), a2 + hstepA, voffA);
            PG8_WAIT_L(8); PG8_BAR; PG8_WAIT_L(0); PG8_MMA(0, 0, At, B0); PG8_BAR; PG8_SCHED;
            PG8_LDB(B1, 1, 1); PG8_STAGE(PG8_SB(1, 0), b3, voffB);
            PG8_BAR; PG8_WAIT_L(0); PG8_MMA(0, 1, At, B1); PG8_BAR;
            PG8_LDA(At, 1, 1); PG8_STAGE(PG8_SA(1, 0), a3, voffA);
            PG8_BAR; PG8_WAIT_L(0); PG8_MMA(1, 0, At, B0); PG8_BAR; PG8_SCHED;
            PG8_STAGE(PG8_SB(1, 1), b3 + hstepB, voffB);
            PG8_WAIT_V(6); PG8_BAR; PG8_MMA(1, 1, At, B1); PG8_BAR;
        }
        E(acc, cur, wr, wc, fr, fq);
        if (!has_next) break;
#pragma unroll
        for (int a = 0; a < 2; ++a)
#pragma unroll
            for (int b = 0; b < 2; ++b)
#pragma unroll
                for (int m = 0; m < 4; ++m)
#pragma unroll
                    for (int n = 0; n < 2; ++n) acc[a][b][m][n] = (f32x4){0.f, 0.f, 0.f, 0.f};
        cur = nxt; cA = nA; cB = nB; ++ui;
    }
    PG8_WAIT_V(0);
    if (wr == 0) PG8_BAR;
    PG8_BAR;
#undef PG8_SA
#undef PG8_SB
#undef PG8_STAGE
#undef PG8_LDA
#undef PG8_LDB
#undef PG8_MMA
#undef PG8_WAIT_V
#undef PG8_WAIT_L
#undef PG8_BAR
#undef PG8_SCHED
}
}
#define XB_TMO      128
#define XB_XCNT(j)  (256  + 64 * (j))
#define XB_XSUB(j)  (1280 + 64 * (j))
#define XB_XGEN(j)  (2304 + 64 * (j))
#define XB_TOP      3328
#define XB_TOPGEN   3392
#define XCD_BAR_WORDS 3456
#define XB_SPIN_CAP (1u << 20)


__device__ __forceinline__ unsigned xb_ld(unsigned* p)              { return __hip_atomic_load(p, __ATOMIC_RELAXED, __HIP_MEMORY_SCOPE_AGENT); }
__device__ __forceinline__ unsigned xb_add(unsigned* p, unsigned v) { return __hip_atomic_fetch_add(p, v, __ATOMIC_RELAXED, __HIP_MEMORY_SCOPE_AGENT); }
__device__ __forceinline__ unsigned xb_xcc_id() { return (unsigned)__builtin_amdgcn_s_getreg((3 << 11) | 20) & 0xFu; }
#define XB_SPIN(cond, bar) do { unsigned _sp = 0; while (cond) { __builtin_amdgcn_s_sleep(1); \
    if ((++_sp & 255u) == 0u) { if (xb_ld(&(bar)[XB_TMO])) break; if (_sp > XB_SPIN_CAP) { atomicAdd(&(bar)[XB_TMO], 1u); break; } } } } while (0)

struct XcdBarrier {
    unsigned* bar; unsigned x;
    volatile LAS unsigned* st;
};

__device__ __forceinline__ XcdBarrier xcd_barrier_post(unsigned* bar, volatile LAS unsigned* st) {
    XcdBarrier b; b.bar = bar; b.x = xb_xcc_id(); b.st = st;
    if (threadIdx.x == 0) (void)xb_add(&bar[XB_XCNT(b.x)], 1u);
    return b;
}
__device__ __forceinline__ void xcd_barrier_complete(unsigned* bar, unsigned x, unsigned& nloc, unsigned& nx) {
    const unsigned G = gridDim.x * gridDim.y * gridDim.z;
    unsigned sum, cnt, mine, sp = 0u;
    for (;;) {
        sum = 0u; cnt = 0u; mine = 0u;
#pragma unroll
        for (unsigned j = 0; j < 16; ++j) { const unsigned c = xb_ld(&bar[XB_XCNT(j)]); sum += c; cnt += (c > 0u) ? 1u : 0u; mine = (j == x) ? c : mine; }
        if (sum == G) break;
        __builtin_amdgcn_s_sleep(1);
        if ((++sp & 255u) == 0u) { if (xb_ld(&bar[XB_TMO])) break; if (sp > XB_SPIN_CAP) { atomicAdd(&bar[XB_TMO], 1u); break; } }
    }
    nloc = mine > 0u ? mine : 1u; nx = cnt > 0u ? cnt : 1u;
}

__device__ __forceinline__ void xcd_barrier(const XcdBarrier& b) {
    asm volatile("s_waitcnt vmcnt(0)" ::: "memory");
    __syncthreads();
    if (threadIdx.x == 0) {
        unsigned* bar = b.bar;
        __builtin_amdgcn_s_waitcnt(0);
        unsigned nloc = b.st[0], nx = b.st[1];
        if (nloc == 0u) { xcd_barrier_complete(bar, b.x, nloc, nx); b.st[0] = nloc; b.st[1] = nx; }
        const unsigned old = xb_add(&bar[XB_XSUB(b.x)], 1u);
        const unsigned gen = old / nloc;
        if (old + 1u == (gen + 1u) * nloc) {
            __builtin_amdgcn_fence(__ATOMIC_RELEASE, "agent");
            asm volatile("s_waitcnt vmcnt(0)" ::: "memory");
            const unsigned og = xb_add(&bar[XB_TOP], 1u);
            const unsigned tg = og / nx;
            if (og + 1u == (tg + 1u) * nx) xb_add(&bar[XB_TOPGEN], 1u);
            else XB_SPIN(xb_ld(&bar[XB_TOPGEN]) == tg, bar);
            __builtin_amdgcn_fence(__ATOMIC_ACQUIRE, "agent");
            xb_add(&bar[XB_XGEN(b.x)], 1u);
            asm volatile("s_waitcnt vmcnt(0)" ::: "memory");
        } else {
            XB_SPIN(xb_ld(&bar[XB_XGEN(b.x)]) == gen, bar);
            __builtin_amdgcn_fence(__ATOMIC_ACQUIRE, "agent");
            asm volatile("s_waitcnt vmcnt(0)" ::: "memory");
        }
    }
    __syncthreads();
}

typedef _Float16 h16;
typedef h16 h16x2 __attribute__((ext_vector_type(2)));
typedef h16 h16x4 __attribute__((ext_vector_type(4)));
typedef h16 h16x8 __attribute__((ext_vector_type(8)));
typedef float f32x4 __attribute__((ext_vector_type(4)));
typedef float f32x2 __attribute__((ext_vector_type(2)));
typedef unsigned u32x4 __attribute__((ext_vector_type(4)));
typedef unsigned u32x2 __attribute__((ext_vector_type(2)));

constexpr int D = 1024, NB = 8, SEQ = 4096, T = NB * SEQ, LC = 256, TC = NB * LC, TALL = T + TC;
constexpr int NTHREADS = 512;
constexpr int LDS_BYTES = 156 * 1024;
constexpr float EPS = 1e-6f;
constexpr size_t MiB = (size_t)1 << 20;
constexpr size_t OFF_CTL = 0;
constexpr size_t OFF_MOD = 64 * 1024;
constexpr size_t OFF_LB = 320 * 1024;
constexpr size_t OFF_WA = 1 * MiB;
constexpr size_t OFF_WG = 6 * MiB;
constexpr size_t OFF_WF = 10 * MiB;
constexpr size_t OFF_WHG = 12 * MiB;
constexpr size_t OFF_WFT = 13 * MiB;
constexpr size_t OFF_WOUT = 14 * MiB;
constexpr size_t OFF_WS = 16 * MiB;
constexpr size_t OFF_UALL = 20 * MiB;
constexpr size_t OFF_OF = 88 * MiB;
constexpr size_t OFF_OB = 120 * MiB;
constexpr size_t OFF_FTT = 152 * MiB;
constexpr size_t OFF_Q = 216 * MiB;
constexpr size_t OFF_LF = 248 * MiB;
constexpr size_t OFF_LBK = 282 * MiB;
constexpr size_t OFF_V = 316 * MiB;
constexpr size_t OFF_G = 350 * MiB;
constexpr size_t OFF_Y1 = 382 * MiB;
constexpr size_t OFF_DFT256 = 512 * 1024;
constexpr size_t OFF_YFT = 446 * MiB;
constexpr size_t OFF_USTATE = 446 * MiB;
constexpr size_t OFF_DLOG = 460 * MiB;
constexpr size_t WS_NEED = 510 * MiB;
constexpr size_t OFF_GH = 216 * MiB;
constexpr size_t OFF_GF = 280 * MiB;
constexpr size_t OFF_Y = 152 * MiB;
constexpr size_t OFF_U2 = 20 * MiB;
constexpr size_t OFF_TU = 478 * MiB;
constexpr size_t OFF_TV = 494 * MiB;
constexpr size_t OFF_QX = 120 * MiB;
constexpr size_t OFF_SU = 768 * 1024;
constexpr size_t OFF_SV = 832 * 1024;
constexpr size_t OFF_SX = 205 * MiB;
constexpr size_t OFF_SC = 216 * MiB;
constexpr size_t OFF_EIDX = 152 * MiB;
constexpr size_t OFF_GATE = 168 * MiB;
constexpr size_t OFF_W = 184 * MiB;
constexpr size_t OFF_PSS = 200 * MiB;
constexpr size_t OFF_PACT = 216 * MiB;
constexpr size_t OFF_PO = 216 * MiB;
constexpr size_t OFF_SIDE = 88 * MiB;
constexpr int CTL_RANK = 4096;
constexpr size_t CTL_ZERO_BYTES = 32 * 1024;

struct Params { const float* in[20]; float* out; unsigned char* ws; int ph_lo, ph_hi; };

__device__ __forceinline__ unsigned pk2(float a, float b) { h16x2 v = {(h16)a, (h16)b}; return __builtin_bit_cast(unsigned, v); }
__device__ __forceinline__ float wave_sum(float v) {
#pragma unroll
    for (int o = 32; o >= 1; o >>= 1) v += __shfl_xor(v, o);
    return v; }
__device__ __forceinline__ float sigmoidf_(float z) { return 1.0f / (1.0f + __expf(-z)); }

constexpr int N_MOD = 192, N_LB = 1, N_TRA = 640, N_TRG = 512, N_TRHG = 128, N_TRFT = 128, N_TROUT = 256, N_WF = 128, N_WSF = 256, N_DFT = 1;
constexpr int P0_TOTAL = N_MOD + N_LB + N_TRA + N_TRG + N_TRHG + N_TRFT + N_TROUT + N_WF + N_WSF + N_DFT;

__device__ __forceinline__ void p0_mod(const Params& p, LAS float* sm, int idx) {
    const int tid = threadIdx.x;
    for (int i = tid; i < 9 * 1024; i += NTHREADS) { const int r = i >> 10, k = i & 1023; const float c = (r < 8) ? p.in[1][r * 1024 + k] : p.in[3][k]; sm[i] = c / (1.0f + __expf(-c)); }
    __syncthreads();
    const int col = tid & 31, ks = tid >> 5;
    float acc[9];
#pragma unroll
    for (int r = 0; r < 9; ++r) acc[r] = 0.f;
    const float* w = p.in[4] + (size_t)(ks * 64) * 6144 + idx * 32 + col;
#pragma unroll 8
    for (int k = 0; k < 64; ++k) { const float wv = w[(size_t)k * 6144];
#pragma unroll
        for (int r = 0; r < 9; ++r) acc[r] += sm[r * 1024 + ks * 64 + k] * wv; }
    LAS float* red = sm + 9 * 1024;
#pragma unroll
    for (int r = 0; r < 9; ++r) red[(ks * 9 + r) * 32 + col] = acc[r];
    __syncthreads();
    float* mod = (float*)(p.ws + OFF_MOD);
    if (tid < 288) { const int r = tid >> 5, c = tid & 31; float s = 0.f;
#pragma unroll
        for (int q = 0; q < 16; ++q) s += red[(q * 9 + r) * 32 + c];
        mod[r * 6144 + idx * 32 + c] = s + p.in[5][idx * 32 + c]; }
    __syncthreads();
}
__device__ __forceinline__ void p0_lb(const Params& p) {
    const int tid = threadIdx.x; float* lb = (float*)(p.ws + OFF_LB);
    if (tid < 512) { lb[tid] = 1.0f / (1.0f + expf(p.in[9][512 + tid] - p.in[9][tid])); lb[512 + tid] = 1.0f / (1.0f + expf(p.in[10][512 + tid] - p.in[10][tid])); }
}
__device__ __forceinline__ void p0_transpose(const float* src, int ld_src, int ncol0, h16* dst, int ld_dst, int nktiles, int item, LAS float* sm) {
    const int tid = threadIdx.x, kt = item % nktiles, nt = item / nktiles;
    { const int n = tid & 63, kk = tid >> 6;
#pragma unroll
      for (int ps = 0; ps < 8; ++ps) { const int k = kk + 8 * ps; sm[k * 65 + n] = src[(size_t)(kt * 64 + k) * ld_src + ncol0 + nt * 64 + n]; } }
    __syncthreads();
    { const int k = tid & 63, nn = tid >> 6;
#pragma unroll
      for (int ps = 0; ps < 8; ++ps) { const int n = nn + 8 * ps; dst[(size_t)(nt * 64 + n) * ld_dst + kt * 64 + k] = (h16)sm[k * 65 + n]; } }
    __syncthreads();
}
__device__ __forceinline__ void p0_wf(const Params& p, LAS float* sm, int item) {
    const int tid = threadIdx.x, dt = item & 15, part = (item >> 4) & 1, g = item >> 5, d0 = dt * 64;
    LAS float* w = sm; LAS float* TT = sm + 8256; LAS float* trig = sm + 8256 + 16384;
    if (tid < 128) trig[tid] = part ? sinpif((float)tid / 64.0f) : cospif((float)tid / 64.0f);
    for (int i = tid; i < 64 * 128; i += NTHREADS) { const int dl = i >> 7, n2 = i & 127; w[dl * 129 + n2] = p.in[8][(size_t)(d0 + dl) * 5120 + 2560 + g * 128 + n2]; }
    __syncthreads();
    for (int i = tid; i < 128 * 128; i += NTHREADS) { const int n2 = i >> 7, k2 = i & 127; TT[i] = trig[(k2 * n2) & 127]; }
    __syncthreads();
    const int dl = tid & 63, kg = tid >> 6; h16* WF = (h16*)(p.ws + OFF_WF);
    float s[16];
#pragma unroll
    for (int j = 0; j < 16; ++j) s[j] = 0.f;
#pragma unroll 2
    for (int n2 = 0; n2 < 128; ++n2) { const float wv = w[dl * 129 + n2];
#pragma unroll
        for (int q = 0; q < 4; ++q) { const f32x4 tv = *(LAS f32x4*)(TT + n2 * 128 + kg * 16 + 4 * q);
#pragma unroll
            for (int j = 0; j < 4; ++j) s[4 * q + j] += wv * tv[j]; } }
#pragma unroll
    for (int j = 0; j < 16; ++j) WF[(size_t)(part * 512 + g * 128 + kg * 16 + j) * 1024 + d0 + dl] = (h16)(s[j] * 0.08838834764831845f);
    __syncthreads();
}
__device__ __forceinline__ void p0_wsf(const Params& p, LAS float* sm, int item) {
    const int tid = threadIdx.x, dt = item & 15, hp = item >> 4, d0 = dt * 64;
    LAS float* wq = sm; LAS float* skT = sm + 8256;
    for (int i = tid; i < 64 * 128; i += NTHREADS) { const int dl = i >> 7, k = i & 127; wq[dl * 129 + k] = p.in[15][(size_t)(d0 + dl) * 2048 + hp * 128 + k]; }
    for (int i = tid; i < 128 * 128; i += NTHREADS) { const int n = i >> 7, k = i & 127; skT[k * 128 + n] = p.in[16][(size_t)hp * 16384 + i]; }
    __syncthreads();
    const int dl = tid & 63, ng = tid >> 6; h16* WS = (h16*)(p.ws + OFF_WS);
    float s[16];
#pragma unroll
    for (int j = 0; j < 16; ++j) s[j] = 0.f;
#pragma unroll 2
    for (int k = 0; k < 128; ++k) { const float wv = wq[dl * 129 + k];
#pragma unroll
        for (int q = 0; q < 4; ++q) { const f32x4 tv = *(LAS f32x4*)(skT + k * 128 + ng * 16 + 4 * q);
#pragma unroll
            for (int j = 0; j < 4; ++j) s[4 * q + j] += wv * tv[j]; } }
#pragma unroll
    for (int j = 0; j < 16; ++j) WS[(size_t)(hp * 128 + ng * 16 + j) * 1024 + d0 + dl] = (h16)s[j];
    __syncthreads();
}
__device__ __forceinline__ void p0_dft256(const Params& p) {
    h16* M = (h16*)(p.ws + OFF_DFT256);
    for (int e = threadIdx.x; e < 256 * 512; e += NTHREADS) { const int c = e >> 9, k = e & 511, part = k >> 8, a = k & 255; const int m = (a * c) & 255;
        M[e] = (h16)((part ? sinpif((float)m / 128.0f) : cospif((float)m / 128.0f)) * 0.25f); }
}
__device__ __forceinline__ void phase0(const Params& p, LAS unsigned char* lds) {
    LAS float* sm = (LAS float*)lds;
    for (int it = blockIdx.x; it < P0_TOTAL; it += gridDim.x) {
        int i = it;
        if (i < N_MOD) { p0_mod(p, sm, i); continue; } i -= N_MOD;
        if (i < N_LB) { p0_lb(p); continue; } i -= N_LB;
        if (i < N_TRA) { p0_transpose(p.in[8], 5120, 0, (h16*)(p.ws + OFF_WA), 1024, 16, i, sm); continue; } i -= N_TRA;
        if (i < N_TRG) { p0_transpose(p.in[8], 5120, 3072, (h16*)(p.ws + OFF_WG), 1024, 16, i, sm); continue; } i -= N_TRG;
        if (i < N_TRHG) { p0_transpose(p.in[12], 1024, 0, (h16*)(p.ws + OFF_WHG), 512, 8, i, sm); continue; } i -= N_TRHG;
        if (i < N_TRFT) { p0_transpose(p.in[13], 1024, 0, (h16*)(p.ws + OFF_WFT), 512, 8, i, sm); continue; } i -= N_TRFT;
        if (i < N_TROUT) { p0_transpose(p.in[14], 1024, 0, (h16*)(p.ws + OFF_WOUT), 1024, 16, i, sm); continue; } i -= N_TROUT;
        if (i < N_WF) { p0_wf(p, sm, i); continue; } i -= N_WF;
        if (i < N_WSF) { p0_wsf(p, sm, i); continue; } i -= N_WSF;
        p0_dft256(p);
    }
}

__device__ __forceinline__ void modulate_rows(const float* src, h16* dst, int nrows, const float* gvec, const float* mod, int sh_off, int sc_off, int ctx_rows, signed char* qdst = nullptr, float* qscale = nullptr) {
    const int wave = threadIdx.x >> 6, lane = threadIdx.x & 63;
    for (int row = blockIdx.x * 8 + wave; row < nrows; row += gridDim.x * 8) {
        const int mr = ctx_rows ? 8 : (row >> 12);
        const float* x = src + (size_t)row * D;
        f32x4 v[4]; float ss = 0.f;
#pragma unroll
        for (int j = 0; j < 4; ++j) { v[j] = *(const f32x4*)(x + j * 256 + lane * 4); ss += v[j].x * v[j].x + v[j].y * v[j].y + v[j].z * v[j].z + v[j].w * v[j].w; }
        ss = wave_sum(ss);
        const float rstd = rsqrtf(ss * (1.0f / D) + EPS);
        float amax = 0.f;
#pragma unroll
        for (int j = 0; j < 4; ++j) { const int c = j * 256 + lane * 4;
            const f32x4 gg = *(const f32x4*)(gvec + c), sc = *(const f32x4*)(mod + mr * 6144 + sc_off + c), sh = *(const f32x4*)(mod + mr * 6144 + sh_off + c);
            const f32x4 o = (v[j] * rstd) * gg * (sc + 1.0f) + sh; v[j] = o;
            amax = fmaxf(amax, fmaxf(fmaxf(fabsf(o.x), fabsf(o.y)), fmaxf(fabsf(o.z), fabsf(o.w))));
            u32x2 w; w.x = pk2(o.x, o.y); w.y = pk2(o.z, o.w);
            *(u32x2*)(dst + (size_t)row * D + c) = w; }
        if (qdst) {
#pragma unroll
            for (int o = 32; o >= 1; o >>= 1) amax = fmaxf(amax, __shfl_xor(amax, o));
            const float qs = amax > 0.f ? amax * (1.0f / 127.0f) : 1.0f, inv = 1.0f / qs;
#pragma unroll
            for (int j = 0; j < 4; ++j) { const int c = j * 256 + lane * 4;
                const int q0 = (int)rintf(v[j].x * inv), q1 = (int)rintf(v[j].y * inv), q2 = (int)rintf(v[j].z * inv), q3 = (int)rintf(v[j].w * inv);
                *(unsigned*)(qdst + (size_t)row * D + c) = (unsigned)(q0 & 255) | ((unsigned)(q1 & 255) << 8) | ((unsigned)(q2 & 255) << 16) | ((unsigned)(q3 & 255) << 24); }
            if (lane == 0) qscale[row] = qs;
        }
    }
}

struct EpiA {
    static constexpr bool PERM = true, TRANS = true;
    unsigned char* ws;
    __device__ __forceinline__ void operator()(const f32x4 (&acc)[2][2][4][2], const pg8::Unit& u, int wr, int wc, int fr, int fq) const {
        const int ty = u.pn >> 1;
        h16* base = (h16*)(ws + (ty == 0 ? OFF_Q : ty == 1 ? OFF_LF : ty == 2 ? OFF_LBK : ty == 3 ? OFF_V : OFF_G));
        const float* lb = (const float*)(ws + OFF_LB) + (ty == 2 ? 512 : 0);
        const int row0 = u.pm * 256 + wr * 64 + fr, col0 = (u.pn & 1) * 256 + wc * 32 + 8 * fq;
#pragma unroll
        for (int bj = 0; bj < 2; ++bj) {
            float lbv[8];
            if (ty == 1 || ty == 2) {
#pragma unroll
                for (int j = 0; j < 8; ++j) lbv[j] = lb[col0 + bj * 128 + j];
            }
#pragma unroll
            for (int ai = 0; ai < 2; ++ai)
#pragma unroll
                for (int m = 0; m < 4; ++m) {
                    float v[8];
#pragma unroll
                    for (int j = 0; j < 4; ++j) { v[j] = acc[ai][bj][m][0][j]; v[4 + j] = acc[ai][bj][m][1][j]; }
                    if (ty == 0) {
#pragma unroll
                        for (int j = 0; j < 8; ++j) v[j] *= 0.08838834764831845f;
                    } else if (ty == 1 || ty == 2) {
#pragma unroll
                        for (int j = 0; j < 8; ++j) v[j] = __logf(lbv[j] + (1.0f - lbv[j]) * sigmoidf_(v[j]));
                    } else if (ty == 4) {
#pragma unroll
                        for (int j = 0; j < 8; ++j) v[j] = v[j] * sigmoidf_(v[j]);
                    }
                    u32x4 w; w.x = pk2(v[0], v[1]); w.y = pk2(v[2], v[3]); w.z = pk2(v[4], v[5]); w.w = pk2(v[6], v[7]);
                    *(u32x4*)(base + (size_t)(row0 + ai * 128 + m * 16) * 512 + col0 + bj * 128) = w;
                }
        }
    }
};
struct OrderA {
    pg8::TileOrder lat; int G, c, rep;
    __device__ void init(int G_, int c_, int rep_ = 1) { lat.init(128, 10, G_, c_); G = G_; c = c_; rep = rep_; }
    __device__ bool next(int i, pg8::Unit& u) const {
        long L = (long)i * G + c; if (L >= 1328L * rep) return false; L %= 1328;
        if (L < 1280) return lat.map(L, u);
        const int l2 = (int)(L - 1280); if (l2 >= 48) return false;
        u.pm = 128 + l2 / 6; u.pn = 2 + l2 % 6; return true;
    }
};
struct EpiGate {
    static constexpr bool PERM = true, TRANS = true;
    unsigned char* ws;
    __device__ __forceinline__ void operator()(const f32x4 (&acc)[2][2][4][2], const pg8::Unit& u, int wr, int wc, int fr, int fq) const {
        h16* base = (h16*)(ws + (u.pn < 4 ? OFF_GH : OFF_GF));
        const int row0 = u.pm * 256 + wr * 64 + fr, col0 = (u.pn & 3) * 256 + wc * 32 + 8 * fq;
#pragma unroll
        for (int ai = 0; ai < 2; ++ai)
#pragma unroll
            for (int m = 0; m < 4; ++m)
#pragma unroll
                for (int bj = 0; bj < 2; ++bj) {
                    float v[8];
#pragma unroll
                    for (int j = 0; j < 4; ++j) { v[j] = sigmoidf_(acc[ai][bj][m][0][j]); v[4 + j] = sigmoidf_(acc[ai][bj][m][1][j]); }
                    u32x4 w; w.x = pk2(v[0], v[1]); w.y = pk2(v[2], v[3]); w.z = pk2(v[4], v[5]); w.w = pk2(v[6], v[7]);
                    *(u32x4*)(base + (size_t)(row0 + ai * 128 + m * 16) * 1024 + col0 + bj * 128) = w;
                }
    }
};
struct EpiFT {
    static constexpr bool PERM = false, TRANS = false;
    unsigned char* ws;
    __device__ __forceinline__ void operator()(const f32x4 (&acc)[2][2][4][2], const pg8::Unit& u, int wr, int wc, int fr, int fq) const {
        h16* F = (h16*)(ws + OFF_FTT);
        const int t0 = u.pm * 256 + wr * 64 + 4 * fq, c0 = u.pn * 256 + wc * 32 + fr;
#pragma unroll
        for (int ai = 0; ai < 2; ++ai)
#pragma unroll
            for (int m = 0; m < 4; ++m)
#pragma unroll
                for (int bj = 0; bj < 2; ++bj)
#pragma unroll
                    for (int n = 0; n < 2; ++n) {
                        const int t = t0 + ai * 128 + m * 16, c = c0 + bj * 128 + n * 16;
                        const int b = t >> 12, n1 = t & 4095, part = c >> 9, gk = c & 511;
                        const f32x4 a = acc[ai][bj][m][n];
                        u32x2 w; w.x = pk2(a.x, a.y); w.y = pk2(a.z, a.w);
                        *(u32x2*)(F + ((size_t)((b * 512 + gk) * 2 + part)) * 4096 + n1) = w;
                    }
    }
};
struct EpiDFT {
    static constexpr bool PERM = true, TRANS = true;
    unsigned char* ws;
    __device__ __forceinline__ void operator()(const f32x4 (&acc)[2][2][4][2], const pg8::Unit& u, int wr, int wc, int fr, int fq) const {
        h16* Y = (h16*)(ws + OFF_YFT);
        const int b = u.pn >> 5, d = (u.pn >> 1) & 15;
        const int c0 = wr * 64 + fr, col0 = (u.pn & 1) * 256 + wc * 32 + 8 * fq;
#pragma unroll
        for (int ai = 0; ai < 2; ++ai)
#pragma unroll
            for (int m = 0; m < 4; ++m)
#pragma unroll
                for (int bj = 0; bj < 2; ++bj) {
                    const int c = c0 + ai * 128 + m * 16;
                    const f32x4 a0 = acc[ai][bj][m][0], a1 = acc[ai][bj][m][1];
                    u32x4 w; w.x = pk2(a0.x, a0.y); w.y = pk2(a0.z, a0.w); w.z = pk2(a1.x, a1.y); w.w = pk2(a1.z, a1.w);
                    *(u32x4*)(Y + (size_t)(b * 4096 + d + 16 * c) * 512 + col0 + bj * 128) = w;
                }
    }
};
template <bool ACCUM> struct EpiMerge1 {
    static constexpr bool PERM = true, TRANS = true;
    unsigned char* ws;
    __device__ __forceinline__ void operator()(const f32x4 (&acc)[2][2][4][2], const pg8::Unit& u, int wr, int wc, int fr, int fq) const {
        h16* Y = (h16*)(ws + OFF_Y); const h16* GT = (const h16*)(ws + (ACCUM ? OFF_GF : OFF_GH));
        const int row0 = u.pm * 256 + wr * 64 + fr, col0 = u.pn * 256 + wc * 32 + 8 * fq;
#pragma unroll
        for (int ai = 0; ai < 2; ++ai)
#pragma unroll
            for (int m = 0; m < 4; ++m)
#pragma unroll
                for (int bj = 0; bj < 2; ++bj) {
                    const size_t off = (size_t)(row0 + ai * 128 + m * 16) * 1024 + col0 + bj * 128;
                    const h16x8 gt = *(const h16x8*)(GT + off);
                    float v[8];
#pragma unroll
                    for (int j = 0; j < 4; ++j) { v[j] = acc[ai][bj][m][0][j] * (float)gt[j]; v[4 + j] = acc[ai][bj][m][1][j] * (float)gt[4 + j]; }
                    if (ACCUM) { const h16x8 y0 = *(const h16x8*)(Y + off);
#pragma unroll
                        for (int j = 0; j < 8; ++j) v[j] += (float)y0[j]; }
                    u32x4 w; w.x = pk2(v[0], v[1]); w.y = pk2(v[2], v[3]); w.z = pk2(v[4], v[5]); w.w = pk2(v[6], v[7]);
                    *(u32x4*)(Y + off) = w;
                }
    }
};
struct EpiMerge2 {
    static constexpr bool PERM = false, TRANS = true;
    const float* x; float* H; const float* mod;
    __device__ __forceinline__ void operator()(const f32x4 (&acc)[2][2][4][2], const pg8::Unit& u, int wr, int wc, int fr, int fq) const {
        const int row0 = u.pm * 256 + wr * 64 + fr, col0 = u.pn * 256 + wc * 32 + 4 * fq;
        const int b = (u.pm * 256) >> 12;
        f32x4 g1[2][2];
#pragma unroll
        for (int bj = 0; bj < 2; ++bj)
#pragma unroll
            for (int n = 0; n < 2; ++n) g1[bj][n] = *(const f32x4*)(mod + b * 6144 + 2048 + col0 + bj * 128 + n * 16);
#pragma unroll
        for (int ai = 0; ai < 2; ++ai)
#pragma unroll
            for (int m = 0; m < 4; ++m) { const size_t ro = (size_t)(row0 + ai * 128 + m * 16) * 1024 + col0;
#pragma unroll
                for (int bj = 0; bj < 2; ++bj)
#pragma unroll
                    for (int n = 0; n < 2; ++n) { const f32x4 xv = *(const f32x4*)(x + ro + bj * 128 + n * 16);
                        *(f32x4*)(H + ro + bj * 128 + n * 16) = xv + g1[bj][n] * acc[ai][bj][m][n]; } }
    }
};
struct EpiF32 {
    static constexpr bool PERM = false, TRANS = true;
    float* C; int ldc;
    __device__ __forceinline__ void operator()(const f32x4 (&acc)[2][2][4][2], const pg8::Unit& u, int wr, int wc, int fr, int fq) const {
        const int row0 = u.pm * 256 + wr * 64 + fr, col0 = u.pn * 256 + wc * 32 + 4 * fq;
#pragma unroll
        for (int ai = 0; ai < 2; ++ai)
#pragma unroll
            for (int m = 0; m < 4; ++m) { float* rowp = C + (size_t)(row0 + ai * 128 + m * 16) * ldc + col0;
#pragma unroll
                for (int bj = 0; bj < 2; ++bj)
#pragma unroll
                    for (int n = 0; n < 2; ++n) *(f32x4*)(rowp + bj * 128 + n * 16) = acc[ai][bj][m][n]; }
    }
};

__device__ __forceinline__ int hgrn_row(int pos, int b, int dir) {
    if (pos < LC) { const int j = dir ? (LC - 1 - pos) : pos; return T + b * LC + j; }
    const int t = pos - LC; return b * SEQ + (dir ? (SEQ - 1 - t) : t);
}
__device__ void hgrn_item(const Params& p, LAS unsigned char* lds, int item) {
    const int tid = threadIdx.x, vq = item & 3, dir = (item >> 2) & 1, h = (item >> 3) & 3, b = item >> 5;
    const h16* Q = (const h16*)(p.ws + OFF_Q); const h16* LF = (const h16*)(p.ws + (dir ? OFF_LBK : OFF_LF)); const h16* V = (const h16*)(p.ws + OFF_V);
    h16* O = (h16*)(p.ws + (dir ? OFF_OB : OFF_OF));
    LAS float* fs = (LAS float*)lds; LAS float* ks = fs + 16 * 128; LAS float* qs = ks + 16 * 128; LAS float* vs = qs + 16 * 128; LAS float* po = vs + 16 * 32;
    const int v = tid & 31, kq = tid >> 5;
    float S[8];
#pragma unroll
    for (int j = 0; j < 8; ++j) S[j] = 0.f;
    const int e = tid * 4, tl_ld = e >> 7, k_ld = e & 127;
    const int tl_v = tid >> 5, vv = tid & 31;
    h16x4 lf4, q4; h16 v1;
    { const int row = hgrn_row(tl_ld, b, dir); lf4 = *(const h16x4*)(LF + (size_t)row * 512 + h * 128 + k_ld); q4 = (h16x4){0, 0, 0, 0};
      const int row2 = hgrn_row(tl_v, b, dir); v1 = V[(size_t)row2 * 512 + h * 128 + vq * 32 + vv]; }
    constexpr int NG = (LC + SEQ) / 16;
    for (int grp = 0; grp < NG; ++grp) {
        const bool latent = grp >= LC / 16;
#pragma unroll
        for (int j = 0; j < 4; ++j) { const float f = __expf((float)lf4[j]); fs[e + j] = f; ks[e + j] = 1.0f - f; qs[e + j] = (float)q4[j]; }
        vs[tid] = (float)v1;
        __syncthreads();
        if (grp + 1 < NG) { const int pos = (grp + 1) * 16; const bool lat2 = (grp + 1) >= LC / 16;
            const int row = hgrn_row(pos + tl_ld, b, dir); lf4 = *(const h16x4*)(LF + (size_t)row * 512 + h * 128 + k_ld);
            if (lat2) q4 = *(const h16x4*)(Q + (size_t)row * 512 + h * 128 + k_ld);
            const int row2 = hgrn_row(pos + tl_v, b, dir); v1 = V[(size_t)row2 * 512 + h * 128 + vq * 32 + vv]; }
#pragma unroll 4
        for (int tl = 0; tl < 16; ++tl) {
            const float vt = vs[tl * 32 + v];
            const f32x4 f0 = *(const LAS f32x4*)(fs + tl * 128 + kq * 8), f1 = *(const LAS f32x4*)(fs + tl * 128 + kq * 8 + 4);
            const f32x4 k0 = *(const LAS f32x4*)(ks + tl * 128 + kq * 8), k1 = *(const LAS f32x4*)(ks + tl * 128 + kq * 8 + 4);
            const f32x4 q0 = *(const LAS f32x4*)(qs + tl * 128 + kq * 8), q1 = *(const LAS f32x4*)(qs + tl * 128 + kq * 8 + 4);
            float a = 0.f;
#pragma unroll
            for (int j = 0; j < 4; ++j) { S[j] = f0[j] * S[j] + k0[j] * vt; a += S[j] * q0[j]; S[4 + j] = f1[j] * S[4 + j] + k1[j] * vt; a += S[4 + j] * q1[j]; }
            po[(tl * 16 + kq) * 32 + v] = a;
        }
        __syncthreads();
        if (latent) { float s = 0.f;
#pragma unroll
            for (int q = 0; q < 16; ++q) s += po[(tl_v * 16 + q) * 32 + vv];
            const int row = hgrn_row(grp * 16 + tl_v, b, dir);
            O[(size_t)row * 512 + h * 128 + vq * 32 + vv] = (h16)s; }
    }
    __syncthreads();
}

typedef short s16x8 __attribute__((ext_vector_type(8)));
typedef short s16x4 __attribute__((ext_vector_type(4)));
__device__ __forceinline__ unsigned cvt_pk_bf16(float lo, float hi) { unsigned r; asm volatile("v_cvt_pk_bf16_f32 %0, %1, %2" : "=v"(r) : "v"(lo), "v"(hi)); return r; }
constexpr int HG_RP = 272, HG_QT = 0, HG_KT = 17408, HG_QD = 34816, HG_KDT = 52224, HG_VT = 68608, HG_AM = 84992, HG_DEC = 93184, HG_SEG = 93696, HG_SEGCH = 17;
#define HG_OPAQUE(x) asm volatile("" : "+v"(x))
template <bool FULL>
__device__ __forceinline__ void hgrn_mfma_unit(const Params& p, LAS unsigned char* lds, int item, int seg) {
    const int tid = threadIdx.x, wave = __builtin_amdgcn_readfirstlane(tid >> 6), lane = tid & 63, fr = lane & 15, fq = lane >> 4;
    const int dir = item & 1, h = (item >> 1) & 3, b = item >> 3;
    const h16* Q = (const h16*)(p.ws + OFF_Q); const h16* LF = (const h16*)(p.ws + (dir ? OFF_LBK : OFF_LF)); const h16* V = (const h16*)(p.ws + OFF_V);
    h16* O = (h16*)(p.ws + (dir ? OFF_OB : OFF_OF));
    float* USTATE = (float*)(p.ws + OFF_USTATE); float* DLOG = (float*)(p.ws + OFF_DLOG);
    const int ch_lo = seg * HG_SEGCH, ch_hi = ch_lo + HG_SEGCH;
    f32x4 S[8];
#pragma unroll
    for (int m = 0; m < 8; ++m) S[m] = (f32x4){0.f, 0.f, 0.f, 0.f};
    if (FULL && seg > 0) {
        for (int i = 0; i < seg; ++i) { const float* U = USTATE + (size_t)(item * 3 + i) * 16384; const float* DL = DLOG + (size_t)(item * 3 + i) * 128;
#pragma unroll
            for (int m = 0; m < 8; ++m)
#pragma unroll
                for (int j = 0; j < 4; ++j) { const int k = 16 * m + 4 * fq + j; const float d = (i > 0) ? __expf(DL[k]) : 0.f; S[m][j] = d * S[m][j] + U[k * 128 + 16 * wave + fr]; } } }
    float dl0 = 0.f, dl1 = 0.f;
    for (int i = tid; i < 8192 / 16; i += NTHREADS) ((LAS u32x4*)(lds + HG_AM))[i] = (u32x4){0u, 0u, 0u, 0u};
    const int kp = lane;
    const unsigned chan = (unsigned)(h * 128 + 2 * kp);
    int bw_rm = wave * 8 * HG_RP + 4 * kp;
    int bw_t0 = (2 * kp) * 128 + ((wave ^ ((2 * kp) & 7)) << 4), bw_t1 = (2 * kp + 1) * 128 + ((wave ^ ((2 * kp + 1) & 7)) << 4);
    int br_rm = fr * HG_RP + 16 * fq;
    int br_qd = HG_QD + fr * HG_RP + 8 * fq;
    int br_t0 = fr * 128 + ((fq ^ (fr & 7)) << 4), br_t1 = fr * 128 + (((4 + fq) ^ (fr & 7)) << 4);
    HG_OPAQUE(bw_rm); HG_OPAQUE(bw_t0); HG_OPAQUE(bw_t1); HG_OPAQUE(br_rm); HG_OPAQUE(br_qd); HG_OPAQUE(br_t0); HG_OPAQUE(br_t1);
    int br_v0 = br_t0 + HG_VT + wave * 2048, br_v1 = br_t1 + HG_VT + wave * 2048, br_k0 = br_t0 + HG_KDT, br_k1 = br_t1 + HG_KDT, br_a0 = br_t0 + HG_AM, br_a1 = br_t1 + HG_AM;
    HG_OPAQUE(br_v0); HG_OPAQUE(br_v1); HG_OPAQUE(br_k0); HG_OPAQUE(br_k1); HG_OPAQUE(br_a0); HG_OPAQUE(br_a1);
    LAS float* DEC = (LAS float*)(lds + HG_DEC); LAS float* SEG = (LAS float*)(lds + HG_SEG);
    unsigned lfr[8], qr[8], vr[8];
#pragma unroll
    for (int r = 0; r < 8; ++r) { const unsigned eo = (unsigned)hgrn_row(ch_lo * 64 + 8 * wave + r, b, dir) * 512u + chan; lfr[r] = *(const unsigned*)(LF + eo); vr[r] = *(const unsigned*)(V + eo);
        qr[r] = (FULL && ch_lo >= LC / 64) ? *(const unsigned*)(Q + eo) : 0u; }
    for (int ch = ch_lo; ch < ch_hi; ++ch) {
        const bool latent = FULL && (ch >= LC / 64);
        float c0[8], c1[8]; float run0 = 0.f, run1 = 0.f;
#pragma unroll
        for (int r = 0; r < 8; ++r) { const h16x2 l = __builtin_bit_cast(h16x2, lfr[r]); run0 += (float)l[0]; run1 += (float)l[1]; c0[r] = run0; c1[r] = run1; }
        *(LAS f32x2*)(SEG + wave * 128 + 2 * kp) = (f32x2){run0, run1};
        __syncthreads();
        float off0 = 0.f, off1 = 0.f, mid0 = 0.f, mid1 = 0.f, tot0 = 0.f, tot1 = 0.f;
#pragma unroll
        for (int w2 = 0; w2 < 8; ++w2) { const f32x2 tt = *(LAS f32x2*)(SEG + w2 * 128 + 2 * kp);
            if (w2 < wave) { off0 += tt[0]; off1 += tt[1]; } if (w2 < 4) { mid0 += tt[0]; mid1 += tt[1]; } tot0 += tt[0]; tot1 += tt[1]; }
        dl0 += tot0; dl1 += tot1;
        const float em0 = __expf(mid0), em1 = __expf(mid1), el0 = __expf(tot0 - mid0), el1 = __expf(tot1 - mid1);
        if (wave == 0) *(LAS f32x2*)(DEC + 2 * kp) = (f32x2){__expf(tot0), __expf(tot1)};
        unsigned kd0[4], kd1[4], vt0[4], vt1[4];
#pragma unroll
        for (int r = 0; r < 8; ++r) {
            const h16x2 l = __builtin_bit_cast(h16x2, lfr[r]), q = __builtin_bit_cast(h16x2, qr[r]), v = __builtin_bit_cast(h16x2, vr[r]);
            const float b0 = off0 + c0[r], b1 = off1 + c1[r];
            const float e20 = __expf(mid0 - b0), e21 = __expf(mid1 - b1);
            const float k0 = 1.0f - __expf((float)l[0]), k1 = 1.0f - __expf((float)l[1]);
            const float kt0 = k0 * e20, kt1 = k1 * e21;
            if (FULL) {
                const float e10 = __expf(b0 - mid0), e11 = __expf(b1 - mid1);
                const float qt0 = (float)q[0] * e10, qt1 = (float)q[1] * e11;
                *(LAS unsigned*)(lds + bw_rm + HG_QT + r * HG_RP) = cvt_pk_bf16(qt0, qt1);
                *(LAS unsigned*)(lds + bw_rm + HG_KT + r * HG_RP) = cvt_pk_bf16(kt0, kt1);
                *(LAS unsigned*)(lds + bw_rm + HG_QD + r * HG_RP) = cvt_pk_bf16(qt0 * em0, qt1 * em1);
            }
            const float kdv0 = kt0 * el0, kdv1 = kt1 * el1;
            if (r & 1) { kd0[r >> 1] = cvt_pk_bf16(__builtin_bit_cast(float, kd0[r >> 1]), kdv0); kd1[r >> 1] = cvt_pk_bf16(__builtin_bit_cast(float, kd1[r >> 1]), kdv1);
                         vt0[r >> 1] = cvt_pk_bf16(__builtin_bit_cast(float, vt0[r >> 1]), (float)v[0]); vt1[r >> 1] = cvt_pk_bf16(__builtin_bit_cast(float, vt1[r >> 1]), (float)v[1]); }
            else { kd0[r >> 1] = __builtin_bit_cast(unsigned, kdv0); kd1[r >> 1] = __builtin_bit_cast(unsigned, kdv1);
                   vt0[r >> 1] = __builtin_bit_cast(unsigned, (float)v[0]); vt1[r >> 1] = __builtin_bit_cast(unsigned, (float)v[1]); }
        }
        *(LAS u32x4*)(lds + bw_t0 + HG_KDT) = (u32x4){kd0[0], kd0[1], kd0[2], kd0[3]};
        *(LAS u32x4*)(lds + bw_t1 + HG_KDT) = (u32x4){kd1[0], kd1[1], kd1[2], kd1[3]};
        *(LAS u32x4*)(lds + bw_t0 + HG_VT) = (u32x4){vt0[0], vt0[1], vt0[2], vt0[3]};
        *(LAS u32x4*)(lds + bw_t1 + HG_VT) = (u32x4){vt1[0], vt1[1], vt1[2], vt1[3]};
        __syncthreads();
        if (ch + 1 < ch_hi) { const bool lat2 = FULL && ((ch + 1) >= LC / 64);
#pragma unroll
            for (int r = 0; r < 8; ++r) { const unsigned eo = (unsigned)hgrn_row((ch + 1) * 64 + 8 * wave + r, b, dir) * 512u + chan;
                lfr[r] = *(const unsigned*)(LF + eo); vr[r] = *(const unsigned*)(V + eo); qr[r] = lat2 ? *(const unsigned*)(Q + eo) : 0u; } }
        if (latent) {
#pragma unroll
            for (int rep = 0; rep < 2; ++rep) {
                const int tile = wave + 8 * rep;
                if (tile < 10) {
                    const int ti = tile < 1 ? 0 : tile < 3 ? 1 : tile < 6 ? 2 : 3, si = tile - (ti * (ti + 1)) / 2;
                    f32x4 acc = (f32x4){0.f, 0.f, 0.f, 0.f};
                    LAS unsigned char* pa = lds + br_rm + HG_KT + 16 * si * HG_RP; LAS unsigned char* pb = lds + br_rm + HG_QT + 16 * ti * HG_RP;
#pragma unroll
                    for (int kk = 0; kk < 4; ++kk) acc = __builtin_amdgcn_mfma_f32_16x16x32_bf16(*(LAS s16x8*)(pa + 64 * kk), *(LAS s16x8*)(pb + 64 * kk), acc, 0, 0, 0);
                    const int t = 16 * ti + fr, s0 = 16 * si + 4 * fq;
                    if (ti == si) {
#pragma unroll
                        for (int j = 0; j < 4; ++j) acc[j] = (s0 + j <= t) ? acc[j] : 0.f; }
                    *(LAS u32x2*)(lds + HG_AM + t * 128 + ((((s0 >> 3)) ^ (fr & 7)) << 4) + (s0 & 7) * 2) = (u32x2){cvt_pk_bf16(acc[0], acc[1]), cvt_pk_bf16(acc[2], acc[3])};
                }
            }
        }
        __syncthreads();
        const s16x8 vf0 = *(LAS s16x8*)(lds + br_v0), vf1 = *(LAS s16x8*)(lds + br_v1);
        if (latent) {
            s16x8 sfrag[4];
#pragma unroll
            for (int kk = 0; kk < 4; ++kk) { const unsigned w0 = cvt_pk_bf16(S[2 * kk][0], S[2 * kk][1]), w1 = cvt_pk_bf16(S[2 * kk][2], S[2 * kk][3]),
                                                          w2 = cvt_pk_bf16(S[2 * kk + 1][0], S[2 * kk + 1][1]), w3 = cvt_pk_bf16(S[2 * kk + 1][2], S[2 * kk + 1][3]);
                sfrag[kk] = __builtin_bit_cast(s16x8, (u32x4){w0, w1, w2, w3}); }
#pragma unroll
            for (int ti = 0; ti < 4; ++ti) {
                f32x4 acc = (f32x4){0.f, 0.f, 0.f, 0.f};
                acc = __builtin_amdgcn_mfma_f32_16x16x32_bf16(vf0, *(LAS s16x8*)(lds + br_a0 + 2048 * ti), acc, 0, 0, 0);
                if (ti >= 2) acc = __builtin_amdgcn_mfma_f32_16x16x32_bf16(vf1, *(LAS s16x8*)(lds + br_a1 + 2048 * ti), acc, 0, 0, 0);
#pragma unroll
                for (int kk = 0; kk < 4; ++kk) {
                    const s16x4 lo = *(LAS s16x4*)(lds + br_qd + 16 * ti * HG_RP + 64 * kk), hi = *(LAS s16x4*)(lds + br_qd + 16 * ti * HG_RP + 64 * kk + 32);
                    const s16x8 bf = (s16x8){lo[0], lo[1], lo[2], lo[3], hi[0], hi[1], hi[2], hi[3]};
                    acc = __builtin_amdgcn_mfma_f32_16x16x32_bf16(sfrag[kk], bf, acc, 0, 0, 0); }
                const unsigned oo = (unsigned)hgrn_row(ch * 64 + 16 * ti + fr, b, dir) * 512u + (unsigned)(h * 128 + 16 * wave + 4 * fq);
                *(u32x2*)(O + oo) = (u32x2){pk2(acc[0], acc[1]), pk2(acc[2], acc[3])};
            }
        }
#pragma unroll
        for (int m = 0; m < 8; ++m) {
            const f32x4 dc = *(LAS f32x4*)(DEC + 16 * m + 4 * fq);
            S[m] = S[m] * dc;
            S[m] = __builtin_amdgcn_mfma_f32_16x16x32_bf16(*(LAS s16x8*)(lds + br_k0 + 2048 * m), vf0, S[m], 0, 0, 0);
            S[m] = __builtin_amdgcn_mfma_f32_16x16x32_bf16(*(LAS s16x8*)(lds + br_k1 + 2048 * m), vf1, S[m], 0, 0, 0);
        }
    }
    if (!FULL) {
        float* U = USTATE + (size_t)(item * 3 + seg) * 16384;
#pragma unroll
        for (int m = 0; m < 8; ++m)
#pragma unroll
            for (int j = 0; j < 4; ++j) U[(16 * m + 4 * fq + j) * 128 + 16 * wave + fr] = S[m][j];
        if (wave == 0) *(f32x2*)(DLOG + (size_t)(item * 3 + seg) * 128 + 2 * kp) = (f32x2){dl0, dl1};
    }
    __syncthreads();
}

__device__ __forceinline__ void fft1_phase(const Params& p, LAS unsigned char* lds, int first_item, int item_stride) {
    LAS float* ctab = (LAS float*)lds;
    LAS float* w16 = ctab + 4096;
    for (int i = threadIdx.x; i < 4096; i += NTHREADS) ctab[i] = cospif((float)i / 2048.0f);
    if (threadIdx.x < 16) { w16[threadIdx.x] = cospif((float)threadIdx.x / 8.0f); w16[16 + threadIdx.x] = sinpif((float)threadIdx.x / 8.0f); }
    __syncthreads();
    const h16* F = (const h16*)(p.ws + OFF_FTT); h16* Y1 = (h16*)(p.ws + OFF_Y1);
    const int ap = threadIdx.x & 127, gl = threadIdx.x >> 7;
    for (int item = first_item; item < 8 * 128; item += item_stride) {
        const int b = item >> 7, gk = (item & 127) * 4 + gl;
        float zr[16][2], zi[16][2];
        const h16* src = F + ((size_t)(b * 512 + gk) * 2) * 4096 + 2 * ap;
#pragma unroll
        for (int r = 0; r < 16; ++r) { const h16x2 c2 = *(const h16x2*)(src + 256 * r), s2 = *(const h16x2*)(src + 4096 + 256 * r);
            zr[r][0] = (float)c2[0]; zr[r][1] = (float)c2[1]; zi[r][0] = -(float)s2[0]; zi[r][1] = -(float)s2[1]; }
        float ur[4][4][2], ui[4][4][2];
#pragma unroll
        for (int r0 = 0; r0 < 4; ++r0)
#pragma unroll
            for (int j = 0; j < 2; ++j) {
                const float a0r = zr[r0][j], a0i = zi[r0][j], a1r = zr[4 + r0][j], a1i = zi[4 + r0][j], a2r = zr[8 + r0][j], a2i = zi[8 + r0][j], a3r = zr[12 + r0][j], a3i = zi[12 + r0][j];
                const float s0r = a0r + a2r, s0i = a0i + a2i, s1r = a0r - a2r, s1i = a0i - a2i, s2r = a1r + a3r, s2i = a1i + a3i, s3r = a1r - a3r, s3i = a1i - a3i;
                float xr[4], xi[4];
                xr[0] = s0r + s2r; xi[0] = s0i + s2i; xr[2] = s0r - s2r; xi[2] = s0i - s2i;
                xr[1] = s1r + s3i; xi[1] = s1i - s3r;
                xr[3] = s1r - s3i; xi[3] = s1i + s3r;
#pragma unroll
                for (int d0 = 0; d0 < 4; ++d0) { const int m = r0 * d0;
                    const float cs = (m == 0) ? 1.f : (m == 1) ? 0.92387953251f : (m == 2) ? 0.70710678119f : (m == 3) ? 0.38268343237f : (m == 4) ? 0.f : (m == 6) ? -0.70710678119f : -0.92387953251f;
                    const float sn = (m == 0) ? 0.f : (m == 1) ? 0.38268343237f : (m == 2) ? 0.70710678119f : (m == 3) ? 0.92387953251f : (m == 4) ? 1.f : (m == 6) ? 0.70710678119f : -0.38268343237f;
                    ur[r0][d0][j] = xr[d0] * cs + xi[d0] * sn; ui[r0][d0][j] = xi[d0] * cs - xr[d0] * sn; } }
#pragma unroll
        for (int d0 = 0; d0 < 4; ++d0) {
            float yr4[4][2], yi4[4][2];
#pragma unroll
            for (int j = 0; j < 2; ++j) {
                const float a0r = ur[0][d0][j], a0i = ui[0][d0][j], a1r = ur[1][d0][j], a1i = ui[1][d0][j], a2r = ur[2][d0][j], a2i = ui[2][d0][j], a3r = ur[3][d0][j], a3i = ui[3][d0][j];
                const float s0r = a0r + a2r, s0i = a0i + a2i, s1r = a0r - a2r, s1i = a0i - a2i, s2r = a1r + a3r, s2i = a1i + a3i, s3r = a1r - a3r, s3i = a1i - a3i;
                yr4[0][j] = s0r + s2r; yi4[0][j] = s0i + s2i; yr4[2][j] = s0r - s2r; yi4[2][j] = s0i - s2i;
                yr4[1][j] = s1r + s3i; yi4[1][j] = s1i - s3r; yr4[3][j] = s1r - s3i; yi4[3][j] = s1i + s3r; }
#pragma unroll
            for (int d1 = 0; d1 < 4; ++d1) { const int d = d0 + 4 * d1;
                float ore[2], oim[2];
#pragma unroll
                for (int j = 0; j < 2; ++j) { const int t = ((2 * ap + j) * d) & 4095; const float ct = ctab[t], st = ctab[(t - 1024) & 4095];
                    ore[j] = (yr4[d1][j] * ct + yi4[d1][j] * st) * 0.0625f; oim[j] = (yi4[d1][j] * ct - yr4[d1][j] * st) * 0.0625f; }
            h16* dst = Y1 + ((size_t)((b * 16 + d) * 512 + gk)) * 512 + 2 * ap;
            *(unsigned*)dst = pk2(ore[0], ore[1]); *(unsigned*)(dst + 256) = pk2(oim[0], oim[1]);
            }
        }
    }
    __syncthreads();
}

__device__ __forceinline__ void a1_prepass(const Params& p) {
    const int wave = threadIdx.x >> 6, lane = threadIdx.x & 63;
    const h16* OF = (const h16*)(p.ws + OFF_OF); const h16* OB = (const h16*)(p.ws + OFF_OB); h16* G = (h16*)(p.ws + OFF_G);
    const float* hgn = p.in[11];
    for (int t = blockIdx.x * 8 + wave; t < T; t += gridDim.x * 8) {
        const size_t off = (size_t)t * 512 + lane * 8;
        const h16x8 a = *(const h16x8*)(OF + off), bq = *(const h16x8*)(OB + off), g = *(const h16x8*)(G + off);
        float o[8]; float ss = 0.f;
#pragma unroll
        for (int j = 0; j < 8; ++j) { o[j] = (float)a[j] + (float)bq[j]; ss += o[j] * o[j]; }
        ss += __shfl_xor(ss, 1); ss += __shfl_xor(ss, 2); ss += __shfl_xor(ss, 4); ss += __shfl_xor(ss, 8);
        const float rstd = rsqrtf(ss * (1.0f / 128.0f) + EPS);
        float r[8];
#pragma unroll
        for (int j = 0; j < 8; ++j) r[j] = o[j] * rstd * hgn[lane * 8 + j] * (float)g[j];
        u32x4 w; w.x = pk2(r[0], r[1]); w.y = pk2(r[2], r[3]); w.z = pk2(r[4], r[5]); w.w = pk2(r[6], r[7]);
        *(u32x4*)(G + off) = w;
    }
}

__device__ __forceinline__ void convert_tables(const Params& p) {
    const int wave = threadIdx.x >> 6, lane = threadIdx.x & 63;
    for (int r2 = blockIdx.x * 8 + wave; r2 < 2 * 16384; r2 += gridDim.x * 8) {
        const int tb = r2 >> 14, e = r2 & 16383;
        const float* src = (tb ? p.in[18] : p.in[17]) + (size_t)e * D + lane * 16;
        f32x4 v[4]; float amax = 0.f;
#pragma unroll
        for (int j = 0; j < 4; ++j) { v[j] = *(const f32x4*)(src + 4 * j); amax = fmaxf(amax, fmaxf(fmaxf(fabsf(v[j].x), fabsf(v[j].y)), fmaxf(fabsf(v[j].z), fabsf(v[j].w)))); }
#pragma unroll
        for (int o = 32; o >= 1; o >>= 1) amax = fmaxf(amax, __shfl_xor(amax, o));
        const float qs = amax > 0.f ? amax * (1.0f / 127.0f) : 1.0f, inv = 1.0f / qs;
        const int bias = 0;
        u32x4 w;
#pragma unroll
        for (int j = 0; j < 4; ++j) { const int q0 = (int)rintf(v[j].x * inv) + bias, q1 = (int)rintf(v[j].y * inv) + bias, q2 = (int)rintf(v[j].z * inv) + bias, q3 = (int)rintf(v[j].w * inv) + bias;
            w[j] = (unsigned)(q0 & 255) | ((unsigned)(q1 & 255) << 8) | ((unsigned)(q2 & 255) << 16) | ((unsigned)(q3 & 255) << 24); }
        unsigned char* dst = p.ws + (tb ? OFF_TV : OFF_TU);
        *(u32x4*)(dst + ((size_t)(lane >> 3) * 16384 + e) * 128 + (lane & 7) * 16) = w;
        if (lane == 0) ((float*)(p.ws + (tb ? OFF_SV : OFF_SU)))[e] = qs;
    }
}

__device__ __forceinline__ unsigned f2key(float x) { const unsigned b = __builtin_bit_cast(unsigned, x); return b ^ ((b >> 31) ? 0xFFFFFFFFu : 0x80000000u); }
__device__ __forceinline__ float key2f(unsigned u) { const unsigned b = (u & 0x80000000u) ? (u ^ 0x80000000u) : ~u; return __builtin_bit_cast(float, b); }
__device__ __forceinline__ unsigned umax3(unsigned a, unsigned b, unsigned c) { return max(max(a, b), c); }
#define CE_DESC(a, b) do { const unsigned hi_ = max(a, b), lo_ = min(a, b); a = hi_; b = lo_; } while (0)
template <int N> __device__ __forceinline__ void sort16_desc(unsigned (&k)[N], const int base) {
#pragma unroll
    for (int size = 2; size <= 16; size *= 2)
#pragma unroll
        for (int stride = size / 2; stride > 0; stride /= 2)
#pragma unroll
            for (int i = 0; i < 16; ++i) { const int j = i ^ stride;
                if (j > i) { if ((i & size) == 0 || size == 16) CE_DESC(k[base + i], k[base + j]); else CE_DESC(k[base + j], k[base + i]); } }
}
template <int N> __device__ __forceinline__ void merge16_desc(unsigned (&k)[N], const int a, const int b) {
#pragma unroll
    for (int i = 0; i < 16; ++i) k[a + i] = max(k[a + i], k[b + 15 - i]);
#pragma unroll
    for (int stride = 8; stride > 0; stride /= 2)
#pragma unroll
        for (int i = 0; i < 16; ++i) if ((i & stride) == 0) CE_DESC(k[a + i], k[a + i + stride]);
}
__device__ __forceinline__ void top16_of_128(const float* sc, unsigned (&out)[16]) {
    unsigned s[128];
#pragma unroll
    for (int i = 0; i < 32; ++i) { const f32x4 t = *(const f32x4*)(sc + i * 4);
#pragma unroll
        for (int j = 0; j < 4; ++j) s[4 * i + j] = (f2key(t[j]) & ~127u) | (unsigned)(127 - (4 * i + j)); }
#pragma unroll
    for (int g = 0; g < 8; ++g) sort16_desc(s, 16 * g);
    merge16_desc(s, 0, 16); merge16_desc(s, 32, 48); merge16_desc(s, 64, 80); merge16_desc(s, 96, 112);
    merge16_desc(s, 0, 32); merge16_desc(s, 64, 96);
    merge16_desc(s, 0, 64);
#pragma unroll
    for (int i = 0; i < 16; ++i) out[i] = s[i];
}
__device__ __forceinline__ void topk_phase(const Params& p, LAS unsigned char* lds) {
    const float* SC = (const float*)(p.ws + OFF_SC); int* EIDX = (int*)(p.ws + OFF_EIDX); float* GATE = (float*)(p.ws + OFF_GATE);
    LAS unsigned* st = (LAS unsigned*)lds;
    const int tid = threadIdx.x;
#ifndef TOPK_REP
#define TOPK_REP 1
#endif
    for (int rr_ = 0; rr_ < TOPK_REP; ++rr_)
    for (int base = blockIdx.x * 256; base < T * 8; base += gridDim.x * 256) {
        {
            unsigned ks[16];
#pragma unroll
            for (int i = 0; i < 16; ++i) ks[i] = 0u;
            top16_of_128(SC + ((size_t)base * 2 + tid) * 128, ks);
#pragma unroll
            for (int i = 0; i < 16; ++i) st[i * NTHREADS + tid] = ks[i];
        }
        __syncthreads();
        if (tid < 256) {
            const int th = base + tid;
            float sv1[16];
#pragma unroll
            for (int j = 0; j < 16; ++j) sv1[j] = key2f(st[j * NTHREADS + 2 * tid + 1] & ~127u);
            unsigned cv[50];
            { int c = 0;
#pragma unroll
              for (int i = 0; i < 16; ++i) { const float a = key2f(st[i * NTHREADS + 2 * tid] & ~127u);
#pragma unroll
                  for (int j = 0; j < 16; ++j) if ((i + 1) * (j + 1) <= 16) { cv[c] = (f2key(a + sv1[j]) & ~255u) | (unsigned)(255 - (i * 16 + j)); ++c; } } }
            unsigned c64[64];
#pragma unroll
            for (int i = 0; i < 64; ++i) c64[i] = (i < 50) ? cv[i] : 0u;
#pragma unroll
            for (int g = 0; g < 4; ++g) sort16_desc(c64, 16 * g);
            merge16_desc(c64, 0, 16); merge16_desc(c64, 32, 48); merge16_desc(c64, 0, 32);
            unsigned ok[16];
#pragma unroll
            for (int i = 0; i < 16; ++i) ok[i] = c64[i];
            float ex[16]; int oe[16]; float den = 0.f;
            const float v0 = key2f(ok[0] & ~255u);
#pragma unroll
            for (int i = 0; i < 16; ++i) { const int ij = 255 - (int)(ok[i] & 255u), ci = ij >> 4, cj = ij & 15;
                const int e0 = 127 - (int)(st[ci * NTHREADS + 2 * tid] & 127u), e1 = 127 - (int)(st[cj * NTHREADS + 2 * tid + 1] & 127u);
                oe[i] = e0 * 128 + e1; ex[i] = __expf(key2f(ok[i] & ~255u) - v0); den += ex[i]; }
            const float inv = 1.0f / den;
#pragma unroll
            for (int i = 0; i < 4; ++i) {
                *(f32x4*)(GATE + (size_t)th * 16 + 4 * i) = (f32x4){ex[4 * i] * inv, ex[4 * i + 1] * inv, ex[4 * i + 2] * inv, ex[4 * i + 3] * inv};
                *(int4*)(EIDX + (size_t)th * 16 + 4 * i) = make_int4(oe[4 * i], oe[4 * i + 1], oe[4 * i + 2], oe[4 * i + 3]); }
        }
        __syncthreads();
    }
}

struct XcdInfo { int px, npop, rank, nloc; };
__device__ __forceinline__ float dot8(const h16x8 a, const h16x8 b, float s) {
    s = __builtin_amdgcn_fdot2((h16x2){a[0], a[1]}, (h16x2){b[0], b[1]}, s, false); s = __builtin_amdgcn_fdot2((h16x2){a[2], a[3]}, (h16x2){b[2], b[3]}, s, false);
    s = __builtin_amdgcn_fdot2((h16x2){a[4], a[5]}, (h16x2){b[4], b[5]}, s, false); s = __builtin_amdgcn_fdot2((h16x2){a[6], a[7]}, (h16x2){b[6], b[7]}, s, false); return s; }
struct PeerTok { int t; bool ok; };
#define PEER_TOUCH(R) do { unsigned tt_ = (R).w; asm volatile("" : "+v"(tt_)); (R).w = tt_; __builtin_amdgcn_sched_barrier(0); } while (0)
__device__ __forceinline__ PeerTok peer_tok(int i, int t0, int step) { const int t = t0 + i * step; PeerTok r; r.ok = t < T; r.t = r.ok ? t : (T - 1); return r; }
__device__ __forceinline__ void peer_ld_e(const int* EIDX, int t, int g, int (&e)[16]) {
#pragma unroll
    for (int q = 0; q < 4; ++q) { const int4 v = *(const int4*)(EIDX + (size_t)t * 128 + 16 * g + 4 * q); e[4 * q] = v.x; e[4 * q + 1] = v.y; e[4 * q + 2] = v.z; e[4 * q + 3] = v.w; } }
__device__ __forceinline__ void peer_ld_rows(const unsigned char* tab, const int (&e)[16], u32x4 (&r)[16]) {
#pragma unroll
    for (int j = 0; j < 16; ++j) r[j] = *(const u32x4*)(tab + (size_t)e[j] * 128); }
__device__ __forceinline__ void peer_u_compute(const u32x4 (&r)[16], const u32x4 xv, float* PACT, int s, PeerTok tk, int lane, int g, int c) {
    float pj[16];
#pragma unroll
    for (int j = 0; j < 16; ++j) { int d = __builtin_amdgcn_sdot4((int)r[j].x, (int)xv.x, 0, false); d = __builtin_amdgcn_sdot4((int)r[j].y, (int)xv.y, d, false);
        d = __builtin_amdgcn_sdot4((int)r[j].z, (int)xv.z, d, false); d = __builtin_amdgcn_sdot4((int)r[j].w, (int)xv.w, d, false); pj[j] = (float)d; }
#define RED_STEP(NIN, MASK) _Pragma("unroll") for (int j = 0; j < (NIN) / 2; ++j) { const bool up = (lane & (MASK)) != 0; \
    const float keep = up ? pj[2 * j + 1] : pj[2 * j], send = up ? pj[2 * j] : pj[2 * j + 1]; pj[j] = keep + __shfl_xor(send, (MASK)); }
    RED_STEP(16, 1) RED_STEP(8, 2) RED_STEP(4, 4)
#undef RED_STEP
    if (tk.ok) { float* po = PACT + ((size_t)s * T + tk.t) * 128 + 16 * g + c; po[0] = pj[0]; po[8] = pj[1]; }
}
__device__ __forceinline__ void peer_u_phase(const Params& p, const XcdInfo xi) {
    const int wave = threadIdx.x >> 6, lane = threadIdx.x & 63, g = lane >> 3, c = lane & 7;
    const unsigned char* QX = (const unsigned char*)(p.ws + OFF_QX); const unsigned char* TU = (const unsigned char*)(p.ws + OFF_TU);
    const int* EIDX = (const int*)(p.ws + OFF_EIDX); float* PACT = (float*)(p.ws + OFF_PACT);
    const int t0 = xi.rank * 8 + wave, step = xi.nloc * 8, ntok = (T - t0 + step - 1) / step;
    for (int s = xi.px; s < 8; s += xi.npop) {
        const unsigned char* tus = TU + (size_t)s * 16384 * 128 + 16 * c; const unsigned char* qxs = QX + s * 128 + 16 * c;
        int eN[16]; u32x4 rA[16], rB[16]; u32x4 xA, xB;
        { PeerTok k0 = peer_tok(0, t0, step); peer_ld_e(EIDX, k0.t, g, eN); xA = *(const u32x4*)(qxs + (size_t)k0.t * D); peer_ld_rows(tus, eN, rA);
          PeerTok k1 = peer_tok(1, t0, step); peer_ld_e(EIDX, k1.t, g, eN); }
        for (int i = 0; i < ntok; i += 2) {
            { const PeerTok k1 = peer_tok(i + 1, t0, step), k2 = peer_tok(i + 2, t0, step);
              PEER_TOUCH(rA[15]);
              xB = *(const u32x4*)(qxs + (size_t)k1.t * D); peer_ld_rows(tus, eN, rB); peer_ld_e(EIDX, k2.t, g, eN);
              __builtin_amdgcn_sched_barrier(0);
              peer_u_compute(rA, xA, PACT, s, peer_tok(i, t0, step), lane, g, c);
              __builtin_amdgcn_sched_barrier(0); }
            { const PeerTok k2 = peer_tok(i + 2, t0, step), k3 = peer_tok(i + 3, t0, step);
              PEER_TOUCH(rB[15]);
              xA = *(const u32x4*)(qxs + (size_t)k2.t * D); peer_ld_rows(tus, eN, rA); peer_ld_e(EIDX, k3.t, g, eN);
              __builtin_amdgcn_sched_barrier(0);
              PeerTok k1 = peer_tok(i + 1, t0, step); k1.ok = k1.ok && (i + 1 < ntok);
              peer_u_compute(rB, xB, PACT, s, k1, lane, g, c);
              __builtin_amdgcn_sched_barrier(0); }
        }
    }
}
__device__ __forceinline__ void peer_combine(const Params& p) {
    const int wave = threadIdx.x >> 6, lane = threadIdx.x & 63;
    const float* PACT = (const float*)(p.ws + OFF_PACT); const float* GATE = (const float*)(p.ws + OFF_GATE); unsigned char* SIDE = p.ws + OFF_SIDE;
    const int* EIDX = (const int*)(p.ws + OFF_EIDX); const float* SU = (const float*)(p.ws + OFF_SU); const float* SV = (const float*)(p.ws + OFF_SV); const float* SX = (const float*)(p.ws + OFF_SX);
    for (int t = blockIdx.x * 8 + wave; t < T; t += gridDim.x * 8) {
        const float sx = SX[t]; float w[2]; int e[2]; float amax = 0.f;
#pragma unroll
        for (int j = 0; j < 2; ++j) { const int k = lane + 64 * j; float a = 0.f;
#pragma unroll
            for (int s = 0; s < 8; ++s) a += PACT[((size_t)s * T + t) * 128 + k];
            e[j] = EIDX[(size_t)t * 128 + k];
            const float act = a * sx * SU[e[j]];
            w[j] = GATE[(size_t)t * 128 + k] * (0.5f * act * (1.0f + erff(act * 0.70710678118654752f))) * SV[e[j]];
            amax = fmaxf(amax, fabsf(w[j])); }
#pragma unroll
        for (int o = 32; o >= 1; o >>= 1) amax = fmaxf(amax, __shfl_xor(amax, o));
        const float inv = amax > 0.f ? 16256.0f / amax : 0.f;
        unsigned char* rec = SIDE + (size_t)t * 1024;
#pragma unroll
        for (int j = 0; j < 2; ++j) { const int k = lane + 64 * j; const int W = (int)rintf(w[j] * inv); const int hi = W >> 7, lo = W & 127;
            const int y = k >> 4, ks = (k >> 3) & 1, h = (k >> 2) & 1, gk = k & 3, off = 512 + ks * 128 + gk * 16 + 8 * h + y;
            ((int*)rec)[k] = e[j]; rec[off] = (unsigned char)(hi & 255); rec[off + 64] = (unsigned char)lo; }
        if (lane == 0) *(float*)(rec + 768) = amax * (1.0f / 16256.0f);
    }
}
typedef int i32x4 __attribute__((ext_vector_type(4)));
__device__ __forceinline__ unsigned lds_addr(const volatile LAS void* p) { return (unsigned)(size_t)p; }
__device__ __forceinline__ void glds16_asm(const void* gsrc, unsigned lds_dst) {
    unsigned keep;
    asm volatile("s_mov_b32 %0, m0\n\ts_mov_b32 m0, %2\n\ts_nop 0\n\tglobal_load_lds_dwordx4 %1, off\n\ts_mov_b32 m0, %0" : "=&s"(keep) : "v"(gsrc), "s"(lds_dst) : "memory");
}
#define PV_WAIT_VM(n) asm volatile("s_waitcnt vmcnt(" #n ")" ::: "memory")
__device__ __forceinline__ void pv_fill(const unsigned char* tvs, LAS unsigned char* lds, unsigned side_slot, unsigned ring_buf, const int ks, int lane) {
    const int g = lane >> 3;
    const u32x4 i0 = *(LAS u32x4*)(lds + side_slot + (16 * g + 8 * ks) * 4), i1 = *(LAS u32x4*)(lds + side_slot + (16 * g + 8 * ks + 4) * 4);
    const unsigned ids[8] = {i0.x, i0.y, i0.z, i0.w, i1.x, i1.y, i1.z, i1.w};
#pragma unroll
    for (int m = 0; m < 8; ++m) glds16_asm(tvs + (size_t)ids[m] * 128 + ((((lane & 7) ^ g ^ (m & 1))) << 4), ring_buf + m * 1024);
}
__device__ __forceinline__ void pv_kstep(LAS unsigned char* lds, unsigned ring_buf, const i32x4 afrag, i32x4 (&acc)[8], int lane) {
    const int gk = lane >> 4, q = (lane & 15) >> 1, pp = lane & 1;
    const unsigned base0 = ring_buf + (8 * gk + q) * 128 + 8 * pp;
    const int xr = q ^ (gk & 1);
#pragma unroll
    for (int ng = 0; ng < 2; ++ng) {
        u32x2 r[8];
#pragma unroll
        for (int j = 0; j < 4; ++j) { const int n = 4 * ng + j;
#pragma unroll
            for (int h = 0; h < 2; ++h) { const unsigned a = base0 + h * 4096 + (((unsigned)(n ^ xr)) << 4);
                asm volatile("ds_read_b64_tr_b8 %0, %1" : "=v"(r[2 * j + h]) : "v"(a) : "memory"); } }
        asm volatile("s_waitcnt lgkmcnt(0)" : "+v"(r[0]), "+v"(r[1]), "+v"(r[2]), "+v"(r[3]), "+v"(r[4]), "+v"(r[5]), "+v"(r[6]), "+v"(r[7]) :: "memory");
        __builtin_amdgcn_sched_barrier(0);
#pragma unroll
        for (int j = 0; j < 4; ++j) { const i32x4 bf = (i32x4){(int)r[2 * j].x, (int)r[2 * j].y, (int)r[2 * j + 1].x, (int)r[2 * j + 1].y};
            acc[4 * ng + j] = __builtin_amdgcn_mfma_i32_16x16x64_i8(afrag, bf, acc[4 * ng + j], 0, 0, 0); }
    }
}
__device__ __forceinline__ void peer_v_phase(const Params& p, LAS unsigned char* lds, const XcdInfo xi) {
    const int wave = __builtin_amdgcn_readfirstlane(threadIdx.x >> 6), lane = threadIdx.x & 63;
    const unsigned char* TV = p.ws + OFF_TV; const unsigned char* SIDE = p.ws + OFF_SIDE; float* PO = (float*)(p.ws + OFF_PO);
    const int t0 = xi.rank * 8 + wave, step = xi.nloc * 8, ntok = (T - t0 + step - 1) / step;
    const unsigned ring = __builtin_amdgcn_readfirstlane(lds_addr(lds + wave * 16384)), side = __builtin_amdgcn_readfirstlane(lds_addr(lds + 131072 + wave * 3072));
    LAS unsigned char* l0 = (LAS unsigned char*)0;
    for (int s = xi.px; s < 8; s += xi.npop) {
        const unsigned char* tvs = TV + (size_t)s * 16384 * 128;
        glds16_asm(SIDE + (size_t)peer_tok(0, t0, step).t * 1024 + lane * 16, side);
        glds16_asm(SIDE + (size_t)peer_tok(1, t0, step).t * 1024 + lane * 16, side + 1024);
        PV_WAIT_VM(0);
        pv_fill(tvs, l0, side, ring, 0, lane); pv_fill(tvs, l0, side, ring + 8192, 1, lane);
        for (int i = 0; i < ntok; ++i) {
            const unsigned sl_cur = side + (unsigned)(i % 3) * 1024, sl_nxt = side + (unsigned)((i + 1) % 3) * 1024, sl_nn = side + (unsigned)((i + 2) % 3) * 1024;
            i32x4 acc[8];
#pragma unroll
            for (int n = 0; n < 8; ++n) acc[n] = (i32x4){0, 0, 0, 0};
            if (i == 0) PV_WAIT_VM(8); else PV_WAIT_VM(16);
            const int fi = lane & 15;
            const i32x4 z4 = (i32x4){0, 0, 0, 0};
            i32x4 af = *(LAS i32x4*)(l0 + sl_cur + 512 + (fi < 2 ? fi : 0) * 64 + (lane >> 4) * 16); af = fi < 2 ? af : z4;
            pv_kstep(l0, ring, af, acc, lane);
            glds16_asm(SIDE + (size_t)peer_tok(i + 2, t0, step).t * 1024 + lane * 16, sl_nn);
            pv_fill(tvs, l0, sl_nxt, ring, 0, lane);
            PV_WAIT_VM(9);
            af = *(LAS i32x4*)(l0 + sl_cur + 512 + 128 + (fi < 2 ? fi : 0) * 64 + (lane >> 4) * 16); af = fi < 2 ? af : z4;
            pv_kstep(l0, ring + 8192, af, acc, lane);
            const float sw = *(LAS float*)(l0 + sl_cur + 768);
            const PeerTok tk = peer_tok(i, t0, step);
            float* po = PO + (size_t)(tk.ok ? tk.t : T) * D + s * 128 + (lane & 15);
            if (lane < 16) {
#pragma unroll
                for (int n = 0; n < 8; ++n) { const float v = (float)(128 * acc[n][0] + acc[n][1]) * sw;
                    asm volatile("global_store_dword %0, %1, off" :: "v"(po + 16 * n), "v"(v) : "memory"); }
            }
            pv_fill(tvs, l0, sl_nxt, ring + 8192, 1, lane);
        }
        PV_WAIT_VM(0);
    }
}
__device__ __forceinline__ void peer_final(const Params& p) {
    const int wave = threadIdx.x >> 6, lane = threadIdx.x & 63;
    float* OUT = p.out; const float* PO = (const float*)(p.ws + OFF_PO); const float* mod = (const float*)(p.ws + OFF_MOD); const float* fg = p.in[19];
    for (int t = blockIdx.x * 8 + wave; t < T; t += gridDim.x * 8) {
        f32x4 h2[4]; float ss = 0.f;
#pragma unroll
        for (int j = 0; j < 4; ++j) { const int cc = j * 256 + lane * 4;
            const f32x4 hv = *(const f32x4*)(OUT + (size_t)t * D + cc), pv = *(const f32x4*)(PO + (size_t)t * D + cc), gv = *(const f32x4*)(mod + (t >> 12) * 6144 + 5120 + cc);
            h2[j] = hv + gv * pv; ss += h2[j].x * h2[j].x + h2[j].y * h2[j].y + h2[j].z * h2[j].z + h2[j].w * h2[j].w; }
        ss = wave_sum(ss);
        const float rstd = rsqrtf(ss * (1.0f / D) + EPS);
#pragma unroll
        for (int j = 0; j < 4; ++j) { const int cc = j * 256 + lane * 4; const f32x4 fv = *(const f32x4*)(fg + cc);
            *(f32x4*)(OUT + (size_t)t * D + cc) = h2[j] * rstd * fv; }
    }
}
#ifndef REP_A
#define REP_A 1
#endif
#ifndef REP_FT
#define REP_FT 1
#endif
#ifndef REP_DFT
#define REP_DFT 1
#endif
#ifndef REP_GATE
#define REP_GATE 1
#endif
constexpr int N_PHASES = 15;
#ifndef MK_CGSYNC
#define MK_CGSYNC 0
#endif
__device__ __forceinline__ Params load_params(volatile LAS unsigned* pw) {
    Params q;
    unsigned long long v[22];
#pragma unroll
    for (int i = 0; i < 22; ++i) { const unsigned lo = (unsigned)__builtin_amdgcn_readfirstlane((int)pw[2 * i]), hi = (unsigned)__builtin_amdgcn_readfirstlane((int)pw[2 * i + 1]); v[i] = ((unsigned long long)hi << 32) | lo; }
#pragma unroll
    for (int i = 0; i < 20; ++i) q.in[i] = (const float*)v[i];
    q.out = (float*)v[20]; q.ws = (unsigned char*)v[21];
    q.ph_lo = __builtin_amdgcn_readfirstlane((int)pw[44]); q.ph_hi = __builtin_amdgcn_readfirstlane((int)pw[45]);
    return q;
}
__global__ void __launch_bounds__(NTHREADS, 2) mega(Params pk) {
    extern __shared__ __attribute__((aligned(16))) unsigned char smem[];
    LAS unsigned char* lds = (LAS unsigned char*)smem;
    const int G = gridDim.x, c = blockIdx.x;
    volatile LAS unsigned* pw = (volatile LAS unsigned*)(lds + LDS_BYTES - 512);
    if (threadIdx.x == 0) {
#pragma unroll
        for (int i = 0; i < 20; ++i) { const unsigned long long v = (unsigned long long)pk.in[i]; pw[2 * i] = (unsigned)v; pw[2 * i + 1] = (unsigned)(v >> 32); }
        { const unsigned long long v = (unsigned long long)pk.out; pw[40] = (unsigned)v; pw[41] = (unsigned)(v >> 32); }
        { const unsigned long long v = (unsigned long long)pk.ws; pw[42] = (unsigned)v; pw[43] = (unsigned)(v >> 32); }
        pw[44] = (unsigned)pk.ph_lo; pw[45] = (unsigned)pk.ph_hi;
    }
    unsigned* ctl = (unsigned*)(pk.ws + OFF_CTL);
    volatile LAS unsigned* misc = (volatile LAS unsigned*)(lds + LDS_BYTES - 64);
    if (threadIdx.x < 16) misc[threadIdx.x] = 0u;
    __syncthreads();
    const bool fused = (pk.ph_hi - pk.ph_lo) > 1;
    XcdBarrier bar; bar.bar = ctl; bar.x = 0; bar.st = misc;
    if (fused) {
        bar = xcd_barrier_post(ctl, misc);
        if (threadIdx.x == 0) misc[2] = xb_add(&ctl[CTL_RANK + 64 * bar.x], 1u);
    }
#define IN(k) (ph_lo <= (k) && (k) < ph_hi)
#if MK_CGSYNC
#define SEAM(k) do { if (IN(k) && IN((k) + 1)) { cg::grid_group grid = cg::this_grid(); grid.sync(); } } while (0)
#else
#define SEAM(k) do { if (IN(k) && IN((k) + 1)) xcd_barrier(bar); } while (0)
#endif
#define PHASE_BEGIN(k) if (IN(k)) { const Params p = load_params(pw); unsigned char* const ws = p.ws; (void)ws;
#define PHASE_END(k) } SEAM(k);
    const int ph_lo = pk.ph_lo, ph_hi = pk.ph_hi;
    PHASE_BEGIN(0) phase0(p, lds); PHASE_END(0)
    PHASE_BEGIN(1)
        const float* mod = (const float*)(ws + OFF_MOD);
        modulate_rows(p.in[0], (h16*)(ws + OFF_UALL), T, p.in[6], mod, 0, 1024, 0);
        modulate_rows(p.in[2], (h16*)(ws + OFF_UALL) + (size_t)T * D, TC, p.in[6], mod, 0, 1024, 1);
    PHASE_END(1)
    PHASE_BEGIN(2)
        { pg8::Gemm g{ws + OFF_UALL, ws + OFF_WA, 1024, 1024, 1024}; OrderA S; S.init(G, c, REP_A); EpiA E{ws}; pg8::gemm_phase(lds, g, S, E); }
        { pg8::Gemm g{ws + OFF_UALL, ws + OFF_WF, 1024, 1024, 1024}; pg8::TileOrder S; S.init(128, 4, G, c, REP_FT); EpiFT E{ws}; pg8::gemm_phase(lds, g, S, E); }
    PHASE_END(2)
    PHASE_BEGIN(3) for (int it = blockIdx.x; it < 192; it += gridDim.x) hgrn_mfma_unit<false>(p, lds, it / 3, it % 3);
        fft1_phase(p, lds, (int)((blockIdx.x + 64u) % gridDim.x), gridDim.x); convert_tables(p); PHASE_END(3)
    PHASE_BEGIN(4) for (int it = blockIdx.x; it < 256; it += gridDim.x) hgrn_mfma_unit<true>(p, lds, it >> 2, it & 3); PHASE_END(4)
    PHASE_BEGIN(5)
        { pg8::Gemm g{ws + OFF_DFT256, ws + OFF_Y1, 512, 512, 512}; pg8::TileOrder S; S.init(1, 256, G, c, REP_DFT); EpiDFT E{ws}; pg8::gemm_phase(lds, g, S, E); }
        { pg8::Gemm g{ws + OFF_UALL, ws + OFF_WG, 1024, 1024, 1024}; pg8::TileOrder S; S.init(128, 8, G, c, REP_GATE); EpiGate E{ws}; pg8::gemm_phase(lds, g, S, E); }
        a1_prepass(p);
    PHASE_END(5)
    PHASE_BEGIN(6)
        { pg8::Gemm g{ws + OFF_G, ws + OFF_WHG, 512, 512, 512}; pg8::TileOrder S; S.init(128, 4, G, c); EpiMerge1<false> E{ws}; pg8::gemm_phase(lds, g, S, E); }
        { pg8::Gemm g{ws + OFF_YFT, ws + OFF_WFT, 512, 512, 512}; pg8::TileOrder S; S.init(128, 4, G, c); EpiMerge1<true> E{ws}; pg8::gemm_phase(lds, g, S, E); }
    PHASE_END(6)
    PHASE_BEGIN(7)
        pg8::Gemm g{ws + OFF_Y, ws + OFF_WOUT, 1024, 1024, 1024}; pg8::TileOrder S; S.init(128, 4, G, c);
        EpiMerge2 E{p.in[0], p.out, (const float*)(ws + OFF_MOD)}; pg8::gemm_phase(lds, g, S, E);
    PHASE_END(7)
    PHASE_BEGIN(8) modulate_rows(p.out, (h16*)(ws + OFF_U2), T, p.in[7], (const float*)(ws + OFF_MOD), 3072, 4096, 0, (signed char*)(ws + OFF_QX), (float*)(ws + OFF_SX)); PHASE_END(8)
    PHASE_BEGIN(9)
        pg8::Gemm g{ws + OFF_U2, ws + OFF_WS, 1024, 1024, 1024}; pg8::TileOrder S; S.init(128, 8, G, c);
        EpiF32 E{(float*)(ws + OFF_SC), 2048}; pg8::gemm_phase(lds, g, S, E);
    PHASE_END(9)
    PHASE_BEGIN(10) topk_phase(p, lds); PHASE_END(10)
    XcdInfo xi;
    if (fused) {
        unsigned cnt[8]; int npop = 0, px = 0;
#pragma unroll
        for (int j = 0; j < 8; ++j) { cnt[j] = xb_ld(&ctl[CTL_RANK + 64 * j]); if (j < (int)(bar.x & 7u)) px += (cnt[j] > 0u); npop += (cnt[j] > 0u); }
        xi.px = px; xi.npop = npop > 0 ? npop : 1; xi.rank = (int)misc[2]; xi.nloc = (int)cnt[bar.x & 7u]; if (xi.nloc < 1) xi.nloc = 1;
    } else { xi.px = c & 7; xi.npop = 8; xi.rank = c >> 3; xi.nloc = G >> 3; }
    PHASE_BEGIN(11) peer_u_phase(p, xi); PHASE_END(11)
    PHASE_BEGIN(12) peer_combine(p); PHASE_END(12)
    PHASE_BEGIN(13) peer_v_phase(p, lds, xi); PHASE_END(13)
    PHASE_BEGIN(14) peer_final(p); }
#undef IN
#undef SEAM
#undef PHASE_BEGIN
#undef PHASE_END
}

#ifndef MK_SINGLE
#define MK_SINGLE 1
#endif
extern "C" void kernel_launch(void* const* d_in, const int* in_sizes, int n_in, void* d_out, int out_size, void* d_ws, size_t ws_size, hipStream_t stream) {
    static int grid = 0;
    if (grid == 0) {
        if (n_in != 20 || out_size != T * D || ws_size < WS_NEED) { fprintf(stderr, "kernel_launch: unexpected shapes (n_in %d out %d ws %zu)\n", n_in, out_size, ws_size); grid = -1; return; }
        int dev = 0, cus = 0, per_cu = 0;
        hipGetDevice(&dev); hipDeviceGetAttribute(&cus, hipDeviceAttributeMultiprocessorCount, dev);
        if (hipFuncSetAttribute((const void*)mega, hipFuncAttributeMaxDynamicSharedMemorySize, LDS_BYTES) != hipSuccess) { fprintf(stderr, "kernel_launch: hipFuncSetAttribute failed\n"); grid = -1; return; }
        hipOccupancyMaxActiveBlocksPerMultiprocessor(&per_cu, (const void*)mega, NTHREADS, LDS_BYTES);
        if (per_cu < 1) { fprintf(stderr, "kernel_launch: occupancy query says %d blocks per CU\n", per_cu); grid = -1; return; }
        grid = cus;
    }
    if (grid < 0) return;
    if (hipMemsetAsync((char*)d_ws + OFF_CTL, 0, CTL_ZERO_BYTES, stream) != hipSuccess) { fprintf(stderr, "kernel_launch: memset failed\n"); return; }
    Params p{};
    for (int i = 0; i < 20; ++i) p.in[i] = (const float*)d_in[i];
    p.out = (float*)d_out; p.ws = (unsigned char*)d_ws;
#if MK_SINGLE
    p.ph_lo = 0; p.ph_hi = N_PHASES;
    void* args[] = {&p};
    hipError_t e = hipLaunchCooperativeKernel((const void*)mega, dim3(grid), dim3(NTHREADS), args, LDS_BYTES, stream);
    if (e != hipSuccess) fprintf(stderr, "cooperative launch failed: %s (grid %d)\n", hipGetErrorString(e), grid);
#else
    for (int ph = 0; ph < N_PHASES; ++ph) { p.ph_lo = ph; p.ph_hi = ph + 1; hipLaunchKernelGGL(mega, dim3(grid), dim3(NTHREADS), LDS_BYTES, stream, p); }
#endif
}
```

```cpp
#include <hip/hip_runtime.h>
#include <hip/hip_cooperative_groups.h>
#include <cstdio>
#include <cstdint>
namespace cg = cooperative_groups;
#define LAS __attribute__((address_space(3)))
namespace pg8 {
#define PG8_LAS __attribute__((address_space(3)))
typedef _Float16 f16x8 __attribute__((ext_vector_type(8)));
typedef float f32x4 __attribute__((ext_vector_type(4)));
typedef unsigned u32x4 __attribute__((ext_vector_type(4)));
typedef unsigned u32x2 __attribute__((ext_vector_type(2)));
constexpr int BM = 256, BK = 64, HALF = 128, HTB = HALF * BK * 2, STAGE_BYTES = 8 * HTB, NXCD = 8, WGM = 8;

__host__ __device__ __forceinline__ int lds_byte(int r, int c) { const int st = (r >> 4) * 2 + (c >> 5), rr = r & 15, cc = c & 31, ob = rr * 64 + cc * 2; return st * 1024 + (ob ^ (((ob >> 9) & 1) << 5)); }
__host__ __device__ __forceinline__ void stage_rc(int b, int& R, int& C) { const int st = b / 1024, sb = b % 1024, swz = sb ^ (((sb >> 9) & 1) << 5); R = (st >> 1) * 16 + swz / 64; C = (st & 1) * 32 + (swz % 64) / 2; }
__host__ __device__ __forceinline__ int perm32(int rho) { const int n = rho >> 4, i = rho & 15; return 8 * (i >> 2) + 4 * n + (i & 3); }

struct Unit { int pm, pn; };
struct Gemm { const void* A; const void* Bt; int lda, ldb, K; };

struct TileOrder {
    int nM, nN, nwg, G, c, rep;
    __device__ void init(int nM_, int nN_, int G_, int c_, int rep_ = 1) { nM = nM_; nN = nN_; nwg = nM * nN; G = G_; c = c_; rep = rep_; }
    __device__ bool map(long L, Unit& u) const {
        if (L >= nwg) return false;
        int wgid = (int)L; { const int q = nwg / NXCD, r = nwg % NXCD, xcd = wgid % NXCD, off = wgid / NXCD; wgid = (xcd < r ? xcd * (q + 1) : r * (q + 1) + (xcd - r) * q) + off; }
        const int nig = WGM * nN, gid = wgid / nig, fm = gid * WGM, gsz = (nM - fm) < WGM ? (nM - fm) : WGM;
        u.pm = fm + ((wgid % nig) % gsz); u.pn = (wgid % nig) / gsz; return true;
    }
    __device__ bool next(int i, Unit& u) const { const long L = (long)i * G + c; if (L >= (long)nwg * rep) return false; return map(L % nwg, u); }
};

template <class Epi, class Sched>
__device__ __forceinline__ void gemm_phase(PG8_LAS unsigned char* lds, const Gemm g, const Sched& S, const Epi& E) {
    const int tid = threadIdx.x, wid = __builtin_amdgcn_readfirstlane(tid >> 6), lane = tid & 63, wr = wid >> 2, wc = wid & 3, fr = lane & 15, fq = lane >> 4;
    const int K = g.K, nt = K / BK;
    unsigned voffA[2], voffB[2];
#pragma unroll
    for (int i = 0; i < 2; ++i) { int R, C; stage_rc(tid * 16 + i * 8192, R, C); const int Rb = Epi::PERM ? ((R & ~31) + perm32(R & 31)) : R;
        voffA[i] = (unsigned)(R * g.lda + C) * 2u; voffB[i] = (unsigned)(Rb * g.ldb + C) * 2u; }
    const size_t kstep = (size_t)(BK * 2);
    const size_t hstepA = (size_t)HALF * g.lda * 2, hstepB = (size_t)HALF * g.ldb * 2;
    const size_t tstepA = 2 * hstepA, tstepB = 2 * hstepB;
    const unsigned ldsw = (unsigned)wid * 1024u;
    const int aoff = lds_byte(wr * 64 + fr, fq * 8), boff = lds_byte(wc * 32 + fr, fq * 8);
#define PG8_SA(b, h) (((b) * 2 + (h)) * HTB)
#define PG8_SB(b, h) ((4 + (b) * 2 + (h)) * HTB)
#define PG8_STAGE(bufoff, gbase, voff) do { _Pragma("unroll") for (int _i = 0; _i < 2; ++_i) \
        __builtin_amdgcn_global_load_lds((const unsigned*)((const char*)(gbase) + (voff)[_i]), (PG8_LAS unsigned*)(lds + (bufoff) + ldsw + _i * 8192), 16, 0, 0); } while (0)
#define PG8_LDA(dst, b, h) do { _Pragma("unroll") for (int m = 0; m < 4; ++m) _Pragma("unroll") for (int k = 0; k < 2; ++k) dst[m][k] = *(const PG8_LAS f16x8*)(lds + PG8_SA(b, h) + aoff + m * 2048 + k * 1024); } while (0)
#define PG8_LDB(dst, b, h) do { _Pragma("unroll") for (int n = 0; n < 2; ++n) _Pragma("unroll") for (int k = 0; k < 2; ++k) dst[n][k] = *(const PG8_LAS f16x8*)(lds + PG8_SB(b, h) + boff + n * 2048 + k * 1024); } while (0)
#define PG8_MMA(ai, bj, At, Bt) do { __builtin_amdgcn_s_setprio(1); _Pragma("unroll") for (int m = 0; m < 4; ++m) _Pragma("unroll") for (int n = 0; n < 2; ++n) _Pragma("unroll") for (int k = 0; k < 2; ++k) \
        acc[ai][bj][m][n] = Epi::TRANS ? __builtin_amdgcn_mfma_f32_16x16x32_f16(Bt[n][k], At[m][k], acc[ai][bj][m][n], 0, 0, 0) \
                                       : __builtin_amdgcn_mfma_f32_16x16x32_f16(At[m][k], Bt[n][k], acc[ai][bj][m][n], 0, 0, 0); __builtin_amdgcn_s_setprio(0); } while (0)
#define PG8_WAIT_V(n) asm volatile("s_waitcnt vmcnt(" #n ")" ::: "memory")
#define PG8_WAIT_L(n) asm volatile("s_waitcnt lgkmcnt(" #n ")" ::: "memory")
#define PG8_WAIT_VN(n) asm volatile("s_waitcnt vmcnt(%0)" :: "n"(n) : "memory")
#define PG8_BAR __builtin_amdgcn_s_barrier()
#define PG8_SCHED __builtin_amdgcn_sched_barrier(0)
    Unit cur, nxt; int ui = 0;
    if (!S.next(0, cur)) return;
    f32x4 acc[2][2][4][2];
#pragma unroll
    for (int a = 0; a < 2; ++a)
#pragma unroll
        for (int b = 0; b < 2; ++b)
#pragma unroll
            for (int m = 0; m < 4; ++m)
#pragma unroll
                for (int n = 0; n < 2; ++n) acc[a][b][m][n] = (f32x4){0.f, 0.f, 0.f, 0.f};
    f16x8 At[4][2], B0[2][2], B1[2][2];
    const char* cA = (const char*)g.A + (size_t)cur.pm * tstepA; const char* cB = (const char*)g.Bt + (size_t)cur.pn * tstepB + E.boff(cur);
    E.init(acc, cur, wr, wc, fr, fq);
    PG8_STAGE(PG8_SB(0, 0), cB, voffB); PG8_STAGE(PG8_SA(0, 0), cA, voffA); PG8_STAGE(PG8_SB(0, 1), cB + hstepB, voffB); PG8_STAGE(PG8_SA(0, 1), cA + hstepA, voffA);
    if (wr == 1) PG8_BAR;
    PG8_WAIT_V(4); PG8_BAR;
    PG8_STAGE(PG8_SB(1, 0), cB + kstep, voffB); PG8_STAGE(PG8_SA(1, 0), cA + kstep, voffA); PG8_STAGE(PG8_SB(1, 1), cB + hstepB + kstep, voffB); PG8_STAGE(PG8_SA(1, 1), cA + hstepA + kstep, voffA);
    PG8_WAIT_V(8); PG8_BAR;
    for (;;) {
        const bool has_next = S.next(ui + 1, nxt);
        const char* nA = has_next ? (const char*)g.A + (size_t)nxt.pm * tstepA : cA; const char* nB = has_next ? (const char*)g.Bt + (size_t)nxt.pn * tstepB + E.boff(nxt) : cB;
        for (int t = 0; t < nt; t += 2) {
            const bool last = (t == nt - 2);
            const char* a2 = last ? nA : cA + (size_t)(t + 2) * kstep; const char* b2 = last ? nB : cB + (size_t)(t + 2) * kstep;
            const char* a3 = a2 + kstep; const char* b3 = b2 + kstep;
            PG8_LDB(B0, 0, 0); PG8_SCHED; PG8_LDA(At, 0, 0);
            PG8_WAIT_L(8); PG8_BAR; PG8_WAIT_L(0); PG8_MMA(0, 0, At, B0); PG8_BAR; PG8_SCHED;
            PG8_LDB(B1, 0, 1); PG8_STAGE(PG8_SB(0, 0), b2, voffB);
            PG8_BAR; PG8_WAIT_L(0); PG8_MMA(0, 1, At, B1); PG8_BAR;
            PG8_LDA(At, 0, 1); PG8_STAGE(PG8_SA(0, 0), a2, voffA);
            PG8_BAR; PG8_WAIT_L(0); PG8_MMA(1, 0, At, B0); PG8_BAR; PG8_SCHED;
            PG8_STAGE(PG8_SB(0, 1), b2 + hstepB, voffB);
            { const int lax_ = __builtin_amdgcn_readfirstlane((int)((t == 0) & (ui != 0)));
              asm volatile("s_cmp_eq_u32 %0, 0\n\ts_cbranch_scc1 1f\n\ts_waitcnt vmcnt(%1)\n\ts_branch 2f\n1:\n\ts_waitcnt vmcnt(6)\n2:" :: "s"(lax_), "n"(6 + Epi::NST) : "memory", "scc"); }
            PG8_BAR; PG8_MMA(1, 1, At, B1); PG8_BAR;
            PG8_LDB(B0, 1, 0); PG8_SCHED; PG8_LDA(At, 1, 0); PG8_STAGE(PG8_SA(0, 1), a2 + hstepA, voffA);
            PG8_WAIT_L(8); PG8_BAR; PG8_WAIT_L(0); PG8_MMA(0, 0, At, B0); PG8_BAR; PG8_SCHED;
            PG8_LDB(B1, 1, 1); PG8_STAGE(PG8_SB(1, 0), b3, voffB);
            PG8_BAR; PG8_WAIT_L(0); PG8_MMA(0, 1, At, B1); PG8_BAR;
            PG8_LDA(At, 1, 1); PG8_STAGE(PG8_SA(1, 0), a3, voffA);
            PG8_BAR; PG8_WAIT_L(0); PG8_MMA(1, 0, At, B0); PG8_BAR; PG8_SCHED;
            PG8_STAGE(PG8_SB(1, 1), b3 + hstepB, voffB);
            PG8_WAIT_V(6); PG8_BAR; PG8_MMA(1, 1, At, B1); PG8_BAR;
            PG8_STAGE(PG8_SA(1, 1), a3 + hstepA, voffA);
        }
        if constexpr (Epi::FUSED) {
            E.fused(acc, cur, nxt, has_next, wr, wc, fr, fq);
            if (!has_next) break;
            cur = nxt; cA = nA; cB = nB; ++ui;
        } else {
            E(acc, cur, wr, wc, fr, fq);
            if (!has_next) break;
#pragma unroll
            for (int a = 0; a < 2; ++a)
#pragma unroll
                for (int b = 0; b < 2; ++b)
#pragma unroll
                    for (int m = 0; m < 4; ++m)
#pragma unroll
                        for (int n = 0; n < 2; ++n) acc[a][b][m][n] = (f32x4){0.f, 0.f, 0.f, 0.f};
            cur = nxt; cA = nA; cB = nB; ++ui;
            E.init(acc, cur, wr, wc, fr, fq);
        }
    }
    PG8_WAIT_V(0);
    if (wr == 0) PG8_BAR;
    PG8_BAR;
#undef PG8_SA
#undef PG8_SB
#undef PG8_STAGE
#undef PG8_LDA
#undef PG8_LDB
#undef PG8_MMA
#undef PG8_WAIT_V
#undef PG8_WAIT_VN
#undef PG8_WAIT_L
#undef PG8_BAR
#undef PG8_SCHED
}
}
#define XB_TMO      128
#define XB_XCNT(j)  (256  + 64 * (j))
#define XB_XSUB(j)  (1280 + 64 * (j))
#define XB_XGEN(j)  (2304 + 64 * (j))
#define XB_TOP      3328
#define XB_TOPGEN   3392
#define XCD_BAR_WORDS 3456
#define XB_SPIN_CAP (1u << 20)


__device__ __forceinline__ unsigned xb_ld(unsigned* p)              { return __hip_atomic_load(p, __ATOMIC_RELAXED, __HIP_MEMORY_SCOPE_AGENT); }
__device__ __forceinline__ unsigned xb_add(unsigned* p, unsigned v) { return __hip_atomic_fetch_add(p, v, __ATOMIC_RELAXED, __HIP_MEMORY_SCOPE_AGENT); }
__device__ __forceinline__ unsigned xb_xcc_id() { return (unsigned)__builtin_amdgcn_s_getreg((3 << 11) | 20) & 0xFu; }
#define XB_SPIN(cond, bar) do { unsigned _sp = 0; while (cond) { __builtin_amdgcn_s_sleep(1); \
    if ((++_sp & 255u) == 0u) { if (xb_ld(&(bar)[XB_TMO])) break; if (_sp > XB_SPIN_CAP) { atomicAdd(&(bar)[XB_TMO], 1u); break; } } } } while (0)

struct XcdBarrier {
    unsigned* bar; unsigned x;
    volatile LAS unsigned* st;
};

__device__ __forceinline__ XcdBarrier xcd_barrier_post(unsigned* bar, volatile LAS unsigned* st) {
    XcdBarrier b; b.bar = bar; b.x = xb_xcc_id(); b.st = st;
    if (threadIdx.x == 0) (void)xb_add(&bar[XB_XCNT(b.x)], 1u);
    return b;
}
__device__ __forceinline__ void xcd_barrier_complete(unsigned* bar, unsigned x, unsigned& nloc, unsigned& nx) {
    const unsigned G = gridDim.x * gridDim.y * gridDim.z;
    unsigned sum, cnt, mine, sp = 0u;
    for (;;) {
        sum = 0u; cnt = 0u; mine = 0u;
#pragma unroll
        for (unsigned j = 0; j < 16; ++j) { const unsigned c = xb_ld(&bar[XB_XCNT(j)]); sum += c; cnt += (c > 0u) ? 1u : 0u; mine = (j == x) ? c : mine; }
        if (sum == G) break;
        __builtin_amdgcn_s_sleep(1);
        if ((++sp & 255u) == 0u) { if (xb_ld(&bar[XB_TMO])) break; if (sp > XB_SPIN_CAP) { atomicAdd(&bar[XB_TMO], 1u); break; } }
    }
    nloc = mine > 0u ? mine : 1u; nx = cnt > 0u ? cnt : 1u;
}

__device__ __forceinline__ void xcd_barrier(const XcdBarrier& b) {
    asm volatile("s_waitcnt vmcnt(0)" ::: "memory");
    __syncthreads();
    if (threadIdx.x == 0) {
        unsigned* bar = b.bar;
        __builtin_amdgcn_s_waitcnt(0);
        unsigned nloc = b.st[0], nx = b.st[1];
        if (nloc == 0u) { xcd_barrier_complete(bar, b.x, nloc, nx); b.st[0] = nloc; b.st[1] = nx; }
        const unsigned old = xb_add(&bar[XB_XSUB(b.x)], 1u);
        const unsigned gen = old / nloc;
        if (old + 1u == (gen + 1u) * nloc) {
            __builtin_amdgcn_fence(__ATOMIC_RELEASE, "agent");
            asm volatile("s_waitcnt vmcnt(0)" ::: "memory");
            const unsigned og = xb_add(&bar[XB_TOP], 1u);
            const unsigned tg = og / nx;
            if (og + 1u == (tg + 1u) * nx) xb_add(&bar[XB_TOPGEN], 1u);
            else XB_SPIN(xb_ld(&bar[XB_TOPGEN]) == tg, bar);
            __builtin_amdgcn_fence(__ATOMIC_ACQUIRE, "agent");
            xb_add(&bar[XB_XGEN(b.x)], 1u);
            asm volatile("s_waitcnt vmcnt(0)" ::: "memory");
        } else {
            XB_SPIN(xb_ld(&bar[XB_XGEN(b.x)]) == gen, bar);
            __builtin_amdgcn_fence(__ATOMIC_ACQUIRE, "agent");
            asm volatile("s_waitcnt vmcnt(0)" ::: "memory");
        }
    }
    __syncthreads();
}

typedef _Float16 h16;
typedef h16 h16x2 __attribute__((ext_vector_type(2)));
typedef h16 h16x4 __attribute__((ext_vector_type(4)));
typedef h16 h16x8 __attribute__((ext_vector_type(8)));
typedef float f32x4 __attribute__((ext_vector_type(4)));
typedef float f32x2 __attribute__((ext_vector_type(2)));
typedef unsigned u32x4 __attribute__((ext_vector_type(4)));
typedef unsigned u32x2 __attribute__((ext_vector_type(2)));

constexpr int D = 1024, NB = 8, SEQ = 4096, T = NB * SEQ, LC = 256, TC = NB * LC, TALL = T + TC;
constexpr int NTHREADS = 512;
constexpr int LDS_BYTES = 156 * 1024;
constexpr float EPS = 1e-6f;
constexpr size_t MiB = (size_t)1 << 20;
constexpr size_t OFF_CTL = 0;
constexpr size_t OFF_MOD = 64 * 1024;
constexpr size_t OFF_LB = 320 * 1024;
constexpr size_t OFF_WA = 1 * MiB;
constexpr size_t OFF_WG = 6 * MiB;
constexpr size_t OFF_WF = 10 * MiB;
constexpr size_t OFF_WHG = 12 * MiB;
constexpr size_t OFF_WFT = 13 * MiB;
constexpr size_t OFF_WOUT = 14 * MiB;
constexpr size_t OFF_WS = 16 * MiB;
constexpr size_t OFF_UALL = 20 * MiB;
constexpr size_t OFF_OF = 88 * MiB;
constexpr size_t OFF_OB = 120 * MiB;
constexpr size_t OFF_FTT = 152 * MiB;
constexpr size_t OFF_Q = 216 * MiB;
constexpr size_t OFF_LF = 248 * MiB;
constexpr size_t OFF_LBK = 282 * MiB;
constexpr size_t OFF_V = 316 * MiB;
constexpr size_t OFF_G = 350 * MiB;
constexpr size_t OFF_WOUTG = 20 * MiB;
constexpr size_t OFF_Y1 = 382 * MiB;
constexpr size_t OFF_DFT256 = 512 * 1024;
constexpr size_t OFF_YFT = 446 * MiB;
constexpr size_t OFF_USTATE = 446 * MiB;
constexpr size_t OFF_DLOG = 460 * MiB;
constexpr size_t WS_NEED = 510 * MiB;
constexpr size_t OFF_GH = 216 * MiB;
constexpr size_t OFF_Y = 152 * MiB;
constexpr size_t OFF_H16 = 382 * MiB;
constexpr size_t OFF_U2 = 20 * MiB;
constexpr size_t OFF_TU = 478 * MiB;
constexpr size_t OFF_TV = 494 * MiB;
constexpr size_t OFF_QX = 120 * MiB;
constexpr size_t OFF_SU = 768 * 1024;
constexpr size_t OFF_SV = 832 * 1024;
constexpr size_t OFF_SX = 205 * MiB;
constexpr size_t OFF_SC = 216 * MiB;
constexpr size_t OFF_EIDX = 152 * MiB;
constexpr size_t OFF_GATE = 168 * MiB;
constexpr size_t OFF_W = 184 * MiB;
constexpr size_t OFF_PSS = 200 * MiB;
constexpr size_t OFF_PACT = 216 * MiB;
constexpr size_t OFF_PO = 216 * MiB;
constexpr size_t OFF_SIDE = 88 * MiB;
constexpr int CTL_RANK = 4096;
constexpr size_t CTL_ZERO_BYTES = 32 * 1024;

struct Params { const float* in[20]; float* out; unsigned char* ws; int ph_lo, ph_hi; };

__device__ __forceinline__ unsigned pk2(float a, float b) { h16x2 v = {(h16)a, (h16)b}; return __builtin_bit_cast(unsigned, v); }
#define GAS __attribute__((address_space(1)))
__device__ __forceinline__ void gst4(void* p, u32x4 v) { *(GAS u32x4*)p = v; }
__device__ __forceinline__ void gst2(void* p, u32x2 v) { *(GAS u32x2*)p = v; }
__device__ __forceinline__ float wave_sum(float v) {
#pragma unroll
    for (int o = 32; o >= 1; o >>= 1) v += __shfl_xor(v, o);
    return v; }
__device__ __forceinline__ float sigmoidf_(float z) { return __builtin_amdgcn_rcpf(1.0f + __expf(-z)); }

constexpr int N_MOD = 192, N_LB = 1, N_TRA = 160, N_TRG = 128, N_TRHG = 32, N_TRFT = 32, N_TROUT = 64, N_WF = 128, N_WSF = 256, N_DFT = 1;
constexpr int P0_TOTAL = N_MOD + N_LB + N_TRA + N_TRG + N_TRHG + N_TRFT + N_TROUT + N_WF + N_WSF + N_DFT;

__device__ __forceinline__ void p0_mod(const Params& p, LAS float* sm, int idx) {
    const int tid = threadIdx.x;
    for (int i = tid; i < 9 * 1024; i += NTHREADS) { const int r = i >> 10, k = i & 1023; const float c = (r < 8) ? p.in[1][r * 1024 + k] : p.in[3][k]; sm[i] = c / (1.0f + __expf(-c)); }
    __syncthreads();
    const int col = tid & 31, ks = tid >> 5;
    float acc[9];
#pragma unroll
    for (int r = 0; r < 9; ++r) acc[r] = 0.f;
    const float* w = p.in[4] + (size_t)(ks * 64) * 6144 + idx * 32 + col;
    float wv[64];
#pragma unroll
    for (int k = 0; k < 64; ++k) wv[k] = w[(size_t)k * 6144];
#pragma unroll
    for (int k = 0; k < 64; ++k) {
#pragma unroll
        for (int r = 0; r < 9; ++r) acc[r] += sm[r * 1024 + ks * 64 + k] * wv[k]; }
    LAS float* red = sm + 9 * 1024;
#pragma unroll
    for (int r = 0; r < 9; ++r) red[(ks * 9 + r) * 32 + col] = acc[r];
    __syncthreads();
    float* mod = (float*)(p.ws + OFF_MOD);
    if (tid < 288) { const int r = tid >> 5, c = tid & 31; float s = 0.f;
#pragma unroll
        for (int q = 0; q < 16; ++q) s += red[(q * 9 + r) * 32 + c];
        mod[r * 6144 + idx * 32 + c] = s + p.in[5][idx * 32 + c]; }
    __syncthreads();
}
__device__ __forceinline__ void p0_lb(const Params& p) {
    const int tid = threadIdx.x; float* lb = (float*)(p.ws + OFF_LB);
    if (tid < 512) { lb[tid] = 1.0f / (1.0f + expf(p.in[9][512 + tid] - p.in[9][tid])); lb[512 + tid] = 1.0f / (1.0f + expf(p.in[10][512 + tid] - p.in[10][tid])); }
}
__device__ __forceinline__ void p0_transpose(const float* src, int ld_src, int ncol0, h16* dst, int ld_dst, int nktiles, int item, LAS float* sm) {
    const int tid = threadIdx.x, kt = item % nktiles, nt = item / nktiles;
    { const int n4 = tid & 63, kk = tid >> 6;
#pragma unroll
      for (int ps = 0; ps < 8; ++ps) { const int k = kk + 8 * ps; const f32x4 v = *(const f32x4*)(src + (size_t)(kt * 64 + k) * ld_src + ncol0 + nt * 256 + 4 * n4);
          sm[k * 257 + 4 * n4] = v.x; sm[k * 257 + 4 * n4 + 1] = v.y; sm[k * 257 + 4 * n4 + 2] = v.z; sm[k * 257 + 4 * n4 + 3] = v.w; } }
    __syncthreads();
#pragma unroll
    for (int ps = 0; ps < 4; ++ps) { const int idx = tid + NTHREADS * ps, n = idx >> 3, k8 = (idx & 7) * 8;
        float v[8];
#pragma unroll
        for (int j = 0; j < 8; ++j) v[j] = sm[(k8 + j) * 257 + n];
        u32x4 w; w.x = pk2(v[0], v[1]); w.y = pk2(v[2], v[3]); w.z = pk2(v[4], v[5]); w.w = pk2(v[6], v[7]);
        *(u32x4*)(dst + (size_t)(nt * 256 + n) * ld_dst + kt * 64 + k8) = w; }
    __syncthreads();
}
__device__ __forceinline__ void p0_wf(const Params& p, LAS float* sm, int item) {
    const int tid = threadIdx.x, dt = item & 15, part = (item >> 4) & 1, g = item >> 5, d0 = dt * 64;
    LAS float* w = sm; LAS float* TT = sm + 8256; LAS float* trig = sm + 8256 + 16384;
    if (tid < 128) trig[tid] = part ? sinpif((float)tid / 64.0f) : cospif((float)tid / 64.0f);
    for (int i = tid; i < 64 * 128; i += NTHREADS) { const int dl = i >> 7, n2 = i & 127; w[dl * 129 + n2] = p.in[8][(size_t)(d0 + dl) * 5120 + 2560 + g * 128 + n2]; }
    __syncthreads();
    for (int i = tid; i < 128 * 128; i += NTHREADS) { const int n2 = i >> 7, k2 = i & 127; TT[i] = trig[(k2 * n2) & 127]; }
    __syncthreads();
    const int dl = tid & 63, kg = tid >> 6; h16* WF = (h16*)(p.ws + OFF_WF);
    float s[16];
#pragma unroll
    for (int j = 0; j < 16; ++j) s[j] = 0.f;
#pragma unroll 2
    for (int n2 = 0; n2 < 128; ++n2) { const float wv = w[dl * 129 + n2];
#pragma unroll
        for (int q = 0; q < 4; ++q) { const f32x4 tv = *(LAS f32x4*)(TT + n2 * 128 + kg * 16 + 4 * q);
#pragma unroll
            for (int j = 0; j < 4; ++j) s[4 * q + j] += wv * tv[j]; } }
#pragma unroll
    for (int j = 0; j < 16; ++j) WF[(size_t)(part * 512 + g * 128 + kg * 16 + j) * 1024 + d0 + dl] = (h16)(s[j] * 0.08838834764831845f);
    __syncthreads();
}
__device__ __forceinline__ void p0_wsf(const Params& p, LAS float* sm, int item) {
    const int tid = threadIdx.x, dt = item & 15, hp = item >> 4, d0 = dt * 64;
    LAS float* wq = sm; LAS float* skT = sm + 8256;
    for (int i = tid; i < 64 * 128; i += NTHREADS) { const int dl = i >> 7, k = i & 127; wq[dl * 129 + k] = p.in[15][(size_t)(d0 + dl) * 2048 + hp * 128 + k]; }
    for (int i = tid; i < 128 * 128; i += NTHREADS) { const int n = i >> 7, k = i & 127; skT[k * 128 + n] = p.in[16][(size_t)hp * 16384 + i]; }
    __syncthreads();
    const int dl = tid & 63, ng = tid >> 6; h16* WS = (h16*)(p.ws + OFF_WS);
    float s[16];
#pragma unroll
    for (int j = 0; j < 16; ++j) s[j] = 0.f;
#pragma unroll 2
    for (int k = 0; k < 128; ++k) { const float wv = wq[dl * 129 + k];
#pragma unroll
        for (int q = 0; q < 4; ++q) { const f32x4 tv = *(LAS f32x4*)(skT + k * 128 + ng * 16 + 4 * q);
#pragma unroll
            for (int j = 0; j < 4; ++j) s[4 * q + j] += wv * tv[j]; } }
#pragma unroll
    for (int j = 0; j < 16; ++j) WS[(size_t)(hp * 128 + ng * 16 + j) * 1024 + d0 + dl] = (h16)s[j];
    __syncthreads();
}
__device__ __forceinline__ void p0_dft256(const Params& p) {
    h16* M = (h16*)(p.ws + OFF_DFT256);
    for (int e = threadIdx.x; e < 256 * 512; e += NTHREADS) { const int c = e >> 9, k = e & 511, part = k >> 8, a = k & 255; const int m = (a * c) & 255;
        M[e] = (h16)((part ? sinpif((float)m / 128.0f) : cospif((float)m / 128.0f)) * 0.25f); }
}
constexpr int CTL_P0Q = 6144;
__device__ __forceinline__ void phase0(const Params& p, LAS unsigned char* lds) {
    LAS float* sm = (LAS float*)lds; volatile LAS unsigned* slot = (volatile LAS unsigned*)(lds + LDS_BYTES - 64) + 8;
    unsigned* ctr = (unsigned*)(p.ws + OFF_CTL) + CTL_P0Q;
    int it = blockIdx.x;
    while (it < P0_TOTAL) {
        unsigned nxt = 0u;
        if (threadIdx.x == 0) nxt = xb_add(ctr, 1u) + gridDim.x;
        int i = it;
        do {
            if (i < N_DFT) { p0_dft256(p); break; } i -= N_DFT;
            if (i < N_MOD) { p0_mod(p, sm, i); break; } i -= N_MOD;
            if (i < N_WSF) { p0_wsf(p, sm, i); break; } i -= N_WSF;
            if (i < N_WF) { p0_wf(p, sm, i); break; } i -= N_WF;
            if (i < N_TRA) { p0_transpose(p.in[8], 5120, 0, (h16*)(p.ws + OFF_WA), 1024, 16, i, sm); break; } i -= N_TRA;
            if (i < N_TRG) { p0_transpose(p.in[8], 5120, 3072, (h16*)(p.ws + OFF_WG), 1024, 16, i, sm); break; } i -= N_TRG;
            if (i < N_TRHG) { p0_transpose(p.in[12], 1024, 0, (h16*)(p.ws + OFF_WHG), 512, 8, i, sm); break; } i -= N_TRHG;
            if (i < N_TRFT) { p0_transpose(p.in[13], 1024, 0, (h16*)(p.ws + OFF_WFT), 512, 8, i, sm); break; } i -= N_TRFT;
            if (i < N_TROUT) { p0_transpose(p.in[14], 1024, 0, (h16*)(p.ws + OFF_WOUT), 1024, 16, i, sm); break; } i -= N_TROUT;
            p0_lb(p);
        } while (0);
        if (threadIdx.x == 0) slot[0] = nxt;
        __syncthreads();
        it = (int)slot[0];
        __syncthreads();
    }
}

template <bool SRC16>
__device__ __forceinline__ void modulate_rows(const void* srcv, h16* dst, int nrows, const float* gvec, const float* mod, int sh_off, int sc_off, int ctx_rows, int vb, int vn, signed char* qdst = nullptr, float* qscale = nullptr) {
    const int wave = threadIdx.x >> 6, lane = threadIdx.x & 63;
    const float* src = (const float*)srcv; const h16* src16 = (const h16*)srcv;
    for (int rowA = vb * 8 + wave; rowA < nrows; rowA += vn * 16) {
        const int rowB = rowA + vn * 8; const bool okB = rowB < nrows;
        const int rows[2] = {rowA, okB ? rowB : rowA};
        f32x4 v[2][4]; float ss[2] = {0.f, 0.f};
#pragma unroll
        for (int q = 0; q < 2; ++q)
#pragma unroll
            for (int j = 0; j < 4; ++j) {
                if (SRC16) { const h16x4 hv = *(const h16x4*)(src16 + (size_t)rows[q] * D + j * 256 + lane * 4); v[q][j] = (f32x4){(float)hv[0], (float)hv[1], (float)hv[2], (float)hv[3]}; }
                else v[q][j] = *(const f32x4*)(src + (size_t)rows[q] * D + j * 256 + lane * 4); }
#pragma unroll
        for (int q = 0; q < 2; ++q) {
#pragma unroll
            for (int j = 0; j < 4; ++j) ss[q] += v[q][j].x * v[q][j].x + v[q][j].y * v[q][j].y + v[q][j].z * v[q][j].z + v[q][j].w * v[q][j].w;
            ss[q] = wave_sum(ss[q]); }
#pragma unroll
        for (int q = 0; q < 2; ++q) {
            if (q == 1 && !okB) break;
            const int row = rows[q], mr = ctx_rows ? 8 : (row >> 12);
            const float rstd = rsqrtf(ss[q] * (1.0f / D) + EPS);
            float amax = 0.f;
#pragma unroll
            for (int j = 0; j < 4; ++j) { const int c = j * 256 + lane * 4;
                const f32x4 gg = *(const f32x4*)(gvec + c), sc = *(const f32x4*)(mod + mr * 6144 + sc_off + c), sh = *(const f32x4*)(mod + mr * 6144 + sh_off + c);
                const f32x4 o = (v[q][j] * rstd) * gg * (sc + 1.0f) + sh; v[q][j] = o;
                amax = fmaxf(amax, fmaxf(fmaxf(fabsf(o.x), fabsf(o.y)), fmaxf(fabsf(o.z), fabsf(o.w))));
                u32x2 w; w.x = pk2(o.x, o.y); w.y = pk2(o.z, o.w);
                *(u32x2*)(dst + (size_t)row * D + c) = w; }
            if (qdst) {
#pragma unroll
                for (int o = 32; o >= 1; o >>= 1) amax = fmaxf(amax, __shfl_xor(amax, o));
                const float qs = amax > 0.f ? amax * (1.0f / 127.0f) : 1.0f, inv = 1.0f / qs;
#pragma unroll
                for (int j = 0; j < 4; ++j) { const int c = j * 256 + lane * 4;
                    const int q0 = (int)rintf(v[q][j].x * inv), q1 = (int)rintf(v[q][j].y * inv), q2 = (int)rintf(v[q][j].z * inv), q3 = (int)rintf(v[q][j].w * inv);
                    *(unsigned*)(qdst + (size_t)row * D + c) = (unsigned)(q0 & 255) | ((unsigned)(q1 & 255) << 8) | ((unsigned)(q2 & 255) << 16) | ((unsigned)(q3 & 255) << 24); }
                if (lane == 0) qscale[row] = qs;
            }
        }
    }
}

#define EPI_DEFAULT_HOOKS \
    static constexpr bool FUSED = false; \
    __device__ __forceinline__ size_t boff(const pg8::Unit&) const { return 0; } \
    __device__ __forceinline__ void init(f32x4 (&)[2][2][4][2], const pg8::Unit&, int, int, int, int) const {}
struct EpiA {
    EPI_DEFAULT_HOOKS
    static constexpr bool PERM = true, TRANS = true;
    static constexpr int NST = 16;
    unsigned char* ws;
    __device__ __forceinline__ void operator()(const f32x4 (&acc)[2][2][4][2], const pg8::Unit& u, int wr, int wc, int fr, int fq) const {
        const int ty = u.pn >> 1;
        h16* base = (h16*)(ws + (ty == 0 ? OFF_Q : ty == 1 ? OFF_LF : ty == 2 ? OFF_LBK : ty == 3 ? OFF_V : OFF_G));
        const float* lb = (const float*)(ws + OFF_LB) + (ty == 2 ? 512 : 0);
        const int row0 = u.pm * 256 + wr * 64 + fr, col0 = (u.pn & 1) * 256 + wc * 32 + 8 * fq;
#pragma unroll
        for (int bj = 0; bj < 2; ++bj) {
            float lbv[8];
            if (ty == 1 || ty == 2) {
#pragma unroll
                for (int j = 0; j < 8; ++j) lbv[j] = lb[col0 + bj * 128 + j];
            }
#pragma unroll
            for (int ai = 0; ai < 2; ++ai)
#pragma unroll
                for (int m = 0; m < 4; ++m) {
                    float v[8];
#pragma unroll
                    for (int j = 0; j < 4; ++j) { v[j] = acc[ai][bj][m][0][j]; v[4 + j] = acc[ai][bj][m][1][j]; }
                    if (ty == 0) {
#pragma unroll
                        for (int j = 0; j < 8; ++j) v[j] *= 0.08838834764831845f;
                    } else if (ty == 1 || ty == 2) {
#pragma unroll
                        for (int j = 0; j < 8; ++j) v[j] = __builtin_amdgcn_logf(lbv[j] + (1.0f - lbv[j]) * sigmoidf_(v[j]));
                    }
                    u32x4 w; w.x = pk2(v[0], v[1]); w.y = pk2(v[2], v[3]); w.z = pk2(v[4], v[5]); w.w = pk2(v[6], v[7]);
                    gst4(base + (size_t)(row0 + ai * 128 + m * 16) * 512 + col0 + bj * 128, w);
                }
        }
    }
};
struct OneUnit { pg8::Unit u; __device__ bool next(int i, pg8::Unit& o) const { if (i > 0) return false; o = u; return true; } };
struct OrderA {
    pg8::TileOrder lat; int G, c, rep;
    __device__ void init(int G_, int c_, int rep_ = 1) { lat.init(128, 10, G_, c_); G = G_; c = c_; rep = rep_; }
    __device__ bool next(int i, pg8::Unit& u) const {
        long L = (long)i * G + c; if (L >= 1328L * rep) return false; L %= 1328;
        if (L < 1280) return lat.map(L, u);
        const int l2 = (int)(L - 1280); if (l2 >= 48) return false;
        u.pm = 128 + l2 / 6; u.pn = 2 + l2 % 6; return true;
    }
};
__device__ __forceinline__ size_t gate_rec(int gate, int pm, int pn4, int wave, int ai, int m, int lane) { return (((((((size_t)gate * 128 + pm) * 4 + pn4) * 8 + wave) * 2 + ai) * 4 + m) * 64 + lane) * 16; }
struct EpiGate {
    EPI_DEFAULT_HOOKS
    static constexpr bool PERM = true, TRANS = true;
    static constexpr int NST = 8;
    unsigned char* ws;
    __device__ __forceinline__ void operator()(const f32x4 (&acc)[2][2][4][2], const pg8::Unit& u, int wr, int wc, int fr, int fq) const {
        unsigned char* G8 = ws + OFF_GH;
#pragma unroll
        for (int ai = 0; ai < 2; ++ai)
#pragma unroll
            for (int m = 0; m < 4; ++m) {
                u32x4 w;
#pragma unroll
                for (int bj = 0; bj < 2; ++bj)
#pragma unroll
                    for (int n = 0; n < 2; ++n) { unsigned d = 0u;
#pragma unroll
                        for (int j = 0; j < 4; ++j) d = __builtin_amdgcn_cvt_pk_u8_f32(__builtin_amdgcn_rcpf(__builtin_fmaf(__expf(-acc[ai][bj][m][n][j]), 1.0f / 255.0f, 1.0f / 255.0f)), j, d);
                        w[2 * bj + n] = d; }
                gst4(G8 + gate_rec(u.pn >> 2, u.pm, u.pn & 3, wr * 4 + wc, ai, m, fq * 16 + fr), w);
            }
    }
};
struct EpiFT {
    EPI_DEFAULT_HOOKS
    static constexpr bool PERM = false, TRANS = false;
    static constexpr int NST = 32;
    unsigned char* ws;
    __device__ __forceinline__ void operator()(const f32x4 (&acc)[2][2][4][2], const pg8::Unit& u, int wr, int wc, int fr, int fq) const {
        h16* F = (h16*)(ws + OFF_FTT);
        const int t0 = u.pm * 256 + wr * 64 + 4 * fq, c0 = u.pn * 256 + wc * 32 + fr;
#pragma unroll
        for (int ai = 0; ai < 2; ++ai)
#pragma unroll
            for (int m = 0; m < 4; ++m)
#pragma unroll
                for (int bj = 0; bj < 2; ++bj)
#pragma unroll
                    for (int n = 0; n < 2; ++n) {
                        const int t = t0 + ai * 128 + m * 16, c = c0 + bj * 128 + n * 16;
                        const int b = t >> 12, n1 = t & 4095, part = c >> 9, gk = c & 511;
                        const f32x4 a = acc[ai][bj][m][n];
                        u32x2 w; w.x = pk2(a.x, a.y); w.y = pk2(a.z, a.w);
                        gst2(F + ((size_t)((b * 512 + gk) * 2 + part)) * 4096 + n1, w);
                    }
    }
};
struct EpiDFT {
    EPI_DEFAULT_HOOKS
    static constexpr bool PERM = true, TRANS = true;
    static constexpr int NST = 16;
    unsigned char* ws;
    __device__ __forceinline__ void operator()(const f32x4 (&acc)[2][2][4][2], const pg8::Unit& u, int wr, int wc, int fr, int fq) const {
        h16* Y = (h16*)(ws + OFF_YFT);
        const int b = u.pn >> 5, d = (u.pn >> 1) & 15;
        const int c0 = wr * 64 + fr, col0 = (u.pn & 1) * 256 + wc * 32 + 8 * fq;
#pragma unroll
        for (int ai = 0; ai < 2; ++ai)
#pragma unroll
            for (int m = 0; m < 4; ++m)
#pragma unroll
                for (int bj = 0; bj < 2; ++bj) {
                    const int c = c0 + ai * 128 + m * 16;
                    const f32x4 a0 = acc[ai][bj][m][0], a1 = acc[ai][bj][m][1];
                    u32x4 w; w.x = pk2(a0.x, a0.y); w.y = pk2(a0.z, a0.w); w.z = pk2(a1.x, a1.y); w.w = pk2(a1.z, a1.w);
                    gst4(Y + (size_t)(b * 4096 + d + 16 * c) * 512 + col0 + bj * 128, w);
                }
    }
};
typedef h16 GAS gh16;
template <bool ACCUM> struct EpiMerge1 {
    EPI_DEFAULT_HOOKS
    static constexpr bool PERM = true, TRANS = true;
    static constexpr int NST = 8;
    unsigned char* ws;
    __device__ __forceinline__ void operator()(const f32x4 (&acc)[2][2][4][2], const pg8::Unit& u, int wr, int wc, int fr, int fq) const {
        gh16* Y = (gh16*)(ws + OFF_Y); const unsigned char* G8 = ws + OFF_GH;
        const int row0 = u.pm * 256 + wr * 64 + fr, col0 = u.pn * 256 + wc * 32 + 8 * fq;
        const unsigned off0 = (unsigned)row0 * 1024u + (unsigned)col0;
#pragma unroll
        for (int ai = 0; ai < 2; ++ai) {
            u32x4 gt[4]; h16x8 yv[8];
#pragma unroll
            for (int m = 0; m < 4; ++m) gt[m] = *(const GAS u32x4*)(G8 + gate_rec(ACCUM ? 1 : 0, u.pm, u.pn, wr * 4 + wc, ai, m, fq * 16 + fr));
            if (ACCUM) {
#pragma unroll
                for (int i = 0; i < 8; ++i) { const int m = i >> 1, bj = i & 1; yv[i] = *(const GAS h16x8*)(Y + (off0 + (unsigned)((ai * 128 + m * 16) * 1024 + bj * 128))); } }
            __builtin_amdgcn_sched_barrier(0);
#pragma unroll
            for (int i = 0; i < 8; ++i) { const int m = i >> 1, bj = i & 1; const unsigned off = off0 + (unsigned)((ai * 128 + m * 16) * 1024 + bj * 128);
                float v[8];
#pragma unroll
                for (int n = 0; n < 2; ++n) { const unsigned d = gt[m][2 * bj + n];
#pragma unroll
                    for (int j = 0; j < 4; ++j) v[4 * n + j] = acc[ai][bj][m][n][j] * ((float)((d >> (8 * j)) & 255u) * (1.0f / 255.0f)); }
                if (ACCUM) {
#pragma unroll
                    for (int j = 0; j < 8; ++j) v[j] += (float)yv[i][j]; }
                u32x4 w; w.x = pk2(v[0], v[1]); w.y = pk2(v[2], v[3]); w.z = pk2(v[4], v[5]); w.w = pk2(v[6], v[7]);
                *(GAS u32x4*)(Y + off) = w; }
            __builtin_amdgcn_sched_barrier(0);
        }
    }
};
struct EpiMerge2 {
    static constexpr bool PERM = true, TRANS = true, FUSED = true;
    static constexpr int NST = 8;
    const float* x; h16* H;
    __device__ __forceinline__ size_t boff(const pg8::Unit& u) const { return (size_t)(u.pm >> 4) * (1024 * 1024 * 2); }
    __device__ __forceinline__ void init(f32x4 (&acc)[2][2][4][2], const pg8::Unit& u, int wr, int wc, int fr, int fq) const {
        const int row0 = u.pm * 256 + wr * 64 + fr, col0 = u.pn * 256 + wc * 32 + 8 * fq;
        const GAS float* xg = (const GAS float*)x;
#pragma unroll
        for (int ai = 0; ai < 2; ++ai)
#pragma unroll
            for (int m = 0; m < 4; ++m) { const GAS float* rowp = xg + (size_t)(row0 + ai * 128 + m * 16) * 1024 + col0;
#pragma unroll
                for (int bj = 0; bj < 2; ++bj)
#pragma unroll
                    for (int n = 0; n < 2; ++n) acc[ai][bj][m][n] = *(const GAS f32x4*)(rowp + bj * 128 + n * 4); }
    }
    __device__ __forceinline__ void fused(f32x4 (&acc)[2][2][4][2], const pg8::Unit& u, const pg8::Unit& nx, bool has_next, int wr, int wc, int fr, int fq) const {
        const int row0 = u.pm * 256 + wr * 64 + fr, col0 = u.pn * 256 + wc * 32 + 8 * fq;
        const int nrow0 = nx.pm * 256 + wr * 64 + fr, ncol0 = nx.pn * 256 + wc * 32 + 8 * fq;
        const GAS float* xg = (const GAS float*)x;
#pragma unroll
        for (int ai = 0; ai < 2; ++ai) {
            u32x4 o[4][2];
#pragma unroll
            for (int m = 0; m < 4; ++m)
#pragma unroll
                for (int bj = 0; bj < 2; ++bj) { const f32x4 a0 = acc[ai][bj][m][0], a1 = acc[ai][bj][m][1];
                    o[m][bj].x = pk2(a0[0], a0[1]); o[m][bj].y = pk2(a0[2], a0[3]); o[m][bj].z = pk2(a1[0], a1[1]); o[m][bj].w = pk2(a1[2], a1[3]); }
            __builtin_amdgcn_sched_barrier(0);
            if (has_next) {
#pragma unroll
                for (int m = 0; m < 4; ++m) { const GAS float* rowp = xg + (size_t)(nrow0 + ai * 128 + m * 16) * 1024 + ncol0;
#pragma unroll
                    for (int bj = 0; bj < 2; ++bj)
#pragma unroll
                        for (int n = 0; n < 2; ++n) acc[ai][bj][m][n] = *(const GAS f32x4*)(rowp + bj * 128 + n * 4); } }
            __builtin_amdgcn_sched_barrier(0);
#pragma unroll
            for (int m = 0; m < 4; ++m) { h16* rowp = H + (size_t)(row0 + ai * 128 + m * 16) * 1024 + col0;
#pragma unroll
                for (int bj = 0; bj < 2; ++bj) gst4(rowp + bj * 128, o[m][bj]); }
            __builtin_amdgcn_sched_barrier(0);
        }
    }
};
__device__ __forceinline__ void scale_wout(const Params& p, int vb, int vn) {
    const h16* W = (const h16*)(p.ws + OFF_WOUT); h16* WG = (h16*)(p.ws + OFF_WOUTG); const float* mod = (const float*)(p.ws + OFF_MOD);
    for (size_t i = (size_t)vb * NTHREADS + threadIdx.x; i < (size_t)8 * 1024 * 128; i += (size_t)vn * NTHREADS) {
        const int b = (int)(i >> 17), c = (int)((i >> 7) & 1023), k8 = (int)(i & 127) * 8;
        const h16x8 w = *(const h16x8*)(W + (size_t)c * 1024 + k8); const float g = mod[b * 6144 + 2048 + c];
        u32x4 o; o.x = pk2((float)w[0] * g, (float)w[1] * g); o.y = pk2((float)w[2] * g, (float)w[3] * g); o.z = pk2((float)w[4] * g, (float)w[5] * g); o.w = pk2((float)w[6] * g, (float)w[7] * g);
        *(u32x4*)(WG + ((size_t)b * 1024 + c) * 1024 + k8) = o; }
}
__device__ __forceinline__ unsigned f2key(float x) { const unsigned b = __builtin_bit_cast(unsigned, x); return b ^ ((b >> 31) ? 0xFFFFFFFFu : 0x80000000u); }
__device__ __forceinline__ float key2f(unsigned u) { const unsigned b = (u & 0x80000000u) ? (u ^ 0x80000000u) : ~u; return __builtin_bit_cast(float, b); }
__device__ __forceinline__ unsigned umax3(unsigned a, unsigned b, unsigned c) { return max(max(a, b), c); }
typedef short s16x2_t __attribute__((ext_vector_type(2)));
__device__ __forceinline__ unsigned hkey2(float a, float b) { const unsigned w = pk2(a, b); const s16x2_t m = __builtin_bit_cast(s16x2_t, w) >> 15;
    return w ^ (__builtin_bit_cast(unsigned, m) | 0x80008000u); }
struct EpiScores {
    static constexpr bool PERM = false, TRANS = true;
    static constexpr int NST = 16;
    EPI_DEFAULT_HOOKS
    unsigned char* C;
    __device__ __forceinline__ void operator()(const f32x4 (&acc)[2][2][4][2], const pg8::Unit& u, int wr, int wc, int fr, int fq) const {
#pragma unroll
        for (int ai = 0; ai < 2; ++ai)
#pragma unroll
            for (int m = 0; m < 4; ++m) { const int t = u.pm * 256 + ai * 128 + wr * 64 + m * 16 + fr, tb = t >> 6, tl = t & 63;
#pragma unroll
                for (int bj = 0; bj < 2; ++bj) { const int c8 = 4 * wc + fq;
                    const f32x4 a0 = acc[ai][bj][m][0], a1 = acc[ai][bj][m][1]; u32x4 kq;
                    kq.x = hkey2(a0[0], a0[1]); kq.y = hkey2(a0[2], a0[3]); kq.z = hkey2(a1[0], a1[1]); kq.w = hkey2(a1[2], a1[3]);
                    gst4(C + ((((size_t)(tb * 8 + u.pn) * 2 + bj) * 16 + c8) * 64 + tl) * 16, kq); } }
    }
};
__device__ __forceinline__ int hgrn_row(int pos, int b, int dir) {
    if (pos < LC) { const int j = dir ? (LC - 1 - pos) : pos; return T + b * LC + j; }
    const int t = pos - LC; return b * SEQ + (dir ? (SEQ - 1 - t) : t);
}
__device__ void hgrn_item(const Params& p, LAS unsigned char* lds, int item) {
    const int tid = threadIdx.x, vq = item & 3, dir = (item >> 2) & 1, h = (item >> 3) & 3, b = item >> 5;
    const h16* Q = (const h16*)(p.ws + OFF_Q); const h16* LF = (const h16*)(p.ws + (dir ? OFF_LBK : OFF_LF)); const h16* V = (const h16*)(p.ws + OFF_V);
    h16* O = (h16*)(p.ws + (dir ? OFF_OB : OFF_OF));
    LAS float* fs = (LAS float*)lds; LAS float* ks = fs + 16 * 128; LAS float* qs = ks + 16 * 128; LAS float* vs = qs + 16 * 128; LAS float* po = vs + 16 * 32;
    const int v = tid & 31, kq = tid >> 5;
    float S[8];
#pragma unroll
    for (int j = 0; j < 8; ++j) S[j] = 0.f;
    const int e = tid * 4, tl_ld = e >> 7, k_ld = e & 127;
    const int tl_v = tid >> 5, vv = tid & 31;
    h16x4 lf4, q4; h16 v1;
    { const int row = hgrn_row(tl_ld, b, dir); lf4 = *(const h16x4*)(LF + (size_t)row * 512 + h * 128 + k_ld); q4 = (h16x4){0, 0, 0, 0};
      const int row2 = hgrn_row(tl_v, b, dir); v1 = V[(size_t)row2 * 512 + h * 128 + vq * 32 + vv]; }
    constexpr int NG = (LC + SEQ) / 16;
    for (int grp = 0; grp < NG; ++grp) {
        const bool latent = grp >= LC / 16;
#pragma unroll
        for (int j = 0; j < 4; ++j) { const float f = __expf((float)lf4[j]); fs[e + j] = f; ks[e + j] = 1.0f - f; qs[e + j] = (float)q4[j]; }
        vs[tid] = (float)v1;
        __syncthreads();
        if (grp + 1 < NG) { const int pos = (grp + 1) * 16; const bool lat2 = (grp + 1) >= LC / 16;
            const int row = hgrn_row(pos + tl_ld, b, dir); lf4 = *(const h16x4*)(LF + (size_t)row * 512 + h * 128 + k_ld);
            if (lat2) q4 = *(const h16x4*)(Q + (size_t)row * 512 + h * 128 + k_ld);
            const int row2 = hgrn_row(pos + tl_v, b, dir); v1 = V[(size_t)row2 * 512 + h * 128 + vq * 32 + vv]; }
#pragma unroll 4
        for (int tl = 0; tl < 16; ++tl) {
            const float vt = vs[tl * 32 + v];
            const f32x4 f0 = *(const LAS f32x4*)(fs + tl * 128 + kq * 8), f1 = *(const LAS f32x4*)(fs + tl * 128 + kq * 8 + 4);
            const f32x4 k0 = *(const LAS f32x4*)(ks + tl * 128 + kq * 8), k1 = *(const LAS f32x4*)(ks + tl * 128 + kq * 8 + 4);
            const f32x4 q0 = *(const LAS f32x4*)(qs + tl * 128 + kq * 8), q1 = *(const LAS f32x4*)(qs + tl * 128 + kq * 8 + 4);
            float a = 0.f;
#pragma unroll
            for (int j = 0; j < 4; ++j) { S[j] = f0[j] * S[j] + k0[j] * vt; a += S[j] * q0[j]; S[4 + j] = f1[j] * S[4 + j] + k1[j] * vt; a += S[4 + j] * q1[j]; }
            po[(tl * 16 + kq) * 32 + v] = a;
        }
        __syncthreads();
        if (latent) { float s = 0.f;
#pragma unroll
            for (int q = 0; q < 16; ++q) s += po[(tl_v * 16 + q) * 32 + vv];
            const int row = hgrn_row(grp * 16 + tl_v, b, dir);
            O[(size_t)row * 512 + h * 128 + vq * 32 + vv] = (h16)s; }
    }
    __syncthreads();
}

typedef short s16x8 __attribute__((ext_vector_type(8)));
typedef short s16x4 __attribute__((ext_vector_type(4)));
__device__ __forceinline__ unsigned cvt_pk_bf16(float lo, float hi) { unsigned r; asm volatile("v_cvt_pk_bf16_f32 %0, %1, %2" : "=v"(r) : "v"(lo), "v"(hi)); return r; }
constexpr int HG_RP = 272, HG_QT = 0, HG_KT = 17408, HG_QD = 34816, HG_KDT = 52224, HG_VT = 68608, HG_AM = 84992, HG_DEC = 93184, HG_SEG = 93696, HG_SEGCH = 17;
#define HG_OPAQUE(x) asm volatile("" : "+v"(x))
template <bool FULL>
__device__ __forceinline__ void hgrn_mfma_unit(const Params& p, LAS unsigned char* lds, int item, int seg) {
    const int tid = threadIdx.x, wave = __builtin_amdgcn_readfirstlane(tid >> 6), lane = tid & 63, fr = lane & 15, fq = lane >> 4;
    const int dir = item & 1, h = (item >> 1) & 3, b = item >> 3;
    const h16* Q = (const h16*)(p.ws + OFF_Q); const h16* LF = (const h16*)(p.ws + (dir ? OFF_LBK : OFF_LF)); const h16* V = (const h16*)(p.ws + OFF_V);
    h16* O = (h16*)(p.ws + (dir ? OFF_OB : OFF_OF));
    float* USTATE = (float*)(p.ws + OFF_USTATE); float* DLOG = (float*)(p.ws + OFF_DLOG);
    const int ch_lo = seg * HG_SEGCH, ch_hi = ch_lo + HG_SEGCH;
    f32x4 S[8];
#pragma unroll
    for (int m = 0; m < 8; ++m) S[m] = (f32x4){0.f, 0.f, 0.f, 0.f};
    if (FULL && seg > 0) {
        for (int i = 0; i < seg; ++i) { const float* U = USTATE + (size_t)(item * 3 + i) * 16384; const float* DL = DLOG + (size_t)(item * 3 + i) * 128;
#pragma unroll
            for (int m = 0; m < 8; ++m)
#pragma unroll
                for (int j = 0; j < 4; ++j) { const int k = 16 * m + 4 * fq + j; const float d = (i > 0) ? __builtin_amdgcn_exp2f(DL[k]) : 0.f; S[m][j] = d * S[m][j] + U[k * 128 + 16 * wave + fr]; } } }
    float dl0 = 0.f, dl1 = 0.f;
    for (int i = tid; i < 8192 / 16; i += NTHREADS) ((LAS u32x4*)(lds + HG_AM))[i] = (u32x4){0u, 0u, 0u, 0u};
    const int kp = lane;
    const unsigned chan = (unsigned)(h * 128 + 2 * kp);
    int bw_rm = wave * 8 * HG_RP + 4 * kp;
    int bw_t0 = (2 * kp) * 128 + ((wave ^ ((2 * kp) & 7)) << 4), bw_t1 = (2 * kp + 1) * 128 + ((wave ^ ((2 * kp + 1) & 7)) << 4);
    int br_rm = fr * HG_RP + 16 * fq;
    int br_qd = HG_QD + fr * HG_RP + 8 * fq;
    int br_t0 = fr * 128 + ((fq ^ (fr & 7)) << 4), br_t1 = fr * 128 + (((4 + fq) ^ (fr & 7)) << 4);
    HG_OPAQUE(bw_rm); HG_OPAQUE(bw_t0); HG_OPAQUE(bw_t1); HG_OPAQUE(br_rm); HG_OPAQUE(br_qd); HG_OPAQUE(br_t0); HG_OPAQUE(br_t1);
    int br_v0 = br_t0 + HG_VT + wave * 2048, br_v1 = br_t1 + HG_VT + wave * 2048, br_k0 = br_t0 + HG_KDT, br_k1 = br_t1 + HG_KDT, br_a0 = br_t0 + HG_AM, br_a1 = br_t1 + HG_AM;
    HG_OPAQUE(br_v0); HG_OPAQUE(br_v1); HG_OPAQUE(br_k0); HG_OPAQUE(br_k1); HG_OPAQUE(br_a0); HG_OPAQUE(br_a1);
    LAS float* DEC = (LAS float*)(lds + HG_DEC); LAS float* SEG = (LAS float*)(lds + HG_SEG);
    unsigned lfr[8], qr[8], vr[8];
#pragma unroll
    for (int r = 0; r < 8; ++r) { const unsigned eo = (unsigned)hgrn_row(ch_lo * 64 + 8 * wave + r, b, dir) * 512u + chan; lfr[r] = *(const unsigned*)(LF + eo); vr[r] = *(const unsigned*)(V + eo);
        qr[r] = (FULL && ch_lo >= LC / 64) ? *(const unsigned*)(Q + eo) : 0u; }
    for (int ch = ch_lo; ch < ch_hi; ++ch) {
        const bool latent = FULL && (ch >= LC / 64);
        float f0[8], f1[8]; float run0 = 0.f, run1 = 0.f;
#pragma unroll
        for (int r = 0; r < 8; ++r) { const h16x2 l = __builtin_bit_cast(h16x2, lfr[r]); const float l0 = (float)l[0], l1 = (float)l[1]; run0 += l0; run1 += l1;
            f0[r] = __builtin_amdgcn_exp2f(l0); f1[r] = __builtin_amdgcn_exp2f(l1); }
        *(LAS f32x2*)(SEG + wave * 128 + 2 * kp) = (f32x2){run0, run1};
        __syncthreads();
        float off0 = 0.f, off1 = 0.f, mid0 = 0.f, mid1 = 0.f, tot0 = 0.f, tot1 = 0.f;
#pragma unroll
        for (int w2 = 0; w2 < 8; ++w2) { const f32x2 tt = *(LAS f32x2*)(SEG + w2 * 128 + 2 * kp);
            if (w2 < wave) { off0 += tt[0]; off1 += tt[1]; } if (w2 < 4) { mid0 += tt[0]; mid1 += tt[1]; } tot0 += tt[0]; tot1 += tt[1]; }
        dl0 += tot0; dl1 += tot1;
        const float em0 = __builtin_amdgcn_exp2f(mid0), em1 = __builtin_amdgcn_exp2f(mid1), el0 = __builtin_amdgcn_exp2f(tot0 - mid0), el1 = __builtin_amdgcn_exp2f(tot1 - mid1);
        if (wave == 0) *(LAS f32x2*)(DEC + 2 * kp) = (f32x2){__builtin_amdgcn_exp2f(tot0), __builtin_amdgcn_exp2f(tot1)};
        float e2a[8], e2b[8];
        e2a[7] = __builtin_amdgcn_exp2f(mid0 - (off0 + run0)); e2b[7] = __builtin_amdgcn_exp2f(mid1 - (off1 + run1));
#pragma unroll
        for (int r = 7; r > 0; --r) { e2a[r - 1] = e2a[r] * f0[r]; e2b[r - 1] = e2b[r] * f1[r]; }
        float e1a = FULL ? __builtin_amdgcn_exp2f(off0 - mid0) : 0.f, e1b = FULL ? __builtin_amdgcn_exp2f(off1 - mid1) : 0.f;
        unsigned kd0[4], kd1[4], vt0[4], vt1[4];
#pragma unroll
        for (int r = 0; r < 8; ++r) {
            const h16x2 q = __builtin_bit_cast(h16x2, qr[r]), v = __builtin_bit_cast(h16x2, vr[r]);
            const float e20 = e2a[r], e21 = e2b[r];
            const float k0 = 1.0f - f0[r], k1 = 1.0f - f1[r];
            const float kt0 = k0 * e20, kt1 = k1 * e21;
            if (FULL) {
                e1a *= f0[r]; e1b *= f1[r]; const float e10 = e1a, e11 = e1b;
                const float qt0 = (float)q[0] * e10, qt1 = (float)q[1] * e11;
                *(LAS unsigned*)(lds + bw_rm + HG_QT + r * HG_RP) = cvt_pk_bf16(qt0, qt1);
                *(LAS unsigned*)(lds + bw_rm + HG_KT + r * HG_RP) = cvt_pk_bf16(kt0, kt1);
                *(LAS unsigned*)(lds + bw_rm + HG_QD + r * HG_RP) = cvt_pk_bf16(qt0 * em0, qt1 * em1);
            }
            const float kdv0 = kt0 * el0, kdv1 = kt1 * el1;
            if (r & 1) { kd0[r >> 1] = cvt_pk_bf16(__builtin_bit_cast(float, kd0[r >> 1]), kdv0); kd1[r >> 1] = cvt_pk_bf16(__builtin_bit_cast(float, kd1[r >> 1]), kdv1);
                         vt0[r >> 1] = cvt_pk_bf16(__builtin_bit_cast(float, vt0[r >> 1]), (float)v[0]); vt1[r >> 1] = cvt_pk_bf16(__builtin_bit_cast(float, vt1[r >> 1]), (float)v[1]); }
            else { kd0[r >> 1] = __builtin_bit_cast(unsigned, kdv0); kd1[r >> 1] = __builtin_bit_cast(unsigned, kdv1);
                   vt0[r >> 1] = __builtin_bit_cast(unsigned, (float)v[0]); vt1[r >> 1] = __builtin_bit_cast(unsigned, (float)v[1]); }
        }
        *(LAS u32x4*)(lds + bw_t0 + HG_KDT) = (u32x4){kd0[0], kd0[1], kd0[2], kd0[3]};
        *(LAS u32x4*)(lds + bw_t1 + HG_KDT) = (u32x4){kd1[0], kd1[1], kd1[2], kd1[3]};
        *(LAS u32x4*)(lds + bw_t0 + HG_VT) = (u32x4){vt0[0], vt0[1], vt0[2], vt0[3]};
        *(LAS u32x4*)(lds + bw_t1 + HG_VT) = (u32x4){vt1[0], vt1[1], vt1[2], vt1[3]};
        __syncthreads();
        if (ch + 1 < ch_hi) { const bool lat2 = FULL && ((ch + 1) >= LC / 64);
#pragma unroll
            for (int r = 0; r < 8; ++r) { const unsigned eo = (unsigned)hgrn_row((ch + 1) * 64 + 8 * wave + r, b, dir) * 512u + chan;
                lfr[r] = *(const unsigned*)(LF + eo); vr[r] = *(const unsigned*)(V + eo); qr[r] = lat2 ? *(const unsigned*)(Q + eo) : 0u; } }
        if (latent) {
#pragma unroll
            for (int rep = 0; rep < 2; ++rep) {
                const int tile = wave + 8 * rep;
                if (tile < 10) {
                    const int ti = tile < 1 ? 0 : tile < 3 ? 1 : tile < 6 ? 2 : 3, si = tile - (ti * (ti + 1)) / 2;
                    f32x4 acc = (f32x4){0.f, 0.f, 0.f, 0.f};
                    LAS unsigned char* pa = lds + br_rm + HG_KT + 16 * si * HG_RP; LAS unsigned char* pb = lds + br_rm + HG_QT + 16 * ti * HG_RP;
#pragma unroll
                    for (int kk = 0; kk < 4; ++kk) acc = __builtin_amdgcn_mfma_f32_16x16x32_bf16(*(LAS s16x8*)(pa + 64 * kk), *(LAS s16x8*)(pb + 64 * kk), acc, 0, 0, 0);
                    const int t = 16 * ti + fr, s0 = 16 * si + 4 * fq;
                    if (ti == si) {
#pragma unroll
                        for (int j = 0; j < 4; ++j) acc[j] = (s0 + j <= t) ? acc[j] : 0.f; }
                    *(LAS u32x2*)(lds + HG_AM + t * 128 + ((((s0 >> 3)) ^ (fr & 7)) << 4) + (s0 & 7) * 2) = (u32x2){cvt_pk_bf16(acc[0], acc[1]), cvt_pk_bf16(acc[2], acc[3])};
                }
            }
        }
        __syncthreads();
        const s16x8 vf0 = *(LAS s16x8*)(lds + br_v0), vf1 = *(LAS s16x8*)(lds + br_v1);
        if (latent) {
            s16x8 sfrag[4];
#pragma unroll
            for (int kk = 0; kk < 4; ++kk) { const unsigned w0 = cvt_pk_bf16(S[2 * kk][0], S[2 * kk][1]), w1 = cvt_pk_bf16(S[2 * kk][2], S[2 * kk][3]),
                                                          w2 = cvt_pk_bf16(S[2 * kk + 1][0], S[2 * kk + 1][1]), w3 = cvt_pk_bf16(S[2 * kk + 1][2], S[2 * kk + 1][3]);
                sfrag[kk] = __builtin_bit_cast(s16x8, (u32x4){w0, w1, w2, w3}); }
#pragma unroll
            for (int ti = 0; ti < 4; ++ti) {
                f32x4 acc = (f32x4){0.f, 0.f, 0.f, 0.f};
                acc = __builtin_amdgcn_mfma_f32_16x16x32_bf16(vf0, *(LAS s16x8*)(lds + br_a0 + 2048 * ti), acc, 0, 0, 0);
                if (ti >= 2) acc = __builtin_amdgcn_mfma_f32_16x16x32_bf16(vf1, *(LAS s16x8*)(lds + br_a1 + 2048 * ti), acc, 0, 0, 0);
#pragma unroll
                for (int kk = 0; kk < 4; ++kk) {
                    const s16x4 lo = *(LAS s16x4*)(lds + br_qd + 16 * ti * HG_RP + 64 * kk), hi = *(LAS s16x4*)(lds + br_qd + 16 * ti * HG_RP + 64 * kk + 32);
                    const s16x8 bf = (s16x8){lo[0], lo[1], lo[2], lo[3], hi[0], hi[1], hi[2], hi[3]};
                    acc = __builtin_amdgcn_mfma_f32_16x16x32_bf16(sfrag[kk], bf, acc, 0, 0, 0); }
                const unsigned oo = (unsigned)hgrn_row(ch * 64 + 16 * ti + fr, b, dir) * 512u + (unsigned)(h * 128 + 16 * wave + 4 * fq);
                *(u32x2*)(O + oo) = (u32x2){pk2(acc[0], acc[1]), pk2(acc[2], acc[3])};
            }
        }
#pragma unroll
        for (int m = 0; m < 8; ++m) {
            const f32x4 dc = *(LAS f32x4*)(DEC + 16 * m + 4 * fq);
            S[m] = S[m] * dc;
            S[m] = __builtin_amdgcn_mfma_f32_16x16x32_bf16(*(LAS s16x8*)(lds + br_k0 + 2048 * m), vf0, S[m], 0, 0, 0);
            S[m] = __builtin_amdgcn_mfma_f32_16x16x32_bf16(*(LAS s16x8*)(lds + br_k1 + 2048 * m), vf1, S[m], 0, 0, 0);
        }
    }
    if (!FULL) {
        float* U = USTATE + (size_t)(item * 3 + seg) * 16384;
#pragma unroll
        for (int m = 0; m < 8; ++m)
#pragma unroll
            for (int j = 0; j < 4; ++j) U[(16 * m + 4 * fq + j) * 128 + 16 * wave + fr] = S[m][j];
        if (wave == 0) *(f32x2*)(DLOG + (size_t)(item * 3 + seg) * 128 + 2 * kp) = (f32x2){dl0, dl1};
    }
    __syncthreads();
}

__device__ __forceinline__ void fft1_phase(const Params& p, LAS unsigned char* lds) {
    LAS float* ctab = (LAS float*)lds;
    LAS float* w16 = ctab + 4096;
    for (int i = threadIdx.x; i < 4096; i += NTHREADS) ctab[i] = cospif((float)i / 2048.0f);
    if (threadIdx.x < 16) { w16[threadIdx.x] = cospif((float)threadIdx.x / 8.0f); w16[16 + threadIdx.x] = sinpif((float)threadIdx.x / 8.0f); }
    __syncthreads();
    const h16* F = (const h16*)(p.ws + OFF_FTT); h16* Y1 = (h16*)(p.ws + OFF_Y1);
    const int ap = threadIdx.x & 127, gl = threadIdx.x >> 7;
    volatile LAS unsigned* slot = (volatile LAS unsigned*)(lds + LDS_BYTES - 64) + 9;
    unsigned* ctr = (unsigned*)(p.ws + OFF_CTL) + CTL_P0Q + 64;
    if (threadIdx.x == 0) slot[0] = xb_add(ctr, 1u);
    __syncthreads();
    int item = (int)slot[0];
    __syncthreads();
    while (item < 8 * 128) {
        unsigned nxt_ = 0u;
        if (threadIdx.x == 0) nxt_ = xb_add(ctr, 1u);
        const int b = item >> 7, gk = (item & 127) * 4 + gl;
        float zr[16][2], zi[16][2];
        const h16* src = F + ((size_t)(b * 512 + gk) * 2) * 4096 + 2 * ap;
#pragma unroll
        for (int r = 0; r < 16; ++r) { const h16x2 c2 = *(const h16x2*)(src + 256 * r), s2 = *(const h16x2*)(src + 4096 + 256 * r);
            zr[r][0] = (float)c2[0]; zr[r][1] = (float)c2[1]; zi[r][0] = -(float)s2[0]; zi[r][1] = -(float)s2[1]; }
        float ur[4][4][2], ui[4][4][2];
#pragma unroll
        for (int r0 = 0; r0 < 4; ++r0)
#pragma unroll
            for (int j = 0; j < 2; ++j) {
                const float a0r = zr[r0][j], a0i = zi[r0][j], a1r = zr[4 + r0][j], a1i = zi[4 + r0][j], a2r = zr[8 + r0][j], a2i = zi[8 + r0][j], a3r = zr[12 + r0][j], a3i = zi[12 + r0][j];
                const float s0r = a0r + a2r, s0i = a0i + a2i, s1r = a0r - a2r, s1i = a0i - a2i, s2r = a1r + a3r, s2i = a1i + a3i, s3r = a1r - a3r, s3i = a1i - a3i;
                float xr[4], xi[4];
                xr[0] = s0r + s2r; xi[0] = s0i + s2i; xr[2] = s0r - s2r; xi[2] = s0i - s2i;
                xr[1] = s1r + s3i; xi[1] = s1i - s3r;
                xr[3] = s1r - s3i; xi[3] = s1i + s3r;
#pragma unroll
                for (int d0 = 0; d0 < 4; ++d0) { const int m = r0 * d0;
                    const float cs = (m == 0) ? 1.f : (m == 1) ? 0.92387953251f : (m == 2) ? 0.70710678119f : (m == 3) ? 0.38268343237f : (m == 4) ? 0.f : (m == 6) ? -0.70710678119f : -0.92387953251f;
                    const float sn = (m == 0) ? 0.f : (m == 1) ? 0.38268343237f : (m == 2) ? 0.70710678119f : (m == 3) ? 0.92387953251f : (m == 4) ? 1.f : (m == 6) ? 0.70710678119f : -0.38268343237f;
                    ur[r0][d0][j] = xr[d0] * cs + xi[d0] * sn; ui[r0][d0][j] = xi[d0] * cs - xr[d0] * sn; } }
#pragma unroll
        for (int d0 = 0; d0 < 4; ++d0) {
            float yr4[4][2], yi4[4][2];
#pragma unroll
            for (int j = 0; j < 2; ++j) {
                const float a0r = ur[0][d0][j], a0i = ui[0][d0][j], a1r = ur[1][d0][j], a1i = ui[1][d0][j], a2r = ur[2][d0][j], a2i = ui[2][d0][j], a3r = ur[3][d0][j], a3i = ui[3][d0][j];
                const float s0r = a0r + a2r, s0i = a0i + a2i, s1r = a0r - a2r, s1i = a0i - a2i, s2r = a1r + a3r, s2i = a1i + a3i, s3r = a1r - a3r, s3i = a1i - a3i;
                yr4[0][j] = s0r + s2r; yi4[0][j] = s0i + s2i; yr4[2][j] = s0r - s2r; yi4[2][j] = s0i - s2i;
                yr4[1][j] = s1r + s3i; yi4[1][j] = s1i - s3r; yr4[3][j] = s1r - s3i; yi4[3][j] = s1i + s3r; }
#pragma unroll
            for (int d1 = 0; d1 < 4; ++d1) { const int d = d0 + 4 * d1;
                float ore[2], oim[2];
#pragma unroll
                for (int j = 0; j < 2; ++j) { const int t = ((2 * ap + j) * d) & 4095; const float ct = ctab[t], st = ctab[(t - 1024) & 4095];
                    ore[j] = (yr4[d1][j] * ct + yi4[d1][j] * st) * 0.0625f; oim[j] = (yi4[d1][j] * ct - yr4[d1][j] * st) * 0.0625f; }
            h16* dst = Y1 + ((size_t)((b * 16 + d) * 512 + gk)) * 512 + 2 * ap;
            *(unsigned*)dst = pk2(ore[0], ore[1]); *(unsigned*)(dst + 256) = pk2(oim[0], oim[1]);
            }
        }
        if (threadIdx.x == 0) slot[0] = nxt_;
        __syncthreads();
        item = (int)slot[0];
        __syncthreads();
    }
    __syncthreads();
}

__device__ __forceinline__ void a1_prepass(const Params& p) {
    const int wave = threadIdx.x >> 6, lane = threadIdx.x & 63;
    const h16* OF = (const h16*)(p.ws + OFF_OF); const h16* OB = (const h16*)(p.ws + OFF_OB); h16* G = (h16*)(p.ws + OFF_G);
    const float* hgn = p.in[11];
    float hg[8];
#pragma unroll
    for (int j = 0; j < 8; ++j) hg[j] = hgn[lane * 8 + j];
    for (int t0 = (blockIdx.x * 8 + wave) * 4; t0 < T; t0 += gridDim.x * 32) {
        h16x8 a[4], bq[4], g[4];
#pragma unroll
        for (int q = 0; q < 4; ++q) { const size_t off = (size_t)(t0 + q) * 512 + lane * 8; a[q] = *(const h16x8*)(OF + off); bq[q] = *(const h16x8*)(OB + off); g[q] = *(const h16x8*)(G + off); }
#pragma unroll
        for (int q = 0; q < 4; ++q) {
            float o[8]; float ss = 0.f;
#pragma unroll
            for (int j = 0; j < 8; ++j) { o[j] = (float)a[q][j] + (float)bq[q][j]; ss += o[j] * o[j]; }
            ss += __shfl_xor(ss, 1); ss += __shfl_xor(ss, 2); ss += __shfl_xor(ss, 4); ss += __shfl_xor(ss, 8);
            const float rstd = rsqrtf(ss * (1.0f / 128.0f) + EPS);
            float r[8];
#pragma unroll
            for (int j = 0; j < 8; ++j) { const float gz = (float)g[q][j]; r[j] = o[j] * rstd * hg[j] * (gz * sigmoidf_(gz)); }
            u32x4 w; w.x = pk2(r[0], r[1]); w.y = pk2(r[2], r[3]); w.z = pk2(r[4], r[5]); w.w = pk2(r[6], r[7]);
            *(u32x4*)(G + (size_t)(t0 + q) * 512 + lane * 8) = w;
        }
    }
}

__device__ __forceinline__ void convert_tables(const Params& p, int vb, int vn) {
    const int wave = threadIdx.x >> 6, lane = threadIdx.x & 63;
    for (int r2 = vb * 8 + wave; r2 < 2 * 16384; r2 += vn * 8) {
        const int tb = r2 >> 14, e = r2 & 16383;
        const float* src = (tb ? p.in[18] : p.in[17]) + (size_t)e * D + lane * 16;
        f32x4 v[4]; float amax = 0.f;
#pragma unroll
        for (int j = 0; j < 4; ++j) { v[j] = *(const f32x4*)(src + 4 * j); amax = fmaxf(amax, fmaxf(fmaxf(fabsf(v[j].x), fabsf(v[j].y)), fmaxf(fabsf(v[j].z), fabsf(v[j].w)))); }
#pragma unroll
        for (int o = 32; o >= 1; o >>= 1) amax = fmaxf(amax, __shfl_xor(amax, o));
        const float qs = amax > 0.f ? amax * (1.0f / 127.0f) : 1.0f, inv = 1.0f / qs;
        const int bias = 0;
        u32x4 w;
#pragma unroll
        for (int j = 0; j < 4; ++j) { const int q0 = (int)rintf(v[j].x * inv) + bias, q1 = (int)rintf(v[j].y * inv) + bias, q2 = (int)rintf(v[j].z * inv) + bias, q3 = (int)rintf(v[j].w * inv) + bias;
            w[j] = (unsigned)(q0 & 255) | ((unsigned)(q1 & 255) << 8) | ((unsigned)(q2 & 255) << 16) | ((unsigned)(q3 & 255) << 24); }
        unsigned char* dst = p.ws + (tb ? OFF_TV : OFF_TU);
        *(u32x4*)(dst + ((size_t)(lane >> 3) * 16384 + e) * 128 + (lane & 7) * 16) = w;
        if (lane == 0) ((float*)(p.ws + (tb ? OFF_SV : OFF_SU)))[e] = qs;
    }
}

#define CE_DESC(a, b) do { const unsigned hi_ = max(a, b), lo_ = min(a, b); a = hi_; b = lo_; } while (0)
template <int N> __device__ __forceinline__ void sort16_desc(unsigned (&k)[N], const int base) {
    CE_DESC(k[base + 0], k[base + 1]); CE_DESC(k[base + 2], k[base + 3]); CE_DESC(k[base + 0], k[base + 2]); CE_DESC(k[base + 1], k[base + 3]); CE_DESC(k[base + 1], k[base + 2]); CE_DESC(k[base + 4], k[base + 5]); CE_DESC(k[base + 6], k[base + 7]); CE_DESC(k[base + 4], k[base + 6]);
    CE_DESC(k[base + 5], k[base + 7]); CE_DESC(k[base + 5], k[base + 6]); CE_DESC(k[base + 0], k[base + 4]); CE_DESC(k[base + 2], k[base + 6]); CE_DESC(k[base + 2], k[base + 4]); CE_DESC(k[base + 1], k[base + 5]); CE_DESC(k[base + 3], k[base + 7]); CE_DESC(k[base + 3], k[base + 5]);
    CE_DESC(k[base + 1], k[base + 2]); CE_DESC(k[base + 3], k[base + 4]); CE_DESC(k[base + 5], k[base + 6]); CE_DESC(k[base + 8], k[base + 9]); CE_DESC(k[base + 10], k[base + 11]); CE_DESC(k[base + 8], k[base + 10]); CE_DESC(k[base + 9], k[base + 11]); CE_DESC(k[base + 9], k[base + 10]);
    CE_DESC(k[base + 12], k[base + 13]); CE_DESC(k[base + 14], k[base + 15]); CE_DESC(k[base + 12], k[base + 14]); CE_DESC(k[base + 13], k[base + 15]); CE_DESC(k[base + 13], k[base + 14]); CE_DESC(k[base + 8], k[base + 12]); CE_DESC(k[base + 10], k[base + 14]); CE_DESC(k[base + 10], k[base + 12]);
    CE_DESC(k[base + 9], k[base + 13]); CE_DESC(k[base + 11], k[base + 15]); CE_DESC(k[base + 11], k[base + 13]); CE_DESC(k[base + 9], k[base + 10]); CE_DESC(k[base + 11], k[base + 12]); CE_DESC(k[base + 13], k[base + 14]); CE_DESC(k[base + 0], k[base + 8]); CE_DESC(k[base + 4], k[base + 12]);
    CE_DESC(k[base + 4], k[base + 8]); CE_DESC(k[base + 2], k[base + 10]); CE_DESC(k[base + 6], k[base + 14]); CE_DESC(k[base + 6], k[base + 10]); CE_DESC(k[base + 2], k[base + 4]); CE_DESC(k[base + 6], k[base + 8]); CE_DESC(k[base + 10], k[base + 12]); CE_DESC(k[base + 1], k[base + 9]);
    CE_DESC(k[base + 5], k[base + 13]); CE_DESC(k[base + 5], k[base + 9]); CE_DESC(k[base + 3], k[base + 11]); CE_DESC(k[base + 7], k[base + 15]); CE_DESC(k[base + 7], k[base + 11]); CE_DESC(k[base + 3], k[base + 5]); CE_DESC(k[base + 7], k[base + 9]); CE_DESC(k[base + 11], k[base + 13]);
    CE_DESC(k[base + 1], k[base + 2]); CE_DESC(k[base + 3], k[base + 4]); CE_DESC(k[base + 5], k[base + 6]); CE_DESC(k[base + 7], k[base + 8]); CE_DESC(k[base + 9], k[base + 10]); CE_DESC(k[base + 11], k[base + 12]); CE_DESC(k[base + 13], k[base + 14]);
}
template <int N> __device__ __forceinline__ void merge16_desc(unsigned (&k)[N], const int a, const int b) {
#pragma unroll
    for (int i = 0; i < 16; ++i) k[a + i] = max(k[a + i], k[b + 15 - i]);
#pragma unroll
    for (int stride = 8; stride > 0; stride /= 2)
#pragma unroll
        for (int i = 0; i < 16; ++i) if ((i & stride) == 0) CE_DESC(k[a + i], k[a + i + stride]);
}
__device__ __forceinline__ float hkey2f(unsigned key) { const unsigned u = key >> 16, b = (u & 0x8000u) ? (u ^ 0x8000u) : (~u & 0xFFFFu); return (float)__builtin_bit_cast(h16, (unsigned short)b); }
__device__ __forceinline__ void top16_of_128(const unsigned char* sc, unsigned (&out)[16]) {
    unsigned s[128];
#pragma unroll
    for (int c8 = 0; c8 < 16; ++c8) { const u32x4 t = *(const u32x4*)(sc + c8 * 1024);
#pragma unroll
        for (int w = 0; w < 4; ++w) { const int e0 = 2 * w, e1 = 2 * w + 1;
            const int col0 = 32 * (c8 >> 2) + 16 * (e0 >> 2) + 4 * (c8 & 3) + (e0 & 3), col1 = 32 * (c8 >> 2) + 16 * (e1 >> 2) + 4 * (c8 & 3) + (e1 & 3);
            s[8 * c8 + e0] = (t[w] << 16) | (unsigned)(127 - col0); s[8 * c8 + e1] = (t[w] & 0xFFFF0000u) | (unsigned)(127 - col1); } }
#pragma unroll
    for (int g = 0; g < 8; ++g) sort16_desc(s, 16 * g);
    merge16_desc(s, 0, 16); merge16_desc(s, 32, 48); merge16_desc(s, 64, 80); merge16_desc(s, 96, 112);
    merge16_desc(s, 0, 32); merge16_desc(s, 64, 96);
    merge16_desc(s, 0, 64);
#pragma unroll
    for (int i = 0; i < 16; ++i) out[i] = s[i];
}
__device__ __forceinline__ void topk_phase(const Params& p, LAS unsigned char* lds) {
    const unsigned char* SC = p.ws + OFF_SC; int* EIDX = (int*)(p.ws + OFF_EIDX); float* GATE = (float*)(p.ws + OFF_GATE);
    LAS unsigned* st = (LAS unsigned*)lds;
    const int tid = threadIdx.x;
#ifndef TOPK_REP
#define TOPK_REP 1
#endif
    for (int rr_ = 0; rr_ < TOPK_REP; ++rr_)
    for (int base = blockIdx.x * 4; base < (T / 64) * 8; base += gridDim.x * 4) {
        {
            const int w = tid >> 6, L = tid & 63, grp = base + (w >> 1), pp = w & 1;
            unsigned ks[16];
#pragma unroll
            for (int i = 0; i < 16; ++i) ks[i] = 0u;
            top16_of_128(SC + ((size_t)(grp * 2 + pp) * 16 * 64 + L) * 16, ks);
#pragma unroll
            for (int i = 0; i < 16; ++i) st[i * NTHREADS + tid] = ks[i];
        }
        __syncthreads();
        if (tid < 256) {
            const int q = tid >> 6, L = tid & 63, grp = base + q, tb = grp >> 3, hh = grp & 7;
            const int th = (tb * 64 + L) * 8 + hh;
            const int s0 = (2 * q) * 64 + L, s1 = (2 * q + 1) * 64 + L;
            float sv1[16];
#pragma unroll
            for (int j = 0; j < 16; ++j) sv1[j] = hkey2f(st[j * NTHREADS + s1]);
            unsigned cv[50];
            { int c = 0;
#pragma unroll
              for (int i = 0; i < 16; ++i) { const float a = hkey2f(st[i * NTHREADS + s0]);
#pragma unroll
                  for (int j = 0; j < 16; ++j) if ((i + 1) * (j + 1) <= 16) { cv[c] = (f2key(a + sv1[j]) & ~255u) | (unsigned)(255 - (i * 16 + j)); ++c; } } }
            unsigned c64[64];
#pragma unroll
            for (int i = 0; i < 64; ++i) c64[i] = (i < 50) ? cv[i] : 0u;
#pragma unroll
            for (int g = 0; g < 4; ++g) sort16_desc(c64, 16 * g);
            merge16_desc(c64, 0, 16); merge16_desc(c64, 32, 48); merge16_desc(c64, 0, 32);
            unsigned ok[16];
#pragma unroll
            for (int i = 0; i < 16; ++i) ok[i] = c64[i];
            float ex[16]; int oe[16]; float den = 0.f;
            const float v0 = key2f(ok[0] & ~255u);
#pragma unroll
            for (int i = 0; i < 16; ++i) { const int ij = 255 - (int)(ok[i] & 255u), ci = ij >> 4, cj = ij & 15;
                const int e0 = 127 - (int)(st[ci * NTHREADS + s0] & 127u), e1 = 127 - (int)(st[cj * NTHREADS + s1] & 127u);
                oe[i] = e0 * 128 + e1; ex[i] = __expf(key2f(ok[i] & ~255u) - v0); den += ex[i]; }
            const float inv = 1.0f / den;
#pragma unroll
            for (int i = 0; i < 4; ++i) {
                *(f32x4*)(GATE + (size_t)th * 16 + 4 * i) = (f32x4){ex[4 * i] * inv, ex[4 * i + 1] * inv, ex[4 * i + 2] * inv, ex[4 * i + 3] * inv};
                *(int4*)(EIDX + (size_t)th * 16 + 4 * i) = make_int4(oe[4 * i], oe[4 * i + 1], oe[4 * i + 2], oe[4 * i + 3]); }
        }
        __syncthreads();
    }
}

struct XcdInfo { int px, npop, rank, nloc; };
__device__ __forceinline__ float dot8(const h16x8 a, const h16x8 b, float s) {
    s = __builtin_amdgcn_fdot2((h16x2){a[0], a[1]}, (h16x2){b[0], b[1]}, s, false); s = __builtin_amdgcn_fdot2((h16x2){a[2], a[3]}, (h16x2){b[2], b[3]}, s, false);
    s = __builtin_amdgcn_fdot2((h16x2){a[4], a[5]}, (h16x2){b[4], b[5]}, s, false); s = __builtin_amdgcn_fdot2((h16x2){a[6], a[7]}, (h16x2){b[6], b[7]}, s, false); return s; }
struct PeerTok { int t; bool ok; };
#define PEER_TOUCH(R) do { unsigned tt_ = (R).w; asm volatile("" : "+v"(tt_)); (R).w = tt_; __builtin_amdgcn_sched_barrier(0); } while (0)
__device__ __forceinline__ PeerTok peer_tok(int i, int t0, int step) { const int t = t0 + i * step; PeerTok r; r.ok = t < T; r.t = r.ok ? t : (T - 1); return r; }
__device__ __forceinline__ void peer_ld_e(const int* EIDX, int t, int g, int (&e)[16]) {
#pragma unroll
    for (int q = 0; q < 4; ++q) { const int4 v = *(const int4*)(EIDX + (size_t)t * 128 + 16 * g + 4 * q); e[4 * q] = v.x; e[4 * q + 1] = v.y; e[4 * q + 2] = v.z; e[4 * q + 3] = v.w; } }
__device__ __forceinline__ void peer_ld_rows(const unsigned char* tab, const int (&e)[16], u32x4 (&r)[16]) {
#pragma unroll
    for (int j = 0; j < 16; ++j) r[j] = *(const u32x4*)(tab + (size_t)e[j] * 128); }
__device__ __forceinline__ void peer_u_compute(const u32x4 (&r)[16], const u32x4 xv, h16* PACT, int s, PeerTok tk, int lane, int g, int c) {
    float pj[16];
#pragma unroll
    for (int j = 0; j < 16; ++j) { int d = __builtin_amdgcn_sdot4((int)r[j].x, (int)xv.x, 0, false); d = __builtin_amdgcn_sdot4((int)r[j].y, (int)xv.y, d, false);
        d = __builtin_amdgcn_sdot4((int)r[j].z, (int)xv.z, d, false); d = __builtin_amdgcn_sdot4((int)r[j].w, (int)xv.w, d, false); pj[j] = (float)d; }
#define RED_STEP(NIN, MASK) _Pragma("unroll") for (int j = 0; j < (NIN) / 2; ++j) { const bool up = (lane & (MASK)) != 0; \
    const float keep = up ? pj[2 * j + 1] : pj[2 * j], send = up ? pj[2 * j] : pj[2 * j + 1]; pj[j] = keep + __shfl_xor(send, (MASK)); }
    RED_STEP(16, 1) RED_STEP(8, 2) RED_STEP(4, 4)
#undef RED_STEP
    { const bool up = (lane & 1) != 0; const float keep = up ? pj[1] : pj[0], send = up ? pj[0] : pj[1], recv = __shfl_xor(send, 1);
      const unsigned w = up ? pk2(recv * 0.015625f, keep * 0.015625f) : pk2(keep * 0.015625f, recv * 0.015625f);
      if (tk.ok) *(unsigned*)(PACT + ((size_t)s * T + tk.t) * 128 + 16 * g + (up ? 7 + c : c)) = w; }
}
__device__ __forceinline__ void peer_u_phase(const Params& p, const XcdInfo xi) {
    const int wave = threadIdx.x >> 6, lane = threadIdx.x & 63, g = lane >> 3, c = lane & 7;
    const unsigned char* QX = (const unsigned char*)(p.ws + OFF_QX); const unsigned char* TU = (const unsigned char*)(p.ws + OFF_TU);
    const int* EIDX = (const int*)(p.ws + OFF_EIDX); h16* PACT = (h16*)(p.ws + OFF_PACT);
    const int t0 = xi.rank * 8 + wave, step = xi.nloc * 8, ntok = (T - t0 + step - 1) / step;
    for (int s = xi.px; s < 8; s += xi.npop) {
        const unsigned char* tus = TU + (size_t)s * 16384 * 128 + 16 * c; const unsigned char* qxs = QX + s * 128 + 16 * c;
        int eN[16]; u32x4 rA[16], rB[16]; u32x4 xA, xB;
        { PeerTok k0 = peer_tok(0, t0, step); peer_ld_e(EIDX, k0.t, g, eN); xA = *(const u32x4*)(qxs + (size_t)k0.t * D); peer_ld_rows(tus, eN, rA);
          PeerTok k1 = peer_tok(1, t0, step); peer_ld_e(EIDX, k1.t, g, eN); }
        for (int i = 0; i < ntok; i += 2) {
            { const PeerTok k1 = peer_tok(i + 1, t0, step), k2 = peer_tok(i + 2, t0, step);
              PEER_TOUCH(rA[15]);
              xB = *(const u32x4*)(qxs + (size_t)k1.t * D); peer_ld_rows(tus, eN, rB); peer_ld_e(EIDX, k2.t, g, eN);
              __builtin_amdgcn_sched_barrier(0);
              peer_u_compute(rA, xA, PACT, s, peer_tok(i, t0, step), lane, g, c);
              __builtin_amdgcn_sched_barrier(0); }
            { const PeerTok k2 = peer_tok(i + 2, t0, step), k3 = peer_tok(i + 3, t0, step);
              PEER_TOUCH(rB[15]);
              xA = *(const u32x4*)(qxs + (size_t)k2.t * D); peer_ld_rows(tus, eN, rA); peer_ld_e(EIDX, k3.t, g, eN);
              __builtin_amdgcn_sched_barrier(0);
              PeerTok k1 = peer_tok(i + 1, t0, step); k1.ok = k1.ok && (i + 1 < ntok);
              peer_u_compute(rB, xB, PACT, s, k1, lane, g, c);
              __builtin_amdgcn_sched_barrier(0); }
        }
    }
}
#ifdef PEER_U_MFMA
#define KIDX kslot
#else
#define KIDX k
#endif
__device__ __forceinline__ void peer_combine(const Params& p) {
    const int wave = threadIdx.x >> 6, lane = threadIdx.x & 63;
    const h16* PACT = (const h16*)(p.ws + OFF_PACT); const float* GATE = (const float*)(p.ws + OFF_GATE); unsigned char* SIDE = p.ws + OFF_SIDE;
    const int* EIDX = (const int*)(p.ws + OFF_EIDX); const float* SU = (const float*)(p.ws + OFF_SU); const float* SV = (const float*)(p.ws + OFF_SV); const float* SX = (const float*)(p.ws + OFF_SX);
    for (int t = blockIdx.x * 8 + wave; t < T; t += gridDim.x * 8) {
        const float sx = SX[t] * 64.0f; float w[2]; float a[2] = {0.f, 0.f}; float amax = 0.f;
#pragma unroll
        for (int s = 0; s < 8; ++s) { const h16x2 v = *(const h16x2*)(PACT + ((size_t)s * T + t) * 128 + 2 * lane); a[0] += (float)v[0]; a[1] += (float)v[1]; }
        const int2 e2 = *(const int2*)(EIDX + (size_t)t * 128 + 2 * lane); const float2 g2 = *(const float2*)(GATE + (size_t)t * 128 + 2 * lane);
        const int e[2] = {e2.x, e2.y}; const float gt[2] = {g2.x, g2.y};
#pragma unroll
        for (int j = 0; j < 2; ++j) {
            const float act = a[j] * sx * SU[e[j]];
            w[j] = gt[j] * (0.5f * act * (1.0f + erff(act * 0.70710678118654752f))) * SV[e[j]];
            amax = fmaxf(amax, fabsf(w[j])); }
#pragma unroll
        for (int o = 32; o >= 1; o >>= 1) amax = fmaxf(amax, __shfl_xor(amax, o));
        const float inv = amax > 0.f ? 16256.0f / amax : 0.f;
        unsigned char* rec = SIDE + (size_t)t * 1024;
        *(int2*)(rec + 8 * lane) = e2;
#pragma unroll
        for (int j = 0; j < 2; ++j) { const int k = 2 * lane + j; const int W = (int)rintf(w[j] * inv); const int hi = W >> 7, lo = W & 127;
            const int y = k >> 4, ks = (k >> 3) & 1, h = (k >> 2) & 1, gk = k & 3, off = 512 + ks * 128 + gk * 16 + 8 * h + y;
            rec[off] = (unsigned char)(hi & 255); rec[off + 64] = (unsigned char)lo; }
        if (lane == 0) *(float*)(rec + 768) = amax * (1.0f / 16256.0f);
    }
}
typedef int i32x4 __attribute__((ext_vector_type(4)));
__device__ __forceinline__ unsigned lds_addr(const volatile LAS void* p) { return (unsigned)(size_t)p; }
__device__ __forceinline__ void glds16_asm(const void* gsrc, unsigned lds_dst) {
    unsigned keep;
    asm volatile("s_mov_b32 %0, m0\n\ts_mov_b32 m0, %2\n\ts_nop 0\n\tglobal_load_lds_dwordx4 %1, off\n\ts_mov_b32 m0, %0" : "=&s"(keep) : "v"(gsrc), "s"(lds_dst) : "memory");
}
#define PV_WAIT_VM(n) asm volatile("s_waitcnt vmcnt(" #n ")" ::: "memory")
__device__ __forceinline__ void pv_fill(const unsigned char* tvs, LAS unsigned char* lds, unsigned side_slot, unsigned ring_buf, const int ks, int lane) {
    const int g = lane >> 3;
    const u32x4 i0 = *(LAS u32x4*)(lds + side_slot + (16 * g + 8 * ks) * 4), i1 = *(LAS u32x4*)(lds + side_slot + (16 * g + 8 * ks + 4) * 4);
    const unsigned ids[8] = {i0.x, i0.y, i0.z, i0.w, i1.x, i1.y, i1.z, i1.w};
#pragma unroll
    for (int m = 0; m < 8; ++m) glds16_asm(tvs + (size_t)ids[m] * 128 + ((((lane & 7) ^ g ^ (m & 1))) << 4), ring_buf + m * 1024);
}
__device__ __forceinline__ void pv_kstep(LAS unsigned char* lds, unsigned ring_buf, const i32x4 afrag, i32x4 (&acc)[8], int lane) {
    const int gk = lane >> 4, q = (lane & 15) >> 1, pp = lane & 1;
    const unsigned base0 = ring_buf + (8 * gk + q) * 128 + 8 * pp;
    const int xr = q ^ (gk & 1);
#pragma unroll
    for (int ng = 0; ng < 2; ++ng) {
        u32x2 r[8];
#pragma unroll
        for (int j = 0; j < 4; ++j) { const int n = 4 * ng + j;
#pragma unroll
            for (int h = 0; h < 2; ++h) { const unsigned a = base0 + h * 4096 + (((unsigned)(n ^ xr)) << 4);
                asm volatile("ds_read_b64_tr_b8 %0, %1" : "=v"(r[2 * j + h]) : "v"(a) : "memory"); } }
        asm volatile("s_waitcnt lgkmcnt(0)" : "+v"(r[0]), "+v"(r[1]), "+v"(r[2]), "+v"(r[3]), "+v"(r[4]), "+v"(r[5]), "+v"(r[6]), "+v"(r[7]) :: "memory");
        __builtin_amdgcn_sched_barrier(0);
#pragma unroll
        for (int j = 0; j < 4; ++j) { const i32x4 bf = (i32x4){(int)r[2 * j].x, (int)r[2 * j].y, (int)r[2 * j + 1].x, (int)r[2 * j + 1].y};
            acc[4 * ng + j] = __builtin_amdgcn_mfma_i32_16x16x64_i8(afrag, bf, acc[4 * ng + j], 0, 0, 0); }
    }
}
__device__ __forceinline__ void peer_v_phase(const Params& p, LAS unsigned char* lds, const XcdInfo xi) {
    const int wave = __builtin_amdgcn_readfirstlane(threadIdx.x >> 6), lane = threadIdx.x & 63;
    const unsigned char* TV = p.ws + OFF_TV; const unsigned char* SIDE = p.ws + OFF_SIDE; h16* PO = (h16*)(p.ws + OFF_PO);
    const int t0 = xi.rank * 8 + wave, step = xi.nloc * 8, ntok = (T - t0 + step - 1) / step;
    const unsigned ring = __builtin_amdgcn_readfirstlane(lds_addr(lds + wave * 16384)), side = __builtin_amdgcn_readfirstlane(lds_addr(lds + 131072 + wave * 3072));
    LAS unsigned char* l0 = (LAS unsigned char*)0;
    for (int s = xi.px; s < 8; s += xi.npop) {
        const unsigned char* tvs = TV + (size_t)s * 16384 * 128;
        glds16_asm(SIDE + (size_t)peer_tok(0, t0, step).t * 1024 + lane * 16, side);
        glds16_asm(SIDE + (size_t)peer_tok(1, t0, step).t * 1024 + lane * 16, side + 1024);
        PV_WAIT_VM(0);
        pv_fill(tvs, l0, side, ring, 0, lane); pv_fill(tvs, l0, side, ring + 8192, 1, lane);
        for (int i = 0; i < ntok; ++i) {
            const unsigned sl_cur = side + (unsigned)(i % 3) * 1024, sl_nxt = side + (unsigned)((i + 1) % 3) * 1024, sl_nn = side + (unsigned)((i + 2) % 3) * 1024;
            i32x4 acc[8];
#pragma unroll
            for (int n = 0; n < 8; ++n) acc[n] = (i32x4){0, 0, 0, 0};
            if (i == 0) PV_WAIT_VM(8); else PV_WAIT_VM(16);
            const int fi = lane & 15;
            const i32x4 z4 = (i32x4){0, 0, 0, 0};
            i32x4 af = *(LAS i32x4*)(l0 + sl_cur + 512 + (fi < 2 ? fi : 0) * 64 + (lane >> 4) * 16); af = fi < 2 ? af : z4;
            pv_kstep(l0, ring, af, acc, lane);
            glds16_asm(SIDE + (size_t)peer_tok(i + 2, t0, step).t * 1024 + lane * 16, sl_nn);
            pv_fill(tvs, l0, sl_nxt, ring, 0, lane);
            PV_WAIT_VM(9);
            af = *(LAS i32x4*)(l0 + sl_cur + 512 + 128 + (fi < 2 ? fi : 0) * 64 + (lane >> 4) * 16); af = fi < 2 ? af : z4;
            pv_kstep(l0, ring + 8192, af, acc, lane);
            const float sw = *(LAS float*)(l0 + sl_cur + 768);
            const PeerTok tk = peer_tok(i, t0, step);
            h16* po = PO + (size_t)(tk.ok ? tk.t : T) * D + s * 128 + (lane & 15);
            if (lane < 16) {
#pragma unroll
                for (int n = 0; n < 8; ++n) { const h16 v = (h16)((float)(128 * acc[n][0] + acc[n][1]) * sw); const unsigned vb = (unsigned)__builtin_bit_cast(unsigned short, v);
                    asm volatile("global_store_short %0, %1, off" :: "v"(po + 16 * n), "v"(vb) : "memory"); }
            }
            pv_fill(tvs, l0, sl_nxt, ring + 8192, 1, lane);
        }
        PV_WAIT_VM(0);
    }
}
__device__ __forceinline__ void pu_buffer(LAS unsigned char* l0, unsigned ring_buf, unsigned side_slot, i32x4 (&acc)[4], int lane) {
    const int i = lane & 15, gk = lane >> 4;
#pragma unroll
    for (int kc = 0; kc < 2; ++kc) {
        i32x4 bx = *(LAS i32x4*)(l0 + side_slot + 512 + 64 * kc + 16 * gk); bx = (i == 0) ? bx : (i32x4){0, 0, 0, 0};
#pragma unroll
        for (int mt = 0; mt < 4; ++mt) { const int r = 16 * mt + i;
            const i32x4 af = *(LAS i32x4*)(l0 + ring_buf + r * 128 + ((((4 * kc + gk) ^ (r & 7) ^ ((r >> 3) & 1))) << 4));
            acc[mt] = __builtin_amdgcn_mfma_i32_16x16x64_i8(af, bx, acc[mt], 0, 0, 0); }
    }
}
__device__ __forceinline__ void peer_u_phase_mfma(const Params& p, LAS unsigned char* lds, const XcdInfo xi) {
    const int wave = __builtin_amdgcn_readfirstlane(threadIdx.x >> 6), lane = threadIdx.x & 63;
    const unsigned char* TU = p.ws + OFF_TU; const unsigned char* QX = p.ws + OFF_QX; const unsigned char* EIDX = p.ws + OFF_EIDX; float* PACT = (float*)(p.ws + OFF_PACT);
    const int t0 = xi.rank * 8 + wave, step = xi.nloc * 8, ntok = (T - t0 + step - 1) / step;
    const unsigned ring = __builtin_amdgcn_readfirstlane(lds_addr(lds + wave * 16384)), side = __builtin_amdgcn_readfirstlane(lds_addr(lds + 131072 + wave * 3072));
    LAS unsigned char* l0 = (LAS unsigned char*)0;
    for (int s = xi.px; s < 8; s += xi.npop) {
        const unsigned char* tus = TU + (size_t)s * 16384 * 128;
#define PU_SIDE(tt, dst) glds16_asm(lane < 32 ? (const void*)(EIDX + (size_t)(tt) * 512 + lane * 16) : (const void*)(QX + (size_t)(tt) * D + s * 128 + ((lane & 7) * 16)), dst)
        PU_SIDE(peer_tok(0, t0, step).t, side);
        PU_SIDE(peer_tok(1, t0, step).t, side + 1024);
        PV_WAIT_VM(0);
        pv_fill(tus, l0, side, ring, 0, lane); pv_fill(tus, l0, side, ring + 8192, 1, lane);
        for (int i = 0; i < ntok; ++i) {
            const unsigned sl_cur = side + (unsigned)(i % 3) * 1024, sl_nxt = side + (unsigned)((i + 1) % 3) * 1024, sl_nn = side + (unsigned)((i + 2) % 3) * 1024;
            i32x4 acc0[4], acc1[4];
#pragma unroll
            for (int n = 0; n < 4; ++n) { acc0[n] = (i32x4){0, 0, 0, 0}; acc1[n] = (i32x4){0, 0, 0, 0}; }
            if (i == 0) PV_WAIT_VM(8); else PV_WAIT_VM(16);
            pu_buffer(l0, ring, sl_cur, acc0, lane);
            PU_SIDE(peer_tok(i + 2, t0, step).t, sl_nn);
            pv_fill(tus, l0, sl_nxt, ring, 0, lane);
            PV_WAIT_VM(9);
            pu_buffer(l0, ring + 8192, sl_cur, acc1, lane);
            const PeerTok tk = peer_tok(i, t0, step);
            float* po = PACT + ((size_t)s * T + (tk.ok ? tk.t : 0)) * 128 + 4 * (lane >> 4);
            if ((lane & 15) == 0) {
#pragma unroll
                for (int mt = 0; mt < 4; ++mt) {
                    const f32x4 v0 = (f32x4){(float)acc0[mt][0], (float)acc0[mt][1], (float)acc0[mt][2], (float)acc0[mt][3]}, v1 = (f32x4){(float)acc1[mt][0], (float)acc1[mt][1], (float)acc1[mt][2], (float)acc1[mt][3]};
                    float* d0 = tk.ok ? po + 16 * mt : (float*)(p.ws + OFF_PO) , *d1 = tk.ok ? po + 64 + 16 * mt : (float*)(p.ws + OFF_PO);
                    asm volatile("global_store_dwordx4 %0, %1, off\n\ts_nop 1" :: "v"(d0), "v"(v0) : "memory");
                    asm volatile("global_store_dwordx4 %0, %1, off\n\ts_nop 1" :: "v"(d1), "v"(v1) : "memory"); }
            }
            pv_fill(tus, l0, sl_nxt, ring + 8192, 1, lane);
        }
        PV_WAIT_VM(0);
#undef PU_SIDE
    }
}
__device__ __forceinline__ void peer_final(const Params& p) {
    const int wave = threadIdx.x >> 6, lane = threadIdx.x & 63;
    float* OUT = p.out; const h16* H16 = (const h16*)(p.ws + OFF_H16); const h16* PO = (const h16*)(p.ws + OFF_PO); const float* mod = (const float*)(p.ws + OFF_MOD); const float* fg = p.in[19];
    for (int t0 = (blockIdx.x * 8 + wave) * 2; t0 < T; t0 += gridDim.x * 16) {
        h16x4 hv[2][4], ph[2][4];
#pragma unroll
        for (int q = 0; q < 2; ++q)
#pragma unroll
            for (int j = 0; j < 4; ++j) { const int cc = j * 256 + lane * 4; hv[q][j] = *(const h16x4*)(H16 + (size_t)(t0 + q) * D + cc); ph[q][j] = *(const h16x4*)(PO + (size_t)(t0 + q) * D + cc); }
#pragma unroll
        for (int q = 0; q < 2; ++q) { const int t = t0 + q;
            f32x4 h2[4]; float ss = 0.f;
#pragma unroll
            for (int j = 0; j < 4; ++j) { const int cc = j * 256 + lane * 4;
                const f32x4 pv = (f32x4){(float)ph[q][j][0], (float)ph[q][j][1], (float)ph[q][j][2], (float)ph[q][j][3]}, gv = *(const f32x4*)(mod + (t >> 12) * 6144 + 5120 + cc);
                h2[j] = (f32x4){(float)hv[q][j][0], (float)hv[q][j][1], (float)hv[q][j][2], (float)hv[q][j][3]} + gv * pv; ss += h2[j].x * h2[j].x + h2[j].y * h2[j].y + h2[j].z * h2[j].z + h2[j].w * h2[j].w; }
            ss = wave_sum(ss);
            const float rstd = rsqrtf(ss * (1.0f / D) + EPS);
#pragma unroll
            for (int j = 0; j < 4; ++j) { const int cc = j * 256 + lane * 4; const f32x4 fv = *(const f32x4*)(fg + cc);
                *(f32x4*)(OUT + (size_t)t * D + cc) = h2[j] * rstd * fv; }
        }
    }
}
#ifndef REP_A
#define REP_A 1
#endif
#ifndef REP_FT
#define REP_FT 1
#endif
#ifndef REP_DFT
#define REP_DFT 1
#endif
#ifndef REP_GATE
#define REP_GATE 1
#endif
#ifndef REP_M2
#define REP_M2 1
#endif
#ifndef REP_M1
#define REP_M1 1
#endif
#ifndef REP_SC
#define REP_SC 1
#endif
constexpr int N_PHASES = 15;
#ifndef MK_CGSYNC
#define MK_CGSYNC 0
#endif
__device__ __forceinline__ Params load_params(volatile LAS unsigned* pw) {
    Params q;
    unsigned long long v[22];
#pragma unroll
    for (int i = 0; i < 22; ++i) { const unsigned lo = (unsigned)__builtin_amdgcn_readfirstlane((int)pw[2 * i]), hi = (unsigned)__builtin_amdgcn_readfirstlane((int)pw[2 * i + 1]); v[i] = ((unsigned long long)hi << 32) | lo; }
#pragma unroll
    for (int i = 0; i < 20; ++i) q.in[i] = (const float*)v[i];
    q.out = (float*)v[20]; q.ws = (unsigned char*)v[21];
    q.ph_lo = __builtin_amdgcn_readfirstlane((int)pw[44]); q.ph_hi = __builtin_amdgcn_readfirstlane((int)pw[45]);
    return q;
}
__global__ void __launch_bounds__(NTHREADS, 2) mega(Params pk) {
    extern __shared__ __attribute__((aligned(16))) unsigned char smem[];
    LAS unsigned char* lds = (LAS unsigned char*)smem;
    const int G = gridDim.x, c = blockIdx.x;
    volatile LAS unsigned* pw = (volatile LAS unsigned*)(lds + LDS_BYTES - 512);
    if (threadIdx.x == 0) {
#pragma unroll
        for (int i = 0; i < 20; ++i) { const unsigned long long v = (unsigned long long)pk.in[i]; pw[2 * i] = (unsigned)v; pw[2 * i + 1] = (unsigned)(v >> 32); }
        { const unsigned long long v = (unsigned long long)pk.out; pw[40] = (unsigned)v; pw[41] = (unsigned)(v >> 32); }
        { const unsigned long long v = (unsigned long long)pk.ws; pw[42] = (unsigned)v; pw[43] = (unsigned)(v >> 32); }
        pw[44] = (unsigned)pk.ph_lo; pw[45] = (unsigned)pk.ph_hi;
    }
    unsigned* ctl = (unsigned*)(pk.ws + OFF_CTL);
    volatile LAS unsigned* misc = (volatile LAS unsigned*)(lds + LDS_BYTES - 64);
    if (threadIdx.x < 16) misc[threadIdx.x] = 0u;
    __syncthreads();
    const bool fused = (pk.ph_hi - pk.ph_lo) > 1;
    XcdBarrier bar; bar.bar = ctl; bar.x = 0; bar.st = misc;
    if (fused) {
        bar = xcd_barrier_post(ctl, misc);
        if (threadIdx.x == 0) misc[2] = xb_add(&ctl[CTL_RANK + 64 * bar.x], 1u);
    }
#define IN(k) (ph_lo <= (k) && (k) < ph_hi)
#if MK_CGSYNC
#define SEAM(k) do { if (IN(k) && IN((k) + 1)) { cg::grid_group grid = cg::this_grid(); grid.sync(); } } while (0)
#else
#define SEAM(k) do { if (IN(k) && IN((k) + 1)) xcd_barrier(bar); } while (0)
#endif
#define PHASE_BEGIN(k) if (IN(k)) { const Params p = load_params(pw); unsigned char* const ws = p.ws; (void)ws;
#define PHASE_END(k) } SEAM(k);
    const int ph_lo = pk.ph_lo, ph_hi = pk.ph_hi;
    PHASE_BEGIN(0) phase0(p, lds); PHASE_END(0)
    PHASE_BEGIN(1)
        const float* mod = (const float*)(ws + OFF_MOD);
        modulate_rows<false>(p.in[0], (h16*)(ws + OFF_UALL), T, p.in[6], mod, 0, 1024, 0, c, G);
        modulate_rows<false>(p.in[2], (h16*)(ws + OFF_UALL) + (size_t)T * D, TC, p.in[6], mod, 0, 1024, 1, c, G);
    PHASE_END(1)
    PHASE_BEGIN(2)
        { pg8::Gemm g{ws + OFF_UALL, ws + OFF_WA, 1024, 1024, 1024}; OrderA S; S.init(G, c, REP_A); EpiA E{ws}; pg8::gemm_phase(lds, g, S, E); }
        { pg8::Gemm g{ws + OFF_UALL, ws + OFF_WF, 1024, 1024, 1024}; pg8::TileOrder S; S.init(128, 4, G, c, REP_FT); EpiFT E{ws}; pg8::gemm_phase(lds, g, S, E); }
        if (G > 96) { if (c >= 48) convert_tables(p, c - 48, G - 48); } else convert_tables(p, c, G);
    PHASE_END(2)
    PHASE_BEGIN(3) for (int it = blockIdx.x; it < 192; it += gridDim.x) hgrn_mfma_unit<false>(p, lds, it / 3, it % 3);
        fft1_phase(p, lds); PHASE_END(3)
    PHASE_BEGIN(4) for (int it = blockIdx.x; it < 256; it += gridDim.x) hgrn_mfma_unit<true>(p, lds, it >> 2, it & 3); PHASE_END(4)
    PHASE_BEGIN(5)
        const bool mem_first = ((c >> 3) & 1) == 0;
        if (mem_first) a1_prepass(p);
        { pg8::Gemm g{ws + OFF_DFT256, ws + OFF_Y1, 512, 512, 512}; pg8::TileOrder S; S.init(1, 256, G, c, REP_DFT); EpiDFT E{ws}; pg8::gemm_phase(lds, g, S, E); }
        { pg8::Gemm g{ws + OFF_UALL, ws + OFF_WG, 1024, 1024, 1024}; pg8::TileOrder S; S.init(128, 8, G, c, REP_GATE); EpiGate E{ws}; pg8::gemm_phase(lds, g, S, E); }
        if (!mem_first) a1_prepass(p);
    PHASE_END(5)
    PHASE_BEGIN(6)
        if (G >= 16 && (G & 15) == 0) { if ((c >> 3) & 1) scale_wout(p, ((c >> 4) << 3) | (c & 7), G >> 1); } else scale_wout(p, c, G);
        { pg8::Gemm g{ws + OFF_G, ws + OFF_WHG, 512, 512, 512}; pg8::TileOrder S; S.init(128, 4, G, c, REP_M1); EpiMerge1<false> E{ws}; pg8::gemm_phase(lds, g, S, E); }
        { pg8::Gemm g{ws + OFF_YFT, ws + OFF_WFT, 512, 512, 512}; pg8::TileOrder S; S.init(128, 4, G, c); EpiMerge1<true> E{ws}; pg8::gemm_phase(lds, g, S, E); }
    PHASE_END(6)
    PHASE_BEGIN(7)
        pg8::Gemm g{ws + OFF_Y, ws + OFF_WOUTG, 1024, 1024, 1024}; pg8::TileOrder S; S.init(128, 4, G, c, REP_M2);
        EpiMerge2 E; E.x = p.in[0]; E.H = (h16*)(ws + OFF_H16); pg8::gemm_phase(lds, g, S, E);
    PHASE_END(7)
    PHASE_BEGIN(8) modulate_rows<true>(ws + OFF_H16, (h16*)(ws + OFF_U2), T, p.in[7], (const float*)(ws + OFF_MOD), 3072, 4096, 0, c, G, (signed char*)(ws + OFF_QX), (float*)(ws + OFF_SX)); PHASE_END(8)
    PHASE_BEGIN(9)
        pg8::Gemm g{ws + OFF_U2, ws + OFF_WS, 1024, 1024, 1024}; pg8::TileOrder S; S.init(128, 8, G, c, REP_SC);
#ifdef STAGGER_US
        if (c & 8) { const unsigned long long t0_ = __builtin_amdgcn_s_memrealtime(); while (__builtin_amdgcn_s_memrealtime() - t0_ < (unsigned long long)(STAGGER_US * 100)) __builtin_amdgcn_s_sleep(8); }
#endif
        EpiScores E; E.C = ws + OFF_SC; pg8::gemm_phase(lds, g, S, E);
    PHASE_END(9)
    PHASE_BEGIN(10) topk_phase(p, lds); PHASE_END(10)
    XcdInfo xi;
    if (fused) {
        unsigned cnt[8]; int npop = 0, px = 0;
#pragma unroll
        for (int j = 0; j < 8; ++j) { cnt[j] = xb_ld(&ctl[CTL_RANK + 64 * j]); if (j < (int)(bar.x & 7u)) px += (cnt[j] > 0u); npop += (cnt[j] > 0u); }
        xi.px = px; xi.npop = npop > 0 ? npop : 1; xi.rank = (int)misc[2]; xi.nloc = (int)cnt[bar.x & 7u]; if (xi.nloc < 1) xi.nloc = 1;
    } else { xi.px = c & 7; xi.npop = 8; xi.rank = c >> 3; xi.nloc = G >> 3; }
    #ifdef PEER_U_MFMA
    PHASE_BEGIN(11) peer_u_phase_mfma(p, lds, xi); PHASE_END(11)
#else
    PHASE_BEGIN(11) peer_u_phase(p, xi); PHASE_END(11)
#endif
    PHASE_BEGIN(12) peer_combine(p); PHASE_END(12)
    PHASE_BEGIN(13) peer_v_phase(p, lds, xi); PHASE_END(13)
    PHASE_BEGIN(14) peer_final(p); }
#undef IN
#undef SEAM
#undef PHASE_BEGIN
#undef PHASE_END
}

#ifndef MK_SINGLE
#define MK_SINGLE 1
#endif
extern "C" void kernel_launch(void* const* d_in, const int* in_sizes, int n_in, void* d_out, int out_size, void* d_ws, size_t ws_size, hipStream_t stream) {
    static int grid = 0;
    if (grid == 0) {
        if (n_in != 20 || out_size != T * D || ws_size < WS_NEED) { fprintf(stderr, "kernel_launch: unexpected shapes (n_in %d out %d ws %zu)\n", n_in, out_size, ws_size); grid = -1; return; }
        int dev = 0, cus = 0, per_cu = 0;
        hipGetDevice(&dev); hipDeviceGetAttribute(&cus, hipDeviceAttributeMultiprocessorCount, dev);
        if (hipFuncSetAttribute((const void*)mega, hipFuncAttributeMaxDynamicSharedMemorySize, LDS_BYTES) != hipSuccess) { fprintf(stderr, "kernel_launch: hipFuncSetAttribute failed\n"); grid = -1; return; }
        hipOccupancyMaxActiveBlocksPerMultiprocessor(&per_cu, (const void*)mega, NTHREADS, LDS_BYTES);
        if (per_cu < 1) { fprintf(stderr, "kernel_launch: occupancy query says %d blocks per CU\n", per_cu); grid = -1; return; }
        grid = cus;
    }
    if (grid < 0) return;
    if (hipMemsetAsync((char*)d_ws + OFF_CTL, 0, CTL_ZERO_BYTES, stream) != hipSuccess) { fprintf(stderr, "kernel_launch: memset failed\n"); return; }
    Params p{};
    for (int i = 0; i < 20; ++i) p.in[i] = (const float*)d_in[i];
    p.out = (float*)d_out; p.ws = (unsigned char*)d_ws;
#if MK_SINGLE
    p.ph_lo = 0; p.ph_hi = N_PHASES;
    void* args[] = {&p};
    hipError_t e = hipLaunchCooperativeKernel((const void*)mega, dim3(grid), dim3(NTHREADS), args, LDS_BYTES, stream);
    if (e != hipSuccess) fprintf(stderr, "cooperative launch failed: %s (grid %d)\n", hipGetErrorString(e), grid);
#else
    for (int ph = 0; ph < N_PHASES; ++ph) { p.ph_lo = ph; p.ph_hi = ph + 1; hipLaunchKernelGGL(mega, dim3(grid), dim3(NTHREADS), LDS_BYTES, stream, p); }
#endif
}
```

```cpp
#include <hip/hip_runtime.h>
#include <hip/hip_cooperative_groups.h>
#include <cstdio>
#include <cstdint>
namespace cg = cooperative_groups;
#define LAS __attribute__((address_space(3)))
namespace pg8 {
#define PG8_LAS __attribute__((address_space(3)))
typedef _Float16 f16x8 __attribute__((ext_vector_type(8)));
typedef float f32x4 __attribute__((ext_vector_type(4)));
typedef unsigned u32x4 __attribute__((ext_vector_type(4)));
typedef unsigned u32x2 __attribute__((ext_vector_type(2)));
constexpr int BM = 256, BK = 64, HALF = 128, HTB = HALF * BK * 2, STAGE_BYTES = 8 * HTB, NXCD = 8, WGM = 8;

__host__ __device__ __forceinline__ int lds_byte(int r, int c) { const int st = (r >> 4) * 2 + (c >> 5), rr = r & 15, cc = c & 31, ob = rr * 64 + cc * 2; return st * 1024 + (ob ^ (((ob >> 9) & 1) << 5)); }
__host__ __device__ __forceinline__ void stage_rc(int b, int& R, int& C) { const int st = b / 1024, sb = b % 1024, swz = sb ^ (((sb >> 9) & 1) << 5); R = (st >> 1) * 16 + swz / 64; C = (st & 1) * 32 + (swz % 64) / 2; }
__host__ __device__ __forceinline__ int perm32(int rho) { const int n = rho >> 4, i = rho & 15; return 8 * (i >> 2) + 4 * n + (i & 3); }

struct Unit { int pm, pn; };
struct Gemm { const void* A; const void* Bt; int lda, ldb, K; };

struct TileOrder {
    int nM, nN, nwg, G, c, rep;
    __device__ void init(int nM_, int nN_, int G_, int c_, int rep_ = 1) { nM = nM_; nN = nN_; nwg = nM * nN; G = G_; c = c_; rep = rep_; }
    __device__ bool map(long L, Unit& u) const {
        if (L >= nwg) return false;
        int wgid = (int)L; { const int q = nwg / NXCD, r = nwg % NXCD, xcd = wgid % NXCD, off = wgid / NXCD; wgid = (xcd < r ? xcd * (q + 1) : r * (q + 1) + (xcd - r) * q) + off; }
        const int nig = WGM * nN, gid = wgid / nig, fm = gid * WGM, gsz = (nM - fm) < WGM ? (nM - fm) : WGM;
        u.pm = fm + ((wgid % nig) % gsz); u.pn = (wgid % nig) / gsz; return true;
    }
    __device__ bool next(int i, Unit& u) const { const long L = (long)i * G + c; if (L >= (long)nwg * rep) return false; return map(L % nwg, u); }
};

template <class Epi, class Sched>
__device__ __forceinline__ void gemm_phase(PG8_LAS unsigned char* lds, const Gemm g, const Sched& S, const Epi& E) {
    const int tid = threadIdx.x, wid = __builtin_amdgcn_readfirstlane(tid >> 6), lane = tid & 63, wr = wid >> 2, wc = wid & 3, fr = lane & 15, fq = lane >> 4;
    const int K = g.K, nt = K / BK;
    unsigned voffA[2], voffB[2];
#pragma unroll
    for (int i = 0; i < 2; ++i) { int R, C; stage_rc(tid * 16 + i * 8192, R, C); const int Rb = Epi::PERM ? ((R & ~31) + perm32(R & 31)) : R;
        voffA[i] = (unsigned)(R * g.lda + C) * 2u; voffB[i] = (unsigned)(Rb * g.ldb + C) * 2u; }
    const size_t kstep = (size_t)(BK * 2);
    const size_t hstepA = (size_t)HALF * g.lda * 2, hstepB = (size_t)HALF * g.ldb * 2;
    const size_t tstepA = 2 * hstepA, tstepB = 2 * hstepB;
    const unsigned ldsw = (unsigned)wid * 1024u;
    const int aoff = lds_byte(wr * 64 + fr, fq * 8), boff = lds_byte(wc * 32 + fr, fq * 8);
#define PG8_SA(b, h) (((b) * 2 + (h)) * HTB)
#define PG8_SB(b, h) ((4 + (b) * 2 + (h)) * HTB)
#define PG8_STAGE(bufoff, gbase, voff) do { _Pragma("unroll") for (int _i = 0; _i < 2; ++_i) \
        __builtin_amdgcn_global_load_lds((const unsigned*)((const char*)(gbase) + (voff)[_i]), (PG8_LAS unsigned*)(lds + (bufoff) + ldsw + _i * 8192), 16, 0, 0); } while (0)
#define PG8_LDA(dst, b, h) do { _Pragma("unroll") for (int m = 0; m < 4; ++m) _Pragma("unroll") for (int k = 0; k < 2; ++k) dst[m][k] = *(const PG8_LAS f16x8*)(lds + PG8_SA(b, h) + aoff + m * 2048 + k * 1024); } while (0)
#define PG8_LDB(dst, b, h) do { _Pragma("unroll") for (int n = 0; n < 2; ++n) _Pragma("unroll") for (int k = 0; k < 2; ++k) dst[n][k] = *(const PG8_LAS f16x8*)(lds + PG8_SB(b, h) + boff + n * 2048 + k * 1024); } while (0)
#define PG8_MMA(ai, bj, At, Bt) do { __builtin_amdgcn_s_setprio(1); _Pragma("unroll") for (int m = 0; m < 4; ++m) _Pragma("unroll") for (int n = 0; n < 2; ++n) _Pragma("unroll") for (int k = 0; k < 2; ++k) \
        acc[ai][bj][m][n] = Epi::TRANS ? __builtin_amdgcn_mfma_f32_16x16x32_f16(Bt[n][k], At[m][k], acc[ai][bj][m][n], 0, 0, 0) \
                                       : __builtin_amdgcn_mfma_f32_16x16x32_f16(At[m][k], Bt[n][k], acc[ai][bj][m][n], 0, 0, 0); __builtin_amdgcn_s_setprio(0); } while (0)
#define PG8_WAIT_V(n) asm volatile("s_waitcnt vmcnt(" #n ")" ::: "memory")
#define PG8_WAIT_L(n) asm volatile("s_waitcnt lgkmcnt(" #n ")" ::: "memory")
#define PG8_WAIT_VN(n) asm volatile("s_waitcnt vmcnt(%0)" :: "n"(n) : "memory")
#define PG8_BAR __builtin_amdgcn_s_barrier()
#define PG8_SCHED __builtin_amdgcn_sched_barrier(0)
    Unit cur, nxt; int ui = 0;
    if (!S.next(0, cur)) return;
    f32x4 acc[2][2][4][2];
#pragma unroll
    for (int a = 0; a < 2; ++a)
#pragma unroll
        for (int b = 0; b < 2; ++b)
#pragma unroll
            for (int m = 0; m < 4; ++m)
#pragma unroll
                for (int n = 0; n < 2; ++n) acc[a][b][m][n] = (f32x4){0.f, 0.f, 0.f, 0.f};
    f16x8 At[4][2], B0[2][2], B1[2][2];
    const char* cA = (const char*)g.A + (size_t)cur.pm * tstepA; const char* cB = (const char*)g.Bt + (size_t)cur.pn * tstepB + E.boff(cur);
    E.init(acc, cur, wr, wc, fr, fq);
    PG8_STAGE(PG8_SB(0, 0), cB, voffB); PG8_STAGE(PG8_SA(0, 0), cA, voffA); PG8_STAGE(PG8_SB(0, 1), cB + hstepB, voffB); PG8_STAGE(PG8_SA(0, 1), cA + hstepA, voffA);
    if (wr == 1) PG8_BAR;
    PG8_WAIT_V(4); PG8_BAR;
    PG8_STAGE(PG8_SB(1, 0), cB + kstep, voffB); PG8_STAGE(PG8_SA(1, 0), cA + kstep, voffA); PG8_STAGE(PG8_SB(1, 1), cB + hstepB + kstep, voffB); PG8_STAGE(PG8_SA(1, 1), cA + hstepA + kstep, voffA);
    PG8_WAIT_V(8); PG8_BAR;
    for (;;) {
        const bool has_next = S.next(ui + 1, nxt);
        const char* nA = has_next ? (const char*)g.A + (size_t)nxt.pm * tstepA : cA; const char* nB = has_next ? (const char*)g.Bt + (size_t)nxt.pn * tstepB + E.boff(nxt) : cB;
        for (int t = 0; t < nt; t += 2) {
            const bool last = (t == nt - 2);
            const char* a2 = last ? nA : cA + (size_t)(t + 2) * kstep; const char* b2 = last ? nB : cB + (size_t)(t + 2) * kstep;
            const char* a3 = a2 + kstep; const char* b3 = b2 + kstep;
            PG8_LDB(B0, 0, 0); PG8_SCHED; PG8_LDA(At, 0, 0);
            PG8_WAIT_L(8); PG8_BAR; PG8_WAIT_L(0); PG8_MMA(0, 0, At, B0); PG8_BAR; PG8_SCHED;
            PG8_LDB(B1, 0, 1); PG8_STAGE(PG8_SB(0, 0), b2, voffB);
            PG8_BAR; PG8_WAIT_L(0); PG8_MMA(0, 1, At, B1); PG8_BAR;
            PG8_LDA(At, 0, 1); PG8_STAGE(PG8_SA(0, 0), a2, voffA);
            PG8_BAR; PG8_WAIT_L(0); PG8_MMA(1, 0, At, B0); PG8_BAR; PG8_SCHED;
            PG8_STAGE(PG8_SB(0, 1), b2 + hstepB, voffB);
            { const int lax_ = __builtin_amdgcn_readfirstlane((int)((t == 0) & (ui != 0)));
              asm volatile("s_cmp_eq_u32 %0, 0\n\ts_cbranch_scc1 1f\n\ts_waitcnt vmcnt(%1)\n\ts_branch 2f\n1:\n\ts_waitcnt vmcnt(6)\n2:" :: "s"(lax_), "n"(6 + Epi::NST) : "memory", "scc"); }
            PG8_BAR; PG8_MMA(1, 1, At, B1); PG8_BAR;
            PG8_LDB(B0, 1, 0); PG8_SCHED; PG8_LDA(At, 1, 0); PG8_STAGE(PG8_SA(0, 1), a2 + hstepA, voffA);
            PG8_WAIT_L(8); PG8_BAR; PG8_WAIT_L(0); PG8_MMA(0, 0, At, B0); PG8_BAR; PG8_SCHED;
            PG8_LDB(B1, 1, 1); PG8_STAGE(PG8_SB(1, 0), b3, voffB);
            PG8_BAR; PG8_WAIT_L(0); PG8_MMA(0, 1, At, B1); PG8_BAR;
            PG8_LDA(At, 1, 1); PG8_STAGE(PG8_SA(1, 0), a3, voffA);
            PG8_BAR; PG8_WAIT_L(0); PG8_MMA(1, 0, At, B0); PG8_BAR; PG8_SCHED;
            PG8_STAGE(PG8_SB(1, 1), b3 + hstepB, voffB);
            PG8_WAIT_V(6); PG8_BAR; PG8_MMA(1, 1, At, B1); PG8_BAR;
            PG8_STAGE(PG8_SA(1, 1), a3 + hstepA, voffA);
        }
        if constexpr (Epi::FUSED) {
            E.fused(acc, cur, nxt, has_next, wr, wc, fr, fq);
            if (!has_next) break;
            cur = nxt; cA = nA; cB = nB; ++ui;
        } else {
            E(acc, cur, wr, wc, fr, fq);
            if (!has_next) break;
#pragma unroll
            for (int a = 0; a < 2; ++a)
#pragma unroll
                for (int b = 0; b < 2; ++b)
#pragma unroll
                    for (int m = 0; m < 4; ++m)
#pragma unroll
                        for (int n = 0; n < 2; ++n) acc[a][b][m][n] = (f32x4){0.f, 0.f, 0.f, 0.f};
            cur = nxt; cA = nA; cB = nB; ++ui;
            E.init(acc, cur, wr, wc, fr, fq);
        }
    }
    PG8_WAIT_V(0);
    if (wr == 0) PG8_BAR;
    PG8_BAR;
#undef PG8_SA
#undef PG8_SB
#undef PG8_STAGE
#undef PG8_LDA
#undef PG8_LDB
#undef PG8_MMA
#undef PG8_WAIT_V
#undef PG8_WAIT_VN
#undef PG8_WAIT_L
#undef PG8_BAR
#undef PG8_SCHED
}
}
#define XB_TMO      128
#define XB_XCNT(j)  (256  + 64 * (j))
#define XB_XSUB(j)  (1280 + 64 * (j))
#define XB_XGEN(j)  (2304 + 64 * (j))
#define XB_TOP      3328
#define XB_TOPGEN   3392
#define XCD_BAR_WORDS 3456
#define XB_SPIN_CAP (1u << 20)


__device__ __forceinline__ unsigned xb_ld(unsigned* p)              { return __hip_atomic_load(p, __ATOMIC_RELAXED, __HIP_MEMORY_SCOPE_AGENT); }
__device__ __forceinline__ unsigned xb_add(unsigned* p, unsigned v) { return __hip_atomic_fetch_add(p, v, __ATOMIC_RELAXED, __HIP_MEMORY_SCOPE_AGENT); }
__device__ __forceinline__ unsigned xb_xcc_id() { return (unsigned)__builtin_amdgcn_s_getreg((3 << 11) | 20) & 0xFu; }
#define XB_SPIN(cond, bar) do { unsigned _sp = 0; while (cond) { __builtin_amdgcn_s_sleep(1); \
    if ((++_sp & 255u) == 0u) { if (xb_ld(&(bar)[XB_TMO])) break; if (_sp > XB_SPIN_CAP) { atomicAdd(&(bar)[XB_TMO], 1u); break; } } } } while (0)

struct XcdBarrier {
    unsigned* bar; unsigned x;
    volatile LAS unsigned* st;
};

__device__ __forceinline__ XcdBarrier xcd_barrier_post(unsigned* bar, volatile LAS unsigned* st) {
    XcdBarrier b; b.bar = bar; b.x = xb_xcc_id(); b.st = st;
    if (threadIdx.x == 0) (void)xb_add(&bar[XB_XCNT(b.x)], 1u);
    return b;
}
__device__ __forceinline__ void xcd_barrier_complete(unsigned* bar, unsigned x, unsigned& nloc, unsigned& nx) {
    const unsigned G = gridDim.x * gridDim.y * gridDim.z;
    unsigned sum, cnt, mine, sp = 0u;
    for (;;) {
        sum = 0u; cnt = 0u; mine = 0u;
#pragma unroll
        for (unsigned j = 0; j < 16; ++j) { const unsigned c = xb_ld(&bar[XB_XCNT(j)]); sum += c; cnt += (c > 0u) ? 1u : 0u; mine = (j == x) ? c : mine; }
        if (sum == G) break;
        __builtin_amdgcn_s_sleep(1);
        if ((++sp & 255u) == 0u) { if (xb_ld(&bar[XB_TMO])) break; if (sp > XB_SPIN_CAP) { atomicAdd(&bar[XB_TMO], 1u); break; } }
    }
    nloc = mine > 0u ? mine : 1u; nx = cnt > 0u ? cnt : 1u;
}

__device__ __forceinline__ void xcd_barrier(const XcdBarrier& b) {
    asm volatile("s_waitcnt vmcnt(0)" ::: "memory");
    __syncthreads();
    if (threadIdx.x == 0) {
        unsigned* bar = b.bar;
        __builtin_amdgcn_s_waitcnt(0);
        unsigned nloc = b.st[0], nx = b.st[1];
        if (nloc == 0u) { xcd_barrier_complete(bar, b.x, nloc, nx); b.st[0] = nloc; b.st[1] = nx; }
        const unsigned old = xb_add(&bar[XB_XSUB(b.x)], 1u);
        const unsigned gen = old / nloc;
        if (old + 1u == (gen + 1u) * nloc) {
            __builtin_amdgcn_fence(__ATOMIC_RELEASE, "agent");
            asm volatile("s_waitcnt vmcnt(0)" ::: "memory");
            const unsigned og = xb_add(&bar[XB_TOP], 1u);
            const unsigned tg = og / nx;
            if (og + 1u == (tg + 1u) * nx) xb_add(&bar[XB_TOPGEN], 1u);
            else XB_SPIN(xb_ld(&bar[XB_TOPGEN]) == tg, bar);
            __builtin_amdgcn_fence(__ATOMIC_ACQUIRE, "agent");
            xb_add(&bar[XB_XGEN(b.x)], 1u);
            asm volatile("s_waitcnt vmcnt(0)" ::: "memory");
        } else {
            XB_SPIN(xb_ld(&bar[XB_XGEN(b.x)]) == gen, bar);
            __builtin_amdgcn_fence(__ATOMIC_ACQUIRE, "agent");
            asm volatile("s_waitcnt vmcnt(0)" ::: "memory");
        }
    }
    __syncthreads();
}

typedef _Float16 h16;
typedef h16 h16x2 __attribute__((ext_vector_type(2)));
typedef h16 h16x4 __attribute__((ext_vector_type(4)));
typedef h16 h16x8 __attribute__((ext_vector_type(8)));
typedef float f32x4 __attribute__((ext_vector_type(4)));
typedef float f32x2 __attribute__((ext_vector_type(2)));
typedef unsigned u32x4 __attribute__((ext_vector_type(4)));
typedef unsigned u32x2 __attribute__((ext_vector_type(2)));

constexpr int D = 1024, NB = 8, SEQ = 4096, T = NB * SEQ, LC = 256, TC = NB * LC, TALL = T + TC;
constexpr int NTHREADS = 512;
constexpr int LDS_BYTES = 156 * 1024;
constexpr float EPS = 1e-6f;
constexpr size_t MiB = (size_t)1 << 20;
constexpr size_t OFF_CTL = 0;
constexpr size_t OFF_MOD = 64 * 1024;
constexpr size_t OFF_LB = 320 * 1024;
constexpr size_t OFF_WA = 1 * MiB;
constexpr size_t OFF_WG = 6 * MiB;
constexpr size_t OFF_WF = 10 * MiB;
constexpr size_t OFF_WHG = 12 * MiB;
constexpr size_t OFF_WFT = 13 * MiB;
constexpr size_t OFF_WOUT = 14 * MiB;
constexpr size_t OFF_WS = 16 * MiB;
constexpr size_t OFF_UALL = 20 * MiB;
constexpr size_t OFF_OF = 88 * MiB;
constexpr size_t OFF_OB = 120 * MiB;
constexpr size_t OFF_FTT = 152 * MiB;
constexpr size_t OFF_Q = 216 * MiB;
constexpr size_t OFF_LF = 248 * MiB;
constexpr size_t OFF_LBK = 282 * MiB;
constexpr size_t OFF_V = 316 * MiB;
constexpr size_t OFF_G = 350 * MiB;
constexpr size_t OFF_WOUTG = 20 * MiB;
constexpr size_t OFF_Y1 = 382 * MiB;
constexpr size_t OFF_DFT256 = 512 * 1024;
constexpr size_t OFF_YFT = 446 * MiB;
constexpr size_t OFF_USTATE = 446 * MiB;
constexpr size_t OFF_DLOG = 460 * MiB;
constexpr size_t WS_NEED = 510 * MiB;
constexpr size_t OFF_GH = 216 * MiB;
constexpr size_t OFF_Y = 152 * MiB;
constexpr size_t OFF_H16 = 382 * MiB;
constexpr size_t OFF_U2 = 20 * MiB;
constexpr size_t OFF_TU = 478 * MiB;
constexpr size_t OFF_TV = 494 * MiB;
constexpr size_t OFF_QX = 120 * MiB;
constexpr size_t OFF_SU = 768 * 1024;
constexpr size_t OFF_SV = 832 * 1024;
constexpr size_t OFF_SX = 205 * MiB;
constexpr size_t OFF_SC = 216 * MiB;
constexpr size_t OFF_EIDX = 152 * MiB;
constexpr size_t OFF_GATE = 168 * MiB;
constexpr size_t OFF_W = 184 * MiB;
constexpr size_t OFF_PSS = 200 * MiB;
constexpr size_t OFF_PACT = 216 * MiB;
constexpr size_t OFF_PO = 216 * MiB;
constexpr size_t OFF_SIDE = 88 * MiB;
constexpr int CTL_RANK = 4096;
constexpr size_t CTL_ZERO_BYTES = 32 * 1024;

struct Params { const float* in[20]; float* out; unsigned char* ws; int ph_lo, ph_hi; };

__device__ __forceinline__ unsigned pk2(float a, float b) { h16x2 v = {(h16)a, (h16)b}; return __builtin_bit_cast(unsigned, v); }
#define GAS __attribute__((address_space(1)))
__device__ __forceinline__ void gst4(void* p, u32x4 v) { *(GAS u32x4*)p = v; }
__device__ __forceinline__ void gst2(void* p, u32x2 v) { *(GAS u32x2*)p = v; }
__device__ __forceinline__ float wave_sum(float v) {
#pragma unroll
    for (int o = 32; o >= 1; o >>= 1) v += __shfl_xor(v, o);
    return v; }
__device__ __forceinline__ float sigmoidf_(float z) { return __builtin_amdgcn_rcpf(1.0f + __expf(-z)); }

constexpr int N_MOD = 192, N_LB = 1, N_TRA = 160, N_TRG = 128, N_TRHG = 32, N_TRFT = 32, N_TROUT = 64, N_WF = 128, N_WSF = 256, N_DFT = 1;
constexpr int P0_TOTAL = N_MOD + N_LB + N_TRA + N_TRG + N_TRHG + N_TRFT + N_TROUT + N_WF + N_WSF + N_DFT;

__device__ __forceinline__ void p0_mod(const Params& p, LAS float* sm, int idx) {
    const int tid = threadIdx.x;
    for (int i = tid; i < 9 * 1024; i += NTHREADS) { const int r = i >> 10, k = i & 1023; const float c = (r < 8) ? p.in[1][r * 1024 + k] : p.in[3][k]; sm[i] = c / (1.0f + __expf(-c)); }
    __syncthreads();
    const int col = tid & 31, ks = tid >> 5;
    float acc[9];
#pragma unroll
    for (int r = 0; r < 9; ++r) acc[r] = 0.f;
    const float* w = p.in[4] + (size_t)(ks * 64) * 6144 + idx * 32 + col;
    float wv[64];
#pragma unroll
    for (int k = 0; k < 64; ++k) wv[k] = w[(size_t)k * 6144];
#pragma unroll
    for (int k = 0; k < 64; ++k) {
#pragma unroll
        for (int r = 0; r < 9; ++r) acc[r] += sm[r * 1024 + ks * 64 + k] * wv[k]; }
    LAS float* red = sm + 9 * 1024;
#pragma unroll
    for (int r = 0; r < 9; ++r) red[(ks * 9 + r) * 32 + col] = acc[r];
    __syncthreads();
    float* mod = (float*)(p.ws + OFF_MOD);
    if (tid < 288) { const int r = tid >> 5, c = tid & 31; float s = 0.f;
#pragma unroll
        for (int q = 0; q < 16; ++q) s += red[(q * 9 + r) * 32 + c];
        mod[r * 6144 + idx * 32 + c] = s + p.in[5][idx * 32 + c]; }
    __syncthreads();
}
__device__ __forceinline__ void p0_lb(const Params& p) {
    const int tid = threadIdx.x; float* lb = (float*)(p.ws + OFF_LB);
    if (tid < 512) { lb[tid] = 1.0f / (1.0f + expf(p.in[9][512 + tid] - p.in[9][tid])); lb[512 + tid] = 1.0f / (1.0f + expf(p.in[10][512 + tid] - p.in[10][tid])); }
}
__device__ __forceinline__ void p0_transpose(const float* src, int ld_src, int ncol0, h16* dst, int ld_dst, int nktiles, int item, LAS float* sm) {
    const int tid = threadIdx.x, kt = item % nktiles, nt = item / nktiles;
    { const int n4 = tid & 63, kk = tid >> 6;
#pragma unroll
      for (int ps = 0; ps < 8; ++ps) { const int k = kk + 8 * ps; const f32x4 v = *(const f32x4*)(src + (size_t)(kt * 64 + k) * ld_src + ncol0 + nt * 256 + 4 * n4);
          sm[k * 257 + 4 * n4] = v.x; sm[k * 257 + 4 * n4 + 1] = v.y; sm[k * 257 + 4 * n4 + 2] = v.z; sm[k * 257 + 4 * n4 + 3] = v.w; } }
    __syncthreads();
#pragma unroll
    for (int ps = 0; ps < 4; ++ps) { const int idx = tid + NTHREADS * ps, n = idx >> 3, k8 = (idx & 7) * 8;
        float v[8];
#pragma unroll
        for (int j = 0; j < 8; ++j) v[j] = sm[(k8 + j) * 257 + n];
        u32x4 w; w.x = pk2(v[0], v[1]); w.y = pk2(v[2], v[3]); w.z = pk2(v[4], v[5]); w.w = pk2(v[6], v[7]);
        *(u32x4*)(dst + (size_t)(nt * 256 + n) * ld_dst + kt * 64 + k8) = w; }
    __syncthreads();
}
__device__ __forceinline__ void p0_wf(const Params& p, LAS float* sm, int item) {
    const int tid = threadIdx.x, dt = item & 15, part = (item >> 4) & 1, g = item >> 5, d0 = dt * 64;
    LAS float* w = sm; LAS float* TT = sm + 8256; LAS float* trig = sm + 8256 + 16384;
    if (tid < 128) trig[tid] = part ? sinpif((float)tid / 64.0f) : cospif((float)tid / 64.0f);
    for (int i = tid; i < 64 * 128; i += NTHREADS) { const int dl = i >> 7, n2 = i & 127; w[dl * 129 + n2] = p.in[8][(size_t)(d0 + dl) * 5120 + 2560 + g * 128 + n2]; }
    __syncthreads();
    for (int i = tid; i < 128 * 128; i += NTHREADS) { const int n2 = i >> 7, k2 = i & 127; TT[i] = trig[(k2 * n2) & 127]; }
    __syncthreads();
    const int dl = tid & 63, kg = tid >> 6; h16* WF = (h16*)(p.ws + OFF_WF);
    float s[16];
#pragma unroll
    for (int j = 0; j < 16; ++j) s[j] = 0.f;
#pragma unroll 2
    for (int n2 = 0; n2 < 128; ++n2) { const float wv = w[dl * 129 + n2];
#pragma unroll
        for (int q = 0; q < 4; ++q) { const f32x4 tv = *(LAS f32x4*)(TT + n2 * 128 + kg * 16 + 4 * q);
#pragma unroll
            for (int j = 0; j < 4; ++j) s[4 * q + j] += wv * tv[j]; } }
#pragma unroll
    for (int j = 0; j < 16; ++j) WF[(size_t)(part * 512 + g * 128 + kg * 16 + j) * 1024 + d0 + dl] = (h16)(s[j] * 0.08838834764831845f);
    __syncthreads();
}
__device__ __forceinline__ void p0_wsf(const Params& p, LAS float* sm, int item) {
    const int tid = threadIdx.x, dt = item & 15, hp = item >> 4, d0 = dt * 64;
    LAS float* wq = sm; LAS float* skT = sm + 8256;
    for (int i = tid; i < 64 * 128; i += NTHREADS) { const int dl = i >> 7, k = i & 127; wq[dl * 129 + k] = p.in[15][(size_t)(d0 + dl) * 2048 + hp * 128 + k]; }
    for (int i = tid; i < 128 * 128; i += NTHREADS) { const int n = i >> 7, k = i & 127; skT[k * 128 + n] = p.in[16][(size_t)hp * 16384 + i]; }
    __syncthreads();
    const int dl = tid & 63, ng = tid >> 6; h16* WS = (h16*)(p.ws + OFF_WS);
    float s[16];
#pragma unroll
    for (int j = 0; j < 16; ++j) s[j] = 0.f;
#pragma unroll 2
    for (int k = 0; k < 128; ++k) { const float wv = wq[dl * 129 + k];
#pragma unroll
        for (int q = 0; q < 4; ++q) { const f32x4 tv = *(LAS f32x4*)(skT + k * 128 + ng * 16 + 4 * q);
#pragma unroll
            for (int j = 0; j < 4; ++j) s[4 * q + j] += wv * tv[j]; } }
#pragma unroll
    for (int j = 0; j < 16; ++j) WS[(size_t)(hp * 128 + ng * 16 + j) * 1024 + d0 + dl] = (h16)s[j];
    __syncthreads();
}
__device__ __forceinline__ void p0_dft256(const Params& p) {
    h16* M = (h16*)(p.ws + OFF_DFT256);
    for (int e = threadIdx.x; e < 256 * 512; e += NTHREADS) { const int c = e >> 9, k = e & 511, part = k >> 8, a = k & 255; const int m = (a * c) & 255;
        M[e] = (h16)((part ? sinpif((float)m / 128.0f) : cospif((float)m / 128.0f)) * 0.25f); }
}
constexpr int CTL_P0Q = 6144;
__device__ __forceinline__ void phase0(const Params& p, LAS unsigned char* lds) {
    LAS float* sm = (LAS float*)lds; volatile LAS unsigned* slot = (volatile LAS unsigned*)(lds + LDS_BYTES - 64) + 8;
    unsigned* ctr = (unsigned*)(p.ws + OFF_CTL) + CTL_P0Q;
    int it = blockIdx.x;
    while (it < P0_TOTAL) {
        unsigned nxt = 0u;
        if (threadIdx.x == 0) nxt = xb_add(ctr, 1u) + gridDim.x;
        int i = it;
        do {
            if (i < N_DFT) { p0_dft256(p); break; } i -= N_DFT;
            if (i < N_MOD) { p0_mod(p, sm, i); break; } i -= N_MOD;
            if (i < N_WSF) { p0_wsf(p, sm, i); break; } i -= N_WSF;
            if (i < N_WF) { p0_wf(p, sm, i); break; } i -= N_WF;
            if (i < N_TRA) { p0_transpose(p.in[8], 5120, 0, (h16*)(p.ws + OFF_WA), 1024, 16, i, sm); break; } i -= N_TRA;
            if (i < N_TRG) { p0_transpose(p.in[8], 5120, 3072, (h16*)(p.ws + OFF_WG), 1024, 16, i, sm); break; } i -= N_TRG;
            if (i < N_TRHG) { p0_transpose(p.in[12], 1024, 0, (h16*)(p.ws + OFF_WHG), 512, 8, i, sm); break; } i -= N_TRHG;
            if (i < N_TRFT) { p0_transpose(p.in[13], 1024, 0, (h16*)(p.ws + OFF_WFT), 512, 8, i, sm); break; } i -= N_TRFT;
            if (i < N_TROUT) { p0_transpose(p.in[14], 1024, 0, (h16*)(p.ws + OFF_WOUT), 1024, 16, i, sm); break; } i -= N_TROUT;
            p0_lb(p);
        } while (0);
        if (threadIdx.x == 0) slot[0] = nxt;
        __syncthreads();
        it = (int)slot[0];
        __syncthreads();
    }
}

template <bool SRC16>
__device__ __forceinline__ void modulate_rows(const void* srcv, h16* dst, int nrows, const float* gvec, const float* mod, int sh_off, int sc_off, int ctx_rows, int vb, int vn, signed char* qdst = nullptr, float* qscale = nullptr) {
    const int wave = threadIdx.x >> 6, lane = threadIdx.x & 63;
    const float* src = (const float*)srcv; const h16* src16 = (const h16*)srcv;
    for (int rowA = vb * 8 + wave; rowA < nrows; rowA += vn * 16) {
        const int rowB = rowA + vn * 8; const bool okB = rowB < nrows;
        const int rows[2] = {rowA, okB ? rowB : rowA};
        f32x4 v[2][4]; float ss[2] = {0.f, 0.f};
#pragma unroll
        for (int q = 0; q < 2; ++q)
#pragma unroll
            for (int j = 0; j < 4; ++j) {
                if (SRC16) { const h16x4 hv = *(const h16x4*)(src16 + (size_t)rows[q] * D + j * 256 + lane * 4); v[q][j] = (f32x4){(float)hv[0], (float)hv[1], (float)hv[2], (float)hv[3]}; }
                else v[q][j] = *(const f32x4*)(src + (size_t)rows[q] * D + j * 256 + lane * 4); }
#pragma unroll
        for (int q = 0; q < 2; ++q) {
#pragma unroll
            for (int j = 0; j < 4; ++j) ss[q] += v[q][j].x * v[q][j].x + v[q][j].y * v[q][j].y + v[q][j].z * v[q][j].z + v[q][j].w * v[q][j].w;
            ss[q] = wave_sum(ss[q]); }
#pragma unroll
        for (int q = 0; q < 2; ++q) {
            if (q == 1 && !okB) break;
            const int row = rows[q], mr = ctx_rows ? 8 : (row >> 12);
            const float rstd = rsqrtf(ss[q] * (1.0f / D) + EPS);
            float amax = 0.f;
#pragma unroll
            for (int j = 0; j < 4; ++j) { const int c = j * 256 + lane * 4;
                const f32x4 gg = *(const f32x4*)(gvec + c), sc = *(const f32x4*)(mod + mr * 6144 + sc_off + c), sh = *(const f32x4*)(mod + mr * 6144 + sh_off + c);
                const f32x4 o = (v[q][j] * rstd) * gg * (sc + 1.0f) + sh; v[q][j] = o;
                amax = fmaxf(amax, fmaxf(fmaxf(fabsf(o.x), fabsf(o.y)), fmaxf(fabsf(o.z), fabsf(o.w))));
                u32x2 w; w.x = pk2(o.x, o.y); w.y = pk2(o.z, o.w);
                *(u32x2*)(dst + (size_t)row * D + c) = w; }
            if (qdst) {
#pragma unroll
                for (int o = 32; o >= 1; o >>= 1) amax = fmaxf(amax, __shfl_xor(amax, o));
                const float qs = amax > 0.f ? amax * (1.0f / 127.0f) : 1.0f, inv = 1.0f / qs;
#pragma unroll
                for (int j = 0; j < 4; ++j) { const int c = j * 256 + lane * 4;
                    const int q0 = (int)rintf(v[q][j].x * inv), q1 = (int)rintf(v[q][j].y * inv), q2 = (int)rintf(v[q][j].z * inv), q3 = (int)rintf(v[q][j].w * inv);
                    *(unsigned*)(qdst + (size_t)row * D + c) = (unsigned)(q0 & 255) | ((unsigned)(q1 & 255) << 8) | ((unsigned)(q2 & 255) << 16) | ((unsigned)(q3 & 255) << 24); }
                if (lane == 0) qscale[row] = qs;
            }
        }
    }
}

#define EPI_DEFAULT_HOOKS \
    static constexpr bool FUSED = false; \
    __device__ __forceinline__ size_t boff(const pg8::Unit&) const { return 0; } \
    __device__ __forceinline__ void init(f32x4 (&)[2][2][4][2], const pg8::Unit&, int, int, int, int) const {}
struct EpiA {
    EPI_DEFAULT_HOOKS
    static constexpr bool PERM = true, TRANS = true;
    static constexpr int NST = 16;
    unsigned char* ws;
    __device__ __forceinline__ void operator()(const f32x4 (&acc)[2][2][4][2], const pg8::Unit& u, int wr, int wc, int fr, int fq) const {
        const int ty = u.pn >> 1;
        h16* base = (h16*)(ws + (ty == 0 ? OFF_Q : ty == 1 ? OFF_LF : ty == 2 ? OFF_LBK : ty == 3 ? OFF_V : OFF_G));
        const float* lb = (const float*)(ws + OFF_LB) + (ty == 2 ? 512 : 0);
        const int row0 = u.pm * 256 + wr * 64 + fr, col0 = (u.pn & 1) * 256 + wc * 32 + 8 * fq;
        float lbv2[2][8], omv2[2][8];
        if (ty == 1 || ty == 2) {
#pragma unroll
            for (int bj = 0; bj < 2; ++bj) { const f32x4 l0 = *(const GAS f32x4*)(lb + col0 + bj * 128), l1 = *(const GAS f32x4*)(lb + col0 + bj * 128 + 4);
#pragma unroll
                for (int j = 0; j < 4; ++j) { lbv2[bj][j] = l0[j]; lbv2[bj][4 + j] = l1[j]; omv2[bj][j] = 1.0f - l0[j]; omv2[bj][4 + j] = 1.0f - l1[j]; } }
        }
#pragma unroll
        for (int bj = 0; bj < 2; ++bj) {
            float lbv[8], omv[8];
#pragma unroll
            for (int j = 0; j < 8; ++j) { lbv[j] = lbv2[bj][j]; omv[j] = omv2[bj][j]; }
#pragma unroll
            for (int ai = 0; ai < 2; ++ai)
#pragma unroll
                for (int m = 0; m < 4; ++m) {
                    float v[8];
#pragma unroll
                    for (int j = 0; j < 4; ++j) { v[j] = acc[ai][bj][m][0][j]; v[4 + j] = acc[ai][bj][m][1][j]; }
                    if (ty == 0) {
#pragma unroll
                        for (int j = 0; j < 8; ++j) v[j] *= 0.08838834764831845f;
                    } else if (ty == 1 || ty == 2) {
#pragma unroll
                        for (int j = 0; j < 8; ++j) v[j] = __builtin_amdgcn_logf(lbv[j] + omv[j] * sigmoidf_(v[j]));
                    }
                    u32x4 w; w.x = pk2(v[0], v[1]); w.y = pk2(v[2], v[3]); w.z = pk2(v[4], v[5]); w.w = pk2(v[6], v[7]);
                    gst4(base + (size_t)(row0 + ai * 128 + m * 16) * 512 + col0 + bj * 128, w);
                }
        }
    }
};
struct OneUnit { pg8::Unit u; __device__ bool next(int i, pg8::Unit& o) const { if (i > 0) return false; o = u; return true; } };
struct OrderA {
    pg8::TileOrder lat; int G, c, rep;
    __device__ void init(int G_, int c_, int rep_ = 1) { lat.init(128, 10, G_, c_); G = G_; c = c_; rep = rep_; }
    __device__ bool next(int i, pg8::Unit& u) const {
        long L = (long)i * G + c; if (L >= 1328L * rep) return false; L %= 1328;
        if (L < 1280) return lat.map(L, u);
        const int l2 = (int)(L - 1280); if (l2 >= 48) return false;
        u.pm = 128 + l2 / 6; u.pn = 2 + l2 % 6; return true;
    }
};
__device__ __forceinline__ size_t gate_rec(int gate, int pm, int pn4, int wave, int ai, int m, int lane) { return (((((((size_t)gate * 128 + pm) * 4 + pn4) * 8 + wave) * 2 + ai) * 4 + m) * 64 + lane) * 16; }
struct EpiGate {
    EPI_DEFAULT_HOOKS
    static constexpr bool PERM = true, TRANS = true;
    static constexpr int NST = 8;
    unsigned char* ws;
    __device__ __forceinline__ void operator()(const f32x4 (&acc)[2][2][4][2], const pg8::Unit& u, int wr, int wc, int fr, int fq) const {
        unsigned char* G8 = ws + OFF_GH;
#pragma unroll
        for (int ai = 0; ai < 2; ++ai)
#pragma unroll
            for (int m = 0; m < 4; ++m) {
                u32x4 w;
#pragma unroll
                for (int bj = 0; bj < 2; ++bj)
#pragma unroll
                    for (int n = 0; n < 2; ++n) { unsigned d = 0u;
#pragma unroll
                        for (int j = 0; j < 4; ++j) d = __builtin_amdgcn_cvt_pk_u8_f32(__builtin_amdgcn_rcpf(__builtin_fmaf(__expf(-acc[ai][bj][m][n][j]), 1.0f / 255.0f, 1.0f / 255.0f)), j, d);
                        w[2 * bj + n] = d; }
                gst4(G8 + gate_rec(u.pn >> 2, u.pm, u.pn & 3, wr * 4 + wc, ai, m, fq * 16 + fr), w);
            }
    }
};
struct EpiFT {
    EPI_DEFAULT_HOOKS
    static constexpr bool PERM = false, TRANS = false;
    static constexpr int NST = 32;
    unsigned char* ws;
    __device__ __forceinline__ void operator()(const f32x4 (&acc)[2][2][4][2], const pg8::Unit& u, int wr, int wc, int fr, int fq) const {
        h16* F = (h16*)(ws + OFF_FTT);
        const int t0 = u.pm * 256 + wr * 64 + 4 * fq, c0 = u.pn * 256 + wc * 32 + fr;
#pragma unroll
        for (int ai = 0; ai < 2; ++ai)
#pragma unroll
            for (int m = 0; m < 4; ++m)
#pragma unroll
                for (int bj = 0; bj < 2; ++bj)
#pragma unroll
                    for (int n = 0; n < 2; ++n) {
                        const int t = t0 + ai * 128 + m * 16, c = c0 + bj * 128 + n * 16;
                        const int b = t >> 12, n1 = t & 4095, part = c >> 9, gk = c & 511;
                        const f32x4 a = acc[ai][bj][m][n];
                        u32x2 w; w.x = pk2(a.x, a.y); w.y = pk2(a.z, a.w);
                        gst2(F + ((size_t)((b * 512 + gk) * 2 + part)) * 4096 + n1, w);
                    }
    }
};
struct EpiDFT {
    EPI_DEFAULT_HOOKS
    static constexpr bool PERM = true, TRANS = true;
    static constexpr int NST = 16;
    unsigned char* ws;
    __device__ __forceinline__ void operator()(const f32x4 (&acc)[2][2][4][2], const pg8::Unit& u, int wr, int wc, int fr, int fq) const {
        h16* Y = (h16*)(ws + OFF_YFT);
        const int b = u.pn >> 5, d = (u.pn >> 1) & 15;
        const int c0 = wr * 64 + fr, col0 = (u.pn & 1) * 256 + wc * 32 + 8 * fq;
#pragma unroll
        for (int ai = 0; ai < 2; ++ai)
#pragma unroll
            for (int m = 0; m < 4; ++m)
#pragma unroll
                for (int bj = 0; bj < 2; ++bj) {
                    const int c = c0 + ai * 128 + m * 16;
                    const f32x4 a0 = acc[ai][bj][m][0], a1 = acc[ai][bj][m][1];
                    u32x4 w; w.x = pk2(a0.x, a0.y); w.y = pk2(a0.z, a0.w); w.z = pk2(a1.x, a1.y); w.w = pk2(a1.z, a1.w);
                    gst4(Y + (size_t)(b * 4096 + d + 16 * c) * 512 + col0 + bj * 128, w);
                }
    }
};
typedef h16 GAS gh16;
template <bool ACCUM> struct EpiMerge1 {
    EPI_DEFAULT_HOOKS
    static constexpr bool PERM = true, TRANS = true;
    static constexpr int NST = 8;
    unsigned char* ws;
    __device__ __forceinline__ void operator()(const f32x4 (&acc)[2][2][4][2], const pg8::Unit& u, int wr, int wc, int fr, int fq) const {
        gh16* Y = (gh16*)(ws + OFF_Y); const unsigned char* G8 = ws + OFF_GH;
        const int row0 = u.pm * 256 + wr * 64 + fr, col0 = u.pn * 256 + wc * 32 + 8 * fq;
        const unsigned off0 = (unsigned)row0 * 1024u + (unsigned)col0;
#pragma unroll
        for (int ai = 0; ai < 2; ++ai) {
            u32x4 gt[4]; h16x8 yv[8];
#pragma unroll
            for (int m = 0; m < 4; ++m) gt[m] = *(const GAS u32x4*)(G8 + gate_rec(ACCUM ? 1 : 0, u.pm, u.pn, wr * 4 + wc, ai, m, fq * 16 + fr));
            if (ACCUM) {
#pragma unroll
                for (int i = 0; i < 8; ++i) { const int m = i >> 1, bj = i & 1; yv[i] = *(const GAS h16x8*)(Y + (off0 + (unsigned)((ai * 128 + m * 16) * 1024 + bj * 128))); } }
            __builtin_amdgcn_sched_barrier(0);
#pragma unroll
            for (int i = 0; i < 8; ++i) { const int m = i >> 1, bj = i & 1; const unsigned off = off0 + (unsigned)((ai * 128 + m * 16) * 1024 + bj * 128);
                float v[8];
#pragma unroll
                for (int n = 0; n < 2; ++n) { const unsigned d = gt[m][2 * bj + n];
#pragma unroll
                    for (int j = 0; j < 4; ++j) v[4 * n + j] = acc[ai][bj][m][n][j] * ((float)((d >> (8 * j)) & 255u) * (1.0f / 255.0f)); }
                if (ACCUM) {
#pragma unroll
                    for (int j = 0; j < 8; ++j) v[j] += (float)yv[i][j]; }
                u32x4 w; w.x = pk2(v[0], v[1]); w.y = pk2(v[2], v[3]); w.z = pk2(v[4], v[5]); w.w = pk2(v[6], v[7]);
                *(GAS u32x4*)(Y + off) = w; }
            __builtin_amdgcn_sched_barrier(0);
        }
    }
};
struct EpiMerge2 {
    static constexpr bool PERM = true, TRANS = true, FUSED = true;
    static constexpr int NST = 8;
    const float* x; h16* H;
    __device__ __forceinline__ size_t boff(const pg8::Unit& u) const { return (size_t)(u.pm >> 4) * (1024 * 1024 * 2); }
    __device__ __forceinline__ void init(f32x4 (&acc)[2][2][4][2], const pg8::Unit& u, int wr, int wc, int fr, int fq) const {
        const int row0 = u.pm * 256 + wr * 64 + fr, col0 = u.pn * 256 + wc * 32 + 8 * fq;
        const GAS float* xg = (const GAS float*)x;
#pragma unroll
        for (int ai = 0; ai < 2; ++ai)
#pragma unroll
            for (int m = 0; m < 4; ++m) { const GAS float* rowp = xg + (size_t)(row0 + ai * 128 + m * 16) * 1024 + col0;
#pragma unroll
                for (int bj = 0; bj < 2; ++bj)
#pragma unroll
                    for (int n = 0; n < 2; ++n) acc[ai][bj][m][n] = *(const GAS f32x4*)(rowp + bj * 128 + n * 4); }
    }
    __device__ __forceinline__ void fused(f32x4 (&acc)[2][2][4][2], const pg8::Unit& u, const pg8::Unit& nx, bool has_next, int wr, int wc, int fr, int fq) const {
        const int row0 = u.pm * 256 + wr * 64 + fr, col0 = u.pn * 256 + wc * 32 + 8 * fq;
        const int nrow0 = nx.pm * 256 + wr * 64 + fr, ncol0 = nx.pn * 256 + wc * 32 + 8 * fq;
        const GAS float* xg = (const GAS float*)x;
#pragma unroll
        for (int ai = 0; ai < 2; ++ai) {
            u32x4 o[4][2];
#pragma unroll
            for (int m = 0; m < 4; ++m)
#pragma unroll
                for (int bj = 0; bj < 2; ++bj) { const f32x4 a0 = acc[ai][bj][m][0], a1 = acc[ai][bj][m][1];
                    o[m][bj].x = pk2(a0[0], a0[1]); o[m][bj].y = pk2(a0[2], a0[3]); o[m][bj].z = pk2(a1[0], a1[1]); o[m][bj].w = pk2(a1[2], a1[3]); }
            __builtin_amdgcn_sched_barrier(0);
            if (has_next) {
#pragma unroll
                for (int m = 0; m < 4; ++m) { const GAS float* rowp = xg + (size_t)(nrow0 + ai * 128 + m * 16) * 1024 + ncol0;
#pragma unroll
                    for (int bj = 0; bj < 2; ++bj)
#pragma unroll
                        for (int n = 0; n < 2; ++n) acc[ai][bj][m][n] = *(const GAS f32x4*)(rowp + bj * 128 + n * 4); } }
            __builtin_amdgcn_sched_barrier(0);
#pragma unroll
            for (int m = 0; m < 4; ++m) { h16* rowp = H + (size_t)(row0 + ai * 128 + m * 16) * 1024 + col0;
#pragma unroll
                for (int bj = 0; bj < 2; ++bj) gst4(rowp + bj * 128, o[m][bj]); }
            __builtin_amdgcn_sched_barrier(0);
        }
    }
};
__device__ __forceinline__ void scale_wout(const Params& p, int vb, int vn) {
    const h16* W = (const h16*)(p.ws + OFF_WOUT); h16* WG = (h16*)(p.ws + OFF_WOUTG); const float* mod = (const float*)(p.ws + OFF_MOD);
    for (size_t i = (size_t)vb * NTHREADS + threadIdx.x; i < (size_t)8 * 1024 * 128; i += (size_t)vn * NTHREADS) {
        const int b = (int)(i >> 17), c = (int)((i >> 7) & 1023), k8 = (int)(i & 127) * 8;
        const h16x8 w = *(const h16x8*)(W + (size_t)c * 1024 + k8); const float g = mod[b * 6144 + 2048 + c];
        u32x4 o; o.x = pk2((float)w[0] * g, (float)w[1] * g); o.y = pk2((float)w[2] * g, (float)w[3] * g); o.z = pk2((float)w[4] * g, (float)w[5] * g); o.w = pk2((float)w[6] * g, (float)w[7] * g);
        *(u32x4*)(WG + ((size_t)b * 1024 + c) * 1024 + k8) = o; }
}
__device__ __forceinline__ unsigned f2key(float x) { const unsigned b = __builtin_bit_cast(unsigned, x); return b ^ ((b >> 31) ? 0xFFFFFFFFu : 0x80000000u); }
__device__ __forceinline__ float key2f(unsigned u) { const unsigned b = (u & 0x80000000u) ? (u ^ 0x80000000u) : ~u; return __builtin_bit_cast(float, b); }
__device__ __forceinline__ unsigned umax3(unsigned a, unsigned b, unsigned c) { return max(max(a, b), c); }
typedef short s16x2_t __attribute__((ext_vector_type(2)));
__device__ __forceinline__ unsigned hkey2(float a, float b) { const unsigned w = pk2(a, b); const s16x2_t m = __builtin_bit_cast(s16x2_t, w) >> 15;
    return w ^ (__builtin_bit_cast(unsigned, m) | 0x80008000u); }
struct EpiScores {
    static constexpr bool PERM = false, TRANS = true;
    static constexpr int NST = 16;
    EPI_DEFAULT_HOOKS
    unsigned char* C;
    __device__ __forceinline__ void operator()(const f32x4 (&acc)[2][2][4][2], const pg8::Unit& u, int wr, int wc, int fr, int fq) const {
#pragma unroll
        for (int ai = 0; ai < 2; ++ai)
#pragma unroll
            for (int m = 0; m < 4; ++m) { const int t = u.pm * 256 + ai * 128 + wr * 64 + m * 16 + fr, tb = t >> 6, tl = t & 63;
#pragma unroll
                for (int bj = 0; bj < 2; ++bj) { const int c8 = 4 * wc + fq;
                    const f32x4 a0 = acc[ai][bj][m][0], a1 = acc[ai][bj][m][1]; u32x4 kq;
                    kq.x = hkey2(a0[0], a0[1]); kq.y = hkey2(a0[2], a0[3]); kq.z = hkey2(a1[0], a1[1]); kq.w = hkey2(a1[2], a1[3]);
                    gst4(C + ((((size_t)(tb * 8 + u.pn) * 2 + bj) * 16 + c8) * 64 + tl) * 16, kq); } }
    }
};
__device__ __forceinline__ int hgrn_row(int pos, int b, int dir) {
    if (pos < LC) { const int j = dir ? (LC - 1 - pos) : pos; return T + b * LC + j; }
    const int t = pos - LC; return b * SEQ + (dir ? (SEQ - 1 - t) : t);
}
__device__ void hgrn_item(const Params& p, LAS unsigned char* lds, int item) {
    const int tid = threadIdx.x, vq = item & 3, dir = (item >> 2) & 1, h = (item >> 3) & 3, b = item >> 5;
    const h16* Q = (const h16*)(p.ws + OFF_Q); const h16* LF = (const h16*)(p.ws + (dir ? OFF_LBK : OFF_LF)); const h16* V = (const h16*)(p.ws + OFF_V);
    h16* O = (h16*)(p.ws + (dir ? OFF_OB : OFF_OF));
    LAS float* fs = (LAS float*)lds; LAS float* ks = fs + 16 * 128; LAS float* qs = ks + 16 * 128; LAS float* vs = qs + 16 * 128; LAS float* po = vs + 16 * 32;
    const int v = tid & 31, kq = tid >> 5;
    float S[8];
#pragma unroll
    for (int j = 0; j < 8; ++j) S[j] = 0.f;
    const int e = tid * 4, tl_ld = e >> 7, k_ld = e & 127;
    const int tl_v = tid >> 5, vv = tid & 31;
    h16x4 lf4, q4; h16 v1;
    { const int row = hgrn_row(tl_ld, b, dir); lf4 = *(const h16x4*)(LF + (size_t)row * 512 + h * 128 + k_ld); q4 = (h16x4){0, 0, 0, 0};
      const int row2 = hgrn_row(tl_v, b, dir); v1 = V[(size_t)row2 * 512 + h * 128 + vq * 32 + vv]; }
    constexpr int NG = (LC + SEQ) / 16;
    for (int grp = 0; grp < NG; ++grp) {
        const bool latent = grp >= LC / 16;
#pragma unroll
        for (int j = 0; j < 4; ++j) { const float f = __expf((float)lf4[j]); fs[e + j] = f; ks[e + j] = 1.0f - f; qs[e + j] = (float)q4[j]; }
        vs[tid] = (float)v1;
        __syncthreads();
        if (grp + 1 < NG) { const int pos = (grp + 1) * 16; const bool lat2 = (grp + 1) >= LC / 16;
            const int row = hgrn_row(pos + tl_ld, b, dir); lf4 = *(const h16x4*)(LF + (size_t)row * 512 + h * 128 + k_ld);
            if (lat2) q4 = *(const h16x4*)(Q + (size_t)row * 512 + h * 128 + k_ld);
            const int row2 = hgrn_row(pos + tl_v, b, dir); v1 = V[(size_t)row2 * 512 + h * 128 + vq * 32 + vv]; }
#pragma unroll 4
        for (int tl = 0; tl < 16; ++tl) {
            const float vt = vs[tl * 32 + v];
            const f32x4 f0 = *(const LAS f32x4*)(fs + tl * 128 + kq * 8), f1 = *(const LAS f32x4*)(fs + tl * 128 + kq * 8 + 4);
            const f32x4 k0 = *(const LAS f32x4*)(ks + tl * 128 + kq * 8), k1 = *(const LAS f32x4*)(ks + tl * 128 + kq * 8 + 4);
            const f32x4 q0 = *(const LAS f32x4*)(qs + tl * 128 + kq * 8), q1 = *(const LAS f32x4*)(qs + tl * 128 + kq * 8 + 4);
            float a = 0.f;
#pragma unroll
            for (int j = 0; j < 4; ++j) { S[j] = f0[j] * S[j] + k0[j] * vt; a += S[j] * q0[j]; S[4 + j] = f1[j] * S[4 + j] + k1[j] * vt; a += S[4 + j] * q1[j]; }
            po[(tl * 16 + kq) * 32 + v] = a;
        }
        __syncthreads();
        if (latent) { float s = 0.f;
#pragma unroll
            for (int q = 0; q < 16; ++q) s += po[(tl_v * 16 + q) * 32 + vv];
            const int row = hgrn_row(grp * 16 + tl_v, b, dir);
            O[(size_t)row * 512 + h * 128 + vq * 32 + vv] = (h16)s; }
    }
    __syncthreads();
}

typedef short s16x8 __attribute__((ext_vector_type(8)));
typedef short s16x4 __attribute__((ext_vector_type(4)));
__device__ __forceinline__ unsigned cvt_pk_bf16(float lo, float hi) { unsigned r; asm volatile("v_cvt_pk_bf16_f32 %0, %1, %2" : "=v"(r) : "v"(lo), "v"(hi)); return r; }
constexpr int HG_RP = 272, HG_QT = 0, HG_KT = 17408, HG_QD = 34816, HG_KDT = 52224, HG_VT = 68608, HG_AM = 84992, HG_DEC = 93184, HG_SEG = 93696, HG_SEGCH = 17;
#define HG_OPAQUE(x) asm volatile("" : "+v"(x))
template <bool FULL>
__device__ __forceinline__ void hgrn_mfma_unit(const Params& p, LAS unsigned char* lds, int item, int seg) {
    const int tid = threadIdx.x, wave = __builtin_amdgcn_readfirstlane(tid >> 6), lane = tid & 63, fr = lane & 15, fq = lane >> 4;
    const int dir = item & 1, h = (item >> 1) & 3, b = item >> 3;
    const h16* Q = (const h16*)(p.ws + OFF_Q); const h16* LF = (const h16*)(p.ws + (dir ? OFF_LBK : OFF_LF)); const h16* V = (const h16*)(p.ws + OFF_V);
    h16* O = (h16*)(p.ws + (dir ? OFF_OB : OFF_OF));
    float* USTATE = (float*)(p.ws + OFF_USTATE); float* DLOG = (float*)(p.ws + OFF_DLOG);
    const int ch_lo = seg * HG_SEGCH, ch_hi = ch_lo + HG_SEGCH;
    f32x4 S[8];
#pragma unroll
    for (int m = 0; m < 8; ++m) S[m] = (f32x4){0.f, 0.f, 0.f, 0.f};
    if (FULL && seg > 0) {
        for (int i = 0; i < seg; ++i) { const float* U = USTATE + (size_t)(item * 3 + i) * 16384; const float* DL = DLOG + (size_t)(item * 3 + i) * 128;
#pragma unroll
            for (int m = 0; m < 8; ++m)
#pragma unroll
                for (int j = 0; j < 4; ++j) { const int k = 16 * m + 4 * fq + j; const float d = (i > 0) ? __builtin_amdgcn_exp2f(DL[k]) : 0.f; S[m][j] = d * S[m][j] + U[k * 128 + 16 * wave + fr]; } } }
    float dl0 = 0.f, dl1 = 0.f;
    for (int i = tid; i < 8192 / 16; i += NTHREADS) ((LAS u32x4*)(lds + HG_AM))[i] = (u32x4){0u, 0u, 0u, 0u};
    const int kp = lane;
    const unsigned chan = (unsigned)(h * 128 + 2 * kp);
    int bw_rm = wave * 8 * HG_RP + 4 * kp;
    int bw_t0 = (2 * kp) * 128 + ((wave ^ ((2 * kp) & 7)) << 4), bw_t1 = (2 * kp + 1) * 128 + ((wave ^ ((2 * kp + 1) & 7)) << 4);
    int br_rm = fr * HG_RP + 16 * fq;
    int br_qd = HG_QD + fr * HG_RP + 8 * fq;
    int br_t0 = fr * 128 + ((fq ^ (fr & 7)) << 4), br_t1 = fr * 128 + (((4 + fq) ^ (fr & 7)) << 4);
    HG_OPAQUE(bw_rm); HG_OPAQUE(bw_t0); HG_OPAQUE(bw_t1); HG_OPAQUE(br_rm); HG_OPAQUE(br_qd); HG_OPAQUE(br_t0); HG_OPAQUE(br_t1);
    int br_v0 = br_t0 + HG_VT + wave * 2048, br_v1 = br_t1 + HG_VT + wave * 2048, br_k0 = br_t0 + HG_KDT, br_k1 = br_t1 + HG_KDT, br_a0 = br_t0 + HG_AM, br_a1 = br_t1 + HG_AM;
    HG_OPAQUE(br_v0); HG_OPAQUE(br_v1); HG_OPAQUE(br_k0); HG_OPAQUE(br_k1); HG_OPAQUE(br_a0); HG_OPAQUE(br_a1);
    LAS float* DEC = (LAS float*)(lds + HG_DEC); LAS float* SEG = (LAS float*)(lds + HG_SEG);
    unsigned lfr[8], qr[8], vr[8];
#pragma unroll
    for (int r = 0; r < 8; ++r) { const unsigned eo = (unsigned)hgrn_row(ch_lo * 64 + 8 * wave + r, b, dir) * 512u + chan; lfr[r] = *(const unsigned*)(LF + eo); vr[r] = *(const unsigned*)(V + eo);
        qr[r] = (FULL && ch_lo >= LC / 64) ? *(const unsigned*)(Q + eo) : 0u; }
    for (int ch = ch_lo; ch < ch_hi; ++ch) {
        const bool latent = FULL && (ch >= LC / 64);
        float f0[8], f1[8]; float run0 = 0.f, run1 = 0.f;
#pragma unroll
        for (int r = 0; r < 8; ++r) { const h16x2 l = __builtin_bit_cast(h16x2, lfr[r]); const float l0 = (float)l[0], l1 = (float)l[1]; run0 += l0; run1 += l1;
            f0[r] = __builtin_amdgcn_exp2f(l0); f1[r] = __builtin_amdgcn_exp2f(l1); }
        *(LAS f32x2*)(SEG + wave * 128 + 2 * kp) = (f32x2){run0, run1};
        __syncthreads();
        float off0 = 0.f, off1 = 0.f, mid0 = 0.f, mid1 = 0.f, tot0 = 0.f, tot1 = 0.f;
#pragma unroll
        for (int w2 = 0; w2 < 8; ++w2) { const f32x2 tt = *(LAS f32x2*)(SEG + w2 * 128 + 2 * kp);
            if (w2 < wave) { off0 += tt[0]; off1 += tt[1]; } if (w2 < 4) { mid0 += tt[0]; mid1 += tt[1]; } tot0 += tt[0]; tot1 += tt[1]; }
        dl0 += tot0; dl1 += tot1;
        const float em0 = __builtin_amdgcn_exp2f(mid0), em1 = __builtin_amdgcn_exp2f(mid1), el0 = __builtin_amdgcn_exp2f(tot0 - mid0), el1 = __builtin_amdgcn_exp2f(tot1 - mid1);
        if (wave == 0) *(LAS f32x2*)(DEC + 2 * kp) = (f32x2){__builtin_amdgcn_exp2f(tot0), __builtin_amdgcn_exp2f(tot1)};
        float e2a[8], e2b[8];
        e2a[7] = __builtin_amdgcn_exp2f(mid0 - (off0 + run0)); e2b[7] = __builtin_amdgcn_exp2f(mid1 - (off1 + run1));
#pragma unroll
        for (int r = 7; r > 0; --r) { e2a[r - 1] = e2a[r] * f0[r]; e2b[r - 1] = e2b[r] * f1[r]; }
        float e1a = FULL ? __builtin_amdgcn_exp2f(off0 - mid0) : 0.f, e1b = FULL ? __builtin_amdgcn_exp2f(off1 - mid1) : 0.f;
        unsigned kd0[4], kd1[4], vt0[4], vt1[4];
#pragma unroll
        for (int r = 0; r < 8; ++r) {
            const h16x2 q = __builtin_bit_cast(h16x2, qr[r]), v = __builtin_bit_cast(h16x2, vr[r]);
            const float e20 = e2a[r], e21 = e2b[r];
            const float k0 = 1.0f - f0[r], k1 = 1.0f - f1[r];
            const float kt0 = k0 * e20, kt1 = k1 * e21;
            if (FULL) {
                e1a *= f0[r]; e1b *= f1[r]; const float e10 = e1a, e11 = e1b;
                const float qt0 = (float)q[0] * e10, qt1 = (float)q[1] * e11;
                *(LAS unsigned*)(lds + bw_rm + HG_QT + r * HG_RP) = cvt_pk_bf16(qt0, qt1);
                *(LAS unsigned*)(lds + bw_rm + HG_KT + r * HG_RP) = cvt_pk_bf16(kt0, kt1);
                *(LAS unsigned*)(lds + bw_rm + HG_QD + r * HG_RP) = cvt_pk_bf16(qt0 * em0, qt1 * em1);
            }
            const float kdv0 = kt0 * el0, kdv1 = kt1 * el1;
            if (r & 1) { kd0[r >> 1] = cvt_pk_bf16(__builtin_bit_cast(float, kd0[r >> 1]), kdv0); kd1[r >> 1] = cvt_pk_bf16(__builtin_bit_cast(float, kd1[r >> 1]), kdv1);
                         vt0[r >> 1] = cvt_pk_bf16(__builtin_bit_cast(float, vt0[r >> 1]), (float)v[0]); vt1[r >> 1] = cvt_pk_bf16(__builtin_bit_cast(float, vt1[r >> 1]), (float)v[1]); }
            else { kd0[r >> 1] = __builtin_bit_cast(unsigned, kdv0); kd1[r >> 1] = __builtin_bit_cast(unsigned, kdv1);
                   vt0[r >> 1] = __builtin_bit_cast(unsigned, (float)v[0]); vt1[r >> 1] = __builtin_bit_cast(unsigned, (float)v[1]); }
        }
        *(LAS u32x4*)(lds + bw_t0 + HG_KDT) = (u32x4){kd0[0], kd0[1], kd0[2], kd0[3]};
        *(LAS u32x4*)(lds + bw_t1 + HG_KDT) = (u32x4){kd1[0], kd1[1], kd1[2], kd1[3]};
        *(LAS u32x4*)(lds + bw_t0 + HG_VT) = (u32x4){vt0[0], vt0[1], vt0[2], vt0[3]};
        *(LAS u32x4*)(lds + bw_t1 + HG_VT) = (u32x4){vt1[0], vt1[1], vt1[2], vt1[3]};
        __syncthreads();
        if (ch + 1 < ch_hi) { const bool lat2 = FULL && ((ch + 1) >= LC / 64);
#pragma unroll
            for (int r = 0; r < 8; ++r) { const unsigned eo = (unsigned)hgrn_row((ch + 1) * 64 + 8 * wave + r, b, dir) * 512u + chan;
                lfr[r] = *(const unsigned*)(LF + eo); vr[r] = *(const unsigned*)(V + eo); qr[r] = lat2 ? *(const unsigned*)(Q + eo) : 0u; } }
        if (latent) {
#pragma unroll
            for (int rep = 0; rep < 2; ++rep) {
                const int tile = wave + 8 * rep;
                if (tile < 10) {
                    const int ti = tile < 1 ? 0 : tile < 3 ? 1 : tile < 6 ? 2 : 3, si = tile - (ti * (ti + 1)) / 2;
                    f32x4 acc = (f32x4){0.f, 0.f, 0.f, 0.f};
                    LAS unsigned char* pa = lds + br_rm + HG_KT + 16 * si * HG_RP; LAS unsigned char* pb = lds + br_rm + HG_QT + 16 * ti * HG_RP;
#pragma unroll
                    for (int kk = 0; kk < 4; ++kk) acc = __builtin_amdgcn_mfma_f32_16x16x32_bf16(*(LAS s16x8*)(pa + 64 * kk), *(LAS s16x8*)(pb + 64 * kk), acc, 0, 0, 0);
                    const int t = 16 * ti + fr, s0 = 16 * si + 4 * fq;
                    if (ti == si) {
#pragma unroll
                        for (int j = 0; j < 4; ++j) acc[j] = (s0 + j <= t) ? acc[j] : 0.f; }
                    *(LAS u32x2*)(lds + HG_AM + t * 128 + ((((s0 >> 3)) ^ (fr & 7)) << 4) + (s0 & 7) * 2) = (u32x2){cvt_pk_bf16(acc[0], acc[1]), cvt_pk_bf16(acc[2], acc[3])};
                }
            }
        }
        __syncthreads();
        const s16x8 vf0 = *(LAS s16x8*)(lds + br_v0), vf1 = *(LAS s16x8*)(lds + br_v1);
        if (latent) {
            s16x8 sfrag[4];
#pragma unroll
            for (int kk = 0; kk < 4; ++kk) { const unsigned w0 = cvt_pk_bf16(S[2 * kk][0], S[2 * kk][1]), w1 = cvt_pk_bf16(S[2 * kk][2], S[2 * kk][3]),
                                                          w2 = cvt_pk_bf16(S[2 * kk + 1][0], S[2 * kk + 1][1]), w3 = cvt_pk_bf16(S[2 * kk + 1][2], S[2 * kk + 1][3]);
                sfrag[kk] = __builtin_bit_cast(s16x8, (u32x4){w0, w1, w2, w3}); }
#pragma unroll
            for (int ti = 0; ti < 4; ++ti) {
                f32x4 acc = (f32x4){0.f, 0.f, 0.f, 0.f};
                acc = __builtin_amdgcn_mfma_f32_16x16x32_bf16(vf0, *(LAS s16x8*)(lds + br_a0 + 2048 * ti), acc, 0, 0, 0);
                if (ti >= 2) acc = __builtin_amdgcn_mfma_f32_16x16x32_bf16(vf1, *(LAS s16x8*)(lds + br_a1 + 2048 * ti), acc, 0, 0, 0);
#pragma unroll
                for (int kk = 0; kk < 4; ++kk) {
                    const s16x4 lo = *(LAS s16x4*)(lds + br_qd + 16 * ti * HG_RP + 64 * kk), hi = *(LAS s16x4*)(lds + br_qd + 16 * ti * HG_RP + 64 * kk + 32);
                    const s16x8 bf = (s16x8){lo[0], lo[1], lo[2], lo[3], hi[0], hi[1], hi[2], hi[3]};
                    acc = __builtin_amdgcn_mfma_f32_16x16x32_bf16(sfrag[kk], bf, acc, 0, 0, 0); }
                const unsigned oo = (unsigned)hgrn_row(ch * 64 + 16 * ti + fr, b, dir) * 512u + (unsigned)(h * 128 + 16 * wave + 4 * fq);
                *(u32x2*)(O + oo) = (u32x2){pk2(acc[0], acc[1]), pk2(acc[2], acc[3])};
            }
        }
#pragma unroll
        for (int m = 0; m < 8; ++m) {
            const f32x4 dc = *(LAS f32x4*)(DEC + 16 * m + 4 * fq);
            S[m] = S[m] * dc;
            S[m] = __builtin_amdgcn_mfma_f32_16x16x32_bf16(*(LAS s16x8*)(lds + br_k0 + 2048 * m), vf0, S[m], 0, 0, 0);
            S[m] = __builtin_amdgcn_mfma_f32_16x16x32_bf16(*(LAS s16x8*)(lds + br_k1 + 2048 * m), vf1, S[m], 0, 0, 0);
        }
    }
    if (!FULL) {
        float* U = USTATE + (size_t)(item * 3 + seg) * 16384;
#pragma unroll
        for (int m = 0; m < 8; ++m)
#pragma unroll
            for (int j = 0; j < 4; ++j) U[(16 * m + 4 * fq + j) * 128 + 16 * wave + fr] = S[m][j];
        if (wave == 0) *(f32x2*)(DLOG + (size_t)(item * 3 + seg) * 128 + 2 * kp) = (f32x2){dl0, dl1};
    }
    __syncthreads();
}

__device__ __forceinline__ void fft1_phase(const Params& p, LAS unsigned char* lds) {
    LAS float* ctab = (LAS float*)lds;
    LAS float* w16 = ctab + 4096;
    for (int i = threadIdx.x; i < 4096; i += NTHREADS) ctab[i] = cospif((float)i / 2048.0f);
    if (threadIdx.x < 16) { w16[threadIdx.x] = cospif((float)threadIdx.x / 8.0f); w16[16 + threadIdx.x] = sinpif((float)threadIdx.x / 8.0f); }
    __syncthreads();
    const h16* F = (const h16*)(p.ws + OFF_FTT); h16* Y1 = (h16*)(p.ws + OFF_Y1);
    const int ap = threadIdx.x & 127, gl = threadIdx.x >> 7;
    volatile LAS unsigned* slot = (volatile LAS unsigned*)(lds + LDS_BYTES - 64) + 9;
    unsigned* ctr = (unsigned*)(p.ws + OFF_CTL) + CTL_P0Q + 64;
    if (threadIdx.x == 0) slot[0] = xb_add(ctr, 1u);
    __syncthreads();
    int item = (int)slot[0];
    __syncthreads();
    while (item < 8 * 128) {
        unsigned nxt_ = 0u;
        if (threadIdx.x == 0) nxt_ = xb_add(ctr, 1u);
        const int b = item >> 7, gk = (item & 127) * 4 + gl;
        float zr[16][2], zi[16][2];
        const h16* src = F + ((size_t)(b * 512 + gk) * 2) * 4096 + 2 * ap;
#pragma unroll
        for (int r = 0; r < 16; ++r) { const h16x2 c2 = *(const h16x2*)(src + 256 * r), s2 = *(const h16x2*)(src + 4096 + 256 * r);
            zr[r][0] = (float)c2[0]; zr[r][1] = (float)c2[1]; zi[r][0] = -(float)s2[0]; zi[r][1] = -(float)s2[1]; }
        float ur[4][4][2], ui[4][4][2];
#pragma unroll
        for (int r0 = 0; r0 < 4; ++r0)
#pragma unroll
            for (int j = 0; j < 2; ++j) {
                const float a0r = zr[r0][j], a0i = zi[r0][j], a1r = zr[4 + r0][j], a1i = zi[4 + r0][j], a2r = zr[8 + r0][j], a2i = zi[8 + r0][j], a3r = zr[12 + r0][j], a3i = zi[12 + r0][j];
                const float s0r = a0r + a2r, s0i = a0i + a2i, s1r = a0r - a2r, s1i = a0i - a2i, s2r = a1r + a3r, s2i = a1i + a3i, s3r = a1r - a3r, s3i = a1i - a3i;
                float xr[4], xi[4];
                xr[0] = s0r + s2r; xi[0] = s0i + s2i; xr[2] = s0r - s2r; xi[2] = s0i - s2i;
                xr[1] = s1r + s3i; xi[1] = s1i - s3r;
                xr[3] = s1r - s3i; xi[3] = s1i + s3r;
#pragma unroll
                for (int d0 = 0; d0 < 4; ++d0) { const int m = r0 * d0;
                    const float cs = (m == 0) ? 1.f : (m == 1) ? 0.92387953251f : (m == 2) ? 0.70710678119f : (m == 3) ? 0.38268343237f : (m == 4) ? 0.f : (m == 6) ? -0.70710678119f : -0.92387953251f;
                    const float sn = (m == 0) ? 0.f : (m == 1) ? 0.38268343237f : (m == 2) ? 0.70710678119f : (m == 3) ? 0.92387953251f : (m == 4) ? 1.f : (m == 6) ? 0.70710678119f : -0.38268343237f;
                    ur[r0][d0][j] = xr[d0] * cs + xi[d0] * sn; ui[r0][d0][j] = xi[d0] * cs - xr[d0] * sn; } }
#pragma unroll
        for (int d0 = 0; d0 < 4; ++d0) {
            float yr4[4][2], yi4[4][2];
#pragma unroll
            for (int j = 0; j < 2; ++j) {
                const float a0r = ur[0][d0][j], a0i = ui[0][d0][j], a1r = ur[1][d0][j], a1i = ui[1][d0][j], a2r = ur[2][d0][j], a2i = ui[2][d0][j], a3r = ur[3][d0][j], a3i = ui[3][d0][j];
                const float s0r = a0r + a2r, s0i = a0i + a2i, s1r = a0r - a2r, s1i = a0i - a2i, s2r = a1r + a3r, s2i = a1i + a3i, s3r = a1r - a3r, s3i = a1i - a3i;
                yr4[0][j] = s0r + s2r; yi4[0][j] = s0i + s2i; yr4[2][j] = s0r - s2r; yi4[2][j] = s0i - s2i;
                yr4[1][j] = s1r + s3i; yi4[1][j] = s1i - s3r; yr4[3][j] = s1r - s3i; yi4[3][j] = s1i + s3r; }
#pragma unroll
            for (int d1 = 0; d1 < 4; ++d1) { const int d = d0 + 4 * d1;
                float ore[2], oim[2];
#pragma unroll
                for (int j = 0; j < 2; ++j) { const int t = ((2 * ap + j) * d) & 4095; const float ct = ctab[t], st = ctab[(t - 1024) & 4095];
                    ore[j] = (yr4[d1][j] * ct + yi4[d1][j] * st) * 0.0625f; oim[j] = (yi4[d1][j] * ct - yr4[d1][j] * st) * 0.0625f; }
            h16* dst = Y1 + ((size_t)((b * 16 + d) * 512 + gk)) * 512 + 2 * ap;
            *(unsigned*)dst = pk2(ore[0], ore[1]); *(unsigned*)(dst + 256) = pk2(oim[0], oim[1]);
            }
        }
        if (threadIdx.x == 0) slot[0] = nxt_;
        __syncthreads();
        item = (int)slot[0];
        __syncthreads();
    }
    __syncthreads();
}

__device__ __forceinline__ void a1_prepass(const Params& p) {
    const int wave = threadIdx.x >> 6, lane = threadIdx.x & 63;
    const h16* OF = (const h16*)(p.ws + OFF_OF); const h16* OB = (const h16*)(p.ws + OFF_OB); h16* G = (h16*)(p.ws + OFF_G);
    const float* hgn = p.in[11];
    float hg[8];
#pragma unroll
    for (int j = 0; j < 8; ++j) hg[j] = hgn[lane * 8 + j];
    for (int t0 = (blockIdx.x * 8 + wave) * 4; t0 < T; t0 += gridDim.x * 32) {
        h16x8 a[4], bq[4], g[4];
#pragma unroll
        for (int q = 0; q < 4; ++q) { const size_t off = (size_t)(t0 + q) * 512 + lane * 8; a[q] = *(const h16x8*)(OF + off); bq[q] = *(const h16x8*)(OB + off); g[q] = *(const h16x8*)(G + off); }
#pragma unroll
        for (int q = 0; q < 4; ++q) {
            float o[8]; float ss = 0.f;
#pragma unroll
            for (int j = 0; j < 8; ++j) { o[j] = (float)a[q][j] + (float)bq[q][j]; ss += o[j] * o[j]; }
            ss += __shfl_xor(ss, 1); ss += __shfl_xor(ss, 2); ss += __shfl_xor(ss, 4); ss += __shfl_xor(ss, 8);
            const float rstd = rsqrtf(ss * (1.0f / 128.0f) + EPS);
            float r[8];
#pragma unroll
            for (int j = 0; j < 8; ++j) { const float gz = (float)g[q][j]; r[j] = o[j] * rstd * hg[j] * (gz * sigmoidf_(gz)); }
            u32x4 w; w.x = pk2(r[0], r[1]); w.y = pk2(r[2], r[3]); w.z = pk2(r[4], r[5]); w.w = pk2(r[6], r[7]);
            *(u32x4*)(G + (size_t)(t0 + q) * 512 + lane * 8) = w;
        }
    }
}

__device__ __forceinline__ void convert_tables(const Params& p, int vb, int vn) {
    const int wave = threadIdx.x >> 6, lane = threadIdx.x & 63;
    for (int r2 = vb * 8 + wave; r2 < 2 * 16384; r2 += vn * 8) {
        const int tb = r2 >> 14, e = r2 & 16383;
        const float* src = (tb ? p.in[18] : p.in[17]) + (size_t)e * D + lane * 16;
        f32x4 v[4]; float amax = 0.f;
#pragma unroll
        for (int j = 0; j < 4; ++j) { v[j] = *(const f32x4*)(src + 4 * j); amax = fmaxf(amax, fmaxf(fmaxf(fabsf(v[j].x), fabsf(v[j].y)), fmaxf(fabsf(v[j].z), fabsf(v[j].w)))); }
#pragma unroll
        for (int o = 32; o >= 1; o >>= 1) amax = fmaxf(amax, __shfl_xor(amax, o));
        const float qs = amax > 0.f ? amax * (1.0f / 127.0f) : 1.0f, inv = 1.0f / qs;
        const int bias = 0;
        u32x4 w;
#pragma unroll
        for (int j = 0; j < 4; ++j) { const int q0 = (int)rintf(v[j].x * inv) + bias, q1 = (int)rintf(v[j].y * inv) + bias, q2 = (int)rintf(v[j].z * inv) + bias, q3 = (int)rintf(v[j].w * inv) + bias;
            w[j] = (unsigned)(q0 & 255) | ((unsigned)(q1 & 255) << 8) | ((unsigned)(q2 & 255) << 16) | ((unsigned)(q3 & 255) << 24); }
        unsigned char* dst = p.ws + (tb ? OFF_TV : OFF_TU);
        *(u32x4*)(dst + ((size_t)(lane >> 3) * 16384 + e) * 128 + (lane & 7) * 16) = w;
        if (lane == 0) ((float*)(p.ws + (tb ? OFF_SV : OFF_SU)))[e] = qs;
    }
}

#define CE_DESC(a, b) do { const unsigned hi_ = max(a, b), lo_ = min(a, b); a = hi_; b = lo_; } while (0)
template <int N> __device__ __forceinline__ void sort16_desc(unsigned (&k)[N], const int base) {
    CE_DESC(k[base + 0], k[base + 1]); CE_DESC(k[base + 2], k[base + 3]); CE_DESC(k[base + 0], k[base + 2]); CE_DESC(k[base + 1], k[base + 3]); CE_DESC(k[base + 1], k[base + 2]); CE_DESC(k[base + 4], k[base + 5]); CE_DESC(k[base + 6], k[base + 7]); CE_DESC(k[base + 4], k[base + 6]);
    CE_DESC(k[base + 5], k[base + 7]); CE_DESC(k[base + 5], k[base + 6]); CE_DESC(k[base + 0], k[base + 4]); CE_DESC(k[base + 2], k[base + 6]); CE_DESC(k[base + 2], k[base + 4]); CE_DESC(k[base + 1], k[base + 5]); CE_DESC(k[base + 3], k[base + 7]); CE_DESC(k[base + 3], k[base + 5]);
    CE_DESC(k[base + 1], k[base + 2]); CE_DESC(k[base + 3], k[base + 4]); CE_DESC(k[base + 5], k[base + 6]); CE_DESC(k[base + 8], k[base + 9]); CE_DESC(k[base + 10], k[base + 11]); CE_DESC(k[base + 8], k[base + 10]); CE_DESC(k[base + 9], k[base + 11]); CE_DESC(k[base + 9], k[base + 10]);
    CE_DESC(k[base + 12], k[base + 13]); CE_DESC(k[base + 14], k[base + 15]); CE_DESC(k[base + 12], k[base + 14]); CE_DESC(k[base + 13], k[base + 15]); CE_DESC(k[base + 13], k[base + 14]); CE_DESC(k[base + 8], k[base + 12]); CE_DESC(k[base + 10], k[base + 14]); CE_DESC(k[base + 10], k[base + 12]);
    CE_DESC(k[base + 9], k[base + 13]); CE_DESC(k[base + 11], k[base + 15]); CE_DESC(k[base + 11], k[base + 13]); CE_DESC(k[base + 9], k[base + 10]); CE_DESC(k[base + 11], k[base + 12]); CE_DESC(k[base + 13], k[base + 14]); CE_DESC(k[base + 0], k[base + 8]); CE_DESC(k[base + 4], k[base + 12]);
    CE_DESC(k[base + 4], k[base + 8]); CE_DESC(k[base + 2], k[base + 10]); CE_DESC(k[base + 6], k[base + 14]); CE_DESC(k[base + 6], k[base + 10]); CE_DESC(k[base + 2], k[base + 4]); CE_DESC(k[base + 6], k[base + 8]); CE_DESC(k[base + 10], k[base + 12]); CE_DESC(k[base + 1], k[base + 9]);
    CE_DESC(k[base + 5], k[base + 13]); CE_DESC(k[base + 5], k[base + 9]); CE_DESC(k[base + 3], k[base + 11]); CE_DESC(k[base + 7], k[base + 15]); CE_DESC(k[base + 7], k[base + 11]); CE_DESC(k[base + 3], k[base + 5]); CE_DESC(k[base + 7], k[base + 9]); CE_DESC(k[base + 11], k[base + 13]);
    CE_DESC(k[base + 1], k[base + 2]); CE_DESC(k[base + 3], k[base + 4]); CE_DESC(k[base + 5], k[base + 6]); CE_DESC(k[base + 7], k[base + 8]); CE_DESC(k[base + 9], k[base + 10]); CE_DESC(k[base + 11], k[base + 12]); CE_DESC(k[base + 13], k[base + 14]);
}
template <int N> __device__ __forceinline__ void merge16_desc(unsigned (&k)[N], const int a, const int b) {
#pragma unroll
    for (int i = 0; i < 16; ++i) k[a + i] = max(k[a + i], k[b + 15 - i]);
#pragma unroll
    for (int stride = 8; stride > 0; stride /= 2)
#pragma unroll
        for (int i = 0; i < 16; ++i) if ((i & stride) == 0) CE_DESC(k[a + i], k[a + i + stride]);
}
__device__ __forceinline__ float hkey2f(unsigned key) { const unsigned u = key >> 16, b = (u & 0x8000u) ? (u ^ 0x8000u) : (~u & 0xFFFFu); return (float)__builtin_bit_cast(h16, (unsigned short)b); }
__device__ __forceinline__ void top16_of_128(const unsigned char* sc, unsigned (&out)[16]) {
    unsigned s[128];
#pragma unroll
    for (int c8 = 0; c8 < 16; ++c8) { const u32x4 t = *(const u32x4*)(sc + c8 * 1024);
#pragma unroll
        for (int w = 0; w < 4; ++w) { const int e0 = 2 * w, e1 = 2 * w + 1;
            const int col0 = 32 * (c8 >> 2) + 16 * (e0 >> 2) + 4 * (c8 & 3) + (e0 & 3), col1 = 32 * (c8 >> 2) + 16 * (e1 >> 2) + 4 * (c8 & 3) + (e1 & 3);
            s[8 * c8 + e0] = (t[w] << 16) | (unsigned)(127 - col0); s[8 * c8 + e1] = (t[w] & 0xFFFF0000u) | (unsigned)(127 - col1); } }
#pragma unroll
    for (int g = 0; g < 8; ++g) sort16_desc(s, 16 * g);
    merge16_desc(s, 0, 16); merge16_desc(s, 32, 48); merge16_desc(s, 64, 80); merge16_desc(s, 96, 112);
    merge16_desc(s, 0, 32); merge16_desc(s, 64, 96);
    merge16_desc(s, 0, 64);
#pragma unroll
    for (int i = 0; i < 16; ++i) out[i] = s[i];
}
__device__ __forceinline__ void topk_phase(const Params& p, LAS unsigned char* lds) {
    const unsigned char* SC = p.ws + OFF_SC; int* EIDX = (int*)(p.ws + OFF_EIDX); float* GATE = (float*)(p.ws + OFF_GATE);
    LAS unsigned* st = (LAS unsigned*)lds;
    const int tid = threadIdx.x;
#ifndef TOPK_REP
#define TOPK_REP 1
#endif
    for (int rr_ = 0; rr_ < TOPK_REP; ++rr_)
    for (int base = blockIdx.x * 4; base < (T / 64) * 8; base += gridDim.x * 4) {
        {
            const int w = tid >> 6, L = tid & 63, grp = base + (w >> 1), pp = w & 1;
            unsigned ks[16];
#pragma unroll
            for (int i = 0; i < 16; ++i) ks[i] = 0u;
            top16_of_128(SC + ((size_t)(grp * 2 + pp) * 16 * 64 + L) * 16, ks);
#pragma unroll
            for (int i = 0; i < 16; ++i) st[i * NTHREADS + tid] = ks[i];
        }
        __syncthreads();
        if (tid < 256) {
            const int q = tid >> 6, L = tid & 63, grp = base + q, tb = grp >> 3, hh = grp & 7;
            const int th = (tb * 64 + L) * 8 + hh;
            const int s0 = (2 * q) * 64 + L, s1 = (2 * q + 1) * 64 + L;
            float sv1[16];
#pragma unroll
            for (int j = 0; j < 16; ++j) sv1[j] = hkey2f(st[j * NTHREADS + s1]);
            unsigned cv[50];
            { int c = 0;
#pragma unroll
              for (int i = 0; i < 16; ++i) { const float a = hkey2f(st[i * NTHREADS + s0]);
#pragma unroll
                  for (int j = 0; j < 16; ++j) if ((i + 1) * (j + 1) <= 16) { cv[c] = (f2key(a + sv1[j]) & ~255u) | (unsigned)(255 - (i * 16 + j)); ++c; } } }
            unsigned c64[64];
#pragma unroll
            for (int i = 0; i < 64; ++i) c64[i] = (i < 50) ? cv[i] : 0u;
#pragma unroll
            for (int g = 0; g < 4; ++g) sort16_desc(c64, 16 * g);
            merge16_desc(c64, 0, 16); merge16_desc(c64, 32, 48); merge16_desc(c64, 0, 32);
            unsigned ok[16];
#pragma unroll
            for (int i = 0; i < 16; ++i) ok[i] = c64[i];
            float ex[16]; int oe[16]; float den = 0.f;
            const float v0 = key2f(ok[0] & ~255u);
#pragma unroll
            for (int i = 0; i < 16; ++i) { const int ij = 255 - (int)(ok[i] & 255u), ci = ij >> 4, cj = ij & 15;
                const int e0 = 127 - (int)(st[ci * NTHREADS + s0] & 127u), e1 = 127 - (int)(st[cj * NTHREADS + s1] & 127u);
                oe[i] = e0 * 128 + e1; ex[i] = __expf(key2f(ok[i] & ~255u) - v0); den += ex[i]; }
            const float inv = 1.0f / den;
#pragma unroll
            for (int i = 0; i < 4; ++i) {
                *(f32x4*)(GATE + (size_t)th * 16 + 4 * i) = (f32x4){ex[4 * i] * inv, ex[4 * i + 1] * inv, ex[4 * i + 2] * inv, ex[4 * i + 3] * inv};
                *(int4*)(EIDX + (size_t)th * 16 + 4 * i) = make_int4(oe[4 * i], oe[4 * i + 1], oe[4 * i + 2], oe[4 * i + 3]); }
        }
        __syncthreads();
    }
}

struct XcdInfo { int px, npop, rank, nloc; };
__device__ __forceinline__ float dot8(const h16x8 a, const h16x8 b, float s) {
    s = __builtin_amdgcn_fdot2((h16x2){a[0], a[1]}, (h16x2){b[0], b[1]}, s, false); s = __builtin_amdgcn_fdot2((h16x2){a[2], a[3]}, (h16x2){b[2], b[3]}, s, false);
    s = __builtin_amdgcn_fdot2((h16x2){a[4], a[5]}, (h16x2){b[4], b[5]}, s, false); s = __builtin_amdgcn_fdot2((h16x2){a[6], a[7]}, (h16x2){b[6], b[7]}, s, false); return s; }
struct PeerTok { int t; bool ok; };
#define PEER_TOUCH(R) do { unsigned tt_ = (R).w; asm volatile("" : "+v"(tt_)); (R).w = tt_; __builtin_amdgcn_sched_barrier(0); } while (0)
__device__ __forceinline__ PeerTok peer_tok(int i, int t0, int step) { const int t = t0 + i * step; PeerTok r; r.ok = t < T; r.t = r.ok ? t : (T - 1); return r; }
__device__ __forceinline__ void peer_ld_e(const int* EIDX, int t, int g, int (&e)[16]) {
#pragma unroll
    for (int q = 0; q < 4; ++q) { const int4 v = *(const int4*)(EIDX + (size_t)t * 128 + 16 * g + 4 * q); e[4 * q] = v.x; e[4 * q + 1] = v.y; e[4 * q + 2] = v.z; e[4 * q + 3] = v.w; } }
__device__ __forceinline__ void peer_ld_rows(const unsigned char* tab, const int (&e)[16], u32x4 (&r)[16]) {
#pragma unroll
    for (int j = 0; j < 16; ++j) r[j] = *(const u32x4*)(tab + (size_t)e[j] * 128); }
__device__ __forceinline__ void peer_u_compute(const u32x4 (&r)[16], const u32x4 xv, h16* PACT, int s, PeerTok tk, int lane, int g, int c) {
    float pj[16];
#pragma unroll
    for (int j = 0; j < 16; ++j) { int d = __builtin_amdgcn_sdot4((int)r[j].x, (int)xv.x, 0, false); d = __builtin_amdgcn_sdot4((int)r[j].y, (int)xv.y, d, false);
        d = __builtin_amdgcn_sdot4((int)r[j].z, (int)xv.z, d, false); d = __builtin_amdgcn_sdot4((int)r[j].w, (int)xv.w, d, false); pj[j] = (float)d; }
#define RED_STEP(NIN, MASK) _Pragma("unroll") for (int j = 0; j < (NIN) / 2; ++j) { const bool up = (lane & (MASK)) != 0; \
    const float keep = up ? pj[2 * j + 1] : pj[2 * j], send = up ? pj[2 * j] : pj[2 * j + 1]; pj[j] = keep + __shfl_xor(send, (MASK)); }
    RED_STEP(16, 1) RED_STEP(8, 2) RED_STEP(4, 4)
#undef RED_STEP
    { const bool up = (lane & 1) != 0; const float keep = up ? pj[1] : pj[0], send = up ? pj[0] : pj[1], recv = __shfl_xor(send, 1);
      const unsigned w = up ? pk2(recv * 0.015625f, keep * 0.015625f) : pk2(keep * 0.015625f, recv * 0.015625f);
      if (tk.ok) *(unsigned*)(PACT + ((size_t)s * T + tk.t) * 128 + 16 * g + (up ? 7 + c : c)) = w; }
}
__device__ __forceinline__ void peer_u_phase(const Params& p, const XcdInfo xi) {
    const int wave = threadIdx.x >> 6, lane = threadIdx.x & 63, g = lane >> 3, c = lane & 7;
    const unsigned char* QX = (const unsigned char*)(p.ws + OFF_QX); const unsigned char* TU = (const unsigned char*)(p.ws + OFF_TU);
    const int* EIDX = (const int*)(p.ws + OFF_EIDX); h16* PACT = (h16*)(p.ws + OFF_PACT);
    const int t0 = xi.rank * 8 + wave, step = xi.nloc * 8, ntok = (T - t0 + step - 1) / step;
    for (int s = xi.px; s < 8; s += xi.npop) {
        const unsigned char* tus = TU + (size_t)s * 16384 * 128 + 16 * c; const unsigned char* qxs = QX + s * 128 + 16 * c;
        int eN[16]; u32x4 rA[16], rB[16]; u32x4 xA, xB;
        { PeerTok k0 = peer_tok(0, t0, step); peer_ld_e(EIDX, k0.t, g, eN); xA = *(const u32x4*)(qxs + (size_t)k0.t * D); peer_ld_rows(tus, eN, rA);
          PeerTok k1 = peer_tok(1, t0, step); peer_ld_e(EIDX, k1.t, g, eN); }
        for (int i = 0; i < ntok; i += 2) {
            { const PeerTok k1 = peer_tok(i + 1, t0, step), k2 = peer_tok(i + 2, t0, step);
              PEER_TOUCH(rA[15]);
              xB = *(const u32x4*)(qxs + (size_t)k1.t * D); peer_ld_rows(tus, eN, rB); peer_ld_e(EIDX, k2.t, g, eN);
              __builtin_amdgcn_sched_barrier(0);
              peer_u_compute(rA, xA, PACT, s, peer_tok(i, t0, step), lane, g, c);
              __builtin_amdgcn_sched_barrier(0); }
            { const PeerTok k2 = peer_tok(i + 2, t0, step), k3 = peer_tok(i + 3, t0, step);
              PEER_TOUCH(rB[15]);
              xA = *(const u32x4*)(qxs + (size_t)k2.t * D); peer_ld_rows(tus, eN, rA); peer_ld_e(EIDX, k3.t, g, eN);
              __builtin_amdgcn_sched_barrier(0);
              PeerTok k1 = peer_tok(i + 1, t0, step); k1.ok = k1.ok && (i + 1 < ntok);
              peer_u_compute(rB, xB, PACT, s, k1, lane, g, c);
              __builtin_amdgcn_sched_barrier(0); }
        }
    }
}
#ifdef PEER_U_MFMA
#define KIDX kslot
#else
#define KIDX k
#endif
__device__ __forceinline__ void peer_combine(const Params& p) {
    const int wave = threadIdx.x >> 6, lane = threadIdx.x & 63;
    const h16* PACT = (const h16*)(p.ws + OFF_PACT); const float* GATE = (const float*)(p.ws + OFF_GATE); unsigned char* SIDE = p.ws + OFF_SIDE;
    const int* EIDX = (const int*)(p.ws + OFF_EIDX); const float* SU = (const float*)(p.ws + OFF_SU); const float* SV = (const float*)(p.ws + OFF_SV); const float* SX = (const float*)(p.ws + OFF_SX);
    for (int t = blockIdx.x * 8 + wave; t < T; t += gridDim.x * 8) {
        const float sx = SX[t] * 64.0f; float w[2]; float a[2] = {0.f, 0.f}; float amax = 0.f;
#pragma unroll
        for (int s = 0; s < 8; ++s) { const h16x2 v = *(const h16x2*)(PACT + ((size_t)s * T + t) * 128 + 2 * lane); a[0] += (float)v[0]; a[1] += (float)v[1]; }
        const int2 e2 = *(const int2*)(EIDX + (size_t)t * 128 + 2 * lane); const float2 g2 = *(const float2*)(GATE + (size_t)t * 128 + 2 * lane);
        const int e[2] = {e2.x, e2.y}; const float gt[2] = {g2.x, g2.y};
#pragma unroll
        for (int j = 0; j < 2; ++j) {
            const float act = a[j] * sx * SU[e[j]];
            w[j] = gt[j] * (0.5f * act * (1.0f + erff(act * 0.70710678118654752f))) * SV[e[j]];
            amax = fmaxf(amax, fabsf(w[j])); }
#pragma unroll
        for (int o = 32; o >= 1; o >>= 1) amax = fmaxf(amax, __shfl_xor(amax, o));
        const float inv = amax > 0.f ? 16256.0f / amax : 0.f;
        unsigned char* rec = SIDE + (size_t)t * 1024;
        *(int2*)(rec + 8 * lane) = e2;
#pragma unroll
        for (int j = 0; j < 2; ++j) { const int k = 2 * lane + j; const int W = (int)rintf(w[j] * inv); const int hi = W >> 7, lo = W & 127;
            const int y = k >> 4, ks = (k >> 3) & 1, h = (k >> 2) & 1, gk = k & 3, off = 512 + ks * 128 + gk * 16 + 8 * h + y;
            rec[off] = (unsigned char)(hi & 255); rec[off + 64] = (unsigned char)lo; }
        if (lane == 0) *(float*)(rec + 768) = amax * (1.0f / 16256.0f);
    }
}
typedef int i32x4 __attribute__((ext_vector_type(4)));
__device__ __forceinline__ unsigned lds_addr(const volatile LAS void* p) { return (unsigned)(size_t)p; }
__device__ __forceinline__ void glds16_asm(const void* gsrc, unsigned lds_dst) {
    unsigned keep;
    asm volatile("s_mov_b32 %0, m0\n\ts_mov_b32 m0, %2\n\ts_nop 0\n\tglobal_load_lds_dwordx4 %1, off\n\ts_mov_b32 m0, %0" : "=&s"(keep) : "v"(gsrc), "s"(lds_dst) : "memory");
}
#define PV_WAIT_VM(n) asm volatile("s_waitcnt vmcnt(" #n ")" ::: "memory")
__device__ __forceinline__ void pv_fill(const unsigned char* tvs, LAS unsigned char* lds, unsigned side_slot, unsigned ring_buf, const int ks, int lane) {
    const int g = lane >> 3;
    const u32x4 i0 = *(LAS u32x4*)(lds + side_slot + (16 * g + 8 * ks) * 4), i1 = *(LAS u32x4*)(lds + side_slot + (16 * g + 8 * ks + 4) * 4);
    const unsigned ids[8] = {i0.x, i0.y, i0.z, i0.w, i1.x, i1.y, i1.z, i1.w};
#pragma unroll
    for (int m = 0; m < 8; ++m) glds16_asm(tvs + (size_t)ids[m] * 128 + ((((lane & 7) ^ g ^ (m & 1))) << 4), ring_buf + m * 1024);
}
__device__ __forceinline__ void pv_kstep(LAS unsigned char* lds, unsigned ring_buf, const i32x4 afrag, i32x4 (&acc)[8], int lane) {
    const int gk = lane >> 4, q = (lane & 15) >> 1, pp = lane & 1;
    const unsigned base0 = ring_buf + (8 * gk + q) * 128 + 8 * pp;
    const int xr = q ^ (gk & 1);
#pragma unroll
    for (int ng = 0; ng < 2; ++ng) {
        u32x2 r[8];
#pragma unroll
        for (int j = 0; j < 4; ++j) { const int n = 4 * ng + j;
#pragma unroll
            for (int h = 0; h < 2; ++h) { const unsigned a = base0 + h * 4096 + (((unsigned)(n ^ xr)) << 4);
                asm volatile("ds_read_b64_tr_b8 %0, %1" : "=v"(r[2 * j + h]) : "v"(a) : "memory"); } }
        asm volatile("s_waitcnt lgkmcnt(0)" : "+v"(r[0]), "+v"(r[1]), "+v"(r[2]), "+v"(r[3]), "+v"(r[4]), "+v"(r[5]), "+v"(r[6]), "+v"(r[7]) :: "memory");
        __builtin_amdgcn_sched_barrier(0);
#pragma unroll
        for (int j = 0; j < 4; ++j) { const i32x4 bf = (i32x4){(int)r[2 * j].x, (int)r[2 * j].y, (int)r[2 * j + 1].x, (int)r[2 * j + 1].y};
            acc[4 * ng + j] = __builtin_amdgcn_mfma_i32_16x16x64_i8(afrag, bf, acc[4 * ng + j], 0, 0, 0); }
    }
}
__device__ __forceinline__ void peer_v_phase(const Params& p, LAS unsigned char* lds, const XcdInfo xi) {
    const int wave = __builtin_amdgcn_readfirstlane(threadIdx.x >> 6), lane = threadIdx.x & 63;
    const unsigned char* TV = p.ws + OFF_TV; const unsigned char* SIDE = p.ws + OFF_SIDE; h16* PO = (h16*)(p.ws + OFF_PO);
    const int t0 = xi.rank * 8 + wave, step = xi.nloc * 8, ntok = (T - t0 + step - 1) / step;
    const unsigned ring = __builtin_amdgcn_readfirstlane(lds_addr(lds + wave * 16384)), side = __builtin_amdgcn_readfirstlane(lds_addr(lds + 131072 + wave * 3072));
    LAS unsigned char* l0 = (LAS unsigned char*)0;
    for (int s = xi.px; s < 8; s += xi.npop) {
        const unsigned char* tvs = TV + (size_t)s * 16384 * 128;
        glds16_asm(SIDE + (size_t)peer_tok(0, t0, step).t * 1024 + lane * 16, side);
        glds16_asm(SIDE + (size_t)peer_tok(1, t0, step).t * 1024 + lane * 16, side + 1024);
        PV_WAIT_VM(0);
        pv_fill(tvs, l0, side, ring, 0, lane); pv_fill(tvs, l0, side, ring + 8192, 1, lane);
        for (int i = 0; i < ntok; ++i) {
            const unsigned sl_cur = side + (unsigned)(i % 3) * 1024, sl_nxt = side + (unsigned)((i + 1) % 3) * 1024, sl_nn = side + (unsigned)((i + 2) % 3) * 1024;
            i32x4 acc[8];
#pragma unroll
            for (int n = 0; n < 8; ++n) acc[n] = (i32x4){0, 0, 0, 0};
            if (i == 0) PV_WAIT_VM(8); else PV_WAIT_VM(16);
            const int fi = lane & 15;
            const i32x4 z4 = (i32x4){0, 0, 0, 0};
            i32x4 af = *(LAS i32x4*)(l0 + sl_cur + 512 + (fi < 2 ? fi : 0) * 64 + (lane >> 4) * 16); af = fi < 2 ? af : z4;
            pv_kstep(l0, ring, af, acc, lane);
            glds16_asm(SIDE + (size_t)peer_tok(i + 2, t0, step).t * 1024 + lane * 16, sl_nn);
            pv_fill(tvs, l0, sl_nxt, ring, 0, lane);
            PV_WAIT_VM(9);
            af = *(LAS i32x4*)(l0 + sl_cur + 512 + 128 + (fi < 2 ? fi : 0) * 64 + (lane >> 4) * 16); af = fi < 2 ? af : z4;
            pv_kstep(l0, ring + 8192, af, acc, lane);
            const float sw = *(LAS float*)(l0 + sl_cur + 768);
            const PeerTok tk = peer_tok(i, t0, step);
            h16* po = PO + (size_t)(tk.ok ? tk.t : T) * D + s * 128 + (lane & 15);
            if (lane < 16) {
#pragma unroll
                for (int n = 0; n < 8; ++n) { const h16 v = (h16)((float)(128 * acc[n][0] + acc[n][1]) * sw); const unsigned vb = (unsigned)__builtin_bit_cast(unsigned short, v);
                    asm volatile("global_store_short %0, %1, off" :: "v"(po + 16 * n), "v"(vb) : "memory"); }
            }
            pv_fill(tvs, l0, sl_nxt, ring + 8192, 1, lane);
        }
        PV_WAIT_VM(0);
    }
}
__device__ __forceinline__ void pu_buffer(LAS unsigned char* l0, unsigned ring_buf, unsigned side_slot, i32x4 (&acc)[4], int lane) {
    const int i = lane & 15, gk = lane >> 4;
#pragma unroll
    for (int kc = 0; kc < 2; ++kc) {
        i32x4 bx = *(LAS i32x4*)(l0 + side_slot + 512 + 64 * kc + 16 * gk); bx = (i == 0) ? bx : (i32x4){0, 0, 0, 0};
#pragma unroll
        for (int mt = 0; mt < 4; ++mt) { const int r = 16 * mt + i;
            const i32x4 af = *(LAS i32x4*)(l0 + ring_buf + r * 128 + ((((4 * kc + gk) ^ (r & 7) ^ ((r >> 3) & 1))) << 4));
            acc[mt] = __builtin_amdgcn_mfma_i32_16x16x64_i8(af, bx, acc[mt], 0, 0, 0); }
    }
}
__device__ __forceinline__ void peer_u_phase_mfma(const Params& p, LAS unsigned char* lds, const XcdInfo xi) {
    const int wave = __builtin_amdgcn_readfirstlane(threadIdx.x >> 6), lane = threadIdx.x & 63;
    const unsigned char* TU = p.ws + OFF_TU; const unsigned char* QX = p.ws + OFF_QX; const unsigned char* EIDX = p.ws + OFF_EIDX; float* PACT = (float*)(p.ws + OFF_PACT);
    const int t0 = xi.rank * 8 + wave, step = xi.nloc * 8, ntok = (T - t0 + step - 1) / step;
    const unsigned ring = __builtin_amdgcn_readfirstlane(lds_addr(lds + wave * 16384)), side = __builtin_amdgcn_readfirstlane(lds_addr(lds + 131072 + wave * 3072));
    LAS unsigned char* l0 = (LAS unsigned char*)0;
    for (int s = xi.px; s < 8; s += xi.npop) {
        const unsigned char* tus = TU + (size_t)s * 16384 * 128;
#define PU_SIDE(tt, dst) glds16_asm(lane < 32 ? (const void*)(EIDX + (size_t)(tt) * 512 + lane * 16) : (const void*)(QX + (size_t)(tt) * D + s * 128 + ((lane & 7) * 16)), dst)
        PU_SIDE(peer_tok(0, t0, step).t, side);
        PU_SIDE(peer_tok(1, t0, step).t, side + 1024);
        PV_WAIT_VM(0);
        pv_fill(tus, l0, side, ring, 0, lane); pv_fill(tus, l0, side, ring + 8192, 1, lane);
        for (int i = 0; i < ntok; ++i) {
            const unsigned sl_cur = side + (unsigned)(i % 3) * 1024, sl_nxt = side + (unsigned)((i + 1) % 3) * 1024, sl_nn = side + (unsigned)((i + 2) % 3) * 1024;
            i32x4 acc0[4], acc1[4];
#pragma unroll
            for (int n = 0; n < 4; ++n) { acc0[n] = (i32x4){0, 0, 0, 0}; acc1[n] = (i32x4){0, 0, 0, 0}; }
            if (i == 0) PV_WAIT_VM(8); else PV_WAIT_VM(16);
            pu_buffer(l0, ring, sl_cur, acc0, lane);
            PU_SIDE(peer_tok(i + 2, t0, step).t, sl_nn);
            pv_fill(tus, l0, sl_nxt, ring, 0, lane);
            PV_WAIT_VM(9);
            pu_buffer(l0, ring + 8192, sl_cur, acc1, lane);
            const PeerTok tk = peer_tok(i, t0, step);
            float* po = PACT + ((size_t)s * T + (tk.ok ? tk.t : 0)) * 128 + 4 * (lane >> 4);
            if ((lane & 15) == 0) {
#pragma unroll
                for (int mt = 0; mt < 4; ++mt) {
                    const f32x4 v0 = (f32x4){(float)acc0[mt][0], (float)acc0[mt][1], (float)acc0[mt][2], (float)acc0[mt][3]}, v1 = (f32x4){(float)acc1[mt][0], (float)acc1[mt][1], (float)acc1[mt][2], (float)acc1[mt][3]};
                    float* d0 = tk.ok ? po + 16 * mt : (float*)(p.ws + OFF_PO) , *d1 = tk.ok ? po + 64 + 16 * mt : (float*)(p.ws + OFF_PO);
                    asm volatile("global_store_dwordx4 %0, %1, off\n\ts_nop 1" :: "v"(d0), "v"(v0) : "memory");
                    asm volatile("global_store_dwordx4 %0, %1, off\n\ts_nop 1" :: "v"(d1), "v"(v1) : "memory"); }
            }
            pv_fill(tus, l0, sl_nxt, ring + 8192, 1, lane);
        }
        PV_WAIT_VM(0);
#undef PU_SIDE
    }
}
__device__ __forceinline__ void peer_final(const Params& p) {
    const int wave = threadIdx.x >> 6, lane = threadIdx.x & 63;
    float* OUT = p.out; const h16* H16 = (const h16*)(p.ws + OFF_H16); const h16* PO = (const h16*)(p.ws + OFF_PO); const float* mod = (const float*)(p.ws + OFF_MOD); const float* fg = p.in[19];
    for (int t0 = (blockIdx.x * 8 + wave) * 2; t0 < T; t0 += gridDim.x * 16) {
        h16x4 hv[2][4], ph[2][4];
#pragma unroll
        for (int q = 0; q < 2; ++q)
#pragma unroll
            for (int j = 0; j < 4; ++j) { const int cc = j * 256 + lane * 4; hv[q][j] = *(const h16x4*)(H16 + (size_t)(t0 + q) * D + cc); ph[q][j] = *(const h16x4*)(PO + (size_t)(t0 + q) * D + cc); }
#pragma unroll
        for (int q = 0; q < 2; ++q) { const int t = t0 + q;
            f32x4 h2[4]; float ss = 0.f;
#pragma unroll
            for (int j = 0; j < 4; ++j) { const int cc = j * 256 + lane * 4;
                const f32x4 pv = (f32x4){(float)ph[q][j][0], (float)ph[q][j][1], (float)ph[q][j][2], (float)ph[q][j][3]}, gv = *(const f32x4*)(mod + (t >> 12) * 6144 + 5120 + cc);
                h2[j] = (f32x4){(float)hv[q][j][0], (float)hv[q][j][1], (float)hv[q][j][2], (float)hv[q][j][3]} + gv * pv; ss += h2[j].x * h2[j].x + h2[j].y * h2[j].y + h2[j].z * h2[j].z + h2[j].w * h2[j].w; }
            ss = wave_sum(ss);
            const float rstd = rsqrtf(ss * (1.0f / D) + EPS);
#pragma unroll
            for (int j = 0; j < 4; ++j) { const int cc = j * 256 + lane * 4; const f32x4 fv = *(const f32x4*)(fg + cc);
                *(f32x4*)(OUT + (size_t)t * D + cc) = h2[j] * rstd * fv; }
        }
    }
}
#ifndef REP_A
#define REP_A 1
#endif
#ifndef REP_FT
#define REP_FT 1
#endif
#ifndef REP_DFT
#define REP_DFT 1
#endif
#ifndef REP_GATE
#define REP_GATE 1
#endif
#ifndef REP_M2
#define REP_M2 1
#endif
#ifndef REP_M1
#define REP_M1 1
#endif
#ifndef REP_SC
#define REP_SC 1
#endif
constexpr int N_PHASES = 15;
#ifndef MK_CGSYNC
#define MK_CGSYNC 0
#endif
__device__ __forceinline__ Params load_params(volatile LAS unsigned* pw) {
    Params q;
    unsigned long long v[22];
#pragma unroll
    for (int i = 0; i < 22; ++i) { const unsigned lo = (unsigned)__builtin_amdgcn_readfirstlane((int)pw[2 * i]), hi = (unsigned)__builtin_amdgcn_readfirstlane((int)pw[2 * i + 1]); v[i] = ((unsigned long long)hi << 32) | lo; }
#pragma unroll
    for (int i = 0; i < 20; ++i) q.in[i] = (const float*)v[i];
    q.out = (float*)v[20]; q.ws = (unsigned char*)v[21];
    q.ph_lo = __builtin_amdgcn_readfirstlane((int)pw[44]); q.ph_hi = __builtin_amdgcn_readfirstlane((int)pw[45]);
    return q;
}
__global__ void __launch_bounds__(NTHREADS, 2) mega(Params pk) {
    extern __shared__ __attribute__((aligned(16))) unsigned char smem[];
    LAS unsigned char* lds = (LAS unsigned char*)smem;
    const int G = gridDim.x, c = blockIdx.x;
    volatile LAS unsigned* pw = (volatile LAS unsigned*)(lds + LDS_BYTES - 512);
    if (threadIdx.x == 0) {
#pragma unroll
        for (int i = 0; i < 20; ++i) { const unsigned long long v = (unsigned long long)pk.in[i]; pw[2 * i] = (unsigned)v; pw[2 * i + 1] = (unsigned)(v >> 32); }
        { const unsigned long long v = (unsigned long long)pk.out; pw[40] = (unsigned)v; pw[41] = (unsigned)(v >> 32); }
        { const unsigned long long v = (unsigned long long)pk.ws; pw[42] = (unsigned)v; pw[43] = (unsigned)(v >> 32); }
        pw[44] = (unsigned)pk.ph_lo; pw[45] = (unsigned)pk.ph_hi;
    }
    unsigned* ctl = (unsigned*)(pk.ws + OFF_CTL);
    volatile LAS unsigned* misc = (volatile LAS unsigned*)(lds + LDS_BYTES - 64);
    if (threadIdx.x < 16) misc[threadIdx.x] = 0u;
    __syncthreads();
    const bool fused = (pk.ph_hi - pk.ph_lo) > 1;
    XcdBarrier bar; bar.bar = ctl; bar.x = 0; bar.st = misc;
    if (fused) {
        bar = xcd_barrier_post(ctl, misc);
        if (threadIdx.x == 0) misc[2] = xb_add(&ctl[CTL_RANK + 64 * bar.x], 1u);
    }
#define IN(k) (ph_lo <= (k) && (k) < ph_hi)
#if MK_CGSYNC
#define SEAM(k) do { if (IN(k) && IN((k) + 1)) { cg::grid_group grid = cg::this_grid(); grid.sync(); } } while (0)
#else
#define SEAM(k) do { if (IN(k) && IN((k) + 1)) xcd_barrier(bar); } while (0)
#endif
#define PHASE_BEGIN(k) if (IN(k)) { const Params p = load_params(pw); unsigned char* const ws = p.ws; (void)ws;
#define PHASE_END(k) } SEAM(k);
    const int ph_lo = pk.ph_lo, ph_hi = pk.ph_hi;
    PHASE_BEGIN(0) phase0(p, lds); PHASE_END(0)
    PHASE_BEGIN(1)
        const float* mod = (const float*)(ws + OFF_MOD);
        modulate_rows<false>(p.in[0], (h16*)(ws + OFF_UALL), T, p.in[6], mod, 0, 1024, 0, c, G);
        modulate_rows<false>(p.in[2], (h16*)(ws + OFF_UALL) + (size_t)T * D, TC, p.in[6], mod, 0, 1024, 1, c, G);
    PHASE_END(1)
    PHASE_BEGIN(2)
        { pg8::Gemm g{ws + OFF_UALL, ws + OFF_WA, 1024, 1024, 1024}; OrderA S; S.init(G, c, REP_A); EpiA E{ws}; pg8::gemm_phase(lds, g, S, E); }
        { pg8::Gemm g{ws + OFF_UALL, ws + OFF_WF, 1024, 1024, 1024}; pg8::TileOrder S; S.init(128, 4, G, c, REP_FT); EpiFT E{ws}; pg8::gemm_phase(lds, g, S, E); }
        if (G > 96) { if (c >= 48) convert_tables(p, c - 48, G - 48); } else convert_tables(p, c, G);
    PHASE_END(2)
    PHASE_BEGIN(3) for (int it = blockIdx.x; it < 192; it += gridDim.x) hgrn_mfma_unit<false>(p, lds, it / 3, it % 3);
        fft1_phase(p, lds); PHASE_END(3)
    PHASE_BEGIN(4) for (int it = blockIdx.x; it < 256; it += gridDim.x) hgrn_mfma_unit<true>(p, lds, it >> 2, it & 3); PHASE_END(4)
    PHASE_BEGIN(5)
        const bool mem_first = ((c >> 3) & 1) == 0;
        if (mem_first) a1_prepass(p);
        { pg8::Gemm g{ws + OFF_DFT256, ws + OFF_Y1, 512, 512, 512}; pg8::TileOrder S; S.init(1, 256, G, c, REP_DFT); EpiDFT E{ws}; pg8::gemm_phase(lds, g, S, E); }
        { pg8::Gemm g{ws + OFF_UALL, ws + OFF_WG, 1024, 1024, 1024}; pg8::TileOrder S; S.init(128, 8, G, c, REP_GATE); EpiGate E{ws}; pg8::gemm_phase(lds, g, S, E); }
        if (!mem_first) a1_prepass(p);
    PHASE_END(5)
    PHASE_BEGIN(6)
        if (G >= 16 && (G & 15) == 0) { if ((c >> 3) & 1) scale_wout(p, ((c >> 4) << 3) | (c & 7), G >> 1); } else scale_wout(p, c, G);
        { pg8::Gemm g{ws + OFF_G, ws + OFF_WHG, 512, 512, 512}; pg8::TileOrder S; S.init(128, 4, G, c, REP_M1); EpiMerge1<false> E{ws}; pg8::gemm_phase(lds, g, S, E); }
        { pg8::Gemm g{ws + OFF_YFT, ws + OFF_WFT, 512, 512, 512}; pg8::TileOrder S; S.init(128, 4, G, c); EpiMerge1<true> E{ws}; pg8::gemm_phase(lds, g, S, E); }
    PHASE_END(6)
    PHASE_BEGIN(7)
        pg8::Gemm g{ws + OFF_Y, ws + OFF_WOUTG, 1024, 1024, 1024}; pg8::TileOrder S; S.init(128, 4, G, c, REP_M2);
        EpiMerge2 E; E.x = p.in[0]; E.H = (h16*)(ws + OFF_H16); pg8::gemm_phase(lds, g, S, E);
    PHASE_END(7)
    PHASE_BEGIN(8) modulate_rows<true>(ws + OFF_H16, (h16*)(ws + OFF_U2), T, p.in[7], (const float*)(ws + OFF_MOD), 3072, 4096, 0, c, G, (signed char*)(ws + OFF_QX), (float*)(ws + OFF_SX)); PHASE_END(8)
    PHASE_BEGIN(9)
        pg8::Gemm g{ws + OFF_U2, ws + OFF_WS, 1024, 1024, 1024}; pg8::TileOrder S; S.init(128, 8, G, c, REP_SC);
#ifdef STAGGER_US
        if (c & 8) { const unsigned long long t0_ = __builtin_amdgcn_s_memrealtime(); while (__builtin_amdgcn_s_memrealtime() - t0_ < (unsigned long long)(STAGGER_US * 100)) __builtin_amdgcn_s_sleep(8); }
#endif
        EpiScores E; E.C = ws + OFF_SC; pg8::gemm_phase(lds, g, S, E);
    PHASE_END(9)
    PHASE_BEGIN(10) topk_phase(p, lds); PHASE_END(10)
    XcdInfo xi;
    if (fused) {
        unsigned cnt[8]; int npop = 0, px = 0;
#pragma unroll
        for (int j = 0; j < 8; ++j) { cnt[j] = xb_ld(&ctl[CTL_RANK + 64 * j]); if (j < (int)(bar.x & 7u)) px += (cnt[j] > 0u); npop += (cnt[j] > 0u); }
        xi.px = px; xi.npop = npop > 0 ? npop : 1; xi.rank = (int)misc[2]; xi.nloc = (int)cnt[bar.x & 7u]; if (xi.nloc < 1) xi.nloc = 1;
    } else { xi.px = c & 7; xi.npop = 8; xi.rank = c >> 3; xi.nloc = G >> 3; }
    #ifdef PEER_U_MFMA
    PHASE_BEGIN(11) peer_u_phase_mfma(p, lds, xi); PHASE_END(11)
#else
    PHASE_BEGIN(11) peer_u_phase(p, xi); PHASE_END(11)
#endif
    PHASE_BEGIN(12) peer_combine(p); PHASE_END(12)
    PHASE_BEGIN(13) peer_v_phase(p, lds, xi); PHASE_END(13)
    PHASE_BEGIN(14) peer_final(p); }
#undef IN
#undef SEAM
#undef PHASE_BEGIN
#undef PHASE_END
}

#ifndef MK_SINGLE
#define MK_SINGLE 1
#endif
extern "C" void kernel_launch(void* const* d_in, const int* in_sizes, int n_in, void* d_out, int out_size, void* d_ws, size_t ws_size, hipStream_t stream) {
    static int grid = 0;
    if (grid == 0) {
        if (n_in != 20 || out_size != T * D || ws_size < WS_NEED) { fprintf(stderr, "kernel_launch: unexpected shapes (n_in %d out %d ws %zu)\n", n_in, out_size, ws_size); grid = -1; return; }
        int dev = 0, cus = 0, per_cu = 0;
        hipGetDevice(&dev); hipDeviceGetAttribute(&cus, hipDeviceAttributeMultiprocessorCount, dev);
        if (hipFuncSetAttribute((const void*)mega, hipFuncAttributeMaxDynamicSharedMemorySize, LDS_BYTES) != hipSuccess) { fprintf(stderr, "kernel_launch: hipFuncSetAttribute failed\n"); grid = -1; return; }
        hipOccupancyMaxActiveBlocksPerMultiprocessor(&per_cu, (const void*)mega, NTHREADS, LDS_BYTES);
        if (per_cu < 1) { fprintf(stderr, "kernel_launch: occupancy query says %d blocks per CU\n", per_cu); grid = -1; return; }
        grid = cus;
    }
    if (grid < 0) return;
    if (hipMemsetAsync((char*)d_ws + OFF_CTL, 0, CTL_ZERO_BYTES, stream) != hipSuccess) { fprintf(stderr, "kernel_launch: memset failed\n"); return; }
    Params p{};
    for (int i = 0; i < 20; ++i) p.in[i] = (const float*)d_in[i];
    p.out = (float*)d_out; p.ws = (unsigned char*)d_ws;
#if MK_SINGLE
    p.ph_lo = 0; p.ph_hi = N_PHASES;
    void* args[] = {&p};
    hipError_t e = hipLaunchCooperativeKernel((const void*)mega, dim3(grid), dim3(NTHREADS), args, LDS_BYTES, stream);
    if (e != hipSuccess) fprintf(stderr, "cooperative launch failed: %s (grid %d)\n", hipGetErrorString(e), grid);
#else
    for (int ph = 0; ph < N_PHASES; ++ph) { p.ph_lo = ph; p.ph_hi = ph + 1; hipLaunchKernelGGL(mega, dim3(grid), dim3(NTHREADS), LDS_BYTES, stream, p); }
#endif
}
```

```cpp
#include <hip/hip_runtime.h>
#include <hip/hip_cooperative_groups.h>
#include <cstdio>
#include <cstdint>
namespace cg = cooperative_groups;
#define LAS __attribute__((address_space(3)))
namespace pg8 {
#define PG8_LAS __attribute__((address_space(3)))
typedef _Float16 f16x8 __attribute__((ext_vector_type(8)));
typedef float f32x4 __attribute__((ext_vector_type(4)));
typedef unsigned u32x4 __attribute__((ext_vector_type(4)));
typedef unsigned u32x2 __attribute__((ext_vector_type(2)));
constexpr int BM = 256, BK = 64, HALF = 128, HTB = HALF * BK * 2, STAGE_BYTES = 8 * HTB, NXCD = 8, WGM = 8;

__host__ __device__ __forceinline__ int lds_byte(int r, int c) { const int st = (r >> 4) * 2 + (c >> 5), rr = r & 15, cc = c & 31, ob = rr * 64 + cc * 2; return st * 1024 + (ob ^ (((ob >> 9) & 1) << 5)); }
__host__ __device__ __forceinline__ void stage_rc(int b, int& R, int& C) { const int st = b / 1024, sb = b % 1024, swz = sb ^ (((sb >> 9) & 1) << 5); R = (st >> 1) * 16 + swz / 64; C = (st & 1) * 32 + (swz % 64) / 2; }
__host__ __device__ __forceinline__ int perm32(int rho) { const int n = rho >> 4, i = rho & 15; return 8 * (i >> 2) + 4 * n + (i & 3); }

struct Unit { int pm, pn; };
struct Gemm { const void* A; const void* Bt; int lda, ldb, K; };

struct TileOrder {
    int nM, nN, nwg, G, c, rep;
    __device__ void init(int nM_, int nN_, int G_, int c_, int rep_ = 1) { nM = nM_; nN = nN_; nwg = nM * nN; G = G_; c = c_; rep = rep_; }
    __device__ bool map(long L, Unit& u) const {
        if (L >= nwg) return false;
        int wgid = (int)L; { const int q = nwg / NXCD, r = nwg % NXCD, xcd = wgid % NXCD, off = wgid / NXCD; wgid = (xcd < r ? xcd * (q + 1) : r * (q + 1) + (xcd - r) * q) + off; }
        const int nig = WGM * nN, gid = wgid / nig, fm = gid * WGM, gsz = (nM - fm) < WGM ? (nM - fm) : WGM;
        u.pm = fm + ((wgid % nig) % gsz); u.pn = (wgid % nig) / gsz; return true;
    }
    __device__ bool next(int i, Unit& u) const { const long L = (long)i * G + c; if (L >= (long)nwg * rep) return false; return map(L % nwg, u); }
};

template <class Epi, class Sched>
__device__ __forceinline__ void gemm_phase(PG8_LAS unsigned char* lds, const Gemm g, const Sched& S, const Epi& E) {
    const int tid = threadIdx.x, wid = __builtin_amdgcn_readfirstlane(tid >> 6), lane = tid & 63, wr = wid >> 2, wc = wid & 3, fr = lane & 15, fq = lane >> 4;
    const int K = g.K, nt = K / BK;
    unsigned voffA[2], voffB[2];
#pragma unroll
    for (int i = 0; i < 2; ++i) { int R, C; stage_rc(tid * 16 + i * 8192, R, C); const int Rb = Epi::PERM ? ((R & ~31) + perm32(R & 31)) : R;
        voffA[i] = (unsigned)(R * g.lda + C) * 2u; voffB[i] = (unsigned)(Rb * g.ldb + C) * 2u; }
    const size_t kstep = (size_t)(BK * 2);
    const size_t hstepA = (size_t)HALF * g.lda * 2, hstepB = (size_t)HALF * g.ldb * 2;
    const size_t tstepA = 2 * hstepA, tstepB = 2 * hstepB;
    const unsigned ldsw = (unsigned)wid * 1024u;
    const int aoff = lds_byte(wr * 64 + fr, fq * 8), boff = lds_byte(wc * 32 + fr, fq * 8);
#define PG8_SA(b, h) (((b) * 2 + (h)) * HTB)
#define PG8_SB(b, h) ((4 + (b) * 2 + (h)) * HTB)
#define PG8_STAGE(bufoff, gbase, voff) do { _Pragma("unroll") for (int _i = 0; _i < 2; ++_i) \
        __builtin_amdgcn_global_load_lds((const unsigned*)((const char*)(gbase) + (voff)[_i]), (PG8_LAS unsigned*)(lds + (bufoff) + ldsw + _i * 8192), 16, 0, 0); } while (0)
#define PG8_LDA(dst, b, h) do { _Pragma("unroll") for (int m = 0; m < 4; ++m) _Pragma("unroll") for (int k = 0; k < 2; ++k) dst[m][k] = *(const PG8_LAS f16x8*)(lds + PG8_SA(b, h) + aoff + m * 2048 + k * 1024); } while (0)
#define PG8_LDB(dst, b, h) do { _Pragma("unroll") for (int n = 0; n < 2; ++n) _Pragma("unroll") for (int k = 0; k < 2; ++k) dst[n][k] = *(const PG8_LAS f16x8*)(lds + PG8_SB(b, h) + boff + n * 2048 + k * 1024); } while (0)
#define PG8_MMA(ai, bj, At, Bt) do { __builtin_amdgcn_s_setprio(1); _Pragma("unroll") for (int m = 0; m < 4; ++m) _Pragma("unroll") for (int n = 0; n < 2; ++n) _Pragma("unroll") for (int k = 0; k < 2; ++k) \
        acc[ai][bj][m][n] = Epi::TRANS ? __builtin_amdgcn_mfma_f32_16x16x32_f16(Bt[n][k], At[m][k], acc[ai][bj][m][n], 0, 0, 0) \
                                       : __builtin_amdgcn_mfma_f32_16x16x32_f16(At[m][k], Bt[n][k], acc[ai][bj][m][n], 0, 0, 0); __builtin_amdgcn_s_setprio(0); } while (0)
#define PG8_WAIT_V(n) asm volatile("s_waitcnt vmcnt(" #n ")" ::: "memory")
#define PG8_WAIT_L(n) asm volatile("s_waitcnt lgkmcnt(" #n ")" ::: "memory")
#define PG8_WAIT_VN(n) asm volatile("s_waitcnt vmcnt(%0)" :: "n"(n) : "memory")
#define PG8_BAR __builtin_amdgcn_s_barrier()
#define PG8_SCHED __builtin_amdgcn_sched_barrier(0)
    Unit cur, nxt; int ui = 0;
    if (!S.next(0, cur)) return;
    f32x4 acc[2][2][4][2];
#pragma unroll
    for (int a = 0; a < 2; ++a)
#pragma unroll
        for (int b = 0; b < 2; ++b)
#pragma unroll
            for (int m = 0; m < 4; ++m)
#pragma unroll
                for (int n = 0; n < 2; ++n) acc[a][b][m][n] = (f32x4){0.f, 0.f, 0.f, 0.f};
    f16x8 At[4][2], B0[2][2], B1[2][2];
    const char* cA = (const char*)g.A + (size_t)cur.pm * tstepA; const char* cB = (const char*)g.Bt + (size_t)cur.pn * tstepB + E.boff(cur);
    E.init(acc, cur, wr, wc, fr, fq);
    PG8_STAGE(PG8_SB(0, 0), cB, voffB); PG8_STAGE(PG8_SA(0, 0), cA, voffA); PG8_STAGE(PG8_SB(0, 1), cB + hstepB, voffB); PG8_STAGE(PG8_SA(0, 1), cA + hstepA, voffA);
    if (wr == 1) PG8_BAR;
    PG8_WAIT_V(4); PG8_BAR;
    PG8_STAGE(PG8_SB(1, 0), cB + kstep, voffB); PG8_STAGE(PG8_SA(1, 0), cA + kstep, voffA); PG8_STAGE(PG8_SB(1, 1), cB + hstepB + kstep, voffB); PG8_STAGE(PG8_SA(1, 1), cA + hstepA + kstep, voffA);
    PG8_WAIT_V(8); PG8_BAR;
    for (;;) {
        const bool has_next = S.next(ui + 1, nxt);
        const char* nA = has_next ? (const char*)g.A + (size_t)nxt.pm * tstepA : cA; const char* nB = has_next ? (const char*)g.Bt + (size_t)nxt.pn * tstepB + E.boff(nxt) : cB;
        for (int t = 0; t < nt; t += 2) {
            const bool last = (t == nt - 2);
            const char* a2 = last ? nA : cA + (size_t)(t + 2) * kstep; const char* b2 = last ? nB : cB + (size_t)(t + 2) * kstep;
            const char* a3 = a2 + kstep; const char* b3 = b2 + kstep;
            PG8_LDB(B0, 0, 0); PG8_SCHED; PG8_LDA(At, 0, 0);
            PG8_WAIT_L(8); PG8_BAR; PG8_WAIT_L(0); PG8_MMA(0, 0, At, B0); PG8_BAR; PG8_SCHED;
            PG8_LDB(B1, 0, 1); PG8_STAGE(PG8_SB(0, 0), b2, voffB);
            PG8_BAR; PG8_WAIT_L(0); PG8_MMA(0, 1, At, B1); PG8_BAR;
            PG8_LDA(At, 0, 1); PG8_STAGE(PG8_SA(0, 0), a2, voffA);
            PG8_BAR; PG8_WAIT_L(0); PG8_MMA(1, 0, At, B0); PG8_BAR; PG8_SCHED;
            PG8_STAGE(PG8_SB(0, 1), b2 + hstepB, voffB);
            { const int lax_ = __builtin_amdgcn_readfirstlane((int)((t == 0) & (ui != 0)));
              asm volatile("s_cmp_eq_u32 %0, 0\n\ts_cbranch_scc1 1f\n\ts_waitcnt vmcnt(%1)\n\ts_branch 2f\n1:\n\ts_waitcnt vmcnt(6)\n2:" :: "s"(lax_), "n"(6 + Epi::NST) : "memory", "scc"); }
            PG8_BAR; PG8_MMA(1, 1, At, B1); PG8_BAR;
            PG8_LDB(B0, 1, 0); PG8_SCHED; PG8_LDA(At, 1, 0); PG8_STAGE(PG8_SA(0, 1), a2 + hstepA, voffA);
            PG8_WAIT_L(8); PG8_BAR; PG8_WAIT_L(0); PG8_MMA(0, 0, At, B0); PG8_BAR; PG8_SCHED;
            PG8_LDB(B1, 1, 1); PG8_STAGE(PG8_SB(1, 0), b3, voffB);
            PG8_BAR; PG8_WAIT_L(0); PG8_MMA(0, 1, At, B1); PG8_BAR;
            PG8_LDA(At, 1, 1); PG8_STAGE(PG8_SA(1, 0), a3, voffA);
            PG8_BAR; PG8_WAIT_L(0); PG8_MMA(1, 0, At, B0); PG8_BAR; PG8_SCHED;
            PG8_STAGE(PG8_SB(1, 1), b3 + hstepB, voffB);
            PG8_WAIT_V(6); PG8_BAR; PG8_MMA(1, 1, At, B1); PG8_BAR;
            PG8_STAGE(PG8_SA(1, 1), a3 + hstepA, voffA);
        }
        if constexpr (Epi::FUSED) {
            E.fused(acc, cur, nxt, has_next, wr, wc, fr, fq);
            if (!has_next) break;
            cur = nxt; cA = nA; cB = nB; ++ui;
        } else {
            E(acc, cur, wr, wc, fr, fq);
            if (!has_next) break;
#pragma unroll
            for (int a = 0; a < 2; ++a)
#pragma unroll
                for (int b = 0; b < 2; ++b)
#pragma unroll
                    for (int m = 0; m < 4; ++m)
#pragma unroll
                        for (int n = 0; n < 2; ++n) acc[a][b][m][n] = (f32x4){0.f, 0.f, 0.f, 0.f};
            cur = nxt; cA = nA; cB = nB; ++ui;
            E.init(acc, cur, wr, wc, fr, fq);
        }
    }
    PG8_WAIT_V(0);
    if (wr == 0) PG8_BAR;
    PG8_BAR;
#undef PG8_SA
#undef PG8_SB
#undef PG8_STAGE
#undef PG8_LDA
#undef PG8_LDB
#undef PG8_MMA
#undef PG8_WAIT_V
#undef PG8_WAIT_VN
#undef PG8_WAIT_L
#undef PG8_BAR
#undef PG8_SCHED
}
}
#define XB_TMO      128
#define XB_XCNT(j)  (256  + 64 * (j))
#define XB_XSUB(j)  (1280 + 64 * (j))
#define XB_XGEN(j)  (2304 + 64 * (j))
#define XB_TOP      3328
#define XB_TOPGEN   3392
#define XCD_BAR_WORDS 3456
#define XB_SPIN_CAP (1u << 20)


__device__ __forceinline__ unsigned xb_ld(unsigned* p)              { return __hip_atomic_load(p, __ATOMIC_RELAXED, __HIP_MEMORY_SCOPE_AGENT); }
__device__ __forceinline__ unsigned xb_add(unsigned* p, unsigned v) { return __hip_atomic_fetch_add(p, v, __ATOMIC_RELAXED, __HIP_MEMORY_SCOPE_AGENT); }
__device__ __forceinline__ unsigned xb_xcc_id() { return (unsigned)__builtin_amdgcn_s_getreg((3 << 11) | 20) & 0xFu; }
#define XB_SPIN(cond, bar) do { unsigned _sp = 0; while (cond) { __builtin_amdgcn_s_sleep(1); \
    if ((++_sp & 255u) == 0u) { if (xb_ld(&(bar)[XB_TMO])) break; if (_sp > XB_SPIN_CAP) { atomicAdd(&(bar)[XB_TMO], 1u); break; } } } } while (0)

struct XcdBarrier {
    unsigned* bar; unsigned x;
    volatile LAS unsigned* st;
};

__device__ __forceinline__ XcdBarrier xcd_barrier_post(unsigned* bar, volatile LAS unsigned* st) {
    XcdBarrier b; b.bar = bar; b.x = xb_xcc_id(); b.st = st;
    if (threadIdx.x == 0) (void)xb_add(&bar[XB_XCNT(b.x)], 1u);
    return b;
}
__device__ __forceinline__ void xcd_barrier_complete(unsigned* bar, unsigned x, unsigned& nloc, unsigned& nx) {
    const unsigned G = gridDim.x * gridDim.y * gridDim.z;
    unsigned sum, cnt, mine, sp = 0u;
    for (;;) {
        sum = 0u; cnt = 0u; mine = 0u;
#pragma unroll
        for (unsigned j = 0; j < 16; ++j) { const unsigned c = xb_ld(&bar[XB_XCNT(j)]); sum += c; cnt += (c > 0u) ? 1u : 0u; mine = (j == x) ? c : mine; }
        if (sum == G) break;
        __builtin_amdgcn_s_sleep(1);
        if ((++sp & 255u) == 0u) { if (xb_ld(&bar[XB_TMO])) break; if (sp > XB_SPIN_CAP) { atomicAdd(&bar[XB_TMO], 1u); break; } }
    }
    nloc = mine > 0u ? mine : 1u; nx = cnt > 0u ? cnt : 1u;
}

__device__ __forceinline__ void xcd_barrier(const XcdBarrier& b) {
    asm volatile("s_waitcnt vmcnt(0)" ::: "memory");
    __syncthreads();
    if (threadIdx.x == 0) {
        unsigned* bar = b.bar;
        __builtin_amdgcn_s_waitcnt(0);
        unsigned nloc = b.st[0], nx = b.st[1];
        if (nloc == 0u) { xcd_barrier_complete(bar, b.x, nloc, nx); b.st[0] = nloc; b.st[1] = nx; }
        const unsigned old = xb_add(&bar[XB_XSUB(b.x)], 1u);
        const unsigned gen = old / nloc;
        if (old + 1u == (gen + 1u) * nloc) {
            __builtin_amdgcn_fence(__ATOMIC_RELEASE, "agent");
            asm volatile("s_waitcnt vmcnt(0)" ::: "memory");
            const unsigned og = xb_add(&bar[XB_TOP], 1u);
            const unsigned tg = og / nx;
            if (og + 1u == (tg + 1u) * nx) xb_add(&bar[XB_TOPGEN], 1u);
            else XB_SPIN(xb_ld(&bar[XB_TOPGEN]) == tg, bar);
            __builtin_amdgcn_fence(__ATOMIC_ACQUIRE, "agent");
            xb_add(&bar[XB_XGEN(b.x)], 1u);
            asm volatile("s_waitcnt vmcnt(0)" ::: "memory");
        } else {
            XB_SPIN(xb_ld(&bar[XB_XGEN(b.x)]) == gen, bar);
            __builtin_amdgcn_fence(__ATOMIC_ACQUIRE, "agent");
            asm volatile("s_waitcnt vmcnt(0)" ::: "memory");
        }
    }
    __syncthreads();
}

typedef _Float16 h16;
typedef h16 h16x2 __attribute__((ext_vector_type(2)));
typedef h16 h16x4 __attribute__((ext_vector_type(4)));
typedef h16 h16x8 __attribute__((ext_vector_type(8)));
typedef float f32x4 __attribute__((ext_vector_type(4)));
typedef float f32x2 __attribute__((ext_vector_type(2)));
typedef unsigned u32x4 __attribute__((ext_vector_type(4)));
typedef unsigned u32x2 __attribute__((ext_vector_type(2)));

constexpr int D = 1024, NB = 8, SEQ = 4096, T = NB * SEQ, LC = 256, TC = NB * LC, TALL = T + TC;
constexpr int NTHREADS = 512;
constexpr int LDS_BYTES = 156 * 1024;
constexpr float EPS = 1e-6f;
constexpr size_t MiB = (size_t)1 << 20;
constexpr size_t OFF_CTL = 0;
constexpr size_t OFF_MOD = 64 * 1024;
constexpr size_t OFF_LB = 320 * 1024;
constexpr size_t OFF_WA = 1 * MiB;
constexpr size_t OFF_WG = 6 * MiB;
constexpr size_t OFF_WF = 10 * MiB;
constexpr size_t OFF_WHG = 12 * MiB;
constexpr size_t OFF_WFT = 13 * MiB;
constexpr size_t OFF_WOUT = 14 * MiB;
constexpr size_t OFF_WS = 16 * MiB;
constexpr size_t OFF_UALL = 20 * MiB;
constexpr size_t OFF_OF = 88 * MiB;
constexpr size_t OFF_OB = 120 * MiB;
constexpr size_t OFF_FTT = 152 * MiB;
constexpr size_t OFF_Q = 216 * MiB;
constexpr size_t OFF_LF = 248 * MiB;
constexpr size_t OFF_LBK = 282 * MiB;
constexpr size_t OFF_V = 316 * MiB;
constexpr size_t OFF_G = 350 * MiB;
constexpr size_t OFF_WOUTG = 20 * MiB;
constexpr size_t OFF_Y1 = 382 * MiB;
constexpr size_t OFF_DFT256 = 512 * 1024;
constexpr size_t OFF_YFT = 446 * MiB;
constexpr size_t OFF_USTATE = 446 * MiB;
constexpr size_t OFF_DLOG = 460 * MiB;
constexpr size_t WS_NEED = 510 * MiB;
constexpr size_t OFF_GH = 216 * MiB;
constexpr size_t OFF_Y = 152 * MiB;
constexpr size_t OFF_H16 = 382 * MiB;
constexpr size_t OFF_U2 = 20 * MiB;
constexpr size_t OFF_TU = 478 * MiB;
constexpr size_t OFF_TV = 494 * MiB;
constexpr size_t OFF_QX = 120 * MiB;
constexpr size_t OFF_SU = 768 * 1024;
constexpr size_t OFF_SV = 832 * 1024;
constexpr size_t OFF_SX = 205 * MiB;
constexpr size_t OFF_SC = 216 * MiB;
constexpr size_t OFF_EIDX = 152 * MiB;
constexpr size_t OFF_GATE = 168 * MiB;
constexpr size_t OFF_W = 184 * MiB;
constexpr size_t OFF_PSS = 200 * MiB;
constexpr size_t OFF_PACT = 216 * MiB;
constexpr size_t OFF_PO = 216 * MiB;
constexpr size_t OFF_SIDE = 88 * MiB;
constexpr int CTL_RANK = 4096;
constexpr size_t CTL_ZERO_BYTES = 32 * 1024;

struct Params { const float* in[20]; float* out; unsigned char* ws; int ph_lo, ph_hi; };

__device__ __forceinline__ unsigned pk2(float a, float b) { h16x2 v = {(h16)a, (h16)b}; return __builtin_bit_cast(unsigned, v); }
#define GAS __attribute__((address_space(1)))
__device__ __forceinline__ void gst4(void* p, u32x4 v) { *(GAS u32x4*)p = v; }
__device__ __forceinline__ void gst2(void* p, u32x2 v) { *(GAS u32x2*)p = v; }
__device__ __forceinline__ float wave_sum(float v) {
#pragma unroll
    for (int o = 32; o >= 1; o >>= 1) v += __shfl_xor(v, o);
    return v; }
__device__ __forceinline__ float sigmoidf_(float z) { return __builtin_amdgcn_rcpf(1.0f + __expf(-z)); }

constexpr int N_MOD = 192, N_LB = 1, N_TRA = 160, N_TRG = 128, N_TRHG = 32, N_TRFT = 32, N_TROUT = 64, N_WF = 128, N_WSF = 256, N_DFT = 1;
constexpr int P0_TOTAL = N_MOD + N_LB + N_TRA + N_TRG + N_TRHG + N_TRFT + N_TROUT + N_WF + N_WSF + N_DFT;

__device__ __forceinline__ void p0_mod(const Params& p, LAS float* sm, int idx) {
    const int tid = threadIdx.x;
    for (int i = tid; i < 9 * 1024; i += NTHREADS) { const int r = i >> 10, k = i & 1023; const float c = (r < 8) ? p.in[1][r * 1024 + k] : p.in[3][k]; sm[i] = c / (1.0f + __expf(-c)); }
    __syncthreads();
    const int col = tid & 31, ks = tid >> 5;
    float acc[9];
#pragma unroll
    for (int r = 0; r < 9; ++r) acc[r] = 0.f;
    const float* w = p.in[4] + (size_t)(ks * 64) * 6144 + idx * 32 + col;
    float wv[64];
#pragma unroll
    for (int k = 0; k < 64; ++k) wv[k] = w[(size_t)k * 6144];
#pragma unroll
    for (int k = 0; k < 64; ++k) {
#pragma unroll
        for (int r = 0; r < 9; ++r) acc[r] += sm[r * 1024 + ks * 64 + k] * wv[k]; }
    LAS float* red = sm + 9 * 1024;
#pragma unroll
    for (int r = 0; r < 9; ++r) red[(ks * 9 + r) * 32 + col] = acc[r];
    __syncthreads();
    float* mod = (float*)(p.ws + OFF_MOD);
    if (tid < 288) { const int r = tid >> 5, c = tid & 31; float s = 0.f;
#pragma unroll
        for (int q = 0; q < 16; ++q) s += red[(q * 9 + r) * 32 + c];
        mod[r * 6144 + idx * 32 + c] = s + p.in[5][idx * 32 + c]; }
    __syncthreads();
}
__device__ __forceinline__ void p0_lb(const Params& p) {
    const int tid = threadIdx.x; float* lb = (float*)(p.ws + OFF_LB);
    if (tid < 512) { lb[tid] = 1.0f / (1.0f + expf(p.in[9][512 + tid] - p.in[9][tid])); lb[512 + tid] = 1.0f / (1.0f + expf(p.in[10][512 + tid] - p.in[10][tid])); }
}
__device__ __forceinline__ void p0_transpose(const float* src, int ld_src, int ncol0, h16* dst, int ld_dst, int nktiles, int item, LAS float* sm) {
    const int tid = threadIdx.x, kt = item % nktiles, nt = item / nktiles;
    { const int n4 = tid & 63, kk = tid >> 6;
#pragma unroll
      for (int ps = 0; ps < 8; ++ps) { const int k = kk + 8 * ps; const f32x4 v = *(const f32x4*)(src + (size_t)(kt * 64 + k) * ld_src + ncol0 + nt * 256 + 4 * n4);
          sm[k * 257 + 4 * n4] = v.x; sm[k * 257 + 4 * n4 + 1] = v.y; sm[k * 257 + 4 * n4 + 2] = v.z; sm[k * 257 + 4 * n4 + 3] = v.w; } }
    __syncthreads();
#pragma unroll
    for (int ps = 0; ps < 4; ++ps) { const int idx = tid + NTHREADS * ps, n = idx >> 3, k8 = (idx & 7) * 8;
        float v[8];
#pragma unroll
        for (int j = 0; j < 8; ++j) v[j] = sm[(k8 + j) * 257 + n];
        u32x4 w; w.x = pk2(v[0], v[1]); w.y = pk2(v[2], v[3]); w.z = pk2(v[4], v[5]); w.w = pk2(v[6], v[7]);
        *(u32x4*)(dst + (size_t)(nt * 256 + n) * ld_dst + kt * 64 + k8) = w; }
    __syncthreads();
}
__device__ __forceinline__ void p0_wf(const Params& p, LAS float* sm, int item) {
    const int tid = threadIdx.x, dt = item & 15, part = (item >> 4) & 1, g = item >> 5, d0 = dt * 64;
    LAS float* w = sm; LAS float* TT = sm + 8256; LAS float* trig = sm + 8256 + 16384;
    if (tid < 128) trig[tid] = part ? sinpif((float)tid / 64.0f) : cospif((float)tid / 64.0f);
    for (int i = tid; i < 64 * 128; i += NTHREADS) { const int dl = i >> 7, n2 = i & 127; w[dl * 129 + n2] = p.in[8][(size_t)(d0 + dl) * 5120 + 2560 + g * 128 + n2]; }
    __syncthreads();
    for (int i = tid; i < 128 * 128; i += NTHREADS) { const int n2 = i >> 7, k2 = i & 127; TT[i] = trig[(k2 * n2) & 127]; }
    __syncthreads();
    const int dl = tid & 63, kg = tid >> 6; h16* WF = (h16*)(p.ws + OFF_WF);
    float s[16];
#pragma unroll
    for (int j = 0; j < 16; ++j) s[j] = 0.f;
#pragma unroll 2
    for (int n2 = 0; n2 < 128; ++n2) { const float wv = w[dl * 129 + n2];
#pragma unroll
        for (int q = 0; q < 4; ++q) { const f32x4 tv = *(LAS f32x4*)(TT + n2 * 128 + kg * 16 + 4 * q);
#pragma unroll
            for (int j = 0; j < 4; ++j) s[4 * q + j] += wv * tv[j]; } }
#pragma unroll
    for (int j = 0; j < 16; ++j) WF[(size_t)(part * 512 + g * 128 + kg * 16 + j) * 1024 + d0 + dl] = (h16)(s[j] * 0.08838834764831845f);
    __syncthreads();
}
__device__ __forceinline__ void p0_wsf(const Params& p, LAS float* sm, int item) {
    const int tid = threadIdx.x, dt = item & 15, hp = item >> 4, d0 = dt * 64;
    LAS float* wq = sm; LAS float* skT = sm + 8256;
    for (int i = tid; i < 64 * 128; i += NTHREADS) { const int dl = i >> 7, k = i & 127; wq[dl * 129 + k] = p.in[15][(size_t)(d0 + dl) * 2048 + hp * 128 + k]; }
    for (int i = tid; i < 128 * 128; i += NTHREADS) { const int n = i >> 7, k = i & 127; skT[k * 128 + n] = p.in[16][(size_t)hp * 16384 + i]; }
    __syncthreads();
    const int dl = tid & 63, ng = tid >> 6; h16* WS = (h16*)(p.ws + OFF_WS);
    float s[16];
#pragma unroll
    for (int j = 0; j < 16; ++j) s[j] = 0.f;
#pragma unroll 2
    for (int k = 0; k < 128; ++k) { const float wv = wq[dl * 129 + k];
#pragma unroll
        for (int q = 0; q < 4; ++q) { const f32x4 tv = *(LAS f32x4*)(skT + k * 128 + ng * 16 + 4 * q);
#pragma unroll
            for (int j = 0; j < 4; ++j) s[4 * q + j] += wv * tv[j]; } }
#pragma unroll
    for (int j = 0; j < 16; ++j) WS[(size_t)(hp * 128 + ng * 16 + j) * 1024 + d0 + dl] = (h16)s[j];
    __syncthreads();
}
__device__ __forceinline__ void p0_dft256(const Params& p) {
    h16* M = (h16*)(p.ws + OFF_DFT256);
    for (int e = threadIdx.x; e < 256 * 512; e += NTHREADS) { const int c = e >> 9, k = e & 511, part = k >> 8, a = k & 255; const int m = (a * c) & 255;
        M[e] = (h16)((part ? sinpif((float)m / 128.0f) : cospif((float)m / 128.0f)) * 0.25f); }
}
constexpr int CTL_P0Q = 6144;
__device__ __forceinline__ void phase0(const Params& p, LAS unsigned char* lds) {
    LAS float* sm = (LAS float*)lds; volatile LAS unsigned* slot = (volatile LAS unsigned*)(lds + LDS_BYTES - 64) + 8;
    unsigned* ctr = (unsigned*)(p.ws + OFF_CTL) + CTL_P0Q;
    int it = blockIdx.x;
    while (it < P0_TOTAL) {
        unsigned nxt = 0u;
        if (threadIdx.x == 0) nxt = xb_add(ctr, 1u) + gridDim.x;
        int i = it;
        do {
            if (i < N_DFT) { p0_dft256(p); break; } i -= N_DFT;
            if (i < N_MOD) { p0_mod(p, sm, i); break; } i -= N_MOD;
            if (i < N_WSF) { p0_wsf(p, sm, i); break; } i -= N_WSF;
            if (i < N_WF) { p0_wf(p, sm, i); break; } i -= N_WF;
            if (i < N_TRA) { p0_transpose(p.in[8], 5120, 0, (h16*)(p.ws + OFF_WA), 1024, 16, i, sm); break; } i -= N_TRA;
            if (i < N_TRG) { p0_transpose(p.in[8], 5120, 3072, (h16*)(p.ws + OFF_WG), 1024, 16, i, sm); break; } i -= N_TRG;
            if (i < N_TRHG) { p0_transpose(p.in[12], 1024, 0, (h16*)(p.ws + OFF_WHG), 512, 8, i, sm); break; } i -= N_TRHG;
            if (i < N_TRFT) { p0_transpose(p.in[13], 1024, 0, (h16*)(p.ws + OFF_WFT), 512, 8, i, sm); break; } i -= N_TRFT;
            if (i < N_TROUT) { p0_transpose(p.in[14], 1024, 0, (h16*)(p.ws + OFF_WOUT), 1024, 16, i, sm); break; } i -= N_TROUT;
            p0_lb(p);
        } while (0);
        if (threadIdx.x == 0) slot[0] = nxt;
        __syncthreads();
        it = (int)slot[0];
        __syncthreads();
    }
}

template <bool SRC16>
__device__ __forceinline__ void modulate_rows(const void* srcv, h16* dst, int nrows, const float* gvec, const float* mod, int sh_off, int sc_off, int ctx_rows, int vb, int vn, signed char* qdst = nullptr, float* qscale = nullptr) {
    const int wave = threadIdx.x >> 6, lane = threadIdx.x & 63;
    const float* src = (const float*)srcv; const h16* src16 = (const h16*)srcv;
    for (int rowA = vb * 8 + wave; rowA < nrows; rowA += vn * 16) {
        const int rowB = rowA + vn * 8; const bool okB = rowB < nrows;
        const int rows[2] = {rowA, okB ? rowB : rowA};
        f32x4 v[2][4]; float ss[2] = {0.f, 0.f};
#pragma unroll
        for (int q = 0; q < 2; ++q)
#pragma unroll
            for (int j = 0; j < 4; ++j) {
                if (SRC16) { const h16x4 hv = *(const h16x4*)(src16 + (size_t)rows[q] * D + j * 256 + lane * 4); v[q][j] = (f32x4){(float)hv[0], (float)hv[1], (float)hv[2], (float)hv[3]}; }
                else v[q][j] = *(const f32x4*)(src + (size_t)rows[q] * D + j * 256 + lane * 4); }
#pragma unroll
        for (int q = 0; q < 2; ++q) {
#pragma unroll
            for (int j = 0; j < 4; ++j) ss[q] += v[q][j].x * v[q][j].x + v[q][j].y * v[q][j].y + v[q][j].z * v[q][j].z + v[q][j].w * v[q][j].w;
            ss[q] = wave_sum(ss[q]); }
        const int mrA = ctx_rows ? 8 : (rows[0] >> 12), mrB = ctx_rows ? 8 : (rows[1] >> 12);
        f32x4 gg4[4], scA[4], shA[4], scB[4], shB[4];
#pragma unroll
        for (int j = 0; j < 4; ++j) { const int c = j * 256 + lane * 4; gg4[j] = *(const f32x4*)(gvec + c); scA[j] = *(const f32x4*)(mod + mrA * 6144 + sc_off + c); shA[j] = *(const f32x4*)(mod + mrA * 6144 + sh_off + c); }
        if (mrB != mrA) {
#pragma unroll
            for (int j = 0; j < 4; ++j) { const int c = j * 256 + lane * 4; scB[j] = *(const f32x4*)(mod + mrB * 6144 + sc_off + c); shB[j] = *(const f32x4*)(mod + mrB * 6144 + sh_off + c); }
        } else {
#pragma unroll
            for (int j = 0; j < 4; ++j) { scB[j] = scA[j]; shB[j] = shA[j]; }
        }
        __builtin_amdgcn_sched_barrier(0);
#pragma unroll
        for (int q = 0; q < 2; ++q) {
            if (q == 1 && !okB) break;
            const int row = rows[q];
            const float rstd = rsqrtf(ss[q] * (1.0f / D) + EPS);
            float amax = 0.f;
            f32x4 sc4[4], sh4[4];
#pragma unroll
            for (int j = 0; j < 4; ++j) { sc4[j] = q ? scB[j] : scA[j]; sh4[j] = q ? shB[j] : shA[j]; }
#pragma unroll
            for (int j = 0; j < 4; ++j) { const int c = j * 256 + lane * 4;
                const f32x4 gg = gg4[j], sc = sc4[j], sh = sh4[j];
                const f32x4 o = (v[q][j] * rstd) * gg * (sc + 1.0f) + sh; v[q][j] = o;
                amax = fmaxf(amax, fmaxf(fmaxf(fabsf(o.x), fabsf(o.y)), fmaxf(fabsf(o.z), fabsf(o.w))));
                u32x2 w; w.x = pk2(o.x, o.y); w.y = pk2(o.z, o.w);
                *(u32x2*)(dst + (size_t)row * D + c) = w; }
            if (qdst) {
#pragma unroll
                for (int o = 32; o >= 1; o >>= 1) amax = fmaxf(amax, __shfl_xor(amax, o));
                const float qs = amax > 0.f ? amax * (1.0f / 127.0f) : 1.0f, inv = 1.0f / qs;
#pragma unroll
                for (int j = 0; j < 4; ++j) { const int c = j * 256 + lane * 4;
                    const int q0 = (int)rintf(v[q][j].x * inv), q1 = (int)rintf(v[q][j].y * inv), q2 = (int)rintf(v[q][j].z * inv), q3 = (int)rintf(v[q][j].w * inv);
                    *(unsigned*)(qdst + (size_t)row * D + c) = (unsigned)(q0 & 255) | ((unsigned)(q1 & 255) << 8) | ((unsigned)(q2 & 255) << 16) | ((unsigned)(q3 & 255) << 24); }
                if (lane == 0) qscale[row] = qs;
            }
        }
    }
}

#define EPI_DEFAULT_HOOKS \
    static constexpr bool FUSED = false; \
    __device__ __forceinline__ size_t boff(const pg8::Unit&) const { return 0; } \
    __device__ __forceinline__ void init(f32x4 (&)[2][2][4][2], const pg8::Unit&, int, int, int, int) const {}
struct EpiA {
    EPI_DEFAULT_HOOKS
    static constexpr bool PERM = true, TRANS = true;
    static constexpr int NST = 16;
    unsigned char* ws;
    __device__ __forceinline__ void operator()(const f32x4 (&acc)[2][2][4][2], const pg8::Unit& u, int wr, int wc, int fr, int fq) const {
        const int ty = u.pn >> 1;
        h16* base = (h16*)(ws + (ty == 0 ? OFF_Q : ty == 1 ? OFF_LF : ty == 2 ? OFF_LBK : ty == 3 ? OFF_V : OFF_G));
        const float* lb = (const float*)(ws + OFF_LB) + (ty == 2 ? 512 : 0);
        const int row0 = u.pm * 256 + wr * 64 + fr, col0 = (u.pn & 1) * 256 + wc * 32 + 8 * fq;
        float lbv2[2][8], omv2[2][8];
        if (ty == 1 || ty == 2) {
#pragma unroll
            for (int bj = 0; bj < 2; ++bj) { const f32x4 l0 = *(const GAS f32x4*)(lb + col0 + bj * 128), l1 = *(const GAS f32x4*)(lb + col0 + bj * 128 + 4);
#pragma unroll
                for (int j = 0; j < 4; ++j) { lbv2[bj][j] = l0[j]; lbv2[bj][4 + j] = l1[j]; omv2[bj][j] = 1.0f - l0[j]; omv2[bj][4 + j] = 1.0f - l1[j]; } }
        }
#pragma unroll
        for (int bj = 0; bj < 2; ++bj) {
            float lbv[8], omv[8];
#pragma unroll
            for (int j = 0; j < 8; ++j) { lbv[j] = lbv2[bj][j]; omv[j] = omv2[bj][j]; }
#pragma unroll
            for (int ai = 0; ai < 2; ++ai)
#pragma unroll
                for (int m = 0; m < 4; ++m) {
                    float v[8];
#pragma unroll
                    for (int j = 0; j < 4; ++j) { v[j] = acc[ai][bj][m][0][j]; v[4 + j] = acc[ai][bj][m][1][j]; }
                    if (ty == 0) {
#pragma unroll
                        for (int j = 0; j < 8; ++j) v[j] *= 0.08838834764831845f;
                    } else if (ty == 1 || ty == 2) {
#pragma unroll
                        for (int j = 0; j < 8; ++j) v[j] = __builtin_amdgcn_logf(lbv[j] + omv[j] * sigmoidf_(v[j]));
                    }
                    u32x4 w; w.x = pk2(v[0], v[1]); w.y = pk2(v[2], v[3]); w.z = pk2(v[4], v[5]); w.w = pk2(v[6], v[7]);
                    gst4(base + (size_t)(row0 + ai * 128 + m * 16) * 512 + col0 + bj * 128, w);
                }
        }
    }
};
struct OneUnit { pg8::Unit u; __device__ bool next(int i, pg8::Unit& o) const { if (i > 0) return false; o = u; return true; } };
struct OrderA {
    pg8::TileOrder lat; int G, c, rep;
    __device__ void init(int G_, int c_, int rep_ = 1) { lat.init(128, 10, G_, c_); G = G_; c = c_; rep = rep_; }
    __device__ bool next(int i, pg8::Unit& u) const {
        long L = (long)i * G + c; if (L >= 1328L * rep) return false; L %= 1328;
        if (L < 1280) return lat.map(L, u);
        const int l2 = (int)(L - 1280); if (l2 >= 48) return false;
        u.pm = 128 + l2 / 6; u.pn = 2 + l2 % 6; return true;
    }
};
__device__ __forceinline__ size_t gate_rec(int gate, int pm, int pn4, int wave, int ai, int m, int lane) { return (((((((size_t)gate * 128 + pm) * 4 + pn4) * 8 + wave) * 2 + ai) * 4 + m) * 64 + lane) * 16; }
struct EpiGate {
    EPI_DEFAULT_HOOKS
    static constexpr bool PERM = true, TRANS = true;
    static constexpr int NST = 8;
    unsigned char* ws;
    __device__ __forceinline__ void operator()(const f32x4 (&acc)[2][2][4][2], const pg8::Unit& u, int wr, int wc, int fr, int fq) const {
        unsigned char* G8 = ws + OFF_GH;
#pragma unroll
        for (int ai = 0; ai < 2; ++ai)
#pragma unroll
            for (int m = 0; m < 4; ++m) {
                u32x4 w;
#pragma unroll
                for (int bj = 0; bj < 2; ++bj)
#pragma unroll
                    for (int n = 0; n < 2; ++n) { unsigned d = 0u;
#pragma unroll
                        for (int j = 0; j < 4; ++j) d = __builtin_amdgcn_cvt_pk_u8_f32(__builtin_amdgcn_rcpf(__builtin_fmaf(__expf(-acc[ai][bj][m][n][j]), 1.0f / 255.0f, 1.0f / 255.0f)), j, d);
                        w[2 * bj + n] = d; }
                gst4(G8 + gate_rec(u.pn >> 2, u.pm, u.pn & 3, wr * 4 + wc, ai, m, fq * 16 + fr), w);
            }
    }
};
struct EpiFT {
    EPI_DEFAULT_HOOKS
    static constexpr bool PERM = false, TRANS = false;
    static constexpr int NST = 32;
    unsigned char* ws;
    __device__ __forceinline__ void operator()(const f32x4 (&acc)[2][2][4][2], const pg8::Unit& u, int wr, int wc, int fr, int fq) const {
        h16* F = (h16*)(ws + OFF_FTT);
        const int t0 = u.pm * 256 + wr * 64 + 4 * fq, c0 = u.pn * 256 + wc * 32 + fr;
#pragma unroll
        for (int ai = 0; ai < 2; ++ai)
#pragma unroll
            for (int m = 0; m < 4; ++m)
#pragma unroll
                for (int bj = 0; bj < 2; ++bj)
#pragma unroll
                    for (int n = 0; n < 2; ++n) {
                        const int t = t0 + ai * 128 + m * 16, c = c0 + bj * 128 + n * 16;
                        const int b = t >> 12, n1 = t & 4095, part = c >> 9, gk = c & 511;
                        const f32x4 a = acc[ai][bj][m][n];
                        u32x2 w; w.x = pk2(a.x, a.y); w.y = pk2(a.z, a.w);
                        gst2(F + ((size_t)((b * 512 + gk) * 2 + part)) * 4096 + n1, w);
                    }
    }
};
struct EpiDFT {
    EPI_DEFAULT_HOOKS
    static constexpr bool PERM = true, TRANS = true;
    static constexpr int NST = 16;
    unsigned char* ws;
    __device__ __forceinline__ void operator()(const f32x4 (&acc)[2][2][4][2], const pg8::Unit& u, int wr, int wc, int fr, int fq) const {
        h16* Y = (h16*)(ws + OFF_YFT);
        const int b = u.pn >> 5, d = (u.pn >> 1) & 15;
        const int c0 = wr * 64 + fr, col0 = (u.pn & 1) * 256 + wc * 32 + 8 * fq;
#pragma unroll
        for (int ai = 0; ai < 2; ++ai)
#pragma unroll
            for (int m = 0; m < 4; ++m)
#pragma unroll
                for (int bj = 0; bj < 2; ++bj) {
                    const int c = c0 + ai * 128 + m * 16;
                    const f32x4 a0 = acc[ai][bj][m][0], a1 = acc[ai][bj][m][1];
                    u32x4 w; w.x = pk2(a0.x, a0.y); w.y = pk2(a0.z, a0.w); w.z = pk2(a1.x, a1.y); w.w = pk2(a1.z, a1.w);
                    gst4(Y + (size_t)(b * 4096 + d + 16 * c) * 512 + col0 + bj * 128, w);
                }
    }
};
typedef h16 GAS gh16;
template <bool ACCUM> struct EpiMerge1 {
    EPI_DEFAULT_HOOKS
    static constexpr bool PERM = true, TRANS = true;
    static constexpr int NST = 8;
    unsigned char* ws;
    __device__ __forceinline__ void operator()(const f32x4 (&acc)[2][2][4][2], const pg8::Unit& u, int wr, int wc, int fr, int fq) const {
        gh16* Y = (gh16*)(ws + OFF_Y); const unsigned char* G8 = ws + OFF_GH;
        const int row0 = u.pm * 256 + wr * 64 + fr, col0 = u.pn * 256 + wc * 32 + 8 * fq;
        const unsigned off0 = (unsigned)row0 * 1024u + (unsigned)col0;
#pragma unroll
        for (int ai = 0; ai < 2; ++ai) {
            u32x4 gt[4]; h16x8 yv[8];
#pragma unroll
            for (int m = 0; m < 4; ++m) gt[m] = *(const GAS u32x4*)(G8 + gate_rec(ACCUM ? 1 : 0, u.pm, u.pn, wr * 4 + wc, ai, m, fq * 16 + fr));
            if (ACCUM) {
#pragma unroll
                for (int i = 0; i < 8; ++i) { const int m = i >> 1, bj = i & 1; yv[i] = *(const GAS h16x8*)(Y + (off0 + (unsigned)((ai * 128 + m * 16) * 1024 + bj * 128))); } }
            __builtin_amdgcn_sched_barrier(0);
#pragma unroll
            for (int i = 0; i < 8; ++i) { const int m = i >> 1, bj = i & 1; const unsigned off = off0 + (unsigned)((ai * 128 + m * 16) * 1024 + bj * 128);
                float v[8];
#pragma unroll
                for (int n = 0; n < 2; ++n) { const unsigned d = gt[m][2 * bj + n];
#pragma unroll
                    for (int j = 0; j < 4; ++j) v[4 * n + j] = acc[ai][bj][m][n][j] * ((float)((d >> (8 * j)) & 255u) * (1.0f / 255.0f)); }
                if (ACCUM) {
#pragma unroll
                    for (int j = 0; j < 8; ++j) v[j] += (float)yv[i][j]; }
                u32x4 w; w.x = pk2(v[0], v[1]); w.y = pk2(v[2], v[3]); w.z = pk2(v[4], v[5]); w.w = pk2(v[6], v[7]);
                *(GAS u32x4*)(Y + off) = w; }
            __builtin_amdgcn_sched_barrier(0);
        }
    }
};
struct EpiMerge2 {
    static constexpr bool PERM = true, TRANS = true, FUSED = true;
    static constexpr int NST = 8;
    const float* x; h16* H;
    __device__ __forceinline__ size_t boff(const pg8::Unit& u) const { return (size_t)(u.pm >> 4) * (1024 * 1024 * 2); }
    __device__ __forceinline__ void init(f32x4 (&acc)[2][2][4][2], const pg8::Unit& u, int wr, int wc, int fr, int fq) const {
        const int row0 = u.pm * 256 + wr * 64 + fr, col0 = u.pn * 256 + wc * 32 + 8 * fq;
        const GAS float* xg = (const GAS float*)x;
#pragma unroll
        for (int ai = 0; ai < 2; ++ai)
#pragma unroll
            for (int m = 0; m < 4; ++m) { const GAS float* rowp = xg + (size_t)(row0 + ai * 128 + m * 16) * 1024 + col0;
#pragma unroll
                for (int bj = 0; bj < 2; ++bj)
#pragma unroll
                    for (int n = 0; n < 2; ++n) acc[ai][bj][m][n] = *(const GAS f32x4*)(rowp + bj * 128 + n * 4); }
    }
    __device__ __forceinline__ void fused(f32x4 (&acc)[2][2][4][2], const pg8::Unit& u, const pg8::Unit& nx, bool has_next, int wr, int wc, int fr, int fq) const {
        const int row0 = u.pm * 256 + wr * 64 + fr, col0 = u.pn * 256 + wc * 32 + 8 * fq;
        const int nrow0 = nx.pm * 256 + wr * 64 + fr, ncol0 = nx.pn * 256 + wc * 32 + 8 * fq;
        const GAS float* xg = (const GAS float*)x;
#pragma unroll
        for (int ai = 0; ai < 2; ++ai) {
            u32x4 o[4][2];
#pragma unroll
            for (int m = 0; m < 4; ++m)
#pragma unroll
                for (int bj = 0; bj < 2; ++bj) { const f32x4 a0 = acc[ai][bj][m][0], a1 = acc[ai][bj][m][1];
                    o[m][bj].x = pk2(a0[0], a0[1]); o[m][bj].y = pk2(a0[2], a0[3]); o[m][bj].z = pk2(a1[0], a1[1]); o[m][bj].w = pk2(a1[2], a1[3]); }
            __builtin_amdgcn_sched_barrier(0);
            if (has_next) {
#pragma unroll
                for (int m = 0; m < 4; ++m) { const GAS float* rowp = xg + (size_t)(nrow0 + ai * 128 + m * 16) * 1024 + ncol0;
#pragma unroll
                    for (int bj = 0; bj < 2; ++bj)
#pragma unroll
                        for (int n = 0; n < 2; ++n) acc[ai][bj][m][n] = *(const GAS f32x4*)(rowp + bj * 128 + n * 4); } }
            __builtin_amdgcn_sched_barrier(0);
#pragma unroll
            for (int m = 0; m < 4; ++m) { h16* rowp = H + (size_t)(row0 + ai * 128 + m * 16) * 1024 + col0;
#pragma unroll
                for (int bj = 0; bj < 2; ++bj) gst4(rowp + bj * 128, o[m][bj]); }
            __builtin_amdgcn_sched_barrier(0);
        }
    }
};
__device__ __forceinline__ void scale_wout(const Params& p, int vb, int vn) {
    const h16* W = (const h16*)(p.ws + OFF_WOUT); h16* WG = (h16*)(p.ws + OFF_WOUTG); const float* mod = (const float*)(p.ws + OFF_MOD);
    for (size_t i = (size_t)vb * NTHREADS + threadIdx.x; i < (size_t)8 * 1024 * 128; i += (size_t)vn * NTHREADS) {
        const int b = (int)(i >> 17), c = (int)((i >> 7) & 1023), k8 = (int)(i & 127) * 8;
        const h16x8 w = *(const h16x8*)(W + (size_t)c * 1024 + k8); const float g = mod[b * 6144 + 2048 + c];
        u32x4 o; o.x = pk2((float)w[0] * g, (float)w[1] * g); o.y = pk2((float)w[2] * g, (float)w[3] * g); o.z = pk2((float)w[4] * g, (float)w[5] * g); o.w = pk2((float)w[6] * g, (float)w[7] * g);
        *(u32x4*)(WG + ((size_t)b * 1024 + c) * 1024 + k8) = o; }
}
__device__ __forceinline__ unsigned f2key(float x) { const unsigned b = __builtin_bit_cast(unsigned, x); return b ^ ((b >> 31) ? 0xFFFFFFFFu : 0x80000000u); }
__device__ __forceinline__ float key2f(unsigned u) { const unsigned b = (u & 0x80000000u) ? (u ^ 0x80000000u) : ~u; return __builtin_bit_cast(float, b); }
__device__ __forceinline__ unsigned umax3(unsigned a, unsigned b, unsigned c) { return max(max(a, b), c); }
typedef short s16x2_t __attribute__((ext_vector_type(2)));
__device__ __forceinline__ unsigned hkey2(float a, float b) { const unsigned w = pk2(a, b); const s16x2_t m = __builtin_bit_cast(s16x2_t, w) >> 15;
    return w ^ (__builtin_bit_cast(unsigned, m) | 0x80008000u); }
struct EpiScores {
    static constexpr bool PERM = false, TRANS = true;
    static constexpr int NST = 16;
    EPI_DEFAULT_HOOKS
    unsigned char* C;
    __device__ __forceinline__ void operator()(const f32x4 (&acc)[2][2][4][2], const pg8::Unit& u, int wr, int wc, int fr, int fq) const {
#pragma unroll
        for (int ai = 0; ai < 2; ++ai)
#pragma unroll
            for (int m = 0; m < 4; ++m) { const int t = u.pm * 256 + ai * 128 + wr * 64 + m * 16 + fr, tb = t >> 6, tl = t & 63;
#pragma unroll
                for (int bj = 0; bj < 2; ++bj) { const int c8 = 4 * wc + fq;
                    const f32x4 a0 = acc[ai][bj][m][0], a1 = acc[ai][bj][m][1]; u32x4 kq;
                    kq.x = hkey2(a0[0], a0[1]); kq.y = hkey2(a0[2], a0[3]); kq.z = hkey2(a1[0], a1[1]); kq.w = hkey2(a1[2], a1[3]);
                    gst4(C + ((((size_t)(tb * 8 + u.pn) * 2 + bj) * 16 + c8) * 64 + tl) * 16, kq); } }
    }
};
__device__ __forceinline__ int hgrn_row(int pos, int b, int dir) {
    if (pos < LC) { const int j = dir ? (LC - 1 - pos) : pos; return T + b * LC + j; }
    const int t = pos - LC; return b * SEQ + (dir ? (SEQ - 1 - t) : t);
}
__device__ void hgrn_item(const Params& p, LAS unsigned char* lds, int item) {
    const int tid = threadIdx.x, vq = item & 3, dir = (item >> 2) & 1, h = (item >> 3) & 3, b = item >> 5;
    const h16* Q = (const h16*)(p.ws + OFF_Q); const h16* LF = (const h16*)(p.ws + (dir ? OFF_LBK : OFF_LF)); const h16* V = (const h16*)(p.ws + OFF_V);
    h16* O = (h16*)(p.ws + (dir ? OFF_OB : OFF_OF));
    LAS float* fs = (LAS float*)lds; LAS float* ks = fs + 16 * 128; LAS float* qs = ks + 16 * 128; LAS float* vs = qs + 16 * 128; LAS float* po = vs + 16 * 32;
    const int v = tid & 31, kq = tid >> 5;
    float S[8];
#pragma unroll
    for (int j = 0; j < 8; ++j) S[j] = 0.f;
    const int e = tid * 4, tl_ld = e >> 7, k_ld = e & 127;
    const int tl_v = tid >> 5, vv = tid & 31;
    h16x4 lf4, q4; h16 v1;
    { const int row = hgrn_row(tl_ld, b, dir); lf4 = *(const h16x4*)(LF + (size_t)row * 512 + h * 128 + k_ld); q4 = (h16x4){0, 0, 0, 0};
      const int row2 = hgrn_row(tl_v, b, dir); v1 = V[(size_t)row2 * 512 + h * 128 + vq * 32 + vv]; }
    constexpr int NG = (LC + SEQ) / 16;
    for (int grp = 0; grp < NG; ++grp) {
        const bool latent = grp >= LC / 16;
#pragma unroll
        for (int j = 0; j < 4; ++j) { const float f = __expf((float)lf4[j]); fs[e + j] = f; ks[e + j] = 1.0f - f; qs[e + j] = (float)q4[j]; }
        vs[tid] = (float)v1;
        __syncthreads();
        if (grp + 1 < NG) { const int pos = (grp + 1) * 16; const bool lat2 = (grp + 1) >= LC / 16;
            const int row = hgrn_row(pos + tl_ld, b, dir); lf4 = *(const h16x4*)(LF + (size_t)row * 512 + h * 128 + k_ld);
            if (lat2) q4 = *(const h16x4*)(Q + (size_t)row * 512 + h * 128 + k_ld);
            const int row2 = hgrn_row(pos + tl_v, b, dir); v1 = V[(size_t)row2 * 512 + h * 128 + vq * 32 + vv]; }
#pragma unroll 4
        for (int tl = 0; tl < 16; ++tl) {
            const float vt = vs[tl * 32 + v];
            const f32x4 f0 = *(const LAS f32x4*)(fs + tl * 128 + kq * 8), f1 = *(const LAS f32x4*)(fs + tl * 128 + kq * 8 + 4);
            const f32x4 k0 = *(const LAS f32x4*)(ks + tl * 128 + kq * 8), k1 = *(const LAS f32x4*)(ks + tl * 128 + kq * 8 + 4);
            const f32x4 q0 = *(const LAS f32x4*)(qs + tl * 128 + kq * 8), q1 = *(const LAS f32x4*)(qs + tl * 128 + kq * 8 + 4);
            float a = 0.f;
#pragma unroll
            for (int j = 0; j < 4; ++j) { S[j] = f0[j] * S[j] + k0[j] * vt; a += S[j] * q0[j]; S[4 + j] = f1[j] * S[4 + j] + k1[j] * vt; a += S[4 + j] * q1[j]; }
            po[(tl * 16 + kq) * 32 + v] = a;
        }
        __syncthreads();
        if (latent) { float s = 0.f;
#pragma unroll
            for (int q = 0; q < 16; ++q) s += po[(tl_v * 16 + q) * 32 + vv];
            const int row = hgrn_row(grp * 16 + tl_v, b, dir);
            O[(size_t)row * 512 + h * 128 + vq * 32 + vv] = (h16)s; }
    }
    __syncthreads();
}

typedef short s16x8 __attribute__((ext_vector_type(8)));
typedef short s16x4 __attribute__((ext_vector_type(4)));
__device__ __forceinline__ unsigned cvt_pk_bf16(float lo, float hi) { unsigned r; asm volatile("v_cvt_pk_bf16_f32 %0, %1, %2" : "=v"(r) : "v"(lo), "v"(hi)); return r; }
constexpr int HG_RP = 272, HG_QT = 0, HG_KT = 17408, HG_QD = 34816, HG_KDT = 52224, HG_VT = 68608, HG_AM = 84992, HG_DEC = 93184, HG_SEG = 93696, HG_SEGCH = 17;
#define HG_OPAQUE(x) asm volatile("" : "+v"(x))
template <bool FULL>
__device__ __forceinline__ void hgrn_mfma_unit(const Params& p, LAS unsigned char* lds, int item, int seg) {
    const int tid = threadIdx.x, wave = __builtin_amdgcn_readfirstlane(tid >> 6), lane = tid & 63, fr = lane & 15, fq = lane >> 4;
    const int dir = item & 1, h = (item >> 1) & 3, b = item >> 3;
    const h16* Q = (const h16*)(p.ws + OFF_Q); const h16* LF = (const h16*)(p.ws + (dir ? OFF_LBK : OFF_LF)); const h16* V = (const h16*)(p.ws + OFF_V);
    h16* O = (h16*)(p.ws + (dir ? OFF_OB : OFF_OF));
    float* USTATE = (float*)(p.ws + OFF_USTATE); float* DLOG = (float*)(p.ws + OFF_DLOG);
    const int ch_lo = seg * HG_SEGCH, ch_hi = ch_lo + HG_SEGCH;
    f32x4 S[8];
#pragma unroll
    for (int m = 0; m < 8; ++m) S[m] = (f32x4){0.f, 0.f, 0.f, 0.f};
    if (FULL && seg > 0) {
        for (int i = 0; i < seg; ++i) { const float* U = USTATE + (size_t)(item * 3 + i) * 16384; const float* DL = DLOG + (size_t)(item * 3 + i) * 128;
#pragma unroll
            for (int m = 0; m < 8; ++m)
#pragma unroll
                for (int j = 0; j < 4; ++j) { const int k = 16 * m + 4 * fq + j; const float d = (i > 0) ? __builtin_amdgcn_exp2f(DL[k]) : 0.f; S[m][j] = d * S[m][j] + U[k * 128 + 16 * wave + fr]; } } }
    float dl0 = 0.f, dl1 = 0.f;
    for (int i = tid; i < 8192 / 16; i += NTHREADS) ((LAS u32x4*)(lds + HG_AM))[i] = (u32x4){0u, 0u, 0u, 0u};
    const int kp = lane;
    const unsigned chan = (unsigned)(h * 128 + 2 * kp);
    int bw_rm = wave * 8 * HG_RP + 4 * kp;
    int bw_t0 = (2 * kp) * 128 + ((wave ^ ((2 * kp) & 7)) << 4), bw_t1 = (2 * kp + 1) * 128 + ((wave ^ ((2 * kp + 1) & 7)) << 4);
    int br_rm = fr * HG_RP + 16 * fq;
    int br_qd = HG_QD + fr * HG_RP + 8 * fq;
    int br_t0 = fr * 128 + ((fq ^ (fr & 7)) << 4), br_t1 = fr * 128 + (((4 + fq) ^ (fr & 7)) << 4);
    HG_OPAQUE(bw_rm); HG_OPAQUE(bw_t0); HG_OPAQUE(bw_t1); HG_OPAQUE(br_rm); HG_OPAQUE(br_qd); HG_OPAQUE(br_t0); HG_OPAQUE(br_t1);
    int br_v0 = br_t0 + HG_VT + wave * 2048, br_v1 = br_t1 + HG_VT + wave * 2048, br_k0 = br_t0 + HG_KDT, br_k1 = br_t1 + HG_KDT, br_a0 = br_t0 + HG_AM, br_a1 = br_t1 + HG_AM;
    HG_OPAQUE(br_v0); HG_OPAQUE(br_v1); HG_OPAQUE(br_k0); HG_OPAQUE(br_k1); HG_OPAQUE(br_a0); HG_OPAQUE(br_a1);
    LAS float* DEC = (LAS float*)(lds + HG_DEC); LAS float* SEG = (LAS float*)(lds + HG_SEG);
    unsigned lfr[8], qr[8], vr[8];
#pragma unroll
    for (int r = 0; r < 8; ++r) { const unsigned eo = (unsigned)hgrn_row(ch_lo * 64 + 8 * wave + r, b, dir) * 512u + chan; lfr[r] = *(const unsigned*)(LF + eo); vr[r] = *(const unsigned*)(V + eo);
        qr[r] = (FULL && ch_lo >= LC / 64) ? *(const unsigned*)(Q + eo) : 0u; }
    for (int ch = ch_lo; ch < ch_hi; ++ch) {
        const bool latent = FULL && (ch >= LC / 64);
        float f0[8], f1[8]; float run0 = 0.f, run1 = 0.f;
#pragma unroll
        for (int r = 0; r < 8; ++r) { const h16x2 l = __builtin_bit_cast(h16x2, lfr[r]); const float l0 = (float)l[0], l1 = (float)l[1]; run0 += l0; run1 += l1;
            f0[r] = __builtin_amdgcn_exp2f(l0); f1[r] = __builtin_amdgcn_exp2f(l1); }
        *(LAS f32x2*)(SEG + wave * 128 + 2 * kp) = (f32x2){run0, run1};
        __syncthreads();
        float off0 = 0.f, off1 = 0.f, mid0 = 0.f, mid1 = 0.f, tot0 = 0.f, tot1 = 0.f;
#pragma unroll
        for (int w2 = 0; w2 < 8; ++w2) { const f32x2 tt = *(LAS f32x2*)(SEG + w2 * 128 + 2 * kp);
            if (w2 < wave) { off0 += tt[0]; off1 += tt[1]; } if (w2 < 4) { mid0 += tt[0]; mid1 += tt[1]; } tot0 += tt[0]; tot1 += tt[1]; }
        dl0 += tot0; dl1 += tot1;
        const float em0 = __builtin_amdgcn_exp2f(mid0), em1 = __builtin_amdgcn_exp2f(mid1), el0 = __builtin_amdgcn_exp2f(tot0 - mid0), el1 = __builtin_amdgcn_exp2f(tot1 - mid1);
        if (wave == 0) *(LAS f32x2*)(DEC + 2 * kp) = (f32x2){__builtin_amdgcn_exp2f(tot0), __builtin_amdgcn_exp2f(tot1)};
        float e2a[8], e2b[8];
        e2a[7] = __builtin_amdgcn_exp2f(mid0 - (off0 + run0)); e2b[7] = __builtin_amdgcn_exp2f(mid1 - (off1 + run1));
#pragma unroll
        for (int r = 7; r > 0; --r) { e2a[r - 1] = e2a[r] * f0[r]; e2b[r - 1] = e2b[r] * f1[r]; }
        float e1a = FULL ? __builtin_amdgcn_exp2f(off0 - mid0) : 0.f, e1b = FULL ? __builtin_amdgcn_exp2f(off1 - mid1) : 0.f;
        unsigned kd0[4], kd1[4], vt0[4], vt1[4];
#pragma unroll
        for (int r = 0; r < 8; ++r) {
            const h16x2 q = __builtin_bit_cast(h16x2, qr[r]), v = __builtin_bit_cast(h16x2, vr[r]);
            const float e20 = e2a[r], e21 = e2b[r];
            const float k0 = 1.0f - f0[r], k1 = 1.0f - f1[r];
            const float kt0 = k0 * e20, kt1 = k1 * e21;
            if (FULL) {
                e1a *= f0[r]; e1b *= f1[r]; const float e10 = e1a, e11 = e1b;
                const float qt0 = (float)q[0] * e10, qt1 = (float)q[1] * e11;
                *(LAS unsigned*)(lds + bw_rm + HG_QT + r * HG_RP) = cvt_pk_bf16(qt0, qt1);
                *(LAS unsigned*)(lds + bw_rm + HG_KT + r * HG_RP) = cvt_pk_bf16(kt0, kt1);
                *(LAS unsigned*)(lds + bw_rm + HG_QD + r * HG_RP) = cvt_pk_bf16(qt0 * em0, qt1 * em1);
            }
            const float kdv0 = kt0 * el0, kdv1 = kt1 * el1;
            if (r & 1) { kd0[r >> 1] = cvt_pk_bf16(__builtin_bit_cast(float, kd0[r >> 1]), kdv0); kd1[r >> 1] = cvt_pk_bf16(__builtin_bit_cast(float, kd1[r >> 1]), kdv1);
                         vt0[r >> 1] = cvt_pk_bf16(__builtin_bit_cast(float, vt0[r >> 1]), (float)v[0]); vt1[r >> 1] = cvt_pk_bf16(__builtin_bit_cast(float, vt1[r >> 1]), (float)v[1]); }
            else { kd0[r >> 1] = __builtin_bit_cast(unsigned, kdv0); kd1[r >> 1] = __builtin_bit_cast(unsigned, kdv1);
                   vt0[r >> 1] = __builtin_bit_cast(unsigned, (float)v[0]); vt1[r >> 1] = __builtin_bit_cast(unsigned, (float)v[1]); }
        }
        *(LAS u32x4*)(lds + bw_t0 + HG_KDT) = (u32x4){kd0[0], kd0[1], kd0[2], kd0[3]};
        *(LAS u32x4*)(lds + bw_t1 + HG_KDT) = (u32x4){kd1[0], kd1[1], kd1[2], kd1[3]};
        *(LAS u32x4*)(lds + bw_t0 + HG_VT) = (u32x4){vt0[0], vt0[1], vt0[2], vt0[3]};
        *(LAS u32x4*)(lds + bw_t1 + HG_VT) = (u32x4){vt1[0], vt1[1], vt1[2], vt1[3]};
        __syncthreads();
        if (ch + 1 < ch_hi) { const bool lat2 = FULL && ((ch + 1) >= LC / 64);
#pragma unroll
            for (int r = 0; r < 8; ++r) { const unsigned eo = (unsigned)hgrn_row((ch + 1) * 64 + 8 * wave + r, b, dir) * 512u + chan;
                lfr[r] = *(const unsigned*)(LF + eo); vr[r] = *(const unsigned*)(V + eo); qr[r] = lat2 ? *(const unsigned*)(Q + eo) : 0u; } }
        if (latent) {
#pragma unroll
            for (int rep = 0; rep < 2; ++rep) {
                const int tile = wave + 8 * rep;
                if (tile < 10) {
                    const int ti = tile < 1 ? 0 : tile < 3 ? 1 : tile < 6 ? 2 : 3, si = tile - (ti * (ti + 1)) / 2;
                    f32x4 acc = (f32x4){0.f, 0.f, 0.f, 0.f};
                    LAS unsigned char* pa = lds + br_rm + HG_KT + 16 * si * HG_RP; LAS unsigned char* pb = lds + br_rm + HG_QT + 16 * ti * HG_RP;
#pragma unroll
                    for (int kk = 0; kk < 4; ++kk) acc = __builtin_amdgcn_mfma_f32_16x16x32_bf16(*(LAS s16x8*)(pa + 64 * kk), *(LAS s16x8*)(pb + 64 * kk), acc, 0, 0, 0);
                    const int t = 16 * ti + fr, s0 = 16 * si + 4 * fq;
                    if (ti == si) {
#pragma unroll
                        for (int j = 0; j < 4; ++j) acc[j] = (s0 + j <= t) ? acc[j] : 0.f; }
                    *(LAS u32x2*)(lds + HG_AM + t * 128 + ((((s0 >> 3)) ^ (fr & 7)) << 4) + (s0 & 7) * 2) = (u32x2){cvt_pk_bf16(acc[0], acc[1]), cvt_pk_bf16(acc[2], acc[3])};
                }
            }
        }
        __syncthreads();
        const s16x8 vf0 = *(LAS s16x8*)(lds + br_v0), vf1 = *(LAS s16x8*)(lds + br_v1);
        if (latent) {
            s16x8 sfrag[4];
#pragma unroll
            for (int kk = 0; kk < 4; ++kk) { const unsigned w0 = cvt_pk_bf16(S[2 * kk][0], S[2 * kk][1]), w1 = cvt_pk_bf16(S[2 * kk][2], S[2 * kk][3]),
                                                          w2 = cvt_pk_bf16(S[2 * kk + 1][0], S[2 * kk + 1][1]), w3 = cvt_pk_bf16(S[2 * kk + 1][2], S[2 * kk + 1][3]);
                sfrag[kk] = __builtin_bit_cast(s16x8, (u32x4){w0, w1, w2, w3}); }
#pragma unroll
            for (int ti = 0; ti < 4; ++ti) {
                f32x4 acc = (f32x4){0.f, 0.f, 0.f, 0.f};
                acc = __builtin_amdgcn_mfma_f32_16x16x32_bf16(vf0, *(LAS s16x8*)(lds + br_a0 + 2048 * ti), acc, 0, 0, 0);
                if (ti >= 2) acc = __builtin_amdgcn_mfma_f32_16x16x32_bf16(vf1, *(LAS s16x8*)(lds + br_a1 + 2048 * ti), acc, 0, 0, 0);
#pragma unroll
                for (int kk = 0; kk < 4; ++kk) {
                    const s16x4 lo = *(LAS s16x4*)(lds + br_qd + 16 * ti * HG_RP + 64 * kk), hi = *(LAS s16x4*)(lds + br_qd + 16 * ti * HG_RP + 64 * kk + 32);
                    const s16x8 bf = (s16x8){lo[0], lo[1], lo[2], lo[3], hi[0], hi[1], hi[2], hi[3]};
                    acc = __builtin_amdgcn_mfma_f32_16x16x32_bf16(sfrag[kk], bf, acc, 0, 0, 0); }
                const unsigned oo = (unsigned)hgrn_row(ch * 64 + 16 * ti + fr, b, dir) * 512u + (unsigned)(h * 128 + 16 * wave + 4 * fq);
                *(u32x2*)(O + oo) = (u32x2){pk2(acc[0], acc[1]), pk2(acc[2], acc[3])};
            }
        }
#pragma unroll
        for (int m = 0; m < 8; ++m) {
            const f32x4 dc = *(LAS f32x4*)(DEC + 16 * m + 4 * fq);
            S[m] = S[m] * dc;
            S[m] = __builtin_amdgcn_mfma_f32_16x16x32_bf16(*(LAS s16x8*)(lds + br_k0 + 2048 * m), vf0, S[m], 0, 0, 0);
            S[m] = __builtin_amdgcn_mfma_f32_16x16x32_bf16(*(LAS s16x8*)(lds + br_k1 + 2048 * m), vf1, S[m], 0, 0, 0);
        }
    }
    if (!FULL) {
        float* U = USTATE + (size_t)(item * 3 + seg) * 16384;
#pragma unroll
        for (int m = 0; m < 8; ++m)
#pragma unroll
            for (int j = 0; j < 4; ++j) U[(16 * m + 4 * fq + j) * 128 + 16 * wave + fr] = S[m][j];
        if (wave == 0) *(f32x2*)(DLOG + (size_t)(item * 3 + seg) * 128 + 2 * kp) = (f32x2){dl0, dl1};
    }
    __syncthreads();
}

__device__ __forceinline__ void fft1_phase(const Params& p, LAS unsigned char* lds) {
    LAS float* ctab = (LAS float*)lds;
    LAS float* w16 = ctab + 4096;
    for (int i = threadIdx.x; i < 4096; i += NTHREADS) ctab[i] = cospif((float)i / 2048.0f);
    if (threadIdx.x < 16) { w16[threadIdx.x] = cospif((float)threadIdx.x / 8.0f); w16[16 + threadIdx.x] = sinpif((float)threadIdx.x / 8.0f); }
    __syncthreads();
    const h16* F = (const h16*)(p.ws + OFF_FTT); h16* Y1 = (h16*)(p.ws + OFF_Y1);
    const int ap = threadIdx.x & 127, gl = threadIdx.x >> 7;
    volatile LAS unsigned* slot = (volatile LAS unsigned*)(lds + LDS_BYTES - 64) + 9;
    unsigned* ctr = (unsigned*)(p.ws + OFF_CTL) + CTL_P0Q + 64;
    if (threadIdx.x == 0) slot[0] = xb_add(ctr, 1u);
    __syncthreads();
    int item = (int)slot[0];
    __syncthreads();
    while (item < 8 * 128) {
        unsigned nxt_ = 0u;
        if (threadIdx.x == 0) nxt_ = xb_add(ctr, 1u);
        const int b = item >> 7, gk = (item & 127) * 4 + gl;
        float zr[16][2], zi[16][2];
        const h16* src = F + ((size_t)(b * 512 + gk) * 2) * 4096 + 2 * ap;
#pragma unroll
        for (int r = 0; r < 16; ++r) { const h16x2 c2 = *(const h16x2*)(src + 256 * r), s2 = *(const h16x2*)(src + 4096 + 256 * r);
            zr[r][0] = (float)c2[0]; zr[r][1] = (float)c2[1]; zi[r][0] = -(float)s2[0]; zi[r][1] = -(float)s2[1]; }
        float ur[4][4][2], ui[4][4][2];
#pragma unroll
        for (int r0 = 0; r0 < 4; ++r0)
#pragma unroll
            for (int j = 0; j < 2; ++j) {
                const float a0r = zr[r0][j], a0i = zi[r0][j], a1r = zr[4 + r0][j], a1i = zi[4 + r0][j], a2r = zr[8 + r0][j], a2i = zi[8 + r0][j], a3r = zr[12 + r0][j], a3i = zi[12 + r0][j];
                const float s0r = a0r + a2r, s0i = a0i + a2i, s1r = a0r - a2r, s1i = a0i - a2i, s2r = a1r + a3r, s2i = a1i + a3i, s3r = a1r - a3r, s3i = a1i - a3i;
                float xr[4], xi[4];
                xr[0] = s0r + s2r; xi[0] = s0i + s2i; xr[2] = s0r - s2r; xi[2] = s0i - s2i;
                xr[1] = s1r + s3i; xi[1] = s1i - s3r;
                xr[3] = s1r - s3i; xi[3] = s1i + s3r;
#pragma unroll
                for (int d0 = 0; d0 < 4; ++d0) { const int m = r0 * d0;
                    const float cs = (m == 0) ? 1.f : (m == 1) ? 0.92387953251f : (m == 2) ? 0.70710678119f : (m == 3) ? 0.38268343237f : (m == 4) ? 0.f : (m == 6) ? -0.70710678119f : -0.92387953251f;
                    const float sn = (m == 0) ? 0.f : (m == 1) ? 0.38268343237f : (m == 2) ? 0.70710678119f : (m == 3) ? 0.92387953251f : (m == 4) ? 1.f : (m == 6) ? 0.70710678119f : -0.38268343237f;
                    ur[r0][d0][j] = xr[d0] * cs + xi[d0] * sn; ui[r0][d0][j] = xi[d0] * cs - xr[d0] * sn; } }
#pragma unroll
        for (int d0 = 0; d0 < 4; ++d0) {
            float yr4[4][2], yi4[4][2];
#pragma unroll
            for (int j = 0; j < 2; ++j) {
                const float a0r = ur[0][d0][j], a0i = ui[0][d0][j], a1r = ur[1][d0][j], a1i = ui[1][d0][j], a2r = ur[2][d0][j], a2i = ui[2][d0][j], a3r = ur[3][d0][j], a3i = ui[3][d0][j];
                const float s0r = a0r + a2r, s0i = a0i + a2i, s1r = a0r - a2r, s1i = a0i - a2i, s2r = a1r + a3r, s2i = a1i + a3i, s3r = a1r - a3r, s3i = a1i - a3i;
                yr4[0][j] = s0r + s2r; yi4[0][j] = s0i + s2i; yr4[2][j] = s0r - s2r; yi4[2][j] = s0i - s2i;
                yr4[1][j] = s1r + s3i; yi4[1][j] = s1i - s3r; yr4[3][j] = s1r - s3i; yi4[3][j] = s1i + s3r; }
#pragma unroll
            for (int d1 = 0; d1 < 4; ++d1) { const int d = d0 + 4 * d1;
                float ore[2], oim[2];
#pragma unroll
                for (int j = 0; j < 2; ++j) { const int t = ((2 * ap + j) * d) & 4095; const float ct = ctab[t], st = ctab[(t - 1024) & 4095];
                    ore[j] = (yr4[d1][j] * ct + yi4[d1][j] * st) * 0.0625f; oim[j] = (yi4[d1][j] * ct - yr4[d1][j] * st) * 0.0625f; }
            h16* dst = Y1 + ((size_t)((b * 16 + d) * 512 + gk)) * 512 + 2 * ap;
            *(unsigned*)dst = pk2(ore[0], ore[1]); *(unsigned*)(dst + 256) = pk2(oim[0], oim[1]);
            }
        }
        if (threadIdx.x == 0) slot[0] = nxt_;
        __syncthreads();
        item = (int)slot[0];
        __syncthreads();
    }
    __syncthreads();
}

__device__ __forceinline__ void a1_prepass(const Params& p) {
    const int wave = threadIdx.x >> 6, lane = threadIdx.x & 63;
    const h16* OF = (const h16*)(p.ws + OFF_OF); const h16* OB = (const h16*)(p.ws + OFF_OB); h16* G = (h16*)(p.ws + OFF_G);
    const float* hgn = p.in[11];
    float hg[8];
#pragma unroll
    for (int j = 0; j < 8; ++j) hg[j] = hgn[lane * 8 + j];
    for (int t0 = (blockIdx.x * 8 + wave) * 4; t0 < T; t0 += gridDim.x * 32) {
        h16x8 a[4], bq[4], g[4];
#pragma unroll
        for (int q = 0; q < 4; ++q) { const size_t off = (size_t)(t0 + q) * 512 + lane * 8; a[q] = *(const h16x8*)(OF + off); bq[q] = *(const h16x8*)(OB + off); g[q] = *(const h16x8*)(G + off); }
#pragma unroll
        for (int q = 0; q < 4; ++q) {
            float o[8]; float ss = 0.f;
#pragma unroll
            for (int j = 0; j < 8; ++j) { o[j] = (float)a[q][j] + (float)bq[q][j]; ss += o[j] * o[j]; }
            ss += __shfl_xor(ss, 1); ss += __shfl_xor(ss, 2); ss += __shfl_xor(ss, 4); ss += __shfl_xor(ss, 8);
            const float rstd = rsqrtf(ss * (1.0f / 128.0f) + EPS);
            float r[8];
#pragma unroll
            for (int j = 0; j < 8; ++j) { const float gz = (float)g[q][j]; r[j] = o[j] * rstd * hg[j] * (gz * sigmoidf_(gz)); }
            u32x4 w; w.x = pk2(r[0], r[1]); w.y = pk2(r[2], r[3]); w.z = pk2(r[4], r[5]); w.w = pk2(r[6], r[7]);
            *(u32x4*)(G + (size_t)(t0 + q) * 512 + lane * 8) = w;
        }
    }
}

__device__ __forceinline__ void convert_tables(const Params& p, int vb, int vn) {
    const int wave = threadIdx.x >> 6, lane = threadIdx.x & 63;
    for (int r2 = vb * 8 + wave; r2 < 2 * 16384; r2 += vn * 8) {
        const int tb = r2 >> 14, e = r2 & 16383;
        const float* src = (tb ? p.in[18] : p.in[17]) + (size_t)e * D + lane * 16;
        f32x4 v[4]; float amax = 0.f;
#pragma unroll
        for (int j = 0; j < 4; ++j) { v[j] = *(const f32x4*)(src + 4 * j); amax = fmaxf(amax, fmaxf(fmaxf(fabsf(v[j].x), fabsf(v[j].y)), fmaxf(fabsf(v[j].z), fabsf(v[j].w)))); }
#pragma unroll
        for (int o = 32; o >= 1; o >>= 1) amax = fmaxf(amax, __shfl_xor(amax, o));
        const float qs = amax > 0.f ? amax * (1.0f / 127.0f) : 1.0f, inv = 1.0f / qs;
        const int bias = 0;
        u32x4 w;
#pragma unroll
        for (int j = 0; j < 4; ++j) { const int q0 = (int)rintf(v[j].x * inv) + bias, q1 = (int)rintf(v[j].y * inv) + bias, q2 = (int)rintf(v[j].z * inv) + bias, q3 = (int)rintf(v[j].w * inv) + bias;
            w[j] = (unsigned)(q0 & 255) | ((unsigned)(q1 & 255) << 8) | ((unsigned)(q2 & 255) << 16) | ((unsigned)(q3 & 255) << 24); }
        unsigned char* dst = p.ws + (tb ? OFF_TV : OFF_TU);
        *(u32x4*)(dst + ((size_t)(lane >> 3) * 16384 + e) * 128 + (lane & 7) * 16) = w;
        if (lane == 0) ((float*)(p.ws + (tb ? OFF_SV : OFF_SU)))[e] = qs;
    }
}

#define CE_DESC(a, b) do { const unsigned hi_ = max(a, b), lo_ = min(a, b); a = hi_; b = lo_; } while (0)
template <int N> __device__ __forceinline__ void sort16_desc(unsigned (&k)[N], const int base) {
    CE_DESC(k[base + 0], k[base + 1]); CE_DESC(k[base + 2], k[base + 3]); CE_DESC(k[base + 0], k[base + 2]); CE_DESC(k[base + 1], k[base + 3]); CE_DESC(k[base + 1], k[base + 2]); CE_DESC(k[base + 4], k[base + 5]); CE_DESC(k[base + 6], k[base + 7]); CE_DESC(k[base + 4], k[base + 6]);
    CE_DESC(k[base + 5], k[base + 7]); CE_DESC(k[base + 5], k[base + 6]); CE_DESC(k[base + 0], k[base + 4]); CE_DESC(k[base + 2], k[base + 6]); CE_DESC(k[base + 2], k[base + 4]); CE_DESC(k[base + 1], k[base + 5]); CE_DESC(k[base + 3], k[base + 7]); CE_DESC(k[base + 3], k[base + 5]);
    CE_DESC(k[base + 1], k[base + 2]); CE_DESC(k[base + 3], k[base + 4]); CE_DESC(k[base + 5], k[base + 6]); CE_DESC(k[base + 8], k[base + 9]); CE_DESC(k[base + 10], k[base + 11]); CE_DESC(k[base + 8], k[base + 10]); CE_DESC(k[base + 9], k[base + 11]); CE_DESC(k[base + 9], k[base + 10]);
    CE_DESC(k[base + 12], k[base + 13]); CE_DESC(k[base + 14], k[base + 15]); CE_DESC(k[base + 12], k[base + 14]); CE_DESC(k[base + 13], k[base + 15]); CE_DESC(k[base + 13], k[base + 14]); CE_DESC(k[base + 8], k[base + 12]); CE_DESC(k[base + 10], k[base + 14]); CE_DESC(k[base + 10], k[base + 12]);
    CE_DESC(k[base + 9], k[base + 13]); CE_DESC(k[base + 11], k[base + 15]); CE_DESC(k[base + 11], k[base + 13]); CE_DESC(k[base + 9], k[base + 10]); CE_DESC(k[base + 11], k[base + 12]); CE_DESC(k[base + 13], k[base + 14]); CE_DESC(k[base + 0], k[base + 8]); CE_DESC(k[base + 4], k[base + 12]);
    CE_DESC(k[base + 4], k[base + 8]); CE_DESC(k[base + 2], k[base + 10]); CE_DESC(k[base + 6], k[base + 14]); CE_DESC(k[base + 6], k[base + 10]); CE_DESC(k[base + 2], k[base + 4]); CE_DESC(k[base + 6], k[base + 8]); CE_DESC(k[base + 10], k[base + 12]); CE_DESC(k[base + 1], k[base + 9]);
    CE_DESC(k[base + 5], k[base + 13]); CE_DESC(k[base + 5], k[base + 9]); CE_DESC(k[base + 3], k[base + 11]); CE_DESC(k[base + 7], k[base + 15]); CE_DESC(k[base + 7], k[base + 11]); CE_DESC(k[base + 3], k[base + 5]); CE_DESC(k[base + 7], k[base + 9]); CE_DESC(k[base + 11], k[base + 13]);
    CE_DESC(k[base + 1], k[base + 2]); CE_DESC(k[base + 3], k[base + 4]); CE_DESC(k[base + 5], k[base + 6]); CE_DESC(k[base + 7], k[base + 8]); CE_DESC(k[base + 9], k[base + 10]); CE_DESC(k[base + 11], k[base + 12]); CE_DESC(k[base + 13], k[base + 14]);
}
template <int N> __device__ __forceinline__ void merge16_desc(unsigned (&k)[N], const int a, const int b) {
#pragma unroll
    for (int i = 0; i < 16; ++i) k[a + i] = max(k[a + i], k[b + 15 - i]);
#pragma unroll
    for (int stride = 8; stride > 0; stride /= 2)
#pragma unroll
        for (int i = 0; i < 16; ++i) if ((i & stride) == 0) CE_DESC(k[a + i], k[a + i + stride]);
}
__device__ __forceinline__ float hkey2f(unsigned key) { const unsigned u = key >> 16, b = (u & 0x8000u) ? (u ^ 0x8000u) : (~u & 0xFFFFu); return (float)__builtin_bit_cast(h16, (unsigned short)b); }
__device__ __forceinline__ void top16_of_128(const unsigned char* sc, unsigned (&out)[16]) {
    unsigned s[128];
#pragma unroll
    for (int c8 = 0; c8 < 16; ++c8) { const u32x4 t = *(const u32x4*)(sc + c8 * 1024);
#pragma unroll
        for (int w = 0; w < 4; ++w) { const int e0 = 2 * w, e1 = 2 * w + 1;
            const int col0 = 32 * (c8 >> 2) + 16 * (e0 >> 2) + 4 * (c8 & 3) + (e0 & 3), col1 = 32 * (c8 >> 2) + 16 * (e1 >> 2) + 4 * (c8 & 3) + (e1 & 3);
            s[8 * c8 + e0] = (t[w] << 16) | (unsigned)(127 - col0); s[8 * c8 + e1] = (t[w] & 0xFFFF0000u) | (unsigned)(127 - col1); } }
#pragma unroll
    for (int g = 0; g < 8; ++g) sort16_desc(s, 16 * g);
    merge16_desc(s, 0, 16); merge16_desc(s, 32, 48); merge16_desc(s, 64, 80); merge16_desc(s, 96, 112);
    merge16_desc(s, 0, 32); merge16_desc(s, 64, 96);
    merge16_desc(s, 0, 64);
#pragma unroll
    for (int i = 0; i < 16; ++i) out[i] = s[i];
}
__device__ __forceinline__ void topk_phase(const Params& p, LAS unsigned char* lds) {
    const unsigned char* SC = p.ws + OFF_SC; int* EIDX = (int*)(p.ws + OFF_EIDX); float* GATE = (float*)(p.ws + OFF_GATE);
    LAS unsigned* st = (LAS unsigned*)lds;
    const int tid = threadIdx.x;
#ifndef TOPK_REP
#define TOPK_REP 1
#endif
    for (int rr_ = 0; rr_ < TOPK_REP; ++rr_)
    for (int base = blockIdx.x * 4; base < (T / 64) * 8; base += gridDim.x * 4) {
        {
            const int w = tid >> 6, L = tid & 63, grp = base + (w >> 1), pp = w & 1;
            unsigned ks[16];
#pragma unroll
            for (int i = 0; i < 16; ++i) ks[i] = 0u;
            top16_of_128(SC + ((size_t)(grp * 2 + pp) * 16 * 64 + L) * 16, ks);
#pragma unroll
            for (int i = 0; i < 16; ++i) st[i * NTHREADS + tid] = ks[i];
        }
        __syncthreads();
        if (tid < 256) {
            const int q = tid >> 6, L = tid & 63, grp = base + q, tb = grp >> 3, hh = grp & 7;
            const int th = (tb * 64 + L) * 8 + hh;
            const int s0 = (2 * q) * 64 + L, s1 = (2 * q + 1) * 64 + L;
            float sv1[16];
#pragma unroll
            for (int j = 0; j < 16; ++j) sv1[j] = hkey2f(st[j * NTHREADS + s1]);
            unsigned cv[50];
            { int c = 0;
#pragma unroll
              for (int i = 0; i < 16; ++i) { const float a = hkey2f(st[i * NTHREADS + s0]);
#pragma unroll
                  for (int j = 0; j < 16; ++j) if ((i + 1) * (j + 1) <= 16) { cv[c] = (f2key(a + sv1[j]) & ~255u) | (unsigned)(255 - (i * 16 + j)); ++c; } } }
            unsigned c64[64];
#pragma unroll
            for (int i = 0; i < 64; ++i) c64[i] = (i < 50) ? cv[i] : 0u;
#pragma unroll
            for (int g = 0; g < 4; ++g) sort16_desc(c64, 16 * g);
            merge16_desc(c64, 0, 16); merge16_desc(c64, 32, 48); merge16_desc(c64, 0, 32);
            unsigned ok[16];
#pragma unroll
            for (int i = 0; i < 16; ++i) ok[i] = c64[i];
            float ex[16]; int oe[16]; float den = 0.f;
            const float v0 = key2f(ok[0] & ~255u);
#pragma unroll
            for (int i = 0; i < 16; ++i) { const int ij = 255 - (int)(ok[i] & 255u), ci = ij >> 4, cj = ij & 15;
                const int e0 = 127 - (int)(st[ci * NTHREADS + s0] & 127u), e1 = 127 - (int)(st[cj * NTHREADS + s1] & 127u);
                oe[i] = e0 * 128 + e1; ex[i] = __expf(key2f(ok[i] & ~255u) - v0); den += ex[i]; }
            const float inv = 1.0f / den;
#pragma unroll
            for (int i = 0; i < 4; ++i) {
                *(f32x4*)(GATE + (size_t)th * 16 + 4 * i) = (f32x4){ex[4 * i] * inv, ex[4 * i + 1] * inv, ex[4 * i + 2] * inv, ex[4 * i + 3] * inv};
                *(int4*)(EIDX + (size_t)th * 16 + 4 * i) = make_int4(oe[4 * i], oe[4 * i + 1], oe[4 * i + 2], oe[4 * i + 3]); }
        }
        __syncthreads();
    }
}

struct XcdInfo { int px, npop, rank, nloc; };
__device__ __forceinline__ float dot8(const h16x8 a, const h16x8 b, float s) {
    s = __builtin_amdgcn_fdot2((h16x2){a[0], a[1]}, (h16x2){b[0], b[1]}, s, false); s = __builtin_amdgcn_fdot2((h16x2){a[2], a[3]}, (h16x2){b[2], b[3]}, s, false);
    s = __builtin_amdgcn_fdot2((h16x2){a[4], a[5]}, (h16x2){b[4], b[5]}, s, false); s = __builtin_amdgcn_fdot2((h16x2){a[6], a[7]}, (h16x2){b[6], b[7]}, s, false); return s; }
struct PeerTok { int t; bool ok; };
#define PEER_TOUCH(R) do { unsigned tt_ = (R).w; asm volatile("" : "+v"(tt_)); (R).w = tt_; __builtin_amdgcn_sched_barrier(0); } while (0)
__device__ __forceinline__ PeerTok peer_tok(int i, int t0, int step) { const int t = t0 + i * step; PeerTok r; r.ok = t < T; r.t = r.ok ? t : (T - 1); return r; }
__device__ __forceinline__ void peer_ld_e(const int* EIDX, int t, int g, int (&e)[16]) {
#pragma unroll
    for (int q = 0; q < 4; ++q) { const int4 v = *(const int4*)(EIDX + (size_t)t * 128 + 16 * g + 4 * q); e[4 * q] = v.x; e[4 * q + 1] = v.y; e[4 * q + 2] = v.z; e[4 * q + 3] = v.w; } }
__device__ __forceinline__ void peer_ld_rows(const unsigned char* tab, const int (&e)[16], u32x4 (&r)[16]) {
#pragma unroll
    for (int j = 0; j < 16; ++j) r[j] = *(const u32x4*)(tab + (size_t)e[j] * 128); }
__device__ __forceinline__ void peer_u_compute(const u32x4 (&r)[16], const u32x4 xv, h16* PACT, int s, PeerTok tk, int lane, int g, int c) {
    float pj[16];
#pragma unroll
    for (int j = 0; j < 16; ++j) { int d = __builtin_amdgcn_sdot4((int)r[j].x, (int)xv.x, 0, false); d = __builtin_amdgcn_sdot4((int)r[j].y, (int)xv.y, d, false);
        d = __builtin_amdgcn_sdot4((int)r[j].z, (int)xv.z, d, false); d = __builtin_amdgcn_sdot4((int)r[j].w, (int)xv.w, d, false); pj[j] = (float)d; }
#define RED_STEP(NIN, MASK) _Pragma("unroll") for (int j = 0; j < (NIN) / 2; ++j) { const bool up = (lane & (MASK)) != 0; \
    const float keep = up ? pj[2 * j + 1] : pj[2 * j], send = up ? pj[2 * j] : pj[2 * j + 1]; pj[j] = keep + __shfl_xor(send, (MASK)); }
    RED_STEP(16, 1) RED_STEP(8, 2) RED_STEP(4, 4)
#undef RED_STEP
    { const bool up = (lane & 1) != 0; const float keep = up ? pj[1] : pj[0], send = up ? pj[0] : pj[1], recv = __shfl_xor(send, 1);
      const unsigned w = up ? pk2(recv * 0.015625f, keep * 0.015625f) : pk2(keep * 0.015625f, recv * 0.015625f);
      if (tk.ok) *(unsigned*)(PACT + ((size_t)s * T + tk.t) * 128 + 16 * g + (up ? 7 + c : c)) = w; }
}
__device__ __forceinline__ void peer_u_phase(const Params& p, const XcdInfo xi) {
    const int wave = threadIdx.x >> 6, lane = threadIdx.x & 63, g = lane >> 3, c = lane & 7;
    const unsigned char* QX = (const unsigned char*)(p.ws + OFF_QX); const unsigned char* TU = (const unsigned char*)(p.ws + OFF_TU);
    const int* EIDX = (const int*)(p.ws + OFF_EIDX); h16* PACT = (h16*)(p.ws + OFF_PACT);
    const int t0 = xi.rank * 8 + wave, step = xi.nloc * 8, ntok = (T - t0 + step - 1) / step;
    for (int s = xi.px; s < 8; s += xi.npop) {
        const unsigned char* tus = TU + (size_t)s * 16384 * 128 + 16 * c; const unsigned char* qxs = QX + s * 128 + 16 * c;
        int eN[16]; u32x4 rA[16], rB[16]; u32x4 xA, xB;
        { PeerTok k0 = peer_tok(0, t0, step); peer_ld_e(EIDX, k0.t, g, eN); xA = *(const u32x4*)(qxs + (size_t)k0.t * D); peer_ld_rows(tus, eN, rA);
          PeerTok k1 = peer_tok(1, t0, step); peer_ld_e(EIDX, k1.t, g, eN); }
        for (int i = 0; i < ntok; i += 2) {
            { const PeerTok k1 = peer_tok(i + 1, t0, step), k2 = peer_tok(i + 2, t0, step);
              PEER_TOUCH(rA[15]);
              xB = *(const u32x4*)(qxs + (size_t)k1.t * D); peer_ld_rows(tus, eN, rB); peer_ld_e(EIDX, k2.t, g, eN);
              __builtin_amdgcn_sched_barrier(0);
              peer_u_compute(rA, xA, PACT, s, peer_tok(i, t0, step), lane, g, c);
              __builtin_amdgcn_sched_barrier(0); }
            { const PeerTok k2 = peer_tok(i + 2, t0, step), k3 = peer_tok(i + 3, t0, step);
              PEER_TOUCH(rB[15]);
              xA = *(const u32x4*)(qxs + (size_t)k2.t * D); peer_ld_rows(tus, eN, rA); peer_ld_e(EIDX, k3.t, g, eN);
              __builtin_amdgcn_sched_barrier(0);
              PeerTok k1 = peer_tok(i + 1, t0, step); k1.ok = k1.ok && (i + 1 < ntok);
              peer_u_compute(rB, xB, PACT, s, k1, lane, g, c);
              __builtin_amdgcn_sched_barrier(0); }
        }
    }
}
#ifdef PEER_U_MFMA
#define KIDX kslot
#else
#define KIDX k
#endif
__device__ __forceinline__ void peer_combine(const Params& p) {
    const int wave = threadIdx.x >> 6, lane = threadIdx.x & 63;
    const h16* PACT = (const h16*)(p.ws + OFF_PACT); const float* GATE = (const float*)(p.ws + OFF_GATE); unsigned char* SIDE = p.ws + OFF_SIDE;
    const int* EIDX = (const int*)(p.ws + OFF_EIDX); const float* SU = (const float*)(p.ws + OFF_SU); const float* SV = (const float*)(p.ws + OFF_SV); const float* SX = (const float*)(p.ws + OFF_SX);
    for (int t = blockIdx.x * 8 + wave; t < T; t += gridDim.x * 8) {
        const float sx = SX[t] * 64.0f; float w[2]; float a[2] = {0.f, 0.f}; float amax = 0.f;
#pragma unroll
        for (int s = 0; s < 8; ++s) { const h16x2 v = *(const h16x2*)(PACT + ((size_t)s * T + t) * 128 + 2 * lane); a[0] += (float)v[0]; a[1] += (float)v[1]; }
        const int2 e2 = *(const int2*)(EIDX + (size_t)t * 128 + 2 * lane); const float2 g2 = *(const float2*)(GATE + (size_t)t * 128 + 2 * lane);
        const int e[2] = {e2.x, e2.y}; const float gt[2] = {g2.x, g2.y};
#pragma unroll
        for (int j = 0; j < 2; ++j) {
            const float act = a[j] * sx * SU[e[j]];
            w[j] = gt[j] * (0.5f * act * (1.0f + erff(act * 0.70710678118654752f))) * SV[e[j]];
            amax = fmaxf(amax, fabsf(w[j])); }
#pragma unroll
        for (int o = 32; o >= 1; o >>= 1) amax = fmaxf(amax, __shfl_xor(amax, o));
        const float inv = amax > 0.f ? 16256.0f / amax : 0.f;
        unsigned char* rec = SIDE + (size_t)t * 1024;
        *(int2*)(rec + 8 * lane) = e2;
#pragma unroll
        for (int j = 0; j < 2; ++j) { const int k = 2 * lane + j; const int W = (int)rintf(w[j] * inv); const int hi = W >> 7, lo = W & 127;
            const int y = k >> 4, ks = (k >> 3) & 1, h = (k >> 2) & 1, gk = k & 3, off = 512 + ks * 128 + gk * 16 + 8 * h + y;
            rec[off] = (unsigned char)(hi & 255); rec[off + 64] = (unsigned char)lo; }
        if (lane == 0) *(float*)(rec + 768) = amax * (1.0f / 16256.0f);
    }
}
typedef int i32x4 __attribute__((ext_vector_type(4)));
__device__ __forceinline__ unsigned lds_addr(const volatile LAS void* p) { return (unsigned)(size_t)p; }
__device__ __forceinline__ void glds16_asm(const void* gsrc, unsigned lds_dst) {
    unsigned keep;
    asm volatile("s_mov_b32 %0, m0\n\ts_mov_b32 m0, %2\n\ts_nop 0\n\tglobal_load_lds_dwordx4 %1, off\n\ts_mov_b32 m0, %0" : "=&s"(keep) : "v"(gsrc), "s"(lds_dst) : "memory");
}
#define PV_WAIT_VM(n) asm volatile("s_waitcnt vmcnt(" #n ")" ::: "memory")
__device__ __forceinline__ void pv_fill(const unsigned char* tvs, LAS unsigned char* lds, unsigned side_slot, unsigned ring_buf, const int ks, int lane) {
    const int g = lane >> 3;
    const u32x4 i0 = *(LAS u32x4*)(lds + side_slot + (16 * g + 8 * ks) * 4), i1 = *(LAS u32x4*)(lds + side_slot + (16 * g + 8 * ks + 4) * 4);
    const unsigned ids[8] = {i0.x, i0.y, i0.z, i0.w, i1.x, i1.y, i1.z, i1.w};
#pragma unroll
    for (int m = 0; m < 8; ++m) glds16_asm(tvs + (size_t)ids[m] * 128 + ((((lane & 7) ^ g ^ (m & 1))) << 4), ring_buf + m * 1024);
}
__device__ __forceinline__ void pv_kstep(LAS unsigned char* lds, unsigned ring_buf, const i32x4 afrag, i32x4 (&acc)[8], int lane) {
    const int gk = lane >> 4, q = (lane & 15) >> 1, pp = lane & 1;
    const unsigned base0 = ring_buf + (8 * gk + q) * 128 + 8 * pp;
    const int xr = q ^ (gk & 1);
#pragma unroll
    for (int ng = 0; ng < 2; ++ng) {
        u32x2 r[8];
#pragma unroll
        for (int j = 0; j < 4; ++j) { const int n = 4 * ng + j;
#pragma unroll
            for (int h = 0; h < 2; ++h) { const unsigned a = base0 + h * 4096 + (((unsigned)(n ^ xr)) << 4);
                asm volatile("ds_read_b64_tr_b8 %0, %1" : "=v"(r[2 * j + h]) : "v"(a) : "memory"); } }
        asm volatile("s_waitcnt lgkmcnt(0)" : "+v"(r[0]), "+v"(r[1]), "+v"(r[2]), "+v"(r[3]), "+v"(r[4]), "+v"(r[5]), "+v"(r[6]), "+v"(r[7]) :: "memory");
        __builtin_amdgcn_sched_barrier(0);
#pragma unroll
        for (int j = 0; j < 4; ++j) { const i32x4 bf = (i32x4){(int)r[2 * j].x, (int)r[2 * j].y, (int)r[2 * j + 1].x, (int)r[2 * j + 1].y};
            acc[4 * ng + j] = __builtin_amdgcn_mfma_i32_16x16x64_i8(afrag, bf, acc[4 * ng + j], 0, 0, 0); }
    }
}
__device__ __forceinline__ void peer_v_phase(const Params& p, LAS unsigned char* lds, const XcdInfo xi) {
    const int wave = __builtin_amdgcn_readfirstlane(threadIdx.x >> 6), lane = threadIdx.x & 63;
    const unsigned char* TV = p.ws + OFF_TV; const unsigned char* SIDE = p.ws + OFF_SIDE; h16* PO = (h16*)(p.ws + OFF_PO);
    const int t0 = xi.rank * 8 + wave, step = xi.nloc * 8, ntok = (T - t0 + step - 1) / step;
    const unsigned ring = __builtin_amdgcn_readfirstlane(lds_addr(lds + wave * 16384)), side = __builtin_amdgcn_readfirstlane(lds_addr(lds + 131072 + wave * 3072));
    LAS unsigned char* l0 = (LAS unsigned char*)0;
    for (int s = xi.px; s < 8; s += xi.npop) {
        const unsigned char* tvs = TV + (size_t)s * 16384 * 128;
        glds16_asm(SIDE + (size_t)peer_tok(0, t0, step).t * 1024 + lane * 16, side);
        glds16_asm(SIDE + (size_t)peer_tok(1, t0, step).t * 1024 + lane * 16, side + 1024);
        PV_WAIT_VM(0);
        pv_fill(tvs, l0, side, ring, 0, lane); pv_fill(tvs, l0, side, ring + 8192, 1, lane);
        for (int i = 0; i < ntok; ++i) {
            const unsigned sl_cur = side + (unsigned)(i % 3) * 1024, sl_nxt = side + (unsigned)((i + 1) % 3) * 1024, sl_nn = side + (unsigned)((i + 2) % 3) * 1024;
            i32x4 acc[8];
#pragma unroll
            for (int n = 0; n < 8; ++n) acc[n] = (i32x4){0, 0, 0, 0};
            if (i == 0) PV_WAIT_VM(8); else PV_WAIT_VM(16);
            const int fi = lane & 15;
            const i32x4 z4 = (i32x4){0, 0, 0, 0};
            i32x4 af = *(LAS i32x4*)(l0 + sl_cur + 512 + (fi < 2 ? fi : 0) * 64 + (lane >> 4) * 16); af = fi < 2 ? af : z4;
            pv_kstep(l0, ring, af, acc, lane);
            glds16_asm(SIDE + (size_t)peer_tok(i + 2, t0, step).t * 1024 + lane * 16, sl_nn);
            pv_fill(tvs, l0, sl_nxt, ring, 0, lane);
            PV_WAIT_VM(9);
            af = *(LAS i32x4*)(l0 + sl_cur + 512 + 128 + (fi < 2 ? fi : 0) * 64 + (lane >> 4) * 16); af = fi < 2 ? af : z4;
            pv_kstep(l0, ring + 8192, af, acc, lane);
            const float sw = *(LAS float*)(l0 + sl_cur + 768);
            const PeerTok tk = peer_tok(i, t0, step);
            h16* po = PO + (size_t)(tk.ok ? tk.t : T) * D + s * 128 + (lane & 15);
            if (lane < 16) {
#pragma unroll
                for (int n = 0; n < 8; ++n) { const h16 v = (h16)((float)(128 * acc[n][0] + acc[n][1]) * sw); const unsigned vb = (unsigned)__builtin_bit_cast(unsigned short, v);
                    asm volatile("global_store_short %0, %1, off" :: "v"(po + 16 * n), "v"(vb) : "memory"); }
            }
            pv_fill(tvs, l0, sl_nxt, ring + 8192, 1, lane);
        }
        PV_WAIT_VM(0);
    }
}
__device__ __forceinline__ void pu_buffer(LAS unsigned char* l0, unsigned ring_buf, unsigned side_slot, i32x4 (&acc)[4], int lane) {
    const int i = lane & 15, gk = lane >> 4;
#pragma unroll
    for (int kc = 0; kc < 2; ++kc) {
        i32x4 bx = *(LAS i32x4*)(l0 + side_slot + 512 + 64 * kc + 16 * gk); bx = (i == 0) ? bx : (i32x4){0, 0, 0, 0};
#pragma unroll
        for (int mt = 0; mt < 4; ++mt) { const int r = 16 * mt + i;
            const i32x4 af = *(LAS i32x4*)(l0 + ring_buf + r * 128 + ((((4 * kc + gk) ^ (r & 7) ^ ((r >> 3) & 1))) << 4));
            acc[mt] = __builtin_amdgcn_mfma_i32_16x16x64_i8(af, bx, acc[mt], 0, 0, 0); }
    }
}
__device__ __forceinline__ void peer_u_phase_mfma(const Params& p, LAS unsigned char* lds, const XcdInfo xi) {
    const int wave = __builtin_amdgcn_readfirstlane(threadIdx.x >> 6), lane = threadIdx.x & 63;
    const unsigned char* TU = p.ws + OFF_TU; const unsigned char* QX = p.ws + OFF_QX; const unsigned char* EIDX = p.ws + OFF_EIDX; float* PACT = (float*)(p.ws + OFF_PACT);
    const int t0 = xi.rank * 8 + wave, step = xi.nloc * 8, ntok = (T - t0 + step - 1) / step;
    const unsigned ring = __builtin_amdgcn_readfirstlane(lds_addr(lds + wave * 16384)), side = __builtin_amdgcn_readfirstlane(lds_addr(lds + 131072 + wave * 3072));
    LAS unsigned char* l0 = (LAS unsigned char*)0;
    for (int s = xi.px; s < 8; s += xi.npop) {
        const unsigned char* tus = TU + (size_t)s * 16384 * 128;
#define PU_SIDE(tt, dst) glds16_asm(lane < 32 ? (const void*)(EIDX + (size_t)(tt) * 512 + lane * 16) : (const void*)(QX + (size_t)(tt) * D + s * 128 + ((lane & 7) * 16)), dst)
        PU_SIDE(peer_tok(0, t0, step).t, side);
        PU_SIDE(peer_tok(1, t0, step).t, side + 1024);
        PV_WAIT_VM(0);
        pv_fill(tus, l0, side, ring, 0, lane); pv_fill(tus, l0, side, ring + 8192, 1, lane);
        for (int i = 0; i < ntok; ++i) {
            const unsigned sl_cur = side + (unsigned)(i % 3) * 1024, sl_nxt = side + (unsigned)((i + 1) % 3) * 1024, sl_nn = side + (unsigned)((i + 2) % 3) * 1024;
            i32x4 acc0[4], acc1[4];
#pragma unroll
            for (int n = 0; n < 4; ++n) { acc0[n] = (i32x4){0, 0, 0, 0}; acc1[n] = (i32x4){0, 0, 0, 0}; }
            if (i == 0) PV_WAIT_VM(8); else PV_WAIT_VM(16);
            pu_buffer(l0, ring, sl_cur, acc0, lane);
            PU_SIDE(peer_tok(i + 2, t0, step).t, sl_nn);
            pv_fill(tus, l0, sl_nxt, ring, 0, lane);
            PV_WAIT_VM(9);
            pu_buffer(l0, ring + 8192, sl_cur, acc1, lane);
            const PeerTok tk = peer_tok(i, t0, step);
            float* po = PACT + ((size_t)s * T + (tk.ok ? tk.t : 0)) * 128 + 4 * (lane >> 4);
            if ((lane & 15) == 0) {
#pragma unroll
                for (int mt = 0; mt < 4; ++mt) {
                    const f32x4 v0 = (f32x4){(float)acc0[mt][0], (float)acc0[mt][1], (float)acc0[mt][2], (float)acc0[mt][3]}, v1 = (f32x4){(float)acc1[mt][0], (float)acc1[mt][1], (float)acc1[mt][2], (float)acc1[mt][3]};
                    float* d0 = tk.ok ? po + 16 * mt : (float*)(p.ws + OFF_PO) , *d1 = tk.ok ? po + 64 + 16 * mt : (float*)(p.ws + OFF_PO);
                    asm volatile("global_store_dwordx4 %0, %1, off\n\ts_nop 1" :: "v"(d0), "v"(v0) : "memory");
                    asm volatile("global_store_dwordx4 %0, %1, off\n\ts_nop 1" :: "v"(d1), "v"(v1) : "memory"); }
            }
            pv_fill(tus, l0, sl_nxt, ring + 8192, 1, lane);
        }
        PV_WAIT_VM(0);
#undef PU_SIDE
    }
}
__device__ __forceinline__ void peer_final(const Params& p) {
    const int wave = threadIdx.x >> 6, lane = threadIdx.x & 63;
    float* OUT = p.out; const h16* H16 = (const h16*)(p.ws + OFF_H16); const h16* PO = (const h16*)(p.ws + OFF_PO); const float* mod = (const float*)(p.ws + OFF_MOD); const float* fg = p.in[19];
    for (int t0 = (blockIdx.x * 8 + wave) * 2; t0 < T; t0 += gridDim.x * 16) {
        h16x4 hv[2][4], ph[2][4];
#pragma unroll
        for (int q = 0; q < 2; ++q)
#pragma unroll
            for (int j = 0; j < 4; ++j) { const int cc = j * 256 + lane * 4; hv[q][j] = *(const h16x4*)(H16 + (size_t)(t0 + q) * D + cc); ph[q][j] = *(const h16x4*)(PO + (size_t)(t0 + q) * D + cc); }
        f32x4 gv4[4], fv4[4];
#pragma unroll
        for (int j = 0; j < 4; ++j) { const int cc = j * 256 + lane * 4; gv4[j] = *(const f32x4*)(mod + (t0 >> 12) * 6144 + 5120 + cc); fv4[j] = *(const f32x4*)(fg + cc); }
        __builtin_amdgcn_sched_barrier(0);
#pragma unroll
        for (int q = 0; q < 2; ++q) { const int t = t0 + q;
            f32x4 h2[4]; float ss = 0.f;
#pragma unroll
            for (int j = 0; j < 4; ++j) {
                const f32x4 pv = (f32x4){(float)ph[q][j][0], (float)ph[q][j][1], (float)ph[q][j][2], (float)ph[q][j][3]}, gv = gv4[j];
                h2[j] = (f32x4){(float)hv[q][j][0], (float)hv[q][j][1], (float)hv[q][j][2], (float)hv[q][j][3]} + gv * pv; ss += h2[j].x * h2[j].x + h2[j].y * h2[j].y + h2[j].z * h2[j].z + h2[j].w * h2[j].w; }
            ss = wave_sum(ss);
            const float rstd = rsqrtf(ss * (1.0f / D) + EPS);
#pragma unroll
            for (int j = 0; j < 4; ++j) { const int cc = j * 256 + lane * 4; const f32x4 fv = fv4[j];
                *(f32x4*)(OUT + (size_t)t * D + cc) = h2[j] * rstd * fv; }
        }
    }
}
#ifndef REP_A
#define REP_A 1
#endif
#ifndef REP_FT
#define REP_FT 1
#endif
#ifndef REP_DFT
#define REP_DFT 1
#endif
#ifndef REP_GATE
#define REP_GATE 1
#endif
#ifndef REP_M2
#define REP_M2 1
#endif
#ifndef REP_M1
#define REP_M1 1
#endif
#ifndef REP_SC
#define REP_SC 1
#endif
constexpr int N_PHASES = 15;
#ifndef MK_CGSYNC
#define MK_CGSYNC 0
#endif
__device__ __forceinline__ Params load_params(volatile LAS unsigned* pw) {
    Params q;
    unsigned long long v[22];
#pragma unroll
    for (int i = 0; i < 22; ++i) { const unsigned lo = (unsigned)__builtin_amdgcn_readfirstlane((int)pw[2 * i]), hi = (unsigned)__builtin_amdgcn_readfirstlane((int)pw[2 * i + 1]); v[i] = ((unsigned long long)hi << 32) | lo; }
#pragma unroll
    for (int i = 0; i < 20; ++i) q.in[i] = (const float*)v[i];
    q.out = (float*)v[20]; q.ws = (unsigned char*)v[21];
    q.ph_lo = __builtin_amdgcn_readfirstlane((int)pw[44]); q.ph_hi = __builtin_amdgcn_readfirstlane((int)pw[45]);
    return q;
}
__global__ void __launch_bounds__(NTHREADS, 2) mega(Params pk) {
    extern __shared__ __attribute__((aligned(16))) unsigned char smem[];
    LAS unsigned char* lds = (LAS unsigned char*)smem;
    const int G = gridDim.x, c = blockIdx.x;
    volatile LAS unsigned* pw = (volatile LAS unsigned*)(lds + LDS_BYTES - 512);
    if (threadIdx.x == 0) {
#pragma unroll
        for (int i = 0; i < 20; ++i) { const unsigned long long v = (unsigned long long)pk.in[i]; pw[2 * i] = (unsigned)v; pw[2 * i + 1] = (unsigned)(v >> 32); }
        { const unsigned long long v = (unsigned long long)pk.out; pw[40] = (unsigned)v; pw[41] = (unsigned)(v >> 32); }
        { const unsigned long long v = (unsigned long long)pk.ws; pw[42] = (unsigned)v; pw[43] = (unsigned)(v >> 32); }
        pw[44] = (unsigned)pk.ph_lo; pw[45] = (unsigned)pk.ph_hi;
    }
    unsigned* ctl = (unsigned*)(pk.ws + OFF_CTL);
    volatile LAS unsigned* misc = (volatile LAS unsigned*)(lds + LDS_BYTES - 64);
    if (threadIdx.x < 16) misc[threadIdx.x] = 0u;
    __syncthreads();
    const bool fused = (pk.ph_hi - pk.ph_lo) > 1;
    XcdBarrier bar; bar.bar = ctl; bar.x = 0; bar.st = misc;
    if (fused) {
        bar = xcd_barrier_post(ctl, misc);
        if (threadIdx.x == 0) misc[2] = xb_add(&ctl[CTL_RANK + 64 * bar.x], 1u);
    }
#define IN(k) (ph_lo <= (k) && (k) < ph_hi)
#if MK_CGSYNC
#define SEAM(k) do { if (IN(k) && IN((k) + 1)) { cg::grid_group grid = cg::this_grid(); grid.sync(); } } while (0)
#else
#define SEAM(k) do { if (IN(k) && IN((k) + 1)) xcd_barrier(bar); } while (0)
#endif
#define PHASE_BEGIN(k) if (IN(k)) { const Params p = load_params(pw); unsigned char* const ws = p.ws; (void)ws;
#define PHASE_END(k) } SEAM(k);
    const int ph_lo = pk.ph_lo, ph_hi = pk.ph_hi;
    PHASE_BEGIN(0) phase0(p, lds); PHASE_END(0)
    PHASE_BEGIN(1)
        const float* mod = (const float*)(ws + OFF_MOD);
        modulate_rows<false>(p.in[0], (h16*)(ws + OFF_UALL), T, p.in[6], mod, 0, 1024, 0, c, G);
        modulate_rows<false>(p.in[2], (h16*)(ws + OFF_UALL) + (size_t)T * D, TC, p.in[6], mod, 0, 1024, 1, c, G);
    PHASE_END(1)
    PHASE_BEGIN(2)
        { pg8::Gemm g{ws + OFF_UALL, ws + OFF_WA, 1024, 1024, 1024}; OrderA S; S.init(G, c, REP_A); EpiA E{ws}; pg8::gemm_phase(lds, g, S, E); }
        { pg8::Gemm g{ws + OFF_UALL, ws + OFF_WF, 1024, 1024, 1024}; pg8::TileOrder S; S.init(128, 4, G, c, REP_FT); EpiFT E{ws}; pg8::gemm_phase(lds, g, S, E); }
        if (G > 96) { if (c >= 48) convert_tables(p, c - 48, G - 48); } else convert_tables(p, c, G);
    PHASE_END(2)
    PHASE_BEGIN(3) for (int it = blockIdx.x; it < 192; it += gridDim.x) hgrn_mfma_unit<false>(p, lds, it / 3, it % 3);
        fft1_phase(p, lds); PHASE_END(3)
    PHASE_BEGIN(4) for (int it = blockIdx.x; it < 256; it += gridDim.x) hgrn_mfma_unit<true>(p, lds, it >> 2, it & 3); PHASE_END(4)
    PHASE_BEGIN(5)
        const bool mem_first = ((c >> 3) & 1) == 0;
        if (mem_first) a1_prepass(p);
        { pg8::Gemm g{ws + OFF_DFT256, ws + OFF_Y1, 512, 512, 512}; pg8::TileOrder S; S.init(1, 256, G, c, REP_DFT); EpiDFT E{ws}; pg8::gemm_phase(lds, g, S, E); }
        { pg8::Gemm g{ws + OFF_UALL, ws + OFF_WG, 1024, 1024, 1024}; pg8::TileOrder S; S.init(128, 8, G, c, REP_GATE); EpiGate E{ws}; pg8::gemm_phase(lds, g, S, E); }
        if (!mem_first) a1_prepass(p);
    PHASE_END(5)
    PHASE_BEGIN(6)
        if (G >= 16 && (G & 15) == 0) { if ((c >> 3) & 1) scale_wout(p, ((c >> 4) << 3) | (c & 7), G >> 1); } else scale_wout(p, c, G);
        { pg8::Gemm g{ws + OFF_G, ws + OFF_WHG, 512, 512, 512}; pg8::TileOrder S; S.init(128, 4, G, c, REP_M1); EpiMerge1<false> E{ws}; pg8::gemm_phase(lds, g, S, E); }
        { pg8::Gemm g{ws + OFF_YFT, ws + OFF_WFT, 512, 512, 512}; pg8::TileOrder S; S.init(128, 4, G, c); EpiMerge1<true> E{ws}; pg8::gemm_phase(lds, g, S, E); }
    PHASE_END(6)
    PHASE_BEGIN(7)
        pg8::Gemm g{ws + OFF_Y, ws + OFF_WOUTG, 1024, 1024, 1024}; pg8::TileOrder S; S.init(128, 4, G, c, REP_M2);
        EpiMerge2 E; E.x = p.in[0]; E.H = (h16*)(ws + OFF_H16); pg8::gemm_phase(lds, g, S, E);
    PHASE_END(7)
    PHASE_BEGIN(8) modulate_rows<true>(ws + OFF_H16, (h16*)(ws + OFF_U2), T, p.in[7], (const float*)(ws + OFF_MOD), 3072, 4096, 0, c, G, (signed char*)(ws + OFF_QX), (float*)(ws + OFF_SX)); PHASE_END(8)
    PHASE_BEGIN(9)
        pg8::Gemm g{ws + OFF_U2, ws + OFF_WS, 1024, 1024, 1024}; pg8::TileOrder S; S.init(128, 8, G, c, REP_SC);
#ifdef STAGGER_US
        if (c & 8) { const unsigned long long t0_ = __builtin_amdgcn_s_memrealtime(); while (__builtin_amdgcn_s_memrealtime() - t0_ < (unsigned long long)(STAGGER_US * 100)) __builtin_amdgcn_s_sleep(8); }
#endif
        EpiScores E; E.C = ws + OFF_SC; pg8::gemm_phase(lds, g, S, E);
    PHASE_END(9)
    PHASE_BEGIN(10) topk_phase(p, lds); PHASE_END(10)
    XcdInfo xi;
    if (fused) {
        unsigned cnt[8]; int npop = 0, px = 0;
#pragma unroll
        for (int j = 0; j < 8; ++j) { cnt[j] = xb_ld(&ctl[CTL_RANK + 64 * j]); if (j < (int)(bar.x & 7u)) px += (cnt[j] > 0u); npop += (cnt[j] > 0u); }
        xi.px = px; xi.npop = npop > 0 ? npop : 1; xi.rank = (int)misc[2]; xi.nloc = (int)cnt[bar.x & 7u]; if (xi.nloc < 1) xi.nloc = 1;
    } else { xi.px = c & 7; xi.npop = 8; xi.rank = c >> 3; xi.nloc = G >> 3; }
    #ifdef PEER_U_MFMA
    PHASE_BEGIN(11) peer_u_phase_mfma(p, lds, xi); PHASE_END(11)
#else
    PHASE_BEGIN(11) peer_u_phase(p, xi); PHASE_END(11)
#endif
    PHASE_BEGIN(12) peer_combine(p); PHASE_END(12)
    PHASE_BEGIN(13) peer_v_phase(p, lds, xi); PHASE_END(13)
    PHASE_BEGIN(14) peer_final(p); }
#undef IN
#undef SEAM
#undef PHASE_BEGIN
#undef PHASE_END
}

#ifndef MK_SINGLE
#define MK_SINGLE 1
#endif
extern "C" void kernel_launch(void* const* d_in, const int* in_sizes, int n_in, void* d_out, int out_size, void* d_ws, size_t ws_size, hipStream_t stream) {
    static int grid = 0;
    if (grid == 0) {
        if (n_in != 20 || out_size != T * D || ws_size < WS_NEED) { fprintf(stderr, "kernel_launch: unexpected shapes (n_in %d out %d ws %zu)\n", n_in, out_size, ws_size); grid = -1; return; }
        int dev = 0, cus = 0, per_cu = 0;
        hipGetDevice(&dev); hipDeviceGetAttribute(&cus, hipDeviceAttributeMultiprocessorCount, dev);
        if (hipFuncSetAttribute((const void*)mega, hipFuncAttributeMaxDynamicSharedMemorySize, LDS_BYTES) != hipSuccess) { fprintf(stderr, "kernel_launch: hipFuncSetAttribute failed\n"); grid = -1; return; }
        hipOccupancyMaxActiveBlocksPerMultiprocessor(&per_cu, (const void*)mega, NTHREADS, LDS_BYTES);
        if (per_cu < 1) { fprintf(stderr, "kernel_launch: occupancy query says %d blocks per CU\n", per_cu); grid = -1; return; }
        grid = cus;
    }
    if (grid < 0) return;
    if (hipMemsetAsync((char*)d_ws + OFF_CTL, 0, CTL_ZERO_BYTES, stream) != hipSuccess) { fprintf(stderr, "kernel_launch: memset failed\n"); return; }
    Params p{};
    for (int i = 0; i < 20; ++i) p.in[i] = (const float*)d_in[i];
    p.out = (float*)d_out; p.ws = (unsigned char*)d_ws;
#if MK_SINGLE
    p.ph_lo = 0; p.ph_hi = N_PHASES;
    void* args[] = {&p};
    hipError_t e = hipLaunchCooperativeKernel((const void*)mega, dim3(grid), dim3(NTHREADS), args, LDS_BYTES, stream);
    if (e != hipSuccess) fprintf(stderr, "cooperative launch failed: %s (grid %d)\n", hipGetErrorString(e), grid);
#else
    for (int ph = 0; ph < N_PHASES; ++ph) { p.ph_lo = ph; p.ph_hi = ph + 1; hipLaunchKernelGGL(mega, dim3(grid), dim3(NTHREADS), LDS_BYTES, stream, p); }
#endif
}
```

```cpp
#include <hip/hip_runtime.h>
#include <hip/hip_cooperative_groups.h>
#include <cstdio>
#include <cstdint>
namespace cg = cooperative_groups;
#define LAS __attribute__((address_space(3)))
namespace pg8 {
#define PG8_LAS __attribute__((address_space(3)))
typedef _Float16 f16x8 __attribute__((ext_vector_type(8)));
typedef float f32x4 __attribute__((ext_vector_type(4)));
typedef unsigned u32x4 __attribute__((ext_vector_type(4)));
typedef unsigned u32x2 __attribute__((ext_vector_type(2)));
constexpr int BM = 256, BK = 64, HALF = 128, HTB = HALF * BK * 2, STAGE_BYTES = 8 * HTB, NXCD = 8, WGM = 8;

__host__ __device__ __forceinline__ int lds_byte(int r, int c) { const int st = (r >> 4) * 2 + (c >> 5), rr = r & 15, cc = c & 31, ob = rr * 64 + cc * 2; return st * 1024 + (ob ^ (((ob >> 9) & 1) << 5)); }
__host__ __device__ __forceinline__ void stage_rc(int b, int& R, int& C) { const int st = b / 1024, sb = b % 1024, swz = sb ^ (((sb >> 9) & 1) << 5); R = (st >> 1) * 16 + swz / 64; C = (st & 1) * 32 + (swz % 64) / 2; }
__host__ __device__ __forceinline__ int perm32(int rho) { const int n = rho >> 4, i = rho & 15; return 8 * (i >> 2) + 4 * n + (i & 3); }

struct Unit { int pm, pn; };
struct Gemm { const void* A; const void* Bt; int lda, ldb, K; };

struct TileOrder {
    int nM, nN, nwg, G, c, rep;
    __device__ void init(int nM_, int nN_, int G_, int c_, int rep_ = 1) { nM = nM_; nN = nN_; nwg = nM * nN; G = G_; c = c_; rep = rep_; }
    __device__ bool map(long L, Unit& u) const {
        if (L >= nwg) return false;
        int wgid = (int)L; { const int q = nwg / NXCD, r = nwg % NXCD, xcd = wgid % NXCD, off = wgid / NXCD; wgid = (xcd < r ? xcd * (q + 1) : r * (q + 1) + (xcd - r) * q) + off; }
        const int nig = WGM * nN, gid = wgid / nig, fm = gid * WGM, gsz = (nM - fm) < WGM ? (nM - fm) : WGM;
        u.pm = fm + ((wgid % nig) % gsz); u.pn = (wgid % nig) / gsz; return true;
    }
    __device__ bool next(int i, Unit& u) const { const long L = (long)i * G + c; if (L >= (long)nwg * rep) return false; return map(L % nwg, u); }
};

template <class Epi, class Sched>
__device__ __forceinline__ void gemm_phase(PG8_LAS unsigned char* lds, const Gemm g, const Sched& S, const Epi& E) {
    const int tid = threadIdx.x, wid = __builtin_amdgcn_readfirstlane(tid >> 6), lane = tid & 63, wr = wid >> 2, wc = wid & 3, fr = lane & 15, fq = lane >> 4;
    const int K = g.K, nt = K / BK;
    unsigned voffA[2], voffB[2];
#pragma unroll
    for (int i = 0; i < 2; ++i) { int R, C; stage_rc(tid * 16 + i * 8192, R, C); const int Rb = Epi::PERM ? ((R & ~31) + perm32(R & 31)) : R;
        voffA[i] = (unsigned)(R * g.lda + C) * 2u; voffB[i] = (unsigned)(Rb * g.ldb + C) * 2u; }
    const size_t kstep = (size_t)(BK * 2);
    const size_t hstepA = (size_t)HALF * g.lda * 2, hstepB = (size_t)HALF * g.ldb * 2;
    const size_t tstepA = 2 * hstepA, tstepB = 2 * hstepB;
    const unsigned ldsw = (unsigned)wid * 1024u;
    const int aoff = lds_byte(wr * 64 + fr, fq * 8), boff = lds_byte(wc * 32 + fr, fq * 8);
#define PG8_SA(b, h) (((b) * 2 + (h)) * HTB)
#define PG8_SB(b, h) ((4 + (b) * 2 + (h)) * HTB)
#define PG8_STAGE(bufoff, gbase, voff) do { _Pragma("unroll") for (int _i = 0; _i < 2; ++_i) \
        __builtin_amdgcn_global_load_lds((const unsigned*)((const char*)(gbase) + (voff)[_i]), (PG8_LAS unsigned*)(lds + (bufoff) + ldsw + _i * 8192), 16, 0, 0); } while (0)
#define PG8_LDA(dst, b, h) do { _Pragma("unroll") for (int m = 0; m < 4; ++m) _Pragma("unroll") for (int k = 0; k < 2; ++k) dst[m][k] = *(const PG8_LAS f16x8*)(lds + PG8_SA(b, h) + aoff + m * 2048 + k * 1024); } while (0)
#define PG8_LDB(dst, b, h) do { _Pragma("unroll") for (int n = 0; n < 2; ++n) _Pragma("unroll") for (int k = 0; k < 2; ++k) dst[n][k] = *(const PG8_LAS f16x8*)(lds + PG8_SB(b, h) + boff + n * 2048 + k * 1024); } while (0)
#define PG8_MMA(ai, bj, At, Bt) do { __builtin_amdgcn_s_setprio(1); _Pragma("unroll") for (int m = 0; m < 4; ++m) _Pragma("unroll") for (int n = 0; n < 2; ++n) _Pragma("unroll") for (int k = 0; k < 2; ++k) \
        acc[ai][bj][m][n] = Epi::TRANS ? __builtin_amdgcn_mfma_f32_16x16x32_f16(Bt[n][k], At[m][k], acc[ai][bj][m][n], 0, 0, 0) \
                                       : __builtin_amdgcn_mfma_f32_16x16x32_f16(At[m][k], Bt[n][k], acc[ai][bj][m][n], 0, 0, 0); __builtin_amdgcn_s_setprio(0); } while (0)
#define PG8_WAIT_V(n) asm volatile("s_waitcnt vmcnt(" #n ")" ::: "memory")
#define PG8_WAIT_L(n) asm volatile("s_waitcnt lgkmcnt(" #n ")" ::: "memory")
#define PG8_WAIT_VN(n) asm volatile("s_waitcnt vmcnt(%0)" :: "n"(n) : "memory")
#define PG8_BAR __builtin_amdgcn_s_barrier()
#define PG8_SCHED __builtin_amdgcn_sched_barrier(0)
    Unit cur, nxt; int ui = 0;
    if (!S.next(0, cur)) return;
    f32x4 acc[2][2][4][2];
#pragma unroll
    for (int a = 0; a < 2; ++a)
#pragma unroll
        for (int b = 0; b < 2; ++b)
#pragma unroll
            for (int m = 0; m < 4; ++m)
#pragma unroll
                for (int n = 0; n < 2; ++n) acc[a][b][m][n] = (f32x4){0.f, 0.f, 0.f, 0.f};
    f16x8 At[4][2], B0[2][2], B1[2][2];
    const char* cA = (const char*)g.A + (size_t)cur.pm * tstepA; const char* cB = (const char*)g.Bt + (size_t)cur.pn * tstepB + E.boff(cur);
    E.init(acc, cur, wr, wc, fr, fq);
    PG8_STAGE(PG8_SB(0, 0), cB, voffB); PG8_STAGE(PG8_SA(0, 0), cA, voffA); PG8_STAGE(PG8_SB(0, 1), cB + hstepB, voffB); PG8_STAGE(PG8_SA(0, 1), cA + hstepA, voffA);
    if (wr == 1) PG8_BAR;
    PG8_WAIT_V(4); PG8_BAR;
    PG8_STAGE(PG8_SB(1, 0), cB + kstep, voffB); PG8_STAGE(PG8_SA(1, 0), cA + kstep, voffA); PG8_STAGE(PG8_SB(1, 1), cB + hstepB + kstep, voffB); PG8_STAGE(PG8_SA(1, 1), cA + hstepA + kstep, voffA);
    PG8_WAIT_V(8); PG8_BAR;
    for (;;) {
        const bool has_next = S.next(ui + 1, nxt);
        const char* nA = has_next ? (const char*)g.A + (size_t)nxt.pm * tstepA : cA; const char* nB = has_next ? (const char*)g.Bt + (size_t)nxt.pn * tstepB + E.boff(nxt) : cB;
        for (int t = 0; t < nt; t += 2) {
            const bool last = (t == nt - 2);
            const char* a2 = last ? nA : cA + (size_t)(t + 2) * kstep; const char* b2 = last ? nB : cB + (size_t)(t + 2) * kstep;
            const char* a3 = a2 + kstep; const char* b3 = b2 + kstep;
            PG8_LDB(B0, 0, 0); PG8_SCHED; PG8_LDA(At, 0, 0);
            PG8_WAIT_L(8); PG8_BAR; PG8_WAIT_L(0); PG8_MMA(0, 0, At, B0); PG8_BAR; PG8_SCHED;
            PG8_LDB(B1, 0, 1); PG8_STAGE(PG8_SB(0, 0), b2, voffB);
            PG8_BAR; PG8_WAIT_L(0); PG8_MMA(0, 1, At, B1); PG8_BAR;
            PG8_LDA(At, 0, 1); PG8_STAGE(PG8_SA(0, 0), a2, voffA);
            PG8_BAR; PG8_WAIT_L(0); PG8_MMA(1, 0, At, B0); PG8_BAR; PG8_SCHED;
            PG8_STAGE(PG8_SB(0, 1), b2 + hstepB, voffB);
            { const int lax_ = __builtin_amdgcn_readfirstlane((int)((t == 0) & (ui != 0)));
              asm volatile("s_cmp_eq_u32 %0, 0\n\ts_cbranch_scc1 1f\n\ts_waitcnt vmcnt(%1)\n\ts_branch 2f\n1:\n\ts_waitcnt vmcnt(6)\n2:" :: "s"(lax_), "n"(6 + Epi::NST) : "memory", "scc"); }
            PG8_BAR; PG8_MMA(1, 1, At, B1); PG8_BAR;
            PG8_LDB(B0, 1, 0); PG8_SCHED; PG8_LDA(At, 1, 0); PG8_STAGE(PG8_SA(0, 1), a2 + hstepA, voffA);
            PG8_WAIT_L(8); PG8_BAR; PG8_WAIT_L(0); PG8_MMA(0, 0, At, B0); PG8_BAR; PG8_SCHED;
            PG8_LDB(B1, 1, 1); PG8_STAGE(PG8_SB(1, 0), b3, voffB);
            PG8_BAR; PG8_WAIT_L(0); PG8_MMA(0, 1, At, B1); PG8_BAR;
            PG8_LDA(At, 1, 1); PG8_STAGE(PG8_SA(1, 0), a3, voffA);
            PG8_BAR; PG8_WAIT_L(0); PG8_MMA(1, 0, At, B0); PG8_BAR; PG8_SCHED;
            PG8_STAGE(PG8_SB(1, 1), b3 + hstepB, voffB);
            PG8_WAIT_V(6); PG8_BAR; PG8_MMA(1, 1, At, B1); PG8_BAR;
            PG8_STAGE(PG8_SA(1, 1), a3 + hstepA, voffA);
        }
        if constexpr (Epi::FUSED) {
            E.fused(acc, cur, nxt, has_next, wr, wc, fr, fq);
            if (!has_next) break;
            cur = nxt; cA = nA; cB = nB; ++ui;
        } else {
            E(acc, cur, wr, wc, fr, fq);
            if (!has_next) break;
#pragma unroll
            for (int a = 0; a < 2; ++a)
#pragma unroll
                for (int b = 0; b < 2; ++b)
#pragma unroll
                    for (int m = 0; m < 4; ++m)
#pragma unroll
                        for (int n = 0; n < 2; ++n) acc[a][b][m][n] = (f32x4){0.f, 0.f, 0.f, 0.f};
            cur = nxt; cA = nA; cB = nB; ++ui;
            E.init(acc, cur, wr, wc, fr, fq);
        }
    }
    PG8_WAIT_V(0);
    if (wr == 0) PG8_BAR;
    PG8_BAR;
#undef PG8_SA
#undef PG8_SB
#undef PG8_STAGE
#undef PG8_LDA
#undef PG8_LDB
#undef PG8_MMA
#undef PG8_WAIT_V
#undef PG8_WAIT_VN
#undef PG8_WAIT_L
#undef PG8_BAR
#undef PG8_SCHED
}
}
#define XB_TMO      128
#define XB_XCNT(j)  (256  + 64 * (j))
#define XB_XSUB(j)  (1280 + 64 * (j))
#define XB_XGEN(j)  (2304 + 64 * (j))
#define XB_TOP      3328
#define XB_TOPGEN   3392
#define XCD_BAR_WORDS 3456
#define XB_SPIN_CAP (1u << 20)


__device__ __forceinline__ unsigned xb_ld(unsigned* p)              { return __hip_atomic_load(p, __ATOMIC_RELAXED, __HIP_MEMORY_SCOPE_AGENT); }
__device__ __forceinline__ unsigned xb_add(unsigned* p, unsigned v) { return __hip_atomic_fetch_add(p, v, __ATOMIC_RELAXED, __HIP_MEMORY_SCOPE_AGENT); }
__device__ __forceinline__ unsigned xb_xcc_id() { return (unsigned)__builtin_amdgcn_s_getreg((3 << 11) | 20) & 0xFu; }
#define XB_SPIN(cond, bar) do { unsigned _sp = 0; while (cond) { __builtin_amdgcn_s_sleep(1); \
    if ((++_sp & 255u) == 0u) { if (xb_ld(&(bar)[XB_TMO])) break; if (_sp > XB_SPIN_CAP) { atomicAdd(&(bar)[XB_TMO], 1u); break; } } } } while (0)

struct XcdBarrier {
    unsigned* bar; unsigned x;
    volatile LAS unsigned* st;
};

__device__ __forceinline__ XcdBarrier xcd_barrier_post(unsigned* bar, volatile LAS unsigned* st) {
    XcdBarrier b; b.bar = bar; b.x = xb_xcc_id(); b.st = st;
    if (threadIdx.x == 0) (void)xb_add(&bar[XB_XCNT(b.x)], 1u);
    return b;
}
__device__ __forceinline__ void xcd_barrier_complete(unsigned* bar, unsigned x, unsigned& nloc, unsigned& nx) {
    const unsigned G = gridDim.x * gridDim.y * gridDim.z;
    unsigned sum, cnt, mine, sp = 0u;
    for (;;) {
        sum = 0u; cnt = 0u; mine = 0u;
#pragma unroll
        for (unsigned j = 0; j < 16; ++j) { const unsigned c = xb_ld(&bar[XB_XCNT(j)]); sum += c; cnt += (c > 0u) ? 1u : 0u; mine = (j == x) ? c : mine; }
        if (sum == G) break;
        __builtin_amdgcn_s_sleep(1);
        if ((++sp & 255u) == 0u) { if (xb_ld(&bar[XB_TMO])) break; if (sp > XB_SPIN_CAP) { atomicAdd(&bar[XB_TMO], 1u); break; } }
    }
    nloc = mine > 0u ? mine : 1u; nx = cnt > 0u ? cnt : 1u;
}

__device__ __forceinline__ void xcd_barrier(const XcdBarrier& b) {
    asm volatile("s_waitcnt vmcnt(0)" ::: "memory");
    __syncthreads();
    if (threadIdx.x == 0) {
        unsigned* bar = b.bar;
        __builtin_amdgcn_s_waitcnt(0);
        unsigned nloc = b.st[0], nx = b.st[1];
        if (nloc == 0u) { xcd_barrier_complete(bar, b.x, nloc, nx); b.st[0] = nloc; b.st[1] = nx; }
        const unsigned old = xb_add(&bar[XB_XSUB(b.x)], 1u);
        const unsigned gen = old / nloc;
        if (old + 1u == (gen + 1u) * nloc) {
            __builtin_amdgcn_fence(__ATOMIC_RELEASE, "agent");
            asm volatile("s_waitcnt vmcnt(0)" ::: "memory");
            const unsigned og = xb_add(&bar[XB_TOP], 1u);
            const unsigned tg = og / nx;
            if (og + 1u == (tg + 1u) * nx) xb_add(&bar[XB_TOPGEN], 1u);
            else XB_SPIN(xb_ld(&bar[XB_TOPGEN]) == tg, bar);
            __builtin_amdgcn_fence(__ATOMIC_ACQUIRE, "agent");
            xb_add(&bar[XB_XGEN(b.x)], 1u);
            asm volatile("s_waitcnt vmcnt(0)" ::: "memory");
        } else {
            XB_SPIN(xb_ld(&bar[XB_XGEN(b.x)]) == gen, bar);
            __builtin_amdgcn_fence(__ATOMIC_ACQUIRE, "agent");
            asm volatile("s_waitcnt vmcnt(0)" ::: "memory");
        }
    }
    __syncthreads();
}

typedef _Float16 h16;
typedef h16 h16x2 __attribute__((ext_vector_type(2)));
typedef h16 h16x4 __attribute__((ext_vector_type(4)));
typedef h16 h16x8 __attribute__((ext_vector_type(8)));
typedef float f32x4 __attribute__((ext_vector_type(4)));
typedef float f32x2 __attribute__((ext_vector_type(2)));
typedef unsigned u32x4 __attribute__((ext_vector_type(4)));
typedef unsigned u32x2 __attribute__((ext_vector_type(2)));

constexpr int D = 1024, NB = 8, SEQ = 4096, T = NB * SEQ, LC = 256, TC = NB * LC, TALL = T + TC;
constexpr int NTHREADS = 512;
constexpr int LDS_BYTES = 156 * 1024;
constexpr float EPS = 1e-6f;
constexpr size_t MiB = (size_t)1 << 20;
constexpr size_t OFF_CTL = 0;
constexpr size_t OFF_MOD = 64 * 1024;
constexpr size_t OFF_LB = 320 * 1024;
constexpr size_t OFF_WA = 1 * MiB;
constexpr size_t OFF_WG = 6 * MiB;
constexpr size_t OFF_WF = 10 * MiB;
constexpr size_t OFF_WHG = 12 * MiB;
constexpr size_t OFF_WFT = 13 * MiB;
constexpr size_t OFF_WOUT = 14 * MiB;
constexpr size_t OFF_WS = 16 * MiB;
constexpr size_t OFF_UALL = 20 * MiB;
constexpr size_t OFF_OF = 88 * MiB;
constexpr size_t OFF_OB = 120 * MiB;
constexpr size_t OFF_FTT = 152 * MiB;
constexpr size_t OFF_Q = 216 * MiB;
constexpr size_t OFF_LF = 248 * MiB;
constexpr size_t OFF_LBK = 282 * MiB;
constexpr size_t OFF_V = 316 * MiB;
constexpr size_t OFF_G = 350 * MiB;
constexpr size_t OFF_WOUTG = 20 * MiB;
constexpr size_t OFF_Y1 = 382 * MiB;
constexpr size_t OFF_DFT256 = 512 * 1024;
constexpr size_t OFF_YFT = 446 * MiB;
constexpr size_t OFF_USTATE = 446 * MiB;
constexpr size_t OFF_DLOG = 460 * MiB;
constexpr size_t WS_NEED = 510 * MiB;
constexpr size_t OFF_GH = 216 * MiB;
constexpr size_t OFF_Y = 152 * MiB;
constexpr size_t OFF_H16 = 382 * MiB;
constexpr size_t OFF_U2 = 20 * MiB;
constexpr size_t OFF_TU = 478 * MiB;
constexpr size_t OFF_TV = 494 * MiB;
constexpr size_t OFF_QX = 120 * MiB;
constexpr size_t OFF_SU = 768 * 1024;
constexpr size_t OFF_SV = 832 * 1024;
constexpr size_t OFF_SX = 205 * MiB;
constexpr size_t OFF_SC = 216 * MiB;
constexpr size_t OFF_EIDX = 152 * MiB;
constexpr size_t OFF_GATE = 168 * MiB;
constexpr size_t OFF_W = 184 * MiB;
constexpr size_t OFF_PSS = 200 * MiB;
constexpr size_t OFF_PACT = 216 * MiB;
constexpr size_t OFF_PO = 216 * MiB;
constexpr size_t OFF_SIDE = 88 * MiB;
constexpr int CTL_RANK = 4096;
constexpr size_t CTL_ZERO_BYTES = 32 * 1024;

struct Params { const float* in[20]; float* out; unsigned char* ws; int ph_lo, ph_hi; };

__device__ __forceinline__ unsigned pk2(float a, float b) { h16x2 v = {(h16)a, (h16)b}; return __builtin_bit_cast(unsigned, v); }
#define GAS __attribute__((address_space(1)))
__device__ __forceinline__ void gst4(void* p, u32x4 v) { *(GAS u32x4*)p = v; }
__device__ __forceinline__ void gst2(void* p, u32x2 v) { *(GAS u32x2*)p = v; }
__device__ __forceinline__ float wave_sum(float v) {
#pragma unroll
    for (int o = 32; o >= 1; o >>= 1) v += __shfl_xor(v, o);
    return v; }
__device__ __forceinline__ float sigmoidf_(float z) { return __builtin_amdgcn_rcpf(1.0f + __expf(-z)); }

constexpr int N_MOD = 192, N_LB = 1, N_TRA = 160, N_TRG = 128, N_TRHG = 32, N_TRFT = 32, N_TROUT = 64, N_WF = 128, N_WSF = 256, N_DFT = 1;
constexpr int P0_TOTAL = N_MOD + N_LB + N_TRA + N_TRG + N_TRHG + N_TRFT + N_TROUT + N_WF + N_WSF + N_DFT;

__device__ __forceinline__ void p0_mod(const Params& p, LAS float* sm, int idx) {
    const int tid = threadIdx.x;
    for (int i = tid; i < 9 * 1024; i += NTHREADS) { const int r = i >> 10, k = i & 1023; const float c = (r < 8) ? p.in[1][r * 1024 + k] : p.in[3][k]; sm[i] = c / (1.0f + __expf(-c)); }
    __syncthreads();
    const int col = tid & 31, ks = tid >> 5;
    float acc[9];
#pragma unroll
    for (int r = 0; r < 9; ++r) acc[r] = 0.f;
    const float* w = p.in[4] + (size_t)(ks * 64) * 6144 + idx * 32 + col;
    float wv[64];
#pragma unroll
    for (int k = 0; k < 64; ++k) wv[k] = w[(size_t)k * 6144];
#pragma unroll
    for (int k = 0; k < 64; ++k) {
#pragma unroll
        for (int r = 0; r < 9; ++r) acc[r] += sm[r * 1024 + ks * 64 + k] * wv[k]; }
    LAS float* red = sm + 9 * 1024;
#pragma unroll
    for (int r = 0; r < 9; ++r) red[(ks * 9 + r) * 32 + col] = acc[r];
    __syncthreads();
    float* mod = (float*)(p.ws + OFF_MOD);
    if (tid < 288) { const int r = tid >> 5, c = tid & 31; float s = 0.f;
#pragma unroll
        for (int q = 0; q < 16; ++q) s += red[(q * 9 + r) * 32 + c];
        mod[r * 6144 + idx * 32 + c] = s + p.in[5][idx * 32 + c]; }
    __syncthreads();
}
__device__ __forceinline__ void p0_lb(const Params& p) {
    const int tid = threadIdx.x; float* lb = (float*)(p.ws + OFF_LB);
    if (tid < 512) { lb[tid] = 1.0f / (1.0f + expf(p.in[9][512 + tid] - p.in[9][tid])); lb[512 + tid] = 1.0f / (1.0f + expf(p.in[10][512 + tid] - p.in[10][tid])); }
}
__device__ __forceinline__ void p0_transpose(const float* src, int ld_src, int ncol0, h16* dst, int ld_dst, int nktiles, int item, LAS float* sm) {
    const int tid = threadIdx.x, kt = item % nktiles, nt = item / nktiles;
    { const int n4 = tid & 63, kk = tid >> 6;
#pragma unroll
      for (int ps = 0; ps < 8; ++ps) { const int k = kk + 8 * ps; const f32x4 v = *(const f32x4*)(src + (size_t)(kt * 64 + k) * ld_src + ncol0 + nt * 256 + 4 * n4);
          sm[k * 257 + 4 * n4] = v.x; sm[k * 257 + 4 * n4 + 1] = v.y; sm[k * 257 + 4 * n4 + 2] = v.z; sm[k * 257 + 4 * n4 + 3] = v.w; } }
    __syncthreads();
#pragma unroll
    for (int ps = 0; ps < 4; ++ps) { const int idx = tid + NTHREADS * ps, n = idx >> 3, k8 = (idx & 7) * 8;
        float v[8];
#pragma unroll
        for (int j = 0; j < 8; ++j) v[j] = sm[(k8 + j) * 257 + n];
        u32x4 w; w.x = pk2(v[0], v[1]); w.y = pk2(v[2], v[3]); w.z = pk2(v[4], v[5]); w.w = pk2(v[6], v[7]);
        *(u32x4*)(dst + (size_t)(nt * 256 + n) * ld_dst + kt * 64 + k8) = w; }
    __syncthreads();
}
__device__ __forceinline__ void p0_wf(const Params& p, LAS float* sm, int item) {
    const int tid = threadIdx.x, dt = item & 15, part = (item >> 4) & 1, g = item >> 5, d0 = dt * 64;
    LAS float* w = sm; LAS float* TT = sm + 8256; LAS float* trig = sm + 8256 + 16384;
    if (tid < 128) trig[tid] = part ? sinpif((float)tid / 64.0f) : cospif((float)tid / 64.0f);
    for (int i = tid; i < 64 * 128; i += NTHREADS) { const int dl = i >> 7, n2 = i & 127; w[dl * 129 + n2] = p.in[8][(size_t)(d0 + dl) * 5120 + 2560 + g * 128 + n2]; }
    __syncthreads();
    for (int i = tid; i < 128 * 128; i += NTHREADS) { const int n2 = i >> 7, k2 = i & 127; TT[i] = trig[(k2 * n2) & 127]; }
    __syncthreads();
    const int dl = tid & 63, kg = tid >> 6; h16* WF = (h16*)(p.ws + OFF_WF);
    float s[16];
#pragma unroll
    for (int j = 0; j < 16; ++j) s[j] = 0.f;
#pragma unroll 2
    for (int n2 = 0; n2 < 128; ++n2) { const float wv = w[dl * 129 + n2];
#pragma unroll
        for (int q = 0; q < 4; ++q) { const f32x4 tv = *(LAS f32x4*)(TT + n2 * 128 + kg * 16 + 4 * q);
#pragma unroll
            for (int j = 0; j < 4; ++j) s[4 * q + j] += wv * tv[j]; } }
#pragma unroll
    for (int j = 0; j < 16; ++j) WF[(size_t)(part * 512 + g * 128 + kg * 16 + j) * 1024 + d0 + dl] = (h16)(s[j] * 0.08838834764831845f);
    __syncthreads();
}
__device__ __forceinline__ void p0_wsf(const Params& p, LAS float* sm, int item) {
    const int tid = threadIdx.x, dt = item & 15, hp = item >> 4, d0 = dt * 64;
    LAS float* wq = sm; LAS float* skT = sm + 8256;
    for (int i = tid; i < 64 * 128; i += NTHREADS) { const int dl = i >> 7, k = i & 127; wq[dl * 129 + k] = p.in[15][(size_t)(d0 + dl) * 2048 + hp * 128 + k]; }
    for (int i = tid; i < 128 * 128; i += NTHREADS) { const int n = i >> 7, k = i & 127; skT[k * 128 + n] = p.in[16][(size_t)hp * 16384 + i]; }
    __syncthreads();
    const int dl = tid & 63, ng = tid >> 6; h16* WS = (h16*)(p.ws + OFF_WS);
    float s[16];
#pragma unroll
    for (int j = 0; j < 16; ++j) s[j] = 0.f;
#pragma unroll 2
    for (int k = 0; k < 128; ++k) { const float wv = wq[dl * 129 + k];
#pragma unroll
        for (int q = 0; q < 4; ++q) { const f32x4 tv = *(LAS f32x4*)(skT + k * 128 + ng * 16 + 4 * q);
#pragma unroll
            for (int j = 0; j < 4; ++j) s[4 * q + j] += wv * tv[j]; } }
#pragma unroll
    for (int j = 0; j < 16; ++j) WS[(size_t)(hp * 128 + ng * 16 + j) * 1024 + d0 + dl] = (h16)s[j];
    __syncthreads();
}
__device__ __forceinline__ void p0_dft256(const Params& p) {
    h16* M = (h16*)(p.ws + OFF_DFT256);
    for (int e = threadIdx.x; e < 256 * 512; e += NTHREADS) { const int c = e >> 9, k = e & 511, part = k >> 8, a = k & 255; const int m = (a * c) & 255;
        M[e] = (h16)((part ? sinpif((float)m / 128.0f) : cospif((float)m / 128.0f)) * 0.25f); }
}
constexpr int CTL_P0Q = 6144;
__device__ __forceinline__ void phase0(const Params& p, LAS unsigned char* lds) {
    LAS float* sm = (LAS float*)lds; volatile LAS unsigned* slot = (volatile LAS unsigned*)(lds + LDS_BYTES - 64) + 8;
    unsigned* ctr = (unsigned*)(p.ws + OFF_CTL) + CTL_P0Q;
    int it = blockIdx.x;
    while (it < P0_TOTAL) {
        unsigned nxt = 0u;
        if (threadIdx.x == 0) nxt = xb_add(ctr, 1u) + gridDim.x;
        int i = it;
        do {
            if (i < N_DFT) { p0_dft256(p); break; } i -= N_DFT;
            if (i < N_MOD) { p0_mod(p, sm, i); break; } i -= N_MOD;
            if (i < N_WSF) { p0_wsf(p, sm, i); break; } i -= N_WSF;
            if (i < N_WF) { p0_wf(p, sm, i); break; } i -= N_WF;
            if (i < N_TRA) { p0_transpose(p.in[8], 5120, 0, (h16*)(p.ws + OFF_WA), 1024, 16, i, sm); break; } i -= N_TRA;
            if (i < N_TRG) { p0_transpose(p.in[8], 5120, 3072, (h16*)(p.ws + OFF_WG), 1024, 16, i, sm); break; } i -= N_TRG;
            if (i < N_TRHG) { p0_transpose(p.in[12], 1024, 0, (h16*)(p.ws + OFF_WHG), 512, 8, i, sm); break; } i -= N_TRHG;
            if (i < N_TRFT) { p0_transpose(p.in[13], 1024, 0, (h16*)(p.ws + OFF_WFT), 512, 8, i, sm); break; } i -= N_TRFT;
            if (i < N_TROUT) { p0_transpose(p.in[14], 1024, 0, (h16*)(p.ws + OFF_WOUT), 1024, 16, i, sm); break; } i -= N_TROUT;
            p0_lb(p);
        } while (0);
        if (threadIdx.x == 0) slot[0] = nxt;
        __syncthreads();
        it = (int)slot[0];
        __syncthreads();
    }
}

template <bool SRC16>
__device__ __forceinline__ void modulate_rows(const void* srcv, h16* dst, int nrows, const float* gvec, const float* mod, int sh_off, int sc_off, int ctx_rows, int vb, int vn, signed char* qdst = nullptr, float* qscale = nullptr) {
    const int wave = threadIdx.x >> 6, lane = threadIdx.x & 63;
    const float* src = (const float*)srcv; const h16* src16 = (const h16*)srcv;
    for (int rowA = vb * 8 + wave; rowA < nrows; rowA += vn * 16) {
        const int rowB = rowA + vn * 8; const bool okB = rowB < nrows;
        const int rows[2] = {rowA, okB ? rowB : rowA};
        f32x4 v[2][4]; float ss[2] = {0.f, 0.f};
#pragma unroll
        for (int q = 0; q < 2; ++q)
#pragma unroll
            for (int j = 0; j < 4; ++j) {
                if (SRC16) { const h16x4 hv = *(const h16x4*)(src16 + (size_t)rows[q] * D + j * 256 + lane * 4); v[q][j] = (f32x4){(float)hv[0], (float)hv[1], (float)hv[2], (float)hv[3]}; }
                else v[q][j] = *(const f32x4*)(src + (size_t)rows[q] * D + j * 256 + lane * 4); }
#pragma unroll
        for (int q = 0; q < 2; ++q) {
#pragma unroll
            for (int j = 0; j < 4; ++j) ss[q] += v[q][j].x * v[q][j].x + v[q][j].y * v[q][j].y + v[q][j].z * v[q][j].z + v[q][j].w * v[q][j].w;
            ss[q] = wave_sum(ss[q]); }
        const int mrA = ctx_rows ? 8 : (rows[0] >> 12), mrB = ctx_rows ? 8 : (rows[1] >> 12);
        f32x4 gg4[4], scA[4], shA[4], scB[4], shB[4];
#pragma unroll
        for (int j = 0; j < 4; ++j) { const int c = j * 256 + lane * 4; gg4[j] = *(const f32x4*)(gvec + c); scA[j] = *(const f32x4*)(mod + mrA * 6144 + sc_off + c); shA[j] = *(const f32x4*)(mod + mrA * 6144 + sh_off + c); }
        if (mrB != mrA) {
#pragma unroll
            for (int j = 0; j < 4; ++j) { const int c = j * 256 + lane * 4; scB[j] = *(const f32x4*)(mod + mrB * 6144 + sc_off + c); shB[j] = *(const f32x4*)(mod + mrB * 6144 + sh_off + c); }
        } else {
#pragma unroll
            for (int j = 0; j < 4; ++j) { scB[j] = scA[j]; shB[j] = shA[j]; }
        }
        __builtin_amdgcn_sched_barrier(0);
#pragma unroll
        for (int q = 0; q < 2; ++q) {
            if (q == 1 && !okB) break;
            const int row = rows[q];
            const float rstd = rsqrtf(ss[q] * (1.0f / D) + EPS);
            float amax = 0.f;
            f32x4 sc4[4], sh4[4];
#pragma unroll
            for (int j = 0; j < 4; ++j) { sc4[j] = q ? scB[j] : scA[j]; sh4[j] = q ? shB[j] : shA[j]; }
#pragma unroll
            for (int j = 0; j < 4; ++j) { const int c = j * 256 + lane * 4;
                const f32x4 gg = gg4[j], sc = sc4[j], sh = sh4[j];
                const f32x4 o = (v[q][j] * rstd) * gg * (sc + 1.0f) + sh; v[q][j] = o;
                amax = fmaxf(amax, fmaxf(fmaxf(fabsf(o.x), fabsf(o.y)), fmaxf(fabsf(o.z), fabsf(o.w))));
                u32x2 w; w.x = pk2(o.x, o.y); w.y = pk2(o.z, o.w);
                *(u32x2*)(dst + (size_t)row * D + c) = w; }
            if (qdst) {
#pragma unroll
                for (int o = 32; o >= 1; o >>= 1) amax = fmaxf(amax, __shfl_xor(amax, o));
                const float qs = amax > 0.f ? amax * (1.0f / 127.0f) : 1.0f, inv = 1.0f / qs;
#pragma unroll
                for (int j = 0; j < 4; ++j) { const int c = j * 256 + lane * 4;
                    const int q0 = (int)rintf(v[q][j].x * inv), q1 = (int)rintf(v[q][j].y * inv), q2 = (int)rintf(v[q][j].z * inv), q3 = (int)rintf(v[q][j].w * inv);
                    *(unsigned*)(qdst + (size_t)row * D + c) = (unsigned)(q0 & 255) | ((unsigned)(q1 & 255) << 8) | ((unsigned)(q2 & 255) << 16) | ((unsigned)(q3 & 255) << 24); }
                if (lane == 0) qscale[row] = qs;
            }
        }
    }
}

#define EPI_DEFAULT_HOOKS \
    static constexpr bool FUSED = false; \
    __device__ __forceinline__ size_t boff(const pg8::Unit&) const { return 0; } \
    __device__ __forceinline__ void init(f32x4 (&)[2][2][4][2], const pg8::Unit&, int, int, int, int) const {}
struct EpiA {
    EPI_DEFAULT_HOOKS
    static constexpr bool PERM = true, TRANS = true;
    static constexpr int NST = 16;
    unsigned char* ws;
    __device__ __forceinline__ void operator()(const f32x4 (&acc)[2][2][4][2], const pg8::Unit& u, int wr, int wc, int fr, int fq) const {
        const int ty = u.pn >> 1;
        h16* base = (h16*)(ws + (ty == 0 ? OFF_Q : ty == 1 ? OFF_LF : ty == 2 ? OFF_LBK : ty == 3 ? OFF_V : OFF_G));
        const float* lb = (const float*)(ws + OFF_LB) + (ty == 2 ? 512 : 0);
        const int row0 = u.pm * 256 + wr * 64 + fr, col0 = (u.pn & 1) * 256 + wc * 32 + 8 * fq;
        float lbv2[2][8], omv2[2][8];
        if (ty == 1 || ty == 2) {
#pragma unroll
            for (int bj = 0; bj < 2; ++bj) { const f32x4 l0 = *(const GAS f32x4*)(lb + col0 + bj * 128), l1 = *(const GAS f32x4*)(lb + col0 + bj * 128 + 4);
#pragma unroll
                for (int j = 0; j < 4; ++j) { lbv2[bj][j] = l0[j]; lbv2[bj][4 + j] = l1[j]; omv2[bj][j] = 1.0f - l0[j]; omv2[bj][4 + j] = 1.0f - l1[j]; } }
        }
#pragma unroll
        for (int bj = 0; bj < 2; ++bj) {
            float lbv[8], omv[8];
#pragma unroll
            for (int j = 0; j < 8; ++j) { lbv[j] = lbv2[bj][j]; omv[j] = omv2[bj][j]; }
#pragma unroll
            for (int ai = 0; ai < 2; ++ai)
#pragma unroll
                for (int m = 0; m < 4; ++m) {
                    float v[8];
#pragma unroll
                    for (int j = 0; j < 4; ++j) { v[j] = acc[ai][bj][m][0][j]; v[4 + j] = acc[ai][bj][m][1][j]; }
                    if (ty == 0) {
#pragma unroll
                        for (int j = 0; j < 8; ++j) v[j] *= 0.08838834764831845f;
                    } else if (ty == 1 || ty == 2) {
#pragma unroll
                        for (int j = 0; j < 8; ++j) v[j] = __builtin_amdgcn_logf(lbv[j] + omv[j] * sigmoidf_(v[j]));
                    }
                    u32x4 w; w.x = pk2(v[0], v[1]); w.y = pk2(v[2], v[3]); w.z = pk2(v[4], v[5]); w.w = pk2(v[6], v[7]);
                    gst4(base + (size_t)(row0 + ai * 128 + m * 16) * 512 + col0 + bj * 128, w);
                }
        }
    }
};
struct OneUnit { pg8::Unit u; __device__ bool next(int i, pg8::Unit& o) const { if (i > 0) return false; o = u; return true; } };
struct OrderA {
    pg8::TileOrder lat; int G, c, rep;
    __device__ void init(int G_, int c_, int rep_ = 1) { lat.init(128, 10, G_, c_); G = G_; c = c_; rep = rep_; }
    __device__ bool next(int i, pg8::Unit& u) const {
        long L = (long)i * G + c; if (L >= 1328L * rep) return false; L %= 1328;
        if (L < 1280) return lat.map(L, u);
        const int l2 = (int)(L - 1280); if (l2 >= 48) return false;
        u.pm = 128 + l2 / 6; u.pn = 2 + l2 % 6; return true;
    }
};
__device__ __forceinline__ size_t gate_rec(int gate, int pm, int pn4, int wave, int ai, int m, int lane) { return (((((((size_t)gate * 128 + pm) * 4 + pn4) * 8 + wave) * 2 + ai) * 4 + m) * 64 + lane) * 16; }
struct EpiGate {
    EPI_DEFAULT_HOOKS
    static constexpr bool PERM = true, TRANS = true;
    static constexpr int NST = 8;
    unsigned char* ws;
    __device__ __forceinline__ void operator()(const f32x4 (&acc)[2][2][4][2], const pg8::Unit& u, int wr, int wc, int fr, int fq) const {
        unsigned char* G8 = ws + OFF_GH;
#pragma unroll
        for (int ai = 0; ai < 2; ++ai)
#pragma unroll
            for (int m = 0; m < 4; ++m) {
                u32x4 w;
#pragma unroll
                for (int bj = 0; bj < 2; ++bj)
#pragma unroll
                    for (int n = 0; n < 2; ++n) { unsigned d = 0u;
#pragma unroll
                        for (int j = 0; j < 4; ++j) d = __builtin_amdgcn_cvt_pk_u8_f32(__builtin_amdgcn_rcpf(__builtin_fmaf(__expf(-acc[ai][bj][m][n][j]), 1.0f / 255.0f, 1.0f / 255.0f)), j, d);
                        w[2 * bj + n] = d; }
                gst4(G8 + gate_rec(u.pn >> 2, u.pm, u.pn & 3, wr * 4 + wc, ai, m, fq * 16 + fr), w);
            }
    }
};
struct EpiFT {
    EPI_DEFAULT_HOOKS
    static constexpr bool PERM = false, TRANS = false;
    static constexpr int NST = 32;
    unsigned char* ws;
    __device__ __forceinline__ void operator()(const f32x4 (&acc)[2][2][4][2], const pg8::Unit& u, int wr, int wc, int fr, int fq) const {
        h16* F = (h16*)(ws + OFF_FTT);
        const int t0 = u.pm * 256 + wr * 64 + 4 * fq, c0 = u.pn * 256 + wc * 32 + fr;
#pragma unroll
        for (int ai = 0; ai < 2; ++ai)
#pragma unroll
            for (int m = 0; m < 4; ++m)
#pragma unroll
                for (int bj = 0; bj < 2; ++bj)
#pragma unroll
                    for (int n = 0; n < 2; ++n) {
                        const int t = t0 + ai * 128 + m * 16, c = c0 + bj * 128 + n * 16;
                        const int b = t >> 12, n1 = t & 4095, part = c >> 9, gk = c & 511;
                        const f32x4 a = acc[ai][bj][m][n];
                        u32x2 w; w.x = pk2(a.x, a.y); w.y = pk2(a.z, a.w);
                        gst2(F + ((size_t)((b * 512 + gk) * 2 + part)) * 4096 + n1, w);
                    }
    }
};
struct EpiDFT {
    EPI_DEFAULT_HOOKS
    static constexpr bool PERM = true, TRANS = true;
    static constexpr int NST = 16;
    unsigned char* ws;
    __device__ __forceinline__ void operator()(const f32x4 (&acc)[2][2][4][2], const pg8::Unit& u, int wr, int wc, int fr, int fq) const {
        h16* Y = (h16*)(ws + OFF_YFT);
        const int b = u.pn >> 5, d = (u.pn >> 1) & 15;
        const int c0 = wr * 64 + fr, col0 = (u.pn & 1) * 256 + wc * 32 + 8 * fq;
#pragma unroll
        for (int ai = 0; ai < 2; ++ai)
#pragma unroll
            for (int m = 0; m < 4; ++m)
#pragma unroll
                for (int bj = 0; bj < 2; ++bj) {
                    const int c = c0 + ai * 128 + m * 16;
                    const f32x4 a0 = acc[ai][bj][m][0], a1 = acc[ai][bj][m][1];
                    u32x4 w; w.x = pk2(a0.x, a0.y); w.y = pk2(a0.z, a0.w); w.z = pk2(a1.x, a1.y); w.w = pk2(a1.z, a1.w);
                    gst4(Y + (size_t)(b * 4096 + d + 16 * c) * 512 + col0 + bj * 128, w);
                }
    }
};
typedef h16 GAS gh16;
template <bool ACCUM> struct EpiMerge1 {
    EPI_DEFAULT_HOOKS
    static constexpr bool PERM = true, TRANS = true;
    static constexpr int NST = 8;
    unsigned char* ws;
    __device__ __forceinline__ void operator()(const f32x4 (&acc)[2][2][4][2], const pg8::Unit& u, int wr, int wc, int fr, int fq) const {
        gh16* Y = (gh16*)(ws + OFF_Y); const unsigned char* G8 = ws + OFF_GH;
        const int row0 = u.pm * 256 + wr * 64 + fr, col0 = u.pn * 256 + wc * 32 + 8 * fq;
        const unsigned off0 = (unsigned)row0 * 1024u + (unsigned)col0;
#pragma unroll
        for (int ai = 0; ai < 2; ++ai) {
            u32x4 gt[4]; h16x8 yv[8];
#pragma unroll
            for (int m = 0; m < 4; ++m) gt[m] = *(const GAS u32x4*)(G8 + gate_rec(ACCUM ? 1 : 0, u.pm, u.pn, wr * 4 + wc, ai, m, fq * 16 + fr));
            if (ACCUM) {
#pragma unroll
                for (int i = 0; i < 8; ++i) { const int m = i >> 1, bj = i & 1; yv[i] = *(const GAS h16x8*)(Y + (off0 + (unsigned)((ai * 128 + m * 16) * 1024 + bj * 128))); } }
            __builtin_amdgcn_sched_barrier(0);
#pragma unroll
            for (int i = 0; i < 8; ++i) { const int m = i >> 1, bj = i & 1; const unsigned off = off0 + (unsigned)((ai * 128 + m * 16) * 1024 + bj * 128);
                float v[8];
#pragma unroll
                for (int n = 0; n < 2; ++n) { const unsigned d = gt[m][2 * bj + n];
#pragma unroll
                    for (int j = 0; j < 4; ++j) v[4 * n + j] = acc[ai][bj][m][n][j] * ((float)((d >> (8 * j)) & 255u) * (1.0f / 255.0f)); }
                if (ACCUM) {
#pragma unroll
                    for (int j = 0; j < 8; ++j) v[j] += (float)yv[i][j]; }
                u32x4 w; w.x = pk2(v[0], v[1]); w.y = pk2(v[2], v[3]); w.z = pk2(v[4], v[5]); w.w = pk2(v[6], v[7]);
                *(GAS u32x4*)(Y + off) = w; }
            __builtin_amdgcn_sched_barrier(0);
        }
    }
};
struct EpiMerge2 {
    static constexpr bool PERM = true, TRANS = true, FUSED = true;
    static constexpr int NST = 8;
    const float* x; h16* H;
    __device__ __forceinline__ size_t boff(const pg8::Unit& u) const { return (size_t)(u.pm >> 4) * (1024 * 1024 * 2); }
    __device__ __forceinline__ void init(f32x4 (&acc)[2][2][4][2], const pg8::Unit& u, int wr, int wc, int fr, int fq) const {
        const int row0 = u.pm * 256 + wr * 64 + fr, col0 = u.pn * 256 + wc * 32 + 8 * fq;
        const GAS float* xg = (const GAS float*)x;
#pragma unroll
        for (int ai = 0; ai < 2; ++ai)
#pragma unroll
            for (int m = 0; m < 4; ++m) { const GAS float* rowp = xg + (size_t)(row0 + ai * 128 + m * 16) * 1024 + col0;
#pragma unroll
                for (int bj = 0; bj < 2; ++bj)
#pragma unroll
                    for (int n = 0; n < 2; ++n) acc[ai][bj][m][n] = *(const GAS f32x4*)(rowp + bj * 128 + n * 4); }
    }
    __device__ __forceinline__ void fused(f32x4 (&acc)[2][2][4][2], const pg8::Unit& u, const pg8::Unit& nx, bool has_next, int wr, int wc, int fr, int fq) const {
        const int row0 = u.pm * 256 + wr * 64 + fr, col0 = u.pn * 256 + wc * 32 + 8 * fq;
        const int nrow0 = nx.pm * 256 + wr * 64 + fr, ncol0 = nx.pn * 256 + wc * 32 + 8 * fq;
        const GAS float* xg = (const GAS float*)x;
#pragma unroll
        for (int ai = 0; ai < 2; ++ai) {
            u32x4 o[4][2];
#pragma unroll
            for (int m = 0; m < 4; ++m)
#pragma unroll
                for (int bj = 0; bj < 2; ++bj) { const f32x4 a0 = acc[ai][bj][m][0], a1 = acc[ai][bj][m][1];
                    o[m][bj].x = pk2(a0[0], a0[1]); o[m][bj].y = pk2(a0[2], a0[3]); o[m][bj].z = pk2(a1[0], a1[1]); o[m][bj].w = pk2(a1[2], a1[3]); }
            __builtin_amdgcn_sched_barrier(0);
            if (has_next) {
#pragma unroll
                for (int m = 0; m < 4; ++m) { const GAS float* rowp = xg + (size_t)(nrow0 + ai * 128 + m * 16) * 1024 + ncol0;
#pragma unroll
                    for (int bj = 0; bj < 2; ++bj)
#pragma unroll
                        for (int n = 0; n < 2; ++n) acc[ai][bj][m][n] = *(const GAS f32x4*)(rowp + bj * 128 + n * 4); } }
            __builtin_amdgcn_sched_barrier(0);
#pragma unroll
            for (int m = 0; m < 4; ++m) { h16* rowp = H + (size_t)(row0 + ai * 128 + m * 16) * 1024 + col0;
#pragma unroll
                for (int bj = 0; bj < 2; ++bj) gst4(rowp + bj * 128, o[m][bj]); }
            __builtin_amdgcn_sched_barrier(0);
        }
    }
};
__device__ __forceinline__ void scale_wout(const Params& p, int vb, int vn) {
    const h16* W = (const h16*)(p.ws + OFF_WOUT); h16* WG = (h16*)(p.ws + OFF_WOUTG); const float* mod = (const float*)(p.ws + OFF_MOD);
    for (size_t i = (size_t)vb * NTHREADS + threadIdx.x; i < (size_t)8 * 1024 * 128; i += (size_t)vn * NTHREADS) {
        const int b = (int)(i >> 17), c = (int)((i >> 7) & 1023), k8 = (int)(i & 127) * 8;
        const h16x8 w = *(const h16x8*)(W + (size_t)c * 1024 + k8); const float g = mod[b * 6144 + 2048 + c];
        u32x4 o; o.x = pk2((float)w[0] * g, (float)w[1] * g); o.y = pk2((float)w[2] * g, (float)w[3] * g); o.z = pk2((float)w[4] * g, (float)w[5] * g); o.w = pk2((float)w[6] * g, (float)w[7] * g);
        *(u32x4*)(WG + ((size_t)b * 1024 + c) * 1024 + k8) = o; }
}
__device__ __forceinline__ unsigned f2key(float x) { const unsigned b = __builtin_bit_cast(unsigned, x); return b ^ ((b >> 31) ? 0xFFFFFFFFu : 0x80000000u); }
__device__ __forceinline__ float key2f(unsigned u) { const unsigned b = (u & 0x80000000u) ? (u ^ 0x80000000u) : ~u; return __builtin_bit_cast(float, b); }
__device__ __forceinline__ unsigned umax3(unsigned a, unsigned b, unsigned c) { return max(max(a, b), c); }
typedef short s16x2_t __attribute__((ext_vector_type(2)));
__device__ __forceinline__ unsigned hkey2(float a, float b) { const unsigned w = pk2(a, b); const s16x2_t m = __builtin_bit_cast(s16x2_t, w) >> 15;
    return w ^ (__builtin_bit_cast(unsigned, m) | 0x80008000u); }
struct EpiScores {
    static constexpr bool PERM = false, TRANS = true;
    static constexpr int NST = 16;
    EPI_DEFAULT_HOOKS
    unsigned char* C;
    __device__ __forceinline__ void operator()(const f32x4 (&acc)[2][2][4][2], const pg8::Unit& u, int wr, int wc, int fr, int fq) const {
#pragma unroll
        for (int ai = 0; ai < 2; ++ai)
#pragma unroll
            for (int m = 0; m < 4; ++m) { const int t = u.pm * 256 + ai * 128 + wr * 64 + m * 16 + fr, tb = t >> 6, tl = t & 63;
#pragma unroll
                for (int bj = 0; bj < 2; ++bj) { const int c8 = 4 * wc + fq;
                    const f32x4 a0 = acc[ai][bj][m][0], a1 = acc[ai][bj][m][1]; u32x4 kq;
                    kq.x = hkey2(a0[0], a0[1]); kq.y = hkey2(a0[2], a0[3]); kq.z = hkey2(a1[0], a1[1]); kq.w = hkey2(a1[2], a1[3]);
                    gst4(C + ((((size_t)(tb * 8 + u.pn) * 2 + bj) * 16 + c8) * 64 + tl) * 16, kq); } }
    }
};
__device__ __forceinline__ int hgrn_row(int pos, int b, int dir) {
    if (pos < LC) { const int j = dir ? (LC - 1 - pos) : pos; return T + b * LC + j; }
    const int t = pos - LC; return b * SEQ + (dir ? (SEQ - 1 - t) : t);
}
__device__ void hgrn_item(const Params& p, LAS unsigned char* lds, int item) {
    const int tid = threadIdx.x, vq = item & 3, dir = (item >> 2) & 1, h = (item >> 3) & 3, b = item >> 5;
    const h16* Q = (const h16*)(p.ws + OFF_Q); const h16* LF = (const h16*)(p.ws + (dir ? OFF_LBK : OFF_LF)); const h16* V = (const h16*)(p.ws + OFF_V);
    h16* O = (h16*)(p.ws + (dir ? OFF_OB : OFF_OF));
    LAS float* fs = (LAS float*)lds; LAS float* ks = fs + 16 * 128; LAS float* qs = ks + 16 * 128; LAS float* vs = qs + 16 * 128; LAS float* po = vs + 16 * 32;
    const int v = tid & 31, kq = tid >> 5;
    float S[8];
#pragma unroll
    for (int j = 0; j < 8; ++j) S[j] = 0.f;
    const int e = tid * 4, tl_ld = e >> 7, k_ld = e & 127;
    const int tl_v = tid >> 5, vv = tid & 31;
    h16x4 lf4, q4; h16 v1;
    { const int row = hgrn_row(tl_ld, b, dir); lf4 = *(const h16x4*)(LF + (size_t)row * 512 + h * 128 + k_ld); q4 = (h16x4){0, 0, 0, 0};
      const int row2 = hgrn_row(tl_v, b, dir); v1 = V[(size_t)row2 * 512 + h * 128 + vq * 32 + vv]; }
    constexpr int NG = (LC + SEQ) / 16;
    for (int grp = 0; grp < NG; ++grp) {
        const bool latent = grp >= LC / 16;
#pragma unroll
        for (int j = 0; j < 4; ++j) { const float f = __expf((float)lf4[j]); fs[e + j] = f; ks[e + j] = 1.0f - f; qs[e + j] = (float)q4[j]; }
        vs[tid] = (float)v1;
        __syncthreads();
        if (grp + 1 < NG) { const int pos = (grp + 1) * 16; const bool lat2 = (grp + 1) >= LC / 16;
            const int row = hgrn_row(pos + tl_ld, b, dir); lf4 = *(const h16x4*)(LF + (size_t)row * 512 + h * 128 + k_ld);
            if (lat2) q4 = *(const h16x4*)(Q + (size_t)row * 512 + h * 128 + k_ld);
            const int row2 = hgrn_row(pos + tl_v, b, dir); v1 = V[(size_t)row2 * 512 + h * 128 + vq * 32 + vv]; }
#pragma unroll 4
        for (int tl = 0; tl < 16; ++tl) {
            const float vt = vs[tl * 32 + v];
            const f32x4 f0 = *(const LAS f32x4*)(fs + tl * 128 + kq * 8), f1 = *(const LAS f32x4*)(fs + tl * 128 + kq * 8 + 4);
            const f32x4 k0 = *(const LAS f32x4*)(ks + tl * 128 + kq * 8), k1 = *(const LAS f32x4*)(ks + tl * 128 + kq * 8 + 4);
            const f32x4 q0 = *(const LAS f32x4*)(qs + tl * 128 + kq * 8), q1 = *(const LAS f32x4*)(qs + tl * 128 + kq * 8 + 4);
            float a = 0.f;
#pragma unroll
            for (int j = 0; j < 4; ++j) { S[j] = f0[j] * S[j] + k0[j] * vt; a += S[j] * q0[j]; S[4 + j] = f1[j] * S[4 + j] + k1[j] * vt; a += S[4 + j] * q1[j]; }
            po[(tl * 16 + kq) * 32 + v] = a;
        }
        __syncthreads();
        if (latent) { float s = 0.f;
#pragma unroll
            for (int q = 0; q < 16; ++q) s += po[(tl_v * 16 + q) * 32 + vv];
            const int row = hgrn_row(grp * 16 + tl_v, b, dir);
            O[(size_t)row * 512 + h * 128 + vq * 32 + vv] = (h16)s; }
    }
    __syncthreads();
}

typedef short s16x8 __attribute__((ext_vector_type(8)));
typedef short s16x4 __attribute__((ext_vector_type(4)));
__device__ __forceinline__ unsigned cvt_pk_bf16(float lo, float hi) { unsigned r; asm volatile("v_cvt_pk_bf16_f32 %0, %1, %2" : "=v"(r) : "v"(lo), "v"(hi)); return r; }
constexpr int HG_RP = 272, HG_QT = 0, HG_KT = 17408, HG_QD = 34816, HG_KDT = 52224, HG_VT = 68608, HG_AM = 84992, HG_DEC = 93184, HG_SEG = 93696, HG_SEGCH = 17;
#define HG_OPAQUE(x) asm volatile("" : "+v"(x))
template <bool FULL>
__device__ __forceinline__ void hgrn_mfma_unit(const Params& p, LAS unsigned char* lds, int item, int seg) {
    const int tid = threadIdx.x, wave = __builtin_amdgcn_readfirstlane(tid >> 6), lane = tid & 63, fr = lane & 15, fq = lane >> 4;
    const int dir = item & 1, h = (item >> 1) & 3, b = item >> 3;
    const h16* Q = (const h16*)(p.ws + OFF_Q); const h16* LF = (const h16*)(p.ws + (dir ? OFF_LBK : OFF_LF)); const h16* V = (const h16*)(p.ws + OFF_V);
    h16* O = (h16*)(p.ws + (dir ? OFF_OB : OFF_OF));
    float* USTATE = (float*)(p.ws + OFF_USTATE); float* DLOG = (float*)(p.ws + OFF_DLOG);
    const int ch_lo = seg * HG_SEGCH, ch_hi = ch_lo + HG_SEGCH;
    f32x4 S[8];
#pragma unroll
    for (int m = 0; m < 8; ++m) S[m] = (f32x4){0.f, 0.f, 0.f, 0.f};
    if (FULL && seg > 0) {
        for (int i = 0; i < seg; ++i) { const float* U = USTATE + (size_t)(item * 3 + i) * 16384; const float* DL = DLOG + (size_t)(item * 3 + i) * 128;
#pragma unroll
            for (int m = 0; m < 8; ++m)
#pragma unroll
                for (int j = 0; j < 4; ++j) { const int k = 16 * m + 4 * fq + j; const float d = (i > 0) ? __builtin_amdgcn_exp2f(DL[k]) : 0.f; S[m][j] = d * S[m][j] + U[k * 128 + 16 * wave + fr]; } } }
    float dl0 = 0.f, dl1 = 0.f;
    for (int i = tid; i < 8192 / 16; i += NTHREADS) ((LAS u32x4*)(lds + HG_AM))[i] = (u32x4){0u, 0u, 0u, 0u};
    const int kp = lane;
    const unsigned chan = (unsigned)(h * 128 + 2 * kp);
    int bw_rm = wave * 8 * HG_RP + 4 * kp;
    int bw_t0 = (2 * kp) * 128 + ((wave ^ ((2 * kp) & 7)) << 4), bw_t1 = (2 * kp + 1) * 128 + ((wave ^ ((2 * kp + 1) & 7)) << 4);
    int br_rm = fr * HG_RP + 16 * fq;
    int br_qd = HG_QD + fr * HG_RP + 8 * fq;
    int br_t0 = fr * 128 + ((fq ^ (fr & 7)) << 4), br_t1 = fr * 128 + (((4 + fq) ^ (fr & 7)) << 4);
    HG_OPAQUE(bw_rm); HG_OPAQUE(bw_t0); HG_OPAQUE(bw_t1); HG_OPAQUE(br_rm); HG_OPAQUE(br_qd); HG_OPAQUE(br_t0); HG_OPAQUE(br_t1);
    int br_v0 = br_t0 + HG_VT + wave * 2048, br_v1 = br_t1 + HG_VT + wave * 2048, br_k0 = br_t0 + HG_KDT, br_k1 = br_t1 + HG_KDT, br_a0 = br_t0 + HG_AM, br_a1 = br_t1 + HG_AM;
    HG_OPAQUE(br_v0); HG_OPAQUE(br_v1); HG_OPAQUE(br_k0); HG_OPAQUE(br_k1); HG_OPAQUE(br_a0); HG_OPAQUE(br_a1);
    LAS float* DEC = (LAS float*)(lds + HG_DEC); LAS float* SEG = (LAS float*)(lds + HG_SEG);
    unsigned lfr[8], qr[8], vr[8];
#pragma unroll
    for (int r = 0; r < 8; ++r) { const unsigned eo = (unsigned)hgrn_row(ch_lo * 64 + 8 * wave + r, b, dir) * 512u + chan; lfr[r] = *(const unsigned*)(LF + eo); vr[r] = *(const unsigned*)(V + eo);
        qr[r] = (FULL && ch_lo >= LC / 64) ? *(const unsigned*)(Q + eo) : 0u; }
    for (int ch = ch_lo; ch < ch_hi; ++ch) {
        const bool latent = FULL && (ch >= LC / 64);
        float f0[8], f1[8]; float run0 = 0.f, run1 = 0.f;
#pragma unroll
        for (int r = 0; r < 8; ++r) { const h16x2 l = __builtin_bit_cast(h16x2, lfr[r]); const float l0 = (float)l[0], l1 = (float)l[1]; run0 += l0; run1 += l1;
            f0[r] = __builtin_amdgcn_exp2f(l0); f1[r] = __builtin_amdgcn_exp2f(l1); }
        *(LAS f32x2*)(SEG + wave * 128 + 2 * kp) = (f32x2){run0, run1};
        __syncthreads();
        float off0 = 0.f, off1 = 0.f, mid0 = 0.f, mid1 = 0.f, tot0 = 0.f, tot1 = 0.f;
#pragma unroll
        for (int w2 = 0; w2 < 8; ++w2) { const f32x2 tt = *(LAS f32x2*)(SEG + w2 * 128 + 2 * kp);
            if (w2 < wave) { off0 += tt[0]; off1 += tt[1]; } if (w2 < 4) { mid0 += tt[0]; mid1 += tt[1]; } tot0 += tt[0]; tot1 += tt[1]; }
        dl0 += tot0; dl1 += tot1;
        const float em0 = __builtin_amdgcn_exp2f(mid0), em1 = __builtin_amdgcn_exp2f(mid1), el0 = __builtin_amdgcn_exp2f(tot0 - mid0), el1 = __builtin_amdgcn_exp2f(tot1 - mid1);
        if (wave == 0) *(LAS f32x2*)(DEC + 2 * kp) = (f32x2){__builtin_amdgcn_exp2f(tot0), __builtin_amdgcn_exp2f(tot1)};
        float e2a[8], e2b[8];
        e2a[7] = __builtin_amdgcn_exp2f(mid0 - (off0 + run0)); e2b[7] = __builtin_amdgcn_exp2f(mid1 - (off1 + run1));
#pragma unroll
        for (int r = 7; r > 0; --r) { e2a[r - 1] = e2a[r] * f0[r]; e2b[r - 1] = e2b[r] * f1[r]; }
        float e1a = FULL ? __builtin_amdgcn_exp2f(off0 - mid0) : 0.f, e1b = FULL ? __builtin_amdgcn_exp2f(off1 - mid1) : 0.f;
        unsigned kd0[4], kd1[4], vt0[4], vt1[4];
#pragma unroll
        for (int r = 0; r < 8; ++r) {
            const h16x2 q = __builtin_bit_cast(h16x2, qr[r]), v = __builtin_bit_cast(h16x2, vr[r]);
            const float e20 = e2a[r], e21 = e2b[r];
            const float k0 = 1.0f - f0[r], k1 = 1.0f - f1[r];
            const float kt0 = k0 * e20, kt1 = k1 * e21;
            if (FULL) {
                e1a *= f0[r]; e1b *= f1[r]; const float e10 = e1a, e11 = e1b;
                const float qt0 = (float)q[0] * e10, qt1 = (float)q[1] * e11;
                *(LAS unsigned*)(lds + bw_rm + HG_QT + r * HG_RP) = cvt_pk_bf16(qt0, qt1);
                *(LAS unsigned*)(lds + bw_rm + HG_KT + r * HG_RP) = cvt_pk_bf16(kt0, kt1);
                *(LAS unsigned*)(lds + bw_rm + HG_QD + r * HG_RP) = cvt_pk_bf16(qt0 * em0, qt1 * em1);
            }
            const float kdv0 = kt0 * el0, kdv1 = kt1 * el1;
            if (r & 1) { kd0[r >> 1] = cvt_pk_bf16(__builtin_bit_cast(float, kd0[r >> 1]), kdv0); kd1[r >> 1] = cvt_pk_bf16(__builtin_bit_cast(float, kd1[r >> 1]), kdv1);
                         vt0[r >> 1] = cvt_pk_bf16(__builtin_bit_cast(float, vt0[r >> 1]), (float)v[0]); vt1[r >> 1] = cvt_pk_bf16(__builtin_bit_cast(float, vt1[r >> 1]), (float)v[1]); }
            else { kd0[r >> 1] = __builtin_bit_cast(unsigned, kdv0); kd1[r >> 1] = __builtin_bit_cast(unsigned, kdv1);
                   vt0[r >> 1] = __builtin_bit_cast(unsigned, (float)v[0]); vt1[r >> 1] = __builtin_bit_cast(unsigned, (float)v[1]); }
        }
        *(LAS u32x4*)(lds + bw_t0 + HG_KDT) = (u32x4){kd0[0], kd0[1], kd0[2], kd0[3]};
        *(LAS u32x4*)(lds + bw_t1 + HG_KDT) = (u32x4){kd1[0], kd1[1], kd1[2], kd1[3]};
        *(LAS u32x4*)(lds + bw_t0 + HG_VT) = (u32x4){vt0[0], vt0[1], vt0[2], vt0[3]};
        *(LAS u32x4*)(lds + bw_t1 + HG_VT) = (u32x4){vt1[0], vt1[1], vt1[2], vt1[3]};
        __syncthreads();
        if (ch + 1 < ch_hi) { const bool lat2 = FULL && ((ch + 1) >= LC / 64);
#pragma unroll
            for (int r = 0; r < 8; ++r) { const unsigned eo = (unsigned)hgrn_row((ch + 1) * 64 + 8 * wave + r, b, dir) * 512u + chan;
                lfr[r] = *(const unsigned*)(LF + eo); vr[r] = *(const unsigned*)(V + eo); qr[r] = lat2 ? *(const unsigned*)(Q + eo) : 0u; } }
        if (latent) {
#pragma unroll
            for (int rep = 0; rep < 2; ++rep) {
                const int tile = wave + 8 * rep;
                if (tile < 10) {
                    const int ti = tile < 1 ? 0 : tile < 3 ? 1 : tile < 6 ? 2 : 3, si = tile - (ti * (ti + 1)) / 2;
                    f32x4 acc = (f32x4){0.f, 0.f, 0.f, 0.f};
                    LAS unsigned char* pa = lds + br_rm + HG_KT + 16 * si * HG_RP; LAS unsigned char* pb = lds + br_rm + HG_QT + 16 * ti * HG_RP;
#pragma unroll
                    for (int kk = 0; kk < 4; ++kk) acc = __builtin_amdgcn_mfma_f32_16x16x32_bf16(*(LAS s16x8*)(pa + 64 * kk), *(LAS s16x8*)(pb + 64 * kk), acc, 0, 0, 0);
                    const int t = 16 * ti + fr, s0 = 16 * si + 4 * fq;
                    if (ti == si) {
#pragma unroll
                        for (int j = 0; j < 4; ++j) acc[j] = (s0 + j <= t) ? acc[j] : 0.f; }
                    *(LAS u32x2*)(lds + HG_AM + t * 128 + ((((s0 >> 3)) ^ (fr & 7)) << 4) + (s0 & 7) * 2) = (u32x2){cvt_pk_bf16(acc[0], acc[1]), cvt_pk_bf16(acc[2], acc[3])};
                }
            }
        }
        __syncthreads();
        const s16x8 vf0 = *(LAS s16x8*)(lds + br_v0), vf1 = *(LAS s16x8*)(lds + br_v1);
        if (latent) {
            s16x8 sfrag[4];
#pragma unroll
            for (int kk = 0; kk < 4; ++kk) { const unsigned w0 = cvt_pk_bf16(S[2 * kk][0], S[2 * kk][1]), w1 = cvt_pk_bf16(S[2 * kk][2], S[2 * kk][3]),
                                                          w2 = cvt_pk_bf16(S[2 * kk + 1][0], S[2 * kk + 1][1]), w3 = cvt_pk_bf16(S[2 * kk + 1][2], S[2 * kk + 1][3]);
                sfrag[kk] = __builtin_bit_cast(s16x8, (u32x4){w0, w1, w2, w3}); }
#pragma unroll
            for (int ti = 0; ti < 4; ++ti) {
                f32x4 acc = (f32x4){0.f, 0.f, 0.f, 0.f};
                acc = __builtin_amdgcn_mfma_f32_16x16x32_bf16(vf0, *(LAS s16x8*)(lds + br_a0 + 2048 * ti), acc, 0, 0, 0);
                if (ti >= 2) acc = __builtin_amdgcn_mfma_f32_16x16x32_bf16(vf1, *(LAS s16x8*)(lds + br_a1 + 2048 * ti), acc, 0, 0, 0);
#pragma unroll
                for (int kk = 0; kk < 4; ++kk) {
                    const s16x4 lo = *(LAS s16x4*)(lds + br_qd + 16 * ti * HG_RP + 64 * kk), hi = *(LAS s16x4*)(lds + br_qd + 16 * ti * HG_RP + 64 * kk + 32);
                    const s16x8 bf = (s16x8){lo[0], lo[1], lo[2], lo[3], hi[0], hi[1], hi[2], hi[3]};
                    acc = __builtin_amdgcn_mfma_f32_16x16x32_bf16(sfrag[kk], bf, acc, 0, 0, 0); }
                const unsigned oo = (unsigned)hgrn_row(ch * 64 + 16 * ti + fr, b, dir) * 512u + (unsigned)(h * 128 + 16 * wave + 4 * fq);
                *(u32x2*)(O + oo) = (u32x2){pk2(acc[0], acc[1]), pk2(acc[2], acc[3])};
            }
        }
#pragma unroll
        for (int m = 0; m < 8; ++m) {
            const f32x4 dc = *(LAS f32x4*)(DEC + 16 * m + 4 * fq);
            S[m] = S[m] * dc;
            S[m] = __builtin_amdgcn_mfma_f32_16x16x32_bf16(*(LAS s16x8*)(lds + br_k0 + 2048 * m), vf0, S[m], 0, 0, 0);
            S[m] = __builtin_amdgcn_mfma_f32_16x16x32_bf16(*(LAS s16x8*)(lds + br_k1 + 2048 * m), vf1, S[m], 0, 0, 0);
        }
    }
    if (!FULL) {
        float* U = USTATE + (size_t)(item * 3 + seg) * 16384;
#pragma unroll
        for (int m = 0; m < 8; ++m)
#pragma unroll
            for (int j = 0; j < 4; ++j) U[(16 * m + 4 * fq + j) * 128 + 16 * wave + fr] = S[m][j];
        if (wave == 0) *(f32x2*)(DLOG + (size_t)(item * 3 + seg) * 128 + 2 * kp) = (f32x2){dl0, dl1};
    }
    __syncthreads();
}

__device__ __forceinline__ void fft1_phase(const Params& p, LAS unsigned char* lds) {
    LAS float* ctab = (LAS float*)lds;
    LAS float* w16 = ctab + 4096;
    for (int i = threadIdx.x; i < 4096; i += NTHREADS) ctab[i] = cospif((float)i / 2048.0f);
    if (threadIdx.x < 16) { w16[threadIdx.x] = cospif((float)threadIdx.x / 8.0f); w16[16 + threadIdx.x] = sinpif((float)threadIdx.x / 8.0f); }
    __syncthreads();
    const h16* F = (const h16*)(p.ws + OFF_FTT); h16* Y1 = (h16*)(p.ws + OFF_Y1);
    const int ap = threadIdx.x & 127, gl = threadIdx.x >> 7;
    volatile LAS unsigned* slot = (volatile LAS unsigned*)(lds + LDS_BYTES - 64) + 9;
    unsigned* ctr = (unsigned*)(p.ws + OFF_CTL) + CTL_P0Q + 64;
    if (threadIdx.x == 0) slot[0] = xb_add(ctr, 1u);
    __syncthreads();
    int item = (int)slot[0];
    __syncthreads();
    while (item < 8 * 128) {
        unsigned nxt_ = 0u;
        if (threadIdx.x == 0) nxt_ = xb_add(ctr, 1u);
        const int b = item >> 7, gk = (item & 127) * 4 + gl;
        float zr[16][2], zi[16][2];
        const h16* src = F + ((size_t)(b * 512 + gk) * 2) * 4096 + 2 * ap;
#pragma unroll
        for (int r = 0; r < 16; ++r) { const h16x2 c2 = *(const h16x2*)(src + 256 * r), s2 = *(const h16x2*)(src + 4096 + 256 * r);
            zr[r][0] = (float)c2[0]; zr[r][1] = (float)c2[1]; zi[r][0] = -(float)s2[0]; zi[r][1] = -(float)s2[1]; }
        float ur[4][4][2], ui[4][4][2];
#pragma unroll
        for (int r0 = 0; r0 < 4; ++r0)
#pragma unroll
            for (int j = 0; j < 2; ++j) {
                const float a0r = zr[r0][j], a0i = zi[r0][j], a1r = zr[4 + r0][j], a1i = zi[4 + r0][j], a2r = zr[8 + r0][j], a2i = zi[8 + r0][j], a3r = zr[12 + r0][j], a3i = zi[12 + r0][j];
                const float s0r = a0r + a2r, s0i = a0i + a2i, s1r = a0r - a2r, s1i = a0i - a2i, s2r = a1r + a3r, s2i = a1i + a3i, s3r = a1r - a3r, s3i = a1i - a3i;
                float xr[4], xi[4];
                xr[0] = s0r + s2r; xi[0] = s0i + s2i; xr[2] = s0r - s2r; xi[2] = s0i - s2i;
                xr[1] = s1r + s3i; xi[1] = s1i - s3r;
                xr[3] = s1r - s3i; xi[3] = s1i + s3r;
#pragma unroll
                for (int d0 = 0; d0 < 4; ++d0) { const int m = r0 * d0;
                    const float cs = (m == 0) ? 1.f : (m == 1) ? 0.92387953251f : (m == 2) ? 0.70710678119f : (m == 3) ? 0.38268343237f : (m == 4) ? 0.f : (m == 6) ? -0.70710678119f : -0.92387953251f;
                    const float sn = (m == 0) ? 0.f : (m == 1) ? 0.38268343237f : (m == 2) ? 0.70710678119f : (m == 3) ? 0.92387953251f : (m == 4) ? 1.f : (m == 6) ? 0.70710678119f : -0.38268343237f;
                    ur[r0][d0][j] = xr[d0] * cs + xi[d0] * sn; ui[r0][d0][j] = xi[d0] * cs - xr[d0] * sn; } }
#pragma unroll
        for (int d0 = 0; d0 < 4; ++d0) {
            float yr4[4][2], yi4[4][2];
#pragma unroll
            for (int j = 0; j < 2; ++j) {
                const float a0r = ur[0][d0][j], a0i = ui[0][d0][j], a1r = ur[1][d0][j], a1i = ui[1][d0][j], a2r = ur[2][d0][j], a2i = ui[2][d0][j], a3r = ur[3][d0][j], a3i = ui[3][d0][j];
                const float s0r = a0r + a2r, s0i = a0i + a2i, s1r = a0r - a2r, s1i = a0i - a2i, s2r = a1r + a3r, s2i = a1i + a3i, s3r = a1r - a3r, s3i = a1i - a3i;
                yr4[0][j] = s0r + s2r; yi4[0][j] = s0i + s2i; yr4[2][j] = s0r - s2r; yi4[2][j] = s0i - s2i;
                yr4[1][j] = s1r + s3i; yi4[1][j] = s1i - s3r; yr4[3][j] = s1r - s3i; yi4[3][j] = s1i + s3r; }
#pragma unroll
            for (int d1 = 0; d1 < 4; ++d1) { const int d = d0 + 4 * d1;
                float ore[2], oim[2];
#pragma unroll
                for (int j = 0; j < 2; ++j) { const int t = ((2 * ap + j) * d) & 4095; const float ct = ctab[t], st = ctab[(t - 1024) & 4095];
                    ore[j] = (yr4[d1][j] * ct + yi4[d1][j] * st) * 0.0625f; oim[j] = (yi4[d1][j] * ct - yr4[d1][j] * st) * 0.0625f; }
            h16* dst = Y1 + ((size_t)((b * 16 + d) * 512 + gk)) * 512 + 2 * ap;
            *(unsigned*)dst = pk2(ore[0], ore[1]); *(unsigned*)(dst + 256) = pk2(oim[0], oim[1]);
            }
        }
        if (threadIdx.x == 0) slot[0] = nxt_;
        __syncthreads();
        item = (int)slot[0];
        __syncthreads();
    }
    __syncthreads();
}

__device__ __forceinline__ void a1_prepass(const Params& p) {
    const int wave = threadIdx.x >> 6, lane = threadIdx.x & 63;
    const h16* OF = (const h16*)(p.ws + OFF_OF); const h16* OB = (const h16*)(p.ws + OFF_OB); h16* G = (h16*)(p.ws + OFF_G);
    const float* hgn = p.in[11];
    float hg[8];
#pragma unroll
    for (int j = 0; j < 8; ++j) hg[j] = hgn[lane * 8 + j];
    for (int t0 = (blockIdx.x * 8 + wave) * 4; t0 < T; t0 += gridDim.x * 32) {
        h16x8 a[4], bq[4], g[4];
#pragma unroll
        for (int q = 0; q < 4; ++q) { const size_t off = (size_t)(t0 + q) * 512 + lane * 8; a[q] = *(const h16x8*)(OF + off); bq[q] = *(const h16x8*)(OB + off); g[q] = *(const h16x8*)(G + off); }
#pragma unroll
        for (int q = 0; q < 4; ++q) {
            float o[8]; float ss = 0.f;
#pragma unroll
            for (int j = 0; j < 8; ++j) { o[j] = (float)a[q][j] + (float)bq[q][j]; ss += o[j] * o[j]; }
            ss += __shfl_xor(ss, 1); ss += __shfl_xor(ss, 2); ss += __shfl_xor(ss, 4); ss += __shfl_xor(ss, 8);
            const float rstd = rsqrtf(ss * (1.0f / 128.0f) + EPS);
            float r[8];
#pragma unroll
            for (int j = 0; j < 8; ++j) { const float gz = (float)g[q][j]; r[j] = o[j] * rstd * hg[j] * (gz * sigmoidf_(gz)); }
            u32x4 w; w.x = pk2(r[0], r[1]); w.y = pk2(r[2], r[3]); w.z = pk2(r[4], r[5]); w.w = pk2(r[6], r[7]);
            *(u32x4*)(G + (size_t)(t0 + q) * 512 + lane * 8) = w;
        }
    }
}

__device__ __forceinline__ void convert_tables(const Params& p, int vb, int vn) {
    const int wave = threadIdx.x >> 6, lane = threadIdx.x & 63;
    for (int r2 = vb * 8 + wave; r2 < 2 * 16384; r2 += vn * 8) {
        const int tb = r2 >> 14, e = r2 & 16383;
        const float* src = (tb ? p.in[18] : p.in[17]) + (size_t)e * D + lane * 16;
        f32x4 v[4]; float amax = 0.f;
#pragma unroll
        for (int j = 0; j < 4; ++j) { v[j] = *(const f32x4*)(src + 4 * j); amax = fmaxf(amax, fmaxf(fmaxf(fabsf(v[j].x), fabsf(v[j].y)), fmaxf(fabsf(v[j].z), fabsf(v[j].w)))); }
#pragma unroll
        for (int o = 32; o >= 1; o >>= 1) amax = fmaxf(amax, __shfl_xor(amax, o));
        const float qs = amax > 0.f ? amax * (1.0f / 127.0f) : 1.0f, inv = 1.0f / qs;
        const int bias = 0;
        u32x4 w;
#pragma unroll
        for (int j = 0; j < 4; ++j) { const int q0 = (int)rintf(v[j].x * inv) + bias, q1 = (int)rintf(v[j].y * inv) + bias, q2 = (int)rintf(v[j].z * inv) + bias, q3 = (int)rintf(v[j].w * inv) + bias;
            w[j] = (unsigned)(q0 & 255) | ((unsigned)(q1 & 255) << 8) | ((unsigned)(q2 & 255) << 16) | ((unsigned)(q3 & 255) << 24); }
        unsigned char* dst = p.ws + (tb ? OFF_TV : OFF_TU);
        *(u32x4*)(dst + ((size_t)(lane >> 3) * 16384 + e) * 128 + (lane & 7) * 16) = w;
        if (lane == 0) ((float*)(p.ws + (tb ? OFF_SV : OFF_SU)))[e] = qs;
    }
}

#define CE_DESC(a, b) do { const unsigned hi_ = max(a, b), lo_ = min(a, b); a = hi_; b = lo_; } while (0)
template <int N> __device__ __forceinline__ void sort16_desc(unsigned (&k)[N], const int base) {
    CE_DESC(k[base + 0], k[base + 1]); CE_DESC(k[base + 2], k[base + 3]); CE_DESC(k[base + 0], k[base + 2]); CE_DESC(k[base + 1], k[base + 3]); CE_DESC(k[base + 1], k[base + 2]); CE_DESC(k[base + 4], k[base + 5]); CE_DESC(k[base + 6], k[base + 7]); CE_DESC(k[base + 4], k[base + 6]);
    CE_DESC(k[base + 5], k[base + 7]); CE_DESC(k[base + 5], k[base + 6]); CE_DESC(k[base + 0], k[base + 4]); CE_DESC(k[base + 2], k[base + 6]); CE_DESC(k[base + 2], k[base + 4]); CE_DESC(k[base + 1], k[base + 5]); CE_DESC(k[base + 3], k[base + 7]); CE_DESC(k[base + 3], k[base + 5]);
    CE_DESC(k[base + 1], k[base + 2]); CE_DESC(k[base + 3], k[base + 4]); CE_DESC(k[base + 5], k[base + 6]); CE_DESC(k[base + 8], k[base + 9]); CE_DESC(k[base + 10], k[base + 11]); CE_DESC(k[base + 8], k[base + 10]); CE_DESC(k[base + 9], k[base + 11]); CE_DESC(k[base + 9], k[base + 10]);
    CE_DESC(k[base + 12], k[base + 13]); CE_DESC(k[base + 14], k[base + 15]); CE_DESC(k[base + 12], k[base + 14]); CE_DESC(k[base + 13], k[base + 15]); CE_DESC(k[base + 13], k[base + 14]); CE_DESC(k[base + 8], k[base + 12]); CE_DESC(k[base + 10], k[base + 14]); CE_DESC(k[base + 10], k[base + 12]);
    CE_DESC(k[base + 9], k[base + 13]); CE_DESC(k[base + 11], k[base + 15]); CE_DESC(k[base + 11], k[base + 13]); CE_DESC(k[base + 9], k[base + 10]); CE_DESC(k[base + 11], k[base + 12]); CE_DESC(k[base + 13], k[base + 14]); CE_DESC(k[base + 0], k[base + 8]); CE_DESC(k[base + 4], k[base + 12]);
    CE_DESC(k[base + 4], k[base + 8]); CE_DESC(k[base + 2], k[base + 10]); CE_DESC(k[base + 6], k[base + 14]); CE_DESC(k[base + 6], k[base + 10]); CE_DESC(k[base + 2], k[base + 4]); CE_DESC(k[base + 6], k[base + 8]); CE_DESC(k[base + 10], k[base + 12]); CE_DESC(k[base + 1], k[base + 9]);
    CE_DESC(k[base + 5], k[base + 13]); CE_DESC(k[base + 5], k[base + 9]); CE_DESC(k[base + 3], k[base + 11]); CE_DESC(k[base + 7], k[base + 15]); CE_DESC(k[base + 7], k[base + 11]); CE_DESC(k[base + 3], k[base + 5]); CE_DESC(k[base + 7], k[base + 9]); CE_DESC(k[base + 11], k[base + 13]);
    CE_DESC(k[base + 1], k[base + 2]); CE_DESC(k[base + 3], k[base + 4]); CE_DESC(k[base + 5], k[base + 6]); CE_DESC(k[base + 7], k[base + 8]); CE_DESC(k[base + 9], k[base + 10]); CE_DESC(k[base + 11], k[base + 12]); CE_DESC(k[base + 13], k[base + 14]);
}
template <int N> __device__ __forceinline__ void merge16_desc(unsigned (&k)[N], const int a, const int b) {
#pragma unroll
    for (int i = 0; i < 16; ++i) k[a + i] = max(k[a + i], k[b + 15 - i]);
#pragma unroll
    for (int stride = 8; stride > 0; stride /= 2)
#pragma unroll
        for (int i = 0; i < 16; ++i) if ((i & stride) == 0) CE_DESC(k[a + i], k[a + i + stride]);
}
__device__ __forceinline__ float hkey2f(unsigned key) { const unsigned u = key >> 16, b = (u & 0x8000u) ? (u ^ 0x8000u) : (~u & 0xFFFFu); return (float)__builtin_bit_cast(h16, (unsigned short)b); }
__device__ __forceinline__ void top16_of_128(const unsigned char* sc, unsigned (&out)[16]) {
    unsigned s[128];
#pragma unroll
    for (int c8 = 0; c8 < 16; ++c8) { const u32x4 t = *(const u32x4*)(sc + c8 * 1024);
#pragma unroll
        for (int w = 0; w < 4; ++w) { const int e0 = 2 * w, e1 = 2 * w + 1;
            const int col0 = 32 * (c8 >> 2) + 16 * (e0 >> 2) + 4 * (c8 & 3) + (e0 & 3), col1 = 32 * (c8 >> 2) + 16 * (e1 >> 2) + 4 * (c8 & 3) + (e1 & 3);
            s[8 * c8 + e0] = (t[w] << 16) | (unsigned)(127 - col0); s[8 * c8 + e1] = (t[w] & 0xFFFF0000u) | (unsigned)(127 - col1); } }
#pragma unroll
    for (int g = 0; g < 8; ++g) sort16_desc(s, 16 * g);
    merge16_desc(s, 0, 16); merge16_desc(s, 32, 48); merge16_desc(s, 64, 80); merge16_desc(s, 96, 112);
    merge16_desc(s, 0, 32); merge16_desc(s, 64, 96);
    merge16_desc(s, 0, 64);
#pragma unroll
    for (int i = 0; i < 16; ++i) out[i] = s[i];
}
__device__ __forceinline__ void topk_phase(const Params& p, LAS unsigned char* lds) {
    const unsigned char* SC = p.ws + OFF_SC; int* EIDX = (int*)(p.ws + OFF_EIDX); float* GATE = (float*)(p.ws + OFF_GATE);
    LAS unsigned* st = (LAS unsigned*)lds;
    const int tid = threadIdx.x;
#ifndef TOPK_REP
#define TOPK_REP 1
#endif
    for (int rr_ = 0; rr_ < TOPK_REP; ++rr_)
    for (int base = blockIdx.x * 4; base < (T / 64) * 8; base += gridDim.x * 4) {
        {
            const int w = tid >> 6, L = tid & 63, grp = base + (w >> 1), pp = w & 1;
            unsigned ks[16];
#pragma unroll
            for (int i = 0; i < 16; ++i) ks[i] = 0u;
            top16_of_128(SC + ((size_t)(grp * 2 + pp) * 16 * 64 + L) * 16, ks);
#pragma unroll
            for (int i = 0; i < 16; ++i) st[i * NTHREADS + tid] = ks[i];
        }
        __syncthreads();
        if (tid < 256) {
            const int q = tid >> 6, L = tid & 63, grp = base + q, tb = grp >> 3, hh = grp & 7;
            const int th = (tb * 64 + L) * 8 + hh;
            const int s0 = (2 * q) * 64 + L, s1 = (2 * q + 1) * 64 + L;
            float sv1[16];
#pragma unroll
            for (int j = 0; j < 16; ++j) sv1[j] = hkey2f(st[j * NTHREADS + s1]);
            unsigned cv[50];
            { int c = 0;
#pragma unroll
              for (int i = 0; i < 16; ++i) { const float a = hkey2f(st[i * NTHREADS + s0]);
#pragma unroll
                  for (int j = 0; j < 16; ++j) if ((i + 1) * (j + 1) <= 16) { cv[c] = (f2key(a + sv1[j]) & ~255u) | (unsigned)(255 - (i * 16 + j)); ++c; } } }
            unsigned c64[64];
#pragma unroll
            for (int i = 0; i < 64; ++i) c64[i] = (i < 50) ? cv[i] : 0u;
#pragma unroll
            for (int g = 0; g < 4; ++g) sort16_desc(c64, 16 * g);
            merge16_desc(c64, 0, 16); merge16_desc(c64, 32, 48); merge16_desc(c64, 0, 32);
            unsigned ok[16];
#pragma unroll
            for (int i = 0; i < 16; ++i) ok[i] = c64[i];
            float ex[16]; int oe[16]; float den = 0.f;
            const float v0 = key2f(ok[0] & ~255u);
#pragma unroll
            for (int i = 0; i < 16; ++i) { const int ij = 255 - (int)(ok[i] & 255u), ci = ij >> 4, cj = ij & 15;
                const int e0 = 127 - (int)(st[ci * NTHREADS + s0] & 127u), e1 = 127 - (int)(st[cj * NTHREADS + s1] & 127u);
                oe[i] = e0 * 128 + e1; ex[i] = __expf(key2f(ok[i] & ~255u) - v0); den += ex[i]; }
            const float inv = 1.0f / den;
#pragma unroll
            for (int i = 0; i < 4; ++i) {
                *(f32x4*)(GATE + (size_t)th * 16 + 4 * i) = (f32x4){ex[4 * i] * inv, ex[4 * i + 1] * inv, ex[4 * i + 2] * inv, ex[4 * i + 3] * inv};
                *(int4*)(EIDX + (size_t)th * 16 + 4 * i) = make_int4(oe[4 * i], oe[4 * i + 1], oe[4 * i + 2], oe[4 * i + 3]); }
        }
        __syncthreads();
    }
}

struct XcdInfo { int px, npop, rank, nloc; };
__device__ __forceinline__ float dot8(const h16x8 a, const h16x8 b, float s) {
    s = __builtin_amdgcn_fdot2((h16x2){a[0], a[1]}, (h16x2){b[0], b[1]}, s, false); s = __builtin_amdgcn_fdot2((h16x2){a[2], a[3]}, (h16x2){b[2], b[3]}, s, false);
    s = __builtin_amdgcn_fdot2((h16x2){a[4], a[5]}, (h16x2){b[4], b[5]}, s, false); s = __builtin_amdgcn_fdot2((h16x2){a[6], a[7]}, (h16x2){b[6], b[7]}, s, false); return s; }
struct PeerTok { int t; bool ok; };
#define PEER_TOUCH(R) do { unsigned tt_ = (R).w; asm volatile("" : "+v"(tt_)); (R).w = tt_; __builtin_amdgcn_sched_barrier(0); } while (0)
__device__ __forceinline__ PeerTok peer_tok(int i, int t0, int step) { const int t = t0 + i * step; PeerTok r; r.ok = t < T; r.t = r.ok ? t : (T - 1); return r; }
__device__ __forceinline__ void peer_ld_e(const int* EIDX, int t, int g, int (&e)[16]) {
#pragma unroll
    for (int q = 0; q < 4; ++q) { const int4 v = *(const int4*)(EIDX + (size_t)t * 128 + 16 * g + 4 * q); e[4 * q] = v.x; e[4 * q + 1] = v.y; e[4 * q + 2] = v.z; e[4 * q + 3] = v.w; } }
__device__ __forceinline__ void peer_ld_rows(const unsigned char* tab, const int (&e)[16], u32x4 (&r)[16]) {
#pragma unroll
    for (int j = 0; j < 16; ++j) r[j] = *(const u32x4*)(tab + (size_t)e[j] * 128); }
__device__ __forceinline__ void peer_u_compute(const u32x4 (&r)[16], const u32x4 xv, h16* PACT, int s, PeerTok tk, int lane, int g, int c) {
    float pj[16];
#pragma unroll
    for (int j = 0; j < 16; ++j) { int d = __builtin_amdgcn_sdot4((int)r[j].x, (int)xv.x, 0, false); d = __builtin_amdgcn_sdot4((int)r[j].y, (int)xv.y, d, false);
        d = __builtin_amdgcn_sdot4((int)r[j].z, (int)xv.z, d, false); d = __builtin_amdgcn_sdot4((int)r[j].w, (int)xv.w, d, false); pj[j] = (float)d; }
#define RED_STEP(NIN, MASK) _Pragma("unroll") for (int j = 0; j < (NIN) / 2; ++j) { const bool up = (lane & (MASK)) != 0; \
    const float keep = up ? pj[2 * j + 1] : pj[2 * j], send = up ? pj[2 * j] : pj[2 * j + 1]; pj[j] = keep + __shfl_xor(send, (MASK)); }
    RED_STEP(16, 1) RED_STEP(8, 2) RED_STEP(4, 4)
#undef RED_STEP
    { const bool up = (lane & 1) != 0; const float keep = up ? pj[1] : pj[0], send = up ? pj[0] : pj[1], recv = __shfl_xor(send, 1);
      const unsigned w = up ? pk2(recv * 0.015625f, keep * 0.015625f) : pk2(keep * 0.015625f, recv * 0.015625f);
      if (tk.ok) *(unsigned*)(PACT + ((size_t)s * T + tk.t) * 128 + 16 * g + (up ? 7 + c : c)) = w; }
}
__device__ __forceinline__ void peer_u_phase(const Params& p, const XcdInfo xi) {
    const int wave = threadIdx.x >> 6, lane = threadIdx.x & 63, g = lane >> 3, c = lane & 7;
    const unsigned char* QX = (const unsigned char*)(p.ws + OFF_QX); const unsigned char* TU = (const unsigned char*)(p.ws + OFF_TU);
    const int* EIDX = (const int*)(p.ws + OFF_EIDX); h16* PACT = (h16*)(p.ws + OFF_PACT);
    const int t0 = xi.rank * 8 + wave, step = xi.nloc * 8, ntok = (T - t0 + step - 1) / step;
    for (int s = xi.px; s < 8; s += xi.npop) {
        const unsigned char* tus = TU + (size_t)s * 16384 * 128 + 16 * c; const unsigned char* qxs = QX + s * 128 + 16 * c;
        int eN[16]; u32x4 rA[16], rB[16]; u32x4 xA, xB;
        { PeerTok k0 = peer_tok(0, t0, step); peer_ld_e(EIDX, k0.t, g, eN); xA = *(const u32x4*)(qxs + (size_t)k0.t * D); peer_ld_rows(tus, eN, rA);
          PeerTok k1 = peer_tok(1, t0, step); peer_ld_e(EIDX, k1.t, g, eN); }
        for (int i = 0; i < ntok; i += 2) {
            { const PeerTok k1 = peer_tok(i + 1, t0, step), k2 = peer_tok(i + 2, t0, step);
              PEER_TOUCH(rA[15]);
              xB = *(const u32x4*)(qxs + (size_t)k1.t * D); peer_ld_rows(tus, eN, rB); peer_ld_e(EIDX, k2.t, g, eN);
              __builtin_amdgcn_sched_barrier(0);
              peer_u_compute(rA, xA, PACT, s, peer_tok(i, t0, step), lane, g, c);
              __builtin_amdgcn_sched_barrier(0); }
            { const PeerTok k2 = peer_tok(i + 2, t0, step), k3 = peer_tok(i + 3, t0, step);
              PEER_TOUCH(rB[15]);
              xA = *(const u32x4*)(qxs + (size_t)k2.t * D); peer_ld_rows(tus, eN, rA); peer_ld_e(EIDX, k3.t, g, eN);
              __builtin_amdgcn_sched_barrier(0);
              PeerTok k1 = peer_tok(i + 1, t0, step); k1.ok = k1.ok && (i + 1 < ntok);
              peer_u_compute(rB, xB, PACT, s, k1, lane, g, c);
              __builtin_amdgcn_sched_barrier(0); }
        }
    }
}
#ifdef PEER_U_MFMA
#define KIDX kslot
#else
#define KIDX k
#endif
__device__ __forceinline__ void peer_combine(const Params& p) {
    const int wave = threadIdx.x >> 6, lane = threadIdx.x & 63;
    const h16* PACT = (const h16*)(p.ws + OFF_PACT); const float* GATE = (const float*)(p.ws + OFF_GATE); unsigned char* SIDE = p.ws + OFF_SIDE;
    const int* EIDX = (const int*)(p.ws + OFF_EIDX); const float* SU = (const float*)(p.ws + OFF_SU); const float* SV = (const float*)(p.ws + OFF_SV); const float* SX = (const float*)(p.ws + OFF_SX);
    for (int t = blockIdx.x * 8 + wave; t < T; t += gridDim.x * 8) {
        const float sx = SX[t] * 64.0f; float w[2]; float a[2] = {0.f, 0.f}; float amax = 0.f;
#pragma unroll
        for (int s = 0; s < 8; ++s) { const h16x2 v = *(const h16x2*)(PACT + ((size_t)s * T + t) * 128 + 2 * lane); a[0] += (float)v[0]; a[1] += (float)v[1]; }
        const int2 e2 = *(const int2*)(EIDX + (size_t)t * 128 + 2 * lane); const float2 g2 = *(const float2*)(GATE + (size_t)t * 128 + 2 * lane);
        const int e[2] = {e2.x, e2.y}; const float gt[2] = {g2.x, g2.y};
#pragma unroll
        for (int j = 0; j < 2; ++j) {
            const float act = a[j] * sx * SU[e[j]];
            w[j] = gt[j] * (0.5f * act * (1.0f + erff(act * 0.70710678118654752f))) * SV[e[j]];
            amax = fmaxf(amax, fabsf(w[j])); }
#pragma unroll
        for (int o = 32; o >= 1; o >>= 1) amax = fmaxf(amax, __shfl_xor(amax, o));
        const float inv = amax > 0.f ? 16256.0f / amax : 0.f;
        unsigned char* rec = SIDE + (size_t)t * 1024;
        *(int2*)(rec + 8 * lane) = e2;
#pragma unroll
        for (int j = 0; j < 2; ++j) { const int k = 2 * lane + j; const int W = (int)rintf(w[j] * inv); const int hi = W >> 7, lo = W & 127;
            const int y = k >> 4, ks = (k >> 3) & 1, h = (k >> 2) & 1, gk = k & 3, off = 512 + ks * 128 + gk * 16 + 8 * h + y;
            rec[off] = (unsigned char)(hi & 255); rec[off + 64] = (unsigned char)lo; }
        if (lane == 0) *(float*)(rec + 768) = amax * (1.0f / 16256.0f);
    }
}
typedef int i32x4 __attribute__((ext_vector_type(4)));
__device__ __forceinline__ unsigned lds_addr(const volatile LAS void* p) { return (unsigned)(size_t)p; }
__device__ __forceinline__ void glds16_asm(const void* gsrc, unsigned lds_dst) {
    unsigned keep;
    asm volatile("s_mov_b32 %0, m0\n\ts_mov_b32 m0, %2\n\ts_nop 0\n\tglobal_load_lds_dwordx4 %1, off\n\ts_mov_b32 m0, %0" : "=&s"(keep) : "v"(gsrc), "s"(lds_dst) : "memory");
}
#define PV_WAIT_VM(n) asm volatile("s_waitcnt vmcnt(" #n ")" ::: "memory")
__device__ __forceinline__ void pv_fill(const unsigned char* tvs, LAS unsigned char* lds, unsigned side_slot, unsigned ring_buf, const int ks, int lane) {
    const int g = lane >> 3;
    const u32x4 i0 = *(LAS u32x4*)(lds + side_slot + (16 * g + 8 * ks) * 4), i1 = *(LAS u32x4*)(lds + side_slot + (16 * g + 8 * ks + 4) * 4);
    const unsigned ids[8] = {i0.x, i0.y, i0.z, i0.w, i1.x, i1.y, i1.z, i1.w};
#pragma unroll
    for (int m = 0; m < 8; ++m) glds16_asm(tvs + (size_t)ids[m] * 128 + ((((lane & 7) ^ g ^ (m & 1))) << 4), ring_buf + m * 1024);
}
__device__ __forceinline__ void pv_kstep(LAS unsigned char* lds, unsigned ring_buf, const i32x4 afrag, i32x4 (&acc)[8], int lane) {
    const int gk = lane >> 4, q = (lane & 15) >> 1, pp = lane & 1;
    const unsigned base0 = ring_buf + (8 * gk + q) * 128 + 8 * pp;
    const int xr = q ^ (gk & 1);
#pragma unroll
    for (int ng = 0; ng < 2; ++ng) {
        u32x2 r[8];
#pragma unroll
        for (int j = 0; j < 4; ++j) { const int n = 4 * ng + j;
#pragma unroll
            for (int h = 0; h < 2; ++h) { const unsigned a = base0 + h * 4096 + (((unsigned)(n ^ xr)) << 4);
                asm volatile("ds_read_b64_tr_b8 %0, %1" : "=v"(r[2 * j + h]) : "v"(a) : "memory"); } }
        asm volatile("s_waitcnt lgkmcnt(0)" : "+v"(r[0]), "+v"(r[1]), "+v"(r[2]), "+v"(r[3]), "+v"(r[4]), "+v"(r[5]), "+v"(r[6]), "+v"(r[7]) :: "memory");
        __builtin_amdgcn_sched_barrier(0);
#pragma unroll
        for (int j = 0; j < 4; ++j) { const i32x4 bf = (i32x4){(int)r[2 * j].x, (int)r[2 * j].y, (int)r[2 * j + 1].x, (int)r[2 * j + 1].y};
            acc[4 * ng + j] = __builtin_amdgcn_mfma_i32_16x16x64_i8(afrag, bf, acc[4 * ng + j], 0, 0, 0); }
    }
}
__device__ __forceinline__ void peer_v_phase(const Params& p, LAS unsigned char* lds, const XcdInfo xi) {
    const int wave = __builtin_amdgcn_readfirstlane(threadIdx.x >> 6), lane = threadIdx.x & 63;
    const unsigned char* TV = p.ws + OFF_TV; const unsigned char* SIDE = p.ws + OFF_SIDE; h16* PO = (h16*)(p.ws + OFF_PO);
    const int t0 = xi.rank * 8 + wave, step = xi.nloc * 8, ntok = (T - t0 + step - 1) / step;
    const unsigned ring = __builtin_amdgcn_readfirstlane(lds_addr(lds + wave * 16384)), side = __builtin_amdgcn_readfirstlane(lds_addr(lds + 131072 + wave * 3072));
    LAS unsigned char* l0 = (LAS unsigned char*)0;
    for (int s = xi.px; s < 8; s += xi.npop) {
        const unsigned char* tvs = TV + (size_t)s * 16384 * 128;
        glds16_asm(SIDE + (size_t)peer_tok(0, t0, step).t * 1024 + lane * 16, side);
        glds16_asm(SIDE + (size_t)peer_tok(1, t0, step).t * 1024 + lane * 16, side + 1024);
        PV_WAIT_VM(0);
        pv_fill(tvs, l0, side, ring, 0, lane); pv_fill(tvs, l0, side, ring + 8192, 1, lane);
        for (int i = 0; i < ntok; ++i) {
            const unsigned sl_cur = side + (unsigned)(i % 3) * 1024, sl_nxt = side + (unsigned)((i + 1) % 3) * 1024, sl_nn = side + (unsigned)((i + 2) % 3) * 1024;
            i32x4 acc[8];
#pragma unroll
            for (int n = 0; n < 8; ++n) acc[n] = (i32x4){0, 0, 0, 0};
            if (i == 0) PV_WAIT_VM(8); else PV_WAIT_VM(16);
            const int fi = lane & 15;
            const i32x4 z4 = (i32x4){0, 0, 0, 0};
            i32x4 af = *(LAS i32x4*)(l0 + sl_cur + 512 + (fi < 2 ? fi : 0) * 64 + (lane >> 4) * 16); af = fi < 2 ? af : z4;
            pv_kstep(l0, ring, af, acc, lane);
            glds16_asm(SIDE + (size_t)peer_tok(i + 2, t0, step).t * 1024 + lane * 16, sl_nn);
            pv_fill(tvs, l0, sl_nxt, ring, 0, lane);
            PV_WAIT_VM(9);
            af = *(LAS i32x4*)(l0 + sl_cur + 512 + 128 + (fi < 2 ? fi : 0) * 64 + (lane >> 4) * 16); af = fi < 2 ? af : z4;
            pv_kstep(l0, ring + 8192, af, acc, lane);
            const float sw = *(LAS float*)(l0 + sl_cur + 768);
            const PeerTok tk = peer_tok(i, t0, step);
            h16* po = PO + (size_t)(tk.ok ? tk.t : T) * D + s * 128 + (lane & 15);
            if (lane < 16) {
#pragma unroll
                for (int n = 0; n < 8; ++n) { const h16 v = (h16)((float)(128 * acc[n][0] + acc[n][1]) * sw); const unsigned vb = (unsigned)__builtin_bit_cast(unsigned short, v);
                    asm volatile("global_store_short %0, %1, off" :: "v"(po + 16 * n), "v"(vb) : "memory"); }
            }
            pv_fill(tvs, l0, sl_nxt, ring + 8192, 1, lane);
        }
        PV_WAIT_VM(0);
    }
}
__device__ __forceinline__ void pu_buffer(LAS unsigned char* l0, unsigned ring_buf, unsigned side_slot, i32x4 (&acc)[4], int lane) {
    const int i = lane & 15, gk = lane >> 4;
#pragma unroll
    for (int kc = 0; kc < 2; ++kc) {
        i32x4 bx = *(LAS i32x4*)(l0 + side_slot + 512 + 64 * kc + 16 * gk); bx = (i == 0) ? bx : (i32x4){0, 0, 0, 0};
#pragma unroll
        for (int mt = 0; mt < 4; ++mt) { const int r = 16 * mt + i;
            const i32x4 af = *(LAS i32x4*)(l0 + ring_buf + r * 128 + ((((4 * kc + gk) ^ (r & 7) ^ ((r >> 3) & 1))) << 4));
            acc[mt] = __builtin_amdgcn_mfma_i32_16x16x64_i8(af, bx, acc[mt], 0, 0, 0); }
    }
}
__device__ __forceinline__ void peer_u_phase_mfma(const Params& p, LAS unsigned char* lds, const XcdInfo xi) {
    const int wave = __builtin_amdgcn_readfirstlane(threadIdx.x >> 6), lane = threadIdx.x & 63;
    const unsigned char* TU = p.ws + OFF_TU; const unsigned char* QX = p.ws + OFF_QX; const unsigned char* EIDX = p.ws + OFF_EIDX; float* PACT = (float*)(p.ws + OFF_PACT);
    const int t0 = xi.rank * 8 + wave, step = xi.nloc * 8, ntok = (T - t0 + step - 1) / step;
    const unsigned ring = __builtin_amdgcn_readfirstlane(lds_addr(lds + wave * 16384)), side = __builtin_amdgcn_readfirstlane(lds_addr(lds + 131072 + wave * 3072));
    LAS unsigned char* l0 = (LAS unsigned char*)0;
    for (int s = xi.px; s < 8; s += xi.npop) {
        const unsigned char* tus = TU + (size_t)s * 16384 * 128;
#define PU_SIDE(tt, dst) glds16_asm(lane < 32 ? (const void*)(EIDX + (size_t)(tt) * 512 + lane * 16) : (const void*)(QX + (size_t)(tt) * D + s * 128 + ((lane & 7) * 16)), dst)
        PU_SIDE(peer_tok(0, t0, step).t, side);
        PU_SIDE(peer_tok(1, t0, step).t, side + 1024);
        PV_WAIT_VM(0);
        pv_fill(tus, l0, side, ring, 0, lane); pv_fill(tus, l0, side, ring + 8192, 1, lane);
        for (int i = 0; i < ntok; ++i) {
            const unsigned sl_cur = side + (unsigned)(i % 3) * 1024, sl_nxt = side + (unsigned)((i + 1) % 3) * 1024, sl_nn = side + (unsigned)((i + 2) % 3) * 1024;
            i32x4 acc0[4], acc1[4];
#pragma unroll
            for (int n = 0; n < 4; ++n) { acc0[n] = (i32x4){0, 0, 0, 0}; acc1[n] = (i32x4){0, 0, 0, 0}; }
            if (i == 0) PV_WAIT_VM(8); else PV_WAIT_VM(16);
            pu_buffer(l0, ring, sl_cur, acc0, lane);
            PU_SIDE(peer_tok(i + 2, t0, step).t, sl_nn);
            pv_fill(tus, l0, sl_nxt, ring, 0, lane);
            PV_WAIT_VM(9);
            pu_buffer(l0, ring + 8192, sl_cur, acc1, lane);
            const PeerTok tk = peer_tok(i, t0, step);
            float* po = PACT + ((size_t)s * T + (tk.ok ? tk.t : 0)) * 128 + 4 * (lane >> 4);
            if ((lane & 15) == 0) {
#pragma unroll
                for (int mt = 0; mt < 4; ++mt) {
                    const f32x4 v0 = (f32x4){(float)acc0[mt][0], (float)acc0[mt][1], (float)acc0[mt][2], (float)acc0[mt][3]}, v1 = (f32x4){(float)acc1[mt][0], (float)acc1[mt][1], (float)acc1[mt][2], (float)acc1[mt][3]};
                    float* d0 = tk.ok ? po + 16 * mt : (float*)(p.ws + OFF_PO) , *d1 = tk.ok ? po + 64 + 16 * mt : (float*)(p.ws + OFF_PO);
                    asm volatile("global_store_dwordx4 %0, %1, off\n\ts_nop 1" :: "v"(d0), "v"(v0) : "memory");
                    asm volatile("global_store_dwordx4 %0, %1, off\n\ts_nop 1" :: "v"(d1), "v"(v1) : "memory"); }
            }
            pv_fill(tus, l0, sl_nxt, ring + 8192, 1, lane);
        }
        PV_WAIT_VM(0);
#undef PU_SIDE
    }
}
__device__ __forceinline__ void peer_final(const Params& p) {
    const int wave = threadIdx.x >> 6, lane = threadIdx.x & 63;
    float* OUT = p.out; const h16* H16 = (const h16*)(p.ws + OFF_H16); const h16* PO = (const h16*)(p.ws + OFF_PO); const float* mod = (const float*)(p.ws + OFF_MOD); const float* fg = p.in[19];
    for (int t0 = (blockIdx.x * 8 + wave) * 2; t0 < T; t0 += gridDim.x * 16) {
        h16x4 hv[2][4], ph[2][4];
#pragma unroll
        for (int q = 0; q < 2; ++q)
#pragma unroll
            for (int j = 0; j < 4; ++j) { const int cc = j * 256 + lane * 4; hv[q][j] = *(const h16x4*)(H16 + (size_t)(t0 + q) * D + cc); ph[q][j] = *(const h16x4*)(PO + (size_t)(t0 + q) * D + cc); }
        f32x4 gv4[4], fv4[4];
#pragma unroll
        for (int j = 0; j < 4; ++j) { const int cc = j * 256 + lane * 4; gv4[j] = *(const f32x4*)(mod + (t0 >> 12) * 6144 + 5120 + cc); fv4[j] = *(const f32x4*)(fg + cc); }
        __builtin_amdgcn_sched_barrier(0);
#pragma unroll
        for (int q = 0; q < 2; ++q) { const int t = t0 + q;
            f32x4 h2[4]; float ss = 0.f;
#pragma unroll
            for (int j = 0; j < 4; ++j) {
                const f32x4 pv = (f32x4){(float)ph[q][j][0], (float)ph[q][j][1], (float)ph[q][j][2], (float)ph[q][j][3]}, gv = gv4[j];
                h2[j] = (f32x4){(float)hv[q][j][0], (float)hv[q][j][1], (float)hv[q][j][2], (float)hv[q][j][3]} + gv * pv; ss += h2[j].x * h2[j].x + h2[j].y * h2[j].y + h2[j].z * h2[j].z + h2[j].w * h2[j].w; }
            ss = wave_sum(ss);
            const float rstd = rsqrtf(ss * (1.0f / D) + EPS);
#pragma unroll
            for (int j = 0; j < 4; ++j) { const int cc = j * 256 + lane * 4; const f32x4 fv = fv4[j];
                *(f32x4*)(OUT + (size_t)t * D + cc) = h2[j] * rstd * fv; }
        }
    }
}
#ifndef REP_A
#define REP_A 1
#endif
#ifndef REP_FT
#define REP_FT 1
#endif
#ifndef REP_DFT
#define REP_DFT 1
#endif
#ifndef REP_GATE
#define REP_GATE 1
#endif
#ifndef REP_M2
#define REP_M2 1
#endif
#ifndef REP_M1
#define REP_M1 1
#endif
#ifndef REP_SC
#define REP_SC 1
#endif
constexpr int N_PHASES = 15;
#ifndef MK_CGSYNC
#define MK_CGSYNC 0
#endif
__device__ __forceinline__ Params load_params(volatile LAS unsigned* pw) {
    Params q;
    unsigned long long v[22];
#pragma unroll
    for (int i = 0; i < 22; ++i) { const unsigned lo = (unsigned)__builtin_amdgcn_readfirstlane((int)pw[2 * i]), hi = (unsigned)__builtin_amdgcn_readfirstlane((int)pw[2 * i + 1]); v[i] = ((unsigned long long)hi << 32) | lo; }
#pragma unroll
    for (int i = 0; i < 20; ++i) q.in[i] = (const float*)(const GAS float*)v[i];
    q.out = (float*)(GAS float*)v[20]; q.ws = (unsigned char*)(GAS unsigned char*)v[21];
    q.ph_lo = __builtin_amdgcn_readfirstlane((int)pw[44]); q.ph_hi = __builtin_amdgcn_readfirstlane((int)pw[45]);
    return q;
}
__global__ void __launch_bounds__(NTHREADS, 2) mega(Params pk) {
    extern __shared__ __attribute__((aligned(16))) unsigned char smem[];
    LAS unsigned char* lds = (LAS unsigned char*)smem;
    const int G = gridDim.x, c = blockIdx.x;
    volatile LAS unsigned* pw = (volatile LAS unsigned*)(lds + LDS_BYTES - 512);
    if (threadIdx.x == 0) {
#pragma unroll
        for (int i = 0; i < 20; ++i) { const unsigned long long v = (unsigned long long)pk.in[i]; pw[2 * i] = (unsigned)v; pw[2 * i + 1] = (unsigned)(v >> 32); }
        { const unsigned long long v = (unsigned long long)pk.out; pw[40] = (unsigned)v; pw[41] = (unsigned)(v >> 32); }
        { const unsigned long long v = (unsigned long long)pk.ws; pw[42] = (unsigned)v; pw[43] = (unsigned)(v >> 32); }
        pw[44] = (unsigned)pk.ph_lo; pw[45] = (unsigned)pk.ph_hi;
    }
    unsigned* ctl = (unsigned*)(pk.ws + OFF_CTL);
    volatile LAS unsigned* misc = (volatile LAS unsigned*)(lds + LDS_BYTES - 64);
    if (threadIdx.x < 16) misc[threadIdx.x] = 0u;
    __syncthreads();
    const bool fused = (pk.ph_hi - pk.ph_lo) > 1;
    XcdBarrier bar; bar.bar = ctl; bar.x = 0; bar.st = misc;
    if (fused) {
        bar = xcd_barrier_post(ctl, misc);
        if (threadIdx.x == 0) misc[2] = xb_add(&ctl[CTL_RANK + 64 * bar.x], 1u);
    }
#define IN(k) (ph_lo <= (k) && (k) < ph_hi)
#if MK_CGSYNC
#define SEAM(k) do { if (IN(k) && IN((k) + 1)) { cg::grid_group grid = cg::this_grid(); grid.sync(); } } while (0)
#else
#define SEAM(k) do { if (IN(k) && IN((k) + 1)) xcd_barrier(bar); } while (0)
#endif
#define PHASE_BEGIN(k) if (IN(k)) { const Params p = load_params(pw); unsigned char* const ws = p.ws; (void)ws;
#define PHASE_END(k) } SEAM(k);
    const int ph_lo = pk.ph_lo, ph_hi = pk.ph_hi;
    PHASE_BEGIN(0) phase0(p, lds); PHASE_END(0)
    PHASE_BEGIN(1)
        const float* mod = (const float*)(ws + OFF_MOD);
        modulate_rows<false>(p.in[0], (h16*)(ws + OFF_UALL), T, p.in[6], mod, 0, 1024, 0, c, G);
        modulate_rows<false>(p.in[2], (h16*)(ws + OFF_UALL) + (size_t)T * D, TC, p.in[6], mod, 0, 1024, 1, c, G);
    PHASE_END(1)
    PHASE_BEGIN(2)
        { pg8::Gemm g{ws + OFF_UALL, ws + OFF_WA, 1024, 1024, 1024}; OrderA S; S.init(G, c, REP_A); EpiA E{ws}; pg8::gemm_phase(lds, g, S, E); }
        { pg8::Gemm g{ws + OFF_UALL, ws + OFF_WF, 1024, 1024, 1024}; pg8::TileOrder S; S.init(128, 4, G, c, REP_FT); EpiFT E{ws}; pg8::gemm_phase(lds, g, S, E); }
        if (G > 96) { if (c >= 48) convert_tables(p, c - 48, G - 48); } else convert_tables(p, c, G);
    PHASE_END(2)
    PHASE_BEGIN(3) for (int it = blockIdx.x; it < 192; it += gridDim.x) hgrn_mfma_unit<false>(p, lds, it / 3, it % 3);
        fft1_phase(p, lds); PHASE_END(3)
    PHASE_BEGIN(4) for (int it = blockIdx.x; it < 256; it += gridDim.x) hgrn_mfma_unit<true>(p, lds, it >> 2, it & 3); PHASE_END(4)
    PHASE_BEGIN(5)
        const bool mem_first = ((c >> 3) & 1) == 0;
        if (mem_first) a1_prepass(p);
        { pg8::Gemm g{ws + OFF_DFT256, ws + OFF_Y1, 512, 512, 512}; pg8::TileOrder S; S.init(1, 256, G, c, REP_DFT); EpiDFT E{ws}; pg8::gemm_phase(lds, g, S, E); }
        { pg8::Gemm g{ws + OFF_UALL, ws + OFF_WG, 1024, 1024, 1024}; pg8::TileOrder S; S.init(128, 8, G, c, REP_GATE); EpiGate E{ws}; pg8::gemm_phase(lds, g, S, E); }
        if (!mem_first) a1_prepass(p);
    PHASE_END(5)
    PHASE_BEGIN(6)
        if (G >= 16 && (G & 15) == 0) { if ((c >> 3) & 1) scale_wout(p, ((c >> 4) << 3) | (c & 7), G >> 1); } else scale_wout(p, c, G);
        { pg8::Gemm g{ws + OFF_G, ws + OFF_WHG, 512, 512, 512}; pg8::TileOrder S; S.init(128, 4, G, c, REP_M1); EpiMerge1<false> E{ws}; pg8::gemm_phase(lds, g, S, E); }
        { pg8::Gemm g{ws + OFF_YFT, ws + OFF_WFT, 512, 512, 512}; pg8::TileOrder S; S.init(128, 4, G, c); EpiMerge1<true> E{ws}; pg8::gemm_phase(lds, g, S, E); }
    PHASE_END(6)
    PHASE_BEGIN(7)
        pg8::Gemm g{ws + OFF_Y, ws + OFF_WOUTG, 1024, 1024, 1024}; pg8::TileOrder S; S.init(128, 4, G, c, REP_M2);
        EpiMerge2 E; E.x = p.in[0]; E.H = (h16*)(ws + OFF_H16); pg8::gemm_phase(lds, g, S, E);
    PHASE_END(7)
    PHASE_BEGIN(8) modulate_rows<true>(ws + OFF_H16, (h16*)(ws + OFF_U2), T, p.in[7], (const float*)(ws + OFF_MOD), 3072, 4096, 0, c, G, (signed char*)(ws + OFF_QX), (float*)(ws + OFF_SX)); PHASE_END(8)
    PHASE_BEGIN(9)
        pg8::Gemm g{ws + OFF_U2, ws + OFF_WS, 1024, 1024, 1024}; pg8::TileOrder S; S.init(128, 8, G, c, REP_SC);
#ifdef STAGGER_US
        if (c & 8) { const unsigned long long t0_ = __builtin_amdgcn_s_memrealtime(); while (__builtin_amdgcn_s_memrealtime() - t0_ < (unsigned long long)(STAGGER_US * 100)) __builtin_amdgcn_s_sleep(8); }
#endif
        EpiScores E; E.C = ws + OFF_SC; pg8::gemm_phase(lds, g, S, E);
    PHASE_END(9)
    PHASE_BEGIN(10) topk_phase(p, lds); PHASE_END(10)
    XcdInfo xi;
    if (fused) {
        unsigned cnt[8]; int npop = 0, px = 0;
#pragma unroll
        for (int j = 0; j < 8; ++j) { cnt[j] = xb_ld(&ctl[CTL_RANK + 64 * j]); if (j < (int)(bar.x & 7u)) px += (cnt[j] > 0u); npop += (cnt[j] > 0u); }
        xi.px = px; xi.npop = npop > 0 ? npop : 1; xi.rank = (int)misc[2]; xi.nloc = (int)cnt[bar.x & 7u]; if (xi.nloc < 1) xi.nloc = 1;
    } else { xi.px = c & 7; xi.npop = 8; xi.rank = c >> 3; xi.nloc = G >> 3; }
    #ifdef PEER_U_MFMA
    PHASE_BEGIN(11) peer_u_phase_mfma(p, lds, xi); PHASE_END(11)
#else
    PHASE_BEGIN(11) peer_u_phase(p, xi); PHASE_END(11)
#endif
    PHASE_BEGIN(12) peer_combine(p); PHASE_END(12)
    PHASE_BEGIN(13) peer_v_phase(p, lds, xi); PHASE_END(13)
    PHASE_BEGIN(14) peer_final(p); }
#undef IN
#undef SEAM
#undef PHASE_BEGIN
#undef PHASE_END
}

#ifndef MK_SINGLE
#define MK_SINGLE 1
#endif
extern "C" void kernel_launch(void* const* d_in, const int* in_sizes, int n_in, void* d_out, int out_size, void* d_ws, size_t ws_size, hipStream_t stream) {
    static int grid = 0;
    if (grid == 0) {
        if (n_in != 20 || out_size != T * D || ws_size < WS_NEED) { fprintf(stderr, "kernel_launch: unexpected shapes (n_in %d out %d ws %zu)\n", n_in, out_size, ws_size); grid = -1; return; }
        int dev = 0, cus = 0, per_cu = 0;
        hipGetDevice(&dev); hipDeviceGetAttribute(&cus, hipDeviceAttributeMultiprocessorCount, dev);
        if (hipFuncSetAttribute((const void*)mega, hipFuncAttributeMaxDynamicSharedMemorySize, LDS_BYTES) != hipSuccess) { fprintf(stderr, "kernel_launch: hipFuncSetAttribute failed\n"); grid = -1; return; }
        hipOccupancyMaxActiveBlocksPerMultiprocessor(&per_cu, (const void*)mega, NTHREADS, LDS_BYTES);
        if (per_cu < 1) { fprintf(stderr, "kernel_launch: occupancy query says %d blocks per CU\n", per_cu); grid = -1; return; }
        grid = cus;
    }
    if (grid < 0) return;
    if (hipMemsetAsync((char*)d_ws + OFF_CTL, 0, CTL_ZERO_BYTES, stream) != hipSuccess) { fprintf(stderr, "kernel_launch: memset failed\n"); return; }
    Params p{};
    for (int i = 0; i < 20; ++i) p.in[i] = (const float*)d_in[i];
    p.out = (float*)d_out; p.ws = (unsigned char*)d_ws;
#if MK_SINGLE
    p.ph_lo = 0; p.ph_hi = N_PHASES;
    void* args[] = {&p};
    hipError_t e = hipLaunchCooperativeKernel((const void*)mega, dim3(grid), dim3(NTHREADS), args, LDS_BYTES, stream);
    if (e != hipSuccess) fprintf(stderr, "cooperative launch failed: %s (grid %d)\n", hipGetErrorString(e), grid);
#else
    for (int ph = 0; ph < N_PHASES; ++ph) { p.ph_lo = ph; p.ph_hi = ph + 1; hipLaunchKernelGGL(mega, dim3(grid), dim3(NTHREADS), LDS_BYTES, stream, p); }
#endif
}
```
